# Optimizing an MI355X kernel written in HIP

```python
import math
import jax, jax.numpy as jnp
from jax import lax
import numpy as np

D_MODEL = 1024
BATCH = 8
SEQ = 8192
DEPTH = 2

GRID_W = 64
CTX_LEN = 256
MIX_WIDTH = D_MODEL
F_WIDTH = D_MODEL // 4
F_GROUPS = 4
F_GROUP_DIM = F_WIDTH // F_GROUPS
ATT_WIDTH = D_MODEL // 2
ATT_HEADS = 4
V_DIM = ATT_WIDTH // ATT_HEADS
QK_DIM = V_DIM // 2
ATT_SCALE = QK_DIM ** -0.5
Q_BLOCK = 128
ROPE_HALF = QK_DIM // 2
ROPE_FREQS = ROPE_HALF // 2
ROPE_BASE = 10000.0
LRU_WIDTH = D_MODEL // 4
LRU_BLOCKS = 4
LRU_BLOCK_DIM = LRU_WIDTH // LRU_BLOCKS
LRU_C = 8.0
CONV_W = 4
CONV_LEFT = (CONV_W - 1) // 2
Q_OFF = F_WIDTH
K_OFF = Q_OFF + ATT_HEADS * 2 * QK_DIM
V_OFF = K_OFF + ATT_HEADS * 2 * QK_DIM
Y_OFF = V_OFF + ATT_WIDTH
R_OFF = Y_OFF + LRU_WIDTH
IN_WIDTH = R_OFF + LRU_WIDTH
N_GROUPS = 4
EXPERTS_PER_GROUP = 8
N_EXPERTS = N_GROUPS * EXPERTS_PER_GROUP
TOP_K = 2
D_EXPERT = D_MODEL // 2
MOE_BLOCK = 256
N_MOD = 6
EPS = 1e-6

kernel_name = 'hybrid_fourier_diffattn_rglru_hmoe_dit'


def _rms(x, g):
    xf = x.astype(jnp.float32)
    y = xf * lax.rsqrt(jnp.mean(xf * xf, axis=-1, keepdims=True) + EPS)
    return (y * g.astype(jnp.float32)).astype(x.dtype)


def _modulation(cond, w, b):
    m = jax.nn.silu(cond) @ w + b
    return [m[:, None, i * D_MODEL:(i + 1) * D_MODEL] for i in range(N_MOD)]


def _adaln(x, g, shift, scale):
    return _rms(x, g) * (1 + scale) + shift


def _fourier_mix(u):
    B, T, _ = u.shape
    z = u.astype(jnp.float32).reshape(B, T, F_GROUPS, F_GROUP_DIM)
    y = jnp.fft.fft2(z, axes=(1, 3), norm='ortho').real
    return y.reshape(B, T, F_WIDTH).astype(u.dtype)


def _rope_axis(x, ang):
    cos = jnp.cos(ang)[None, :, None, None, :]
    sin = jnp.sin(ang)[None, :, None, None, :]
    x1, x2 = x[..., :ROPE_FREQS], x[..., ROPE_FREQS:]
    return jnp.concatenate([x1 * cos - x2 * sin, x2 * cos + x1 * sin], axis=-1)


def _rope2d(x, ang_row, ang_col):
    y = jnp.concatenate([_rope_axis(x[..., :ROPE_HALF], ang_row),
                         _rope_axis(x[..., ROPE_HALF:], ang_col)], axis=-1)
    return y.astype(x.dtype)


def _diff_attend(q, k, v, lam):
    s = jnp.einsum('bqhmd,bkhmd->bhmqk', q, k).astype(jnp.float32) * ATT_SCALE
    p = jax.nn.softmax(s, axis=-1)
    a = p[:, :, 0] - lam * p[:, :, 1]
    return jnp.einsum('bhqk,bkhd->bqhd', a.astype(v.dtype), v)


def _diff_head_out(o, subln_g, lam_init):
    B, T = o.shape[0], o.shape[1]
    return (_rms(o, subln_g) * (1 - lam_init)).reshape(B, T, ATT_WIDTH)


def _dwconv_centred(x, w, b):
    T = x.shape[1]
    xp = jnp.pad(x, ((0, 0), (CONV_LEFT, CONV_W - 1 - CONV_LEFT), (0, 0)))
    out = b
    for k in range(CONV_W):
        out = out + xp[:, k:k + T] * w[k]
    return out


def _rglru_coeffs(xr, w_a, b_a, w_x, b_x, lam):
    B, T, _ = xr.shape
    xg = xr.reshape(B, T, LRU_BLOCKS, LRU_BLOCK_DIM)
    r = jax.nn.sigmoid(jnp.einsum('btgi,gio->btgo', xg, w_a).reshape(B, T, LRU_WIDTH) + b_a)
    i = jax.nn.sigmoid(jnp.einsum('btgi,gio->btgo', xg, w_x).reshape(B, T, LRU_WIDTH) + b_x)
    log_a = -LRU_C * r.astype(jnp.float32) * jax.nn.softplus(-lam.astype(jnp.float32))
    a = jnp.exp(log_a)
    bt = jnp.sqrt(-jnp.expm1(2.0 * log_a)) * (i * xr).astype(jnp.float32)
    return a, bt


def _scan_combine(left, right):
    a_l, b_l = left
    a_r, b_r = right
    return a_l * a_r, a_r * b_l + b_r


def _linear_scan(a, b, h0, reverse):
    if h0 is not None:
        idx = -1 if reverse else 0
        b = b.at[:, idx].add(a[:, idx] * h0)
    _, h = lax.associative_scan(_scan_combine, (a, b), reverse=reverse, axis=1)
    return h


def _mixer(hx, hc, p, lam_init, need_ctx):
    B, S, _ = hx.shape
    ux = hx @ p['w_in']
    uc = hc @ p['w_in']

    def split_qkv(u):
        T = u.shape[1]
        q = _rms(u[..., Q_OFF:K_OFF].reshape(B, T, ATT_HEADS, 2, QK_DIM), p['q_norm_g'])
        k = _rms(u[..., K_OFF:V_OFF].reshape(B, T, ATT_HEADS, 2, QK_DIM), p['k_norm_g'])
        v = u[..., V_OFF:Y_OFF].reshape(B, T, ATT_HEADS, V_DIM)
        return q, k, v

    qx, kx, vx = split_qkv(ux)
    qc, kc, vc = split_qkv(uc)
    rows_n = S // GRID_W
    row = jnp.repeat(jnp.arange(rows_n, dtype=jnp.float32), GRID_W)
    col = jnp.tile(jnp.arange(GRID_W, dtype=jnp.float32), rows_n)
    freqs = ROPE_BASE ** (-jnp.arange(ROPE_FREQS, dtype=jnp.float32) / ROPE_FREQS)
    ang_r = row[:, None] * freqs
    ang_c = col[:, None] * freqs
    qx = _rope2d(qx, ang_r, ang_c)
    kx = _rope2d(kx, ang_r, ang_c)
    lam = (jnp.exp(jnp.sum(p['lq1'] * p['lk1']).astype(jnp.float32))
           - jnp.exp(jnp.sum(p['lq2'] * p['lk2']).astype(jnp.float32)) + lam_init)
    k_all = jnp.concatenate([kc, kx], axis=1)
    v_all = jnp.concatenate([vc, vx], axis=1)
    nb = S // Q_BLOCK
    qb = qx.reshape(B, nb, Q_BLOCK, ATT_HEADS, 2, QK_DIM).transpose(1, 0, 2, 3, 4, 5)
    ob = lax.map(lambda qq: _diff_attend(qq, k_all, v_all, lam), qb)
    att_x = _diff_head_out(ob.transpose(1, 0, 2, 3, 4).reshape(B, S, ATT_HEADS, V_DIM),
                           p['subln_g'], lam_init)

    def coeffs(xr, d):
        return _rglru_coeffs(xr, p['gate_a_w'][d], p['gate_a_b'][d], p['gate_x_w'][d],
                             p['gate_x_b'][d], p['lru_lambda'][d])

    xr_c = _dwconv_centred(uc[..., R_OFF:], p['conv_w'], p['conv_b'])
    xr_x = _dwconv_centred(ux[..., R_OFF:], p['conv_w'], p['conv_b'])
    a, bt = coeffs(xr_c, 0)
    hc_f = _linear_scan(a, bt, None, False)
    a, bt = coeffs(xr_c, 1)
    hc_b = _linear_scan(a, bt, None, True)
    a, bt = coeffs(xr_x, 0)
    hx_f = _linear_scan(a, bt, hc_f[:, -1], False)
    a, bt = coeffs(xr_x, 1)
    hx_b = _linear_scan(a, bt, hc_b[:, 0], True)
    rec_x = (jax.nn.gelu(ux[..., Y_OFF:R_OFF]).astype(jnp.float32) * (hx_f + hx_b)).astype(hx.dtype)

    y_x = jnp.concatenate([_fourier_mix(ux[..., :F_WIDTH]), att_x, rec_x], axis=-1) @ p['w_out']
    if not need_ctx:
        return y_x, None
    att_c = _diff_head_out(_diff_attend(qc, kc, vc, lam), p['subln_g'], lam_init)
    rec_c = (jax.nn.gelu(uc[..., Y_OFF:R_OFF]).astype(jnp.float32) * (hc_f + hc_b)).astype(hc.dtype)
    y_c = jnp.concatenate([_fourier_mix(uc[..., :F_WIDTH]), att_c, rec_c], axis=-1) @ p['w_out']
    return y_x, y_c


def _hier_moe(xt, w_group, b_group, w_router, b_router, w1, w3, w2):
    N, D = xt.shape
    gp = jax.nn.softmax((xt @ w_group).astype(jnp.float32) + b_group, axis=-1)
    g_idx = jnp.argmax(gp, axis=-1).astype(jnp.int32)
    p_g = jnp.take_along_axis(gp, g_idx[:, None], axis=1)
    el = (xt @ w_router).astype(jnp.float32) + b_router
    cols = g_idx[:, None] * EXPERTS_PER_GROUP + jnp.arange(EXPERTS_PER_GROUP, dtype=jnp.int32)[None]
    el_g = jnp.take_along_axis(el, cols, axis=1)
    top_v, top_i = lax.top_k(el_g, TOP_K)
    wts = jax.nn.softmax(top_v, axis=-1) * p_g
    eid = g_idx[:, None] * EXPERTS_PER_GROUP + top_i.astype(jnp.int32)

    A = N * TOP_K
    eid_f = eid.reshape(A)
    tok_f = jnp.repeat(jnp.arange(N, dtype=jnp.int32), TOP_K)
    w_f = wts.reshape(A)
    order = jnp.argsort(eid_f)
    se, st, sw = eid_f[order], tok_f[order], w_f[order]
    counts = jnp.zeros((N_EXPERTS,), jnp.int32).at[eid_f].add(1)
    starts = jnp.cumsum(counts) - counts
    padded = (counts + MOE_BLOCK - 1) // MOE_BLOCK * MOE_BLOCK
    pends = jnp.cumsum(padded)
    pstarts = pends - padded
    dest = pstarts[se] + jnp.arange(A, dtype=jnp.int32) - starts[se]
    n_blocks = -(-A // MOE_BLOCK) + N_EXPERTS
    P = n_blocks * MOE_BLOCK
    slot_tok = jnp.full((P,), N, jnp.int32).at[dest].set(st)
    slot_w = jnp.zeros((P,), jnp.float32).at[dest].set(sw)
    block_exp = jnp.minimum(jnp.searchsorted(pends, jnp.arange(n_blocks, dtype=jnp.int32) * MOE_BLOCK,
                                             side='right'), N_EXPERTS - 1).astype(jnp.int32)
    xpad = jnp.concatenate([xt, jnp.zeros((1, D), xt.dtype)], axis=0)

    def body(acc, blk):
        e, toks, ws = blk
        xb = xpad[toks]
        hb = jax.nn.silu(xb @ w1[e]) * (xb @ w3[e])
        yb = (hb @ w2[e]) * ws[:, None].astype(xb.dtype)
        return acc.at[toks].add(yb), None

    acc, _ = lax.scan(body, jnp.zeros((N + 1, D), xt.dtype),
                      (block_exp, slot_tok.reshape(n_blocks, MOE_BLOCK), slot_w.reshape(n_blocks, MOE_BLOCK)))
    return acc[:N]


def setup_inputs(seed: int = 0) -> dict:
    key = jax.random.key(seed)
    ks = jax.random.split(key, 32)
    L, D = DEPTH, D_MODEL

    def nrm(k, shape, s):
        return jax.random.normal(k, shape, jnp.float32) * s

    u = jax.random.uniform(ks[22], (L, 2, LRU_WIDTH), jnp.float32, minval=0.9, maxval=0.999)
    s_lru = u ** (1.0 / LRU_C)
    return {
        'x': nrm(ks[0], (BATCH, SEQ, D), 1.0),
        'c': nrm(ks[1], (BATCH, D), 1.0),
        'ctx': nrm(ks[2], (BATCH, CTX_LEN, D), 1.0),
        'c_ctx': nrm(ks[3], (D,), 1.0),
        'w_mod': nrm(ks[4], (L, D, N_MOD * D), 0.5 * D ** -0.5),
        'b_mod': nrm(ks[5], (L, N_MOD * D), 0.01),
        'norm1_g': 1.0 + nrm(ks[6], (L, D), 0.02),
        'norm2_g': 1.0 + nrm(ks[7], (L, D), 0.02),
        'w_in': nrm(ks[8], (L, D, IN_WIDTH), D ** -0.5),
        'q_norm_g': 1.0 + nrm(ks[9], (L, QK_DIM), 0.02),
        'k_norm_g': 1.0 + nrm(ks[10], (L, QK_DIM), 0.02),
        'lambda_q1': nrm(ks[11], (L, QK_DIM), 0.1),
        'lambda_k1': nrm(ks[12], (L, QK_DIM), 0.1),
        'lambda_q2': nrm(ks[13], (L, QK_DIM), 0.1),
        'lambda_k2': nrm(ks[14], (L, QK_DIM), 0.1),
        'subln_g': 1.0 + nrm(ks[15], (L, V_DIM), 0.02),
        'conv_w': nrm(ks[16], (L, CONV_W, LRU_WIDTH), CONV_W ** -0.5),
        'conv_b': nrm(ks[17], (L, LRU_WIDTH), 0.01),
        'gate_a_w': nrm(ks[18], (L, 2, LRU_BLOCKS, LRU_BLOCK_DIM, LRU_BLOCK_DIM), LRU_BLOCK_DIM ** -0.5),
        'gate_a_b': nrm(ks[19], (L, 2, LRU_WIDTH), 0.01),
        'gate_x_w': nrm(ks[20], (L, 2, LRU_BLOCKS, LRU_BLOCK_DIM, LRU_BLOCK_DIM), LRU_BLOCK_DIM ** -0.5),
        'gate_x_b': nrm(ks[21], (L, 2, LRU_WIDTH), 0.01),
        'lru_lambda': jnp.log(s_lru) - jnp.log1p(-s_lru),
        'w_out': nrm(ks[23], (L, MIX_WIDTH, D), MIX_WIDTH ** -0.5),
        'w_group': nrm(ks[24], (L, D, N_GROUPS), D ** -0.5),
        'b_group': nrm(ks[25], (L, N_GROUPS), 0.01),
        'w_router': nrm(ks[26], (L, D, N_EXPERTS), D ** -0.5),
        'b_router': nrm(ks[27], (L, N_EXPERTS), 0.01),
        'w1': nrm(ks[28], (L, N_EXPERTS, D, D_EXPERT), D ** -0.5),
        'w3': nrm(ks[29], (L, N_EXPERTS, D, D_EXPERT), D ** -0.5),
        'w2': nrm(ks[30], (L, N_EXPERTS, D_EXPERT, D), D_EXPERT ** -0.5),
    }


def reference(x, c, ctx, c_ctx, w_mod, b_mod, norm1_g, norm2_g, w_in, q_norm_g, k_norm_g,
              lambda_q1, lambda_k1, lambda_q2, lambda_k2, subln_g, conv_w, conv_b,
              gate_a_w, gate_a_b, gate_x_w, gate_x_b, lru_lambda, w_out,
              w_group, b_group, w_router, b_router, w1, w3, w2):
    B, S, D = x.shape
    xc = ctx
    for l in range(DEPTH):
        last = l == DEPTH - 1
        lam_init = 0.8 - 0.6 * math.exp(-0.3 * l)
        sh1, sc1, g1, sh2, sc2, g2 = _modulation(c, w_mod[l], b_mod[l])
        csh1, csc1, cg1, csh2, csc2, cg2 = _modulation(c_ctx[None], w_mod[l], b_mod[l])
        p = {
            'w_in': w_in[l], 'q_norm_g': q_norm_g[l], 'k_norm_g': k_norm_g[l],
            'lq1': lambda_q1[l], 'lk1': lambda_k1[l], 'lq2': lambda_q2[l], 'lk2': lambda_k2[l],
            'subln_g': subln_g[l], 'conv_w': conv_w[l], 'conv_b': conv_b[l],
            'gate_a_w': gate_a_w[l], 'gate_a_b': gate_a_b[l], 'gate_x_w': gate_x_w[l],
            'gate_x_b': gate_x_b[l], 'lru_lambda': lru_lambda[l], 'w_out': w_out[l],
        }
        y_x, y_c = _mixer(_adaln(x, norm1_g[l], sh1, sc1), _adaln(xc, norm1_g[l], csh1, csc1),
                          p, lam_init, not last)
        x = x + g1 * y_x
        hx2 = _adaln(x, norm2_g[l], sh2, sc2).reshape(B * S, D)
        if last:
            y = _hier_moe(hx2, w_group[l], b_group[l], w_router[l], b_router[l], w1[l], w3[l], w2[l])
            x = x + g2 * y.reshape(B, S, D)
        else:
            xc = xc + cg1 * y_c
            hc2 = _adaln(xc, norm2_g[l], csh2, csc2).reshape(-1, D)
            nc = hc2.shape[0]
            y = _hier_moe(jnp.concatenate([hc2, hx2], axis=0), w_group[l], b_group[l],
                          w_router[l], b_router[l], w1[l], w3[l], w2[l])
            xc = xc + cg2 * y[:nc].reshape(xc.shape)
            x = x + g2 * y[nc:].reshape(B, S, D)
    return x
```

```cpp
#include <hip/hip_runtime.h>
#include <hip/hip_cooperative_groups.h>
#include <cstdio>
namespace cg = cooperative_groups;

typedef _Float16 half_t;
typedef _Float16 h8 __attribute__((ext_vector_type(8)));
typedef _Float16 h4 __attribute__((ext_vector_type(4)));
typedef __fp16 fp16x2 __attribute__((ext_vector_type(2)));
typedef unsigned u4 __attribute__((ext_vector_type(4)));
typedef float f4 __attribute__((ext_vector_type(4)));
typedef float f16v __attribute__((ext_vector_type(16)));
#define DI __device__ __forceinline__
__device__ __forceinline__ int tid_opaque() { int t = threadIdx.x; asm volatile("" : "+v"(t)); return t; }
#define TIDX tid_opaque()

constexpr int D = 1024, NB_ = 8, SEQ = 8192, CL = 256;
constexpr int TC = NB_ * CL;
constexpr int TX = NB_ * SEQ;
constexpr int TA = TC + TX;
constexpr int KV = CL + SEQ;
constexpr int NIN = 2560;
constexpr int LCAP = 2 * TA;
constexpr float EPS = 1e-6f;

struct Params {
  const float *x, *c, *ctx, *c_ctx, *w_mod, *b_mod, *norm1_g, *norm2_g, *w_in, *q_norm_g, *k_norm_g, *lq1, *lk1, *lq2, *lk2,
      *subln_g, *conv_w, *conv_b, *gate_a_w, *gate_a_b, *gate_x_w, *gate_x_b, *lru_lambda, *w_out, *w_group, *b_group,
      *w_router, *b_router, *w1, *w3, *w2;
  float* out;
  half_t *WtIn, *WtOut, *Wt1, *Wt3, *Wt2;
  float* mod; float2* rope; float2* tw; half_t *DA, *DB, *DC; float* consts; int* cnt; int* qctr; float* tokW; int* list;
  float* xcbuf; float* WrT;
  half_t *hx, *mix, *q, *kall, *vT, *QF, *gy, *rr; float* hf; half_t* GA; half_t *H, *yA;
};

DI float wave_sum(float v) {
#pragma unroll
  for (int o = 32; o; o >>= 1) v += __shfl_xor(v, o);
  return v;
}
DI void glds16(const void* g, void* l) {
  __builtin_amdgcn_global_load_lds((const unsigned*)g, (unsigned*)l, 16, 0, 0);
}
DI void wait_vm0() { asm volatile("s_waitcnt vmcnt(0)" ::: "memory"); }
DI f4 mfma16(h8 a, h8 b, f4 c) { return __builtin_amdgcn_mfma_f32_16x16x32_f16(a, b, c, 0, 0, 0); }
DI f16v mfma32(h8 a, h8 b, f16v c) { return __builtin_amdgcn_mfma_f32_32x32x16_f16(a, b, c, 0, 0, 0); }
DI unsigned pk2(float a, float b) { fp16x2 r = __builtin_amdgcn_cvt_pkrtz(a, b); return __builtin_bit_cast(unsigned, r); }
DI float sigmoidf_(float x) { return 1.f / (1.f + __expf(-x)); }
DI float gelu_tanh(float x) {
  float u = 0.7978845608028654f * (x + 0.044715f * x * x * x);
  float e = __expf(2.f * u);
  float t = 1.f - 2.f / (e + 1.f);
  return 0.5f * x * (1.f + t);
}
DI int row_mod(int r) { return r < TC ? 8 : ((r - TC) >> 13); }

DI void transpose_tile(const float* src, int lds_, half_t* dst, int ldd, float* tile) {
  const int tid = TIDX, n = tid & 63, kq = tid >> 6;
#pragma unroll 4
  for (int i = 0; i < 16; i++) { int k = i * 4 + kq; tile[k * 65 + n] = src[(size_t)k * lds_ + n]; }
  __syncthreads();
#pragma unroll 4
  for (int i = 0; i < 16; i++) { int nn = i * 4 + kq; dst[(size_t)nn * ldd + n] = (half_t)tile[n * 65 + nn]; }
  __syncthreads();
}

DI void phase0(const Params& P, char* smem) {
  float* tile = (float*)smem;
  const int tid = TIDX;
  constexpr int NT = 26112, NF = 128, NM = 192, NX = 6;
  for (int t = blockIdx.x; t < NT + NF + NM + NX; t += gridDim.x) {
    if (t < NT) {
      const float* src; half_t* dst; int lds_, ldd;
      if (t < 1024) {
        int l = t / 512, r = t % 512, kt = r / 32, nt = r % 32;
        src = P.w_in + (size_t)l * 1024 * 2304 + (size_t)kt * 64 * 2304 + 256 + nt * 64; lds_ = 2304;
        dst = P.WtIn + (size_t)l * NIN * 1024 + (size_t)(512 + nt * 64) * 1024 + kt * 64; ldd = 1024;
      } else if (t < 1536) {
        int u = t - 1024, l = u / 256, r = u % 256, kt = r / 16, nt = r % 16;
        src = P.w_out + (size_t)l * 1048576 + (size_t)kt * 64 * 1024 + nt * 64; lds_ = 1024;
        dst = P.WtOut + (size_t)l * 1048576 + (size_t)nt * 64 * 1024 + kt * 64; ldd = 1024;
      } else if (t < 1536 + 16384) {
        int u = t - 1536; const float* w = P.w1; half_t* o = P.Wt1;
        if (u >= 8192) { u -= 8192; w = P.w3; o = P.Wt3; }
        int le = u / 128, r = u % 128, kt = r / 8, nt = r % 8;
        src = w + (size_t)le * 524288 + (size_t)kt * 64 * 512 + nt * 64; lds_ = 512;
        dst = o + (size_t)le * 524288 + (size_t)nt * 64 * 1024 + kt * 64; ldd = 1024;
      } else {
        int u = t - 1536 - 16384, le = u / 128, r = u % 128, kt = r / 16, nt = r % 16;
        src = P.w2 + (size_t)le * 524288 + (size_t)kt * 64 * 1024 + nt * 64; lds_ = 1024;
        dst = P.Wt2 + (size_t)le * 524288 + (size_t)nt * 64 * 512 + kt * 64; ldd = 512;
      }
      transpose_tile(src, lds_, dst, ldd, tile);
    } else if (t < NT + NF) {
      int f = t - NT, l = f / 64, r = f % 64, kt = r / 4, g = r % 4;
      float* cst = tile + 64 * 65; float* snt = cst + 64;
      const float* src = P.w_in + (size_t)l * 1024 * 2304 + (size_t)kt * 64 * 2304 + g * 64;
      { int n = tid & 63, kq = tid >> 6;
        for (int i = 0; i < 16; i++) { int k = i * 4 + kq; tile[k * 65 + n] = src[(size_t)k * 2304 + n]; } }
      if (tid < 64) { float s, c; sincospif((float)tid / 32.f, &s, &c); cst[tid] = c; snt[tid] = s; }
      __syncthreads();
      int k = tid & 63, jq = tid >> 6;
      half_t* o = P.WtIn + (size_t)l * NIN * 1024 + kt * 64 + k;
      for (int jj = 0; jj < 16; jj++) {
        int j = jq * 16 + jj; float ac = 0.f, as = 0.f;
        for (int c = 0; c < 64; c++) { float v = tile[k * 65 + c]; int idx = (c * j) & 63; ac += v * cst[idx]; as += v * snt[idx]; }
        o[(size_t)(g * 64 + j) * 1024] = (half_t)(ac * 0.125f);
        o[(size_t)(256 + g * 64 + j) * 1024] = (half_t)(-as * 0.125f);
      }
      __syncthreads();
    } else if (t < NT + NF + NM) {
      int mi = t - NT - NF, l = mi / 96, col0 = (mi % 96) * 64;
      float* scond = tile; float* red = tile + 9216;
      for (int idx = tid; idx < 9216; idx += 256) {
        int n = idx >> 10, k = idx & 1023; float v = n < 8 ? P.c[n * 1024 + k] : P.c_ctx[k];
        scond[idx] = v / (1.f + expf(-v));
      }
      __syncthreads();
      int col = tid & 63, kq = tid >> 6; float acc[9];
#pragma unroll
      for (int n = 0; n < 9; n++) acc[n] = 0.f;
      const float* w = P.w_mod + ((size_t)l * 1024 + kq * 256) * 6144 + col0 + col;
#pragma unroll 4
      for (int k = 0; k < 256; k++) {
        float wv = w[(size_t)k * 6144];
#pragma unroll
        for (int n = 0; n < 9; n++) acc[n] += scond[n * 1024 + kq * 256 + k] * wv;
      }
#pragma unroll
      for (int n = 0; n < 9; n++) red[(kq * 9 + n) * 64 + col] = acc[n];
      __syncthreads();
      for (int idx = tid; idx < 576; idx += 256) {
        int n = idx / 64, cc = idx % 64;
        float s = red[(0 * 9 + n) * 64 + cc] + red[(1 * 9 + n) * 64 + cc] + red[(2 * 9 + n) * 64 + cc] + red[(3 * 9 + n) * 64 + cc];
        P.mod[(size_t)(l * 9 + n) * 6144 + col0 + cc] = s + P.b_mod[l * 6144 + col0 + cc];
      }
      __syncthreads();
    } else {
      int m = t - NT - NF - NM;
      if (m == 0) {
        for (int idx = tid; idx < 128 * 16; idx += 256) {
          int pos = idx >> 4, i = idx & 15; float f = powf(10000.f, -(float)i / 16.f); float ang = (float)pos * f;
          float s, c; sincosf(ang, &s, &c); P.rope[idx] = make_float2(c, s);
        }
      } else if (m == 1) {
        for (int j = tid; j < 8192; j += 256) { float s, c; sincospif((float)j / 4096.f, &s, &c); P.tw[j] = make_float2(c, s); }
      } else if (m == 2) {
        for (int idx = tid; idx < 16384; idx += 256) {
          int mm = idx >> 7, k = idx & 127, part = mm >> 6, f1 = mm & 63, pp = k >> 6, a = k & 63;
          float s, c; sincospif((float)((a * f1) & 63) / 32.f, &s, &c);
          float v = part == 0 ? (pp == 0 ? c : s) : (pp == 0 ? -s : c);
          P.DA[idx] = (half_t)(v * 0.125f);
        }
      } else if (m == 3) {
        for (int idx = tid; idx < 32768; idx += 256) {
          int mm = idx >> 8, k = idx & 255, part = k >> 7, bb = k & 127;
          float s, c; sincospif((float)((bb * mm) & 127) / 64.f, &s, &c);
          P.DB[idx] = (half_t)((part == 0 ? c : s) * 0.08838834764831845f);
        }
      } else if (m == 4) {
        for (int idx = tid; idx < 131072; idx += 256) {
          int mm = idx >> 9, k = idx & 511, part = k >> 8, tt = k & 255;
          float s, c; sincospif((float)((tt * mm) & 255) / 128.f, &s, &c);
          P.DC[idx] = (half_t)((part == 0 ? c : s) * 0.0625f);
        }
      } else {
        for (int idx = tid; idx < 2 * 36 * 1024; idx += 256) {
          int l = idx / 36864, r = idx % 36864, col = r >> 10, k = r & 1023;
          P.WrT[idx] = col < 4 ? P.w_group[((size_t)l * 1024 + k) * 4 + col] : P.w_router[((size_t)l * 1024 + k) * 32 + col - 4];
        }
        if (tid < 2) {
          int l = tid; float s1 = 0.f, s2 = 0.f, mq = 0.f, mk = 0.f;
          for (int i = 0; i < 64; i++) {
            s1 += P.lq1[l * 64 + i] * P.lk1[l * 64 + i]; s2 += P.lq2[l * 64 + i] * P.lk2[l * 64 + i];
            mq = fmaxf(mq, fabsf(P.q_norm_g[l * 64 + i])); mk = fmaxf(mk, fabsf(P.k_norm_g[l * 64 + i]));
          }
          float lam_init = 0.8f - 0.6f * expf(-0.3f * (float)l);
          P.consts[l * 4 + 0] = expf(s1) - expf(s2) + lam_init;
          P.consts[l * 4 + 1] = 8.f * mq * mk * 1.4426950408889634f * 1.002f - 15.f;
          P.consts[l * 4 + 2] = lam_init;
        }
        if (tid < 64) P.cnt[tid] = 0;
        if (tid < 8) P.qctr[tid] = 0;
      }
    }
  }
}

DI void row1_phase(const Params& P, int combine_l, int norm_l, int r_begin) {
  const int lane = TIDX & 63, gw = blockIdx.x * 4 + (TIDX >> 6), nw = gridDim.x * 4;
  for (int r = r_begin + gw; r < TA; r += nw) {
    const int n = row_mod(r);
    float v[16];
    if (combine_l < 0) {
      const float* src = r < TC ? P.ctx + (size_t)r * D : P.x + (size_t)(r - TC) * D;
#pragma unroll
      for (int i = 0; i < 4; i++) { float4 t = *(const float4*)(src + i * 256 + lane * 4); v[i*4] = t.x; v[i*4+1] = t.y; v[i*4+2] = t.z; v[i*4+3] = t.w; }
    } else {
      float* xm = r < TC ? P.xcbuf + (size_t)r * D : P.out + (size_t)(r - TC) * D;
      const float* g2 = P.mod + (size_t)(combine_l * 9 + n) * 6144 + 5 * 1024;
      const half_t* y0 = P.yA + (size_t)(2 * r) * D; const half_t* y1 = y0 + D;
#pragma unroll
      for (int i = 0; i < 4; i++) {
        int c = i * 256 + lane * 4;
        float4 t = *(const float4*)(xm + c); float4 g = *(const float4*)(g2 + c);
        h4 a = *(const h4*)(y0 + c); h4 b = *(const h4*)(y1 + c);
        t.x += g.x * ((float)a[0] + (float)b[0]); t.y += g.y * ((float)a[1] + (float)b[1]);
        t.z += g.z * ((float)a[2] + (float)b[2]); t.w += g.w * ((float)a[3] + (float)b[3]);
        *(float4*)(xm + c) = t;
        v[i*4] = t.x; v[i*4+1] = t.y; v[i*4+2] = t.z; v[i*4+3] = t.w;
      }
    }
    if (norm_l >= 0) {
      float ss = 0.f;
#pragma unroll
      for (int i = 0; i < 16; i++) ss += v[i] * v[i];
      ss = wave_sum(ss);
      const float rstd = rsqrtf(ss * (1.f / 1024.f) + EPS);
      const float* g = P.norm1_g + norm_l * 1024;
      const float* sh = P.mod + (size_t)(norm_l * 9 + n) * 6144; const float* sc = sh + 1024;
#pragma unroll
      for (int i = 0; i < 4; i++) {
        int c = i * 256 + lane * 4;
        float4 gg = *(const float4*)(g + c), s1 = *(const float4*)(sc + c), s0 = *(const float4*)(sh + c);
        h4 o;
        o[0] = (half_t)(v[i*4] * rstd * gg.x * (1.f + s1.x) + s0.x); o[1] = (half_t)(v[i*4+1] * rstd * gg.y * (1.f + s1.y) + s0.y);
        o[2] = (half_t)(v[i*4+2] * rstd * gg.z * (1.f + s1.z) + s0.z); o[3] = (half_t)(v[i*4+3] * rstd * gg.w * (1.f + s1.w) + s0.w);
        *(h4*)(P.hx + (size_t)r * D + c) = o;
      }
    }
  }
}

DI void row2_phase(const Params& P, int l, int r_begin) {
  const int lane = TIDX & 63, gw = blockIdx.x * 4 + (TIDX >> 6), nw = gridDim.x * 4;
  const float* WrT = P.WrT + (size_t)l * 36 * 1024;
  for (int r = r_begin + gw; r < TA; r += nw) {
    const int n = row_mod(r);
    const float* xm = r < TC ? P.xcbuf + (size_t)r * D : P.out + (size_t)(r - TC) * D;
    float v[16];
#pragma unroll
    for (int i = 0; i < 4; i++) { float4 t = *(const float4*)(xm + i * 256 + lane * 4); v[i*4] = t.x; v[i*4+1] = t.y; v[i*4+2] = t.z; v[i*4+3] = t.w; }
    float ss = 0.f;
#pragma unroll
    for (int i = 0; i < 16; i++) ss += v[i] * v[i];
    ss = wave_sum(ss);
    const float rstd = rsqrtf(ss * (1.f / 1024.f) + EPS);
    const float* g = P.norm2_g + l * 1024;
    const float* sh = P.mod + (size_t)(l * 9 + n) * 6144 + 3 * 1024; const float* sc = sh + 1024;
#pragma unroll
    for (int i = 0; i < 4; i++) {
      int c = i * 256 + lane * 4;
      float4 gg = *(const float4*)(g + c), s1 = *(const float4*)(sc + c), s0 = *(const float4*)(sh + c);
      v[i*4] = v[i*4] * rstd * gg.x * (1.f + s1.x) + s0.x; v[i*4+1] = v[i*4+1] * rstd * gg.y * (1.f + s1.y) + s0.y;
      v[i*4+2] = v[i*4+2] * rstd * gg.z * (1.f + s1.z) + s0.z; v[i*4+3] = v[i*4+3] * rstd * gg.w * (1.f + s1.w) + s0.w;
      h4 o; o[0] = (half_t)v[i*4]; o[1] = (half_t)v[i*4+1]; o[2] = (half_t)v[i*4+2]; o[3] = (half_t)v[i*4+3];
      *(h4*)(P.hx + (size_t)r * D + c) = o;
    }
    float mine = 0.f;
#pragma unroll 2
    for (int col = 0; col < 36; col++) {
      float p = 0.f;
#pragma unroll
      for (int i = 0; i < 4; i++) {
        float4 w = *(const float4*)(WrT + col * 1024 + i * 256 + lane * 4);
        p += v[i*4] * w.x + v[i*4+1] * w.y + v[i*4+2] * w.z + v[i*4+3] * w.w;
      }
      p = wave_sum(p);
      mine = (lane == col) ? p : mine;
    }
    float gl[4]; int gi = 0; float gm;
#pragma unroll
    for (int j = 0; j < 4; j++) gl[j] = __shfl(mine, j) + P.b_group[l * 4 + j];
    gm = gl[0];
#pragma unroll
    for (int j = 1; j < 4; j++) if (gl[j] > gm) { gm = gl[j]; gi = j; }
    float gs = 0.f;
#pragma unroll
    for (int j = 0; j < 4; j++) gs += expf(gl[j] - gm);
    const float pg = 1.f / gs;
    float el[8];
#pragma unroll
    for (int j = 0; j < 8; j++) el[j] = __shfl(mine, 4 + gi * 8 + j) + P.b_router[l * 32 + gi * 8 + j];
    int i0 = 0; float v0 = el[0];
#pragma unroll
    for (int j = 1; j < 8; j++) if (el[j] > v0) { v0 = el[j]; i0 = j; }
    int i1 = -1; float v1 = -3.0e38f;
#pragma unroll
    for (int j = 0; j < 8; j++) if (j != i0 && el[j] > v1) { v1 = el[j]; i1 = j; }
    const float ex = expf(v1 - v0);
    const float w0 = pg / (1.f + ex), w1 = pg * ex / (1.f + ex);
    if (lane == 0) {
      int e0 = gi * 8 + i0, e1 = gi * 8 + i1;
      int p0 = atomicAdd(&P.cnt[l * 32 + e0], 1); P.list[(size_t)e0 * LCAP + p0] = 2 * r;
      int p1 = atomicAdd(&P.cnt[l * 32 + e1], 1); P.list[(size_t)e1 * LCAP + p1] = 2 * r + 1;
      P.tokW[2 * r] = w0; P.tokW[2 * r + 1] = w1;
    }
  }
}

template <int WM, int WN>
DI void gemm128(const half_t* const (&ap)[4], const half_t* const (&bp)[4], int nk, char* smem, f4 (&acc)[WM][WN]) {
  const int tid = TIDX, lane = tid & 63, wave = tid >> 6, fr = lane & 15, fq = lane >> 4;
  const int rbase = (WM == 4) ? (wave >> 1) * 64 : wave * 32;
  const int cbase = (WM == 4) ? (wave & 1) * 64 : 0;
#pragma unroll
  for (int m = 0; m < WM; m++)
#pragma unroll
    for (int n = 0; n < WN; n++) acc[m][n] = (f4){0.f, 0.f, 0.f, 0.f};
  {
    char* d = smem + tid * 16;
#pragma unroll
    for (int i = 0; i < 4; i++) { glds16(ap[i], d + i * 4096); glds16(bp[i], d + 16384 + i * 4096); }
  }
  for (int kt = 0; kt < nk; kt++) {
    wait_vm0();
    __syncthreads();
    if (kt + 1 < nk) {
      char* d = smem + ((kt + 1) & 1) * 32768 + tid * 16;
#pragma unroll
      for (int i = 0; i < 4; i++) { glds16(ap[i] + (kt + 1) * 64, d + i * 4096); glds16(bp[i] + (kt + 1) * 64, d + 16384 + i * 4096); }
    }
    const char* As = smem + (kt & 1) * 32768; const char* Bs = As + 16384;
#pragma unroll
    for (int kk = 0; kk < 2; kk++) {
      h8 af[WM], bf[WN];
#pragma unroll
      for (int m = 0; m < WM; m++) { int row = rbase + m * 16 + fr; af[m] = *(const h8*)(As + row * 128 + (((kk * 4 + fq) ^ ((row >> 1) & 7)) << 4)); }
#pragma unroll
      for (int n = 0; n < WN; n++) { int row = cbase + n * 16 + fr; bf[n] = *(const h8*)(Bs + row * 128 + (((kk * 4 + fq) ^ ((row >> 1) & 7)) << 4)); }
#pragma unroll
      for (int m = 0; m < WM; m++)
#pragma unroll
        for (int n = 0; n < WN; n++) acc[m][n] = mfma16(af[m], bf[n], acc[m][n]);
    }
  }
  __syncthreads();
}
DI void slot_rc(int i, int& row, int& coff) { int s = i * 256 + TIDX; row = s >> 3; coff = ((s & 7) ^ ((row >> 1) & 7)) * 8; }

DI void gemm_in_phase(const Params& P, int l, char* smem) {
  const int tid = TIDX, lane = tid & 63, wave = tid >> 6, fr = lane & 15, fq = lane >> 4, wr = wave >> 1, wc = wave & 1;
  const half_t* Wt = P.WtIn + (size_t)l * NIN * 1024;
  for (int t = blockIdx.x; t < 528 * 20; t += gridDim.x) {
    const int mt = t / 20, nt = t % 20;
    const half_t* ap[4]; const half_t* bp[4];
#pragma unroll
    for (int i = 0; i < 4; i++) { int row, co; slot_rc(i, row, co); ap[i] = P.hx + (size_t)(mt * 128 + row) * D + co; bp[i] = Wt + (size_t)(nt * 128 + row) * D + co; }
    f4 acc[4][4];
    gemm128<4, 4>(ap, bp, 16, smem, acc);
    const int r0 = mt * 128 + wr * 64;
    const bool isctx = r0 < TC;
    int b, pos0;
    if (isctx) { b = r0 >> 8; pos0 = r0 & 255; } else { b = (r0 - TC) >> 13; pos0 = 256 + ((r0 - TC) & 8191); }
    if (nt < 4 || nt >= 16) {
      half_t* dst; int ld, c0; bool gel = false;
      if (nt < 4) { dst = P.QF; ld = 512; c0 = nt * 128; }
      else if (nt < 18) { dst = P.gy; ld = 256; c0 = (nt - 16) * 128; gel = true; }
      else { dst = P.rr; ld = 256; c0 = (nt - 18) * 128; }
#pragma unroll
      for (int m = 0; m < 4; m++)
#pragma unroll
        for (int n = 0; n < 4; n++)
#pragma unroll
          for (int j = 0; j < 4; j++) {
            float v = acc[m][n][j]; if (gel) v = gelu_tanh(v);
            dst[(size_t)(r0 + m * 16 + fq * 4 + j) * ld + c0 + wc * 64 + n * 16 + fr] = (half_t)v;
          }
    } else if (nt < 12) {
      const bool isq = nt < 8; const int head = isq ? nt - 4 : nt - 8;
      const float* gvec = (isq ? P.q_norm_g : P.k_norm_g) + l * 64;
      float gg[4];
#pragma unroll
      for (int n = 0; n < 4; n++) gg[n] = gvec[n * 16 + fr];
      const float qs = isq ? 0.125f * 1.4426950408889634f : 1.f;
#pragma unroll
      for (int m = 0; m < 4; m++)
#pragma unroll
        for (int j = 0; j < 4; j++) {
          float ss = 0.f;
#pragma unroll
          for (int n = 0; n < 4; n++) ss += acc[m][n][j] * acc[m][n][j];
          ss += __shfl_xor(ss, 1); ss += __shfl_xor(ss, 2); ss += __shfl_xor(ss, 4); ss += __shfl_xor(ss, 8);
          const float rstd = rsqrtf(ss * (1.f / 64.f) + EPS);
          float o[4];
#pragma unroll
          for (int n = 0; n < 4; n++) o[n] = acc[m][n][j] * rstd * gg[n];
          const int rl = m * 16 + fq * 4 + j;
          if (!isctx) {
            const int tpos = pos0 - 256 + rl;
            float2 cr = P.rope[(tpos >> 6) * 16 + fr], cc = P.rope[(tpos & 63) * 16 + fr];
            float a0 = o[0] * cr.x - o[1] * cr.y, a1 = o[1] * cr.x + o[0] * cr.y;
            float a2 = o[2] * cc.x - o[3] * cc.y, a3 = o[3] * cc.x + o[2] * cc.y;
            o[0] = a0; o[1] = a1; o[2] = a2; o[3] = a3;
          }
          half_t* dst = isq ? P.q + (size_t)(r0 + rl) * 512 : P.kall + ((size_t)b * KV + pos0 + rl) * 512;
#pragma unroll
          for (int n = 0; n < 4; n++) dst[head * 128 + wc * 64 + n * 16 + fr] = (half_t)(o[n] * qs);
        }
    } else {
      const int head = nt - 12;
#pragma unroll
      for (int m = 0; m < 4; m++)
#pragma unroll
        for (int n = 0; n < 4; n++) {
          h4 o; o[0] = (half_t)acc[m][n][0]; o[1] = (half_t)acc[m][n][1]; o[2] = (half_t)acc[m][n][2]; o[3] = (half_t)acc[m][n][3];
          const int d = wc * 64 + n * 16 + fr;
          *(h4*)(P.vT + ((size_t)(b * 4 + head) * 128 + d) * KV + pos0 + m * 16 + fq * 4) = o;
        }
    }
  }
}

DI void gemm_out_phase(const Params& P, int l, char* smem) {
  const int tid = TIDX, lane = tid & 63, wave = tid >> 6, fr = lane & 15, fq = lane >> 4, wr = wave >> 1, wc = wave & 1;
  const half_t* Wt = P.WtOut + (size_t)l * 1048576;
  const int mt0 = l == 0 ? 0 : TC / 128;
  for (int t = blockIdx.x + mt0 * 8; t < 528 * 8; t += gridDim.x) {
    const int mt = t / 8, nt = t % 8;
    const half_t* ap[4]; const half_t* bp[4];
#pragma unroll
    for (int i = 0; i < 4; i++) { int row, co; slot_rc(i, row, co); ap[i] = P.mix + (size_t)(mt * 128 + row) * D + co; bp[i] = Wt + (size_t)(nt * 128 + row) * D + co; }
    f4 acc[4][4];
    gemm128<4, 4>(ap, bp, 16, smem, acc);
    const int r0 = mt * 128 + wr * 64;
    const int n = row_mod(r0);
    const float* g1 = P.mod + (size_t)(l * 9 + n) * 6144 + 2 * 1024;
    const float* res; float* dst;
    if (r0 < TC) { res = P.ctx + (size_t)r0 * D; dst = P.xcbuf + (size_t)r0 * D; }
    else { dst = P.out + (size_t)(r0 - TC) * D; res = l == 0 ? P.x + (size_t)(r0 - TC) * D : dst; }
#pragma unroll
    for (int m = 0; m < 4; m++)
#pragma unroll
      for (int nn = 0; nn < 4; nn++) {
        const int c = nt * 128 + wc * 64 + nn * 16 + fr; const float g = g1[c];
#pragma unroll
        for (int j = 0; j < 4; j++) { size_t o = (size_t)(m * 16 + fq * 4 + j) * D + c; dst[o] = res[o] + g * acc[m][nn][j]; }
      }
  }
}

DI void moe_prefix(const Params& P, int l, int* tb) {
  __syncthreads();
  if (TIDX == 0) { int s = 0; for (int e = 0; e < 32; e++) { tb[e] = s; s += (P.cnt[l * 32 + e] + 127) >> 7; } tb[32] = s; }
  __syncthreads();
}
DI void moe_e1_phase(const Params& P, int l, char* smem, int* tb) {
  const int tid = TIDX, lane = tid & 63, wave = tid >> 6, fr = lane & 15, fq = lane >> 4;
  moe_prefix(P, l, tb);
  const int total = tb[32] * 8;
  for (int t = blockIdx.x; t < total; t += gridDim.x) {
    const int rt = t >> 3, nt = t & 7;
    int e = 0;
    while (tb[e + 1] <= rt) e++;
    const int rl = rt - tb[e], cnt = P.cnt[l * 32 + e];
    const int* lst = P.list + (size_t)e * LCAP;
    const half_t* w1 = P.Wt1 + ((size_t)(l * 32 + e) * 512 + nt * 64) * 1024;
    const half_t* w3 = P.Wt3 + ((size_t)(l * 32 + e) * 512 + nt * 64) * 1024;
    const half_t* ap[4]; const half_t* bp[4];
#pragma unroll
    for (int i = 0; i < 4; i++) {
      int row, co; slot_rc(i, row, co);
      int idx = min(rl * 128 + row, cnt - 1);
      int a = lst[idx];
      ap[i] = P.hx + (size_t)(a >> 1) * D + co;
      bp[i] = (row < 64 ? w1 + (size_t)row * 1024 : w3 + (size_t)(row - 64) * 1024) + co;
    }
    f4 acc[2][8];
    gemm128<2, 8>(ap, bp, 16, smem, acc);
    half_t* Hd = P.H + ((size_t)rt * 128 + wave * 32) * 512 + nt * 64;
#pragma unroll
    for (int m = 0; m < 2; m++)
#pragma unroll
      for (int n = 0; n < 4; n++)
#pragma unroll
        for (int j = 0; j < 4; j++) {
          float a1 = acc[m][n][j], a3 = acc[m][n + 4][j];
          Hd[(size_t)(m * 16 + fq * 4 + j) * 512 + n * 16 + fr] = (half_t)(a1 * sigmoidf_(a1) * a3);
        }
  }
}
DI void moe_e2_phase(const Params& P, int l, char* smem, int* tb) {
  const int tid = TIDX, lane = tid & 63, wave = tid >> 6, fr = lane & 15, fq = lane >> 4, wr = wave >> 1, wc = wave & 1;
  moe_prefix(P, l, tb);
  const int total = tb[32] * 8;
  for (int t = blockIdx.x; t < total; t += gridDim.x) {
    const int rt = t >> 3, nt = t & 7;
    int e = 0;
    while (tb[e + 1] <= rt) e++;
    const int rl = rt - tb[e], cnt = P.cnt[l * 32 + e];
    const int* lst = P.list + (size_t)e * LCAP;
    const half_t* w2 = P.Wt2 + ((size_t)(l * 32 + e) * 1024 + nt * 128) * 512;
    const half_t* ap[4]; const half_t* bp[4];
#pragma unroll
    for (int i = 0; i < 4; i++) { int row, co; slot_rc(i, row, co); ap[i] = P.H + ((size_t)rt * 128 + row) * 512 + co; bp[i] = w2 + (size_t)row * 512 + co; }
    f4 acc[4][4];
    gemm128<4, 4>(ap, bp, 8, smem, acc);
#pragma unroll
    for (int m = 0; m < 4; m++)
#pragma unroll
      for (int j = 0; j < 4; j++) {
        const int idx = rl * 128 + wr * 64 + m * 16 + fq * 4 + j;
        if (idx < cnt) {
          const int a = lst[idx]; const float w = P.tokW[a];
          half_t* dst = P.yA + (size_t)a * D + nt * 128 + wc * 64 + fr;
#pragma unroll
          for (int n = 0; n < 4; n++) dst[n * 16] = (half_t)(w * acc[m][n][j]);
        }
      }
  }
}

DI int swap23(int x) { return (x & ~12) | ((x & 4) << 1) | ((x & 8) >> 1); }
DI void attn_item(const Params& P, int l, int b, int head, int row0, int nkeys, char* smem) {
  const int tid = TIDX, lane = tid & 63, wave = tid >> 6, ql = lane & 31, hh = lane >> 5;
  const float lam = P.consts[l * 4 + 0], negc = -P.consts[l * 4 + 1], lam_init = P.consts[l * 4 + 2];
  const int myrow = row0 + wave * 32 + ql;
  h8 qf[2][4];
  {
    const half_t* qp = P.q + (size_t)myrow * 512 + head * 128 + hh * 8;
#pragma unroll
    for (int m = 0; m < 2; m++)
#pragma unroll
      for (int s = 0; s < 4; s++) qf[m][s] = *(const h8*)(qp + m * 64 + s * 16);
  }
  f16v o0[4], o1[4];
#pragma unroll
  for (int dt = 0; dt < 4; dt++)
#pragma unroll
    for (int i = 0; i < 16; i++) { o0[dt][i] = 0.f; o1[dt][i] = 0.f; }
  float ls0 = 0.f, ls1 = 0.f;
  const half_t* kp[4]; const half_t* vp[4];
  {
    const half_t* kbase = P.kall + (size_t)b * KV * 512 + head * 128;
    const half_t* vbase = P.vT + (size_t)(b * 4 + head) * 128 * KV;
#pragma unroll
    for (int i = 0; i < 4; i++) {
      int s = i * 256 + tid;
      int row = s >> 4, c = (s & 15) ^ (row & 15); kp[i] = kbase + (size_t)row * 512 + c * 8;
      int vr = s >> 3, vc = (s & 7) ^ ((vr >> 1) & 7); vp[i] = vbase + (size_t)vr * KV + vc * 8;
    }
  }
  const int ntile = nkeys >> 6;
  {
    char* d = smem + tid * 16;
#pragma unroll
    for (int i = 0; i < 4; i++) { glds16(kp[i], d + i * 4096); glds16(vp[i], d + 16384 + i * 4096); }
  }
  const int kr_lo = swap23(ql);
#pragma unroll 1
  for (int t = 0; t < ntile; t++) {
    wait_vm0();
    __syncthreads();
    if (t + 1 < ntile) {
      char* d = smem + ((t + 1) & 1) * 32768 + tid * 16;
#pragma unroll
      for (int i = 0; i < 4; i++) { glds16(kp[i] + (size_t)(t + 1) * 64 * 512, d + i * 4096); glds16(vp[i] + (t + 1) * 64, d + 16384 + i * 4096); }
    }
    const char* Ks = smem + (t & 1) * 32768; const char* Vs = Ks + 16384;
#pragma unroll 1
    for (int kt = 0; kt < 2; kt++) {
      f16v s0, s1;
#pragma unroll
      for (int i = 0; i < 16; i++) { s0[i] = negc; s1[i] = negc; }
      const int krow = kt * 32 + kr_lo; const int ksw = krow & 15;
      const char* kr = Ks + krow * 256;
#pragma unroll
      for (int st = 0; st < 4; st++) {
        h8 k0 = *(const h8*)(kr + (((st * 2 + hh) ^ ksw) << 4));
        h8 k1 = *(const h8*)(kr + (((8 + st * 2 + hh) ^ ksw) << 4));
        s0 = mfma32(k0, qf[0][st], s0);
        s1 = mfma32(k1, qf[1][st], s1);
      }
#pragma unroll
      for (int i = 0; i < 16; i++) { s0[i] = __builtin_amdgcn_exp2f(s0[i]); ls0 += s0[i]; s1[i] = __builtin_amdgcn_exp2f(s1[i]); ls1 += s1[i]; }
#pragma unroll
      for (int sp = 0; sp < 2; sp++) {
        u4 a, c;
        a[0] = pk2(s0[8*sp+0], s0[8*sp+1]); a[1] = pk2(s0[8*sp+2], s0[8*sp+3]); a[2] = pk2(s0[8*sp+4], s0[8*sp+5]); a[3] = pk2(s0[8*sp+6], s0[8*sp+7]);
        c[0] = pk2(s1[8*sp+0], s1[8*sp+1]); c[1] = pk2(s1[8*sp+2], s1[8*sp+3]); c[2] = pk2(s1[8*sp+4], s1[8*sp+5]); c[3] = pk2(s1[8*sp+6], s1[8*sp+7]);
        const h8 p0 = __builtin_bit_cast(h8, a), p1 = __builtin_bit_cast(h8, c);
        const int chunk = kt * 4 + sp * 2 + hh;
#pragma unroll
        for (int dt = 0; dt < 4; dt++) {
          const int vrow = dt * 32 + ql;
          h8 vf = *(const h8*)(Vs + vrow * 128 + ((chunk ^ ((vrow >> 1) & 7)) << 4));
          o0[dt] = mfma32(vf, p0, o0[dt]);
          o1[dt] = mfma32(vf, p1, o1[dt]);
        }
      }
    }
  }
  __syncthreads();
  ls0 += __shfl_xor(ls0, 32); ls1 += __shfl_xor(ls1, 32);
  const float i0 = 1.f / ls0, i1 = lam / ls1;
  float ss = 0.f;
#pragma unroll
  for (int dt = 0; dt < 4; dt++)
#pragma unroll
    for (int i = 0; i < 16; i++) { float v = o0[dt][i] * i0 - o1[dt][i] * i1; o0[dt][i] = v; ss += v * v; }
  ss += __shfl_xor(ss, 32);
  const float mult = rsqrtf(ss * (1.f / 128.f) + EPS) * (1.f - lam_init);
  const float* sg = P.subln_g + l * 128;
  half_t* dst = P.mix + (size_t)myrow * D + 256 + head * 128;
#pragma unroll
  for (int dt = 0; dt < 4; dt++)
#pragma unroll
    for (int g = 0; g < 4; g++) {
      const int d0 = dt * 32 + 8 * g + 4 * hh;
      float4 gv = *(const float4*)(sg + d0);
      h4 o; o[0] = (half_t)(o0[dt][4*g] * mult * gv.x); o[1] = (half_t)(o0[dt][4*g+1] * mult * gv.y);
      o[2] = (half_t)(o0[dt][4*g+2] * mult * gv.z); o[3] = (half_t)(o0[dt][4*g+3] * mult * gv.w);
      *(h4*)(dst + d0) = o;
    }
}

DI int swz128(int row, int colh) { return row * 128 + ((((colh >> 3)) ^ ((row >> 1) & 7)) << 4) + (colh & 7) * 2; }
DI void lru_item(const Params& P, int l, int b, int g, char* smem) {
  const int tid = TIDX, lane = tid & 63, wave = tid >> 6, fr = lane & 15, fq = lane >> 4;
  char* Wt = smem;
  char* xr16 = smem + 16384;
  float* xr32 = (float*)(smem + 24576);
  float2* ab = (float2*)(smem + 40960);
  float2* subst = (float2*)(smem + 73728);
  float* carry = (float*)(smem + 75776);
  const int ch = tid & 63, tq = tid >> 6;
  const int gc = g * 64 + ch;
  const float cw0 = P.conv_w[(l * 4 + 0) * 256 + gc], cw1 = P.conv_w[(l * 4 + 1) * 256 + gc], cw2 = P.conv_w[(l * 4 + 2) * 256 + gc],
              cw3 = P.conv_w[(l * 4 + 3) * 256 + gc], cb = P.conv_b[l * 256 + gc];
  for (int dir = 0; dir < 2; dir++) {
    __syncthreads();
    {
      const float* wa = P.gate_a_w + ((size_t)((l * 2 + dir) * 4 + g)) * 4096;
      const float* wx = P.gate_x_w + ((size_t)((l * 2 + dir) * 4 + g)) * 4096;
      for (int idx = tid; idx < 4096; idx += 256) {
        int i = idx >> 6, o = idx & 63;
        *(half_t*)(Wt + swz128(o, i)) = (half_t)wa[idx];
        *(half_t*)(Wt + 8192 + swz128(o, i)) = (half_t)wx[idx];
      }
      if (tid < 64) carry[tid] = 0.f;
    }
    float ba[4], bx[4], sp[4];
#pragma unroll
    for (int n = 0; n < 4; n++) {
      int cc = (l * 2 + dir) * 256 + g * 64 + n * 16 + fr;
      ba[n] = P.gate_a_b[cc]; bx[n] = P.gate_x_b[cc];
      sp[n] = log1pf(expf(-P.lru_lambda[cc]));
    }
    for (int seg = 0; seg < 2; seg++) {
      const int T = seg == 0 ? CL : SEQ;
      const int rowbase = seg == 0 ? b * CL : TC + b * SEQ;
      for (int ti = 0; ti < T / 64; ti++) {
        const int t0 = dir == 0 ? ti * 64 : T - 64 - ti * 64;
        {
          float v[19];
          const int tb = t0 + tq * 16 - 1;
#pragma unroll
          for (int e = 0; e < 19; e++) { int tt = tb + e; v[e] = (tt >= 0 && tt < T) ? (float)P.rr[(size_t)(rowbase + tt) * 256 + gc] : 0.f; }
#pragma unroll
          for (int e = 0; e < 16; e++) {
            float xv = cb + cw0 * v[e] + cw1 * v[e + 1] + cw2 * v[e + 2] + cw3 * v[e + 3];
            int tl = tq * 16 + e;
            xr32[tl * 64 + ch] = xv;
            *(half_t*)(xr16 + swz128(tl, ch)) = (half_t)xv;
          }
        }
        __syncthreads();
        {
          f4 acc[2][4];
#pragma unroll
          for (int gt = 0; gt < 2; gt++)
#pragma unroll
            for (int n = 0; n < 4; n++) acc[gt][n] = (f4){0.f, 0.f, 0.f, 0.f};
#pragma unroll
          for (int kk = 0; kk < 2; kk++) {
            int row = wave * 16 + fr;
            h8 af = *(const h8*)(xr16 + row * 128 + (((kk * 4 + fq) ^ ((row >> 1) & 7)) << 4));
#pragma unroll
            for (int gt = 0; gt < 2; gt++)
#pragma unroll
              for (int n = 0; n < 4; n++) {
                int orow = n * 16 + fr;
                h8 bf = *(const h8*)(Wt + gt * 8192 + orow * 128 + (((kk * 4 + fq) ^ ((orow >> 1) & 7)) << 4));
                acc[gt][n] = mfma16(af, bf, acc[gt][n]);
              }
          }
#pragma unroll
          for (int n = 0; n < 4; n++)
#pragma unroll
            for (int j = 0; j < 4; j++) {
              int tl = wave * 16 + fq * 4 + j, c2 = n * 16 + fr;
              float xv = xr32[tl * 64 + c2];
              float rg = sigmoidf_(acc[0][n][j] + ba[n]), ig = sigmoidf_(acc[1][n][j] + bx[n]);
              float log_a = -8.f * rg * sp[n];
              float a = expf(log_a);
              float bt = sqrtf(-expm1f(2.f * log_a)) * (ig * xv);
              ab[tl * 64 + c2] = make_float2(a, bt);
            }
        }
        __syncthreads();
        float2 av[16];
        {
          float A = 1.f, h = 0.f;
#pragma unroll
          for (int e = 0; e < 16; e++) {
            int tl = dir == 0 ? tq * 16 + e : 63 - (tq * 16 + e);
            av[e] = ab[tl * 64 + ch];
            h = av[e].x * h + av[e].y; A *= av[e].x;
          }
          subst[tq * 64 + ch] = make_float2(A, h);
        }
        __syncthreads();
        float h = carry[ch];
        for (int s = 0; s < tq; s++) { float2 ss = subst[s * 64 + ch]; h = ss.x * h + ss.y; }
#pragma unroll
        for (int e = 0; e < 16; e++) {
          int tl = dir == 0 ? tq * 16 + e : 63 - (tq * 16 + e);
          h = av[e].x * h + av[e].y;
          size_t row = (size_t)(rowbase + t0 + tl);
          if (dir == 0) P.hf[row * 256 + gc] = h;
          else {
            float rec = (float)P.gy[row * 256 + gc] * (P.hf[row * 256 + gc] + h);
            P.mix[row * D + 768 + gc] = (half_t)rec;
          }
        }
        __syncthreads();
        if (tq == 3) carry[ch] = h;
      }
    }
  }
  __syncthreads();
}

DI void fft_load(const half_t* src, size_t rs, int nrows, char* Bt, int rowbytes, int k0) {
  for (int idx = TIDX; idx < nrows * 16; idx += 256) {
    int kr = idx >> 4, cc = idx & 15, k = k0 + kr;
    h8 v = *(const h8*)(src + (size_t)kr * rs + cc * 8);
#pragma unroll
    for (int u = 0; u < 8; u++) { int n = cc * 8 + u; *(half_t*)(Bt + n * rowbytes + ((((k >> 3)) ^ (n & 15)) << 4) + (k & 7) * 2) = v[u]; }
  }
}
template <class RF>
DI void fft_mma(const half_t* Dm, int ldD, int nkk, const char* Bt, int rowbytes, f4 (&acc)[4][4], RF arow) {
  const int lane = TIDX & 63, wave = TIDX >> 6, fr = lane & 15, fq = lane >> 4, wc = wave & 1;
#pragma unroll 1
  for (int kk = 0; kk < nkk; kk++) {
    h8 af[4], bf[4];
#pragma unroll
    for (int ms = 0; ms < 4; ms++) af[ms] = *(const h8*)(Dm + (size_t)arow(ms) * ldD + kk * 32 + fq * 8);
#pragma unroll
    for (int ns = 0; ns < 4; ns++) { int n = wc * 64 + ns * 16 + fr; bf[ns] = *(const h8*)(Bt + n * rowbytes + (((kk * 4 + fq) ^ (n & 15)) << 4)); }
#pragma unroll
    for (int ms = 0; ms < 4; ms++)
#pragma unroll
      for (int ns = 0; ns < 4; ns++) acc[ms][ns] = mfma16(af[ms], bf[ns], acc[ms][ns]);
  }
}
DI void zero44(f4 (&acc)[4][4]) {
#pragma unroll
  for (int m = 0; m < 4; m++)
#pragma unroll
    for (int n = 0; n < 4; n++) acc[m][n] = (f4){0.f, 0.f, 0.f, 0.f};
}
DI void fftA_item(const Params& P, int it, char* smem) {
  const int b = it >> 8, bb = (it >> 1) & 127, chh = it & 1;
  const int lane = TIDX & 63, wave = TIDX >> 6, fr = lane & 15, fq = lane >> 4, wr = wave >> 1, wc = wave & 1;
  __syncthreads();
  fft_load(P.QF + (size_t)(TC + b * SEQ + bb) * 512 + chh * 128, (size_t)128 * 512, 64, smem, 256, 0);
  fft_load(P.QF + (size_t)(TC + b * SEQ + bb) * 512 + 256 + chh * 128, (size_t)128 * 512, 64, smem, 256, 64);
  __syncthreads();
  f4 acc[4][4]; zero44(acc);
  fft_mma(P.DA, 128, 4, smem, 256, acc, [&](int ms) { return (ms >> 1) * 64 + wr * 32 + (ms & 1) * 16 + fr; });
#pragma unroll
  for (int ms = 0; ms < 2; ms++)
#pragma unroll
    for (int j = 0; j < 4; j++) {
      const int f1 = wr * 32 + ms * 16 + fq * 4 + j;
      const float2 w = P.tw[(bb * f1) & 8191];
      half_t* d0 = P.GA + ((size_t)(b * 64 + f1) * 256 + bb) * 256 + chh * 128 + wc * 64 + fr;
#pragma unroll
      for (int ns = 0; ns < 4; ns++) {
        float gr = acc[ms][ns][j], gi = acc[ms + 2][ns][j];
        d0[ns * 16] = (half_t)(gr * w.x + gi * w.y);
        d0[(size_t)128 * 256 + ns * 16] = (half_t)(gi * w.x - gr * w.y);
      }
    }
}
DI void fftB_item(const Params& P, int it, char* smem) {
  const int b = it >> 7, f1 = (it >> 1) & 63, chh = it & 1;
  const int lane = TIDX & 63, wave = TIDX >> 6, fr = lane & 15, fq = lane >> 4, wr = wave >> 1, wc = wave & 1;
  __syncthreads();
  fft_load(P.GA + (size_t)(b * 64 + f1) * 256 * 256 + chh * 128, 256, 256, smem, 512, 0);
  __syncthreads();
  f4 acc[4][4]; zero44(acc);
  fft_mma(P.DB, 256, 8, smem, 512, acc, [&](int ms) { return wr * 64 + ms * 16 + fr; });
#pragma unroll
  for (int ms = 0; ms < 4; ms++)
#pragma unroll
    for (int j = 0; j < 4; j++) {
      const int f2 = wr * 64 + ms * 16 + fq * 4 + j;
      half_t* d0 = P.mix + (size_t)(TC + b * SEQ + f1 + 64 * f2) * D + chh * 128 + wc * 64 + fr;
#pragma unroll
      for (int ns = 0; ns < 4; ns++) d0[ns * 16] = (half_t)acc[ms][ns][j];
    }
}
DI void fftC_item(const Params& P, int it, char* smem) {
  const int b = it >> 1, chh = it & 1;
  const int lane = TIDX & 63, wave = TIDX >> 6, fr = lane & 15, fq = lane >> 4, wr = wave >> 1, wc = wave & 1;
#pragma unroll 1
  for (int mh = 0; mh < 2; mh++) {
    f4 acc[4][4]; zero44(acc);
#pragma unroll 1
    for (int part = 0; part < 2; part++) {
      __syncthreads();
      fft_load(P.QF + (size_t)(b * CL) * 512 + part * 256 + chh * 128, 512, 256, smem, 512, 0);
      __syncthreads();
      fft_mma(P.DC + part * 256, 512, 8, smem, 512, acc, [&](int ms) { return mh * 128 + wr * 64 + ms * 16 + fr; });
    }
#pragma unroll
    for (int ms = 0; ms < 4; ms++)
#pragma unroll
      for (int j = 0; j < 4; j++) {
        const int f = mh * 128 + wr * 64 + ms * 16 + fq * 4 + j;
        half_t* d0 = P.mix + (size_t)(b * CL + f) * D + chh * 128 + wc * 64 + fr;
#pragma unroll
        for (int ns = 0; ns < 4; ns++) d0[ns * 16] = (half_t)acc[ms][ns][j];
      }
  }
}

DI void mix_phase(const Params& P, int l, char* smem, int* s_item) {
  const int nL = 32, nA = 2048, nC = l == 0 ? 64 : 0, nFA = 2048, nFC = l == 0 ? 16 : 0;
  const int total = nL + nA + nC + nFA + nFC;
  for (;;) {
    __syncthreads();
    if (TIDX == 0) *s_item = atomicAdd(&P.qctr[l], 1);
    __syncthreads();
    int it = *s_item;
    if (it >= total) break;
    #ifndef MX
#define MX 15
#endif
    if (it < nL) {
#if MX & 1
      lru_item(P, l, it >> 2, it & 3, smem);
#endif
      continue; }
    it -= nL;
    if (it < nA + nC) {
#if MX & 2
      int b, head, row0, nk;
      if (it < nA) { b = it >> 8; head = (it >> 6) & 3; row0 = TC + b * SEQ + (it & 63) * 128; nk = KV; }
      else { int u = it - nA; b = u >> 3; head = (u >> 1) & 3; row0 = b * CL + (u & 1) * 128; nk = CL; }
      attn_item(P, l, b, head, row0, nk, smem);
#endif
      continue; }
    it -= nA;
    it -= nC;
    if (it < nFA) {
#if MX & 4
      fftA_item(P, it, smem);
#endif
      continue; }
    it -= nFA;
#if MX & 8
    fftC_item(P, it, smem);
#endif
  }
}

__global__ void __launch_bounds__(256, 1) fwd_megakernel(Params P) {
  __shared__ __attribute__((aligned(16))) char smem[77824];
  __shared__ int tb[33];
  __shared__ int s_item;
  cg::grid_group grid = cg::this_grid();
#ifndef PH
#define PH 0xFFFF
#endif
#if PH & 1
  phase0(P, smem);
#endif
  grid.sync();
  for (int l = 0; l < 2; l++) {
#if PH & 2
    row1_phase(P, l == 0 ? -1 : 0, l, 0);
#endif
    grid.sync();
#if PH & 4
    gemm_in_phase(P, l, smem);
#endif
    grid.sync();
#if PH & 8
    mix_phase(P, l, smem, &s_item);
#endif
    grid.sync();
#if PH & 16
    for (int it = blockIdx.x; it < 1024; it += gridDim.x) fftB_item(P, it, smem);
#endif
    grid.sync();
#if PH & 32
    gemm_out_phase(P, l, smem);
#endif
    grid.sync();
#if PH & 64
    row2_phase(P, l, l == 0 ? 0 : TC);
#endif
    grid.sync();
#if PH & 128
    moe_e1_phase(P, l, smem, tb);
#endif
    grid.sync();
#if PH & 256
    moe_e2_phase(P, l, smem, tb);
#endif
    grid.sync();
  }
#if PH & 2
  row1_phase(P, 1, -1, TC);
#endif
}

extern "C" void kernel_launch(void* const* d_in, const int* in_sizes, int n_in, void* d_out, int out_size, void* d_ws, size_t ws_size,
                              hipStream_t stream) {
  static int grid_blocks = 0;
  if (!grid_blocks) {
    int dev = 0, cus = 0, per_cu = 0;
    hipGetDevice(&dev);
    hipDeviceGetAttribute(&cus, hipDeviceAttributeMultiprocessorCount, dev);
    hipOccupancyMaxActiveBlocksPerMultiprocessor(&per_cu, fwd_megakernel, 256, 0);
    if (per_cu > 2) per_cu = 2;
    grid_blocks = cus * per_cu;
  }
  Params p{};
  const float** pin = (const float**)&p;
  for (int i = 0; i < 31; i++) pin[i] = (const float*)d_in[i];
  p.out = (float*)d_out;
  char* w = (char*)d_ws; size_t off = 0;
  auto take = [&](size_t bytes) { char* r = w + off; off += (bytes + 255) & ~(size_t)255; return r; };
  p.WtIn = (half_t*)take((size_t)2 * NIN * 1024 * 2);
  p.WtOut = (half_t*)take((size_t)2 * 1024 * 1024 * 2);
  p.Wt1 = (half_t*)take((size_t)64 * 524288 * 2);
  p.Wt3 = (half_t*)take((size_t)64 * 524288 * 2);
  p.Wt2 = (half_t*)take((size_t)64 * 524288 * 2);
  p.mod = (float*)take((size_t)2 * 9 * 6144 * 4);
  p.rope = (float2*)take(128 * 16 * 8);
  p.tw = (float2*)take(8192 * 8);
  p.DA = (half_t*)take(16384 * 2);
  p.DB = (half_t*)take(32768 * 2);
  p.DC = (half_t*)take(131072 * 2);
  p.consts = (float*)take(256);
  p.cnt = (int*)take(256);
  p.qctr = (int*)take(256);
  p.tokW = (float*)take((size_t)2 * TA * 4);
  p.list = (int*)take((size_t)32 * LCAP * 4);
  p.xcbuf = (float*)take((size_t)TC * D * 4);
  p.WrT = (float*)take((size_t)2 * 36 * 1024 * 4);
  p.hx = (half_t*)take((size_t)TA * D * 2);
  p.mix = (half_t*)take((size_t)TA * D * 2);
  char* regB = w + off;
  p.q = (half_t*)take((size_t)TA * 512 * 2);
  p.kall = (half_t*)take((size_t)NB_ * KV * 512 * 2);
  p.vT = (half_t*)take((size_t)NB_ * 4 * 128 * KV * 2);
  p.QF = (half_t*)take((size_t)TA * 512 * 2);
  p.gy = (half_t*)take((size_t)TA * 256 * 2);
  p.rr = (half_t*)take((size_t)TA * 256 * 2);
  p.hf = (float*)take((size_t)TA * 256 * 4);
  p.GA = (half_t*)take((size_t)NB_ * 64 * 256 * 256 * 2);
  p.H = (half_t*)regB;
  p.yA = (half_t*)(regB + (((size_t)(2 * TA + 32 * 128) * 512 * 2 + 255) & ~(size_t)255));
  size_t moe_end = (size_t)((char*)p.yA - w) + (size_t)2 * TA * D * 2;
  if (off > ws_size || moe_end > off) { fprintf(stderr, "workspace too small: need %zu have %zu\n", off, ws_size); return; }
  void* args[] = {&p};
  hipError_t e = hipLaunchCooperativeKernel((void*)fwd_megakernel, dim3(grid_blocks), dim3(256), args, 0, stream);
  if (e != hipSuccess) fprintf(stderr, "cooperative launch failed: %s (grid %d)\n", hipGetErrorString(e), grid_blocks);
}
```

```cpp
#include <hip/hip_runtime.h>
#include <hip/hip_cooperative_groups.h>
#include <cstdio>
namespace cg = cooperative_groups;

typedef _Float16 half_t;
typedef _Float16 h8 __attribute__((ext_vector_type(8)));
typedef _Float16 h4 __attribute__((ext_vector_type(4)));
typedef __fp16 fp16x2 __attribute__((ext_vector_type(2)));
typedef unsigned u4 __attribute__((ext_vector_type(4)));
typedef float f4 __attribute__((ext_vector_type(4)));
typedef float f16v __attribute__((ext_vector_type(16)));
#define DI __device__ __forceinline__
__device__ __forceinline__ int tid_opaque() { int t = threadIdx.x; asm volatile("" : "+v"(t)); return t; }
#define TIDX tid_opaque()

constexpr int D = 1024, NB_ = 8, SEQ = 8192, CL = 256;
constexpr int TC = NB_ * CL;
constexpr int TX = NB_ * SEQ;
constexpr int TA = TC + TX;
constexpr int KV = CL + SEQ;
constexpr int NIN = 2560;
constexpr int LCAP = 2 * TA;
constexpr float EPS = 1e-6f;

struct Params {
  const float *x, *c, *ctx, *c_ctx, *w_mod, *b_mod, *norm1_g, *norm2_g, *w_in, *q_norm_g, *k_norm_g, *lq1, *lk1, *lq2, *lk2,
      *subln_g, *conv_w, *conv_b, *gate_a_w, *gate_a_b, *gate_x_w, *gate_x_b, *lru_lambda, *w_out, *w_group, *b_group,
      *w_router, *b_router, *w1, *w3, *w2;
  float* out;
  half_t *WtIn, *WtOut, *Wt1, *Wt3, *Wt2;
  float* mod; float2* rope; float2* tw; half_t *DA, *DB, *DC; float* consts; int* cnt; int* qctr; float* tokW; int* list;
  float* xcbuf; float* WrT;
  half_t *hx, *mix, *q, *kall, *vT, *QF, *gy, *rr; float2* lsum; float* lcar; half_t* GA; half_t *H, *yA;
};

DI float wave_sum(float v) {
#pragma unroll
  for (int o = 32; o; o >>= 1) v += __shfl_xor(v, o);
  return v;
}
DI void glds16(const void* g, void* l) {
  __builtin_amdgcn_global_load_lds((const unsigned*)g, (unsigned*)l, 16, 0, 0);
}
DI void wait_vm0() { asm volatile("s_waitcnt vmcnt(0)" ::: "memory"); }
DI f4 mfma16(h8 a, h8 b, f4 c) { return __builtin_amdgcn_mfma_f32_16x16x32_f16(a, b, c, 0, 0, 0); }
DI f16v mfma32(h8 a, h8 b, f16v c) { return __builtin_amdgcn_mfma_f32_32x32x16_f16(a, b, c, 0, 0, 0); }
DI unsigned pk2(float a, float b) { fp16x2 r = __builtin_amdgcn_cvt_pkrtz(a, b); return __builtin_bit_cast(unsigned, r); }
DI float sigmoidf_(float x) { return 1.f / (1.f + __expf(-x)); }
DI float gelu_tanh(float x) {
  float u = 0.7978845608028654f * (x + 0.044715f * x * x * x);
  float e = __expf(2.f * u);
  float t = 1.f - 2.f / (e + 1.f);
  return 0.5f * x * (1.f + t);
}
DI int row_mod(int r) { return r < TC ? 8 : ((r - TC) >> 13); }

DI void transpose_tile(const float* src, int lds_, half_t* dst, int ldd, float* tile) {
  const int tid = TIDX, n = tid & 63, kq = tid >> 6;
#pragma unroll 4
  for (int i = 0; i < 16; i++) { int k = i * 4 + kq; tile[k * 65 + n] = src[(size_t)k * lds_ + n]; }
  __syncthreads();
#pragma unroll 4
  for (int i = 0; i < 16; i++) { int nn = i * 4 + kq; dst[(size_t)nn * ldd + n] = (half_t)tile[n * 65 + nn]; }
  __syncthreads();
}

DI void phase0(const Params& P, char* smem) {
  float* tile = (float*)smem;
  const int tid = TIDX;
  constexpr int NT = 26112, NF = 128, NM = 192, NX = 6;
  for (int t = blockIdx.x; t < NT + NF + NM + NX; t += gridDim.x) {
    if (t < NT) {
      const float* src; half_t* dst; int lds_, ldd;
      if (t < 1024) {
        int l = t / 512, r = t % 512, kt = r / 32, nt = r % 32;
        src = P.w_in + (size_t)l * 1024 * 2304 + (size_t)kt * 64 * 2304 + 256 + nt * 64; lds_ = 2304;
        dst = P.WtIn + (size_t)l * NIN * 1024 + (size_t)(512 + nt * 64) * 1024 + kt * 64; ldd = 1024;
      } else if (t < 1536) {
        int u = t - 1024, l = u / 256, r = u % 256, kt = r / 16, nt = r % 16;
        src = P.w_out + (size_t)l * 1048576 + (size_t)kt * 64 * 1024 + nt * 64; lds_ = 1024;
        dst = P.WtOut + (size_t)l * 1048576 + (size_t)nt * 64 * 1024 + kt * 64; ldd = 1024;
      } else if (t < 1536 + 16384) {
        int u = t - 1536; const float* w = P.w1; half_t* o = P.Wt1;
        if (u >= 8192) { u -= 8192; w = P.w3; o = P.Wt3; }
        int le = u / 128, r = u % 128, kt = r / 8, nt = r % 8;
        src = w + (size_t)le * 524288 + (size_t)kt * 64 * 512 + nt * 64; lds_ = 512;
        dst = o + (size_t)le * 524288 + (size_t)nt * 64 * 1024 + kt * 64; ldd = 1024;
      } else {
        int u = t - 1536 - 16384, le = u / 128, r = u % 128, kt = r / 16, nt = r % 16;
        src = P.w2 + (size_t)le * 524288 + (size_t)kt * 64 * 1024 + nt * 64; lds_ = 1024;
        dst = P.Wt2 + (size_t)le * 524288 + (size_t)nt * 64 * 512 + kt * 64; ldd = 512;
      }
      transpose_tile(src, lds_, dst, ldd, tile);
    } else if (t < NT + NF) {
      int f = t - NT, l = f / 64, r = f % 64, kt = r / 4, g = r % 4;
      float* cst = tile + 64 * 65; float* snt = cst + 64;
      const float* src = P.w_in + (size_t)l * 1024 * 2304 + (size_t)kt * 64 * 2304 + g * 64;
      { int n = tid & 63, kq = tid >> 6;
        for (int i = 0; i < 16; i++) { int k = i * 4 + kq; tile[k * 65 + n] = src[(size_t)k * 2304 + n]; } }
      if (tid < 64) { float s, c; sincospif((float)tid / 32.f, &s, &c); cst[tid] = c; snt[tid] = s; }
      __syncthreads();
      int k = tid & 63, jq = tid >> 6;
      half_t* o = P.WtIn + (size_t)l * NIN * 1024 + kt * 64 + k;
      for (int jj = 0; jj < 16; jj++) {
        int j = jq * 16 + jj; float ac = 0.f, as = 0.f;
        for (int c = 0; c < 64; c++) { float v = tile[k * 65 + c]; int idx = (c * j) & 63; ac += v * cst[idx]; as += v * snt[idx]; }
        o[(size_t)(g * 64 + j) * 1024] = (half_t)(ac * 0.125f);
        o[(size_t)(256 + g * 64 + j) * 1024] = (half_t)(-as * 0.125f);
      }
      __syncthreads();
    } else if (t < NT + NF + NM) {
      int mi = t - NT - NF, l = mi / 96, col0 = (mi % 96) * 64;
      float* scond = tile; float* red = tile + 9216;
      for (int idx = tid; idx < 9216; idx += 256) {
        int n = idx >> 10, k = idx & 1023; float v = n < 8 ? P.c[n * 1024 + k] : P.c_ctx[k];
        scond[idx] = v / (1.f + expf(-v));
      }
      __syncthreads();
      int col = tid & 63, kq = tid >> 6; float acc[9];
#pragma unroll
      for (int n = 0; n < 9; n++) acc[n] = 0.f;
      const float* w = P.w_mod + ((size_t)l * 1024 + kq * 256) * 6144 + col0 + col;
#pragma unroll 4
      for (int k = 0; k < 256; k++) {
        float wv = w[(size_t)k * 6144];
#pragma unroll
        for (int n = 0; n < 9; n++) acc[n] += scond[n * 1024 + kq * 256 + k] * wv;
      }
#pragma unroll
      for (int n = 0; n < 9; n++) red[(kq * 9 + n) * 64 + col] = acc[n];
      __syncthreads();
      for (int idx = tid; idx < 576; idx += 256) {
        int n = idx / 64, cc = idx % 64;
        float s = red[(0 * 9 + n) * 64 + cc] + red[(1 * 9 + n) * 64 + cc] + red[(2 * 9 + n) * 64 + cc] + red[(3 * 9 + n) * 64 + cc];
        P.mod[(size_t)(l * 9 + n) * 6144 + col0 + cc] = s + P.b_mod[l * 6144 + col0 + cc];
      }
      __syncthreads();
    } else {
      int m = t - NT - NF - NM;
      if (m == 0) {
        for (int idx = tid; idx < 128 * 16; idx += 256) {
          int pos = idx >> 4, i = idx & 15; float f = powf(10000.f, -(float)i / 16.f); float ang = (float)pos * f;
          float s, c; sincosf(ang, &s, &c); P.rope[idx] = make_float2(c, s);
        }
      } else if (m == 1) {
        for (int j = tid; j < 8192; j += 256) { float s, c; sincospif((float)j / 4096.f, &s, &c); P.tw[j] = make_float2(c, s); }
      } else if (m == 2) {
        for (int idx = tid; idx < 16384; idx += 256) {
          int mm = idx >> 7, k = idx & 127, part = mm >> 6, f1 = mm & 63, pp = k >> 6, a = k & 63;
          float s, c; sincospif((float)((a * f1) & 63) / 32.f, &s, &c);
          float v = part == 0 ? (pp == 0 ? c : s) : (pp == 0 ? -s : c);
          P.DA[idx] = (half_t)(v * 0.125f);
        }
      } else if (m == 3) {
        for (int idx = tid; idx < 32768; idx += 256) {
          int mm = idx >> 8, k = idx & 255, part = k >> 7, bb = k & 127;
          float s, c; sincospif((float)((bb * mm) & 127) / 64.f, &s, &c);
          P.DB[idx] = (half_t)((part == 0 ? c : s) * 0.08838834764831845f);
        }
      } else if (m == 4) {
        for (int idx = tid; idx < 131072; idx += 256) {
          int mm = idx >> 9, k = idx & 511, part = k >> 8, tt = k & 255;
          float s, c; sincospif((float)((tt * mm) & 255) / 128.f, &s, &c);
          P.DC[idx] = (half_t)((part == 0 ? c : s) * 0.0625f);
        }
      } else {
        for (int idx = tid; idx < 2 * 36 * 1024; idx += 256) {
          int l = idx / 36864, r = idx % 36864, col = r >> 10, k = r & 1023;
          P.WrT[idx] = col < 4 ? P.w_group[((size_t)l * 1024 + k) * 4 + col] : P.w_router[((size_t)l * 1024 + k) * 32 + col - 4];
        }
        if (tid < 2) {
          int l = tid; float s1 = 0.f, s2 = 0.f, mq = 0.f, mk = 0.f;
          for (int i = 0; i < 64; i++) {
            s1 += P.lq1[l * 64 + i] * P.lk1[l * 64 + i]; s2 += P.lq2[l * 64 + i] * P.lk2[l * 64 + i];
            mq = fmaxf(mq, fabsf(P.q_norm_g[l * 64 + i])); mk = fmaxf(mk, fabsf(P.k_norm_g[l * 64 + i]));
          }
          float lam_init = 0.8f - 0.6f * expf(-0.3f * (float)l);
          P.consts[l * 4 + 0] = expf(s1) - expf(s2) + lam_init;
          P.consts[l * 4 + 1] = 8.f * mq * mk * 1.4426950408889634f * 1.002f - 15.f;
          P.consts[l * 4 + 2] = lam_init;
        }
        if (tid < 64) P.cnt[tid] = 0;
        if (tid < 8) P.qctr[tid] = 0;
      }
    }
  }
}

DI void row1_phase(const Params& P, int combine_l, int norm_l, int r_begin) {
  const int lane = TIDX & 63, gw = blockIdx.x * 4 + (TIDX >> 6), nw = gridDim.x * 4;
  for (int r = r_begin + gw; r < TA; r += nw) {
    const int n = row_mod(r);
    float v[16];
    if (combine_l < 0) {
      const float* src = r < TC ? P.ctx + (size_t)r * D : P.x + (size_t)(r - TC) * D;
#pragma unroll
      for (int i = 0; i < 4; i++) { float4 t = *(const float4*)(src + i * 256 + lane * 4); v[i*4] = t.x; v[i*4+1] = t.y; v[i*4+2] = t.z; v[i*4+3] = t.w; }
    } else {
      float* xm = r < TC ? P.xcbuf + (size_t)r * D : P.out + (size_t)(r - TC) * D;
      const float* g2 = P.mod + (size_t)(combine_l * 9 + n) * 6144 + 5 * 1024;
      const half_t* y0 = P.yA + (size_t)(2 * r) * D; const half_t* y1 = y0 + D;
#pragma unroll
      for (int i = 0; i < 4; i++) {
        int c = i * 256 + lane * 4;
        float4 t = *(const float4*)(xm + c); float4 g = *(const float4*)(g2 + c);
        h4 a = *(const h4*)(y0 + c); h4 b = *(const h4*)(y1 + c);
        t.x += g.x * ((float)a[0] + (float)b[0]); t.y += g.y * ((float)a[1] + (float)b[1]);
        t.z += g.z * ((float)a[2] + (float)b[2]); t.w += g.w * ((float)a[3] + (float)b[3]);
        *(float4*)(xm + c) = t;
        v[i*4] = t.x; v[i*4+1] = t.y; v[i*4+2] = t.z; v[i*4+3] = t.w;
      }
    }
    if (norm_l >= 0) {
      float ss = 0.f;
#pragma unroll
      for (int i = 0; i < 16; i++) ss += v[i] * v[i];
      ss = wave_sum(ss);
      const float rstd = rsqrtf(ss * (1.f / 1024.f) + EPS);
      const float* g = P.norm1_g + norm_l * 1024;
      const float* sh = P.mod + (size_t)(norm_l * 9 + n) * 6144; const float* sc = sh + 1024;
#pragma unroll
      for (int i = 0; i < 4; i++) {
        int c = i * 256 + lane * 4;
        float4 gg = *(const float4*)(g + c), s1 = *(const float4*)(sc + c), s0 = *(const float4*)(sh + c);
        h4 o;
        o[0] = (half_t)(v[i*4] * rstd * gg.x * (1.f + s1.x) + s0.x); o[1] = (half_t)(v[i*4+1] * rstd * gg.y * (1.f + s1.y) + s0.y);
        o[2] = (half_t)(v[i*4+2] * rstd * gg.z * (1.f + s1.z) + s0.z); o[3] = (half_t)(v[i*4+3] * rstd * gg.w * (1.f + s1.w) + s0.w);
        *(h4*)(P.hx + (size_t)r * D + c) = o;
      }
    }
  }
}

DI void row2_phase(const Params& P, int l, int r_begin) {
  const int lane = TIDX & 63, gw = blockIdx.x * 4 + (TIDX >> 6), nw = gridDim.x * 4;
  const float* WrT = P.WrT + (size_t)l * 36 * 1024;
  for (int r = r_begin + gw; r < TA; r += nw) {
    const int n = row_mod(r);
    const float* xm = r < TC ? P.xcbuf + (size_t)r * D : P.out + (size_t)(r - TC) * D;
    float v[16];
#pragma unroll
    for (int i = 0; i < 4; i++) { float4 t = *(const float4*)(xm + i * 256 + lane * 4); v[i*4] = t.x; v[i*4+1] = t.y; v[i*4+2] = t.z; v[i*4+3] = t.w; }
    float ss = 0.f;
#pragma unroll
    for (int i = 0; i < 16; i++) ss += v[i] * v[i];
    ss = wave_sum(ss);
    const float rstd = rsqrtf(ss * (1.f / 1024.f) + EPS);
    const float* g = P.norm2_g + l * 1024;
    const float* sh = P.mod + (size_t)(l * 9 + n) * 6144 + 3 * 1024; const float* sc = sh + 1024;
#pragma unroll
    for (int i = 0; i < 4; i++) {
      int c = i * 256 + lane * 4;
      float4 gg = *(const float4*)(g + c), s1 = *(const float4*)(sc + c), s0 = *(const float4*)(sh + c);
      v[i*4] = v[i*4] * rstd * gg.x * (1.f + s1.x) + s0.x; v[i*4+1] = v[i*4+1] * rstd * gg.y * (1.f + s1.y) + s0.y;
      v[i*4+2] = v[i*4+2] * rstd * gg.z * (1.f + s1.z) + s0.z; v[i*4+3] = v[i*4+3] * rstd * gg.w * (1.f + s1.w) + s0.w;
      h4 o; o[0] = (half_t)v[i*4]; o[1] = (half_t)v[i*4+1]; o[2] = (half_t)v[i*4+2]; o[3] = (half_t)v[i*4+3];
      *(h4*)(P.hx + (size_t)r * D + c) = o;
    }
    float mine = 0.f;
#pragma unroll 2
    for (int col = 0; col < 36; col++) {
      float p = 0.f;
#pragma unroll
      for (int i = 0; i < 4; i++) {
        float4 w = *(const float4*)(WrT + col * 1024 + i * 256 + lane * 4);
        p += v[i*4] * w.x + v[i*4+1] * w.y + v[i*4+2] * w.z + v[i*4+3] * w.w;
      }
      p = wave_sum(p);
      mine = (lane == col) ? p : mine;
    }
    float gl[4]; int gi = 0; float gm;
#pragma unroll
    for (int j = 0; j < 4; j++) gl[j] = __shfl(mine, j) + P.b_group[l * 4 + j];
    gm = gl[0];
#pragma unroll
    for (int j = 1; j < 4; j++) if (gl[j] > gm) { gm = gl[j]; gi = j; }
    float gs = 0.f;
#pragma unroll
    for (int j = 0; j < 4; j++) gs += expf(gl[j] - gm);
    const float pg = 1.f / gs;
    float el[8];
#pragma unroll
    for (int j = 0; j < 8; j++) el[j] = __shfl(mine, 4 + gi * 8 + j) + P.b_router[l * 32 + gi * 8 + j];
    int i0 = 0; float v0 = el[0];
#pragma unroll
    for (int j = 1; j < 8; j++) if (el[j] > v0) { v0 = el[j]; i0 = j; }
    int i1 = -1; float v1 = -3.0e38f;
#pragma unroll
    for (int j = 0; j < 8; j++) if (j != i0 && el[j] > v1) { v1 = el[j]; i1 = j; }
    const float ex = expf(v1 - v0);
    const float w0 = pg / (1.f + ex), w1 = pg * ex / (1.f + ex);
    if (lane == 0) {
      int e0 = gi * 8 + i0, e1 = gi * 8 + i1;
      int p0 = atomicAdd(&P.cnt[l * 32 + e0], 1); P.list[(size_t)e0 * LCAP + p0] = 2 * r;
      int p1 = atomicAdd(&P.cnt[l * 32 + e1], 1); P.list[(size_t)e1 * LCAP + p1] = 2 * r + 1;
      P.tokW[2 * r] = w0; P.tokW[2 * r + 1] = w1;
    }
  }
}

DI h8 lds128(unsigned a) { h8 r; asm volatile("ds_read_b128 %0, %1" : "=v"(r) : "v"(a)); return r; }
DI void tie(h8& x) { asm volatile("" : "+v"(x)); }
DI unsigned lds_addr(const void* p) { return (unsigned)(size_t)p; }
#define WAIT_LGKM(n) asm volatile("s_waitcnt lgkmcnt(" #n ")" ::: "memory")
DI void wait_vm8() { asm volatile("s_waitcnt vmcnt(8)" ::: "memory"); }
DI void raw_barrier() { asm volatile("" ::: "memory"); __builtin_amdgcn_s_barrier(); asm volatile("" ::: "memory"); }
template <int WM, int WN>
DI void gemm128(const half_t* const (&ap)[4], const half_t* const (&bp)[4], int nk, char* S0, char* S1, char* S2, f4 (&acc)[WM][WN]) {
  const int tid = TIDX, lane = tid & 63, wave = tid >> 6, fr = lane & 15, fq = lane >> 4;
  const int rbase = (WM == 4) ? (wave >> 1) * 64 : wave * 32;
  const int cbase = (WM == 4) ? (wave & 1) * 64 : 0;
#pragma unroll
  for (int m = 0; m < WM; m++)
#pragma unroll
    for (int n = 0; n < WN; n++) acc[m][n] = (f4){0.f, 0.f, 0.f, 0.f};
  auto issue = [&](int kt, char* S) {
    char* d = S + tid * 16;
#pragma unroll
    for (int i = 0; i < 4; i++) { glds16(ap[i] + kt * 64, d + i * 4096); glds16(bp[i] + kt * 64, d + 16384 + i * 4096); }
  };
  unsigned offA[WM], offB[WN];
#pragma unroll
  for (int m = 0; m < WM; m++) { int row = rbase + m * 16 + fr; offA[m] = row * 128 + ((fq ^ ((row >> 1) & 7)) << 4); }
#pragma unroll
  for (int n = 0; n < WN; n++) { int row = cbase + n * 16 + fr; offB[n] = 16384 + row * 128 + ((fq ^ ((row >> 1) & 7)) << 4); }
  auto compute = [&](const char* Asp) {
    const unsigned As = lds_addr(Asp);
    h8 a0[WM], b0[WN], a1[WM], b1[WN];
#pragma unroll
    for (int m = 0; m < WM; m++) a0[m] = lds128(As + offA[m]);
#pragma unroll
    for (int n = 0; n < WN; n++) b0[n] = lds128(As + offB[n]);
#pragma unroll
    for (int m = 0; m < WM; m++) a1[m] = lds128(As + (offA[m] ^ 64));
#pragma unroll
    for (int n = 0; n < WN; n++) b1[n] = lds128(As + (offB[n] ^ 64));
    if (WM + WN == 8) WAIT_LGKM(8); else WAIT_LGKM(10);
#pragma unroll
    for (int m = 0; m < WM; m++) tie(a0[m]);
#pragma unroll
    for (int n = 0; n < WN; n++) tie(b0[n]);
#pragma unroll
    for (int m = 0; m < WM; m++)
#pragma unroll
      for (int n = 0; n < WN; n++) acc[m][n] = mfma16(a0[m], b0[n], acc[m][n]);
    WAIT_LGKM(0);
#pragma unroll
    for (int m = 0; m < WM; m++) tie(a1[m]);
#pragma unroll
    for (int n = 0; n < WN; n++) tie(b1[n]);
#pragma unroll
    for (int m = 0; m < WM; m++)
#pragma unroll
      for (int n = 0; n < WN; n++) acc[m][n] = mfma16(a1[m], b1[n], acc[m][n]);
  };
  auto step = [&](int k, char* cur, char* nxt) {
    if (k + 1 < nk) wait_vm8(); else wait_vm0();
    raw_barrier();
    if (k + 2 < nk) issue(k + 2, nxt);
    compute(cur);
  };
  issue(0, S0);
  if (nk > 1) issue(1, S1);
#pragma unroll 1
  for (int kt = 0; kt < nk; kt += 3) {
    step(kt, S0, S2);
    if (kt + 1 < nk) step(kt + 1, S1, S0);
    if (kt + 2 < nk) step(kt + 2, S2, S1);
  }
  raw_barrier();
}
DI void slot_rc(int i, int& row, int& coff) { int s = i * 256 + TIDX; row = s >> 3; coff = ((s & 7) ^ ((row >> 1) & 7)) * 8; }

DI void gemm_in_phase(const Params& P, int l, char* smem, char* stB, char* stC) {
  const int tid = TIDX, lane = tid & 63, wave = tid >> 6, fr = lane & 15, fq = lane >> 4, wr = wave >> 1, wc = wave & 1;
  const half_t* Wt = P.WtIn + (size_t)l * NIN * 1024;
  for (int t = blockIdx.x; t < 528 * 20; t += gridDim.x) {
    const int mt = t / 20, nt = t % 20;
    const half_t* ap[4]; const half_t* bp[4];
#pragma unroll
    for (int i = 0; i < 4; i++) { int row, co; slot_rc(i, row, co); ap[i] = P.hx + (size_t)(mt * 128 + row) * D + co; bp[i] = Wt + (size_t)(nt * 128 + row) * D + co; }
    f4 acc[4][4];
    gemm128<4, 4>(ap, bp, 16, smem, stB, stC, acc);
    const int r0 = mt * 128 + wr * 64;
    const bool isctx = r0 < TC;
    int b, pos0;
    if (isctx) { b = r0 >> 8; pos0 = r0 & 255; } else { b = (r0 - TC) >> 13; pos0 = 256 + ((r0 - TC) & 8191); }
    if (nt < 4 || nt >= 16) {
      half_t* dst; int ld, c0; bool gel = false;
      if (nt < 4) { dst = P.QF; ld = 512; c0 = nt * 128; }
      else if (nt < 18) { dst = P.gy; ld = 256; c0 = (nt - 16) * 128; gel = true; }
      else { dst = P.rr; ld = 256; c0 = (nt - 18) * 128; }
#pragma unroll
      for (int m = 0; m < 4; m++)
#pragma unroll
        for (int n = 0; n < 4; n++)
#pragma unroll
          for (int j = 0; j < 4; j++) {
            float v = acc[m][n][j]; if (gel) v = gelu_tanh(v);
            dst[(size_t)(r0 + m * 16 + fq * 4 + j) * ld + c0 + wc * 64 + n * 16 + fr] = (half_t)v;
          }
    } else if (nt < 12) {
      const bool isq = nt < 8; const int head = isq ? nt - 4 : nt - 8;
      const float* gvec = (isq ? P.q_norm_g : P.k_norm_g) + l * 64;
      float gg[4];
#pragma unroll
      for (int n = 0; n < 4; n++) gg[n] = gvec[n * 16 + fr];
      const float qs = isq ? 0.125f * 1.4426950408889634f : 1.f;
#pragma unroll
      for (int m = 0; m < 4; m++)
#pragma unroll
        for (int j = 0; j < 4; j++) {
          float ss = 0.f;
#pragma unroll
          for (int n = 0; n < 4; n++) ss += acc[m][n][j] * acc[m][n][j];
          ss += __shfl_xor(ss, 1); ss += __shfl_xor(ss, 2); ss += __shfl_xor(ss, 4); ss += __shfl_xor(ss, 8);
          const float rstd = rsqrtf(ss * (1.f / 64.f) + EPS);
          float o[4];
#pragma unroll
          for (int n = 0; n < 4; n++) o[n] = acc[m][n][j] * rstd * gg[n];
          const int rl = m * 16 + fq * 4 + j;
          if (!isctx) {
            const int tpos = pos0 - 256 + rl;
            float2 cr = P.rope[(tpos >> 6) * 16 + fr], cc = P.rope[(tpos & 63) * 16 + fr];
            float a0 = o[0] * cr.x - o[1] * cr.y, a1 = o[1] * cr.x + o[0] * cr.y;
            float a2 = o[2] * cc.x - o[3] * cc.y, a3 = o[3] * cc.x + o[2] * cc.y;
            o[0] = a0; o[1] = a1; o[2] = a2; o[3] = a3;
          }
          half_t* dst = isq ? P.q + (size_t)(r0 + rl) * 512 : P.kall + ((size_t)b * KV + pos0 + rl) * 512;
#pragma unroll
          for (int n = 0; n < 4; n++) dst[head * 128 + wc * 64 + n * 16 + fr] = (half_t)(o[n] * qs);
        }
    } else {
      const int head = nt - 12;
#pragma unroll
      for (int m = 0; m < 4; m++)
#pragma unroll
        for (int n = 0; n < 4; n++) {
          h4 o; o[0] = (half_t)acc[m][n][0]; o[1] = (half_t)acc[m][n][1]; o[2] = (half_t)acc[m][n][2]; o[3] = (half_t)acc[m][n][3];
          const int d = wc * 64 + n * 16 + fr;
          *(h4*)(P.vT + ((size_t)(b * 4 + head) * 128 + d) * KV + pos0 + m * 16 + fq * 4) = o;
        }
    }
  }
}

DI void gemm_out_phase(const Params& P, int l, char* smem, char* stB, char* stC) {
  const int tid = TIDX, lane = tid & 63, wave = tid >> 6, fr = lane & 15, fq = lane >> 4, wr = wave >> 1, wc = wave & 1;
  const half_t* Wt = P.WtOut + (size_t)l * 1048576;
  const int mt0 = l == 0 ? 0 : TC / 128;
  for (int t = blockIdx.x + mt0 * 8; t < 528 * 8; t += gridDim.x) {
    const int mt = t / 8, nt = t % 8;
    const half_t* ap[4]; const half_t* bp[4];
#pragma unroll
    for (int i = 0; i < 4; i++) { int row, co; slot_rc(i, row, co); ap[i] = P.mix + (size_t)(mt * 128 + row) * D + co; bp[i] = Wt + (size_t)(nt * 128 + row) * D + co; }
    f4 acc[4][4];
    gemm128<4, 4>(ap, bp, 16, smem, stB, stC, acc);
    const int r0 = mt * 128 + wr * 64;
    const int n = row_mod(r0);
    const float* g1 = P.mod + (size_t)(l * 9 + n) * 6144 + 2 * 1024;
    const float* res; float* dst;
    if (r0 < TC) { res = P.ctx + (size_t)r0 * D; dst = P.xcbuf + (size_t)r0 * D; }
    else { dst = P.out + (size_t)(r0 - TC) * D; res = l == 0 ? P.x + (size_t)(r0 - TC) * D : dst; }
#pragma unroll
    for (int m = 0; m < 4; m++)
#pragma unroll
      for (int nn = 0; nn < 4; nn++) {
        const int c = nt * 128 + wc * 64 + nn * 16 + fr; const float g = g1[c];
#pragma unroll
        for (int j = 0; j < 4; j++) { size_t o = (size_t)(m * 16 + fq * 4 + j) * D + c; dst[o] = res[o] + g * acc[m][nn][j]; }
      }
  }
}

DI void moe_prefix(const Params& P, int l, int* tb) {
  __syncthreads();
  if (TIDX == 0) { int s = 0; for (int e = 0; e < 32; e++) { tb[e] = s; s += (P.cnt[l * 32 + e] + 127) >> 7; } tb[32] = s; }
  __syncthreads();
}
DI void moe_e1_phase(const Params& P, int l, char* smem, char* stB, char* stC, int* tb) {
  const int tid = TIDX, lane = tid & 63, wave = tid >> 6, fr = lane & 15, fq = lane >> 4;
  moe_prefix(P, l, tb);
  const int total = tb[32] * 8;
  for (int t = blockIdx.x; t < total; t += gridDim.x) {
    const int rt = t >> 3, nt = t & 7;
    int e = 0;
    while (tb[e + 1] <= rt) e++;
    const int rl = rt - tb[e], cnt = P.cnt[l * 32 + e];
    const int* lst = P.list + (size_t)e * LCAP;
    const half_t* w1 = P.Wt1 + ((size_t)(l * 32 + e) * 512 + nt * 64) * 1024;
    const half_t* w3 = P.Wt3 + ((size_t)(l * 32 + e) * 512 + nt * 64) * 1024;
    const half_t* ap[4]; const half_t* bp[4];
#pragma unroll
    for (int i = 0; i < 4; i++) {
      int row, co; slot_rc(i, row, co);
      int idx = min(rl * 128 + row, cnt - 1);
      int a = lst[idx];
      ap[i] = P.hx + (size_t)(a >> 1) * D + co;
      bp[i] = (row < 64 ? w1 + (size_t)row * 1024 : w3 + (size_t)(row - 64) * 1024) + co;
    }
    f4 acc[2][8];
    gemm128<2, 8>(ap, bp, 16, smem, stB, stC, acc);
    half_t* Hd = P.H + ((size_t)rt * 128 + wave * 32) * 512 + nt * 64;
#pragma unroll
    for (int m = 0; m < 2; m++)
#pragma unroll
      for (int n = 0; n < 4; n++)
#pragma unroll
        for (int j = 0; j < 4; j++) {
          float a1 = acc[m][n][j], a3 = acc[m][n + 4][j];
          Hd[(size_t)(m * 16 + fq * 4 + j) * 512 + n * 16 + fr] = (half_t)(a1 * sigmoidf_(a1) * a3);
        }
  }
}
DI void moe_e2_phase(const Params& P, int l, char* smem, char* stB, char* stC, int* tb) {
  const int tid = TIDX, lane = tid & 63, wave = tid >> 6, fr = lane & 15, fq = lane >> 4, wr = wave >> 1, wc = wave & 1;
  moe_prefix(P, l, tb);
  const int total = tb[32] * 8;
  for (int t = blockIdx.x; t < total; t += gridDim.x) {
    const int rt = t >> 3, nt = t & 7;
    int e = 0;
    while (tb[e + 1] <= rt) e++;
    const int rl = rt - tb[e], cnt = P.cnt[l * 32 + e];
    const int* lst = P.list + (size_t)e * LCAP;
    const half_t* w2 = P.Wt2 + ((size_t)(l * 32 + e) * 1024 + nt * 128) * 512;
    const half_t* ap[4]; const half_t* bp[4];
#pragma unroll
    for (int i = 0; i < 4; i++) { int row, co; slot_rc(i, row, co); ap[i] = P.H + ((size_t)rt * 128 + row) * 512 + co; bp[i] = w2 + (size_t)row * 512 + co; }
    f4 acc[4][4];
    gemm128<4, 4>(ap, bp, 8, smem, stB, stC, acc);
#pragma unroll
    for (int m = 0; m < 4; m++)
#pragma unroll
      for (int j = 0; j < 4; j++) {
        const int idx = rl * 128 + wr * 64 + m * 16 + fq * 4 + j;
        if (idx < cnt) {
          const int a = lst[idx]; const float w = P.tokW[a];
          half_t* dst = P.yA + (size_t)a * D + nt * 128 + wc * 64 + fr;
#pragma unroll
          for (int n = 0; n < 4; n++) dst[n * 16] = (half_t)(w * acc[m][n][j]);
        }
      }
  }
}

DI int swap23(int x) { return (x & ~12) | ((x & 4) << 1) | ((x & 8) >> 1); }
DI void attn_item(const Params& P, int l, int b, int head, int row0, int nkeys, char* smem) {
  const int tid = TIDX, lane = tid & 63, wave = tid >> 6, ql = lane & 31, hh = lane >> 5;
  const float lam = P.consts[l * 4 + 0], negc = -P.consts[l * 4 + 1], lam_init = P.consts[l * 4 + 2];
  const int myrow = row0 + wave * 32 + ql;
  h8 qf[2][4];
  {
    const half_t* qp = P.q + (size_t)myrow * 512 + head * 128 + hh * 8;
#pragma unroll
    for (int m = 0; m < 2; m++)
#pragma unroll
      for (int s = 0; s < 4; s++) { qf[m][s] = *(const h8*)(qp + m * 64 + s * 16); }
#pragma unroll
    for (int m = 0; m < 2; m++)
#pragma unroll
      for (int s = 0; s < 4; s++) tie(qf[m][s]);
  }
  f16v o0[4], o1[4];
#pragma unroll
  for (int dt = 0; dt < 4; dt++)
#pragma unroll
    for (int i = 0; i < 16; i++) { o0[dt][i] = 0.f; o1[dt][i] = 0.f; }
  float ls0 = 0.f, ls1 = 0.f;
  const half_t* kp[4]; const half_t* vp[4];
  {
    const half_t* kbase = P.kall + (size_t)b * KV * 512 + head * 128;
    const half_t* vbase = P.vT + (size_t)(b * 4 + head) * 128 * KV;
#pragma unroll
    for (int i = 0; i < 4; i++) {
      int s = i * 256 + tid;
      int row = s >> 4, c = (s & 15) ^ (row & 15); kp[i] = kbase + (size_t)row * 512 + c * 8;
      int vr = s >> 3, vc = (s & 7) ^ ((vr >> 1) & 7); vp[i] = vbase + (size_t)vr * KV + vc * 8;
    }
  }
  const int ntile = nkeys >> 6;
  const unsigned sbase = lds_addr(smem);
  auto issue = [&](int t) {
    char* d = smem + (t % 3) * 32768 + tid * 16;
#pragma unroll
    for (int i = 0; i < 4; i++) { glds16(kp[i] + (size_t)t * 64 * 512, d + i * 4096); glds16(vp[i] + t * 64, d + 16384 + i * 4096); }
  };
  unsigned koff[2];
  const int kr_lo = swap23(ql), ksw = kr_lo & 15;
  koff[0] = kr_lo * 256; koff[1] = (32 + kr_lo) * 256;
  unsigned voff[4];
#pragma unroll
  for (int dt = 0; dt < 4; dt++) { int vrow = dt * 32 + ql; voff[dt] = 16384 + vrow * 128; }
  const int vsw = (ql >> 1) & 7;
  h8 pp0[2], pp1[2];
  unsigned pendV = 0; int pendkt = 0; bool pend = false;
  issue(0);
#pragma unroll 1
  for (int t = 0; t < ntile; t++) {
    wait_vm0();
    raw_barrier();
    if (t + 1 < ntile) issue(t + 1);
    const unsigned cur = sbase + (t % 3) * 32768;
#pragma unroll 1
    for (int kt = 0; kt < 2; kt++) {
      h8 kf[8];
#pragma unroll
      for (int st = 0; st < 4; st++) {
        kf[st] = lds128(cur + koff[kt] + (((st * 2 + hh) ^ ksw) << 4));
        kf[4 + st] = lds128(cur + koff[kt] + (((8 + st * 2 + hh) ^ ksw) << 4));
      }
      h8 vf[8];
      if (pend) {
#pragma unroll
        for (int sp = 0; sp < 2; sp++)
#pragma unroll
          for (int dt = 0; dt < 4; dt++) vf[sp * 4 + dt] = lds128(pendV + voff[dt] + (((pendkt * 4 + sp * 2 + hh) ^ vsw) << 4));
      }
      if (pend) WAIT_LGKM(8); else WAIT_LGKM(0);
#pragma unroll
      for (int i = 0; i < 8; i++) tie(kf[i]);
      f16v s0, s1;
#pragma unroll
      for (int i = 0; i < 16; i++) { s0[i] = negc; s1[i] = negc; }
#pragma unroll
      for (int st = 0; st < 4; st++) { s0 = mfma32(kf[st], qf[0][st], s0); s1 = mfma32(kf[4 + st], qf[1][st], s1); }
      if (pend) {
        WAIT_LGKM(0);
#pragma unroll
        for (int i = 0; i < 8; i++) tie(vf[i]);
#pragma unroll
        for (int sp = 0; sp < 2; sp++)
#pragma unroll
          for (int dt = 0; dt < 4; dt++) { o0[dt] = mfma32(vf[sp * 4 + dt], pp0[sp], o0[dt]); o1[dt] = mfma32(vf[sp * 4 + dt], pp1[sp], o1[dt]); }
      }
#pragma unroll
      for (int i = 0; i < 16; i++) { s0[i] = __builtin_amdgcn_exp2f(s0[i]); ls0 += s0[i]; s1[i] = __builtin_amdgcn_exp2f(s1[i]); ls1 += s1[i]; }
#pragma unroll
      for (int sp = 0; sp < 2; sp++) {
        u4 a, c;
        a[0] = pk2(s0[8*sp+0], s0[8*sp+1]); a[1] = pk2(s0[8*sp+2], s0[8*sp+3]); a[2] = pk2(s0[8*sp+4], s0[8*sp+5]); a[3] = pk2(s0[8*sp+6], s0[8*sp+7]);
        c[0] = pk2(s1[8*sp+0], s1[8*sp+1]); c[1] = pk2(s1[8*sp+2], s1[8*sp+3]); c[2] = pk2(s1[8*sp+4], s1[8*sp+5]); c[3] = pk2(s1[8*sp+6], s1[8*sp+7]);
        pp0[sp] = __builtin_bit_cast(h8, a); pp1[sp] = __builtin_bit_cast(h8, c);
      }
      pend = true; pendV = cur; pendkt = kt;
    }
  }
  {
    h8 vf[8];
#pragma unroll
    for (int sp = 0; sp < 2; sp++)
#pragma unroll
      for (int dt = 0; dt < 4; dt++) vf[sp * 4 + dt] = lds128(pendV + voff[dt] + (((pendkt * 4 + sp * 2 + hh) ^ vsw) << 4));
    WAIT_LGKM(0);
#pragma unroll
    for (int i = 0; i < 8; i++) tie(vf[i]);
#pragma unroll
    for (int sp = 0; sp < 2; sp++)
#pragma unroll
      for (int dt = 0; dt < 4; dt++) { o0[dt] = mfma32(vf[sp * 4 + dt], pp0[sp], o0[dt]); o1[dt] = mfma32(vf[sp * 4 + dt], pp1[sp], o1[dt]); }
  }
  raw_barrier();
  ls0 += __shfl_xor(ls0, 32); ls1 += __shfl_xor(ls1, 32);
  const float i0 = 1.f / ls0, i1 = lam / ls1;
  float ss = 0.f;
#pragma unroll
  for (int dt = 0; dt < 4; dt++)
#pragma unroll
    for (int i = 0; i < 16; i++) { float v = o0[dt][i] * i0 - o1[dt][i] * i1; o0[dt][i] = v; ss += v * v; }
  ss += __shfl_xor(ss, 32);
  const float mult = rsqrtf(ss * (1.f / 128.f) + EPS) * (1.f - lam_init);
  const float* sg = P.subln_g + l * 128;
  half_t* dst = P.mix + (size_t)myrow * D + 256 + head * 128;
#pragma unroll
  for (int dt = 0; dt < 4; dt++)
#pragma unroll
    for (int g = 0; g < 4; g++) {
      const int d0 = dt * 32 + 8 * g + 4 * hh;
      float4 gv = *(const float4*)(sg + d0);
      h4 o; o[0] = (half_t)(o0[dt][4*g] * mult * gv.x); o[1] = (half_t)(o0[dt][4*g+1] * mult * gv.y);
      o[2] = (half_t)(o0[dt][4*g+2] * mult * gv.z); o[3] = (half_t)(o0[dt][4*g+3] * mult * gv.w);
      *(h4*)(dst + d0) = o;
    }
}

DI int swz128(int row, int colh) { return row * 128 + ((((colh >> 3)) ^ ((row >> 1) & 7)) << 4) + (colh & 7) * 2; }
DI void lru_load_w(const Params& P, int l, int g, char* Wt) {
  const int tid = TIDX;
  for (int dg = 0; dg < 4; dg++) {
    const int dir = dg >> 1;
    const float* w = ((dg & 1) ? P.gate_x_w : P.gate_a_w) + ((size_t)((l * 2 + dir) * 4 + g)) * 4096;
    for (int idx = tid; idx < 4096; idx += 256) { int i = idx >> 6, o = idx & 63; *(half_t*)(Wt + dg * 8192 + swz128(o, i)) = (half_t)w[idx]; }
  }
}
DI void lru_tile(const Params& P, int l, int b, int tile, int g, char* smem, bool final) {
  const int tid = TIDX, lane = tid & 63, wave = tid >> 6, fr = lane & 15, fq = lane >> 4;
  char* Wt = smem;
  char* xr16 = smem + 32768;
  float2* ab = (float2*)(smem + 40960);
  half_t* raw = (half_t*)(smem + 40960);
  float2* subst = (float2*)(smem + 73728);
  const int ch = tid & 63, tq = tid >> 6, gc = g * 64 + ch;
  const int T = tile < 4 ? CL : SEQ;
  const int t0 = tile < 4 ? tile * 64 : (tile - 4) * 64;
  const int rowbase = tile < 4 ? b * CL : TC + b * SEQ;
  __syncthreads();
  for (int idx = tid; idx < 67 * 8; idx += 256) {
    int row = idx >> 3, c = idx & 7, tt = t0 - 1 + row;
    h8 v = {0, 0, 0, 0, 0, 0, 0, 0};
    if (tt >= 0 && tt < T) v = *(const h8*)(P.rr + (size_t)(rowbase + tt) * 256 + g * 64 + c * 8);
    *(h8*)(raw + row * 64 + c * 8) = v;
  }
  float gyv[16];
  if (final) {
#pragma unroll
    for (int e = 0; e < 16; e++) gyv[e] = (float)P.gy[(size_t)(rowbase + t0 + tq * 16 + e) * 256 + gc];
  }
  const float cw0 = P.conv_w[(l * 4 + 0) * 256 + gc], cw1 = P.conv_w[(l * 4 + 1) * 256 + gc], cw2 = P.conv_w[(l * 4 + 2) * 256 + gc],
              cw3 = P.conv_w[(l * 4 + 3) * 256 + gc], cb = P.conv_b[l * 256 + gc];
  __syncthreads();
  {
    float v[19];
#pragma unroll
    for (int e = 0; e < 19; e++) v[e] = (float)raw[(tq * 16 + e) * 64 + ch];
    __syncthreads();
#pragma unroll
    for (int e = 0; e < 16; e++) {
      float xv = cb + cw0 * v[e] + cw1 * v[e + 1] + cw2 * v[e + 2] + cw3 * v[e + 3];
      *(half_t*)(xr16 + swz128(tq * 16 + e, ch)) = (half_t)xv;
    }
  }
  __syncthreads();
  float hsum[16];
#pragma unroll
  for (int e = 0; e < 16; e++) hsum[e] = 0.f;
#pragma unroll 1
  for (int dir = 0; dir < 2; dir++) {
    {
      f4 acc[2][4];
#pragma unroll
      for (int gt = 0; gt < 2; gt++)
#pragma unroll
        for (int n = 0; n < 4; n++) acc[gt][n] = (f4){0.f, 0.f, 0.f, 0.f};
#pragma unroll
      for (int kk = 0; kk < 2; kk++) {
        int row = wave * 16 + fr;
        h8 af = *(const h8*)(xr16 + row * 128 + (((kk * 4 + fq) ^ ((row >> 1) & 7)) << 4));
#pragma unroll
        for (int gt = 0; gt < 2; gt++)
#pragma unroll
          for (int n = 0; n < 4; n++) {
            int orow = n * 16 + fr;
            h8 bf = *(const h8*)(Wt + (dir * 2 + gt) * 8192 + orow * 128 + (((kk * 4 + fq) ^ ((orow >> 1) & 7)) << 4));
            acc[gt][n] = mfma16(af, bf, acc[gt][n]);
          }
      }
#pragma unroll
      for (int n = 0; n < 4; n++) {
        const int cc = (l * 2 + dir) * 256 + g * 64 + n * 16 + fr;
        const float ba = P.gate_a_b[cc], bx = P.gate_x_b[cc];
        const float sp8 = -8.f * log1pf(__expf(-P.lru_lambda[cc]));
#pragma unroll
        for (int j = 0; j < 4; j++) {
          int tl = wave * 16 + fq * 4 + j, c2 = n * 16 + fr;
          float xv = (float)*(const half_t*)(xr16 + swz128(tl, c2));
          float rg = sigmoidf_(acc[0][n][j] + ba), ig = sigmoidf_(acc[1][n][j] + bx);
          float log_a = rg * sp8;
          float a = __expf(log_a);
          float x2 = 2.f * log_a;
          float om = -x2 * (1.f + x2 * (0.5f + x2 * (0.16666667f + x2 * (0.041666668f + x2 * (0.008333334f + x2 * 0.0013888889f)))));
          om = x2 < -0.4f ? 1.f - a * a : om;
          ab[tl * 64 + c2] = make_float2(a, sqrtf(om) * (ig * xv));
        }
      }
    }
    __syncthreads();
    float2 av[16];
    {
      float A = 1.f, h = 0.f;
#pragma unroll
      for (int e = 0; e < 16; e++) {
        int ee = dir == 0 ? e : 15 - e;
        av[e] = ab[(tq * 16 + ee) * 64 + ch];
        h = av[e].x * h + av[e].y; A *= av[e].x;
      }
      subst[tq * 64 + ch] = make_float2(A, h);
    }
    __syncthreads();
    const size_t sidx = ((size_t)((b * 2 + dir) * 132 + tile)) * 256 + gc;
    if (!final) {
      if (tq == 0) {
        float A = 1.f, h = 0.f;
#pragma unroll
        for (int s = 0; s < 4; s++) { float2 ss = subst[(dir == 0 ? s : 3 - s) * 64 + ch]; h = ss.x * h + ss.y; A *= ss.x; }
        P.lsum[sidx] = make_float2(A, h);
      }
    } else {
      float h = P.lcar[sidx];
      if (dir == 0) { for (int s = 0; s < tq; s++) { float2 ss = subst[s * 64 + ch]; h = ss.x * h + ss.y; } }
      else { for (int s = 3; s > tq; s--) { float2 ss = subst[s * 64 + ch]; h = ss.x * h + ss.y; } }
#pragma unroll
      for (int e = 0; e < 16; e++) {
        int ee = dir == 0 ? e : 15 - e;
        h = av[e].x * h + av[e].y;
#pragma unroll
        for (int q = 0; q < 16; q++) hsum[q] += (q == ee) ? h : 0.f;
      }
    }
    __syncthreads();
  }
  if (final) {
#pragma unroll
    for (int e = 0; e < 16; e++)
      P.mix[(size_t)(rowbase + t0 + tq * 16 + e) * D + 768 + gc] = (half_t)(gyv[e] * hsum[e]);
  }
}
DI void lru_carry_item(const Params& P, int it) {
  const int ch = TIDX, dir = it & 1;
  const size_t base = (size_t)it * 132 * 256 + ch;
  float c = 0.f;
#pragma unroll 4
  for (int k = 0; k < 132; k++) {
    int tile = dir == 0 ? k : (k < 4 ? 3 - k : 135 - k);
    float2 s = P.lsum[base + (size_t)tile * 256];
    P.lcar[base + (size_t)tile * 256] = c;
    c = s.x * c + s.y;
  }
}

DI void fft_load(const half_t* src, size_t rs, int nrows, char* Bt, int rowbytes, int k0) {
  for (int idx = TIDX; idx < nrows * 16; idx += 256) {
    int kr = idx >> 4, cc = idx & 15, k = k0 + kr;
    h8 v = *(const h8*)(src + (size_t)kr * rs + cc * 8);
#pragma unroll
    for (int u = 0; u < 8; u++) { int n = cc * 8 + u; *(half_t*)(Bt + n * rowbytes + ((((k >> 3)) ^ (n & 15)) << 4) + (k & 7) * 2) = v[u]; }
  }
}
template <class RF>
DI void fft_mma(const half_t* Dm, int ldD, int nkk, const char* Bt, int rowbytes, f4 (&acc)[4][4], RF arow) {
  const int lane = TIDX & 63, wave = TIDX >> 6, fr = lane & 15, fq = lane >> 4, wc = wave & 1;
#pragma unroll 1
  for (int kk = 0; kk < nkk; kk++) {
    h8 af[4], bf[4];
#pragma unroll
    for (int ms = 0; ms < 4; ms++) af[ms] = *(const h8*)(Dm + (size_t)arow(ms) * ldD + kk * 32 + fq * 8);
#pragma unroll
    for (int ns = 0; ns < 4; ns++) { int n = wc * 64 + ns * 16 + fr; bf[ns] = *(const h8*)(Bt + n * rowbytes + (((kk * 4 + fq) ^ (n & 15)) << 4)); }
#pragma unroll
    for (int ms = 0; ms < 4; ms++)
#pragma unroll
      for (int ns = 0; ns < 4; ns++) acc[ms][ns] = mfma16(af[ms], bf[ns], acc[ms][ns]);
  }
}
DI void zero44(f4 (&acc)[4][4]) {
#pragma unroll
  for (int m = 0; m < 4; m++)
#pragma unroll
    for (int n = 0; n < 4; n++) acc[m][n] = (f4){0.f, 0.f, 0.f, 0.f};
}
DI void fftA_item(const Params& P, int it, char* smem) {
  const int b = it >> 8, bb = (it >> 1) & 127, chh = it & 1;
  const int lane = TIDX & 63, wave = TIDX >> 6, fr = lane & 15, fq = lane >> 4, wr = wave >> 1, wc = wave & 1;
  __syncthreads();
  fft_load(P.QF + (size_t)(TC + b * SEQ + bb) * 512 + chh * 128, (size_t)128 * 512, 64, smem, 256, 0);
  fft_load(P.QF + (size_t)(TC + b * SEQ + bb) * 512 + 256 + chh * 128, (size_t)128 * 512, 64, smem, 256, 64);
  __syncthreads();
  f4 acc[4][4]; zero44(acc);
  fft_mma(P.DA, 128, 4, smem, 256, acc, [&](int ms) { return (ms >> 1) * 64 + wr * 32 + (ms & 1) * 16 + fr; });
#pragma unroll
  for (int ms = 0; ms < 2; ms++)
#pragma unroll
    for (int j = 0; j < 4; j++) {
      const int f1 = wr * 32 + ms * 16 + fq * 4 + j;
      const float2 w = P.tw[(bb * f1) & 8191];
      half_t* d0 = P.GA + ((size_t)(b * 64 + f1) * 256 + bb) * 256 + chh * 128 + wc * 64 + fr;
#pragma unroll
      for (int ns = 0; ns < 4; ns++) {
        float gr = acc[ms][ns][j], gi = acc[ms + 2][ns][j];
        d0[ns * 16] = (half_t)(gr * w.x + gi * w.y);
        d0[(size_t)128 * 256 + ns * 16] = (half_t)(gi * w.x - gr * w.y);
      }
    }
}
DI void fftB_item(const Params& P, int it, char* smem) {
  const int b = it >> 7, f1 = (it >> 1) & 63, chh = it & 1;
  const int lane = TIDX & 63, wave = TIDX >> 6, fr = lane & 15, fq = lane >> 4, wr = wave >> 1, wc = wave & 1;
  __syncthreads();
  fft_load(P.GA + (size_t)(b * 64 + f1) * 256 * 256 + chh * 128, 256, 256, smem, 512, 0);
  __syncthreads();
  f4 acc[4][4]; zero44(acc);
  fft_mma(P.DB, 256, 8, smem, 512, acc, [&](int ms) { return wr * 64 + ms * 16 + fr; });
#pragma unroll
  for (int ms = 0; ms < 4; ms++)
#pragma unroll
    for (int j = 0; j < 4; j++) {
      const int f2 = wr * 64 + ms * 16 + fq * 4 + j;
      half_t* d0 = P.mix + (size_t)(TC + b * SEQ + f1 + 64 * f2) * D + chh * 128 + wc * 64 + fr;
#pragma unroll
      for (int ns = 0; ns < 4; ns++) d0[ns * 16] = (half_t)acc[ms][ns][j];
    }
}
DI void fftC_item(const Params& P, int it, char* smem) {
  const int b = it >> 1, chh = it & 1;
  const int lane = TIDX & 63, wave = TIDX >> 6, fr = lane & 15, fq = lane >> 4, wr = wave >> 1, wc = wave & 1;
#pragma unroll 1
  for (int mh = 0; mh < 2; mh++) {
    f4 acc[4][4]; zero44(acc);
#pragma unroll 1
    for (int part = 0; part < 2; part++) {
      __syncthreads();
      fft_load(P.QF + (size_t)(b * CL) * 512 + part * 256 + chh * 128, 512, 256, smem, 512, 0);
      __syncthreads();
      fft_mma(P.DC + part * 256, 512, 8, smem, 512, acc, [&](int ms) { return mh * 128 + wr * 64 + ms * 16 + fr; });
    }
#pragma unroll
    for (int ms = 0; ms < 4; ms++)
#pragma unroll
      for (int j = 0; j < 4; j++) {
        const int f = mh * 128 + wr * 64 + ms * 16 + fq * 4 + j;
        half_t* d0 = P.mix + (size_t)(b * CL + f) * D + chh * 128 + wc * 64 + fr;
#pragma unroll
        for (int ns = 0; ns < 4; ns++) d0[ns * 16] = (half_t)acc[ms][ns][j];
      }
  }
}

#ifndef MX
#define MX 15
#endif
DI void mix_phase(const Params& P, int l, char* smem, int* s_item, int qi) {
  const int nL = 0, nA = 2048, nC = l == 0 ? 64 : 0, nFA = 2048, nFC = l == 0 ? 16 : 0;
  const int total = nL + nA + nC + nFA + nFC;
  {
    const int g = blockIdx.x & 3;
    lru_load_w(P, l, g, smem);
    for (int u = blockIdx.x >> 2; u < NB_ * 132; u += gridDim.x >> 2) lru_tile(P, l, u / 132, u % 132, g, smem, false);
  }
  for (;;) {
    __syncthreads();
    if (TIDX == 0) *s_item = atomicAdd(&P.qctr[qi], 1);
    __syncthreads();
    int it = *s_item;
    if (it >= total) break;
        it -= nL;
    if (it < nA + nC) {
#if MX & 2
      int b, head, row0, nk;
      if (it < nA) { b = it >> 8; head = (it >> 6) & 3; row0 = TC + b * SEQ + (it & 63) * 128; nk = KV; }
      else { int u = it - nA; b = u >> 3; head = (u >> 1) & 3; row0 = b * CL + (u & 1) * 128; nk = CL; }
      attn_item(P, l, b, head, row0, nk, smem);
#endif
      continue; }
    it -= nA;
    it -= nC;
    if (it < nFA) {
#if MX & 4
      fftA_item(P, it, smem);
#endif
      continue; }
    it -= nFA;
#if MX & 8
    fftC_item(P, it, smem);
#endif
  }
}

__global__ void __launch_bounds__(256, 1) fwd_megakernel(Params P) {
  __shared__ __attribute__((aligned(16))) char smem[98304];
  char* stB = smem + 32768; char* stC = smem + 65536;
  __shared__ int tb[33];
  __shared__ int s_item;
  cg::grid_group grid = cg::this_grid();
#ifndef PH
#define PH 0xFFFF
#endif
#if PH & 1
  phase0(P, smem);
#endif
  grid.sync();
  for (int l = 0; l < 2; l++) {
#if PH & 2
    row1_phase(P, l == 0 ? -1 : 0, l, 0);
#endif
    grid.sync();
#if PH & 4
    gemm_in_phase(P, l, smem, stB, stC);
#ifdef DUP_GEMM
    grid.sync();
    gemm_in_phase(P, l, smem, stB, stC);
#endif
#endif
    grid.sync();
#if PH & 8
    mix_phase(P, l, smem, &s_item, l);
#ifdef DUP_MIX
    grid.sync();
    mix_phase(P, l, smem, &s_item, 2 + l);
#endif
#endif
    grid.sync();
#if PH & 16
    if (blockIdx.x >= gridDim.x - 16) lru_carry_item(P, gridDim.x - 1 - blockIdx.x);
    for (int it = blockIdx.x; it < 1024; it += gridDim.x) fftB_item(P, it, smem);
#endif
    grid.sync();
    {
      const int g = blockIdx.x & 3;
      __syncthreads();
      lru_load_w(P, l, g, smem);
      for (int u = blockIdx.x >> 2; u < NB_ * 132; u += gridDim.x >> 2) lru_tile(P, l, u / 132, u % 132, g, smem, true);
    }
    grid.sync();
#if PH & 32
    gemm_out_phase(P, l, smem, stB, stC);
#endif
    grid.sync();
#if PH & 64
    row2_phase(P, l, l == 0 ? 0 : TC);
#endif
    grid.sync();
#if PH & 128
    moe_e1_phase(P, l, smem, stB, stC, tb);
#ifdef DUP_GEMM
    grid.sync();
    moe_e1_phase(P, l, smem, stB, stC, tb);
#endif
#endif
    grid.sync();
#if PH & 256
    moe_e2_phase(P, l, smem, stB, stC, tb);
#ifdef DUP_GEMM
    grid.sync();
    moe_e2_phase(P, l, smem, stB, stC, tb);
#endif
#endif
    grid.sync();
  }
#if PH & 2
  row1_phase(P, 1, -1, TC);
#endif
}

extern "C" void kernel_launch(void* const* d_in, const int* in_sizes, int n_in, void* d_out, int out_size, void* d_ws, size_t ws_size,
                              hipStream_t stream) {
  static int grid_blocks = 0;
  if (!grid_blocks) {
    int dev = 0, cus = 0, per_cu = 0;
    hipGetDevice(&dev);
    hipDeviceGetAttribute(&cus, hipDeviceAttributeMultiprocessorCount, dev);
    hipOccupancyMaxActiveBlocksPerMultiprocessor(&per_cu, fwd_megakernel, 256, 0);
    if (per_cu > 2) per_cu = 2;
    grid_blocks = cus * per_cu;
  }
  Params p{};
  const float** pin = (const float**)&p;
  for (int i = 0; i < 31; i++) pin[i] = (const float*)d_in[i];
  p.out = (float*)d_out;
  char* w = (char*)d_ws; size_t off = 0;
  auto take = [&](size_t bytes) { char* r = w + off; off += (bytes + 255) & ~(size_t)255; return r; };
  p.WtIn = (half_t*)take((size_t)2 * NIN * 1024 * 2);
  p.WtOut = (half_t*)take((size_t)2 * 1024 * 1024 * 2);
  p.Wt1 = (half_t*)take((size_t)64 * 524288 * 2);
  p.Wt3 = (half_t*)take((size_t)64 * 524288 * 2);
  p.Wt2 = (half_t*)take((size_t)64 * 524288 * 2);
  p.mod = (float*)take((size_t)2 * 9 * 6144 * 4);
  p.rope = (float2*)take(128 * 16 * 8);
  p.tw = (float2*)take(8192 * 8);
  p.DA = (half_t*)take(16384 * 2);
  p.DB = (half_t*)take(32768 * 2);
  p.DC = (half_t*)take(131072 * 2);
  p.consts = (float*)take(256);
  p.cnt = (int*)take(256);
  p.qctr = (int*)take(256);
  p.tokW = (float*)take((size_t)2 * TA * 4);
  p.list = (int*)take((size_t)32 * LCAP * 4);
  p.xcbuf = (float*)take((size_t)TC * D * 4);
  p.WrT = (float*)take((size_t)2 * 36 * 1024 * 4);
  p.hx = (half_t*)take((size_t)TA * D * 2);
  p.mix = (half_t*)take((size_t)TA * D * 2);
  char* regB = w + off;
  p.q = (half_t*)take((size_t)TA * 512 * 2);
  p.kall = (half_t*)take((size_t)NB_ * KV * 512 * 2);
  p.vT = (half_t*)take((size_t)NB_ * 4 * 128 * KV * 2);
  p.QF = (half_t*)take((size_t)TA * 512 * 2);
  p.gy = (half_t*)take((size_t)TA * 256 * 2);
  p.rr = (half_t*)take((size_t)TA * 256 * 2);
  p.lsum = (float2*)take((size_t)16 * 132 * 256 * 8);
  p.lcar = (float*)take((size_t)16 * 132 * 256 * 4);
  p.GA = (half_t*)take((size_t)NB_ * 64 * 256 * 256 * 2);
  p.H = (half_t*)regB;
  p.yA = (half_t*)(regB + (((size_t)(2 * TA + 32 * 128) * 512 * 2 + 255) & ~(size_t)255));
  size_t moe_end = (size_t)((char*)p.yA - w) + (size_t)2 * TA * D * 2;
  if (off > ws_size || moe_end > off) { fprintf(stderr, "workspace too small: need %zu have %zu\n", off, ws_size); return; }
  void* args[] = {&p};
  hipError_t e = hipLaunchCooperativeKernel((void*)fwd_megakernel, dim3(grid_blocks), dim3(256), args, 0, stream);
  if (e != hipSuccess) fprintf(stderr, "cooperative launch failed: %s (grid %d)\n", hipGetErrorString(e), grid_blocks);
}
```

```cpp
#include <hip/hip_runtime.h>
#include <hip/hip_cooperative_groups.h>
#include <cstdio>
namespace cg = cooperative_groups;

typedef _Float16 half_t;
typedef _Float16 h8 __attribute__((ext_vector_type(8)));
typedef _Float16 h4 __attribute__((ext_vector_type(4)));
typedef __fp16 fp16x2 __attribute__((ext_vector_type(2)));
typedef unsigned u4 __attribute__((ext_vector_type(4)));
typedef float f4 __attribute__((ext_vector_type(4)));
typedef float f16v __attribute__((ext_vector_type(16)));
#define DI __device__ __forceinline__
__device__ __forceinline__ int tid_opaque() { int t = threadIdx.x; asm volatile("" : "+v"(t)); return t; }
#define TIDX tid_opaque()

constexpr int D = 1024, NB_ = 8, SEQ = 8192, CL = 256;
constexpr int TC = NB_ * CL;
constexpr int TX = NB_ * SEQ;
constexpr int TA = TC + TX;
constexpr int KV = CL + SEQ;
constexpr int NIN = 2560;
constexpr int LCAP = 2 * TA;
constexpr float EPS = 1e-6f;

struct Params {
  const float *x, *c, *ctx, *c_ctx, *w_mod, *b_mod, *norm1_g, *norm2_g, *w_in, *q_norm_g, *k_norm_g, *lq1, *lk1, *lq2, *lk2,
      *subln_g, *conv_w, *conv_b, *gate_a_w, *gate_a_b, *gate_x_w, *gate_x_b, *lru_lambda, *w_out, *w_group, *b_group,
      *w_router, *b_router, *w1, *w3, *w2;
  float* out; char* ws;
  half_t *WtIn, *WtOut, *Wt1, *Wt3, *Wt2;
  float* mod; float2* rope; float2* tw; half_t *DA, *DB, *DC; float* consts; int* cnt; int* qctr; float* tokW; int* list;
  float* xcbuf; half_t* WrH;
  half_t *hx, *mix, *q, *kall, *vT, *QF, *gy, *rr; float2* lsum; float* lcar; half_t* GA; half_t *H, *yA;
};


constexpr size_t al256(size_t x) { return (x + 255) & ~(size_t)255; }
constexpr size_t O_WtIn = 0;
constexpr size_t O_WtOut = O_WtIn + al256((size_t)2 * NIN * 1024 * 2);
constexpr size_t O_Wt1 = O_WtOut + al256((size_t)2 * 1024 * 1024 * 2);
constexpr size_t O_Wt3 = O_Wt1 + al256((size_t)64 * 524288 * 2);
constexpr size_t O_Wt2 = O_Wt3 + al256((size_t)64 * 524288 * 2);
constexpr size_t O_mod = O_Wt2 + al256((size_t)64 * 524288 * 2);
constexpr size_t O_rope = O_mod + al256((size_t)2 * 9 * 6144 * 4);
constexpr size_t O_tw = O_rope + al256(128 * 16 * 8);
constexpr size_t O_DA = O_tw + al256(8192 * 8);
constexpr size_t O_DB = O_DA + al256(16384 * 2);
constexpr size_t O_DC = O_DB + al256(32768 * 2);
constexpr size_t O_consts = O_DC + al256(131072 * 2);
constexpr size_t O_cnt = O_consts + 256;
constexpr size_t O_qctr = O_cnt + 256;
constexpr size_t O_tokW = O_qctr + 256;
constexpr size_t O_list = O_tokW + al256((size_t)2 * TA * 4);
constexpr size_t O_xcbuf = O_list + al256((size_t)32 * LCAP * 4);
constexpr size_t O_WrT = O_xcbuf + al256((size_t)TC * D * 4);
constexpr size_t O_hx = O_WrT + al256((size_t)2 * 2 * 48 * 1024 * 2);
constexpr size_t O_mix = O_hx + al256((size_t)TA * D * 2);
constexpr size_t O_regB = O_mix + al256((size_t)TA * D * 2);
constexpr size_t O_q = O_regB;
constexpr size_t O_kall = O_q + al256((size_t)TA * 512 * 2);
constexpr size_t O_vT = O_kall + al256((size_t)NB_ * KV * 512 * 2);
constexpr size_t O_QF = O_vT + al256((size_t)NB_ * 4 * 128 * KV * 2);
constexpr size_t O_gy = O_QF + al256((size_t)TA * 512 * 2);
constexpr size_t O_rr = O_gy + al256((size_t)TA * 256 * 2);
constexpr size_t O_lsum = O_rr + al256((size_t)TA * 256 * 2);
constexpr size_t O_lcar = O_lsum + al256((size_t)16 * 132 * 256 * 8);
constexpr size_t O_GA = O_lcar + al256((size_t)16 * 132 * 256 * 4);
constexpr size_t O_mixer_end = O_GA + al256((size_t)NB_ * 64 * 256 * 256 * 2);
constexpr size_t O_H = O_regB;
constexpr size_t O_yA = O_H + al256((size_t)(2 * TA + 32 * 256) * 512 * 2);
constexpr size_t O_moe_end = O_yA + al256((size_t)2 * TA * D * 2);
constexpr size_t WS_NEED = O_mixer_end > O_moe_end ? O_mixer_end : O_moe_end;
DI void bind_ws(Params& P) {
  char* w = P.ws;
  P.WtIn = (half_t*)(w + O_WtIn); P.WtOut = (half_t*)(w + O_WtOut); P.Wt1 = (half_t*)(w + O_Wt1); P.Wt3 = (half_t*)(w + O_Wt3); P.Wt2 = (half_t*)(w + O_Wt2);
  P.mod = (float*)(w + O_mod); P.rope = (float2*)(w + O_rope); P.tw = (float2*)(w + O_tw); P.DA = (half_t*)(w + O_DA); P.DB = (half_t*)(w + O_DB); P.DC = (half_t*)(w + O_DC);
  P.consts = (float*)(w + O_consts); P.cnt = (int*)(w + O_cnt); P.qctr = (int*)(w + O_qctr); P.tokW = (float*)(w + O_tokW); P.list = (int*)(w + O_list);
  P.xcbuf = (float*)(w + O_xcbuf); P.WrH = (half_t*)(w + O_WrT); P.hx = (half_t*)(w + O_hx); P.mix = (half_t*)(w + O_mix);
  P.q = (half_t*)(w + O_q); P.kall = (half_t*)(w + O_kall); P.vT = (half_t*)(w + O_vT); P.QF = (half_t*)(w + O_QF); P.gy = (half_t*)(w + O_gy); P.rr = (half_t*)(w + O_rr);
  P.lsum = (float2*)(w + O_lsum); P.lcar = (float*)(w + O_lcar); P.GA = (half_t*)(w + O_GA); P.H = (half_t*)(w + O_H); P.yA = (half_t*)(w + O_yA);
}
DI float shx(float v, int o) { int ln = TIDX & 63; return __builtin_bit_cast(float, __builtin_amdgcn_ds_bpermute((ln ^ o) << 2, __builtin_bit_cast(int, v))); }
DI float shi(float v, int idx) { return __builtin_bit_cast(float, __builtin_amdgcn_ds_bpermute(idx << 2, __builtin_bit_cast(int, v))); }
DI float wave_sum(float v) {
#pragma unroll
  for (int o = 32; o; o >>= 1) v += shx(v, o);
  return v;
}
DI void glds16(const void* g, void* l) {
  __builtin_amdgcn_global_load_lds((const unsigned*)g, (unsigned*)l, 16, 0, 0);
}
DI void wait_vm0() { asm volatile("s_waitcnt vmcnt(0)" ::: "memory"); }
DI f4 mfma16(h8 a, h8 b, f4 c) { return __builtin_amdgcn_mfma_f32_16x16x32_f16(a, b, c, 0, 0, 0); }
DI f16v mfma32(h8 a, h8 b, f16v c) { return __builtin_amdgcn_mfma_f32_32x32x16_f16(a, b, c, 0, 0, 0); }
DI unsigned pk2(float a, float b) { fp16x2 r = __builtin_amdgcn_cvt_pkrtz(a, b); return __builtin_bit_cast(unsigned, r); }
DI float sigmoidf_(float x) { return 1.f / (1.f + __expf(-x)); }
DI float gelu_tanh(float x) {
  float u = 0.7978845608028654f * (x + 0.044715f * x * x * x);
  float e = __expf(2.f * u);
  float t = 1.f - 2.f / (e + 1.f);
  return 0.5f * x * (1.f + t);
}
DI int row_mod(int r) { return r < TC ? 8 : ((r - TC) >> 13); }

DI void transpose_tile(const float* src, int lds_, half_t* dst, int ldd, float* tile) {
  const int tid = TIDX, n = tid & 63, kq = tid >> 6;
#pragma unroll 4
  for (int i = 0; i < 16; i++) { int k = i * 4 + kq; tile[k * 65 + n] = src[(size_t)k * lds_ + n]; }
  __syncthreads();
#pragma unroll 4
  for (int i = 0; i < 16; i++) { int nn = i * 4 + kq; dst[(size_t)nn * ldd + n] = (half_t)tile[n * 65 + nn]; }
  __syncthreads();
}

DI void phase0(const Params& P, char* smem) {
  float* tile = (float*)smem;
  const int tid = TIDX;
  constexpr int NT = 26112, NF = 128, NM = 192, NX = 6;
  for (int t = blockIdx.x; t < NT + NF + NM + NX; t += gridDim.x) {
    if (t < NT) {
      const float* src; half_t* dst; int lds_, ldd;
      if (t < 1024) {
        int l = t / 512, r = t % 512, kt = r / 32, nt = r % 32;
        src = P.w_in + (size_t)l * 1024 * 2304 + (size_t)kt * 64 * 2304 + 256 + nt * 64; lds_ = 2304;
        dst = P.WtIn + (size_t)l * NIN * 1024 + (size_t)(512 + nt * 64) * 1024 + kt * 64; ldd = 1024;
      } else if (t < 1536) {
        int u = t - 1024, l = u / 256, r = u % 256, kt = r / 16, nt = r % 16;
        src = P.w_out + (size_t)l * 1048576 + (size_t)kt * 64 * 1024 + nt * 64; lds_ = 1024;
        dst = P.WtOut + (size_t)l * 1048576 + (size_t)nt * 64 * 1024 + kt * 64; ldd = 1024;
      } else if (t < 1536 + 16384) {
        int u = t - 1536; const float* w = P.w1; half_t* o = P.Wt1;
        if (u >= 8192) { u -= 8192; w = P.w3; o = P.Wt3; }
        int le = u / 128, r = u % 128, kt = r / 8, nt = r % 8;
        src = w + (size_t)le * 524288 + (size_t)kt * 64 * 512 + nt * 64; lds_ = 512;
        dst = o + (size_t)le * 524288 + (size_t)nt * 64 * 1024 + kt * 64; ldd = 1024;
      } else {
        int u = t - 1536 - 16384, le = u / 128, r = u % 128, kt = r / 16, nt = r % 16;
        src = P.w2 + (size_t)le * 524288 + (size_t)kt * 64 * 1024 + nt * 64; lds_ = 1024;
        dst = P.Wt2 + (size_t)le * 524288 + (size_t)nt * 64 * 512 + kt * 64; ldd = 512;
      }
      transpose_tile(src, lds_, dst, ldd, tile);
    } else if (t < NT + NF) {
      int f = t - NT, l = f / 64, r = f % 64, kt = r / 4, g = r % 4;
      float* cst = tile + 64 * 65; float* snt = cst + 64;
      const float* src = P.w_in + (size_t)l * 1024 * 2304 + (size_t)kt * 64 * 2304 + g * 64;
      { int n = tid & 63, kq = tid >> 6;
        for (int i = 0; i < 16; i++) { int k = i * 4 + kq; tile[k * 65 + n] = src[(size_t)k * 2304 + n]; } }
      if (tid < 64) { float s, c; sincospif((float)tid / 32.f, &s, &c); cst[tid] = c; snt[tid] = s; }
      __syncthreads();
      int k = tid & 63, jq = tid >> 6;
      half_t* o = P.WtIn + (size_t)l * NIN * 1024 + kt * 64 + k;
      for (int jj = 0; jj < 16; jj++) {
        int j = jq * 16 + jj; float ac = 0.f, as = 0.f;
        for (int c = 0; c < 64; c++) { float v = tile[k * 65 + c]; int idx = (c * j) & 63; ac += v * cst[idx]; as += v * snt[idx]; }
        o[(size_t)(g * 64 + j) * 1024] = (half_t)(ac * 0.125f);
        o[(size_t)(256 + g * 64 + j) * 1024] = (half_t)(-as * 0.125f);
      }
      __syncthreads();
    } else if (t < NT + NF + NM) {
      int mi = t - NT - NF, l = mi / 96, col0 = (mi % 96) * 64;
      float* scond = tile; float* red = tile + 9216;
      for (int idx = tid; idx < 9216; idx += 256) {
        int n = idx >> 10, k = idx & 1023; float v = n < 8 ? P.c[n * 1024 + k] : P.c_ctx[k];
        scond[idx] = v / (1.f + expf(-v));
      }
      __syncthreads();
      int col = tid & 63, kq = tid >> 6; float acc[9];
#pragma unroll
      for (int n = 0; n < 9; n++) acc[n] = 0.f;
      const float* w = P.w_mod + ((size_t)l * 1024 + kq * 256) * 6144 + col0 + col;
#pragma unroll 4
      for (int k = 0; k < 256; k++) {
        float wv = w[(size_t)k * 6144];
#pragma unroll
        for (int n = 0; n < 9; n++) acc[n] += scond[n * 1024 + kq * 256 + k] * wv;
      }
#pragma unroll
      for (int n = 0; n < 9; n++) red[(kq * 9 + n) * 64 + col] = acc[n];
      __syncthreads();
      for (int idx = tid; idx < 576; idx += 256) {
        int n = idx / 64, cc = idx % 64;
        float s = red[(0 * 9 + n) * 64 + cc] + red[(1 * 9 + n) * 64 + cc] + red[(2 * 9 + n) * 64 + cc] + red[(3 * 9 + n) * 64 + cc];
        P.mod[(size_t)(l * 9 + n) * 6144 + col0 + cc] = s + P.b_mod[l * 6144 + col0 + cc];
      }
      __syncthreads();
    } else {
      int m = t - NT - NF - NM;
      if (m == 0) {
        for (int idx = tid; idx < 128 * 16; idx += 256) {
          int pos = idx >> 4, i = idx & 15; float f = powf(10000.f, -(float)i / 16.f); float ang = (float)pos * f;
          float s, c; sincosf(ang, &s, &c); P.rope[idx] = make_float2(c, s);
        }
      } else if (m == 1) {
        for (int j = tid; j < 8192; j += 256) { float s, c; sincospif((float)j / 4096.f, &s, &c); P.tw[j] = make_float2(c, s); }
      } else if (m == 2) {
        for (int idx = tid; idx < 16384; idx += 256) {
          int mm = idx >> 7, k = idx & 127, part = mm >> 6, f1 = mm & 63, pp = k >> 6, a = k & 63;
          float s, c; sincospif((float)((a * f1) & 63) / 32.f, &s, &c);
          float v = part == 0 ? (pp == 0 ? c : s) : (pp == 0 ? -s : c);
          P.DA[idx] = (half_t)(v * 0.125f);
        }
      } else if (m == 3) {
        for (int idx = tid; idx < 32768; idx += 256) {
          int mm = idx >> 8, k = idx & 255, part = k >> 7, bb = k & 127;
          float s, c; sincospif((float)((bb * mm) & 127) / 64.f, &s, &c);
          P.DB[idx] = (half_t)((part == 0 ? c : s) * 0.08838834764831845f);
        }
      } else if (m == 4) {
        for (int idx = tid; idx < 131072; idx += 256) {
          int mm = idx >> 9, k = idx & 511, part = k >> 8, tt = k & 255;
          float s, c; sincospif((float)((tt * mm) & 255) / 128.f, &s, &c);
          P.DC[idx] = (half_t)((part == 0 ? c : s) * 0.0625f);
        }
      } else {
        for (int idx = tid; idx < 2 * 48 * 1024; idx += 256) {
          int l = idx / 49152, r = idx % 49152, col = r >> 10, k = r & 1023;
          float w = col < 4 ? P.w_group[((size_t)l * 1024 + k) * 4 + col] : (col < 36 ? P.w_router[((size_t)l * 1024 + k) * 32 + col - 4] : 0.f);
          half_t hi = (half_t)w, lo = (half_t)(w - (float)hi);
          P.WrH[(size_t)(l * 2) * 49152 + r] = hi; P.WrH[(size_t)(l * 2 + 1) * 49152 + r] = lo;
        }
        if (tid < 2) {
          int l = tid; float s1 = 0.f, s2 = 0.f, mq = 0.f, mk = 0.f;
          for (int i = 0; i < 64; i++) {
            s1 += P.lq1[l * 64 + i] * P.lk1[l * 64 + i]; s2 += P.lq2[l * 64 + i] * P.lk2[l * 64 + i];
            mq = fmaxf(mq, fabsf(P.q_norm_g[l * 64 + i])); mk = fmaxf(mk, fabsf(P.k_norm_g[l * 64 + i]));
          }
          float lam_init = 0.8f - 0.6f * expf(-0.3f * (float)l);
          P.consts[l * 4 + 0] = expf(s1) - expf(s2) + lam_init;
          P.consts[l * 4 + 1] = 8.f * mq * mk * 1.4426950408889634f * 1.002f - 15.f;
          P.consts[l * 4 + 2] = lam_init;
        }
        if (tid < 64) P.cnt[tid] = 0;
        if (tid < 64) P.qctr[tid] = 0;
      }
    }
  }
}

DI void row1_phase(const Params& P, int combine_l, int norm_l, int r_begin) {
  const int lane = TIDX & 63, gw = blockIdx.x * 4 + (TIDX >> 6), nw = gridDim.x * 4;
  for (int r = r_begin + gw; r < TA; r += nw) {
    const int n = row_mod(r);
    float v[16];
    if (combine_l < 0) {
      const float* src = r < TC ? P.ctx + (size_t)r * D : P.x + (size_t)(r - TC) * D;
#pragma unroll
      for (int i = 0; i < 4; i++) { float4 t = *(const float4*)(src + i * 256 + lane * 4); v[i*4] = t.x; v[i*4+1] = t.y; v[i*4+2] = t.z; v[i*4+3] = t.w; }
    } else {
      float* xm = r < TC ? P.xcbuf + (size_t)r * D : P.out + (size_t)(r - TC) * D;
      const float* g2 = P.mod + (size_t)(combine_l * 9 + n) * 6144 + 5 * 1024;
      const half_t* y0 = P.yA + (size_t)(2 * r) * D; const half_t* y1 = y0 + D;
#pragma unroll
      for (int i = 0; i < 4; i++) {
        int c = i * 256 + lane * 4;
        float4 t = *(const float4*)(xm + c); float4 g = *(const float4*)(g2 + c);
        h4 a = *(const h4*)(y0 + c); h4 b = *(const h4*)(y1 + c);
        t.x += g.x * ((float)a[0] + (float)b[0]); t.y += g.y * ((float)a[1] + (float)b[1]);
        t.z += g.z * ((float)a[2] + (float)b[2]); t.w += g.w * ((float)a[3] + (float)b[3]);
        *(float4*)(xm + c) = t;
        v[i*4] = t.x; v[i*4+1] = t.y; v[i*4+2] = t.z; v[i*4+3] = t.w;
      }
    }
    if (norm_l >= 0) {
      float ss = 0.f;
#pragma unroll
      for (int i = 0; i < 16; i++) ss += v[i] * v[i];
      ss = wave_sum(ss);
      const float rstd = rsqrtf(ss * (1.f / 1024.f) + EPS);
      const float* g = P.norm1_g + norm_l * 1024;
      const float* sh = P.mod + (size_t)(norm_l * 9 + n) * 6144; const float* sc = sh + 1024;
#pragma unroll
      for (int i = 0; i < 4; i++) {
        int c = i * 256 + lane * 4;
        float4 gg = *(const float4*)(g + c), s1 = *(const float4*)(sc + c), s0 = *(const float4*)(sh + c);
        h4 o;
        o[0] = (half_t)(v[i*4] * rstd * gg.x * (1.f + s1.x) + s0.x); o[1] = (half_t)(v[i*4+1] * rstd * gg.y * (1.f + s1.y) + s0.y);
        o[2] = (half_t)(v[i*4+2] * rstd * gg.z * (1.f + s1.z) + s0.z); o[3] = (half_t)(v[i*4+3] * rstd * gg.w * (1.f + s1.w) + s0.w);
        *(h4*)(P.hx + (size_t)r * D + c) = o;
      }
    }
  }
}

DI void row2_phase(const Params& P, int l, int r_begin, char* smem) {
  const int tid = TIDX, lane = tid & 63, wave = tid >> 6, fr = lane & 15, fq = lane >> 4;
  float* lg = (float*)smem + wave * 16 * 48;
  const half_t* Whi = P.WrH + (size_t)(l * 2) * 49152; const half_t* Wlo = Whi + 49152;
  const int ngroups = (TA - r_begin) >> 4, gw = blockIdx.x * 4 + wave, nw = gridDim.x * 4;
  const float* gam = P.norm2_g + l * 1024;
#pragma unroll 1
  for (int grp = gw; grp < ngroups; grp += nw) {
    const int r0 = r_begin + grp * 16, row = r0 + fr, n = row_mod(r0);
    const float* xm = (row < TC ? P.xcbuf + (size_t)row * D : P.out + (size_t)(row - TC) * D) + fq * 8;
    float ss = 0.f;
#pragma unroll 8
    for (int kk = 0; kk < 32; kk++) {
      float4 a = *(const float4*)(xm + kk * 32), b = *(const float4*)(xm + kk * 32 + 4);
      ss += a.x * a.x + a.y * a.y + a.z * a.z + a.w * a.w + b.x * b.x + b.y * b.y + b.z * b.z + b.w * b.w;
    }
    ss += shx(ss, 16); ss += shx(ss, 32);
    const float rstd = rsqrtf(ss * (1.f / 1024.f) + EPS);
    const float* sh = P.mod + (size_t)(l * 9 + n) * 6144 + 3 * 1024 + fq * 8; const float* sc = sh + 1024;
    f4 acc[3];
#pragma unroll
    for (int i = 0; i < 3; i++) acc[i] = (f4){0.f, 0.f, 0.f, 0.f};
    half_t* hxo = P.hx + (size_t)row * D + fq * 8;
#pragma unroll 2
    for (int kk = 0; kk < 32; kk++) {
      const int k0 = kk * 32;
      float x[8], g[8], s1[8], s0[8];
      *(float4*)&x[0] = *(const float4*)(xm + k0); *(float4*)&x[4] = *(const float4*)(xm + k0 + 4);
      *(float4*)&g[0] = *(const float4*)(gam + fq * 8 + k0); *(float4*)&g[4] = *(const float4*)(gam + fq * 8 + k0 + 4);
      *(float4*)&s1[0] = *(const float4*)(sc + k0); *(float4*)&s1[4] = *(const float4*)(sc + k0 + 4);
      *(float4*)&s0[0] = *(const float4*)(sh + k0); *(float4*)&s0[4] = *(const float4*)(sh + k0 + 4);
      h8 hi, lo;
#pragma unroll
      for (int i = 0; i < 8; i++) {
        float v = x[i] * rstd * g[i] * (1.f + s1[i]) + s0[i];
        hi[i] = (half_t)v; lo[i] = (half_t)(v - (float)hi[i]);
      }
      *(h8*)(hxo + k0) = hi;
#pragma unroll
      for (int n3 = 0; n3 < 3; n3++) {
        h8 bh = *(const h8*)(Whi + (size_t)(n3 * 16 + fr) * 1024 + k0 + fq * 8);
        h8 bl = *(const h8*)(Wlo + (size_t)(n3 * 16 + fr) * 1024 + k0 + fq * 8);
        acc[n3] = mfma16(hi, bh, acc[n3]); acc[n3] = mfma16(lo, bh, acc[n3]); acc[n3] = mfma16(hi, bl, acc[n3]);
      }
    }
    __builtin_amdgcn_wave_barrier();
#pragma unroll
    for (int n3 = 0; n3 < 3; n3++)
#pragma unroll
      for (int j = 0; j < 4; j++) lg[(fq * 4 + j) * 48 + n3 * 16 + fr] = acc[n3][j];
    __builtin_amdgcn_wave_barrier();
    if (lane < 16) {
      const int r = r0 + lane;
      const float* L = lg + lane * 48;
      float gl[4]; int gi = 0;
#pragma unroll
      for (int j = 0; j < 4; j++) gl[j] = L[j] + P.b_group[l * 4 + j];
      float gm = gl[0];
#pragma unroll
      for (int j = 1; j < 4; j++) if (gl[j] > gm) { gm = gl[j]; gi = j; }
      float gs = 0.f;
#pragma unroll
      for (int j = 0; j < 4; j++) gs += expf(gl[j] - gm);
      const float pg = 1.f / gs;
      float el[8];
#pragma unroll
      for (int j = 0; j < 8; j++) el[j] = L[4 + gi * 8 + j] + P.b_router[l * 32 + gi * 8 + j];
      int i0 = 0; float v0 = el[0];
#pragma unroll
      for (int j = 1; j < 8; j++) if (el[j] > v0) { v0 = el[j]; i0 = j; }
      int i1 = -1; float v1 = -3.0e38f;
#pragma unroll
      for (int j = 0; j < 8; j++) if (j != i0 && el[j] > v1) { v1 = el[j]; i1 = j; }
      const float ex = expf(v1 - v0);
      const float w0 = pg / (1.f + ex), w1 = pg * ex / (1.f + ex);
      const int e0 = gi * 8 + i0, e1 = gi * 8 + i1;
      int p0 = atomicAdd(&P.cnt[l * 32 + e0], 1); P.list[(size_t)e0 * LCAP + p0] = 2 * r;
      int p1 = atomicAdd(&P.cnt[l * 32 + e1], 1); P.list[(size_t)e1 * LCAP + p1] = 2 * r + 1;
      P.tokW[2 * r] = w0; P.tokW[2 * r + 1] = w1;
    }
    __builtin_amdgcn_wave_barrier();
  }
}

DI h8 lds128(unsigned a) { h8 r; asm volatile("ds_read_b128 %0, %1" : "=v"(r) : "v"(a)); return r; }
DI void tie(h8& x) { asm volatile("" : "+v"(x)); }
DI unsigned lds_addr(const void* p) { return (unsigned)(size_t)p; }
#define WAIT_LGKM(n) asm volatile("s_waitcnt lgkmcnt(" #n ")" ::: "memory")
DI void raw_barrier() { asm volatile("" ::: "memory"); __builtin_amdgcn_s_barrier(); asm volatile("" ::: "memory"); }
DI void slot_rc(int i, int& row, int& coff) { int s = i * 256 + TIDX; row = s >> 3; coff = ((s & 7) ^ ((row >> 1) & 7)) * 8; }

template <class AF, class BF>
DI void gemm256(AF aptr, BF bptr, int nk, char* smem, f4 (&acc)[8][4]) {
  const int tid = TIDX, lane = tid & 63, wave = tid >> 6, fr = lane & 15, fq = lane >> 4, wr = wave >> 1, wc = wave & 1;
#pragma unroll
  for (int m = 0; m < 8; m++)
#pragma unroll
    for (int n = 0; n < 4; n++) acc[m][n] = (f4){0.f, 0.f, 0.f, 0.f};
  auto issue = [&](int kt, int st) {
    char* d = smem + st * 49152 + tid * 16;
#pragma unroll
    for (int i = 0; i < 8; i++) glds16(aptr(i) + kt * 64, d + i * 4096);
#pragma unroll
    for (int i = 0; i < 4; i++) glds16(bptr(i) + kt * 64, d + 32768 + i * 4096);
  };
  const unsigned sw = (unsigned)((fq ^ (fr >> 1)) << 4);
  const unsigned offA = (wr * 128 + fr) * 128 + sw, offB = 32768 + (wc * 64 + fr) * 128 + sw;
  const unsigned sbase = lds_addr(smem);
  issue(0, 0);
  if (nk > 1) issue(1, 1);
  int st = 0;
#pragma unroll 1
  for (int kt = 0; kt < nk; kt++) {
    if (kt + 1 < nk) asm volatile("s_waitcnt vmcnt(12)" ::: "memory"); else wait_vm0();
    raw_barrier();
    if (kt + 2 < nk) issue(kt + 2, st == 0 ? 2 : st - 1);
    const unsigned base = sbase + st * 49152;
    st = st == 2 ? 0 : st + 1;
    h8 a0[8], b0[4], a1[8], b1[4];
#pragma unroll
    for (int m = 0; m < 8; m++) a0[m] = lds128(base + offA + m * 2048);
#pragma unroll
    for (int n = 0; n < 4; n++) b0[n] = lds128(base + offB + n * 2048);
#pragma unroll
    for (int m = 0; m < 8; m++) a1[m] = lds128(base + (offA ^ 64) + m * 2048);
#pragma unroll
    for (int n = 0; n < 4; n++) b1[n] = lds128(base + (offB ^ 64) + n * 2048);
    WAIT_LGKM(12);
#pragma unroll
    for (int m = 0; m < 8; m++) tie(a0[m]);
#pragma unroll
    for (int n = 0; n < 4; n++) tie(b0[n]);
#pragma unroll
    for (int m = 0; m < 8; m++)
#pragma unroll
      for (int n = 0; n < 4; n++) acc[m][n] = mfma16(a0[m], b0[n], acc[m][n]);
    WAIT_LGKM(0);
#pragma unroll
    for (int m = 0; m < 8; m++) tie(a1[m]);
#pragma unroll
    for (int n = 0; n < 4; n++) tie(b1[n]);
#pragma unroll
    for (int m = 0; m < 8; m++)
#pragma unroll
      for (int n = 0; n < 4; n++) acc[m][n] = mfma16(a1[m], b1[n], acc[m][n]);
  }
  raw_barrier();
}
DI bool xcd_tile(int it, int MT, int NT, int& mt, int& nt) {
  const int x = blockIdx.x & 7, j = blockIdx.x >> 3;
  const int nsn = NT >> 2, nsm = (MT + 7) >> 3;
  const int s = x + 8 * it;
  if (s >= nsm * nsn) return false;
  const int sm = s / nsn, sn = s % nsn;
  mt = sm * 8 + (j >> 2); nt = sn * 4 + (j & 3);
  return true;
}
DI int slot_col() { int t = TIDX; return ((t & 7) ^ ((t >> 4) & 7)) * 8; }

DI void gemm_in_phase(const Params& P, int l, char* smem) {
  const int tid = TIDX, lane = tid & 63, wave = tid >> 6, fr = lane & 15, fq = lane >> 4, wr = wave >> 1, wc = wave & 1;
  const half_t* Wt = P.WtIn + (size_t)l * NIN * 1024;
  const int sc = slot_col(), srow = tid >> 3;
#pragma unroll 1
  for (int it = 0;; it++) {
    int mt, nt;
    if (!xcd_tile(it, 264, 20, mt, nt)) break;
    if (mt >= 264) continue;
    asm volatile("" : "+s"(mt), "+s"(nt));
    f4 acc[8][4];
    {
      const half_t* a0 = P.hx + (size_t)(mt * 256 + srow) * D + sc; const half_t* b0 = Wt + (size_t)(nt * 128 + srow) * D + sc;
      gemm256([&](int i) { return a0 + (size_t)i * 32 * D; }, [&](int i) { return b0 + (size_t)i * 32 * D; }, 16, smem, acc);
    }
    const int r0 = mt * 256 + wr * 128;
    const bool isctx = r0 < TC;
    int b, pos0;
    if (isctx) { b = r0 >> 8; pos0 = r0 & 255; } else { b = (r0 - TC) >> 13; pos0 = 256 + ((r0 - TC) & 8191); }
    if (nt < 4 || nt >= 16) {
      half_t* dst; int ld, c0; bool gel = false;
      if (nt < 4) { dst = P.QF; ld = 512; c0 = nt * 128; }
      else if (nt < 18) { dst = P.gy; ld = 256; c0 = (nt - 16) * 128; gel = true; }
      else { dst = P.rr; ld = 256; c0 = (nt - 18) * 128; }
#pragma unroll
      for (int m = 0; m < 8; m++) {
        int rb = r0 + m * 16 + fq * 4;
        asm volatile("" : "+v"(rb) :: "memory");
#pragma unroll
        for (int n = 0; n < 4; n++)
#pragma unroll
          for (int j = 0; j < 4; j++) {
            float v = acc[m][n][j]; if (gel) v = gelu_tanh(v);
            dst[(size_t)(rb + j) * ld + c0 + wc * 64 + n * 16 + fr] = (half_t)v;
          }
      }
    } else if (nt < 12) {
      const bool isq = nt < 8; const int head = isq ? nt - 4 : nt - 8;
      const float* gvec = (isq ? P.q_norm_g : P.k_norm_g) + l * 64;
      float gg[4];
#pragma unroll
      for (int n = 0; n < 4; n++) gg[n] = gvec[n * 16 + fr];
      const float qs = isq ? 0.125f * 1.4426950408889634f : 1.f;
#pragma unroll
      for (int m = 0; m < 8; m++)
#pragma unroll
        for (int j = 0; j < 4; j++) {
          asm volatile("" ::: "memory");
          float ss = 0.f;
#pragma unroll
          for (int n = 0; n < 4; n++) ss += acc[m][n][j] * acc[m][n][j];
          ss += shx(ss, 1); ss += shx(ss, 2); ss += shx(ss, 4); ss += shx(ss, 8);
          const float rstd = rsqrtf(ss * (1.f / 64.f) + EPS);
          float o[4];
#pragma unroll
          for (int n = 0; n < 4; n++) o[n] = acc[m][n][j] * rstd * gg[n];
          int rl = m * 16 + fq * 4 + j;
          asm volatile("" : "+v"(rl));
          if (!isctx) {
            const int tpos = pos0 - 256 + rl;
            float2 cr = P.rope[(tpos >> 6) * 16 + fr], cc = P.rope[(tpos & 63) * 16 + fr];
            float a0 = o[0] * cr.x - o[1] * cr.y, a1 = o[1] * cr.x + o[0] * cr.y;
            float a2 = o[2] * cc.x - o[3] * cc.y, a3 = o[3] * cc.x + o[2] * cc.y;
            o[0] = a0; o[1] = a1; o[2] = a2; o[3] = a3;
          }
          half_t* dst = isq ? P.q + (size_t)(r0 + rl) * 512 : P.kall + ((size_t)b * KV + pos0 + rl) * 512;
#pragma unroll
          for (int n = 0; n < 4; n++) dst[head * 128 + wc * 64 + n * 16 + fr] = (half_t)(o[n] * qs);
        }
    } else {
      const int head = nt - 12;
#pragma unroll
      for (int m = 0; m < 8; m++)
#pragma unroll
        for (int n = 0; n < 4; n++) {
          h4 o; o[0] = (half_t)acc[m][n][0]; o[1] = (half_t)acc[m][n][1]; o[2] = (half_t)acc[m][n][2]; o[3] = (half_t)acc[m][n][3];
          int d = wc * 64 + n * 16 + fr;
          asm volatile("" : "+v"(d) :: "memory");
          *(h4*)(P.vT + ((size_t)(b * 4 + head) * 128 + d) * KV + pos0 + m * 16 + fq * 4) = o;
        }
    }
  }
}

DI void gemm_out_phase(const Params& P, int l, char* smem) {
  const int tid = TIDX, lane = tid & 63, wave = tid >> 6, fr = lane & 15, fq = lane >> 4, wr = wave >> 1, wc = wave & 1;
  const half_t* Wt = P.WtOut + (size_t)l * 1048576;
  const int mt0 = l == 0 ? 0 : TC / 256;
  const int sc = slot_col(), srow = tid >> 3;
#pragma unroll 1
  for (int it = 0;; it++) {
    int mt, nt;
    if (!xcd_tile(it, 264 - mt0, 8, mt, nt)) break;
    mt += mt0;
    if (mt >= 264) continue;
    asm volatile("" : "+s"(mt), "+s"(nt));
    f4 acc[8][4];
    {
      const half_t* a0 = P.mix + (size_t)(mt * 256 + srow) * D + sc; const half_t* b0 = Wt + (size_t)(nt * 128 + srow) * D + sc;
      gemm256([&](int i) { return a0 + (size_t)i * 32 * D; }, [&](int i) { return b0 + (size_t)i * 32 * D; }, 16, smem, acc);
    }
    const int r0 = mt * 256 + wr * 128;
    const int n = row_mod(r0);
    const float* g1 = P.mod + (size_t)(l * 9 + n) * 6144 + 2 * 1024;
    const float* res; float* dst;
    if (r0 < TC) { res = P.ctx + (size_t)r0 * D; dst = P.xcbuf + (size_t)r0 * D; }
    else { dst = P.out + (size_t)(r0 - TC) * D; res = l == 0 ? P.x + (size_t)(r0 - TC) * D : dst; }
#pragma unroll
    for (int m = 0; m < 8; m++) {
      int rb = m * 16 + fq * 4;
      asm volatile("" : "+v"(rb) :: "memory");
#pragma unroll
      for (int nn = 0; nn < 4; nn++) {
        const int c = nt * 128 + wc * 64 + nn * 16 + fr; const float g = g1[c];
#pragma unroll
        for (int j = 0; j < 4; j++) { size_t o = (size_t)(rb + j) * D + c; dst[o] = res[o] + g * acc[m][nn][j]; }
      }
    }
  }
}

DI void moe_prefix(const Params& P, int l, int* tb) {
  __syncthreads();
  if (TIDX == 0) { int s = 0; for (int e = 0; e < 32; e++) { tb[e] = s; s += (P.cnt[l * 32 + e] + 255) >> 8; } tb[32] = s; }
  __syncthreads();
}
DI void moe_e1_phase(const Params& P, int l, char* smem, int* tb) {
  const int tid = TIDX, lane = tid & 63, wave = tid >> 6, fr = lane & 15, fq = lane >> 4, wr = wave >> 1, wc = wave & 1;
  moe_prefix(P, l, tb);
  const int sc = slot_col(), srow = tid >> 3;
#pragma unroll 1
  for (int it = 0;; it++) {
    int rt, nt;
    if (!xcd_tile(it, tb[32], 8, rt, nt)) break;
    if (rt >= tb[32]) continue;
    asm volatile("" : "+s"(rt), "+s"(nt));
    int e = 0;
    while (tb[e + 1] <= rt) e++;
    const int rl = rt - tb[e], cnt = P.cnt[l * 32 + e];
    const int* lst = P.list + (size_t)e * LCAP;
    const half_t* w1 = P.Wt1 + ((size_t)(l * 32 + e) * 512 + nt * 64) * 1024 + sc;
    const half_t* w3 = P.Wt3 + ((size_t)(l * 32 + e) * 512 + nt * 64) * 1024 + sc;
    int tok[8];
#pragma unroll
    for (int i = 0; i < 8; i++) tok[i] = lst[min(rl * 256 + i * 32 + srow, cnt - 1)] >> 1;
    f4 acc[8][4];
    gemm256([&](int i) { return P.hx + (size_t)tok[i] * D + sc; },
            [&](int i) { return ((i & 1) ? w3 : w1) + (size_t)((i >> 1) * 32 + srow) * 1024; },
            16, smem, acc);
    half_t* Hd = P.H + ((size_t)rt * 256 + wr * 128) * 512 + nt * 64 + wc * 32;
#pragma unroll
    for (int m = 0; m < 8; m++) {
      int rb = m * 16 + fq * 4;
      asm volatile("" : "+v"(rb) :: "memory");
#pragma unroll
      for (int n = 0; n < 2; n++)
#pragma unroll
        for (int j = 0; j < 4; j++) {
          float a1 = acc[m][n][j], a3 = acc[m][n + 2][j];
          Hd[(size_t)(rb + j) * 512 + n * 16 + fr] = (half_t)(a1 * sigmoidf_(a1) * a3);
        }
    }
  }
}
DI void moe_e2_phase(const Params& P, int l, char* smem, int* tb) {
  const int tid = TIDX, lane = tid & 63, wave = tid >> 6, fr = lane & 15, fq = lane >> 4, wr = wave >> 1, wc = wave & 1;
  moe_prefix(P, l, tb);
  const int sc = slot_col(), srow = tid >> 3;
#pragma unroll 1
  for (int it = 0;; it++) {
    int rt, nt;
    if (!xcd_tile(it, tb[32], 8, rt, nt)) break;
    if (rt >= tb[32]) continue;
    asm volatile("" : "+s"(rt), "+s"(nt));
    int e = 0;
    while (tb[e + 1] <= rt) e++;
    const int rl = rt - tb[e], cnt = P.cnt[l * 32 + e];
    const int* lst = P.list + (size_t)e * LCAP;
    f4 acc[8][4];
    {
      const half_t* a0 = P.H + ((size_t)rt * 256 + srow) * 512 + sc;
      const half_t* b0 = P.Wt2 + ((size_t)(l * 32 + e) * 1024 + nt * 128 + srow) * 512 + sc;
      gemm256([&](int i) { return a0 + (size_t)i * 32 * 512; }, [&](int i) { return b0 + (size_t)i * 32 * 512; }, 8, smem, acc);
    }
#pragma unroll
    for (int m = 0; m < 8; m++)
#pragma unroll
      for (int j = 0; j < 4; j++) {
        int idx = rl * 256 + wr * 128 + m * 16 + fq * 4 + j;
        asm volatile("" : "+v"(idx) :: "memory");
        if (idx < cnt) {
          const int a = lst[idx]; const float w = P.tokW[a];
          half_t* dst = P.yA + (size_t)a * D + nt * 128 + wc * 64 + fr;
#pragma unroll
          for (int n = 0; n < 4; n++) dst[n * 16] = (half_t)(w * acc[m][n][j]);
        }
      }
  }
}

DI int swap23(int x) { return (x & ~12) | ((x & 4) << 1) | ((x & 8) >> 1); }
DI void attn_item(const Params& P, int l, int b, int head, int row0, int nkeys, char* smem) {
  const int tid = TIDX, lane = tid & 63, wave = tid >> 6, ql = lane & 31, hh = lane >> 5;
  const float lam = P.consts[l * 4 + 0], negc = -P.consts[l * 4 + 1], lam_init = P.consts[l * 4 + 2];
  const int myrow = row0 + wave * 32 + ql;
  h8 qf[2][4];
  {
    const half_t* qp = P.q + (size_t)myrow * 512 + head * 128 + hh * 8;
#pragma unroll
    for (int m = 0; m < 2; m++)
#pragma unroll
      for (int s = 0; s < 4; s++) { qf[m][s] = *(const h8*)(qp + m * 64 + s * 16); }
#pragma unroll
    for (int m = 0; m < 2; m++)
#pragma unroll
      for (int s = 0; s < 4; s++) tie(qf[m][s]);
  }
  f16v o0[4], o1[4];
#pragma unroll
  for (int dt = 0; dt < 4; dt++)
#pragma unroll
    for (int i = 0; i < 16; i++) { o0[dt][i] = 0.f; o1[dt][i] = 0.f; }
  float ls0 = 0.f, ls1 = 0.f;
  const half_t* kp[4]; const half_t* vp[4];
  {
    const half_t* kbase = P.kall + (size_t)b * KV * 512 + head * 128;
    const half_t* vbase = P.vT + (size_t)(b * 4 + head) * 128 * KV;
#pragma unroll
    for (int i = 0; i < 4; i++) {
      int s = i * 256 + tid;
      int row = s >> 4, c = (s & 15) ^ (row & 15); kp[i] = kbase + (size_t)row * 512 + c * 8;
      int vr = s >> 3, vc = (s & 7) ^ ((vr >> 1) & 7); vp[i] = vbase + (size_t)vr * KV + vc * 8;
    }
  }
  const int ntile = nkeys >> 6;
  const unsigned sbase = lds_addr(smem);
  auto issue = [&](int t) {
    char* d = smem + (t % 3) * 32768 + tid * 16;
#pragma unroll
    for (int i = 0; i < 4; i++) { glds16(kp[i] + (size_t)t * 64 * 512, d + i * 4096); glds16(vp[i] + t * 64, d + 16384 + i * 4096); }
  };
  unsigned koff[2];
  const int kr_lo = swap23(ql), ksw = kr_lo & 15;
  koff[0] = kr_lo * 256; koff[1] = (32 + kr_lo) * 256;
  unsigned voff[4];
#pragma unroll
  for (int dt = 0; dt < 4; dt++) { int vrow = dt * 32 + ql; voff[dt] = 16384 + vrow * 128; }
  const int vsw = (ql >> 1) & 7;
  h8 pp0[2], pp1[2];
  unsigned pendV = 0; int pendkt = 0; bool pend = false;
  issue(0);
#pragma unroll 1
  for (int t = 0; t < ntile; t++) {
    wait_vm0();
    raw_barrier();
    if (t + 1 < ntile) issue(t + 1);
    const unsigned cur = sbase + (t % 3) * 32768;
#pragma unroll 1
    for (int kt = 0; kt < 2; kt++) {
      h8 kf[8];
#pragma unroll
      for (int st = 0; st < 4; st++) {
        kf[st] = lds128(cur + koff[kt] + (((st * 2 + hh) ^ ksw) << 4));
        kf[4 + st] = lds128(cur + koff[kt] + (((8 + st * 2 + hh) ^ ksw) << 4));
      }
      h8 vf[8];
      if (pend) {
#pragma unroll
        for (int sp = 0; sp < 2; sp++)
#pragma unroll
          for (int dt = 0; dt < 4; dt++) vf[sp * 4 + dt] = lds128(pendV + voff[dt] + (((pendkt * 4 + sp * 2 + hh) ^ vsw) << 4));
      }
      if (pend) WAIT_LGKM(8); else WAIT_LGKM(0);
#pragma unroll
      for (int i = 0; i < 8; i++) tie(kf[i]);
      f16v s0, s1;
#pragma unroll
      for (int i = 0; i < 16; i++) { s0[i] = negc; s1[i] = negc; }
#pragma unroll
      for (int st = 0; st < 4; st++) { s0 = mfma32(kf[st], qf[0][st], s0); s1 = mfma32(kf[4 + st], qf[1][st], s1); }
      if (pend) {
        WAIT_LGKM(0);
#pragma unroll
        for (int i = 0; i < 8; i++) tie(vf[i]);
#pragma unroll
        for (int sp = 0; sp < 2; sp++)
#pragma unroll
          for (int dt = 0; dt < 4; dt++) { o0[dt] = mfma32(vf[sp * 4 + dt], pp0[sp], o0[dt]); o1[dt] = mfma32(vf[sp * 4 + dt], pp1[sp], o1[dt]); }
      }
#pragma unroll
      for (int i = 0; i < 16; i++) { s0[i] = __builtin_amdgcn_exp2f(s0[i]); ls0 += s0[i]; s1[i] = __builtin_amdgcn_exp2f(s1[i]); ls1 += s1[i]; }
#pragma unroll
      for (int sp = 0; sp < 2; sp++) {
        u4 a, c;
        a[0] = pk2(s0[8*sp+0], s0[8*sp+1]); a[1] = pk2(s0[8*sp+2], s0[8*sp+3]); a[2] = pk2(s0[8*sp+4], s0[8*sp+5]); a[3] = pk2(s0[8*sp+6], s0[8*sp+7]);
        c[0] = pk2(s1[8*sp+0], s1[8*sp+1]); c[1] = pk2(s1[8*sp+2], s1[8*sp+3]); c[2] = pk2(s1[8*sp+4], s1[8*sp+5]); c[3] = pk2(s1[8*sp+6], s1[8*sp+7]);
        pp0[sp] = __builtin_bit_cast(h8, a); pp1[sp] = __builtin_bit_cast(h8, c);
      }
      pend = true; pendV = cur; pendkt = kt;
    }
  }
  {
    h8 vf[8];
#pragma unroll
    for (int sp = 0; sp < 2; sp++)
#pragma unroll
      for (int dt = 0; dt < 4; dt++) vf[sp * 4 + dt] = lds128(pendV + voff[dt] + (((pendkt * 4 + sp * 2 + hh) ^ vsw) << 4));
    WAIT_LGKM(0);
#pragma unroll
    for (int i = 0; i < 8; i++) tie(vf[i]);
#pragma unroll
    for (int sp = 0; sp < 2; sp++)
#pragma unroll
      for (int dt = 0; dt < 4; dt++) { o0[dt] = mfma32(vf[sp * 4 + dt], pp0[sp], o0[dt]); o1[dt] = mfma32(vf[sp * 4 + dt], pp1[sp], o1[dt]); }
  }
  raw_barrier();
  ls0 += shx(ls0, 32); ls1 += shx(ls1, 32);
  const float i0 = 1.f / ls0, i1 = lam / ls1;
  float ss = 0.f;
#pragma unroll
  for (int dt = 0; dt < 4; dt++)
#pragma unroll
    for (int i = 0; i < 16; i++) { float v = o0[dt][i] * i0 - o1[dt][i] * i1; o0[dt][i] = v; ss += v * v; }
  ss += shx(ss, 32);
  const float mult = rsqrtf(ss * (1.f / 128.f) + EPS) * (1.f - lam_init);
  const float* sg = P.subln_g + l * 128;
  half_t* dst = P.mix + (size_t)myrow * D + 256 + head * 128;
#pragma unroll
  for (int dt = 0; dt < 4; dt++)
#pragma unroll
    for (int g = 0; g < 4; g++) {
      const int d0 = dt * 32 + 8 * g + 4 * hh;
      float4 gv = *(const float4*)(sg + d0);
      h4 o; o[0] = (half_t)(o0[dt][4*g] * mult * gv.x); o[1] = (half_t)(o0[dt][4*g+1] * mult * gv.y);
      o[2] = (half_t)(o0[dt][4*g+2] * mult * gv.z); o[3] = (half_t)(o0[dt][4*g+3] * mult * gv.w);
      *(h4*)(dst + d0) = o;
    }
}

DI int swz128(int row, int colh) { return row * 128 + ((((colh >> 3)) ^ ((row >> 1) & 7)) << 4) + (colh & 7) * 2; }
DI void lru_load_w(const Params& P, int l, int g, char* Wt) {
  const int tid = TIDX;
  for (int dg = 0; dg < 4; dg++) {
    const int dir = dg >> 1;
    const float* w = ((dg & 1) ? P.gate_x_w : P.gate_a_w) + ((size_t)((l * 2 + dir) * 4 + g)) * 4096;
    for (int idx = tid; idx < 4096; idx += 256) { int i = idx >> 6, o = idx & 63; *(half_t*)(Wt + dg * 8192 + swz128(o, i)) = (half_t)w[idx]; }
  }
}
DI void lru_tile(const Params& P, int l, int b, int tile, int g, char* smem, bool final) {
  const int tid = TIDX, lane = tid & 63, wave = tid >> 6, fr = lane & 15, fq = lane >> 4;
  char* Wt = smem;
  char* xr16 = smem + 32768;
  float2* ab = (float2*)(smem + 40960);
  half_t* raw = (half_t*)(smem + 40960);
  float2* subst = (float2*)(smem + 73728);
  const int ch = tid & 63, tq = tid >> 6, gc = g * 64 + ch;
  const int T = tile < 4 ? CL : SEQ;
  const int t0 = tile < 4 ? tile * 64 : (tile - 4) * 64;
  const int rowbase = tile < 4 ? b * CL : TC + b * SEQ;
  __syncthreads();
  for (int idx = tid; idx < 67 * 8; idx += 256) {
    int row = idx >> 3, c = idx & 7, tt = t0 - 1 + row;
    h8 v = {0, 0, 0, 0, 0, 0, 0, 0};
    if (tt >= 0 && tt < T) v = *(const h8*)(P.rr + (size_t)(rowbase + tt) * 256 + g * 64 + c * 8);
    *(h8*)(raw + row * 64 + c * 8) = v;
  }
  float gyv[16];
  if (final) {
#pragma unroll
    for (int e = 0; e < 16; e++) gyv[e] = (float)P.gy[(size_t)(rowbase + t0 + tq * 16 + e) * 256 + gc];
  }
  const float cw0 = P.conv_w[(l * 4 + 0) * 256 + gc], cw1 = P.conv_w[(l * 4 + 1) * 256 + gc], cw2 = P.conv_w[(l * 4 + 2) * 256 + gc],
              cw3 = P.conv_w[(l * 4 + 3) * 256 + gc], cb = P.conv_b[l * 256 + gc];
  __syncthreads();
  {
    float v[19];
#pragma unroll
    for (int e = 0; e < 19; e++) v[e] = (float)raw[(tq * 16 + e) * 64 + ch];
    __syncthreads();
#pragma unroll
    for (int e = 0; e < 16; e++) {
      float xv = cb + cw0 * v[e] + cw1 * v[e + 1] + cw2 * v[e + 2] + cw3 * v[e + 3];
      *(half_t*)(xr16 + swz128(tq * 16 + e, ch)) = (half_t)xv;
    }
  }
  __syncthreads();
  float hsum[16];
#pragma unroll
  for (int e = 0; e < 16; e++) hsum[e] = 0.f;
#pragma unroll 1
  for (int dir = 0; dir < 2; dir++) {
    {
      f4 acc[2][4];
#pragma unroll
      for (int gt = 0; gt < 2; gt++)
#pragma unroll
        for (int n = 0; n < 4; n++) acc[gt][n] = (f4){0.f, 0.f, 0.f, 0.f};
#pragma unroll
      for (int kk = 0; kk < 2; kk++) {
        int row = wave * 16 + fr;
        h8 af = *(const h8*)(xr16 + row * 128 + (((kk * 4 + fq) ^ ((row >> 1) & 7)) << 4));
#pragma unroll
        for (int gt = 0; gt < 2; gt++)
#pragma unroll
          for (int n = 0; n < 4; n++) {
            int orow = n * 16 + fr;
            h8 bf = *(const h8*)(Wt + (dir * 2 + gt) * 8192 + orow * 128 + (((kk * 4 + fq) ^ ((orow >> 1) & 7)) << 4));
            acc[gt][n] = mfma16(af, bf, acc[gt][n]);
          }
      }
#pragma unroll
      for (int n = 0; n < 4; n++) {
        const int cc = (l * 2 + dir) * 256 + g * 64 + n * 16 + fr;
        const float ba = P.gate_a_b[cc], bx = P.gate_x_b[cc];
        const float sp8 = -8.f * log1pf(__expf(-P.lru_lambda[cc]));
#pragma unroll
        for (int j = 0; j < 4; j++) {
          int tl = wave * 16 + fq * 4 + j, c2 = n * 16 + fr;
          float xv = (float)*(const half_t*)(xr16 + swz128(tl, c2));
          float rg = sigmoidf_(acc[0][n][j] + ba), ig = sigmoidf_(acc[1][n][j] + bx);
          float log_a = rg * sp8;
          float a = __expf(log_a);
          float x2 = 2.f * log_a;
          float om = -x2 * (1.f + x2 * (0.5f + x2 * (0.16666667f + x2 * (0.041666668f + x2 * (0.008333334f + x2 * 0.0013888889f)))));
          om = x2 < -0.4f ? 1.f - a * a : om;
          ab[tl * 64 + c2] = make_float2(a, sqrtf(om) * (ig * xv));
        }
      }
    }
    __syncthreads();
    float2 av[16];
    {
      float A = 1.f, h = 0.f;
#pragma unroll
      for (int e = 0; e < 16; e++) {
        int ee = dir == 0 ? e : 15 - e;
        av[e] = ab[(tq * 16 + ee) * 64 + ch];
        h = av[e].x * h + av[e].y; A *= av[e].x;
      }
      subst[tq * 64 + ch] = make_float2(A, h);
    }
    __syncthreads();
    const size_t sidx = ((size_t)((b * 2 + dir) * 132 + tile)) * 256 + gc;
    if (!final) {
      if (tq == 0) {
        float A = 1.f, h = 0.f;
#pragma unroll
        for (int s = 0; s < 4; s++) { float2 ss = subst[(dir == 0 ? s : 3 - s) * 64 + ch]; h = ss.x * h + ss.y; A *= ss.x; }
        P.lsum[sidx] = make_float2(A, h);
      }
    } else {
      float h = P.lcar[sidx];
      if (dir == 0) { for (int s = 0; s < tq; s++) { float2 ss = subst[s * 64 + ch]; h = ss.x * h + ss.y; } }
      else { for (int s = 3; s > tq; s--) { float2 ss = subst[s * 64 + ch]; h = ss.x * h + ss.y; } }
#pragma unroll
      for (int e = 0; e < 16; e++) {
        int ee = dir == 0 ? e : 15 - e;
        h = av[e].x * h + av[e].y;
#pragma unroll
        for (int q = 0; q < 16; q++) hsum[q] += (q == ee) ? h : 0.f;
      }
    }
    __syncthreads();
  }
  if (final) {
#pragma unroll
    for (int e = 0; e < 16; e++)
      P.mix[(size_t)(rowbase + t0 + tq * 16 + e) * D + 768 + gc] = (half_t)(gyv[e] * hsum[e]);
  }
}
DI void lru_carry_item(const Params& P, int it) {
  const int ch = TIDX, dir = it & 1;
  const size_t base = (size_t)it * 132 * 256 + ch;
  float c = 0.f;
#pragma unroll 4
  for (int k = 0; k < 132; k++) {
    int tile = dir == 0 ? k : (k < 4 ? 3 - k : 135 - k);
    float2 s = P.lsum[base + (size_t)tile * 256];
    P.lcar[base + (size_t)tile * 256] = c;
    c = s.x * c + s.y;
  }
}

DI void fft_load(const half_t* src, size_t rs, int nrows, char* Bt, int rowbytes, int k0) {
  for (int idx = TIDX; idx < nrows * 16; idx += 256) {
    int kr = idx >> 4, cc = idx & 15, k = k0 + kr;
    h8 v = *(const h8*)(src + (size_t)kr * rs + cc * 8);
#pragma unroll
    for (int u = 0; u < 8; u++) { int n = cc * 8 + u; *(half_t*)(Bt + n * rowbytes + ((((k >> 3)) ^ (n & 15)) << 4) + (k & 7) * 2) = v[u]; }
  }
}
template <class RF>
DI void fft_mma(const half_t* Dm, int ldD, int nkk, const char* Bt, int rowbytes, f4 (&acc)[4][4], RF arow) {
  const int lane = TIDX & 63, wave = TIDX >> 6, fr = lane & 15, fq = lane >> 4, wc = wave & 1;
#pragma unroll 1
  for (int kk = 0; kk < nkk; kk++) {
    h8 af[4], bf[4];
#pragma unroll
    for (int ms = 0; ms < 4; ms++) af[ms] = *(const h8*)(Dm + (size_t)arow(ms) * ldD + kk * 32 + fq * 8);
#pragma unroll
    for (int ns = 0; ns < 4; ns++) { int n = wc * 64 + ns * 16 + fr; bf[ns] = *(const h8*)(Bt + n * rowbytes + (((kk * 4 + fq) ^ (n & 15)) << 4)); }
#pragma unroll
    for (int ms = 0; ms < 4; ms++)
#pragma unroll
      for (int ns = 0; ns < 4; ns++) acc[ms][ns] = mfma16(af[ms], bf[ns], acc[ms][ns]);
  }
}
DI void zero44(f4 (&acc)[4][4]) {
#pragma unroll
  for (int m = 0; m < 4; m++)
#pragma unroll
    for (int n = 0; n < 4; n++) acc[m][n] = (f4){0.f, 0.f, 0.f, 0.f};
}
DI void fftA_item(const Params& P, int it, char* smem) {
  const int b = it >> 8, bb = (it >> 1) & 127, chh = it & 1;
  const int lane = TIDX & 63, wave = TIDX >> 6, fr = lane & 15, fq = lane >> 4, wr = wave >> 1, wc = wave & 1;
  __syncthreads();
  fft_load(P.QF + (size_t)(TC + b * SEQ + bb) * 512 + chh * 128, (size_t)128 * 512, 64, smem, 256, 0);
  fft_load(P.QF + (size_t)(TC + b * SEQ + bb) * 512 + 256 + chh * 128, (size_t)128 * 512, 64, smem, 256, 64);
  __syncthreads();
  f4 acc[4][4]; zero44(acc);
  fft_mma(P.DA, 128, 4, smem, 256, acc, [&](int ms) { return (ms >> 1) * 64 + wr * 32 + (ms & 1) * 16 + fr; });
#pragma unroll
  for (int ms = 0; ms < 2; ms++)
#pragma unroll
    for (int j = 0; j < 4; j++) {
      const int f1 = wr * 32 + ms * 16 + fq * 4 + j;
      const float2 w = P.tw[(bb * f1) & 8191];
      half_t* d0 = P.GA + ((size_t)(b * 64 + f1) * 256 + bb) * 256 + chh * 128 + wc * 64 + fr;
#pragma unroll
      for (int ns = 0; ns < 4; ns++) {
        float gr = acc[ms][ns][j], gi = acc[ms + 2][ns][j];
        d0[ns * 16] = (half_t)(gr * w.x + gi * w.y);
        d0[(size_t)128 * 256 + ns * 16] = (half_t)(gi * w.x - gr * w.y);
      }
    }
}
DI void fftB_item(const Params& P, int it, char* smem) {
  const int b = it >> 7, f1 = (it >> 1) & 63, chh = it & 1;
  const int lane = TIDX & 63, wave = TIDX >> 6, fr = lane & 15, fq = lane >> 4, wr = wave >> 1, wc = wave & 1;
  __syncthreads();
  fft_load(P.GA + (size_t)(b * 64 + f1) * 256 * 256 + chh * 128, 256, 256, smem, 512, 0);
  __syncthreads();
  f4 acc[4][4]; zero44(acc);
  fft_mma(P.DB, 256, 8, smem, 512, acc, [&](int ms) { return wr * 64 + ms * 16 + fr; });
#pragma unroll
  for (int ms = 0; ms < 4; ms++)
#pragma unroll
    for (int j = 0; j < 4; j++) {
      const int f2 = wr * 64 + ms * 16 + fq * 4 + j;
      half_t* d0 = P.mix + (size_t)(TC + b * SEQ + f1 + 64 * f2) * D + chh * 128 + wc * 64 + fr;
#pragma unroll
      for (int ns = 0; ns < 4; ns++) d0[ns * 16] = (half_t)acc[ms][ns][j];
    }
}
DI void fftC_item(const Params& P, int it, char* smem) {
  const int b = it >> 1, chh = it & 1;
  const int lane = TIDX & 63, wave = TIDX >> 6, fr = lane & 15, fq = lane >> 4, wr = wave >> 1, wc = wave & 1;
#pragma unroll 1
  for (int mh = 0; mh < 2; mh++) {
    f4 acc[4][4]; zero44(acc);
#pragma unroll 1
    for (int part = 0; part < 2; part++) {
      __syncthreads();
      fft_load(P.QF + (size_t)(b * CL) * 512 + part * 256 + chh * 128, 512, 256, smem, 512, 0);
      __syncthreads();
      fft_mma(P.DC + part * 256, 512, 8, smem, 512, acc, [&](int ms) { return mh * 128 + wr * 64 + ms * 16 + fr; });
    }
#pragma unroll
    for (int ms = 0; ms < 4; ms++)
#pragma unroll
      for (int j = 0; j < 4; j++) {
        const int f = mh * 128 + wr * 64 + ms * 16 + fq * 4 + j;
        half_t* d0 = P.mix + (size_t)(b * CL + f) * D + chh * 128 + wc * 64 + fr;
#pragma unroll
        for (int ns = 0; ns < 4; ns++) d0[ns * 16] = (half_t)acc[ms][ns][j];
      }
  }
}

#ifndef MX
#define MX 15
#endif
DI void mix_phase(const Params& P, int l, char* smem, int* s_item, int qi) {
  const int nL = 0, nA = 0, nC = l == 0 ? 64 : 0, nFA = 2048, nFC = l == 0 ? 16 : 0;
  const int total = nL + nA + nC + nFA + nFC;
  {
    const int g = blockIdx.x & 3;
    lru_load_w(P, l, g, smem);
    for (int u = blockIdx.x >> 2; u < NB_ * 132; u += gridDim.x >> 2) lru_tile(P, l, u / 132, u % 132, g, smem, false);
  }
  int stage = 0;
  for (;;) {
    __syncthreads();
    if (TIDX == 0) *s_item = stage == 0 ? atomicAdd(&P.qctr[8 + qi * 8 + (blockIdx.x & 7)], 1) : atomicAdd(&P.qctr[qi], 1);
    __syncthreads();
    int it = *s_item;
    int kind = -1, b = 0, head = 0, row0 = 0, nk = 0;
    if (stage == 0) {
      if (it >= 256) { stage = 1; continue; }
      const int pair = (blockIdx.x & 7) + 8 * (it >> 6);
      b = pair >> 2; head = pair & 3; row0 = TC + b * SEQ + (it & 63) * 128; nk = KV; kind = 0;
    } else {
      if (it >= total) break;
      if (it < nC) { b = it >> 3; head = (it >> 1) & 3; row0 = b * CL + (it & 1) * 128; nk = CL; kind = 0; }
      else if (it < nC + nFA) { kind = 1; it -= nC; }
      else { kind = 2; it -= nC + nFA; }
    }
    if (kind == 0) attn_item(P, l, b, head, row0, nk, smem);
    else if (kind == 1) fftA_item(P, it, smem);
    else fftC_item(P, it, smem);
  }
}

__global__ void __launch_bounds__(256, 1) fwd_megakernel(Params Pin) {
  Params P = Pin; bind_ws(P);
  __shared__ __attribute__((aligned(16))) char smem[147456];
  __shared__ int tb[33];
  __shared__ int s_item;
  cg::grid_group grid = cg::this_grid();
#ifndef PH
#define PH 0xFFFF
#endif
#if PH & 1
  phase0(P, smem);
#endif
  grid.sync();
  for (int l = 0; l < 2; l++) {
#if PH & 2
    row1_phase(P, l == 0 ? -1 : 0, l, 0);
#endif
    grid.sync();
#if PH & 4
    gemm_in_phase(P, l, smem);
#ifdef DUP_GEMM
    grid.sync();
    gemm_in_phase(P, l, smem);
#endif
#endif
    grid.sync();
#if PH & 8
    mix_phase(P, l, smem, &s_item, l);
#ifdef DUP_MIX
    grid.sync();
    mix_phase(P, l, smem, &s_item, 2 + l);
#endif
#endif
    grid.sync();
#if PH & 16
    if (blockIdx.x >= gridDim.x - 16) lru_carry_item(P, gridDim.x - 1 - blockIdx.x);
    for (int it = blockIdx.x; it < 1024; it += gridDim.x) fftB_item(P, it, smem);
#endif
    grid.sync();
#if PH & 512
    {
      const int g = blockIdx.x & 3;
      __syncthreads();
      lru_load_w(P, l, g, smem);
      for (int u = blockIdx.x >> 2; u < NB_ * 132; u += gridDim.x >> 2) lru_tile(P, l, u / 132, u % 132, g, smem, true);
    }
#endif
    grid.sync();
#if PH & 32
    gemm_out_phase(P, l, smem);
#endif
    grid.sync();
#if PH & 64
    row2_phase(P, l, l == 0 ? 0 : TC, smem);
#endif
    grid.sync();
#if PH & 128
    moe_e1_phase(P, l, smem, tb);
#ifdef DUP_GEMM
    grid.sync();
    moe_e1_phase(P, l, smem, tb);
#endif
#endif
    grid.sync();
#if PH & 256
    moe_e2_phase(P, l, smem, tb);
#ifdef DUP_GEMM
    grid.sync();
    moe_e2_phase(P, l, smem, tb);
#endif
#endif
    grid.sync();
  }
#if PH & 2
  row1_phase(P, 1, -1, TC);
#endif
}

extern "C" void kernel_launch(void* const* d_in, const int* in_sizes, int n_in, void* d_out, int out_size, void* d_ws, size_t ws_size,
                              hipStream_t stream) {
  static int grid_blocks = 0;
  if (!grid_blocks) {
    int dev = 0, cus = 0, per_cu = 0;
    hipGetDevice(&dev);
    hipDeviceGetAttribute(&cus, hipDeviceAttributeMultiprocessorCount, dev);
    hipOccupancyMaxActiveBlocksPerMultiprocessor(&per_cu, fwd_megakernel, 256, 0);
    if (per_cu > 2) per_cu = 2;
    grid_blocks = cus * per_cu;
  }
  Params p{};
  const float** pin = (const float**)&p;
  for (int i = 0; i < 31; i++) pin[i] = (const float*)d_in[i];
  p.out = (float*)d_out;
  p.ws = (char*)d_ws;
  if (WS_NEED > ws_size) { fprintf(stderr, "workspace too small: need %zu have %zu\n", (size_t)WS_NEED, ws_size); return; }
  void* args[] = {&p};
  hipError_t e = hipLaunchCooperativeKernel((void*)fwd_megakernel, dim3(grid_blocks), dim3(256), args, 0, stream);
  if (e != hipSuccess) fprintf(stderr, "cooperative launch failed: %s (grid %d)\n", hipGetErrorString(e), grid_blocks);
}
```

```cpp
#include <hip/hip_runtime.h>
#include <hip/hip_cooperative_groups.h>
#include <cstdio>
namespace cg = cooperative_groups;

typedef _Float16 half_t;
typedef _Float16 h8 __attribute__((ext_vector_type(8)));
typedef _Float16 h4 __attribute__((ext_vector_type(4)));
typedef __fp16 fp16x2 __attribute__((ext_vector_type(2)));
typedef unsigned u4 __attribute__((ext_vector_type(4)));
typedef float f4 __attribute__((ext_vector_type(4)));
typedef float f16v __attribute__((ext_vector_type(16)));
#define DI __device__ __forceinline__
__device__ __forceinline__ int tid_opaque() { int t = threadIdx.x; asm volatile("" : "+v"(t)); return t; }
#define TIDX tid_opaque()

constexpr int D = 1024, NB_ = 8, SEQ = 8192, CL = 256;
constexpr int TC = NB_ * CL;
constexpr int TX = NB_ * SEQ;
constexpr int TA = TC + TX;
constexpr int KV = CL + SEQ;
constexpr int NIN = 2560;
constexpr int LCAP = 2 * TA;
constexpr float EPS = 1e-6f;

struct Params {
  const float *x, *c, *ctx, *c_ctx, *w_mod, *b_mod, *norm1_g, *norm2_g, *w_in, *q_norm_g, *k_norm_g, *lq1, *lk1, *lq2, *lk2,
      *subln_g, *conv_w, *conv_b, *gate_a_w, *gate_a_b, *gate_x_w, *gate_x_b, *lru_lambda, *w_out, *w_group, *b_group,
      *w_router, *b_router, *w1, *w3, *w2;
  float* out; char* ws;
  half_t *WtIn, *WtOut, *Wt1, *Wt3, *Wt2;
  float* mod; float2* rope; float2* tw; half_t *DA, *DB, *DC; float* consts; int* cnt; int* qctr; float* tokW; int* list;
  float* xcbuf; half_t* WrH;
  half_t *hx, *mix, *q, *kall, *vT, *QF, *gy, *rr; float2* lsum; float* lcar; half_t* GA; half_t *H, *yA;
};


constexpr size_t al256(size_t x) { return (x + 255) & ~(size_t)255; }
constexpr size_t O_WtIn = 0;
constexpr size_t O_WtOut = O_WtIn + al256((size_t)2 * NIN * 1024 * 2);
constexpr size_t O_Wt1 = O_WtOut + al256((size_t)2 * 1024 * 1024 * 2);
constexpr size_t O_Wt3 = O_Wt1 + al256((size_t)64 * 524288 * 2);
constexpr size_t O_Wt2 = O_Wt3 + al256((size_t)64 * 524288 * 2);
constexpr size_t O_mod = O_Wt2 + al256((size_t)64 * 524288 * 2);
constexpr size_t O_rope = O_mod + al256((size_t)2 * 9 * 6144 * 4);
constexpr size_t O_tw = O_rope + al256(128 * 16 * 8);
constexpr size_t O_DA = O_tw + al256(8192 * 8);
constexpr size_t O_DB = O_DA + al256(16384 * 2);
constexpr size_t O_DC = O_DB + al256(32768 * 2);
constexpr size_t O_consts = O_DC + al256(131072 * 2);
constexpr size_t O_cnt = O_consts + 256;
constexpr size_t O_qctr = O_cnt + 256;
constexpr size_t O_tokW = O_qctr + 256;
constexpr size_t O_list = O_tokW + al256((size_t)2 * TA * 4);
constexpr size_t O_xcbuf = O_list + al256((size_t)32 * LCAP * 4);
constexpr size_t O_WrT = O_xcbuf + al256((size_t)TC * D * 4);
constexpr size_t O_hx = O_WrT + al256((size_t)2 * 2 * 48 * 1024 * 2);
constexpr size_t O_mix = O_hx + al256((size_t)TA * D * 2);
constexpr size_t O_regB = O_mix + al256((size_t)TA * D * 2);
constexpr size_t O_q = O_regB;
constexpr size_t O_kall = O_q + al256((size_t)TA * 512 * 2);
constexpr size_t O_vT = O_kall + al256((size_t)NB_ * KV * 512 * 2);
constexpr size_t O_QF = O_vT + al256((size_t)NB_ * 4 * 128 * KV * 2);
constexpr size_t O_gy = O_QF + al256((size_t)TA * 512 * 2);
constexpr size_t O_rr = O_gy + al256((size_t)TA * 256 * 2);
constexpr size_t O_lsum = O_rr + al256((size_t)TA * 256 * 2);
constexpr size_t O_lcar = O_lsum + al256((size_t)16 * 132 * 256 * 8);
constexpr size_t O_GA = O_lcar + al256((size_t)16 * 132 * 256 * 4);
constexpr size_t O_mixer_end = O_GA + al256((size_t)NB_ * 64 * 256 * 256 * 2);
constexpr size_t O_H = O_regB;
constexpr size_t O_yA = O_H + al256((size_t)(2 * TA + 32 * 256) * 512 * 2);
constexpr size_t O_moe_end = O_yA + al256((size_t)2 * TA * D * 2);
constexpr size_t WS_NEED = O_mixer_end > O_moe_end ? O_mixer_end : O_moe_end;
DI void bind_ws(Params& P) {
  char* w = P.ws;
  P.WtIn = (half_t*)(w + O_WtIn); P.WtOut = (half_t*)(w + O_WtOut); P.Wt1 = (half_t*)(w + O_Wt1); P.Wt3 = (half_t*)(w + O_Wt3); P.Wt2 = (half_t*)(w + O_Wt2);
  P.mod = (float*)(w + O_mod); P.rope = (float2*)(w + O_rope); P.tw = (float2*)(w + O_tw); P.DA = (half_t*)(w + O_DA); P.DB = (half_t*)(w + O_DB); P.DC = (half_t*)(w + O_DC);
  P.consts = (float*)(w + O_consts); P.cnt = (int*)(w + O_cnt); P.qctr = (int*)(w + O_qctr); P.tokW = (float*)(w + O_tokW); P.list = (int*)(w + O_list);
  P.xcbuf = (float*)(w + O_xcbuf); P.WrH = (half_t*)(w + O_WrT); P.hx = (half_t*)(w + O_hx); P.mix = (half_t*)(w + O_mix);
  P.q = (half_t*)(w + O_q); P.kall = (half_t*)(w + O_kall); P.vT = (half_t*)(w + O_vT); P.QF = (half_t*)(w + O_QF); P.gy = (half_t*)(w + O_gy); P.rr = (half_t*)(w + O_rr);
  P.lsum = (float2*)(w + O_lsum); P.lcar = (float*)(w + O_lcar); P.GA = (half_t*)(w + O_GA); P.H = (half_t*)(w + O_H); P.yA = (half_t*)(w + O_yA);
}
DI float shx(float v, int o) { int ln = TIDX & 63; return __builtin_bit_cast(float, __builtin_amdgcn_ds_bpermute((ln ^ o) << 2, __builtin_bit_cast(int, v))); }
DI float shi(float v, int idx) { return __builtin_bit_cast(float, __builtin_amdgcn_ds_bpermute(idx << 2, __builtin_bit_cast(int, v))); }
DI float wave_sum(float v) {
#pragma unroll
  for (int o = 32; o; o >>= 1) v += shx(v, o);
  return v;
}
DI void glds16(const void* g, void* l) {
  __builtin_amdgcn_global_load_lds((const unsigned*)g, (unsigned*)l, 16, 0, 0);
}
DI void wait_vm0() { asm volatile("s_waitcnt vmcnt(0)" ::: "memory"); }
DI f4 mfma16(h8 a, h8 b, f4 c) { return __builtin_amdgcn_mfma_f32_16x16x32_f16(a, b, c, 0, 0, 0); }
DI f16v mfma32(h8 a, h8 b, f16v c) { return __builtin_amdgcn_mfma_f32_32x32x16_f16(a, b, c, 0, 0, 0); }
DI unsigned pk2(float a, float b) { fp16x2 r = __builtin_amdgcn_cvt_pkrtz(a, b); return __builtin_bit_cast(unsigned, r); }
DI float sigmoidf_(float x) { return 1.f / (1.f + __expf(-x)); }
DI float gelu_tanh(float x) {
  float u = 0.7978845608028654f * (x + 0.044715f * x * x * x);
  float e = __expf(2.f * u);
  float t = 1.f - 2.f / (e + 1.f);
  return 0.5f * x * (1.f + t);
}
DI int row_mod(int r) { return r < TC ? 8 : ((r - TC) >> 13); }

DI void transpose_tile(const float* src, int lds_, half_t* dst, int ldd, float* tile) {
  const int tid = TIDX, n = tid & 63, kq = tid >> 6;
#pragma unroll 4
  for (int i = 0; i < 16; i++) { int k = i * 4 + kq; tile[k * 65 + n] = src[(size_t)k * lds_ + n]; }
  __syncthreads();
#pragma unroll 4
  for (int i = 0; i < 16; i++) { int nn = i * 4 + kq; dst[(size_t)nn * ldd + n] = (half_t)tile[n * 65 + nn]; }
  __syncthreads();
}

DI void phase0(const Params& P, char* smem) {
  float* tile = (float*)smem;
  const int tid = TIDX;
  constexpr int NT = 26112, NF = 128, NM = 192, NX = 6;
  for (int t = blockIdx.x; t < NT + NF + NM + NX; t += gridDim.x) {
    if (t < NT) {
      const float* src; half_t* dst; int lds_, ldd;
      if (t < 1024) {
        int l = t / 512, r = t % 512, kt = r / 32, nt = r % 32;
        src = P.w_in + (size_t)l * 1024 * 2304 + (size_t)kt * 64 * 2304 + 256 + nt * 64; lds_ = 2304;
        dst = P.WtIn + (size_t)l * NIN * 1024 + (size_t)(512 + nt * 64) * 1024 + kt * 64; ldd = 1024;
      } else if (t < 1536) {
        int u = t - 1024, l = u / 256, r = u % 256, kt = r / 16, nt = r % 16;
        src = P.w_out + (size_t)l * 1048576 + (size_t)kt * 64 * 1024 + nt * 64; lds_ = 1024;
        dst = P.WtOut + (size_t)l * 1048576 + (size_t)nt * 64 * 1024 + kt * 64; ldd = 1024;
      } else if (t < 1536 + 16384) {
        int u = t - 1536; const float* w = P.w1; half_t* o = P.Wt1;
        if (u >= 8192) { u -= 8192; w = P.w3; o = P.Wt3; }
        int le = u / 128, r = u % 128, kt = r / 8, nt = r % 8;
        src = w + (size_t)le * 524288 + (size_t)kt * 64 * 512 + nt * 64; lds_ = 512;
        dst = o + (size_t)le * 524288 + (size_t)nt * 64 * 1024 + kt * 64; ldd = 1024;
      } else {
        int u = t - 1536 - 16384, le = u / 128, r = u % 128, kt = r / 16, nt = r % 16;
        src = P.w2 + (size_t)le * 524288 + (size_t)kt * 64 * 1024 + nt * 64; lds_ = 1024;
        dst = P.Wt2 + (size_t)le * 524288 + (size_t)nt * 64 * 512 + kt * 64; ldd = 512;
      }
      transpose_tile(src, lds_, dst, ldd, tile);
    } else if (t < NT + NF) {
      int f = t - NT, l = f / 64, r = f % 64, kt = r / 4, g = r % 4;
      float* cst = tile + 64 * 65; float* snt = cst + 64;
      const float* src = P.w_in + (size_t)l * 1024 * 2304 + (size_t)kt * 64 * 2304 + g * 64;
      { int n = tid & 63, kq = tid >> 6;
        for (int i = 0; i < 16; i++) { int k = i * 4 + kq; tile[k * 65 + n] = src[(size_t)k * 2304 + n]; } }
      if (tid < 64) { float s, c; sincospif((float)tid / 32.f, &s, &c); cst[tid] = c; snt[tid] = s; }
      __syncthreads();
      int k = tid & 63, jq = tid >> 6;
      half_t* o = P.WtIn + (size_t)l * NIN * 1024 + kt * 64 + k;
      for (int jj = 0; jj < 16; jj++) {
        int j = jq * 16 + jj; float ac = 0.f, as = 0.f;
        for (int c = 0; c < 64; c++) { float v = tile[k * 65 + c]; int idx = (c * j) & 63; ac += v * cst[idx]; as += v * snt[idx]; }
        o[(size_t)(g * 64 + j) * 1024] = (half_t)(ac * 0.125f);
        o[(size_t)(256 + g * 64 + j) * 1024] = (half_t)(-as * 0.125f);
      }
      __syncthreads();
    } else if (t < NT + NF + NM) {
      int mi = t - NT - NF, l = mi / 96, col0 = (mi % 96) * 64;
      float* scond = tile; float* red = tile + 9216;
      for (int idx = tid; idx < 9216; idx += 256) {
        int n = idx >> 10, k = idx & 1023; float v = n < 8 ? P.c[n * 1024 + k] : P.c_ctx[k];
        scond[idx] = v / (1.f + expf(-v));
      }
      __syncthreads();
      int col = tid & 63, kq = tid >> 6; float acc[9];
#pragma unroll
      for (int n = 0; n < 9; n++) acc[n] = 0.f;
      const float* w = P.w_mod + ((size_t)l * 1024 + kq * 256) * 6144 + col0 + col;
#pragma unroll 4
      for (int k = 0; k < 256; k++) {
        float wv = w[(size_t)k * 6144];
#pragma unroll
        for (int n = 0; n < 9; n++) acc[n] += scond[n * 1024 + kq * 256 + k] * wv;
      }
#pragma unroll
      for (int n = 0; n < 9; n++) red[(kq * 9 + n) * 64 + col] = acc[n];
      __syncthreads();
      for (int idx = tid; idx < 576; idx += 256) {
        int n = idx / 64, cc = idx % 64;
        float s = red[(0 * 9 + n) * 64 + cc] + red[(1 * 9 + n) * 64 + cc] + red[(2 * 9 + n) * 64 + cc] + red[(3 * 9 + n) * 64 + cc];
        P.mod[(size_t)(l * 9 + n) * 6144 + col0 + cc] = s + P.b_mod[l * 6144 + col0 + cc];
      }
      __syncthreads();
    } else {
      int m = t - NT - NF - NM;
      if (m == 0) {
        for (int idx = tid; idx < 128 * 16; idx += 256) {
          int pos = idx >> 4, i = idx & 15; float f = powf(10000.f, -(float)i / 16.f); float ang = (float)pos * f;
          float s, c; sincosf(ang, &s, &c); P.rope[idx] = make_float2(c, s);
        }
      } else if (m == 1) {
        for (int j = tid; j < 8192; j += 256) { float s, c; sincospif((float)j / 4096.f, &s, &c); P.tw[j] = make_float2(c, s); }
      } else if (m == 2) {
        for (int idx = tid; idx < 16384; idx += 256) {
          int mm = idx >> 7, k = idx & 127, part = mm >> 6, f1 = mm & 63, pp = k >> 6, a = k & 63;
          float s, c; sincospif((float)((a * f1) & 63) / 32.f, &s, &c);
          float v = part == 0 ? (pp == 0 ? c : s) : (pp == 0 ? -s : c);
          P.DA[idx] = (half_t)(v * 0.125f);
        }
      } else if (m == 3) {
        for (int idx = tid; idx < 32768; idx += 256) {
          int mm = idx >> 8, k = idx & 255, part = k >> 7, bb = k & 127;
          float s, c; sincospif((float)((bb * mm) & 127) / 64.f, &s, &c);
          P.DB[idx] = (half_t)((part == 0 ? c : s) * 0.08838834764831845f);
        }
      } else if (m == 4) {
        for (int idx = tid; idx < 131072; idx += 256) {
          int mm = idx >> 9, k = idx & 511, part = k >> 8, tt = k & 255;
          float s, c; sincospif((float)((tt * mm) & 255) / 128.f, &s, &c);
          P.DC[idx] = (half_t)((part == 0 ? c : s) * 0.0625f);
        }
      } else {
        for (int idx = tid; idx < 2 * 48 * 1024; idx += 256) {
          int l = idx / 49152, r = idx % 49152, col = r >> 10, k = r & 1023;
          float w = col < 4 ? P.w_group[((size_t)l * 1024 + k) * 4 + col] : (col < 36 ? P.w_router[((size_t)l * 1024 + k) * 32 + col - 4] : 0.f);
          half_t hi = (half_t)w, lo = (half_t)(w - (float)hi);
          P.WrH[(size_t)(l * 2) * 49152 + r] = hi; P.WrH[(size_t)(l * 2 + 1) * 49152 + r] = lo;
        }
        if (tid < 2) {
          int l = tid; float s1 = 0.f, s2 = 0.f, mq = 0.f, mk = 0.f;
          for (int i = 0; i < 64; i++) {
            s1 += P.lq1[l * 64 + i] * P.lk1[l * 64 + i]; s2 += P.lq2[l * 64 + i] * P.lk2[l * 64 + i];
            mq = fmaxf(mq, fabsf(P.q_norm_g[l * 64 + i])); mk = fmaxf(mk, fabsf(P.k_norm_g[l * 64 + i]));
          }
          float lam_init = 0.8f - 0.6f * expf(-0.3f * (float)l);
          P.consts[l * 4 + 0] = expf(s1) - expf(s2) + lam_init;
          P.consts[l * 4 + 1] = 8.f * mq * mk * 1.4426950408889634f * 1.002f - 15.f;
          P.consts[l * 4 + 2] = lam_init;
        }
        if (tid < 64) P.cnt[tid] = 0;
        if (tid < 64) P.qctr[tid] = 0;
      }
    }
  }
}

DI void row1_phase(const Params& P, int combine_l, int norm_l, int r_begin) {
  const int lane = TIDX & 63, gw = blockIdx.x * 4 + (TIDX >> 6), nw = gridDim.x * 4;
  for (int r = r_begin + gw; r < TA; r += nw) {
    const int n = row_mod(r);
    float v[16];
    if (combine_l < 0) {
      const float* src = r < TC ? P.ctx + (size_t)r * D : P.x + (size_t)(r - TC) * D;
#pragma unroll
      for (int i = 0; i < 4; i++) { float4 t = *(const float4*)(src + i * 256 + lane * 4); v[i*4] = t.x; v[i*4+1] = t.y; v[i*4+2] = t.z; v[i*4+3] = t.w; }
    } else {
      float* xm = r < TC ? P.xcbuf + (size_t)r * D : P.out + (size_t)(r - TC) * D;
      const float* g2 = P.mod + (size_t)(combine_l * 9 + n) * 6144 + 5 * 1024;
      const half_t* y0 = P.yA + (size_t)(2 * r) * D; const half_t* y1 = y0 + D;
#pragma unroll
      for (int i = 0; i < 4; i++) {
        int c = i * 256 + lane * 4;
        float4 t = *(const float4*)(xm + c); float4 g = *(const float4*)(g2 + c);
        h4 a = *(const h4*)(y0 + c); h4 b = *(const h4*)(y1 + c);
        t.x += g.x * ((float)a[0] + (float)b[0]); t.y += g.y * ((float)a[1] + (float)b[1]);
        t.z += g.z * ((float)a[2] + (float)b[2]); t.w += g.w * ((float)a[3] + (float)b[3]);
        *(float4*)(xm + c) = t;
        v[i*4] = t.x; v[i*4+1] = t.y; v[i*4+2] = t.z; v[i*4+3] = t.w;
      }
    }
    if (norm_l >= 0) {
      float ss = 0.f;
#pragma unroll
      for (int i = 0; i < 16; i++) ss += v[i] * v[i];
      ss = wave_sum(ss);
      const float rstd = rsqrtf(ss * (1.f / 1024.f) + EPS);
      const float* g = P.norm1_g + norm_l * 1024;
      const float* sh = P.mod + (size_t)(norm_l * 9 + n) * 6144; const float* sc = sh + 1024;
#pragma unroll
      for (int i = 0; i < 4; i++) {
        int c = i * 256 + lane * 4;
        float4 gg = *(const float4*)(g + c), s1 = *(const float4*)(sc + c), s0 = *(const float4*)(sh + c);
        h4 o;
        o[0] = (half_t)(v[i*4] * rstd * gg.x * (1.f + s1.x) + s0.x); o[1] = (half_t)(v[i*4+1] * rstd * gg.y * (1.f + s1.y) + s0.y);
        o[2] = (half_t)(v[i*4+2] * rstd * gg.z * (1.f + s1.z) + s0.z); o[3] = (half_t)(v[i*4+3] * rstd * gg.w * (1.f + s1.w) + s0.w);
        *(h4*)(P.hx + (size_t)r * D + c) = o;
      }
    }
  }
}

DI void row2_phase(const Params& P, int l, int r_begin, char* smem) {
  const int tid = TIDX, lane = tid & 63, wave = tid >> 6, fr = lane & 15, fq = lane >> 4;
  float* lg = (float*)smem + wave * 16 * 48;
  const half_t* Whi = P.WrH + (size_t)(l * 2) * 49152; const half_t* Wlo = Whi + 49152;
  const int ngroups = (TA - r_begin) >> 4, gw = blockIdx.x * 4 + wave, nw = gridDim.x * 4;
  const float* gam = P.norm2_g + l * 1024;
#pragma unroll 1
  for (int grp = gw; grp < ngroups; grp += nw) {
    const int r0 = r_begin + grp * 16, row = r0 + fr, n = row_mod(r0);
    const float* xm = (row < TC ? P.xcbuf + (size_t)row * D : P.out + (size_t)(row - TC) * D) + fq * 8;
    float ss = 0.f;
#pragma unroll 8
    for (int kk = 0; kk < 32; kk++) {
      float4 a = *(const float4*)(xm + kk * 32), b = *(const float4*)(xm + kk * 32 + 4);
      ss += a.x * a.x + a.y * a.y + a.z * a.z + a.w * a.w + b.x * b.x + b.y * b.y + b.z * b.z + b.w * b.w;
    }
    ss += shx(ss, 16); ss += shx(ss, 32);
    const float rstd = rsqrtf(ss * (1.f / 1024.f) + EPS);
    const float* sh = P.mod + (size_t)(l * 9 + n) * 6144 + 3 * 1024 + fq * 8; const float* sc = sh + 1024;
    f4 acc[3];
#pragma unroll
    for (int i = 0; i < 3; i++) acc[i] = (f4){0.f, 0.f, 0.f, 0.f};
    half_t* hxo = P.hx + (size_t)row * D + fq * 8;
#pragma unroll 2
    for (int kk = 0; kk < 32; kk++) {
      const int k0 = kk * 32;
      float x[8], g[8], s1[8], s0[8];
      *(float4*)&x[0] = *(const float4*)(xm + k0); *(float4*)&x[4] = *(const float4*)(xm + k0 + 4);
      *(float4*)&g[0] = *(const float4*)(gam + fq * 8 + k0); *(float4*)&g[4] = *(const float4*)(gam + fq * 8 + k0 + 4);
      *(float4*)&s1[0] = *(const float4*)(sc + k0); *(float4*)&s1[4] = *(const float4*)(sc + k0 + 4);
      *(float4*)&s0[0] = *(const float4*)(sh + k0); *(float4*)&s0[4] = *(const float4*)(sh + k0 + 4);
      h8 hi, lo;
#pragma unroll
      for (int i = 0; i < 8; i++) {
        float v = x[i] * rstd * g[i] * (1.f + s1[i]) + s0[i];
        hi[i] = (half_t)v; lo[i] = (half_t)(v - (float)hi[i]);
      }
      *(h8*)(hxo + k0) = hi;
#pragma unroll
      for (int n3 = 0; n3 < 3; n3++) {
        h8 bh = *(const h8*)(Whi + (size_t)(n3 * 16 + fr) * 1024 + k0 + fq * 8);
        h8 bl = *(const h8*)(Wlo + (size_t)(n3 * 16 + fr) * 1024 + k0 + fq * 8);
        acc[n3] = mfma16(hi, bh, acc[n3]); acc[n3] = mfma16(lo, bh, acc[n3]); acc[n3] = mfma16(hi, bl, acc[n3]);
      }
    }
    __builtin_amdgcn_wave_barrier();
#pragma unroll
    for (int n3 = 0; n3 < 3; n3++)
#pragma unroll
      for (int j = 0; j < 4; j++) lg[(fq * 4 + j) * 48 + n3 * 16 + fr] = acc[n3][j];
    __builtin_amdgcn_wave_barrier();
    if (lane < 16) {
      const int r = r0 + lane;
      const float* L = lg + lane * 48;
      float gl[4]; int gi = 0;
#pragma unroll
      for (int j = 0; j < 4; j++) gl[j] = L[j] + P.b_group[l * 4 + j];
      float gm = gl[0];
#pragma unroll
      for (int j = 1; j < 4; j++) if (gl[j] > gm) { gm = gl[j]; gi = j; }
      float gs = 0.f;
#pragma unroll
      for (int j = 0; j < 4; j++) gs += expf(gl[j] - gm);
      const float pg = 1.f / gs;
      float el[8];
#pragma unroll
      for (int j = 0; j < 8; j++) el[j] = L[4 + gi * 8 + j] + P.b_router[l * 32 + gi * 8 + j];
      int i0 = 0; float v0 = el[0];
#pragma unroll
      for (int j = 1; j < 8; j++) if (el[j] > v0) { v0 = el[j]; i0 = j; }
      int i1 = -1; float v1 = -3.0e38f;
#pragma unroll
      for (int j = 0; j < 8; j++) if (j != i0 && el[j] > v1) { v1 = el[j]; i1 = j; }
      const float ex = expf(v1 - v0);
      const float w0 = pg / (1.f + ex), w1 = pg * ex / (1.f + ex);
      const int e0 = gi * 8 + i0, e1 = gi * 8 + i1;
      int p0 = atomicAdd(&P.cnt[l * 32 + e0], 1); P.list[(size_t)e0 * LCAP + p0] = 2 * r;
      int p1 = atomicAdd(&P.cnt[l * 32 + e1], 1); P.list[(size_t)e1 * LCAP + p1] = 2 * r + 1;
      P.tokW[2 * r] = w0; P.tokW[2 * r + 1] = w1;
    }
    __builtin_amdgcn_wave_barrier();
  }
}

DI h8 lds128(unsigned a) { h8 r; asm volatile("ds_read_b128 %0, %1" : "=v"(r) : "v"(a)); return r; }
DI void tie(h8& x) { asm volatile("" : "+v"(x)); }
DI unsigned lds_addr(const void* p) { return (unsigned)(size_t)p; }
#define WAIT_LGKM(n) asm volatile("s_waitcnt lgkmcnt(" #n ")" ::: "memory")
DI void raw_barrier() { asm volatile("" ::: "memory"); __builtin_amdgcn_s_barrier(); asm volatile("" ::: "memory"); }
DI void slot_rc(int i, int& row, int& coff) { int s = i * 256 + TIDX; row = s >> 3; coff = ((s & 7) ^ ((row >> 1) & 7)) * 8; }

template <class AF, class BF>
DI void gemm256(AF aptr, BF bptr, int nk, char* smem, f4 (&acc)[8][4]) {
  const int tid = TIDX, lane = tid & 63, wave = tid >> 6, fr = lane & 15, fq = lane >> 4, wr = wave >> 1, wc = wave & 1;
#pragma unroll
  for (int m = 0; m < 8; m++)
#pragma unroll
    for (int n = 0; n < 4; n++) acc[m][n] = (f4){0.f, 0.f, 0.f, 0.f};
  auto issue = [&](int kt, int st) {
    char* d = smem + st * 49152 + tid * 16;
#pragma unroll
    for (int i = 0; i < 8; i++) glds16(aptr(i) + kt * 64, d + i * 4096);
#pragma unroll
    for (int i = 0; i < 4; i++) glds16(bptr(i) + kt * 64, d + 32768 + i * 4096);
  };
  const unsigned sw = (unsigned)((fq ^ (fr >> 1)) << 4);
  const unsigned offA = (wr * 128 + fr) * 128 + sw, offB = 32768 + (wc * 64 + fr) * 128 + sw;
  const unsigned sbase = lds_addr(smem);
  issue(0, 0);
  if (nk > 1) issue(1, 1);
  int st = 0;
#pragma unroll 1
  for (int kt = 0; kt < nk; kt++) {
    if (kt + 1 < nk) asm volatile("s_waitcnt vmcnt(12)" ::: "memory"); else wait_vm0();
    raw_barrier();
    if (kt + 2 < nk) issue(kt + 2, st == 0 ? 2 : st - 1);
    const unsigned base = sbase + st * 49152;
    st = st == 2 ? 0 : st + 1;
    h8 a0[8], b0[4], a1[8], b1[4];
#pragma unroll
    for (int m = 0; m < 8; m++) a0[m] = lds128(base + offA + m * 2048);
#pragma unroll
    for (int n = 0; n < 4; n++) b0[n] = lds128(base + offB + n * 2048);
#pragma unroll
    for (int m = 0; m < 8; m++) a1[m] = lds128(base + (offA ^ 64) + m * 2048);
#pragma unroll
    for (int n = 0; n < 4; n++) b1[n] = lds128(base + (offB ^ 64) + n * 2048);
    WAIT_LGKM(12);
#pragma unroll
    for (int m = 0; m < 8; m++) tie(a0[m]);
#pragma unroll
    for (int n = 0; n < 4; n++) tie(b0[n]);
#pragma unroll
    for (int m = 0; m < 8; m++)
#pragma unroll
      for (int n = 0; n < 4; n++) acc[m][n] = mfma16(a0[m], b0[n], acc[m][n]);
    WAIT_LGKM(0);
#pragma unroll
    for (int m = 0; m < 8; m++) tie(a1[m]);
#pragma unroll
    for (int n = 0; n < 4; n++) tie(b1[n]);
#pragma unroll
    for (int m = 0; m < 8; m++)
#pragma unroll
      for (int n = 0; n < 4; n++) acc[m][n] = mfma16(a1[m], b1[n], acc[m][n]);
  }
  raw_barrier();
}
DI bool xcd_tile(int it, int MT, int NT, int& mt, int& nt) {
  const int x = blockIdx.x & 7, j = blockIdx.x >> 3;
  const int nsn = NT >> 2, nsm = (MT + 7) >> 3;
  const int s = x + 8 * it;
  if (s >= nsm * nsn) return false;
  const int sm = s / nsn, sn = s % nsn;
  mt = sm * 8 + (j >> 2); nt = sn * 4 + (j & 3);
  return true;
}
DI int slot_col() { int t = TIDX; return ((t & 7) ^ ((t >> 4) & 7)) * 8; }

DI float dpp_row_sum(float v) {
  v += __builtin_bit_cast(float, __builtin_amdgcn_update_dpp(0, __builtin_bit_cast(int, v), 0x128, 0xf, 0xf, false));
  v += __builtin_bit_cast(float, __builtin_amdgcn_update_dpp(0, __builtin_bit_cast(int, v), 0x124, 0xf, 0xf, false));
  v += __builtin_bit_cast(float, __builtin_amdgcn_update_dpp(0, __builtin_bit_cast(int, v), 0x122, 0xf, 0xf, false));
  v += __builtin_bit_cast(float, __builtin_amdgcn_update_dpp(0, __builtin_bit_cast(int, v), 0x121, 0xf, 0xf, false));
  return v;
}
DI void stage_put(char* stg, int ml, int n, int j, int fr, int fq, float v) { *(half_t*)(stg + (ml * 16 + fq * 4 + j) * 144 + (n * 16 + fr) * 2) = (half_t)v; }
template <class RP, class SC>
DI void stage_flush(char* stg, int h, RP rowptr, SC rowscale) {
  const int lane = TIDX & 63;
  __builtin_amdgcn_wave_barrier();
#pragma unroll
  for (int i = 0; i < 8; i++) {
    const int c = i * 64 + lane, row = c >> 3, c16 = c & 7;
    h8 v = *(const h8*)(stg + row * 144 + c16 * 16);
    half_t* d = rowptr(h * 64 + row);
    if (d) { rowscale(h * 64 + row, v); *(h8*)(d + c16 * 8) = v; }
  }
  __builtin_amdgcn_wave_barrier();
}
template <class VF, class RP, class SC>
DI void wave_store_tile(VF val, char* stg, RP rowptr, SC rowscale) {
  const int lane = TIDX & 63, fr = lane & 15, fq = lane >> 4;
#pragma unroll
  for (int h = 0; h < 2; h++) {
#pragma unroll
    for (int ml = 0; ml < 4; ml++)
#pragma unroll
      for (int n = 0; n < 4; n++)
#pragma unroll
        for (int j = 0; j < 4; j++) stage_put(stg, ml, n, j, fr, fq, val(h * 4 + ml, n, j));
    stage_flush(stg, h, rowptr, rowscale);
  }
}
DI void gemm_in_phase(const Params& P, int l, char* smem) {
  const int tid = TIDX;
  const half_t* Wt = P.WtIn + (size_t)l * NIN * 1024;
  const int sc = slot_col(), srow = tid >> 3;
#pragma unroll 1
  for (int it = 0;; it++) {
    int mt, nt;
    if (!xcd_tile(it, 264, 20, mt, nt)) break;
    if (mt >= 264) continue;
    asm volatile("" : "+s"(mt), "+s"(nt));
    f4 acc[8][4];
    {
      const half_t* a0 = P.hx + (size_t)(mt * 256 + srow) * D + sc; const half_t* b0 = Wt + (size_t)(nt * 128 + srow) * D + sc;
      gemm256([&](int i) { return a0 + (size_t)i * 32 * D; }, [&](int i) { return b0 + (size_t)i * 32 * D; }, 16, smem, acc);
    }
    const int tid2 = TIDX, lane = tid2 & 63, wave = tid2 >> 6, fr = lane & 15, fq = lane >> 4, wr = wave >> 1, wc = wave & 1;
    const int r0 = mt * 256 + wr * 128;
    const bool isctx = r0 < TC;
    int b, pos0;
    if (isctx) { b = r0 >> 8; pos0 = r0 & 255; } else { b = (r0 - TC) >> 13; pos0 = 256 + ((r0 - TC) & 8191); }
    char* stg = smem + 98304 + wave * 12288;
    auto noscale = [](int, h8&) {};
    if (nt < 4 || nt >= 16) {
      half_t* dst; int ld, c0; bool gel = false;
      if (nt < 4) { dst = P.QF; ld = 512; c0 = nt * 128; }
      else if (nt < 18) { dst = P.gy; ld = 256; c0 = (nt - 16) * 128; gel = true; }
      else { dst = P.rr; ld = 256; c0 = (nt - 18) * 128; }
      half_t* base = dst + (size_t)r0 * ld + c0 + wc * 64;
      if (gel) wave_store_tile([&](int m, int n, int j) { return gelu_tanh(acc[m][n][j]); }, stg, [&](int r) { return base + (size_t)r * ld; }, noscale);
      else wave_store_tile([&](int m, int n, int j) { return acc[m][n][j]; }, stg, [&](int r) { return base + (size_t)r * ld; }, noscale);
    } else if (nt < 12) {
      const bool isq = nt < 8; const int head = isq ? nt - 4 : nt - 8;
      const float* gvec = (isq ? P.q_norm_g : P.k_norm_g) + l * 64;
      const float qs = isq ? 0.125f * 1.4426950408889634f : 1.f;
      float gg[4];
#pragma unroll
      for (int n = 0; n < 4; n++) gg[n] = gvec[n * 16 + fr] * qs;
      float2 rr2[2];
      const int tp0 = pos0 - 256;
      if (!isctx) { rr2[0] = P.rope[(tp0 >> 6) * 16 + fr]; rr2[1] = P.rope[((tp0 >> 6) + 1) * 16 + fr]; }
      half_t* base = (isq ? P.q + (size_t)r0 * 512 : P.kall + ((size_t)b * KV + pos0) * 512) + head * 128 + wc * 64;
#pragma unroll
      for (int mh = 0; mh < 2; mh++) {
#pragma unroll
        for (int mm = 0; mm < 4; mm++) {
          const int m = mh * 4 + mm;
#pragma unroll
          for (int j = 0; j < 4; j++) {
            float ss = 0.f;
#pragma unroll
            for (int n = 0; n < 4; n++) ss += acc[m][n][j] * acc[m][n][j];
            ss = dpp_row_sum(ss);
            const float rstd = rsqrtf(ss * (1.f / 64.f) + EPS);
            float o[4];
#pragma unroll
            for (int n = 0; n < 4; n++) o[n] = acc[m][n][j] * rstd * gg[n];
            if (!isctx) {
              const float2 cr = rr2[mh], cc = P.rope[(mm * 16 + fq * 4 + j) * 16 + fr];
              float a0 = o[0] * cr.x - o[1] * cr.y, a1 = o[1] * cr.x + o[0] * cr.y;
              float a2 = o[2] * cc.x - o[3] * cc.y, a3 = o[3] * cc.x + o[2] * cc.y;
              o[0] = a0; o[1] = a1; o[2] = a2; o[3] = a3;
            }
#pragma unroll
            for (int n = 0; n < 4; n++) stage_put(stg, mm, n, j, fr, fq, o[n]);
          }
        }
        stage_flush(stg, mh, [&](int r) { return base + (size_t)r * 512; }, noscale);
      }
    } else {
      const int head = nt - 12;
#pragma unroll
      for (int m = 0; m < 8; m++)
#pragma unroll
        for (int n = 0; n < 4; n++) {
          h4 o; o[0] = (half_t)acc[m][n][0]; o[1] = (half_t)acc[m][n][1]; o[2] = (half_t)acc[m][n][2]; o[3] = (half_t)acc[m][n][3];
          int d = wc * 64 + n * 16 + fr;
          asm volatile("" : "+v"(d) :: "memory");
          *(h4*)(P.vT + ((size_t)(b * 4 + head) * 128 + d) * KV + pos0 + m * 16 + fq * 4) = o;
        }
    }
  }
}

DI void gemm_out_phase(const Params& P, int l, char* smem) {
  const int tid = TIDX, lane = tid & 63, wave = tid >> 6, fr = lane & 15, fq = lane >> 4, wr = wave >> 1, wc = wave & 1;
  const half_t* Wt = P.WtOut + (size_t)l * 1048576;
  const int mt0 = l == 0 ? 0 : TC / 256;
  const int sc = slot_col(), srow = tid >> 3;
#pragma unroll 1
  for (int it = 0;; it++) {
    int mt, nt;
    if (!xcd_tile(it, 264 - mt0, 8, mt, nt)) break;
    mt += mt0;
    if (mt >= 264) continue;
    asm volatile("" : "+s"(mt), "+s"(nt));
    f4 acc[8][4];
    {
      const half_t* a0 = P.mix + (size_t)(mt * 256 + srow) * D + sc; const half_t* b0 = Wt + (size_t)(nt * 128 + srow) * D + sc;
      gemm256([&](int i) { return a0 + (size_t)i * 32 * D; }, [&](int i) { return b0 + (size_t)i * 32 * D; }, 16, smem, acc);
    }
    const int r0 = mt * 256 + wr * 128;
    const int n = row_mod(r0);
    const float* g1 = P.mod + (size_t)(l * 9 + n) * 6144 + 2 * 1024;
    const float* res; float* dst;
    if (r0 < TC) { res = P.ctx + (size_t)r0 * D; dst = P.xcbuf + (size_t)r0 * D; }
    else { dst = P.out + (size_t)(r0 - TC) * D; res = l == 0 ? P.x + (size_t)(r0 - TC) * D : dst; }
#pragma unroll
    for (int m = 0; m < 8; m++) {
      int rb = m * 16 + fq * 4;
      asm volatile("" : "+v"(rb) :: "memory");
#pragma unroll
      for (int nn = 0; nn < 4; nn++) {
        const int c = nt * 128 + wc * 64 + nn * 16 + fr; const float g = g1[c];
#pragma unroll
        for (int j = 0; j < 4; j++) { size_t o = (size_t)(rb + j) * D + c; dst[o] = res[o] + g * acc[m][nn][j]; }
      }
    }
  }
}

DI void moe_prefix(const Params& P, int l, int* tb) {
  __syncthreads();
  if (TIDX == 0) { int s = 0; for (int e = 0; e < 32; e++) { tb[e] = s; s += (P.cnt[l * 32 + e] + 255) >> 8; } tb[32] = s; }
  __syncthreads();
}
DI void moe_e1_phase(const Params& P, int l, char* smem, int* tb) {
  const int tid = TIDX, lane = tid & 63, wave = tid >> 6, fr = lane & 15, fq = lane >> 4, wr = wave >> 1, wc = wave & 1;
  moe_prefix(P, l, tb);
  const int sc = slot_col(), srow = tid >> 3;
#pragma unroll 1
  for (int it = 0;; it++) {
    int rt, nt;
    if (!xcd_tile(it, tb[32], 8, rt, nt)) break;
    if (rt >= tb[32]) continue;
    asm volatile("" : "+s"(rt), "+s"(nt));
    int e = 0;
    while (tb[e + 1] <= rt) e++;
    const int rl = rt - tb[e], cnt = P.cnt[l * 32 + e];
    const int* lst = P.list + (size_t)e * LCAP;
    const half_t* w1 = P.Wt1 + ((size_t)(l * 32 + e) * 512 + nt * 64) * 1024 + sc;
    const half_t* w3 = P.Wt3 + ((size_t)(l * 32 + e) * 512 + nt * 64) * 1024 + sc;
    int tok[8];
#pragma unroll
    for (int i = 0; i < 8; i++) tok[i] = lst[min(rl * 256 + i * 32 + srow, cnt - 1)] >> 1;
    f4 acc[8][4];
    gemm256([&](int i) { return P.hx + (size_t)tok[i] * D + sc; },
            [&](int i) { return ((i & 1) ? w3 : w1) + (size_t)((i >> 1) * 32 + srow) * 1024; },
            16, smem, acc);
    {
      const int tid2 = TIDX, lane2 = tid2 & 63, wave2 = tid2 >> 6, fr2 = lane2 & 15, fq2 = lane2 >> 4, wr2 = wave2 >> 1, wc2 = wave2 & 1;
      char* stg = smem + 98304 + wave2 * 12288;
      half_t* Hd = P.H + ((size_t)rt * 256 + wr2 * 128) * 512 + nt * 64 + wc2 * 32;
#pragma unroll
      for (int h = 0; h < 2; h++) {
#pragma unroll
        for (int ml = 0; ml < 4; ml++)
#pragma unroll
          for (int n = 0; n < 2; n++)
#pragma unroll
            for (int j = 0; j < 4; j++) {
              float a1 = acc[h * 4 + ml][n][j], a3 = acc[h * 4 + ml][n + 2][j];
              *(half_t*)(stg + (ml * 16 + fq2 * 4 + j) * 80 + (n * 16 + fr2) * 2) = (half_t)(a1 * sigmoidf_(a1) * a3);
            }
        __builtin_amdgcn_wave_barrier();
#pragma unroll
        for (int i = 0; i < 4; i++) {
          const int c = i * 64 + lane2, row = c >> 2, c16 = c & 3;
          h8 v = *(const h8*)(stg + row * 80 + c16 * 16);
          *(h8*)(Hd + (size_t)(h * 64 + row) * 512 + c16 * 8) = v;
        }
        __builtin_amdgcn_wave_barrier();
      }
    }
  }
}
DI void moe_e2_phase(const Params& P, int l, char* smem, int* tb) {
  const int tid = TIDX, lane = tid & 63, wave = tid >> 6, fr = lane & 15, fq = lane >> 4, wr = wave >> 1, wc = wave & 1;
  moe_prefix(P, l, tb);
  const int sc = slot_col(), srow = tid >> 3;
#pragma unroll 1
  for (int it = 0;; it++) {
    int rt, nt;
    if (!xcd_tile(it, tb[32], 8, rt, nt)) break;
    if (rt >= tb[32]) continue;
    asm volatile("" : "+s"(rt), "+s"(nt));
    int e = 0;
    while (tb[e + 1] <= rt) e++;
    const int rl = rt - tb[e], cnt = P.cnt[l * 32 + e];
    const int* lst = P.list + (size_t)e * LCAP;
    f4 acc[8][4];
    {
      const half_t* a0 = P.H + ((size_t)rt * 256 + srow) * 512 + sc;
      const half_t* b0 = P.Wt2 + ((size_t)(l * 32 + e) * 1024 + nt * 128 + srow) * 512 + sc;
      gemm256([&](int i) { return a0 + (size_t)i * 32 * 512; }, [&](int i) { return b0 + (size_t)i * 32 * 512; }, 8, smem, acc);
    }
    {
      const int tid2 = TIDX, wave2 = tid2 >> 6, wr2 = wave2 >> 1, wc2 = wave2 & 1;
      char* stg = smem + 98304 + wave2 * 12288;
      float wrow = 0.f;
      wave_store_tile([&](int m, int n, int j) { return acc[m][n][j]; }, stg,
        [&](int r) -> half_t* {
          const int idx = rl * 256 + wr2 * 128 + r;
          if (idx >= cnt) return nullptr;
          const int a = lst[idx]; wrow = P.tokW[a];
          return P.yA + (size_t)a * D + nt * 128 + wc2 * 64;
        },
        [&](int, h8& v) {
#pragma unroll
          for (int u = 0; u < 8; u++) v[u] = (half_t)(wrow * (float)v[u]);
        });
    }
  }
}

DI int swap23(int x) { return (x & ~12) | ((x & 4) << 1) | ((x & 8) >> 1); }
DI void attn_item(const Params& P, int l, int b, int head, int row0, int nkeys, char* smem) {
  const int tid = TIDX, lane = tid & 63, wave = tid >> 6, ql = lane & 31, hh = lane >> 5;
  const float lam = P.consts[l * 4 + 0], negc = -P.consts[l * 4 + 1], lam_init = P.consts[l * 4 + 2];
  const int myrow = row0 + wave * 32 + ql;
  h8 qf[2][4];
  {
    const half_t* qp = P.q + (size_t)myrow * 512 + head * 128 + hh * 8;
#pragma unroll
    for (int m = 0; m < 2; m++)
#pragma unroll
      for (int s = 0; s < 4; s++) { qf[m][s] = *(const h8*)(qp + m * 64 + s * 16); }
#pragma unroll
    for (int m = 0; m < 2; m++)
#pragma unroll
      for (int s = 0; s < 4; s++) tie(qf[m][s]);
  }
  f16v o0[4], o1[4];
#pragma unroll
  for (int dt = 0; dt < 4; dt++)
#pragma unroll
    for (int i = 0; i < 16; i++) { o0[dt][i] = 0.f; o1[dt][i] = 0.f; }
  float ls0 = 0.f, ls1 = 0.f;
  const half_t* kp[4]; const half_t* vp[4];
  {
    const half_t* kbase = P.kall + (size_t)b * KV * 512 + head * 128;
    const half_t* vbase = P.vT + (size_t)(b * 4 + head) * 128 * KV;
#pragma unroll
    for (int i = 0; i < 4; i++) {
      int s = i * 256 + tid;
      int row = s >> 4, c = (s & 15) ^ (row & 15); kp[i] = kbase + (size_t)row * 512 + c * 8;
      int vr = s >> 3, vc = (s & 7) ^ ((vr >> 1) & 7); vp[i] = vbase + (size_t)vr * KV + vc * 8;
    }
  }
  const int ntile = nkeys >> 6;
  const unsigned sbase = lds_addr(smem);
  auto issue = [&](int t) {
    char* d = smem + (t % 3) * 32768 + tid * 16;
#pragma unroll
    for (int i = 0; i < 4; i++) { glds16(kp[i] + (size_t)t * 64 * 512, d + i * 4096); glds16(vp[i] + t * 64, d + 16384 + i * 4096); }
  };
  unsigned koff[2];
  const int kr_lo = swap23(ql), ksw = kr_lo & 15;
  koff[0] = kr_lo * 256; koff[1] = (32 + kr_lo) * 256;
  unsigned voff[4];
#pragma unroll
  for (int dt = 0; dt < 4; dt++) { int vrow = dt * 32 + ql; voff[dt] = 16384 + vrow * 128; }
  const int vsw = (ql >> 1) & 7;
  h8 pp0[2], pp1[2];
  unsigned pendV = 0; int pendkt = 0; bool pend = false;
  issue(0);
#pragma unroll 1
  for (int t = 0; t < ntile; t++) {
    wait_vm0();
    raw_barrier();
    if (t + 1 < ntile) issue(t + 1);
    const unsigned cur = sbase + (t % 3) * 32768;
#pragma unroll 1
    for (int kt = 0; kt < 2; kt++) {
      h8 kf[8];
#pragma unroll
      for (int st = 0; st < 4; st++) {
        kf[st] = lds128(cur + koff[kt] + (((st * 2 + hh) ^ ksw) << 4));
        kf[4 + st] = lds128(cur + koff[kt] + (((8 + st * 2 + hh) ^ ksw) << 4));
      }
      h8 vf[8];
      if (pend) {
#pragma unroll
        for (int sp = 0; sp < 2; sp++)
#pragma unroll
          for (int dt = 0; dt < 4; dt++) vf[sp * 4 + dt] = lds128(pendV + voff[dt] + (((pendkt * 4 + sp * 2 + hh) ^ vsw) << 4));
      }
      if (pend) WAIT_LGKM(8); else WAIT_LGKM(0);
#pragma unroll
      for (int i = 0; i < 8; i++) tie(kf[i]);
      f16v s0, s1;
#pragma unroll
      for (int i = 0; i < 16; i++) { s0[i] = negc; s1[i] = negc; }
#pragma unroll
      for (int st = 0; st < 4; st++) { s0 = mfma32(kf[st], qf[0][st], s0); s1 = mfma32(kf[4 + st], qf[1][st], s1); }
      if (pend) {
        WAIT_LGKM(0);
#pragma unroll
        for (int i = 0; i < 8; i++) tie(vf[i]);
#pragma unroll
        for (int sp = 0; sp < 2; sp++)
#pragma unroll
          for (int dt = 0; dt < 4; dt++) { o0[dt] = mfma32(vf[sp * 4 + dt], pp0[sp], o0[dt]); o1[dt] = mfma32(vf[sp * 4 + dt], pp1[sp], o1[dt]); }
      }
#pragma unroll
      for (int i = 0; i < 16; i++) { s0[i] = __builtin_amdgcn_exp2f(s0[i]); ls0 += s0[i]; s1[i] = __builtin_amdgcn_exp2f(s1[i]); ls1 += s1[i]; }
#pragma unroll
      for (int sp = 0; sp < 2; sp++) {
        u4 a, c;
        a[0] = pk2(s0[8*sp+0], s0[8*sp+1]); a[1] = pk2(s0[8*sp+2], s0[8*sp+3]); a[2] = pk2(s0[8*sp+4], s0[8*sp+5]); a[3] = pk2(s0[8*sp+6], s0[8*sp+7]);
        c[0] = pk2(s1[8*sp+0], s1[8*sp+1]); c[1] = pk2(s1[8*sp+2], s1[8*sp+3]); c[2] = pk2(s1[8*sp+4], s1[8*sp+5]); c[3] = pk2(s1[8*sp+6], s1[8*sp+7]);
        pp0[sp] = __builtin_bit_cast(h8, a); pp1[sp] = __builtin_bit_cast(h8, c);
      }
      pend = true; pendV = cur; pendkt = kt;
    }
  }
  {
    h8 vf[8];
#pragma unroll
    for (int sp = 0; sp < 2; sp++)
#pragma unroll
      for (int dt = 0; dt < 4; dt++) vf[sp * 4 + dt] = lds128(pendV + voff[dt] + (((pendkt * 4 + sp * 2 + hh) ^ vsw) << 4));
    WAIT_LGKM(0);
#pragma unroll
    for (int i = 0; i < 8; i++) tie(vf[i]);
#pragma unroll
    for (int sp = 0; sp < 2; sp++)
#pragma unroll
      for (int dt = 0; dt < 4; dt++) { o0[dt] = mfma32(vf[sp * 4 + dt], pp0[sp], o0[dt]); o1[dt] = mfma32(vf[sp * 4 + dt], pp1[sp], o1[dt]); }
  }
  raw_barrier();
  ls0 += shx(ls0, 32); ls1 += shx(ls1, 32);
  const float i0 = 1.f / ls0, i1 = lam / ls1;
  float ss = 0.f;
#pragma unroll
  for (int dt = 0; dt < 4; dt++)
#pragma unroll
    for (int i = 0; i < 16; i++) { float v = o0[dt][i] * i0 - o1[dt][i] * i1; o0[dt][i] = v; ss += v * v; }
  ss += shx(ss, 32);
  const float mult = rsqrtf(ss * (1.f / 128.f) + EPS) * (1.f - lam_init);
  const float* sg = P.subln_g + l * 128;
  half_t* dst = P.mix + (size_t)myrow * D + 256 + head * 128;
#pragma unroll
  for (int dt = 0; dt < 4; dt++)
#pragma unroll
    for (int g = 0; g < 4; g++) {
      const int d0 = dt * 32 + 8 * g + 4 * hh;
      float4 gv = *(const float4*)(sg + d0);
      h4 o; o[0] = (half_t)(o0[dt][4*g] * mult * gv.x); o[1] = (half_t)(o0[dt][4*g+1] * mult * gv.y);
      o[2] = (half_t)(o0[dt][4*g+2] * mult * gv.z); o[3] = (half_t)(o0[dt][4*g+3] * mult * gv.w);
      *(h4*)(dst + d0) = o;
    }
}

DI int swz128(int row, int colh) { return row * 128 + ((((colh >> 3)) ^ ((row >> 1) & 7)) << 4) + (colh & 7) * 2; }
DI void lru_load_w(const Params& P, int l, int g, char* Wt) {
  const int tid = TIDX;
  for (int dg = 0; dg < 4; dg++) {
    const int dir = dg >> 1;
    const float* w = ((dg & 1) ? P.gate_x_w : P.gate_a_w) + ((size_t)((l * 2 + dir) * 4 + g)) * 4096;
    for (int idx = tid; idx < 4096; idx += 256) { int i = idx >> 6, o = idx & 63; *(half_t*)(Wt + dg * 8192 + swz128(o, i)) = (half_t)w[idx]; }
  }
}
DI void lru_tile(const Params& P, int l, int b, int tile, int g, char* smem, bool final) {
  const int tid = TIDX, lane = tid & 63, wave = tid >> 6, fr = lane & 15, fq = lane >> 4;
  char* Wt = smem;
  char* xr16 = smem + 32768;
  float2* ab = (float2*)(smem + 40960);
  half_t* raw = (half_t*)(smem + 40960);
  float2* subst = (float2*)(smem + 73728);
  const int ch = tid & 63, tq = tid >> 6, gc = g * 64 + ch;
  const int T = tile < 4 ? CL : SEQ;
  const int t0 = tile < 4 ? tile * 64 : (tile - 4) * 64;
  const int rowbase = tile < 4 ? b * CL : TC + b * SEQ;
  __syncthreads();
  for (int idx = tid; idx < 67 * 8; idx += 256) {
    int row = idx >> 3, c = idx & 7, tt = t0 - 1 + row;
    h8 v = {0, 0, 0, 0, 0, 0, 0, 0};
    if (tt >= 0 && tt < T) v = *(const h8*)(P.rr + (size_t)(rowbase + tt) * 256 + g * 64 + c * 8);
    *(h8*)(raw + row * 64 + c * 8) = v;
  }
  float gyv[16];
  if (final) {
#pragma unroll
    for (int e = 0; e < 16; e++) gyv[e] = (float)P.gy[(size_t)(rowbase + t0 + tq * 16 + e) * 256 + gc];
  }
  const float cw0 = P.conv_w[(l * 4 + 0) * 256 + gc], cw1 = P.conv_w[(l * 4 + 1) * 256 + gc], cw2 = P.conv_w[(l * 4 + 2) * 256 + gc],
              cw3 = P.conv_w[(l * 4 + 3) * 256 + gc], cb = P.conv_b[l * 256 + gc];
  __syncthreads();
  {
    float v[19];
#pragma unroll
    for (int e = 0; e < 19; e++) v[e] = (float)raw[(tq * 16 + e) * 64 + ch];
    __syncthreads();
#pragma unroll
    for (int e = 0; e < 16; e++) {
      float xv = cb + cw0 * v[e] + cw1 * v[e + 1] + cw2 * v[e + 2] + cw3 * v[e + 3];
      *(half_t*)(xr16 + swz128(tq * 16 + e, ch)) = (half_t)xv;
    }
  }
  __syncthreads();
  float hsum[16];
#pragma unroll
  for (int e = 0; e < 16; e++) hsum[e] = 0.f;
#pragma unroll 1
  for (int dir = 0; dir < 2; dir++) {
    {
      f4 acc[2][4];
#pragma unroll
      for (int gt = 0; gt < 2; gt++)
#pragma unroll
        for (int n = 0; n < 4; n++) acc[gt][n] = (f4){0.f, 0.f, 0.f, 0.f};
#pragma unroll
      for (int kk = 0; kk < 2; kk++) {
        int row = wave * 16 + fr;
        h8 af = *(const h8*)(xr16 + row * 128 + (((kk * 4 + fq) ^ ((row >> 1) & 7)) << 4));
#pragma unroll
        for (int gt = 0; gt < 2; gt++)
#pragma unroll
          for (int n = 0; n < 4; n++) {
            int orow = n * 16 + fr;
            h8 bf = *(const h8*)(Wt + (dir * 2 + gt) * 8192 + orow * 128 + (((kk * 4 + fq) ^ ((orow >> 1) & 7)) << 4));
            acc[gt][n] = mfma16(af, bf, acc[gt][n]);
          }
      }
#pragma unroll
      for (int n = 0; n < 4; n++) {
        const int cc = (l * 2 + dir) * 256 + g * 64 + n * 16 + fr;
        const float ba = P.gate_a_b[cc], bx = P.gate_x_b[cc];
        const float sp8 = -8.f * log1pf(__expf(-P.lru_lambda[cc]));
#pragma unroll
        for (int j = 0; j < 4; j++) {
          int tl = wave * 16 + fq * 4 + j, c2 = n * 16 + fr;
          float xv = (float)*(const half_t*)(xr16 + swz128(tl, c2));
          float rg = sigmoidf_(acc[0][n][j] + ba), ig = sigmoidf_(acc[1][n][j] + bx);
          float log_a = rg * sp8;
          float a = __expf(log_a);
          float x2 = 2.f * log_a;
          float om = -x2 * (1.f + x2 * (0.5f + x2 * (0.16666667f + x2 * (0.041666668f + x2 * (0.008333334f + x2 * 0.0013888889f)))));
          om = x2 < -0.4f ? 1.f - a * a : om;
          ab[tl * 64 + c2] = make_float2(a, sqrtf(om) * (ig * xv));
        }
      }
    }
    __syncthreads();
    float2 av[16];
    {
      float A = 1.f, h = 0.f;
#pragma unroll
      for (int e = 0; e < 16; e++) {
        int ee = dir == 0 ? e : 15 - e;
        av[e] = ab[(tq * 16 + ee) * 64 + ch];
        h = av[e].x * h + av[e].y; A *= av[e].x;
      }
      subst[tq * 64 + ch] = make_float2(A, h);
    }
    __syncthreads();
    const size_t sidx = ((size_t)((b * 2 + dir) * 132 + tile)) * 256 + gc;
    if (!final) {
      if (tq == 0) {
        float A = 1.f, h = 0.f;
#pragma unroll
        for (int s = 0; s < 4; s++) { float2 ss = subst[(dir == 0 ? s : 3 - s) * 64 + ch]; h = ss.x * h + ss.y; A *= ss.x; }
        P.lsum[sidx] = make_float2(A, h);
      }
    } else {
      float h = P.lcar[sidx];
      if (dir == 0) { for (int s = 0; s < tq; s++) { float2 ss = subst[s * 64 + ch]; h = ss.x * h + ss.y; } }
      else { for (int s = 3; s > tq; s--) { float2 ss = subst[s * 64 + ch]; h = ss.x * h + ss.y; } }
#pragma unroll
      for (int e = 0; e < 16; e++) {
        int ee = dir == 0 ? e : 15 - e;
        h = av[e].x * h + av[e].y;
#pragma unroll
        for (int q = 0; q < 16; q++) hsum[q] += (q == ee) ? h : 0.f;
      }
    }
    __syncthreads();
  }
  if (final) {
#pragma unroll
    for (int e = 0; e < 16; e++)
      P.mix[(size_t)(rowbase + t0 + tq * 16 + e) * D + 768 + gc] = (half_t)(gyv[e] * hsum[e]);
  }
}
DI void lru_carry_item(const Params& P, int it) {
  const int ch = TIDX, dir = it & 1;
  const size_t base = (size_t)it * 132 * 256 + ch;
  float c = 0.f;
#pragma unroll 4
  for (int k = 0; k < 132; k++) {
    int tile = dir == 0 ? k : (k < 4 ? 3 - k : 135 - k);
    float2 s = P.lsum[base + (size_t)tile * 256];
    P.lcar[base + (size_t)tile * 256] = c;
    c = s.x * c + s.y;
  }
}

DI void fft_load(const half_t* src, size_t rs, int nrows, char* Bt, int rowbytes, int k0) {
  for (int idx = TIDX; idx < nrows * 16; idx += 256) {
    int kr = idx >> 4, cc = idx & 15, k = k0 + kr;
    h8 v = *(const h8*)(src + (size_t)kr * rs + cc * 8);
#pragma unroll
    for (int u = 0; u < 8; u++) { int n = cc * 8 + u; *(half_t*)(Bt + n * rowbytes + ((((k >> 3)) ^ (n & 15)) << 4) + (k & 7) * 2) = v[u]; }
  }
}
template <class RF>
DI void fft_mma(const half_t* Dm, int ldD, int nkk, const char* Bt, int rowbytes, f4 (&acc)[4][4], RF arow) {
  const int lane = TIDX & 63, wave = TIDX >> 6, fr = lane & 15, fq = lane >> 4, wc = wave & 1;
#pragma unroll 1
  for (int kk = 0; kk < nkk; kk++) {
    h8 af[4], bf[4];
#pragma unroll
    for (int ms = 0; ms < 4; ms++) af[ms] = *(const h8*)(Dm + (size_t)arow(ms) * ldD + kk * 32 + fq * 8);
#pragma unroll
    for (int ns = 0; ns < 4; ns++) { int n = wc * 64 + ns * 16 + fr; bf[ns] = *(const h8*)(Bt + n * rowbytes + (((kk * 4 + fq) ^ (n & 15)) << 4)); }
#pragma unroll
    for (int ms = 0; ms < 4; ms++)
#pragma unroll
      for (int ns = 0; ns < 4; ns++) acc[ms][ns] = mfma16(af[ms], bf[ns], acc[ms][ns]);
  }
}
DI void zero44(f4 (&acc)[4][4]) {
#pragma unroll
  for (int m = 0; m < 4; m++)
#pragma unroll
    for (int n = 0; n < 4; n++) acc[m][n] = (f4){0.f, 0.f, 0.f, 0.f};
}
DI void fftA_item(const Params& P, int it, char* smem) {
  const int b = it >> 8, bb = (it >> 1) & 127, chh = it & 1;
  const int lane = TIDX & 63, wave = TIDX >> 6, fr = lane & 15, fq = lane >> 4, wr = wave >> 1, wc = wave & 1;
  __syncthreads();
  fft_load(P.QF + (size_t)(TC + b * SEQ + bb) * 512 + chh * 128, (size_t)128 * 512, 64, smem, 256, 0);
  fft_load(P.QF + (size_t)(TC + b * SEQ + bb) * 512 + 256 + chh * 128, (size_t)128 * 512, 64, smem, 256, 64);
  __syncthreads();
  f4 acc[4][4]; zero44(acc);
  fft_mma(P.DA, 128, 4, smem, 256, acc, [&](int ms) { return (ms >> 1) * 64 + wr * 32 + (ms & 1) * 16 + fr; });
#pragma unroll
  for (int ms = 0; ms < 2; ms++)
#pragma unroll
    for (int j = 0; j < 4; j++) {
      const int f1 = wr * 32 + ms * 16 + fq * 4 + j;
      const float2 w = P.tw[(bb * f1) & 8191];
      half_t* d0 = P.GA + ((size_t)(b * 64 + f1) * 256 + bb) * 256 + chh * 128 + wc * 64 + fr;
#pragma unroll
      for (int ns = 0; ns < 4; ns++) {
        float gr = acc[ms][ns][j], gi = acc[ms + 2][ns][j];
        d0[ns * 16] = (half_t)(gr * w.x + gi * w.y);
        d0[(size_t)128 * 256 + ns * 16] = (half_t)(gi * w.x - gr * w.y);
      }
    }
}
DI void fftB_item(const Params& P, int it, char* smem) {
  const int b = it >> 7, f1 = (it >> 1) & 63, chh = it & 1;
  const int lane = TIDX & 63, wave = TIDX >> 6, fr = lane & 15, fq = lane >> 4, wr = wave >> 1, wc = wave & 1;
  __syncthreads();
  fft_load(P.GA + (size_t)(b * 64 + f1) * 256 * 256 + chh * 128, 256, 256, smem, 512, 0);
  __syncthreads();
  f4 acc[4][4]; zero44(acc);
  fft_mma(P.DB, 256, 8, smem, 512, acc, [&](int ms) { return wr * 64 + ms * 16 + fr; });
#pragma unroll
  for (int ms = 0; ms < 4; ms++)
#pragma unroll
    for (int j = 0; j < 4; j++) {
      const int f2 = wr * 64 + ms * 16 + fq * 4 + j;
      half_t* d0 = P.mix + (size_t)(TC + b * SEQ + f1 + 64 * f2) * D + chh * 128 + wc * 64 + fr;
#pragma unroll
      for (int ns = 0; ns < 4; ns++) d0[ns * 16] = (half_t)acc[ms][ns][j];
    }
}
DI void fftC_item(const Params& P, int it, char* smem) {
  const int b = it >> 1, chh = it & 1;
  const int lane = TIDX & 63, wave = TIDX >> 6, fr = lane & 15, fq = lane >> 4, wr = wave >> 1, wc = wave & 1;
#pragma unroll 1
  for (int mh = 0; mh < 2; mh++) {
    f4 acc[4][4]; zero44(acc);
#pragma unroll 1
    for (int part = 0; part < 2; part++) {
      __syncthreads();
      fft_load(P.QF + (size_t)(b * CL) * 512 + part * 256 + chh * 128, 512, 256, smem, 512, 0);
      __syncthreads();
      fft_mma(P.DC + part * 256, 512, 8, smem, 512, acc, [&](int ms) { return mh * 128 + wr * 64 + ms * 16 + fr; });
    }
#pragma unroll
    for (int ms = 0; ms < 4; ms++)
#pragma unroll
      for (int j = 0; j < 4; j++) {
        const int f = mh * 128 + wr * 64 + ms * 16 + fq * 4 + j;
        half_t* d0 = P.mix + (size_t)(b * CL + f) * D + chh * 128 + wc * 64 + fr;
#pragma unroll
        for (int ns = 0; ns < 4; ns++) d0[ns * 16] = (half_t)acc[ms][ns][j];
      }
  }
}

#ifndef MX
#define MX 15
#endif
DI void mix_phase(const Params& P, int l, char* smem, int* s_item, int qi) {
  const int nL = 0, nA = 0, nC = l == 0 ? 64 : 0, nFA = 2048, nFC = l == 0 ? 16 : 0;
  const int total = nL + nA + nC + nFA + nFC;
  {
    const int g = blockIdx.x & 3;
    lru_load_w(P, l, g, smem);
    for (int u = blockIdx.x >> 2; u < NB_ * 132; u += gridDim.x >> 2) lru_tile(P, l, u / 132, u % 132, g, smem, false);
  }
  int stage = 0;
  for (;;) {
    __syncthreads();
    if (TIDX == 0) *s_item = stage == 0 ? atomicAdd(&P.qctr[8 + qi * 8 + (blockIdx.x & 7)], 1) : atomicAdd(&P.qctr[qi], 1);
    __syncthreads();
    int it = *s_item;
    int kind = -1, b = 0, head = 0, row0 = 0, nk = 0;
    if (stage == 0) {
      if (it >= 256) { stage = 1; continue; }
      const int pair = (blockIdx.x & 7) + 8 * (it >> 6);
      b = pair >> 2; head = pair & 3; row0 = TC + b * SEQ + (it & 63) * 128; nk = KV; kind = 0;
    } else {
      if (it >= total) break;
      if (it < nC) { b = it >> 3; head = (it >> 1) & 3; row0 = b * CL + (it & 1) * 128; nk = CL; kind = 0; }
      else if (it < nC + nFA) { kind = 1; it -= nC; }
      else { kind = 2; it -= nC + nFA; }
    }
    if (kind == 0) attn_item(P, l, b, head, row0, nk, smem);
    else if (kind == 1) fftA_item(P, it, smem);
    else fftC_item(P, it, smem);
  }
}

__global__ void __launch_bounds__(256, 1) fwd_megakernel(Params Pin) {
  Params P = Pin; bind_ws(P);
  __shared__ __attribute__((aligned(16))) char smem[147456];
  __shared__ int tb[33];
  __shared__ int s_item;
  cg::grid_group grid = cg::this_grid();
#ifndef PH
#define PH 0xFFFF
#endif
#if PH & 1
  phase0(P, smem);
#endif
  grid.sync();
  for (int l = 0; l < 2; l++) {
#if PH & 2
    row1_phase(P, l == 0 ? -1 : 0, l, 0);
#endif
    grid.sync();
#if PH & 4
    gemm_in_phase(P, l, smem);
#ifdef DUP_GEMM
    grid.sync();
    gemm_in_phase(P, l, smem);
#endif
#endif
    grid.sync();
#if PH & 8
    mix_phase(P, l, smem, &s_item, l);
#ifdef DUP_MIX
    grid.sync();
    mix_phase(P, l, smem, &s_item, 2 + l);
#endif
#endif
    grid.sync();
#if PH & 16
    if (blockIdx.x >= gridDim.x - 16) lru_carry_item(P, gridDim.x - 1 - blockIdx.x);
    for (int it = blockIdx.x; it < 1024; it += gridDim.x) fftB_item(P, it, smem);
#endif
    grid.sync();
#if PH & 512
    {
      const int g = blockIdx.x & 3;
      __syncthreads();
      lru_load_w(P, l, g, smem);
      for (int u = blockIdx.x >> 2; u < NB_ * 132; u += gridDim.x >> 2) lru_tile(P, l, u / 132, u % 132, g, smem, true);
    }
#endif
    grid.sync();
#if PH & 32
    gemm_out_phase(P, l, smem);
#endif
    grid.sync();
#if PH & 64
    row2_phase(P, l, l == 0 ? 0 : TC, smem);
#endif
    grid.sync();
#if PH & 128
    moe_e1_phase(P, l, smem, tb);
#ifdef DUP_GEMM
    grid.sync();
    moe_e1_phase(P, l, smem, tb);
#endif
#endif
    grid.sync();
#if PH & 256
    moe_e2_phase(P, l, smem, tb);
#ifdef DUP_GEMM
    grid.sync();
    moe_e2_phase(P, l, smem, tb);
#endif
#endif
    grid.sync();
  }
#if PH & 2
  row1_phase(P, 1, -1, TC);
#endif
}

extern "C" void kernel_launch(void* const* d_in, const int* in_sizes, int n_in, void* d_out, int out_size, void* d_ws, size_t ws_size,
                              hipStream_t stream) {
  static int grid_blocks = 0;
  if (!grid_blocks) {
    int dev = 0, cus = 0, per_cu = 0;
    hipGetDevice(&dev);
    hipDeviceGetAttribute(&cus, hipDeviceAttributeMultiprocessorCount, dev);
    hipOccupancyMaxActiveBlocksPerMultiprocessor(&per_cu, fwd_megakernel, 256, 0);
    if (per_cu > 2) per_cu = 2;
    grid_blocks = cus * per_cu;
  }
  Params p{};
  const float** pin = (const float**)&p;
  for (int i = 0; i < 31; i++) pin[i] = (const float*)d_in[i];
  p.out = (float*)d_out;
  p.ws = (char*)d_ws;
  if (WS_NEED > ws_size) { fprintf(stderr, "workspace too small: need %zu have %zu\n", (size_t)WS_NEED, ws_size); return; }
  void* args[] = {&p};
  hipError_t e = hipLaunchCooperativeKernel((void*)fwd_megakernel, dim3(grid_blocks), dim3(256), args, 0, stream);
  if (e != hipSuccess) fprintf(stderr, "cooperative launch failed: %s (grid %d)\n", hipGetErrorString(e), grid_blocks);
}
```

```cpp
#include <hip/hip_runtime.h>
#include <hip/hip_cooperative_groups.h>
#include <cstdio>
namespace cg = cooperative_groups;

typedef _Float16 half_t;
typedef _Float16 h8 __attribute__((ext_vector_type(8)));
typedef _Float16 h4 __attribute__((ext_vector_type(4)));
typedef __fp16 fp16x2 __attribute__((ext_vector_type(2)));
typedef unsigned u4 __attribute__((ext_vector_type(4)));
typedef float f4 __attribute__((ext_vector_type(4)));
typedef float f16v __attribute__((ext_vector_type(16)));
#define DI __device__ __forceinline__
__device__ __forceinline__ int tid_opaque() { int t = threadIdx.x; asm volatile("" : "+v"(t)); return t; }
#define TIDX tid_opaque()

constexpr int D = 1024, NB_ = 8, SEQ = 8192, CL = 256;
constexpr int TC = NB_ * CL;
constexpr int TX = NB_ * SEQ;
constexpr int TA = TC + TX;
constexpr int KV = CL + SEQ;
constexpr int NIN = 2560;
constexpr int LCAP = 2 * TA;
constexpr float EPS = 1e-6f;

struct Params {
  const float *x, *c, *ctx, *c_ctx, *w_mod, *b_mod, *norm1_g, *norm2_g, *w_in, *q_norm_g, *k_norm_g, *lq1, *lk1, *lq2, *lk2,
      *subln_g, *conv_w, *conv_b, *gate_a_w, *gate_a_b, *gate_x_w, *gate_x_b, *lru_lambda, *w_out, *w_group, *b_group,
      *w_router, *b_router, *w1, *w3, *w2;
  float* out; char* ws;
  half_t *WtIn, *WtOut, *Wt1, *Wt3, *Wt2;
  float* mod; float2* rope; float2* tw; half_t *DA, *DB, *DC; float* consts; int* cnt; int* qctr; float* tokW; int* list;
  float* xcbuf; half_t* WrH;
  half_t *hx, *mix, *q, *kall, *vT, *QF, *gy, *rr; float2* lsum; float* lcar; half_t* GA; half_t *H, *yA;
};


constexpr size_t al256(size_t x) { return (x + 255) & ~(size_t)255; }
constexpr size_t O_WtIn = 0;
constexpr size_t O_WtOut = O_WtIn + al256((size_t)2 * NIN * 1024 * 2);
constexpr size_t O_Wt1 = O_WtOut + al256((size_t)2 * 1024 * 1024 * 2);
constexpr size_t O_Wt3 = O_Wt1 + al256((size_t)64 * 524288 * 2);
constexpr size_t O_Wt2 = O_Wt3 + al256((size_t)64 * 524288 * 2);
constexpr size_t O_mod = O_Wt2 + al256((size_t)64 * 524288 * 2);
constexpr size_t O_rope = O_mod + al256((size_t)2 * 9 * 6144 * 4);
constexpr size_t O_tw = O_rope + al256(128 * 16 * 8);
constexpr size_t O_DA = O_tw + al256(8192 * 8);
constexpr size_t O_DB = O_DA + al256(16384 * 2);
constexpr size_t O_DC = O_DB + al256(32768 * 2);
constexpr size_t O_consts = O_DC + al256(131072 * 2);
constexpr size_t O_cnt = O_consts + 256;
constexpr size_t O_qctr = O_cnt + 256;
constexpr size_t O_bar = O_qctr + 256;
constexpr size_t O_tokW = O_bar + 256;
constexpr size_t O_list = O_tokW + al256((size_t)2 * TA * 4);
constexpr size_t O_xcbuf = O_list + al256((size_t)32 * LCAP * 4);
constexpr size_t O_WrT = O_xcbuf + al256((size_t)TC * D * 4);
constexpr size_t O_hx = O_WrT + al256((size_t)2 * 2 * 48 * 1024 * 2);
constexpr size_t O_mix = O_hx + al256((size_t)TA * D * 2);
constexpr size_t O_regB = O_mix + al256((size_t)TA * D * 2);
constexpr size_t O_q = O_regB;
constexpr size_t O_kall = O_q + al256((size_t)TA * 512 * 2);
constexpr size_t O_vT = O_kall + al256((size_t)NB_ * KV * 512 * 2);
constexpr size_t O_QF = O_vT + al256((size_t)NB_ * 4 * 128 * KV * 2);
constexpr size_t O_gy = O_QF + al256((size_t)TA * 512 * 2);
constexpr size_t O_rr = O_gy + al256((size_t)TA * 256 * 2);
constexpr size_t O_lsum = O_rr + al256((size_t)TA * 256 * 2);
constexpr size_t O_lcar = O_lsum + al256((size_t)16 * 132 * 256 * 8);
constexpr size_t O_GA = O_lcar + al256((size_t)16 * 132 * 256 * 4);
constexpr size_t O_mixer_end = O_GA + al256((size_t)NB_ * 64 * 256 * 256 * 2);
constexpr size_t O_H = O_regB;
constexpr size_t O_yA = O_H + al256((size_t)(2 * TA + 32 * 256) * 512 * 2);
constexpr size_t O_moe_end = O_yA + al256((size_t)2 * TA * D * 2);
constexpr size_t WS_NEED = O_mixer_end > O_moe_end ? O_mixer_end : O_moe_end;
DI void bind_ws(Params& P) {
  char* w = P.ws;
  P.WtIn = (half_t*)(w + O_WtIn); P.WtOut = (half_t*)(w + O_WtOut); P.Wt1 = (half_t*)(w + O_Wt1); P.Wt3 = (half_t*)(w + O_Wt3); P.Wt2 = (half_t*)(w + O_Wt2);
  P.mod = (float*)(w + O_mod); P.rope = (float2*)(w + O_rope); P.tw = (float2*)(w + O_tw); P.DA = (half_t*)(w + O_DA); P.DB = (half_t*)(w + O_DB); P.DC = (half_t*)(w + O_DC);
  P.consts = (float*)(w + O_consts); P.cnt = (int*)(w + O_cnt); P.qctr = (int*)(w + O_qctr); P.tokW = (float*)(w + O_tokW); P.list = (int*)(w + O_list);
  P.xcbuf = (float*)(w + O_xcbuf); P.WrH = (half_t*)(w + O_WrT); P.hx = (half_t*)(w + O_hx); P.mix = (half_t*)(w + O_mix);
  P.q = (half_t*)(w + O_q); P.kall = (half_t*)(w + O_kall); P.vT = (half_t*)(w + O_vT); P.QF = (half_t*)(w + O_QF); P.gy = (half_t*)(w + O_gy); P.rr = (half_t*)(w + O_rr);
  P.lsum = (float2*)(w + O_lsum); P.lcar = (float*)(w + O_lcar); P.GA = (half_t*)(w + O_GA); P.H = (half_t*)(w + O_H); P.yA = (half_t*)(w + O_yA);
}
DI float shx(float v, int o) { int ln = TIDX & 63; return __builtin_bit_cast(float, __builtin_amdgcn_ds_bpermute((ln ^ o) << 2, __builtin_bit_cast(int, v))); }
DI float shi(float v, int idx) { return __builtin_bit_cast(float, __builtin_amdgcn_ds_bpermute(idx << 2, __builtin_bit_cast(int, v))); }
DI float wave_sum(float v) {
#pragma unroll
  for (int o = 32; o; o >>= 1) v += shx(v, o);
  return v;
}
DI void glds16(const void* g, void* l) {
  __builtin_amdgcn_global_load_lds((const unsigned*)g, (unsigned*)l, 16, 0, 0);
}
DI void wait_vm0() { asm volatile("s_waitcnt vmcnt(0)" ::: "memory"); }
DI f4 mfma16(h8 a, h8 b, f4 c) { return __builtin_amdgcn_mfma_f32_16x16x32_f16(a, b, c, 0, 0, 0); }
DI f16v mfma32(h8 a, h8 b, f16v c) { return __builtin_amdgcn_mfma_f32_32x32x16_f16(a, b, c, 0, 0, 0); }
DI unsigned pk2(float a, float b) { fp16x2 r = __builtin_amdgcn_cvt_pkrtz(a, b); return __builtin_bit_cast(unsigned, r); }
DI float sigmoidf_(float x) { return 1.f / (1.f + __expf(-x)); }
DI float gelu_tanh(float x) {
  float u = 0.7978845608028654f * (x + 0.044715f * x * x * x);
  float e = __expf(2.f * u);
  float t = 1.f - 2.f / (e + 1.f);
  return 0.5f * x * (1.f + t);
}
DI int row_mod(int r) { return r < TC ? 8 : ((r - TC) >> 13); }

DI void transpose_tile(const float* src, int lds_, half_t* dst, int ldd, float* tile) {
  const int tid = TIDX, n = tid & 63, kq = tid >> 6;
#pragma unroll 4
  for (int i = 0; i < 16; i++) { int k = i * 4 + kq; tile[k * 65 + n] = src[(size_t)k * lds_ + n]; }
  __syncthreads();
#pragma unroll 4
  for (int i = 0; i < 16; i++) { int nn = i * 4 + kq; dst[(size_t)nn * ldd + n] = (half_t)tile[n * 65 + nn]; }
  __syncthreads();
}

DI void phase0(const Params& P, char* smem) {
  float* tile = (float*)smem;
  const int tid = TIDX;
  constexpr int NT = 26112, NF = 128, NM = 192, NX = 6;
  for (int t = blockIdx.x; t < NT + NF + NM + NX; t += gridDim.x) {
    if (t < NT) {
      const float* src; half_t* dst; int lds_, ldd;
      if (t < 1024) {
        int l = t / 512, r = t % 512, kt = r / 32, nt = r % 32;
        src = P.w_in + (size_t)l * 1024 * 2304 + (size_t)kt * 64 * 2304 + 256 + nt * 64; lds_ = 2304;
        dst = P.WtIn + (size_t)l * NIN * 1024 + (size_t)(512 + nt * 64) * 1024 + kt * 64; ldd = 1024;
      } else if (t < 1536) {
        int u = t - 1024, l = u / 256, r = u % 256, kt = r / 16, nt = r % 16;
        src = P.w_out + (size_t)l * 1048576 + (size_t)kt * 64 * 1024 + nt * 64; lds_ = 1024;
        dst = P.WtOut + (size_t)l * 1048576 + (size_t)nt * 64 * 1024 + kt * 64; ldd = 1024;
      } else if (t < 1536 + 16384) {
        int u = t - 1536; const float* w = P.w1; half_t* o = P.Wt1;
        if (u >= 8192) { u -= 8192; w = P.w3; o = P.Wt3; }
        int le = u / 128, r = u % 128, kt = r / 8, nt = r % 8;
        src = w + (size_t)le * 524288 + (size_t)kt * 64 * 512 + nt * 64; lds_ = 512;
        dst = o + (size_t)le * 524288 + (size_t)nt * 64 * 1024 + kt * 64; ldd = 1024;
      } else {
        int u = t - 1536 - 16384, le = u / 128, r = u % 128, kt = r / 16, nt = r % 16;
        src = P.w2 + (size_t)le * 524288 + (size_t)kt * 64 * 1024 + nt * 64; lds_ = 1024;
        dst = P.Wt2 + (size_t)le * 524288 + (size_t)nt * 64 * 512 + kt * 64; ldd = 512;
      }
      transpose_tile(src, lds_, dst, ldd, tile);
    } else if (t < NT + NF) {
      int f = t - NT, l = f / 64, r = f % 64, kt = r / 4, g = r % 4;
      float* cst = tile + 64 * 65; float* snt = cst + 64;
      const float* src = P.w_in + (size_t)l * 1024 * 2304 + (size_t)kt * 64 * 2304 + g * 64;
      { int n = tid & 63, kq = tid >> 6;
        for (int i = 0; i < 16; i++) { int k = i * 4 + kq; tile[k * 65 + n] = src[(size_t)k * 2304 + n]; } }
      if (tid < 64) { float s, c; sincospif((float)tid / 32.f, &s, &c); cst[tid] = c; snt[tid] = s; }
      __syncthreads();
      int k = tid & 63, jq = tid >> 6;
      half_t* o = P.WtIn + (size_t)l * NIN * 1024 + kt * 64 + k;
      for (int jj = 0; jj < 16; jj++) {
        int j = jq * 16 + jj; float ac = 0.f, as = 0.f;
        for (int c = 0; c < 64; c++) { float v = tile[k * 65 + c]; int idx = (c * j) & 63; ac += v * cst[idx]; as += v * snt[idx]; }
        o[(size_t)(g * 64 + j) * 1024] = (half_t)(ac * 0.125f);
        o[(size_t)(256 + g * 64 + j) * 1024] = (half_t)(-as * 0.125f);
      }
      __syncthreads();
    } else if (t < NT + NF + NM) {
      int mi = t - NT - NF, l = mi / 96, col0 = (mi % 96) * 64;
      float* scond = tile; float* red = tile + 9216;
      for (int idx = tid; idx < 9216; idx += 256) {
        int n = idx >> 10, k = idx & 1023; float v = n < 8 ? P.c[n * 1024 + k] : P.c_ctx[k];
        scond[idx] = v / (1.f + expf(-v));
      }
      __syncthreads();
      int col = tid & 63, kq = tid >> 6; float acc[9];
#pragma unroll
      for (int n = 0; n < 9; n++) acc[n] = 0.f;
      const float* w = P.w_mod + ((size_t)l * 1024 + kq * 256) * 6144 + col0 + col;
#pragma unroll 4
      for (int k = 0; k < 256; k++) {
        float wv = w[(size_t)k * 6144];
#pragma unroll
        for (int n = 0; n < 9; n++) acc[n] += scond[n * 1024 + kq * 256 + k] * wv;
      }
#pragma unroll
      for (int n = 0; n < 9; n++) red[(kq * 9 + n) * 64 + col] = acc[n];
      __syncthreads();
      for (int idx = tid; idx < 576; idx += 256) {
        int n = idx / 64, cc = idx % 64;
        float s = red[(0 * 9 + n) * 64 + cc] + red[(1 * 9 + n) * 64 + cc] + red[(2 * 9 + n) * 64 + cc] + red[(3 * 9 + n) * 64 + cc];
        P.mod[(size_t)(l * 9 + n) * 6144 + col0 + cc] = s + P.b_mod[l * 6144 + col0 + cc];
      }
      __syncthreads();
    } else {
      int m = t - NT - NF - NM;
      if (m == 0) {
        for (int idx = tid; idx < 128 * 16; idx += 256) {
          int pos = idx >> 4, i = idx & 15; float f = powf(10000.f, -(float)i / 16.f); float ang = (float)pos * f;
          float s, c; sincosf(ang, &s, &c); P.rope[idx] = make_float2(c, s);
        }
      } else if (m == 1) {
        for (int j = tid; j < 8192; j += 256) { float s, c; sincospif((float)j / 4096.f, &s, &c); P.tw[j] = make_float2(c, s); }
      } else if (m == 2) {
        for (int idx = tid; idx < 16384; idx += 256) {
          int mm = idx >> 7, k = idx & 127, part = mm >> 6, f1 = mm & 63, pp = k >> 6, a = k & 63;
          float s, c; sincospif((float)((a * f1) & 63) / 32.f, &s, &c);
          float v = part == 0 ? (pp == 0 ? c : s) : (pp == 0 ? -s : c);
          P.DA[idx] = (half_t)(v * 0.125f);
        }
      } else if (m == 3) {
        for (int idx = tid; idx < 32768; idx += 256) {
          int mm = idx >> 8, k = idx & 255, part = k >> 7, bb = k & 127;
          float s, c; sincospif((float)((bb * mm) & 127) / 64.f, &s, &c);
          P.DB[idx] = (half_t)((part == 0 ? c : s) * 0.08838834764831845f);
        }
      } else if (m == 4) {
        for (int idx = tid; idx < 131072; idx += 256) {
          int mm = idx >> 9, k = idx & 511, part = k >> 8, tt = k & 255;
          float s, c; sincospif((float)((tt * mm) & 255) / 128.f, &s, &c);
          P.DC[idx] = (half_t)((part == 0 ? c : s) * 0.0625f);
        }
      } else {
        for (int idx = tid; idx < 2 * 48 * 1024; idx += 256) {
          int l = idx / 49152, r = idx % 49152, col = r >> 10, k = r & 1023;
          float w = col < 4 ? P.w_group[((size_t)l * 1024 + k) * 4 + col] : (col < 36 ? P.w_router[((size_t)l * 1024 + k) * 32 + col - 4] : 0.f);
          half_t hi = (half_t)w, lo = (half_t)(w - (float)hi);
          P.WrH[(size_t)(l * 2) * 49152 + r] = hi; P.WrH[(size_t)(l * 2 + 1) * 49152 + r] = lo;
        }
        if (tid < 2) {
          int l = tid; float s1 = 0.f, s2 = 0.f, mq = 0.f, mk = 0.f;
          for (int i = 0; i < 64; i++) {
            s1 += P.lq1[l * 64 + i] * P.lk1[l * 64 + i]; s2 += P.lq2[l * 64 + i] * P.lk2[l * 64 + i];
            mq = fmaxf(mq, fabsf(P.q_norm_g[l * 64 + i])); mk = fmaxf(mk, fabsf(P.k_norm_g[l * 64 + i]));
          }
          float lam_init = 0.8f - 0.6f * expf(-0.3f * (float)l);
          P.consts[l * 4 + 0] = expf(s1) - expf(s2) + lam_init;
          P.consts[l * 4 + 1] = 8.f * mq * mk * 1.4426950408889634f * 1.002f - 15.f;
          P.consts[l * 4 + 2] = lam_init;
        }
        if (tid < 64) P.cnt[tid] = 0;
        if (tid < 64) P.qctr[tid] = 0;
      }
    }
  }
}

DI void row1_phase(const Params& P, int combine_l, int norm_l, int r_begin) {
  const int lane = TIDX & 63, gw = blockIdx.x * 4 + (TIDX >> 6), nw = gridDim.x * 4;
  for (int r = r_begin + gw; r < TA; r += nw) {
    const int n = row_mod(r);
    float v[16];
    if (combine_l < 0) {
      const float* src = r < TC ? P.ctx + (size_t)r * D : P.x + (size_t)(r - TC) * D;
#pragma unroll
      for (int i = 0; i < 4; i++) { float4 t = *(const float4*)(src + i * 256 + lane * 4); v[i*4] = t.x; v[i*4+1] = t.y; v[i*4+2] = t.z; v[i*4+3] = t.w; }
    } else {
      float* xm = r < TC ? P.xcbuf + (size_t)r * D : P.out + (size_t)(r - TC) * D;
      const float* g2 = P.mod + (size_t)(combine_l * 9 + n) * 6144 + 5 * 1024;
      const half_t* y0 = P.yA + (size_t)(2 * r) * D; const half_t* y1 = y0 + D;
#pragma unroll
      for (int i = 0; i < 4; i++) {
        int c = i * 256 + lane * 4;
        float4 t = *(const float4*)(xm + c); float4 g = *(const float4*)(g2 + c);
        h4 a = *(const h4*)(y0 + c); h4 b = *(const h4*)(y1 + c);
        t.x += g.x * ((float)a[0] + (float)b[0]); t.y += g.y * ((float)a[1] + (float)b[1]);
        t.z += g.z * ((float)a[2] + (float)b[2]); t.w += g.w * ((float)a[3] + (float)b[3]);
        *(float4*)(xm + c) = t;
        v[i*4] = t.x; v[i*4+1] = t.y; v[i*4+2] = t.z; v[i*4+3] = t.w;
      }
    }
    if (norm_l >= 0) {
      float ss = 0.f;
#pragma unroll
      for (int i = 0; i < 16; i++) ss += v[i] * v[i];
      ss = wave_sum(ss);
      const float rstd = rsqrtf(ss * (1.f / 1024.f) + EPS);
      const float* g = P.norm1_g + norm_l * 1024;
      const float* sh = P.mod + (size_t)(norm_l * 9 + n) * 6144; const float* sc = sh + 1024;
#pragma unroll
      for (int i = 0; i < 4; i++) {
        int c = i * 256 + lane * 4;
        float4 gg = *(const float4*)(g + c), s1 = *(const float4*)(sc + c), s0 = *(const float4*)(sh + c);
        h4 o;
        o[0] = (half_t)(v[i*4] * rstd * gg.x * (1.f + s1.x) + s0.x); o[1] = (half_t)(v[i*4+1] * rstd * gg.y * (1.f + s1.y) + s0.y);
        o[2] = (half_t)(v[i*4+2] * rstd * gg.z * (1.f + s1.z) + s0.z); o[3] = (half_t)(v[i*4+3] * rstd * gg.w * (1.f + s1.w) + s0.w);
        *(h4*)(P.hx + (size_t)r * D + c) = o;
      }
    }
  }
}

DI void row2_phase(const Params& P, int l, int r_begin, char* smem) {
  const int tid = TIDX, lane = tid & 63, wave = tid >> 6, fr = lane & 15, fq = lane >> 4;
  float* lg = (float*)smem + wave * 16 * 48;
  const half_t* Whi = P.WrH + (size_t)(l * 2) * 49152; const half_t* Wlo = Whi + 49152;
  const int ngroups = (TA - r_begin) >> 4, gw = blockIdx.x * 4 + wave, nw = gridDim.x * 4;
  const float* gam = P.norm2_g + l * 1024;
#pragma unroll 1
  for (int grp = gw; grp < ngroups; grp += nw) {
    const int r0 = r_begin + grp * 16, row = r0 + fr, n = row_mod(r0);
    const float* xm = (row < TC ? P.xcbuf + (size_t)row * D : P.out + (size_t)(row - TC) * D) + fq * 8;
    float ss = 0.f;
#pragma unroll 16
    for (int kk = 0; kk < 32; kk++) {
      const float4 a = *(const float4*)(xm + kk * 32), b = *(const float4*)(xm + kk * 32 + 4);
      ss += a.x * a.x + a.y * a.y + a.z * a.z + a.w * a.w + b.x * b.x + b.y * b.y + b.z * b.z + b.w * b.w;
    }
    ss += shx(ss, 16); ss += shx(ss, 32);
    const float rstd = rsqrtf(ss * (1.f / 1024.f) + EPS);
    const float* sh = P.mod + (size_t)(l * 9 + n) * 6144 + 3 * 1024 + fq * 8; const float* sc = sh + 1024;
    f4 acc[3];
#pragma unroll
    for (int i = 0; i < 3; i++) acc[i] = (f4){0.f, 0.f, 0.f, 0.f};
    half_t* hxo = P.hx + (size_t)row * D + fq * 8;
#pragma unroll 4
    for (int kk = 0; kk < 32; kk++) {
      const int k0 = kk * 32;
      float x[8], g[8], s1[8], s0[8];
      *(float4*)&x[0] = *(const float4*)(xm + k0); *(float4*)&x[4] = *(const float4*)(xm + k0 + 4);
      *(float4*)&g[0] = *(const float4*)(gam + fq * 8 + k0); *(float4*)&g[4] = *(const float4*)(gam + fq * 8 + k0 + 4);
      *(float4*)&s1[0] = *(const float4*)(sc + k0); *(float4*)&s1[4] = *(const float4*)(sc + k0 + 4);
      *(float4*)&s0[0] = *(const float4*)(sh + k0); *(float4*)&s0[4] = *(const float4*)(sh + k0 + 4);
      h8 hi, lo;
#pragma unroll
      for (int i = 0; i < 8; i++) {
        float v = x[i] * rstd * g[i] * (1.f + s1[i]) + s0[i];
        hi[i] = (half_t)v; lo[i] = (half_t)(v - (float)hi[i]);
      }
      *(h8*)(hxo + k0) = hi;
#pragma unroll
      for (int n3 = 0; n3 < 3; n3++) {
        h8 bh = *(const h8*)(Whi + (size_t)(n3 * 16 + fr) * 1024 + k0 + fq * 8);
        h8 bl = *(const h8*)(Wlo + (size_t)(n3 * 16 + fr) * 1024 + k0 + fq * 8);
        acc[n3] = mfma16(hi, bh, acc[n3]); acc[n3] = mfma16(lo, bh, acc[n3]); acc[n3] = mfma16(hi, bl, acc[n3]);
      }
    }
    __builtin_amdgcn_wave_barrier();
#pragma unroll
    for (int n3 = 0; n3 < 3; n3++)
#pragma unroll
      for (int j = 0; j < 4; j++) lg[(fq * 4 + j) * 48 + n3 * 16 + fr] = acc[n3][j];
    __builtin_amdgcn_wave_barrier();
    if (lane < 16) {
      const int r = r0 + lane;
      const float* L = lg + lane * 48;
      float gl[4]; int gi = 0;
#pragma unroll
      for (int j = 0; j < 4; j++) gl[j] = L[j] + P.b_group[l * 4 + j];
      float gm = gl[0];
#pragma unroll
      for (int j = 1; j < 4; j++) if (gl[j] > gm) { gm = gl[j]; gi = j; }
      float gs = 0.f;
#pragma unroll
      for (int j = 0; j < 4; j++) gs += expf(gl[j] - gm);
      const float pg = 1.f / gs;
      float el[8];
#pragma unroll
      for (int j = 0; j < 8; j++) el[j] = L[4 + gi * 8 + j] + P.b_router[l * 32 + gi * 8 + j];
      int i0 = 0; float v0 = el[0];
#pragma unroll
      for (int j = 1; j < 8; j++) if (el[j] > v0) { v0 = el[j]; i0 = j; }
      int i1 = -1; float v1 = -3.0e38f;
#pragma unroll
      for (int j = 0; j < 8; j++) if (j != i0 && el[j] > v1) { v1 = el[j]; i1 = j; }
      const float ex = expf(v1 - v0);
      const float w0 = pg / (1.f + ex), w1 = pg * ex / (1.f + ex);
      const int e0 = gi * 8 + i0, e1 = gi * 8 + i1;
      int p0 = atomicAdd(&P.cnt[l * 32 + e0], 1); P.list[(size_t)e0 * LCAP + p0] = 2 * r;
      int p1 = atomicAdd(&P.cnt[l * 32 + e1], 1); P.list[(size_t)e1 * LCAP + p1] = 2 * r + 1;
      P.tokW[2 * r] = w0; P.tokW[2 * r + 1] = w1;
    }
    __builtin_amdgcn_wave_barrier();
  }
}

DI h8 lds128(unsigned a) { h8 r; asm volatile("ds_read_b128 %0, %1" : "=v"(r) : "v"(a)); return r; }
DI void tie(h8& x) { asm volatile("" : "+v"(x)); }
DI unsigned lds_addr(const void* p) { return (unsigned)(size_t)p; }
#define WAIT_LGKM(n) asm volatile("s_waitcnt lgkmcnt(" #n ")" ::: "memory")
DI void raw_barrier() { asm volatile("" ::: "memory"); __builtin_amdgcn_s_barrier(); asm volatile("" ::: "memory"); }
DI void slot_rc(int i, int& row, int& coff) { int s = i * 256 + TIDX; row = s >> 3; coff = ((s & 7) ^ ((row >> 1) & 7)) * 8; }

template <class AF, class BF>
DI void gemm256(AF aptr, BF bptr, int nk, char* smem, f4 (&acc)[8][4]) {
  const int tid = TIDX, lane = tid & 63, wave = tid >> 6, fr = lane & 15, fq = lane >> 4, wr = wave >> 1, wc = wave & 1;
#pragma unroll
  for (int m = 0; m < 8; m++)
#pragma unroll
    for (int n = 0; n < 4; n++) acc[m][n] = (f4){0.f, 0.f, 0.f, 0.f};
  auto issue = [&](int kt, int st) {
    char* d = smem + st * 49152 + tid * 16;
#pragma unroll
    for (int i = 0; i < 8; i++) glds16(aptr(i) + kt * 64, d + i * 4096);
#pragma unroll
    for (int i = 0; i < 4; i++) glds16(bptr(i) + kt * 64, d + 32768 + i * 4096);
  };
  const unsigned sw = (unsigned)((fq ^ (fr >> 1)) << 4);
  const unsigned offA = (wr * 128 + fr) * 128 + sw, offB = 32768 + (wc * 64 + fr) * 128 + sw;
  const unsigned sbase = lds_addr(smem);
  issue(0, 0);
  if (nk > 1) issue(1, 1);
  int st = 0;
#pragma unroll 1
  for (int kt = 0; kt < nk; kt++) {
    if (kt + 1 < nk) asm volatile("s_waitcnt vmcnt(12)" ::: "memory"); else wait_vm0();
    raw_barrier();
    if (kt + 2 < nk) issue(kt + 2, st == 0 ? 2 : st - 1);
    const unsigned base = sbase + st * 49152;
    st = st == 2 ? 0 : st + 1;
    h8 a0[8], b0[4], a1[8], b1[4];
#pragma unroll
    for (int m = 0; m < 8; m++) a0[m] = lds128(base + offA + m * 2048);
#pragma unroll
    for (int n = 0; n < 4; n++) b0[n] = lds128(base + offB + n * 2048);
#pragma unroll
    for (int m = 0; m < 8; m++) a1[m] = lds128(base + (offA ^ 64) + m * 2048);
#pragma unroll
    for (int n = 0; n < 4; n++) b1[n] = lds128(base + (offB ^ 64) + n * 2048);
    WAIT_LGKM(12);
#pragma unroll
    for (int m = 0; m < 8; m++) tie(a0[m]);
#pragma unroll
    for (int n = 0; n < 4; n++) tie(b0[n]);
#pragma unroll
    for (int m = 0; m < 8; m++)
#pragma unroll
      for (int n = 0; n < 4; n++) acc[m][n] = mfma16(a0[m], b0[n], acc[m][n]);
    WAIT_LGKM(0);
#pragma unroll
    for (int m = 0; m < 8; m++) tie(a1[m]);
#pragma unroll
    for (int n = 0; n < 4; n++) tie(b1[n]);
#pragma unroll
    for (int m = 0; m < 8; m++)
#pragma unroll
      for (int n = 0; n < 4; n++) acc[m][n] = mfma16(a1[m], b1[n], acc[m][n]);
  }
  raw_barrier();
}
DI bool xcd_tile(int it, int MT, int NT, int& mt, int& nt) {
  const int x = blockIdx.x & 7, j = blockIdx.x >> 3;
  const int nsn = NT >> 2, nsm = (MT + 7) >> 3;
  const int s = x + 8 * it;
  if (s >= nsm * nsn) return false;
  const int sm = s / nsn, sn = s % nsn;
  mt = sm * 8 + (j >> 2); nt = sn * 4 + (j & 3);
  return true;
}
DI int slot_col() { int t = TIDX; return ((t & 7) ^ ((t >> 4) & 7)) * 8; }

DI float dpp_row_sum(float v) {
  v += __builtin_bit_cast(float, __builtin_amdgcn_update_dpp(0, __builtin_bit_cast(int, v), 0x128, 0xf, 0xf, false));
  v += __builtin_bit_cast(float, __builtin_amdgcn_update_dpp(0, __builtin_bit_cast(int, v), 0x124, 0xf, 0xf, false));
  v += __builtin_bit_cast(float, __builtin_amdgcn_update_dpp(0, __builtin_bit_cast(int, v), 0x122, 0xf, 0xf, false));
  v += __builtin_bit_cast(float, __builtin_amdgcn_update_dpp(0, __builtin_bit_cast(int, v), 0x121, 0xf, 0xf, false));
  return v;
}
DI void stage_put(char* stg, int ml, int n, int j, int fr, int fq, float v) { *(half_t*)(stg + (ml * 16 + fq * 4 + j) * 144 + (n * 16 + fr) * 2) = (half_t)v; }
template <class RP, class SC>
DI void stage_flush(char* stg, int h, RP rowptr, SC rowscale) {
  const int lane = TIDX & 63;
  __builtin_amdgcn_wave_barrier();
#pragma unroll
  for (int i = 0; i < 8; i++) {
    const int c = i * 64 + lane, row = c >> 3, c16 = c & 7;
    h8 v = *(const h8*)(stg + row * 144 + c16 * 16);
    half_t* d = rowptr(h * 64 + row);
    if (d) { rowscale(h * 64 + row, v); *(h8*)(d + c16 * 8) = v; }
  }
  __builtin_amdgcn_wave_barrier();
}
template <class VF, class RP, class SC>
DI void wave_store_tile(VF val, char* stg, RP rowptr, SC rowscale) {
  const int lane = TIDX & 63, fr = lane & 15, fq = lane >> 4;
#pragma unroll
  for (int h = 0; h < 2; h++) {
#pragma unroll
    for (int ml = 0; ml < 4; ml++)
#pragma unroll
      for (int n = 0; n < 4; n++)
#pragma unroll
        for (int j = 0; j < 4; j++) stage_put(stg, ml, n, j, fr, fq, val(h * 4 + ml, n, j));
    stage_flush(stg, h, rowptr, rowscale);
  }
}
DI void gemm_in_phase(const Params& P, int l, char* smem) {
  const int tid = TIDX;
  const half_t* Wt = P.WtIn + (size_t)l * NIN * 1024;
  const int sc = slot_col(), srow = tid >> 3;
#pragma unroll 1
  for (int it = 0;; it++) {
    int mt, nt;
    if (!xcd_tile(it, 264, 20, mt, nt)) break;
    if (mt >= 264) continue;
    asm volatile("" : "+s"(mt), "+s"(nt));
    f4 acc[8][4];
    {
      const half_t* a0 = P.hx + (size_t)(mt * 256 + srow) * D + sc; const half_t* b0 = Wt + (size_t)(nt * 128 + srow) * D + sc;
      gemm256([&](int i) { return a0 + (size_t)i * 32 * D; }, [&](int i) { return b0 + (size_t)i * 32 * D; }, 16, smem, acc);
    }
    const int tid2 = TIDX, lane = tid2 & 63, wave = tid2 >> 6, fr = lane & 15, fq = lane >> 4, wr = wave >> 1, wc = wave & 1;
    const int r0 = mt * 256 + wr * 128;
    const bool isctx = r0 < TC;
    int b, pos0;
    if (isctx) { b = r0 >> 8; pos0 = r0 & 255; } else { b = (r0 - TC) >> 13; pos0 = 256 + ((r0 - TC) & 8191); }
    char* stg = smem + 98304 + wave * 12288;
    auto noscale = [](int, h8&) {};
    if (nt < 4 || nt >= 16) {
      half_t* dst; int ld, c0; bool gel = false;
      if (nt < 4) { dst = P.QF; ld = 512; c0 = nt * 128; }
      else if (nt < 18) { dst = P.gy; ld = 256; c0 = (nt - 16) * 128; gel = true; }
      else { dst = P.rr; ld = 256; c0 = (nt - 18) * 128; }
      half_t* base = dst + (size_t)r0 * ld + c0 + wc * 64;
      if (gel) wave_store_tile([&](int m, int n, int j) { return gelu_tanh(acc[m][n][j]); }, stg, [&](int r) { return base + (size_t)r * ld; }, noscale);
      else wave_store_tile([&](int m, int n, int j) { return acc[m][n][j]; }, stg, [&](int r) { return base + (size_t)r * ld; }, noscale);
    } else if (nt < 12) {
      const bool isq = nt < 8; const int head = isq ? nt - 4 : nt - 8;
      const float* gvec = (isq ? P.q_norm_g : P.k_norm_g) + l * 64;
      const float qs = isq ? 0.125f * 1.4426950408889634f : 1.f;
      float gg[4];
#pragma unroll
      for (int n = 0; n < 4; n++) gg[n] = gvec[n * 16 + fr] * qs;
      float2 rr2[2];
      const int tp0 = pos0 - 256;
      if (!isctx) { rr2[0] = P.rope[(tp0 >> 6) * 16 + fr]; rr2[1] = P.rope[((tp0 >> 6) + 1) * 16 + fr]; }
      half_t* base = (isq ? P.q + (size_t)r0 * 512 : P.kall + ((size_t)b * KV + pos0) * 512) + head * 128 + wc * 64;
#pragma unroll
      for (int mh = 0; mh < 2; mh++) {
#pragma unroll
        for (int mm = 0; mm < 4; mm++) {
          const int m = mh * 4 + mm;
#pragma unroll
          for (int j = 0; j < 4; j++) {
            float ss = 0.f;
#pragma unroll
            for (int n = 0; n < 4; n++) ss += acc[m][n][j] * acc[m][n][j];
            ss = dpp_row_sum(ss);
            const float rstd = rsqrtf(ss * (1.f / 64.f) + EPS);
            float o[4];
#pragma unroll
            for (int n = 0; n < 4; n++) o[n] = acc[m][n][j] * rstd * gg[n];
            if (!isctx) {
              const float2 cr = rr2[mh], cc = P.rope[(mm * 16 + fq * 4 + j) * 16 + fr];
              float a0 = o[0] * cr.x - o[1] * cr.y, a1 = o[1] * cr.x + o[0] * cr.y;
              float a2 = o[2] * cc.x - o[3] * cc.y, a3 = o[3] * cc.x + o[2] * cc.y;
              o[0] = a0; o[1] = a1; o[2] = a2; o[3] = a3;
            }
#pragma unroll
            for (int n = 0; n < 4; n++) stage_put(stg, mm, n, j, fr, fq, o[n]);
          }
        }
        stage_flush(stg, mh, [&](int r) { return base + (size_t)r * 512; }, noscale);
      }
    } else {
      const int head = nt - 12;
#pragma unroll
      for (int m = 0; m < 8; m++)
#pragma unroll
        for (int n = 0; n < 4; n++) {
          h4 o; o[0] = (half_t)acc[m][n][0]; o[1] = (half_t)acc[m][n][1]; o[2] = (half_t)acc[m][n][2]; o[3] = (half_t)acc[m][n][3];
          int d = wc * 64 + n * 16 + fr;
          asm volatile("" : "+v"(d) :: "memory");
          *(h4*)(P.vT + ((size_t)(b * 4 + head) * 128 + d) * KV + pos0 + m * 16 + fq * 4) = o;
        }
    }
  }
}

DI void gemm_out_phase(const Params& P, int l, char* smem) {
  const int tid = TIDX, lane = tid & 63, wave = tid >> 6, fr = lane & 15, fq = lane >> 4, wr = wave >> 1, wc = wave & 1;
  const half_t* Wt = P.WtOut + (size_t)l * 1048576;
  const int mt0 = l == 0 ? 0 : TC / 256;
  const int sc = slot_col(), srow = tid >> 3;
#pragma unroll 1
  for (int it = 0;; it++) {
    int mt, nt;
    if (!xcd_tile(it, 264 - mt0, 8, mt, nt)) break;
    mt += mt0;
    if (mt >= 264) continue;
    asm volatile("" : "+s"(mt), "+s"(nt));
    f4 acc[8][4];
    {
      const half_t* a0 = P.mix + (size_t)(mt * 256 + srow) * D + sc; const half_t* b0 = Wt + (size_t)(nt * 128 + srow) * D + sc;
      gemm256([&](int i) { return a0 + (size_t)i * 32 * D; }, [&](int i) { return b0 + (size_t)i * 32 * D; }, 16, smem, acc);
    }
    const int r0 = mt * 256 + wr * 128;
    const int n = row_mod(r0);
    const float* g1 = P.mod + (size_t)(l * 9 + n) * 6144 + 2 * 1024;
    const float* res; float* dst;
    if (r0 < TC) { res = P.ctx + (size_t)r0 * D; dst = P.xcbuf + (size_t)r0 * D; }
    else { dst = P.out + (size_t)(r0 - TC) * D; res = l == 0 ? P.x + (size_t)(r0 - TC) * D : dst; }
#pragma unroll
    for (int m = 0; m < 8; m++) {
      int rb = m * 16 + fq * 4;
      asm volatile("" : "+v"(rb) :: "memory");
#pragma unroll
      for (int nn = 0; nn < 4; nn++) {
        const int c = nt * 128 + wc * 64 + nn * 16 + fr; const float g = g1[c];
#pragma unroll
        for (int j = 0; j < 4; j++) { size_t o = (size_t)(rb + j) * D + c; dst[o] = res[o] + g * acc[m][nn][j]; }
      }
    }
  }
}

DI void moe_prefix(const Params& P, int l, int* tb) {
  __syncthreads();
  if (TIDX == 0) { int s = 0; for (int e = 0; e < 32; e++) { tb[e] = s; s += (P.cnt[l * 32 + e] + 255) >> 8; } tb[32] = s; }
  __syncthreads();
}
DI void moe_e1_phase(const Params& P, int l, char* smem, int* tb) {
  const int tid = TIDX, lane = tid & 63, wave = tid >> 6, fr = lane & 15, fq = lane >> 4, wr = wave >> 1, wc = wave & 1;
  moe_prefix(P, l, tb);
  const int sc = slot_col(), srow = tid >> 3;
#pragma unroll 1
  for (int it = 0;; it++) {
    int rt, nt;
    if (!xcd_tile(it, tb[32], 8, rt, nt)) break;
    if (rt >= tb[32]) continue;
    asm volatile("" : "+s"(rt), "+s"(nt));
    int e = 0;
    while (tb[e + 1] <= rt) e++;
    const int rl = rt - tb[e], cnt = P.cnt[l * 32 + e];
    const int* lst = P.list + (size_t)e * LCAP;
    const half_t* w1 = P.Wt1 + ((size_t)(l * 32 + e) * 512 + nt * 64) * 1024 + sc;
    const half_t* w3 = P.Wt3 + ((size_t)(l * 32 + e) * 512 + nt * 64) * 1024 + sc;
    int tok[8];
#pragma unroll
    for (int i = 0; i < 8; i++) tok[i] = lst[min(rl * 256 + i * 32 + srow, cnt - 1)] >> 1;
    f4 acc[8][4];
    gemm256([&](int i) { return P.hx + (size_t)tok[i] * D + sc; },
            [&](int i) { return ((i & 1) ? w3 : w1) + (size_t)((i >> 1) * 32 + srow) * 1024; },
            16, smem, acc);
    {
      const int tid2 = TIDX, lane2 = tid2 & 63, wave2 = tid2 >> 6, fr2 = lane2 & 15, fq2 = lane2 >> 4, wr2 = wave2 >> 1, wc2 = wave2 & 1;
      char* stg = smem + 98304 + wave2 * 12288;
      half_t* Hd = P.H + ((size_t)rt * 256 + wr2 * 128) * 512 + nt * 64 + wc2 * 32;
#pragma unroll
      for (int h = 0; h < 2; h++) {
#pragma unroll
        for (int ml = 0; ml < 4; ml++)
#pragma unroll
          for (int n = 0; n < 2; n++)
#pragma unroll
            for (int j = 0; j < 4; j++) {
              float a1 = acc[h * 4 + ml][n][j], a3 = acc[h * 4 + ml][n + 2][j];
              *(half_t*)(stg + (ml * 16 + fq2 * 4 + j) * 80 + (n * 16 + fr2) * 2) = (half_t)(a1 * sigmoidf_(a1) * a3);
            }
        __builtin_amdgcn_wave_barrier();
#pragma unroll
        for (int i = 0; i < 4; i++) {
          const int c = i * 64 + lane2, row = c >> 2, c16 = c & 3;
          h8 v = *(const h8*)(stg + row * 80 + c16 * 16);
          *(h8*)(Hd + (size_t)(h * 64 + row) * 512 + c16 * 8) = v;
        }
        __builtin_amdgcn_wave_barrier();
      }
    }
  }
}
DI void moe_e2_phase(const Params& P, int l, char* smem, int* tb) {
  const int tid = TIDX, lane = tid & 63, wave = tid >> 6, fr = lane & 15, fq = lane >> 4, wr = wave >> 1, wc = wave & 1;
  moe_prefix(P, l, tb);
  const int sc = slot_col(), srow = tid >> 3;
#pragma unroll 1
  for (int it = 0;; it++) {
    int rt, nt;
    if (!xcd_tile(it, tb[32], 8, rt, nt)) break;
    if (rt >= tb[32]) continue;
    asm volatile("" : "+s"(rt), "+s"(nt));
    int e = 0;
    while (tb[e + 1] <= rt) e++;
    const int rl = rt - tb[e], cnt = P.cnt[l * 32 + e];
    const int* lst = P.list + (size_t)e * LCAP;
    f4 acc[8][4];
    {
      const half_t* a0 = P.H + ((size_t)rt * 256 + srow) * 512 + sc;
      const half_t* b0 = P.Wt2 + ((size_t)(l * 32 + e) * 1024 + nt * 128 + srow) * 512 + sc;
      gemm256([&](int i) { return a0 + (size_t)i * 32 * 512; }, [&](int i) { return b0 + (size_t)i * 32 * 512; }, 8, smem, acc);
    }
    {
      const int tid2 = TIDX, wave2 = tid2 >> 6, wr2 = wave2 >> 1, wc2 = wave2 & 1;
      char* stg = smem + 98304 + wave2 * 12288;
      float wrow = 0.f;
      wave_store_tile([&](int m, int n, int j) { return acc[m][n][j]; }, stg,
        [&](int r) -> half_t* {
          const int idx = rl * 256 + wr2 * 128 + r;
          if (idx >= cnt) return nullptr;
          const int a = lst[idx]; wrow = P.tokW[a];
          return P.yA + (size_t)a * D + nt * 128 + wc2 * 64;
        },
        [&](int, h8& v) {
#pragma unroll
          for (int u = 0; u < 8; u++) v[u] = (half_t)(wrow * (float)v[u]);
        });
    }
  }
}

DI int swap23(int x) { return (x & ~12) | ((x & 4) << 1) | ((x & 8) >> 1); }
DI void attn_item(const Params& P, int l, int b, int head, int row0, int nkeys, char* smem) {
  const int tid = TIDX, lane = tid & 63, wave = tid >> 6, ql = lane & 31, hh = lane >> 5;
  const float lam = P.consts[l * 4 + 0], negc = -P.consts[l * 4 + 1], lam_init = P.consts[l * 4 + 2];
  const int myrow = row0 + wave * 32 + ql;
  h8 qf[2][4];
  {
    const half_t* qp = P.q + (size_t)myrow * 512 + head * 128 + hh * 8;
#pragma unroll
    for (int m = 0; m < 2; m++)
#pragma unroll
      for (int s = 0; s < 4; s++) { qf[m][s] = *(const h8*)(qp + m * 64 + s * 16); }
#pragma unroll
    for (int m = 0; m < 2; m++)
#pragma unroll
      for (int s = 0; s < 4; s++) tie(qf[m][s]);
  }
  f16v o0[4], o1[4];
#pragma unroll
  for (int dt = 0; dt < 4; dt++)
#pragma unroll
    for (int i = 0; i < 16; i++) { o0[dt][i] = 0.f; o1[dt][i] = 0.f; }
  float ls0 = 0.f, ls1 = 0.f;
  const half_t* kp[4]; const half_t* vp[4];
  {
    const half_t* kbase = P.kall + (size_t)b * KV * 512 + head * 128;
    const half_t* vbase = P.vT + (size_t)(b * 4 + head) * 128 * KV;
#pragma unroll
    for (int i = 0; i < 4; i++) {
      int s = i * 256 + tid;
      int row = s >> 4, c = (s & 15) ^ (row & 15); kp[i] = kbase + (size_t)row * 512 + c * 8;
      int vr = s >> 3, vc = (s & 7) ^ ((vr >> 1) & 7); vp[i] = vbase + (size_t)vr * KV + vc * 8;
    }
  }
  const int ntile = nkeys >> 6;
  const unsigned sbase = lds_addr(smem);
  auto issue = [&](int t) {
    char* d = smem + (t % 3) * 32768 + tid * 16;
#pragma unroll
    for (int i = 0; i < 4; i++) { glds16(kp[i] + (size_t)t * 64 * 512, d + i * 4096); glds16(vp[i] + t * 64, d + 16384 + i * 4096); }
  };
  unsigned koff[2];
  const int kr_lo = swap23(ql), ksw = kr_lo & 15;
  koff[0] = kr_lo * 256; koff[1] = (32 + kr_lo) * 256;
  unsigned voff[4];
#pragma unroll
  for (int dt = 0; dt < 4; dt++) { int vrow = dt * 32 + ql; voff[dt] = 16384 + vrow * 128; }
  const int vsw = (ql >> 1) & 7;
  f16v negcv;
#pragma unroll
  for (int i = 0; i < 16; i++) negcv[i] = negc;
  h8 pp0[2], pp1[2];
  unsigned pendV = 0; int pendkt = 0; bool pend = false;
  auto half_step = [&](h8 (&kf)[8], unsigned cur, int kt) {
    h8 vf[8];
    if (pend) {
#pragma unroll
      for (int sp = 0; sp < 2; sp++)
#pragma unroll
        for (int dt = 0; dt < 4; dt++) vf[sp * 4 + dt] = lds128(pendV + voff[dt] + (((pendkt * 4 + sp * 2 + hh) ^ vsw) << 4));
    }
    f16v s0 = mfma32(kf[0], qf[0][0], negcv), s1 = mfma32(kf[4], qf[1][0], negcv);
#pragma unroll
    for (int st = 1; st < 4; st++) { s0 = mfma32(kf[st], qf[0][st], s0); s1 = mfma32(kf[4 + st], qf[1][st], s1); }
    if (pend) {
      WAIT_LGKM(0);
#pragma unroll
      for (int i = 0; i < 8; i++) tie(vf[i]);
#pragma unroll
      for (int sp = 0; sp < 2; sp++)
#pragma unroll
        for (int dt = 0; dt < 4; dt++) { o0[dt] = mfma32(vf[sp * 4 + dt], pp0[sp], o0[dt]); o1[dt] = mfma32(vf[sp * 4 + dt], pp1[sp], o1[dt]); }
    }
#pragma unroll
    for (int i = 0; i < 16; i++) { s0[i] = __builtin_amdgcn_exp2f(s0[i]); ls0 += s0[i]; s1[i] = __builtin_amdgcn_exp2f(s1[i]); ls1 += s1[i]; }
#pragma unroll
    for (int sp = 0; sp < 2; sp++) {
      u4 a, c;
      a[0] = pk2(s0[8*sp+0], s0[8*sp+1]); a[1] = pk2(s0[8*sp+2], s0[8*sp+3]); a[2] = pk2(s0[8*sp+4], s0[8*sp+5]); a[3] = pk2(s0[8*sp+6], s0[8*sp+7]);
      c[0] = pk2(s1[8*sp+0], s1[8*sp+1]); c[1] = pk2(s1[8*sp+2], s1[8*sp+3]); c[2] = pk2(s1[8*sp+4], s1[8*sp+5]); c[3] = pk2(s1[8*sp+6], s1[8*sp+7]);
      pp0[sp] = __builtin_bit_cast(h8, a); pp1[sp] = __builtin_bit_cast(h8, c);
    }
    pend = true; pendV = cur; pendkt = kt;
  };
  issue(0);
#pragma unroll 1
  for (int t = 0; t < ntile; t++) {
    wait_vm0();
    raw_barrier();
    if (t + 1 < ntile) issue(t + 1);
    const unsigned cur = sbase + (t % 3) * 32768;
    h8 kfa[8], kfb[8];
#pragma unroll
    for (int st = 0; st < 4; st++) {
      kfa[st] = lds128(cur + koff[0] + (((st * 2 + hh) ^ ksw) << 4));
      kfa[4 + st] = lds128(cur + koff[0] + (((8 + st * 2 + hh) ^ ksw) << 4));
    }
#pragma unroll
    for (int st = 0; st < 4; st++) {
      kfb[st] = lds128(cur + koff[1] + (((st * 2 + hh) ^ ksw) << 4));
      kfb[4 + st] = lds128(cur + koff[1] + (((8 + st * 2 + hh) ^ ksw) << 4));
    }
    WAIT_LGKM(8);
#pragma unroll
    for (int i = 0; i < 8; i++) tie(kfa[i]);
    half_step(kfa, cur, 0);
    WAIT_LGKM(0);
#pragma unroll
    for (int i = 0; i < 8; i++) tie(kfb[i]);
    half_step(kfb, cur, 1);
  }
  {
    h8 vf[8];
#pragma unroll
    for (int sp = 0; sp < 2; sp++)
#pragma unroll
      for (int dt = 0; dt < 4; dt++) vf[sp * 4 + dt] = lds128(pendV + voff[dt] + (((pendkt * 4 + sp * 2 + hh) ^ vsw) << 4));
    WAIT_LGKM(0);
#pragma unroll
    for (int i = 0; i < 8; i++) tie(vf[i]);
#pragma unroll
    for (int sp = 0; sp < 2; sp++)
#pragma unroll
      for (int dt = 0; dt < 4; dt++) { o0[dt] = mfma32(vf[sp * 4 + dt], pp0[sp], o0[dt]); o1[dt] = mfma32(vf[sp * 4 + dt], pp1[sp], o1[dt]); }
  }
  raw_barrier();
  ls0 += shx(ls0, 32); ls1 += shx(ls1, 32);
  const float i0 = 1.f / ls0, i1 = lam / ls1;
  float ss = 0.f;
#pragma unroll
  for (int dt = 0; dt < 4; dt++)
#pragma unroll
    for (int i = 0; i < 16; i++) { float v = o0[dt][i] * i0 - o1[dt][i] * i1; o0[dt][i] = v; ss += v * v; }
  ss += shx(ss, 32);
  const float mult = rsqrtf(ss * (1.f / 128.f) + EPS) * (1.f - lam_init);
  const float* sg = P.subln_g + l * 128;
  half_t* dst = P.mix + (size_t)myrow * D + 256 + head * 128;
#pragma unroll
  for (int dt = 0; dt < 4; dt++)
#pragma unroll
    for (int g = 0; g < 4; g++) {
      const int d0 = dt * 32 + 8 * g + 4 * hh;
      float4 gv = *(const float4*)(sg + d0);
      h4 o; o[0] = (half_t)(o0[dt][4*g] * mult * gv.x); o[1] = (half_t)(o0[dt][4*g+1] * mult * gv.y);
      o[2] = (half_t)(o0[dt][4*g+2] * mult * gv.z); o[3] = (half_t)(o0[dt][4*g+3] * mult * gv.w);
      *(h4*)(dst + d0) = o;
    }
}

DI int swz128(int row, int colh) { return row * 128 + ((((colh >> 3)) ^ ((row >> 1) & 7)) << 4) + (colh & 7) * 2; }
DI void lru_load_w(const Params& P, int l, int g, char* Wt) {
  const int tid = TIDX;
  for (int dg = 0; dg < 4; dg++) {
    const int dir = dg >> 1;
    const float* w = ((dg & 1) ? P.gate_x_w : P.gate_a_w) + ((size_t)((l * 2 + dir) * 4 + g)) * 4096;
    for (int idx = tid; idx < 4096; idx += 256) { int i = idx >> 6, o = idx & 63; *(half_t*)(Wt + dg * 8192 + swz128(o, i)) = (half_t)w[idx]; }
  }
}
DI void lru_tile(const Params& P, int l, int b, int tile, int g, char* smem, bool final) {
  const int tid = TIDX, lane = tid & 63, wave = tid >> 6, fr = lane & 15, fq = lane >> 4;
  char* Wt = smem;
  char* xr16 = smem + 32768;
  float2* ab = (float2*)(smem + 40960);
  half_t* raw = (half_t*)(smem + 40960);
  float2* subst = (float2*)(smem + 73728);
  const int ch = tid & 63, tq = tid >> 6, gc = g * 64 + ch;
  const int T = tile < 4 ? CL : SEQ;
  const int t0 = tile < 4 ? tile * 64 : (tile - 4) * 64;
  const int rowbase = tile < 4 ? b * CL : TC + b * SEQ;
  __syncthreads();
  for (int idx = tid; idx < 67 * 8; idx += 256) {
    int row = idx >> 3, c = idx & 7, tt = t0 - 1 + row;
    h8 v = {0, 0, 0, 0, 0, 0, 0, 0};
    if (tt >= 0 && tt < T) v = *(const h8*)(P.rr + (size_t)(rowbase + tt) * 256 + g * 64 + c * 8);
    *(h8*)(raw + row * 64 + c * 8) = v;
  }
  float gyv[16];
  if (final) {
#pragma unroll
    for (int e = 0; e < 16; e++) gyv[e] = (float)P.gy[(size_t)(rowbase + t0 + tq * 16 + e) * 256 + gc];
  }
  const float cw0 = P.conv_w[(l * 4 + 0) * 256 + gc], cw1 = P.conv_w[(l * 4 + 1) * 256 + gc], cw2 = P.conv_w[(l * 4 + 2) * 256 + gc],
              cw3 = P.conv_w[(l * 4 + 3) * 256 + gc], cb = P.conv_b[l * 256 + gc];
  __syncthreads();
  {
    float v[19];
#pragma unroll
    for (int e = 0; e < 19; e++) v[e] = (float)raw[(tq * 16 + e) * 64 + ch];
    __syncthreads();
#pragma unroll
    for (int e = 0; e < 16; e++) {
      float xv = cb + cw0 * v[e] + cw1 * v[e + 1] + cw2 * v[e + 2] + cw3 * v[e + 3];
      *(half_t*)(xr16 + swz128(tq * 16 + e, ch)) = (half_t)xv;
    }
  }
  __syncthreads();
  float hsum[16];
#pragma unroll
  for (int e = 0; e < 16; e++) hsum[e] = 0.f;
#pragma unroll 1
  for (int dir = 0; dir < 2; dir++) {
    {
      f4 acc[2][4];
#pragma unroll
      for (int gt = 0; gt < 2; gt++)
#pragma unroll
        for (int n = 0; n < 4; n++) acc[gt][n] = (f4){0.f, 0.f, 0.f, 0.f};
#pragma unroll
      for (int kk = 0; kk < 2; kk++) {
        int row = wave * 16 + fr;
        h8 af = *(const h8*)(xr16 + row * 128 + (((kk * 4 + fq) ^ ((row >> 1) & 7)) << 4));
#pragma unroll
        for (int gt = 0; gt < 2; gt++)
#pragma unroll
          for (int n = 0; n < 4; n++) {
            int orow = n * 16 + fr;
            h8 bf = *(const h8*)(Wt + (dir * 2 + gt) * 8192 + orow * 128 + (((kk * 4 + fq) ^ ((orow >> 1) & 7)) << 4));
            acc[gt][n] = mfma16(af, bf, acc[gt][n]);
          }
      }
#pragma unroll
      for (int n = 0; n < 4; n++) {
        const int cc = (l * 2 + dir) * 256 + g * 64 + n * 16 + fr;
        const float ba = P.gate_a_b[cc], bx = P.gate_x_b[cc];
        const float sp8 = -8.f * log1pf(__expf(-P.lru_lambda[cc]));
#pragma unroll
        for (int j = 0; j < 4; j++) {
          int tl = wave * 16 + fq * 4 + j, c2 = n * 16 + fr;
          float xv = (float)*(const half_t*)(xr16 + swz128(tl, c2));
          float rg = sigmoidf_(acc[0][n][j] + ba), ig = sigmoidf_(acc[1][n][j] + bx);
          float log_a = rg * sp8;
          float a = __expf(log_a);
          float x2 = 2.f * log_a;
          float om = -x2 * (1.f + x2 * (0.5f + x2 * (0.16666667f + x2 * (0.041666668f + x2 * (0.008333334f + x2 * 0.0013888889f)))));
          om = x2 < -0.4f ? 1.f - a * a : om;
          ab[tl * 64 + c2] = make_float2(a, sqrtf(om) * (ig * xv));
        }
      }
    }
    __syncthreads();
    float2 av[16];
    {
      float A = 1.f, h = 0.f;
#pragma unroll
      for (int e = 0; e < 16; e++) {
        int ee = dir == 0 ? e : 15 - e;
        av[e] = ab[(tq * 16 + ee) * 64 + ch];
        h = av[e].x * h + av[e].y; A *= av[e].x;
      }
      subst[tq * 64 + ch] = make_float2(A, h);
    }
    __syncthreads();
    const size_t sidx = ((size_t)((b * 2 + dir) * 132 + tile)) * 256 + gc;
    if (!final) {
      if (tq == 0) {
        float A = 1.f, h = 0.f;
#pragma unroll
        for (int s = 0; s < 4; s++) { float2 ss = subst[(dir == 0 ? s : 3 - s) * 64 + ch]; h = ss.x * h + ss.y; A *= ss.x; }
        P.lsum[sidx] = make_float2(A, h);
      }
    } else {
      float h = P.lcar[sidx];
      if (dir == 0) { for (int s = 0; s < tq; s++) { float2 ss = subst[s * 64 + ch]; h = ss.x * h + ss.y; } }
      else { for (int s = 3; s > tq; s--) { float2 ss = subst[s * 64 + ch]; h = ss.x * h + ss.y; } }
#pragma unroll
      for (int e = 0; e < 16; e++) {
        int ee = dir == 0 ? e : 15 - e;
        h = av[e].x * h + av[e].y;
#pragma unroll
        for (int q = 0; q < 16; q++) hsum[q] += (q == ee) ? h : 0.f;
      }
    }
    __syncthreads();
  }
  if (final) {
#pragma unroll
    for (int e = 0; e < 16; e++)
      P.mix[(size_t)(rowbase + t0 + tq * 16 + e) * D + 768 + gc] = (half_t)(gyv[e] * hsum[e]);
  }
}
DI void lru_carry_item(const Params& P, int it) {
  const int ch = TIDX, dir = it & 1;
  const size_t base = (size_t)it * 132 * 256 + ch;
  float c = 0.f;
#pragma unroll 4
  for (int k = 0; k < 132; k++) {
    int tile = dir == 0 ? k : (k < 4 ? 3 - k : 135 - k);
    float2 s = P.lsum[base + (size_t)tile * 256];
    P.lcar[base + (size_t)tile * 256] = c;
    c = s.x * c + s.y;
  }
}

DI void fft_load(const half_t* src, size_t rs, int nrows, char* Bt, int rowbytes, int k0) {
  for (int idx = TIDX; idx < nrows * 16; idx += 256) {
    int kr = idx >> 4, cc = idx & 15, k = k0 + kr;
    h8 v = *(const h8*)(src + (size_t)kr * rs + cc * 8);
#pragma unroll
    for (int u = 0; u < 8; u++) { int n = cc * 8 + u; *(half_t*)(Bt + n * rowbytes + ((((k >> 3)) ^ (n & 15)) << 4) + (k & 7) * 2) = v[u]; }
  }
}
template <class RF>
DI void fft_mma(const half_t* Dm, int ldD, int nkk, const char* Bt, int rowbytes, f4 (&acc)[4][4], RF arow) {
  const int lane = TIDX & 63, wave = TIDX >> 6, fr = lane & 15, fq = lane >> 4, wc = wave & 1;
#pragma unroll 1
  for (int kk = 0; kk < nkk; kk++) {
    h8 af[4], bf[4];
#pragma unroll
    for (int ms = 0; ms < 4; ms++) af[ms] = *(const h8*)(Dm + (size_t)arow(ms) * ldD + kk * 32 + fq * 8);
#pragma unroll
    for (int ns = 0; ns < 4; ns++) { int n = wc * 64 + ns * 16 + fr; bf[ns] = *(const h8*)(Bt + n * rowbytes + (((kk * 4 + fq) ^ (n & 15)) << 4)); }
#pragma unroll
    for (int ms = 0; ms < 4; ms++)
#pragma unroll
      for (int ns = 0; ns < 4; ns++) acc[ms][ns] = mfma16(af[ms], bf[ns], acc[ms][ns]);
  }
}
DI void zero44(f4 (&acc)[4][4]) {
#pragma unroll
  for (int m = 0; m < 4; m++)
#pragma unroll
    for (int n = 0; n < 4; n++) acc[m][n] = (f4){0.f, 0.f, 0.f, 0.f};
}
DI void fftA_item(const Params& P, int it, char* smem) {
  const int b = it >> 8, bb = (it >> 1) & 127, chh = it & 1;
  const int lane = TIDX & 63, wave = TIDX >> 6, fr = lane & 15, fq = lane >> 4, wr = wave >> 1, wc = wave & 1;
  __syncthreads();
  fft_load(P.QF + (size_t)(TC + b * SEQ + bb) * 512 + chh * 128, (size_t)128 * 512, 64, smem, 256, 0);
  fft_load(P.QF + (size_t)(TC + b * SEQ + bb) * 512 + 256 + chh * 128, (size_t)128 * 512, 64, smem, 256, 64);
  __syncthreads();
  f4 acc[4][4]; zero44(acc);
  fft_mma(P.DA, 128, 4, smem, 256, acc, [&](int ms) { return (ms >> 1) * 64 + wr * 32 + (ms & 1) * 16 + fr; });
#pragma unroll
  for (int ms = 0; ms < 2; ms++)
#pragma unroll
    for (int j = 0; j < 4; j++) {
      const int f1 = wr * 32 + ms * 16 + fq * 4 + j;
      const float2 w = P.tw[(bb * f1) & 8191];
      half_t* d0 = P.GA + ((size_t)(b * 64 + f1) * 256 + bb) * 256 + chh * 128 + wc * 64 + fr;
#pragma unroll
      for (int ns = 0; ns < 4; ns++) {
        float gr = acc[ms][ns][j], gi = acc[ms + 2][ns][j];
        d0[ns * 16] = (half_t)(gr * w.x + gi * w.y);
        d0[(size_t)128 * 256 + ns * 16] = (half_t)(gi * w.x - gr * w.y);
      }
    }
}
DI void fftB_item(const Params& P, int it, char* smem) {
  const int b = it >> 7, f1 = (it >> 1) & 63, chh = it & 1;
  const int lane = TIDX & 63, wave = TIDX >> 6, fr = lane & 15, fq = lane >> 4, wr = wave >> 1, wc = wave & 1;
  __syncthreads();
  fft_load(P.GA + (size_t)(b * 64 + f1) * 256 * 256 + chh * 128, 256, 256, smem, 512, 0);
  __syncthreads();
  f4 acc[4][4]; zero44(acc);
  fft_mma(P.DB, 256, 8, smem, 512, acc, [&](int ms) { return wr * 64 + ms * 16 + fr; });
#pragma unroll
  for (int ms = 0; ms < 4; ms++)
#pragma unroll
    for (int j = 0; j < 4; j++) {
      const int f2 = wr * 64 + ms * 16 + fq * 4 + j;
      half_t* d0 = P.mix + (size_t)(TC + b * SEQ + f1 + 64 * f2) * D + chh * 128 + wc * 64 + fr;
#pragma unroll
      for (int ns = 0; ns < 4; ns++) d0[ns * 16] = (half_t)acc[ms][ns][j];
    }
}
DI void fftC_item(const Params& P, int it, char* smem) {
  const int b = it >> 1, chh = it & 1;
  const int lane = TIDX & 63, wave = TIDX >> 6, fr = lane & 15, fq = lane >> 4, wr = wave >> 1, wc = wave & 1;
#pragma unroll 1
  for (int mh = 0; mh < 2; mh++) {
    f4 acc[4][4]; zero44(acc);
#pragma unroll 1
    for (int part = 0; part < 2; part++) {
      __syncthreads();
      fft_load(P.QF + (size_t)(b * CL) * 512 + part * 256 + chh * 128, 512, 256, smem, 512, 0);
      __syncthreads();
      fft_mma(P.DC + part * 256, 512, 8, smem, 512, acc, [&](int ms) { return mh * 128 + wr * 64 + ms * 16 + fr; });
    }
#pragma unroll
    for (int ms = 0; ms < 4; ms++)
#pragma unroll
      for (int j = 0; j < 4; j++) {
        const int f = mh * 128 + wr * 64 + ms * 16 + fq * 4 + j;
        half_t* d0 = P.mix + (size_t)(b * CL + f) * D + chh * 128 + wc * 64 + fr;
#pragma unroll
        for (int ns = 0; ns < 4; ns++) d0[ns * 16] = (half_t)acc[ms][ns][j];
      }
  }
}

#ifndef MX
#define MX 15
#endif
DI void mix_phase(const Params& P, int l, char* smem, int* s_item, int qi) {
  const int nL = 0, nA = 0, nC = l == 0 ? 64 : 0, nFA = 2048, nFC = l == 0 ? 16 : 0;
  const int total = nL + nA + nC + nFA + nFC;
  {
    const int g = blockIdx.x & 3;
    lru_load_w(P, l, g, smem);
    for (int u = blockIdx.x >> 2; u < NB_ * 132; u += gridDim.x >> 2) lru_tile(P, l, u / 132, u % 132, g, smem, false);
  }
  int stage = 0;
  for (;;) {
    __syncthreads();
    if (TIDX == 0) *s_item = stage == 0 ? atomicAdd(&P.qctr[8 + qi * 8 + (blockIdx.x & 7)], 1) : atomicAdd(&P.qctr[qi], 1);
    __syncthreads();
    int it = *s_item;
    int kind = -1, b = 0, head = 0, row0 = 0, nk = 0;
    if (stage == 0) {
      if (it >= 256) { stage = 1; continue; }
      const int pair = (blockIdx.x & 7) + 8 * (it >> 6);
      b = pair >> 2; head = pair & 3; row0 = TC + b * SEQ + (it & 63) * 128; nk = KV; kind = 0;
    } else {
      if (it >= total) break;
      if (it < nC) { b = it >> 3; head = (it >> 1) & 3; row0 = b * CL + (it & 1) * 128; nk = CL; kind = 0; }
      else if (it < nC + nFA) { kind = 1; it -= nC; }
      else { kind = 2; it -= nC + nFA; }
    }
    if (kind == 0) attn_item(P, l, b, head, row0, nk, smem);
    else if (kind == 1) fftA_item(P, it, smem);
    else fftC_item(P, it, smem);
  }
}

DI void grid_barrier(unsigned* ctr, unsigned target) {
  asm volatile("s_waitcnt vmcnt(0)" ::: "memory");
  __syncthreads();
  if (threadIdx.x == 0) {
    __builtin_amdgcn_fence(__ATOMIC_RELEASE, "agent");
    asm volatile("s_waitcnt vmcnt(0)" ::: "memory");
    __hip_atomic_fetch_add(ctr, 1u, __ATOMIC_RELAXED, __HIP_MEMORY_SCOPE_AGENT);
    while (__hip_atomic_load(ctr, __ATOMIC_RELAXED, __HIP_MEMORY_SCOPE_AGENT) < target) __builtin_amdgcn_s_sleep(1);
    __builtin_amdgcn_fence(__ATOMIC_ACQUIRE, "agent");
    asm volatile("s_waitcnt vmcnt(0)" ::: "memory");
  }
  __syncthreads();
}
__global__ void __launch_bounds__(256, 1) fwd_megakernel(Params Pin) {
  Params P = Pin; bind_ws(P);
  __shared__ __attribute__((aligned(16))) char smem[147456];
  __shared__ int tb[33];
  __shared__ int s_item;
  cg::grid_group grid = cg::this_grid();
  unsigned* bar = (unsigned*)(P.ws + O_bar); unsigned bk = 0;
#ifndef PH
#define PH 0xFFFF
#endif
#if PH & 1
  phase0(P, smem);
#endif
  grid.sync();
  for (int l = 0; l < 2; l++) {
#if PH & 2
    row1_phase(P, l == 0 ? -1 : 0, l, 0);
#endif
    grid_barrier(bar, (++bk) * gridDim.x);
#if PH & 4
    gemm_in_phase(P, l, smem);
#ifdef DUP_GEMM
    grid_barrier(bar, (++bk) * gridDim.x);
    gemm_in_phase(P, l, smem);
#endif
#endif
    grid_barrier(bar, (++bk) * gridDim.x);
#if PH & 8
    mix_phase(P, l, smem, &s_item, l);
#ifdef DUP_MIX
    grid_barrier(bar, (++bk) * gridDim.x);
    mix_phase(P, l, smem, &s_item, 2 + l);
#endif
#endif
    grid_barrier(bar, (++bk) * gridDim.x);
#if PH & 16
    if (blockIdx.x >= gridDim.x - 16) lru_carry_item(P, gridDim.x - 1 - blockIdx.x);
    for (int it = blockIdx.x; it < 1024; it += gridDim.x) fftB_item(P, it, smem);
#endif
    grid_barrier(bar, (++bk) * gridDim.x);
#if PH & 512
    {
      const int g = blockIdx.x & 3;
      __syncthreads();
      lru_load_w(P, l, g, smem);
      for (int u = blockIdx.x >> 2; u < NB_ * 132; u += gridDim.x >> 2) lru_tile(P, l, u / 132, u % 132, g, smem, true);
    }
#endif
    grid_barrier(bar, (++bk) * gridDim.x);
#if PH & 32
    gemm_out_phase(P, l, smem);
#endif
    grid_barrier(bar, (++bk) * gridDim.x);
#if PH & 64
    row2_phase(P, l, l == 0 ? 0 : TC, smem);
#endif
    grid_barrier(bar, (++bk) * gridDim.x);
#if PH & 128
    moe_e1_phase(P, l, smem, tb);
#ifdef DUP_GEMM
    grid_barrier(bar, (++bk) * gridDim.x);
    moe_e1_phase(P, l, smem, tb);
#endif
#endif
    grid_barrier(bar, (++bk) * gridDim.x);
#if PH & 256
    moe_e2_phase(P, l, smem, tb);
#ifdef DUP_GEMM
    grid_barrier(bar, (++bk) * gridDim.x);
    moe_e2_phase(P, l, smem, tb);
#endif
#endif
    grid_barrier(bar, (++bk) * gridDim.x);
  }
#if PH & 2
  row1_phase(P, 1, -1, TC);
#endif
}

extern "C" void kernel_launch(void* const* d_in, const int* in_sizes, int n_in, void* d_out, int out_size, void* d_ws, size_t ws_size,
                              hipStream_t stream) {
  static int grid_blocks = 0;
  if (!grid_blocks) {
    int dev = 0, cus = 0, per_cu = 0;
    hipGetDevice(&dev);
    hipDeviceGetAttribute(&cus, hipDeviceAttributeMultiprocessorCount, dev);
    hipOccupancyMaxActiveBlocksPerMultiprocessor(&per_cu, fwd_megakernel, 256, 0);
    if (per_cu > 2) per_cu = 2;
    grid_blocks = cus * per_cu;
  }
  Params p{};
  const float** pin = (const float**)&p;
  for (int i = 0; i < 31; i++) pin[i] = (const float*)d_in[i];
  p.out = (float*)d_out;
  p.ws = (char*)d_ws;
  if (WS_NEED > ws_size) { fprintf(stderr, "workspace too small: need %zu have %zu\n", (size_t)WS_NEED, ws_size); return; }
  hipMemsetAsync((char*)d_ws + O_bar, 0, 256, stream);
  void* args[] = {&p};
  hipError_t e = hipLaunchCooperativeKernel((void*)fwd_megakernel, dim3(grid_blocks), dim3(256), args, 0, stream);
  if (e != hipSuccess) fprintf(stderr, "cooperative launch failed: %s (grid %d)\n", hipGetErrorString(e), grid_blocks);
}
```

```cpp
#include <hip/hip_runtime.h>
#include <hip/hip_cooperative_groups.h>
#include <cstdio>
namespace cg = cooperative_groups;

typedef _Float16 half_t;
typedef _Float16 h8 __attribute__((ext_vector_type(8)));
typedef _Float16 h4 __attribute__((ext_vector_type(4)));
typedef __fp16 fp16x2 __attribute__((ext_vector_type(2)));
typedef unsigned u4 __attribute__((ext_vector_type(4)));
typedef float f4 __attribute__((ext_vector_type(4)));
typedef float f16v __attribute__((ext_vector_type(16)));
#define DI __device__ __forceinline__
__device__ __forceinline__ int tid_opaque() { int t = threadIdx.x; asm volatile("" : "+v"(t)); return t; }
#define TIDX tid_opaque()

constexpr int D = 1024, NB_ = 8, SEQ = 8192, CL = 256;
constexpr int TC = NB_ * CL;
constexpr int TX = NB_ * SEQ;
constexpr int TA = TC + TX;
constexpr int KV = CL + SEQ;
constexpr int NIN = 2560;
constexpr int LCAP = 2 * TA;
constexpr float EPS = 1e-6f;

struct Params {
  const float *x, *c, *ctx, *c_ctx, *w_mod, *b_mod, *norm1_g, *norm2_g, *w_in, *q_norm_g, *k_norm_g, *lq1, *lk1, *lq2, *lk2,
      *subln_g, *conv_w, *conv_b, *gate_a_w, *gate_a_b, *gate_x_w, *gate_x_b, *lru_lambda, *w_out, *w_group, *b_group,
      *w_router, *b_router, *w1, *w3, *w2;
  float* out; char* ws;
  half_t *WtIn, *WtOut, *Wt1, *Wt3, *Wt2;
  float* mod; float2* rope; float2* tw; half_t *DA, *DB, *DC; float* consts; int* cnt; int* qctr; float* tokW; int* list;
  float* xcbuf; half_t* WrH;
  half_t *hx, *mix, *q, *kall, *vT, *QF, *gy, *rr; float2* lsum; float* lcar; half_t* GA; half_t *H, *yA;
};


constexpr size_t al256(size_t x) { return (x + 255) & ~(size_t)255; }
constexpr size_t O_WtIn = 0;
constexpr size_t O_WtOut = O_WtIn + al256((size_t)2 * NIN * 1024 * 2);
constexpr size_t O_Wt1 = O_WtOut + al256((size_t)2 * 1024 * 1024 * 2);
constexpr size_t O_Wt3 = O_Wt1 + al256((size_t)64 * 524288 * 2);
constexpr size_t O_Wt2 = O_Wt3 + al256((size_t)64 * 524288 * 2);
constexpr size_t O_mod = O_Wt2 + al256((size_t)64 * 524288 * 2);
constexpr size_t O_rope = O_mod + al256((size_t)2 * 9 * 6144 * 4);
constexpr size_t O_tw = O_rope + al256(128 * 16 * 8);
constexpr size_t O_DA = O_tw + al256(8192 * 8);
constexpr size_t O_DB = O_DA + al256(16384 * 2);
constexpr size_t O_DC = O_DB + al256(32768 * 2);
constexpr size_t O_consts = O_DC + al256(131072 * 2);
constexpr size_t O_cnt = O_consts + 256;
constexpr size_t O_qctr = O_cnt + 256;
constexpr size_t O_bar = O_qctr + 256;
constexpr size_t O_tokW = O_bar + 256;
constexpr size_t O_list = O_tokW + al256((size_t)2 * TA * 4);
constexpr size_t O_xcbuf = O_list + al256((size_t)32 * LCAP * 4);
constexpr size_t O_WrT = O_xcbuf + al256((size_t)TC * D * 4);
constexpr size_t O_hx = O_WrT + al256((size_t)2 * 2 * 48 * 1024 * 2);
constexpr size_t O_mix = O_hx + al256((size_t)TA * D * 2);
constexpr size_t O_regB = O_mix + al256((size_t)TA * D * 2);
constexpr size_t O_q = O_regB;
constexpr size_t O_kall = O_q + al256((size_t)TA * 512 * 2);
constexpr size_t O_vT = O_kall + al256((size_t)NB_ * KV * 512 * 2);
constexpr size_t O_QF = O_vT + al256((size_t)NB_ * 4 * 128 * KV * 2);
constexpr size_t O_gy = O_QF + al256((size_t)TA * 512 * 2);
constexpr size_t O_rr = O_gy + al256((size_t)TA * 256 * 2);
constexpr size_t O_lsum = O_rr + al256((size_t)TA * 256 * 2);
constexpr size_t O_lcar = O_lsum + al256((size_t)16 * 132 * 256 * 8);
constexpr size_t O_GA = O_lcar + al256((size_t)16 * 132 * 256 * 4);
constexpr size_t O_mixer_end = O_GA + al256((size_t)NB_ * 64 * 256 * 256 * 2);
constexpr size_t O_H = O_regB;
constexpr size_t O_yA = O_H + al256((size_t)(2 * TA + 32 * 256) * 512 * 2);
constexpr size_t O_moe_end = O_yA + al256((size_t)2 * TA * D * 2);
constexpr size_t WS_NEED = O_mixer_end > O_moe_end ? O_mixer_end : O_moe_end;
DI void bind_ws(Params& P) {
  char* w = P.ws;
  P.WtIn = (half_t*)(w + O_WtIn); P.WtOut = (half_t*)(w + O_WtOut); P.Wt1 = (half_t*)(w + O_Wt1); P.Wt3 = (half_t*)(w + O_Wt3); P.Wt2 = (half_t*)(w + O_Wt2);
  P.mod = (float*)(w + O_mod); P.rope = (float2*)(w + O_rope); P.tw = (float2*)(w + O_tw); P.DA = (half_t*)(w + O_DA); P.DB = (half_t*)(w + O_DB); P.DC = (half_t*)(w + O_DC);
  P.consts = (float*)(w + O_consts); P.cnt = (int*)(w + O_cnt); P.qctr = (int*)(w + O_qctr); P.tokW = (float*)(w + O_tokW); P.list = (int*)(w + O_list);
  P.xcbuf = (float*)(w + O_xcbuf); P.WrH = (half_t*)(w + O_WrT); P.hx = (half_t*)(w + O_hx); P.mix = (half_t*)(w + O_mix);
  P.q = (half_t*)(w + O_q); P.kall = (half_t*)(w + O_kall); P.vT = (half_t*)(w + O_vT); P.QF = (half_t*)(w + O_QF); P.gy = (half_t*)(w + O_gy); P.rr = (half_t*)(w + O_rr);
  P.lsum = (float2*)(w + O_lsum); P.lcar = (float*)(w + O_lcar); P.GA = (half_t*)(w + O_GA); P.H = (half_t*)(w + O_H); P.yA = (half_t*)(w + O_yA);
}
DI float shx(float v, int o) { int ln = TIDX & 63; return __builtin_bit_cast(float, __builtin_amdgcn_ds_bpermute((ln ^ o) << 2, __builtin_bit_cast(int, v))); }
DI float shi(float v, int idx) { return __builtin_bit_cast(float, __builtin_amdgcn_ds_bpermute(idx << 2, __builtin_bit_cast(int, v))); }
DI float wave_sum(float v) {
#pragma unroll
  for (int o = 32; o; o >>= 1) v += shx(v, o);
  return v;
}
DI void glds16(const void* g, void* l) {
  __builtin_amdgcn_global_load_lds((const unsigned*)g, (unsigned*)l, 16, 0, 0);
}
DI void wait_vm0() { asm volatile("s_waitcnt vmcnt(0)" ::: "memory"); }
DI f4 mfma16(h8 a, h8 b, f4 c) { return __builtin_amdgcn_mfma_f32_16x16x32_f16(a, b, c, 0, 0, 0); }
DI f16v mfma32(h8 a, h8 b, f16v c) { return __builtin_amdgcn_mfma_f32_32x32x16_f16(a, b, c, 0, 0, 0); }
DI unsigned pk2(float a, float b) { fp16x2 r = __builtin_amdgcn_cvt_pkrtz(a, b); return __builtin_bit_cast(unsigned, r); }
DI float sigmoidf_(float x) { return 1.f / (1.f + __expf(-x)); }
DI float gelu_tanh(float x) {
  float u = 0.7978845608028654f * (x + 0.044715f * x * x * x);
  float e = __expf(2.f * u);
  float t = 1.f - 2.f / (e + 1.f);
  return 0.5f * x * (1.f + t);
}
DI int row_mod(int r) { return r < TC ? 8 : ((r - TC) >> 13); }

DI void transpose_tile(const float* src, int lds_, half_t* dst, int ldd, float* tile) {
  const int tid = TIDX, n = tid & 63, kq = tid >> 6;
#pragma unroll 4
  for (int i = 0; i < 16; i++) { int k = i * 4 + kq; tile[k * 65 + n] = src[(size_t)k * lds_ + n]; }
  __syncthreads();
#pragma unroll 4
  for (int i = 0; i < 16; i++) { int nn = i * 4 + kq; dst[(size_t)nn * ldd + n] = (half_t)tile[n * 65 + nn]; }
  __syncthreads();
}

DI void phase0(const Params& P, char* smem) {
  float* tile = (float*)smem;
  const int tid = TIDX;
  constexpr int NT = 26112, NF = 128, NM = 192, NX = 6;
  for (int t = blockIdx.x; t < NT + NF + NM + NX; t += gridDim.x) {
    if (t < NT) {
      const float* src; half_t* dst; int lds_, ldd;
      if (t < 1024) {
        int l = t / 512, r = t % 512, kt = r / 32, nt = r % 32;
        src = P.w_in + (size_t)l * 1024 * 2304 + (size_t)kt * 64 * 2304 + 256 + nt * 64; lds_ = 2304;
        dst = P.WtIn + (size_t)l * NIN * 1024 + (size_t)(512 + nt * 64) * 1024 + kt * 64; ldd = 1024;
      } else if (t < 1536) {
        int u = t - 1024, l = u / 256, r = u % 256, kt = r / 16, nt = r % 16;
        src = P.w_out + (size_t)l * 1048576 + (size_t)kt * 64 * 1024 + nt * 64; lds_ = 1024;
        dst = P.WtOut + (size_t)l * 1048576 + (size_t)nt * 64 * 1024 + kt * 64; ldd = 1024;
      } else if (t < 1536 + 16384) {
        int u = t - 1536; const float* w = P.w1; half_t* o = P.Wt1;
        if (u >= 8192) { u -= 8192; w = P.w3; o = P.Wt3; }
        int le = u / 128, r = u % 128, kt = r / 8, nt = r % 8;
        src = w + (size_t)le * 524288 + (size_t)kt * 64 * 512 + nt * 64; lds_ = 512;
        dst = o + (size_t)le * 524288 + (size_t)nt * 64 * 1024 + kt * 64; ldd = 1024;
      } else {
        int u = t - 1536 - 16384, le = u / 128, r = u % 128, kt = r / 16, nt = r % 16;
        src = P.w2 + (size_t)le * 524288 + (size_t)kt * 64 * 1024 + nt * 64; lds_ = 1024;
        dst = P.Wt2 + (size_t)le * 524288 + (size_t)nt * 64 * 512 + kt * 64; ldd = 512;
      }
      transpose_tile(src, lds_, dst, ldd, tile);
    } else if (t < NT + NF) {
      int f = t - NT, l = f / 64, r = f % 64, kt = r / 4, g = r % 4;
      float* cst = tile + 64 * 65; float* snt = cst + 64;
      const float* src = P.w_in + (size_t)l * 1024 * 2304 + (size_t)kt * 64 * 2304 + g * 64;
      { int n = tid & 63, kq = tid >> 6;
        for (int i = 0; i < 16; i++) { int k = i * 4 + kq; tile[k * 65 + n] = src[(size_t)k * 2304 + n]; } }
      if (tid < 64) { float s, c; sincospif((float)tid / 32.f, &s, &c); cst[tid] = c; snt[tid] = s; }
      __syncthreads();
      int k = tid & 63, jq = tid >> 6;
      half_t* o = P.WtIn + (size_t)l * NIN * 1024 + kt * 64 + k;
      for (int jj = 0; jj < 16; jj++) {
        int j = jq * 16 + jj; float ac = 0.f, as = 0.f;
        for (int c = 0; c < 64; c++) { float v = tile[k * 65 + c]; int idx = (c * j) & 63; ac += v * cst[idx]; as += v * snt[idx]; }
        o[(size_t)(g * 64 + j) * 1024] = (half_t)(ac * 0.125f);
        o[(size_t)(256 + g * 64 + j) * 1024] = (half_t)(-as * 0.125f);
      }
      __syncthreads();
    } else if (t < NT + NF + NM) {
      int mi = t - NT - NF, l = mi / 96, col0 = (mi % 96) * 64;
      float* scond = tile; float* red = tile + 9216;
      for (int idx = tid; idx < 9216; idx += 256) {
        int n = idx >> 10, k = idx & 1023; float v = n < 8 ? P.c[n * 1024 + k] : P.c_ctx[k];
        scond[idx] = v / (1.f + expf(-v));
      }
      __syncthreads();
      int col = tid & 63, kq = tid >> 6; float acc[9];
#pragma unroll
      for (int n = 0; n < 9; n++) acc[n] = 0.f;
      const float* w = P.w_mod + ((size_t)l * 1024 + kq * 256) * 6144 + col0 + col;
#pragma unroll 4
      for (int k = 0; k < 256; k++) {
        float wv = w[(size_t)k * 6144];
#pragma unroll
        for (int n = 0; n < 9; n++) acc[n] += scond[n * 1024 + kq * 256 + k] * wv;
      }
#pragma unroll
      for (int n = 0; n < 9; n++) red[(kq * 9 + n) * 64 + col] = acc[n];
      __syncthreads();
      for (int idx = tid; idx < 576; idx += 256) {
        int n = idx / 64, cc = idx % 64;
        float s = red[(0 * 9 + n) * 64 + cc] + red[(1 * 9 + n) * 64 + cc] + red[(2 * 9 + n) * 64 + cc] + red[(3 * 9 + n) * 64 + cc];
        P.mod[(size_t)(l * 9 + n) * 6144 + col0 + cc] = s + P.b_mod[l * 6144 + col0 + cc];
      }
      __syncthreads();
    } else {
      int m = t - NT - NF - NM;
      if (m == 0) {
        for (int idx = tid; idx < 128 * 16; idx += 256) {
          int pos = idx >> 4, i = idx & 15; float f = powf(10000.f, -(float)i / 16.f); float ang = (float)pos * f;
          float s, c; sincosf(ang, &s, &c); P.rope[idx] = make_float2(c, s);
        }
      } else if (m == 1) {
        for (int j = tid; j < 8192; j += 256) { float s, c; sincospif((float)j / 4096.f, &s, &c); P.tw[j] = make_float2(c, s); }
      } else if (m == 2) {
        for (int idx = tid; idx < 16384; idx += 256) {
          int mm = idx >> 7, k = idx & 127, part = mm >> 6, f1 = mm & 63, pp = k >> 6, a = k & 63;
          float s, c; sincospif((float)((a * f1) & 63) / 32.f, &s, &c);
          float v = part == 0 ? (pp == 0 ? c : s) : (pp == 0 ? -s : c);
          P.DA[idx] = (half_t)(v * 0.125f);
        }
      } else if (m == 3) {
        for (int idx = tid; idx < 32768; idx += 256) {
          int mm = idx >> 8, k = idx & 255, part = k >> 7, bb = k & 127;
          float s, c; sincospif((float)((bb * mm) & 127) / 64.f, &s, &c);
          P.DB[idx] = (half_t)((part == 0 ? c : s) * 0.08838834764831845f);
        }
      } else if (m == 4) {
        for (int idx = tid; idx < 131072; idx += 256) {
          int mm = idx >> 9, k = idx & 511, part = k >> 8, tt = k & 255;
          float s, c; sincospif((float)((tt * mm) & 255) / 128.f, &s, &c);
          P.DC[idx] = (half_t)((part == 0 ? c : s) * 0.0625f);
        }
      } else {
        for (int idx = tid; idx < 2 * 48 * 1024; idx += 256) {
          int l = idx / 49152, r = idx % 49152, col = r >> 10, k = r & 1023;
          float w = col < 4 ? P.w_group[((size_t)l * 1024 + k) * 4 + col] : (col < 36 ? P.w_router[((size_t)l * 1024 + k) * 32 + col - 4] : 0.f);
          half_t hi = (half_t)w, lo = (half_t)(w - (float)hi);
          P.WrH[(size_t)(l * 2) * 49152 + r] = hi; P.WrH[(size_t)(l * 2 + 1) * 49152 + r] = lo;
        }
        if (tid < 2) {
          int l = tid; float s1 = 0.f, s2 = 0.f, mq = 0.f, mk = 0.f;
          for (int i = 0; i < 64; i++) {
            s1 += P.lq1[l * 64 + i] * P.lk1[l * 64 + i]; s2 += P.lq2[l * 64 + i] * P.lk2[l * 64 + i];
            mq = fmaxf(mq, fabsf(P.q_norm_g[l * 64 + i])); mk = fmaxf(mk, fabsf(P.k_norm_g[l * 64 + i]));
          }
          float lam_init = 0.8f - 0.6f * expf(-0.3f * (float)l);
          P.consts[l * 4 + 0] = expf(s1) - expf(s2) + lam_init;
          P.consts[l * 4 + 1] = 8.f * mq * mk * 1.4426950408889634f * 1.002f - 15.f;
          P.consts[l * 4 + 2] = lam_init;
        }
        if (tid < 64) P.cnt[tid] = 0;
        if (tid < 64) P.qctr[tid] = 0;
      }
    }
  }
}

DI void row1_phase(const Params& P, int combine_l, int norm_l, int r_begin) {
  const int lane = TIDX & 63, gw = blockIdx.x * 4 + (TIDX >> 6), nw = gridDim.x * 4;
  for (int r = r_begin + gw; r < TA; r += nw) {
    const int n = row_mod(r);
    float v[16];
    if (combine_l < 0) {
      const float* src = r < TC ? P.ctx + (size_t)r * D : P.x + (size_t)(r - TC) * D;
#pragma unroll
      for (int i = 0; i < 4; i++) { float4 t = *(const float4*)(src + i * 256 + lane * 4); v[i*4] = t.x; v[i*4+1] = t.y; v[i*4+2] = t.z; v[i*4+3] = t.w; }
    } else {
      float* xm = r < TC ? P.xcbuf + (size_t)r * D : P.out + (size_t)(r - TC) * D;
      const float* g2 = P.mod + (size_t)(combine_l * 9 + n) * 6144 + 5 * 1024;
      const half_t* y0 = P.yA + (size_t)(2 * r) * D; const half_t* y1 = y0 + D;
#pragma unroll
      for (int i = 0; i < 4; i++) {
        int c = i * 256 + lane * 4;
        float4 t = *(const float4*)(xm + c); float4 g = *(const float4*)(g2 + c);
        h4 a = *(const h4*)(y0 + c); h4 b = *(const h4*)(y1 + c);
        t.x += g.x * ((float)a[0] + (float)b[0]); t.y += g.y * ((float)a[1] + (float)b[1]);
        t.z += g.z * ((float)a[2] + (float)b[2]); t.w += g.w * ((float)a[3] + (float)b[3]);
        *(float4*)(xm + c) = t;
        v[i*4] = t.x; v[i*4+1] = t.y; v[i*4+2] = t.z; v[i*4+3] = t.w;
      }
    }
    if (norm_l >= 0) {
      float ss = 0.f;
#pragma unroll
      for (int i = 0; i < 16; i++) ss += v[i] * v[i];
      ss = wave_sum(ss);
      const float rstd = rsqrtf(ss * (1.f / 1024.f) + EPS);
      const float* g = P.norm1_g + norm_l * 1024;
      const float* sh = P.mod + (size_t)(norm_l * 9 + n) * 6144; const float* sc = sh + 1024;
#pragma unroll
      for (int i = 0; i < 4; i++) {
        int c = i * 256 + lane * 4;
        float4 gg = *(const float4*)(g + c), s1 = *(const float4*)(sc + c), s0 = *(const float4*)(sh + c);
        h4 o;
        o[0] = (half_t)(v[i*4] * rstd * gg.x * (1.f + s1.x) + s0.x); o[1] = (half_t)(v[i*4+1] * rstd * gg.y * (1.f + s1.y) + s0.y);
        o[2] = (half_t)(v[i*4+2] * rstd * gg.z * (1.f + s1.z) + s0.z); o[3] = (half_t)(v[i*4+3] * rstd * gg.w * (1.f + s1.w) + s0.w);
        *(h4*)(P.hx + (size_t)r * D + c) = o;
      }
    }
  }
}

DI void row2_phase(const Params& P, int l, int r_begin, char* smem) {
  const int tid = TIDX, lane = tid & 63, wave = tid >> 6, fr = lane & 15, fq = lane >> 4;
  float* lg = (float*)smem + wave * 16 * 48;
  const half_t* Whi = P.WrH + (size_t)(l * 2) * 49152; const half_t* Wlo = Whi + 49152;
  const int ngroups = (TA - r_begin) >> 4, gw = blockIdx.x * 4 + wave, nw = gridDim.x * 4;
  const float* gam = P.norm2_g + l * 1024;
#pragma unroll 1
  for (int grp = gw; grp < ngroups; grp += nw) {
    const int r0 = r_begin + grp * 16, row = r0 + fr, n = row_mod(r0);
    const float* xm = (row < TC ? P.xcbuf + (size_t)row * D : P.out + (size_t)(row - TC) * D) + fq * 8;
    float ss = 0.f;
#pragma unroll 16
    for (int kk = 0; kk < 32; kk++) {
      const float4 a = *(const float4*)(xm + kk * 32), b = *(const float4*)(xm + kk * 32 + 4);
      ss += a.x * a.x + a.y * a.y + a.z * a.z + a.w * a.w + b.x * b.x + b.y * b.y + b.z * b.z + b.w * b.w;
    }
    ss += shx(ss, 16); ss += shx(ss, 32);
    const float rstd = rsqrtf(ss * (1.f / 1024.f) + EPS);
    const float* sh = P.mod + (size_t)(l * 9 + n) * 6144 + 3 * 1024 + fq * 8; const float* sc = sh + 1024;
    f4 acc[3];
#pragma unroll
    for (int i = 0; i < 3; i++) acc[i] = (f4){0.f, 0.f, 0.f, 0.f};
    half_t* hxo = P.hx + (size_t)row * D + fq * 8;
#pragma unroll 4
    for (int kk = 0; kk < 32; kk++) {
      const int k0 = kk * 32;
      float x[8], g[8], s1[8], s0[8];
      *(float4*)&x[0] = *(const float4*)(xm + k0); *(float4*)&x[4] = *(const float4*)(xm + k0 + 4);
      *(float4*)&g[0] = *(const float4*)(gam + fq * 8 + k0); *(float4*)&g[4] = *(const float4*)(gam + fq * 8 + k0 + 4);
      *(float4*)&s1[0] = *(const float4*)(sc + k0); *(float4*)&s1[4] = *(const float4*)(sc + k0 + 4);
      *(float4*)&s0[0] = *(const float4*)(sh + k0); *(float4*)&s0[4] = *(const float4*)(sh + k0 + 4);
      h8 hi, lo;
#pragma unroll
      for (int i = 0; i < 8; i++) {
        float v = x[i] * rstd * g[i] * (1.f + s1[i]) + s0[i];
        hi[i] = (half_t)v; lo[i] = (half_t)(v - (float)hi[i]);
      }
      *(h8*)(hxo + k0) = hi;
#pragma unroll
      for (int n3 = 0; n3 < 3; n3++) {
        h8 bh = *(const h8*)(Whi + (size_t)(n3 * 16 + fr) * 1024 + k0 + fq * 8);
        h8 bl = *(const h8*)(Wlo + (size_t)(n3 * 16 + fr) * 1024 + k0 + fq * 8);
        acc[n3] = mfma16(hi, bh, acc[n3]); acc[n3] = mfma16(lo, bh, acc[n3]); acc[n3] = mfma16(hi, bl, acc[n3]);
      }
    }
    __builtin_amdgcn_wave_barrier();
#pragma unroll
    for (int n3 = 0; n3 < 3; n3++)
#pragma unroll
      for (int j = 0; j < 4; j++) lg[(fq * 4 + j) * 48 + n3 * 16 + fr] = acc[n3][j];
    __builtin_amdgcn_wave_barrier();
    if (lane < 16) {
      const int r = r0 + lane;
      const float* L = lg + lane * 48;
      float gl[4]; int gi = 0;
#pragma unroll
      for (int j = 0; j < 4; j++) gl[j] = L[j] + P.b_group[l * 4 + j];
      float gm = gl[0];
#pragma unroll
      for (int j = 1; j < 4; j++) if (gl[j] > gm) { gm = gl[j]; gi = j; }
      float gs = 0.f;
#pragma unroll
      for (int j = 0; j < 4; j++) gs += expf(gl[j] - gm);
      const float pg = 1.f / gs;
      float el[8];
#pragma unroll
      for (int j = 0; j < 8; j++) el[j] = L[4 + gi * 8 + j] + P.b_router[l * 32 + gi * 8 + j];
      int i0 = 0; float v0 = el[0];
#pragma unroll
      for (int j = 1; j < 8; j++) if (el[j] > v0) { v0 = el[j]; i0 = j; }
      int i1 = -1; float v1 = -3.0e38f;
#pragma unroll
      for (int j = 0; j < 8; j++) if (j != i0 && el[j] > v1) { v1 = el[j]; i1 = j; }
      const float ex = expf(v1 - v0);
      const float w0 = pg / (1.f + ex), w1 = pg * ex / (1.f + ex);
      const int e0 = gi * 8 + i0, e1 = gi * 8 + i1;
      int p0 = atomicAdd(&P.cnt[l * 32 + e0], 1); P.list[(size_t)e0 * LCAP + p0] = 2 * r;
      int p1 = atomicAdd(&P.cnt[l * 32 + e1], 1); P.list[(size_t)e1 * LCAP + p1] = 2 * r + 1;
      P.tokW[2 * r] = w0; P.tokW[2 * r + 1] = w1;
    }
    __builtin_amdgcn_wave_barrier();
  }
}

DI h8 lds128(unsigned a) { h8 r; asm volatile("ds_read_b128 %0, %1" : "=v"(r) : "v"(a)); return r; }
DI void tie(h8& x) { asm volatile("" : "+v"(x)); }
DI unsigned lds_addr(const void* p) { return (unsigned)(size_t)p; }
#define WAIT_LGKM(n) asm volatile("s_waitcnt lgkmcnt(" #n ")" ::: "memory")
DI void raw_barrier() { asm volatile("" ::: "memory"); __builtin_amdgcn_s_barrier(); asm volatile("" ::: "memory"); }
DI void slot_rc(int i, int& row, int& coff) { int s = i * 256 + TIDX; row = s >> 3; coff = ((s & 7) ^ ((row >> 1) & 7)) * 8; }

template <class AF, class BF>
DI void gemm_prologue(AF aptr, BF bptr, int nk, char* smem) {
  const int tid = TIDX;
#pragma unroll
  for (int st = 0; st < 2; st++) {
    if (st < nk) {
      char* d = smem + st * 49152 + tid * 16;
#pragma unroll
      for (int i = 0; i < 8; i++) glds16(aptr(i) + st * 64, d + i * 4096);
#pragma unroll
      for (int i = 0; i < 4; i++) glds16(bptr(i) + st * 64, d + 32768 + i * 4096);
    }
  }
}
template <bool PRE = false, class AF, class BF>
DI void gemm256(AF aptr, BF bptr, int nk, char* smem, f4 (&acc)[8][4]) {
  const int tid = TIDX, lane = tid & 63, wave = tid >> 6, fr = lane & 15, fq = lane >> 4, wr = wave >> 1, wc = wave & 1;
#pragma unroll
  for (int m = 0; m < 8; m++)
#pragma unroll
    for (int n = 0; n < 4; n++) acc[m][n] = (f4){0.f, 0.f, 0.f, 0.f};
  auto issue = [&](int kt, int st) {
    char* d = smem + st * 49152 + tid * 16;
#pragma unroll
    for (int i = 0; i < 8; i++) glds16(aptr(i) + kt * 64, d + i * 4096);
#pragma unroll
    for (int i = 0; i < 4; i++) glds16(bptr(i) + kt * 64, d + 32768 + i * 4096);
  };
  const unsigned sw = (unsigned)((fq ^ (fr >> 1)) << 4);
  const unsigned offA = (wr * 128 + fr) * 128 + sw, offB = 32768 + (wc * 64 + fr) * 128 + sw;
  const unsigned sbase = lds_addr(smem);
  if (!PRE) { issue(0, 0); if (nk > 1) issue(1, 1); }
  int st = 0;
#pragma unroll 1
  for (int kt = 0; kt < nk; kt++) {
    if (kt + 1 < nk) asm volatile("s_waitcnt vmcnt(12)" ::: "memory"); else wait_vm0();
    raw_barrier();
    if (kt + 2 < nk) issue(kt + 2, st == 0 ? 2 : st - 1);
    const unsigned base = sbase + st * 49152;
    st = st == 2 ? 0 : st + 1;
    h8 a0[8], b0[4], a1[8], b1[4];
#pragma unroll
    for (int m = 0; m < 8; m++) a0[m] = lds128(base + offA + m * 2048);
#pragma unroll
    for (int n = 0; n < 4; n++) b0[n] = lds128(base + offB + n * 2048);
#pragma unroll
    for (int m = 0; m < 8; m++) a1[m] = lds128(base + (offA ^ 64) + m * 2048);
#pragma unroll
    for (int n = 0; n < 4; n++) b1[n] = lds128(base + (offB ^ 64) + n * 2048);
    WAIT_LGKM(12);
#pragma unroll
    for (int m = 0; m < 8; m++) tie(a0[m]);
#pragma unroll
    for (int n = 0; n < 4; n++) tie(b0[n]);
#pragma unroll
    for (int m = 0; m < 8; m++)
#pragma unroll
      for (int n = 0; n < 4; n++) acc[m][n] = mfma16(a0[m], b0[n], acc[m][n]);
    WAIT_LGKM(0);
#pragma unroll
    for (int m = 0; m < 8; m++) tie(a1[m]);
#pragma unroll
    for (int n = 0; n < 4; n++) tie(b1[n]);
#pragma unroll
    for (int m = 0; m < 8; m++)
#pragma unroll
      for (int n = 0; n < 4; n++) acc[m][n] = mfma16(a1[m], b1[n], acc[m][n]);
  }
  raw_barrier();
}
DI bool xcd_tile(int it, int MT, int NT, int& mt, int& nt) {
  const int x = blockIdx.x & 7, j = blockIdx.x >> 3;
  const int nsn = NT >> 2, nsm = (MT + 7) >> 3;
  const int s = x + 8 * it;
  if (s >= nsm * nsn) return false;
  const int sm = s / nsn, sn = s % nsn;
  mt = sm * 8 + (j >> 2); nt = sn * 4 + (j & 3);
  return true;
}
DI bool next_tile(int& it, int MT, int NT, int& mt, int& nt) {
  for (;; it++) {
    if (!xcd_tile(it, MT, NT, mt, nt)) return false;
    if (mt < MT) return true;
  }
}
DI int slot_col() { int t = TIDX; return ((t & 7) ^ ((t >> 4) & 7)) * 8; }

DI float dpp_row_sum(float v) {
  v += __builtin_bit_cast(float, __builtin_amdgcn_update_dpp(0, __builtin_bit_cast(int, v), 0x128, 0xf, 0xf, false));
  v += __builtin_bit_cast(float, __builtin_amdgcn_update_dpp(0, __builtin_bit_cast(int, v), 0x124, 0xf, 0xf, false));
  v += __builtin_bit_cast(float, __builtin_amdgcn_update_dpp(0, __builtin_bit_cast(int, v), 0x122, 0xf, 0xf, false));
  v += __builtin_bit_cast(float, __builtin_amdgcn_update_dpp(0, __builtin_bit_cast(int, v), 0x121, 0xf, 0xf, false));
  return v;
}
DI void stage_put(char* stg, int ml, int n, int j, int fr, int fq, float v) { *(half_t*)(stg + (ml * 16 + fq * 4 + j) * 144 + (n * 16 + fr) * 2) = (half_t)v; }
template <class RP, class SC>
DI void stage_flush(char* stg, int h, RP rowptr, SC rowscale) {
  const int lane = TIDX & 63;
  __builtin_amdgcn_wave_barrier();
#pragma unroll
  for (int i = 0; i < 8; i++) {
    const int c = i * 64 + lane, row = c >> 3, c16 = c & 7;
    h8 v = *(const h8*)(stg + row * 144 + c16 * 16);
    half_t* d = rowptr(h * 64 + row);
    if (d) { rowscale(h * 64 + row, v); *(h8*)(d + c16 * 8) = v; }
  }
  __builtin_amdgcn_wave_barrier();
}
template <class VF, class RP, class SC>
DI void wave_store_tile(VF val, char* stg, RP rowptr, SC rowscale) {
  const int lane = TIDX & 63, fr = lane & 15, fq = lane >> 4;
#pragma unroll
  for (int h = 0; h < 2; h++) {
#pragma unroll
    for (int ml = 0; ml < 4; ml++)
#pragma unroll
      for (int n = 0; n < 4; n++)
#pragma unroll
        for (int j = 0; j < 4; j++) stage_put(stg, ml, n, j, fr, fq, val(h * 4 + ml, n, j));
    stage_flush(stg, h, rowptr, rowscale);
  }
}
DI void gemm_in_phase(const Params& P, int l, char* smem) {
  const int tid = TIDX;
  const half_t* Wt = P.WtIn + (size_t)l * NIN * 1024;
  const int sc = slot_col(), srow = tid >> 3;
  {
    float2* rcl = (float2*)(smem + 147456);
    for (int i = tid; i < 1024; i += 256) rcl[i] = P.rope[i];
    __syncthreads();
  }
  int it = 0, mt, nt;
  bool have = next_tile(it, 264, 20, mt, nt);
  const half_t* a0 = nullptr; const half_t* b0 = nullptr;
  if (have) {
    asm volatile("" : "+s"(mt), "+s"(nt));
    a0 = P.hx + (size_t)(mt * 256 + srow) * D + sc; b0 = Wt + (size_t)(nt * 128 + srow) * D + sc;
    gemm_prologue([&](int i) { return a0 + (size_t)i * 32 * D; }, [&](int i) { return b0 + (size_t)i * 32 * D; }, 16, smem);
  }
#pragma unroll 1
  while (have) {
    f4 acc[8][4];
    gemm256<true>([&](int i) { return a0 + (size_t)i * 32 * D; }, [&](int i) { return b0 + (size_t)i * 32 * D; }, 16, smem, acc);
    const int tid2 = TIDX, lane = tid2 & 63, wave = tid2 >> 6, fr = lane & 15, fq = lane >> 4, wr = wave >> 1, wc = wave & 1;
    const int r0 = mt * 256 + wr * 128;
    const bool isctx = r0 < TC;
    int b, pos0;
    if (isctx) { b = r0 >> 8; pos0 = r0 & 255; } else { b = (r0 - TC) >> 13; pos0 = 256 + ((r0 - TC) & 8191); }
    const bool isqk = nt >= 4 && nt < 12;
    float gg[4] = {0.f, 0.f, 0.f, 0.f}; float2 rr2[2] = {make_float2(1.f, 0.f), make_float2(1.f, 0.f)};
    if (isqk) {
      const float* gvec = (nt < 8 ? P.q_norm_g : P.k_norm_g) + l * 64;
      const float qs = nt < 8 ? 0.125f * 1.4426950408889634f : 1.f;
#pragma unroll
      for (int n = 0; n < 4; n++) gg[n] = gvec[n * 16 + fr] * qs;
      if (!isctx) { const int tp0 = pos0 - 256; rr2[0] = P.rope[(tp0 >> 6) * 16 + fr]; rr2[1] = P.rope[((tp0 >> 6) + 1) * 16 + fr]; }
    }
#pragma unroll
    for (int n = 0; n < 4; n++) asm volatile("" : "+v"(gg[n]));
    asm volatile("" : "+v"(rr2[0].x), "+v"(rr2[0].y), "+v"(rr2[1].x), "+v"(rr2[1].y));
    int it2 = it + 1, mt2, nt2;
    const bool have2 = next_tile(it2, 264, 20, mt2, nt2);
    const half_t* a1 = a0; const half_t* b1 = b0;
    if (have2) {
      asm volatile("" : "+s"(mt2), "+s"(nt2));
      a1 = P.hx + (size_t)(mt2 * 256 + srow) * D + sc; b1 = Wt + (size_t)(nt2 * 128 + srow) * D + sc;
      gemm_prologue([&](int i) { return a1 + (size_t)i * 32 * D; }, [&](int i) { return b1 + (size_t)i * 32 * D; }, 16, smem);
    }
    char* stg = smem + 98304 + wave * 12288;
    auto noscale = [](int, h8&) {};
    if (nt < 4 || nt >= 16) {
      half_t* dst; int ld, c0; bool gel = false;
      if (nt < 4) { dst = P.QF; ld = 512; c0 = nt * 128; }
      else if (nt < 18) { dst = P.gy; ld = 256; c0 = (nt - 16) * 128; gel = true; }
      else { dst = P.rr; ld = 256; c0 = (nt - 18) * 128; }
      half_t* base = dst + (size_t)r0 * ld + c0 + wc * 64;
      if (gel) wave_store_tile([&](int m, int n, int j) { return gelu_tanh(acc[m][n][j]); }, stg, [&](int r) { return base + (size_t)r * ld; }, noscale);
      else wave_store_tile([&](int m, int n, int j) { return acc[m][n][j]; }, stg, [&](int r) { return base + (size_t)r * ld; }, noscale);
    } else if (nt < 12) {
      const bool isq = nt < 8; const int head = isq ? nt - 4 : nt - 8;
      const float2* rcl = (const float2*)(smem + 147456);
      half_t* base = (isq ? P.q + (size_t)r0 * 512 : P.kall + ((size_t)b * KV + pos0) * 512) + head * 128 + wc * 64;
#pragma unroll
      for (int mh = 0; mh < 2; mh++) {
#pragma unroll
        for (int mm = 0; mm < 4; mm++) {
          const int m = mh * 4 + mm;
#pragma unroll
          for (int j = 0; j < 4; j++) {
            float ss = 0.f;
#pragma unroll
            for (int n = 0; n < 4; n++) ss += acc[m][n][j] * acc[m][n][j];
            ss = dpp_row_sum(ss);
            const float rstd = rsqrtf(ss * (1.f / 64.f) + EPS);
            float o[4];
#pragma unroll
            for (int n = 0; n < 4; n++) o[n] = acc[m][n][j] * rstd * gg[n];
            if (!isctx) {
              const float2 cr = rr2[mh], cc = rcl[(mm * 16 + fq * 4 + j) * 16 + fr];
              float a0 = o[0] * cr.x - o[1] * cr.y, a1 = o[1] * cr.x + o[0] * cr.y;
              float a2 = o[2] * cc.x - o[3] * cc.y, a3 = o[3] * cc.x + o[2] * cc.y;
              o[0] = a0; o[1] = a1; o[2] = a2; o[3] = a3;
            }
#pragma unroll
            for (int n = 0; n < 4; n++) stage_put(stg, mm, n, j, fr, fq, o[n]);
          }
        }
        stage_flush(stg, mh, [&](int r) { return base + (size_t)r * 512; }, noscale);
      }
    } else {
      const int head = nt - 12;
#pragma unroll
      for (int m = 0; m < 8; m++)
#pragma unroll
        for (int n = 0; n < 4; n++) {
          h4 o; o[0] = (half_t)acc[m][n][0]; o[1] = (half_t)acc[m][n][1]; o[2] = (half_t)acc[m][n][2]; o[3] = (half_t)acc[m][n][3];
          int d = wc * 64 + n * 16 + fr;
          asm volatile("" : "+v"(d) :: "memory");
          *(h4*)(P.vT + ((size_t)(b * 4 + head) * 128 + d) * KV + pos0 + m * 16 + fq * 4) = o;
        }
    }
    mt = mt2; nt = nt2; it = it2; have = have2; a0 = a1; b0 = b1;
  }
}

DI void gemm_out_phase(const Params& P, int l, char* smem) {
  const int tid = TIDX, lane = tid & 63, wave = tid >> 6, fr = lane & 15, fq = lane >> 4, wr = wave >> 1, wc = wave & 1;
  const half_t* Wt = P.WtOut + (size_t)l * 1048576;
  const int mt0 = l == 0 ? 0 : TC / 256;
  const int sc = slot_col(), srow = tid >> 3;
#pragma unroll 1
  for (int it = 0;; it++) {
    int mt, nt;
    if (!xcd_tile(it, 264 - mt0, 8, mt, nt)) break;
    mt += mt0;
    if (mt >= 264) continue;
    asm volatile("" : "+s"(mt), "+s"(nt));
    f4 acc[8][4];
    {
      const half_t* a0 = P.mix + (size_t)(mt * 256 + srow) * D + sc; const half_t* b0 = Wt + (size_t)(nt * 128 + srow) * D + sc;
      gemm256([&](int i) { return a0 + (size_t)i * 32 * D; }, [&](int i) { return b0 + (size_t)i * 32 * D; }, 16, smem, acc);
    }
    const int r0 = mt * 256 + wr * 128;
    const int n = row_mod(r0);
    const float* g1 = P.mod + (size_t)(l * 9 + n) * 6144 + 2 * 1024;
    const float* res; float* dst;
    if (r0 < TC) { res = P.ctx + (size_t)r0 * D; dst = P.xcbuf + (size_t)r0 * D; }
    else { dst = P.out + (size_t)(r0 - TC) * D; res = l == 0 ? P.x + (size_t)(r0 - TC) * D : dst; }
#pragma unroll
    for (int m = 0; m < 8; m++) {
      int rb = m * 16 + fq * 4;
      asm volatile("" : "+v"(rb) :: "memory");
#pragma unroll
      for (int nn = 0; nn < 4; nn++) {
        const int c = nt * 128 + wc * 64 + nn * 16 + fr; const float g = g1[c];
#pragma unroll
        for (int j = 0; j < 4; j++) { size_t o = (size_t)(rb + j) * D + c; dst[o] = res[o] + g * acc[m][nn][j]; }
      }
    }
  }
}

DI void moe_prefix(const Params& P, int l, int* tb) {
  __syncthreads();
  if (TIDX == 0) { int s = 0; for (int e = 0; e < 32; e++) { tb[e] = s; s += (P.cnt[l * 32 + e] + 255) >> 8; } tb[32] = s; }
  __syncthreads();
}
DI void moe_e1_phase(const Params& P, int l, char* smem, int* tb) {
  const int tid = TIDX;
  moe_prefix(P, l, tb);
  const int sc = slot_col(), srow = tid >> 3;
  const int MT = tb[32];
  auto setup = [&](int rt, int nt, int (&tok)[8], const half_t*& w1, const half_t*& w3) {
    int e = 0;
    while (tb[e + 1] <= rt) e++;
    const int rl = rt - tb[e], cnt = P.cnt[l * 32 + e];
    const int* lst = P.list + (size_t)e * LCAP;
    w1 = P.Wt1 + ((size_t)(l * 32 + e) * 512 + nt * 64) * 1024 + sc;
    w3 = P.Wt3 + ((size_t)(l * 32 + e) * 512 + nt * 64) * 1024 + sc;
#pragma unroll
    for (int i = 0; i < 8; i++) tok[i] = lst[min(rl * 256 + i * 32 + srow, cnt - 1)] >> 1;
  };
  int it = 0, rt, nt;
  bool have = next_tile(it, MT, 8, rt, nt);
  int tok[8]; const half_t* w1 = nullptr; const half_t* w3 = nullptr;
  if (have) {
    asm volatile("" : "+s"(rt), "+s"(nt));
    setup(rt, nt, tok, w1, w3);
    gemm_prologue([&](int i) { return P.hx + (size_t)tok[i] * D + sc; }, [&](int i) { return ((i & 1) ? w3 : w1) + (size_t)((i >> 1) * 32 + srow) * 1024; }, 16, smem);
  }
#pragma unroll 1
  while (have) {
    f4 acc[8][4];
    gemm256<true>([&](int i) { return P.hx + (size_t)tok[i] * D + sc; },
                  [&](int i) { return ((i & 1) ? w3 : w1) + (size_t)((i >> 1) * 32 + srow) * 1024; }, 16, smem, acc);
    int it2 = it + 1, rt2, nt2;
    const bool have2 = next_tile(it2, MT, 8, rt2, nt2);
    int tok2[8]; const half_t* w1n = w1; const half_t* w3n = w3;
#pragma unroll
    for (int i = 0; i < 8; i++) tok2[i] = tok[i];
    if (have2) {
      asm volatile("" : "+s"(rt2), "+s"(nt2));
      setup(rt2, nt2, tok2, w1n, w3n);
      gemm_prologue([&](int i) { return P.hx + (size_t)tok2[i] * D + sc; }, [&](int i) { return ((i & 1) ? w3n : w1n) + (size_t)((i >> 1) * 32 + srow) * 1024; }, 16, smem);
    }
    {
      const int tid2 = TIDX, lane2 = tid2 & 63, wave2 = tid2 >> 6, fr2 = lane2 & 15, fq2 = lane2 >> 4, wr2 = wave2 >> 1, wc2 = wave2 & 1;
      char* stg = smem + 98304 + wave2 * 12288;
      half_t* Hd = P.H + ((size_t)rt * 256 + wr2 * 128) * 512 + nt * 64 + wc2 * 32;
#pragma unroll
      for (int h = 0; h < 2; h++) {
#pragma unroll
        for (int ml = 0; ml < 4; ml++)
#pragma unroll
          for (int n = 0; n < 2; n++)
#pragma unroll
            for (int j = 0; j < 4; j++) {
              float a1 = acc[h * 4 + ml][n][j], a3 = acc[h * 4 + ml][n + 2][j];
              *(half_t*)(stg + (ml * 16 + fq2 * 4 + j) * 80 + (n * 16 + fr2) * 2) = (half_t)(a1 * sigmoidf_(a1) * a3);
            }
        __builtin_amdgcn_wave_barrier();
#pragma unroll
        for (int i = 0; i < 4; i++) {
          const int c = i * 64 + lane2, row = c >> 2, c16 = c & 3;
          h8 v = *(const h8*)(stg + row * 80 + c16 * 16);
          *(h8*)(Hd + (size_t)(h * 64 + row) * 512 + c16 * 8) = v;
        }
        __builtin_amdgcn_wave_barrier();
      }
    }
    rt = rt2; nt = nt2; it = it2; have = have2; w1 = w1n; w3 = w3n;
#pragma unroll
    for (int i = 0; i < 8; i++) tok[i] = tok2[i];
  }
}
DI void moe_e2_phase(const Params& P, int l, char* smem, int* tb) {
  const int tid = TIDX;
  moe_prefix(P, l, tb);
  const int sc = slot_col(), srow = tid >> 3;
  const int MT = tb[32];
  auto ptrs = [&](int rt, int nt, const half_t*& a0, const half_t*& b0) {
    int e = 0;
    while (tb[e + 1] <= rt) e++;
    a0 = P.H + ((size_t)rt * 256 + srow) * 512 + sc;
    b0 = P.Wt2 + ((size_t)(l * 32 + e) * 1024 + nt * 128 + srow) * 512 + sc;
  };
  int it = 0, rt, nt;
  bool have = next_tile(it, MT, 8, rt, nt);
  const half_t* a0 = nullptr; const half_t* b0 = nullptr;
  if (have) {
    asm volatile("" : "+s"(rt), "+s"(nt));
    ptrs(rt, nt, a0, b0);
    gemm_prologue([&](int i) { return a0 + (size_t)i * 32 * 512; }, [&](int i) { return b0 + (size_t)i * 32 * 512; }, 8, smem);
  }
#pragma unroll 1
  while (have) {
    f4 acc[8][4];
    gemm256<true>([&](int i) { return a0 + (size_t)i * 32 * 512; }, [&](int i) { return b0 + (size_t)i * 32 * 512; }, 8, smem, acc);
    const int tid2 = TIDX, lane2 = tid2 & 63, wave2 = tid2 >> 6, wr2 = wave2 >> 1, wc2 = wave2 & 1;
    int e = 0;
    while (tb[e + 1] <= rt) e++;
    const int rl = rt - tb[e], cnt = P.cnt[l * 32 + e];
    const int* lst = P.list + (size_t)e * LCAP;
    int aa[2][8]; float ww[2][8];
#pragma unroll
    for (int h = 0; h < 2; h++)
#pragma unroll
      for (int i = 0; i < 8; i++) {
        const int idx = rl * 256 + wr2 * 128 + h * 64 + ((i * 64 + lane2) >> 3);
        aa[h][i] = idx < cnt ? lst[idx] : -1;
      }
#pragma unroll
    for (int h = 0; h < 2; h++)
#pragma unroll
      for (int i = 0; i < 8; i++) ww[h][i] = aa[h][i] >= 0 ? P.tokW[aa[h][i]] : 0.f;
#pragma unroll
    for (int h = 0; h < 2; h++)
#pragma unroll
      for (int i = 0; i < 8; i++) asm volatile("" : "+v"(ww[h][i]), "+v"(aa[h][i]));
    int it2 = it + 1, rt2, nt2;
    const bool have2 = next_tile(it2, MT, 8, rt2, nt2);
    const half_t* a1 = a0; const half_t* b1 = b0;
    if (have2) {
      asm volatile("" : "+s"(rt2), "+s"(nt2));
      ptrs(rt2, nt2, a1, b1);
      gemm_prologue([&](int i) { return a1 + (size_t)i * 32 * 512; }, [&](int i) { return b1 + (size_t)i * 32 * 512; }, 8, smem);
    }
    {
      char* stg = smem + 98304 + wave2 * 12288;
      const int fr2 = lane2 & 15, fq2 = lane2 >> 4;
#pragma unroll
      for (int h = 0; h < 2; h++) {
#pragma unroll
        for (int ml = 0; ml < 4; ml++)
#pragma unroll
          for (int n = 0; n < 4; n++)
#pragma unroll
            for (int j = 0; j < 4; j++) stage_put(stg, ml, n, j, fr2, fq2, acc[h * 4 + ml][n][j]);
        __builtin_amdgcn_wave_barrier();
#pragma unroll
        for (int i = 0; i < 8; i++) {
          const int c = i * 64 + lane2, row = c >> 3, c16 = c & 7;
          h8 v = *(const h8*)(stg + row * 144 + c16 * 16);
          if (aa[h][i] >= 0) {
            const float w = ww[h][i];
#pragma unroll
            for (int u = 0; u < 8; u++) v[u] = (half_t)(w * (float)v[u]);
            *(h8*)(P.yA + (size_t)aa[h][i] * D + nt * 128 + wc2 * 64 + c16 * 8) = v;
          }
        }
        __builtin_amdgcn_wave_barrier();
      }
    }
    rt = rt2; nt = nt2; it = it2; have = have2; a0 = a1; b0 = b1;
  }
}

DI int swap23(int x) { return (x & ~12) | ((x & 4) << 1) | ((x & 8) >> 1); }
DI void attn_item(const Params& P, int l, int b, int head, int row0, int nkeys, char* smem) {
  const int tid = TIDX, lane = tid & 63, wave = tid >> 6, ql = lane & 31, hh = lane >> 5;
  const float lam = P.consts[l * 4 + 0], negc = -P.consts[l * 4 + 1], lam_init = P.consts[l * 4 + 2];
  const int myrow = row0 + wave * 32 + ql;
  h8 qf[2][4];
  {
    const half_t* qp = P.q + (size_t)myrow * 512 + head * 128 + hh * 8;
#pragma unroll
    for (int m = 0; m < 2; m++)
#pragma unroll
      for (int s = 0; s < 4; s++) { qf[m][s] = *(const h8*)(qp + m * 64 + s * 16); }
#pragma unroll
    for (int m = 0; m < 2; m++)
#pragma unroll
      for (int s = 0; s < 4; s++) tie(qf[m][s]);
  }
  f16v o0[4], o1[4];
#pragma unroll
  for (int dt = 0; dt < 4; dt++)
#pragma unroll
    for (int i = 0; i < 16; i++) { o0[dt][i] = 0.f; o1[dt][i] = 0.f; }
  float ls0 = 0.f, ls1 = 0.f;
  const half_t* kp[4]; const half_t* vp[4];
  {
    const half_t* kbase = P.kall + (size_t)b * KV * 512 + head * 128;
    const half_t* vbase = P.vT + (size_t)(b * 4 + head) * 128 * KV;
#pragma unroll
    for (int i = 0; i < 4; i++) {
      int s = i * 256 + tid;
      int row = s >> 4, c = (s & 15) ^ (row & 15); kp[i] = kbase + (size_t)row * 512 + c * 8;
      int vr = s >> 3, vc = (s & 7) ^ ((vr >> 1) & 7); vp[i] = vbase + (size_t)vr * KV + vc * 8;
    }
  }
  const int ntile = nkeys >> 6;
  const unsigned sbase = lds_addr(smem);
  auto issue = [&](int t) {
    char* d = smem + (t % 3) * 32768 + tid * 16;
#pragma unroll
    for (int i = 0; i < 4; i++) { glds16(kp[i] + (size_t)t * 64 * 512, d + i * 4096); glds16(vp[i] + t * 64, d + 16384 + i * 4096); }
  };
  unsigned koff[2];
  const int kr_lo = swap23(ql), ksw = kr_lo & 15;
  koff[0] = kr_lo * 256; koff[1] = (32 + kr_lo) * 256;
  unsigned voff[4];
#pragma unroll
  for (int dt = 0; dt < 4; dt++) { int vrow = dt * 32 + ql; voff[dt] = 16384 + vrow * 128; }
  const int vsw = (ql >> 1) & 7;
  f16v negcv;
#pragma unroll
  for (int i = 0; i < 16; i++) negcv[i] = negc;
  h8 pp0[2], pp1[2];
  unsigned pendV = 0; int pendkt = 0; bool pend = false;
  auto half_step = [&](h8 (&kf)[8], unsigned cur, int kt) {
    h8 vf[8];
    if (pend) {
#pragma unroll
      for (int sp = 0; sp < 2; sp++)
#pragma unroll
        for (int dt = 0; dt < 4; dt++) vf[sp * 4 + dt] = lds128(pendV + voff[dt] + (((pendkt * 4 + sp * 2 + hh) ^ vsw) << 4));
    }
    f16v s0 = mfma32(kf[0], qf[0][0], negcv), s1 = mfma32(kf[4], qf[1][0], negcv);
#pragma unroll
    for (int st = 1; st < 4; st++) { s0 = mfma32(kf[st], qf[0][st], s0); s1 = mfma32(kf[4 + st], qf[1][st], s1); }
    if (pend) {
      WAIT_LGKM(0);
#pragma unroll
      for (int i = 0; i < 8; i++) tie(vf[i]);
#pragma unroll
      for (int sp = 0; sp < 2; sp++)
#pragma unroll
        for (int dt = 0; dt < 4; dt++) { o0[dt] = mfma32(vf[sp * 4 + dt], pp0[sp], o0[dt]); o1[dt] = mfma32(vf[sp * 4 + dt], pp1[sp], o1[dt]); }
    }
#pragma unroll
    for (int i = 0; i < 16; i++) { s0[i] = __builtin_amdgcn_exp2f(s0[i]); ls0 += s0[i]; s1[i] = __builtin_amdgcn_exp2f(s1[i]); ls1 += s1[i]; }
#pragma unroll
    for (int sp = 0; sp < 2; sp++) {
      u4 a, c;
      a[0] = pk2(s0[8*sp+0], s0[8*sp+1]); a[1] = pk2(s0[8*sp+2], s0[8*sp+3]); a[2] = pk2(s0[8*sp+4], s0[8*sp+5]); a[3] = pk2(s0[8*sp+6], s0[8*sp+7]);
      c[0] = pk2(s1[8*sp+0], s1[8*sp+1]); c[1] = pk2(s1[8*sp+2], s1[8*sp+3]); c[2] = pk2(s1[8*sp+4], s1[8*sp+5]); c[3] = pk2(s1[8*sp+6], s1[8*sp+7]);
      pp0[sp] = __builtin_bit_cast(h8, a); pp1[sp] = __builtin_bit_cast(h8, c);
    }
    pend = true; pendV = cur; pendkt = kt;
  };
  issue(0);
#pragma unroll 1
  for (int t = 0; t < ntile; t++) {
    wait_vm0();
    raw_barrier();
    if (t + 1 < ntile) issue(t + 1);
    const unsigned cur = sbase + (t % 3) * 32768;
    h8 kfa[8], kfb[8];
#pragma unroll
    for (int st = 0; st < 4; st++) {
      kfa[st] = lds128(cur + koff[0] + (((st * 2 + hh) ^ ksw) << 4));
      kfa[4 + st] = lds128(cur + koff[0] + (((8 + st * 2 + hh) ^ ksw) << 4));
    }
#pragma unroll
    for (int st = 0; st < 4; st++) {
      kfb[st] = lds128(cur + koff[1] + (((st * 2 + hh) ^ ksw) << 4));
      kfb[4 + st] = lds128(cur + koff[1] + (((8 + st * 2 + hh) ^ ksw) << 4));
    }
    WAIT_LGKM(8);
#pragma unroll
    for (int i = 0; i < 8; i++) tie(kfa[i]);
    half_step(kfa, cur, 0);
    WAIT_LGKM(0);
#pragma unroll
    for (int i = 0; i < 8; i++) tie(kfb[i]);
    half_step(kfb, cur, 1);
  }
  {
    h8 vf[8];
#pragma unroll
    for (int sp = 0; sp < 2; sp++)
#pragma unroll
      for (int dt = 0; dt < 4; dt++) vf[sp * 4 + dt] = lds128(pendV + voff[dt] + (((pendkt * 4 + sp * 2 + hh) ^ vsw) << 4));
    WAIT_LGKM(0);
#pragma unroll
    for (int i = 0; i < 8; i++) tie(vf[i]);
#pragma unroll
    for (int sp = 0; sp < 2; sp++)
#pragma unroll
      for (int dt = 0; dt < 4; dt++) { o0[dt] = mfma32(vf[sp * 4 + dt], pp0[sp], o0[dt]); o1[dt] = mfma32(vf[sp * 4 + dt], pp1[sp], o1[dt]); }
  }
  raw_barrier();
  ls0 += shx(ls0, 32); ls1 += shx(ls1, 32);
  const float i0 = 1.f / ls0, i1 = lam / ls1;
  float ss = 0.f;
#pragma unroll
  for (int dt = 0; dt < 4; dt++)
#pragma unroll
    for (int i = 0; i < 16; i++) { float v = o0[dt][i] * i0 - o1[dt][i] * i1; o0[dt][i] = v; ss += v * v; }
  ss += shx(ss, 32);
  const float mult = rsqrtf(ss * (1.f / 128.f) + EPS) * (1.f - lam_init);
  const float* sg = P.subln_g + l * 128;
  half_t* dst = P.mix + (size_t)myrow * D + 256 + head * 128;
#pragma unroll
  for (int dt = 0; dt < 4; dt++)
#pragma unroll
    for (int g = 0; g < 4; g++) {
      const int d0 = dt * 32 + 8 * g + 4 * hh;
      float4 gv = *(const float4*)(sg + d0);
      h4 o; o[0] = (half_t)(o0[dt][4*g] * mult * gv.x); o[1] = (half_t)(o0[dt][4*g+1] * mult * gv.y);
      o[2] = (half_t)(o0[dt][4*g+2] * mult * gv.z); o[3] = (half_t)(o0[dt][4*g+3] * mult * gv.w);
      *(h4*)(dst + d0) = o;
    }
}

DI int swz128(int row, int colh) { return row * 128 + ((((colh >> 3)) ^ ((row >> 1) & 7)) << 4) + (colh & 7) * 2; }
DI void lru_load_w(const Params& P, int l, int g, char* Wt) {
  const int tid = TIDX;
  for (int dg = 0; dg < 4; dg++) {
    const int dir = dg >> 1;
    const float* w = ((dg & 1) ? P.gate_x_w : P.gate_a_w) + ((size_t)((l * 2 + dir) * 4 + g)) * 4096;
    for (int idx = tid; idx < 4096; idx += 256) { int i = idx >> 6, o = idx & 63; *(half_t*)(Wt + dg * 8192 + swz128(o, i)) = (half_t)w[idx]; }
  }
}
DI void lru_tile(const Params& P, int l, int b, int tile, int g, char* smem, bool final) {
  const int tid = TIDX, lane = tid & 63, wave = tid >> 6, fr = lane & 15, fq = lane >> 4;
  char* Wt = smem;
  char* xr16 = smem + 32768;
  float2* ab = (float2*)(smem + 40960);
  half_t* raw = (half_t*)(smem + 40960);
  float2* subst = (float2*)(smem + 73728);
  const int ch = tid & 63, tq = tid >> 6, gc = g * 64 + ch;
  const int T = tile < 4 ? CL : SEQ;
  const int t0 = tile < 4 ? tile * 64 : (tile - 4) * 64;
  const int rowbase = tile < 4 ? b * CL : TC + b * SEQ;
  __syncthreads();
  for (int idx = tid; idx < 67 * 8; idx += 256) {
    int row = idx >> 3, c = idx & 7, tt = t0 - 1 + row;
    h8 v = {0, 0, 0, 0, 0, 0, 0, 0};
    if (tt >= 0 && tt < T) v = *(const h8*)(P.rr + (size_t)(rowbase + tt) * 256 + g * 64 + c * 8);
    *(h8*)(raw + row * 64 + c * 8) = v;
  }
  float gyv[16];
  if (final) {
#pragma unroll
    for (int e = 0; e < 16; e++) gyv[e] = (float)P.gy[(size_t)(rowbase + t0 + tq * 16 + e) * 256 + gc];
  }
  const float cw0 = P.conv_w[(l * 4 + 0) * 256 + gc], cw1 = P.conv_w[(l * 4 + 1) * 256 + gc], cw2 = P.conv_w[(l * 4 + 2) * 256 + gc],
              cw3 = P.conv_w[(l * 4 + 3) * 256 + gc], cb = P.conv_b[l * 256 + gc];
  __syncthreads();
  {
    float v[19];
#pragma unroll
    for (int e = 0; e < 19; e++) v[e] = (float)raw[(tq * 16 + e) * 64 + ch];
    __syncthreads();
#pragma unroll
    for (int e = 0; e < 16; e++) {
      float xv = cb + cw0 * v[e] + cw1 * v[e + 1] + cw2 * v[e + 2] + cw3 * v[e + 3];
      *(half_t*)(xr16 + swz128(tq * 16 + e, ch)) = (half_t)xv;
    }
  }
  __syncthreads();
  float hsum[16];
#pragma unroll
  for (int e = 0; e < 16; e++) hsum[e] = 0.f;
#pragma unroll 1
  for (int dir = 0; dir < 2; dir++) {
    {
      f4 acc[2][4];
#pragma unroll
      for (int gt = 0; gt < 2; gt++)
#pragma unroll
        for (int n = 0; n < 4; n++) acc[gt][n] = (f4){0.f, 0.f, 0.f, 0.f};
#pragma unroll
      for (int kk = 0; kk < 2; kk++) {
        int row = wave * 16 + fr;
        h8 af = *(const h8*)(xr16 + row * 128 + (((kk * 4 + fq) ^ ((row >> 1) & 7)) << 4));
#pragma unroll
        for (int gt = 0; gt < 2; gt++)
#pragma unroll
          for (int n = 0; n < 4; n++) {
            int orow = n * 16 + fr;
            h8 bf = *(const h8*)(Wt + (dir * 2 + gt) * 8192 + orow * 128 + (((kk * 4 + fq) ^ ((orow >> 1) & 7)) << 4));
            acc[gt][n] = mfma16(af, bf, acc[gt][n]);
          }
      }
#pragma unroll
      for (int n = 0; n < 4; n++) {
        const int cc = (l * 2 + dir) * 256 + g * 64 + n * 16 + fr;
        const float ba = P.gate_a_b[cc], bx = P.gate_x_b[cc];
        const float sp8 = -8.f * log1pf(__expf(-P.lru_lambda[cc]));
#pragma unroll
        for (int j = 0; j < 4; j++) {
          int tl = wave * 16 + fq * 4 + j, c2 = n * 16 + fr;
          float xv = (float)*(const half_t*)(xr16 + swz128(tl, c2));
          float rg = sigmoidf_(acc[0][n][j] + ba), ig = sigmoidf_(acc[1][n][j] + bx);
          float log_a = rg * sp8;
          float a = __expf(log_a);
          float x2 = 2.f * log_a;
          float om = -x2 * (1.f + x2 * (0.5f + x2 * (0.16666667f + x2 * (0.041666668f + x2 * (0.008333334f + x2 * 0.0013888889f)))));
          om = x2 < -0.4f ? 1.f - a * a : om;
          ab[tl * 64 + c2] = make_float2(a, sqrtf(om) * (ig * xv));
        }
      }
    }
    __syncthreads();
    float2 av[16];
    {
      float A = 1.f, h = 0.f;
#pragma unroll
      for (int e = 0; e < 16; e++) {
        int ee = dir == 0 ? e : 15 - e;
        av[e] = ab[(tq * 16 + ee) * 64 + ch];
        h = av[e].x * h + av[e].y; A *= av[e].x;
      }
      subst[tq * 64 + ch] = make_float2(A, h);
    }
    __syncthreads();
    const size_t sidx = ((size_t)((b * 2 + dir) * 132 + tile)) * 256 + gc;
    if (!final) {
      if (tq == 0) {
        float A = 1.f, h = 0.f;
#pragma unroll
        for (int s = 0; s < 4; s++) { float2 ss = subst[(dir == 0 ? s : 3 - s) * 64 + ch]; h = ss.x * h + ss.y; A *= ss.x; }
        P.lsum[sidx] = make_float2(A, h);
      }
    } else {
      float h = P.lcar[sidx];
      if (dir == 0) { for (int s = 0; s < tq; s++) { float2 ss = subst[s * 64 + ch]; h = ss.x * h + ss.y; } }
      else { for (int s = 3; s > tq; s--) { float2 ss = subst[s * 64 + ch]; h = ss.x * h + ss.y; } }
#pragma unroll
      for (int e = 0; e < 16; e++) {
        int ee = dir == 0 ? e : 15 - e;
        h = av[e].x * h + av[e].y;
#pragma unroll
        for (int q = 0; q < 16; q++) hsum[q] += (q == ee) ? h : 0.f;
      }
    }
    __syncthreads();
  }
  if (final) {
#pragma unroll
    for (int e = 0; e < 16; e++)
      P.mix[(size_t)(rowbase + t0 + tq * 16 + e) * D + 768 + gc] = (half_t)(gyv[e] * hsum[e]);
  }
}
DI void lru_carry_item(const Params& P, int it) {
  const int ch = TIDX, dir = it & 1;
  const size_t base = (size_t)it * 132 * 256 + ch;
  float c = 0.f;
#pragma unroll 4
  for (int k = 0; k < 132; k++) {
    int tile = dir == 0 ? k : (k < 4 ? 3 - k : 135 - k);
    float2 s = P.lsum[base + (size_t)tile * 256];
    P.lcar[base + (size_t)tile * 256] = c;
    c = s.x * c + s.y;
  }
}

DI void fft_load(const half_t* src, size_t rs, int nrows, char* Bt, int rowbytes, int k0) {
  for (int idx = TIDX; idx < nrows * 16; idx += 256) {
    int kr = idx >> 4, cc = idx & 15, k = k0 + kr;
    h8 v = *(const h8*)(src + (size_t)kr * rs + cc * 8);
#pragma unroll
    for (int u = 0; u < 8; u++) { int n = cc * 8 + u; *(half_t*)(Bt + n * rowbytes + ((((k >> 3)) ^ (n & 15)) << 4) + (k & 7) * 2) = v[u]; }
  }
}
template <class RF>
DI void fft_mma(const half_t* Dm, int ldD, int nkk, const char* Bt, int rowbytes, f4 (&acc)[4][4], RF arow) {
  const int lane = TIDX & 63, wave = TIDX >> 6, fr = lane & 15, fq = lane >> 4, wc = wave & 1;
#pragma unroll 1
  for (int kk = 0; kk < nkk; kk++) {
    h8 af[4], bf[4];
#pragma unroll
    for (int ms = 0; ms < 4; ms++) af[ms] = *(const h8*)(Dm + (size_t)arow(ms) * ldD + kk * 32 + fq * 8);
#pragma unroll
    for (int ns = 0; ns < 4; ns++) { int n = wc * 64 + ns * 16 + fr; bf[ns] = *(const h8*)(Bt + n * rowbytes + (((kk * 4 + fq) ^ (n & 15)) << 4)); }
#pragma unroll
    for (int ms = 0; ms < 4; ms++)
#pragma unroll
      for (int ns = 0; ns < 4; ns++) acc[ms][ns] = mfma16(af[ms], bf[ns], acc[ms][ns]);
  }
}
DI void zero44(f4 (&acc)[4][4]) {
#pragma unroll
  for (int m = 0; m < 4; m++)
#pragma unroll
    for (int n = 0; n < 4; n++) acc[m][n] = (f4){0.f, 0.f, 0.f, 0.f};
}
DI void fftA_item(const Params& P, int it, char* smem) {
  const int b = it >> 8, bb = (it >> 1) & 127, chh = it & 1;
  const int lane = TIDX & 63, wave = TIDX >> 6, fr = lane & 15, fq = lane >> 4, wr = wave >> 1, wc = wave & 1;
  __syncthreads();
  fft_load(P.QF + (size_t)(TC + b * SEQ + bb) * 512 + chh * 128, (size_t)128 * 512, 64, smem, 256, 0);
  fft_load(P.QF + (size_t)(TC + b * SEQ + bb) * 512 + 256 + chh * 128, (size_t)128 * 512, 64, smem, 256, 64);
  __syncthreads();
  f4 acc[4][4]; zero44(acc);
  fft_mma(P.DA, 128, 4, smem, 256, acc, [&](int ms) { return (ms >> 1) * 64 + wr * 32 + (ms & 1) * 16 + fr; });
#pragma unroll
  for (int ms = 0; ms < 2; ms++)
#pragma unroll
    for (int j = 0; j < 4; j++) {
      const int f1 = wr * 32 + ms * 16 + fq * 4 + j;
      const float2 w = P.tw[(bb * f1) & 8191];
      half_t* d0 = P.GA + ((size_t)(b * 64 + f1) * 256 + bb) * 256 + chh * 128 + wc * 64 + fr;
#pragma unroll
      for (int ns = 0; ns < 4; ns++) {
        float gr = acc[ms][ns][j], gi = acc[ms + 2][ns][j];
        d0[ns * 16] = (half_t)(gr * w.x + gi * w.y);
        d0[(size_t)128 * 256 + ns * 16] = (half_t)(gi * w.x - gr * w.y);
      }
    }
}
DI void fftB_item(const Params& P, int it, char* smem) {
  const int b = it >> 7, f1 = (it >> 1) & 63, chh = it & 1;
  const int lane = TIDX & 63, wave = TIDX >> 6, fr = lane & 15, fq = lane >> 4, wr = wave >> 1, wc = wave & 1;
  __syncthreads();
  fft_load(P.GA + (size_t)(b * 64 + f1) * 256 * 256 + chh * 128, 256, 256, smem, 512, 0);
  __syncthreads();
  f4 acc[4][4]; zero44(acc);
  fft_mma(P.DB, 256, 8, smem, 512, acc, [&](int ms) { return wr * 64 + ms * 16 + fr; });
#pragma unroll
  for (int ms = 0; ms < 4; ms++)
#pragma unroll
    for (int j = 0; j < 4; j++) {
      const int f2 = wr * 64 + ms * 16 + fq * 4 + j;
      half_t* d0 = P.mix + (size_t)(TC + b * SEQ + f1 + 64 * f2) * D + chh * 128 + wc * 64 + fr;
#pragma unroll
      for (int ns = 0; ns < 4; ns++) d0[ns * 16] = (half_t)acc[ms][ns][j];
    }
}
DI void fftC_item(const Params& P, int it, char* smem) {
  const int b = it >> 1, chh = it & 1;
  const int lane = TIDX & 63, wave = TIDX >> 6, fr = lane & 15, fq = lane >> 4, wr = wave >> 1, wc = wave & 1;
#pragma unroll 1
  for (int mh = 0; mh < 2; mh++) {
    f4 acc[4][4]; zero44(acc);
#pragma unroll 1
    for (int part = 0; part < 2; part++) {
      __syncthreads();
      fft_load(P.QF + (size_t)(b * CL) * 512 + part * 256 + chh * 128, 512, 256, smem, 512, 0);
      __syncthreads();
      fft_mma(P.DC + part * 256, 512, 8, smem, 512, acc, [&](int ms) { return mh * 128 + wr * 64 + ms * 16 + fr; });
    }
#pragma unroll
    for (int ms = 0; ms < 4; ms++)
#pragma unroll
      for (int j = 0; j < 4; j++) {
        const int f = mh * 128 + wr * 64 + ms * 16 + fq * 4 + j;
        half_t* d0 = P.mix + (size_t)(b * CL + f) * D + chh * 128 + wc * 64 + fr;
#pragma unroll
        for (int ns = 0; ns < 4; ns++) d0[ns * 16] = (half_t)acc[ms][ns][j];
      }
  }
}

#ifndef MX
#define MX 15
#endif
DI void mix_phase(const Params& P, int l, char* smem, int* s_item, int qi) {
  const int nL = 0, nA = 0, nC = l == 0 ? 64 : 0, nFA = 2048, nFC = l == 0 ? 16 : 0;
  const int total = nL + nA + nC + nFA + nFC;
  {
    const int g = blockIdx.x & 3;
    lru_load_w(P, l, g, smem);
    for (int u = blockIdx.x >> 2; u < NB_ * 132; u += gridDim.x >> 2) lru_tile(P, l, u / 132, u % 132, g, smem, false);
  }
  int stage = 0;
  for (;;) {
    __syncthreads();
    if (TIDX == 0) *s_item = stage == 0 ? atomicAdd(&P.qctr[8 + qi * 8 + (blockIdx.x & 7)], 1) : atomicAdd(&P.qctr[qi], 1);
    __syncthreads();
    int it = *s_item;
    int kind = -1, b = 0, head = 0, row0 = 0, nk = 0;
    if (stage == 0) {
      if (it >= 256) { stage = 1; continue; }
      const int pair = (blockIdx.x & 7) + 8 * (it >> 6);
      b = pair >> 2; head = pair & 3; row0 = TC + b * SEQ + (it & 63) * 128; nk = KV; kind = 0;
    } else {
      if (it >= total) break;
      if (it < nC) { b = it >> 3; head = (it >> 1) & 3; row0 = b * CL + (it & 1) * 128; nk = CL; kind = 0; }
      else if (it < nC + nFA) { kind = 1; it -= nC; }
      else { kind = 2; it -= nC + nFA; }
    }
    if (kind == 0) attn_item(P, l, b, head, row0, nk, smem);
    else if (kind == 1) fftA_item(P, it, smem);
    else fftC_item(P, it, smem);
  }
}

DI void grid_barrier(unsigned* ctr, unsigned target) {
  asm volatile("s_waitcnt vmcnt(0)" ::: "memory");
  __syncthreads();
  if (threadIdx.x == 0) {
    __builtin_amdgcn_fence(__ATOMIC_RELEASE, "agent");
    asm volatile("s_waitcnt vmcnt(0)" ::: "memory");
    __hip_atomic_fetch_add(ctr, 1u, __ATOMIC_RELAXED, __HIP_MEMORY_SCOPE_AGENT);
    while (__hip_atomic_load(ctr, __ATOMIC_RELAXED, __HIP_MEMORY_SCOPE_AGENT) < target) __builtin_amdgcn_s_sleep(1);
    __builtin_amdgcn_fence(__ATOMIC_ACQUIRE, "agent");
    asm volatile("s_waitcnt vmcnt(0)" ::: "memory");
  }
  __syncthreads();
}
__global__ void __launch_bounds__(256, 1) fwd_megakernel(Params Pin) {
  Params P = Pin; bind_ws(P);
  __shared__ __attribute__((aligned(16))) char smem[147456 + 8192];
  __shared__ int tb[33];
  __shared__ int s_item;
  cg::grid_group grid = cg::this_grid();
  unsigned* bar = (unsigned*)(P.ws + O_bar); unsigned bk = 0;
#ifndef PH
#define PH 0xFFFF
#endif
#if PH & 1
  phase0(P, smem);
#endif
  grid.sync();
  for (int l = 0; l < 2; l++) {
#if PH & 2
    row1_phase(P, l == 0 ? -1 : 0, l, 0);
#endif
    grid_barrier(bar, (++bk) * gridDim.x);
#if PH & 4
    gemm_in_phase(P, l, smem);
#ifdef DUP_GEMM
    grid_barrier(bar, (++bk) * gridDim.x);
    gemm_in_phase(P, l, smem);
#endif
#endif
    grid_barrier(bar, (++bk) * gridDim.x);
#if PH & 8
    mix_phase(P, l, smem, &s_item, l);
#ifdef DUP_MIX
    grid_barrier(bar, (++bk) * gridDim.x);
    mix_phase(P, l, smem, &s_item, 2 + l);
#endif
#endif
    grid_barrier(bar, (++bk) * gridDim.x);
#if PH & 16
    if (blockIdx.x >= gridDim.x - 16) lru_carry_item(P, gridDim.x - 1 - blockIdx.x);
    for (int it = blockIdx.x; it < 1024; it += gridDim.x) fftB_item(P, it, smem);
#endif
    grid_barrier(bar, (++bk) * gridDim.x);
#if PH & 512
    {
      const int g = blockIdx.x & 3;
      __syncthreads();
      lru_load_w(P, l, g, smem);
      for (int u = blockIdx.x >> 2; u < NB_ * 132; u += gridDim.x >> 2) lru_tile(P, l, u / 132, u % 132, g, smem, true);
    }
#endif
    grid_barrier(bar, (++bk) * gridDim.x);
#if PH & 32
    gemm_out_phase(P, l, smem);
#endif
    grid_barrier(bar, (++bk) * gridDim.x);
#if PH & 64
    row2_phase(P, l, l == 0 ? 0 : TC, smem);
#endif
    grid_barrier(bar, (++bk) * gridDim.x);
#if PH & 128
    moe_e1_phase(P, l, smem, tb);
#ifdef DUP_GEMM
    grid_barrier(bar, (++bk) * gridDim.x);
    moe_e1_phase(P, l, smem, tb);
#endif
#endif
    grid_barrier(bar, (++bk) * gridDim.x);
#if PH & 256
    moe_e2_phase(P, l, smem, tb);
#ifdef DUP_GEMM
    grid_barrier(bar, (++bk) * gridDim.x);
    moe_e2_phase(P, l, smem, tb);
#endif
#endif
    grid_barrier(bar, (++bk) * gridDim.x);
  }
#if PH & 2
  row1_phase(P, 1, -1, TC);
#endif
}

extern "C" void kernel_launch(void* const* d_in, const int* in_sizes, int n_in, void* d_out, int out_size, void* d_ws, size_t ws_size,
                              hipStream_t stream) {
  static int grid_blocks = 0;
  if (!grid_blocks) {
    int dev = 0, cus = 0, per_cu = 0;
    hipGetDevice(&dev);
    hipDeviceGetAttribute(&cus, hipDeviceAttributeMultiprocessorCount, dev);
    hipOccupancyMaxActiveBlocksPerMultiprocessor(&per_cu, fwd_megakernel, 256, 0);
    if (per_cu > 2) per_cu = 2;
    grid_blocks = cus * per_cu;
  }
  Params p{};
  const float** pin = (const float**)&p;
  for (int i = 0; i < 31; i++) pin[i] = (const float*)d_in[i];
  p.out = (float*)d_out;
  p.ws = (char*)d_ws;
  if (WS_NEED > ws_size) { fprintf(stderr, "workspace too small: need %zu have %zu\n", (size_t)WS_NEED, ws_size); return; }
  hipMemsetAsync((char*)d_ws + O_bar, 0, 256, stream);
  void* args[] = {&p};
  hipError_t e = hipLaunchCooperativeKernel((void*)fwd_megakernel, dim3(grid_blocks), dim3(256), args, 0, stream);
  if (e != hipSuccess) fprintf(stderr, "cooperative launch failed: %s (grid %d)\n", hipGetErrorString(e), grid_blocks);
}
```

```cpp
#include <hip/hip_runtime.h>
#include <hip/hip_cooperative_groups.h>
#include <cstdio>
namespace cg = cooperative_groups;

typedef _Float16 half_t;
typedef _Float16 h8 __attribute__((ext_vector_type(8)));
typedef _Float16 h4 __attribute__((ext_vector_type(4)));
typedef __fp16 fp16x2 __attribute__((ext_vector_type(2)));
typedef unsigned u4 __attribute__((ext_vector_type(4)));
typedef float f4 __attribute__((ext_vector_type(4)));
typedef float f16v __attribute__((ext_vector_type(16)));
#define DI __device__ __forceinline__
__device__ __forceinline__ int tid_opaque() { int t = threadIdx.x; asm volatile("" : "+v"(t)); return t; }
#define TIDX tid_opaque()

constexpr int D = 1024, NB_ = 8, SEQ = 8192, CL = 256;
constexpr int TC = NB_ * CL;
constexpr int TX = NB_ * SEQ;
constexpr int TA = TC + TX;
constexpr int KV = CL + SEQ;
constexpr int NIN = 2560;
constexpr int LCAP = 2 * TA;
constexpr float EPS = 1e-6f;

struct Params {
  const float *x, *c, *ctx, *c_ctx, *w_mod, *b_mod, *norm1_g, *norm2_g, *w_in, *q_norm_g, *k_norm_g, *lq1, *lk1, *lq2, *lk2,
      *subln_g, *conv_w, *conv_b, *gate_a_w, *gate_a_b, *gate_x_w, *gate_x_b, *lru_lambda, *w_out, *w_group, *b_group,
      *w_router, *b_router, *w1, *w3, *w2;
  float* out; char* ws;
  half_t *WtIn, *WtOut, *Wt1, *Wt3, *Wt2;
  float* mod; float2* rope; float2* tw; half_t *DA, *DB, *DC; float* consts; int* cnt; int* qctr; float* tokW; int* list;
  float* xcbuf; half_t* WrH;
  half_t *hx, *mix, *q, *kall, *vT, *QF, *gy, *rr; float2* lsum; float* lcar; half_t* GA; half_t *H, *yA;
};


constexpr size_t al256(size_t x) { return (x + 255) & ~(size_t)255; }
constexpr size_t O_WtIn = 0;
constexpr size_t O_WtOut = O_WtIn + al256((size_t)2 * NIN * 1024 * 2);
constexpr size_t O_Wt1 = O_WtOut + al256((size_t)2 * 1024 * 1024 * 2);
constexpr size_t O_Wt3 = O_Wt1 + al256((size_t)64 * 524288 * 2);
constexpr size_t O_Wt2 = O_Wt3 + al256((size_t)64 * 524288 * 2);
constexpr size_t O_mod = O_Wt2 + al256((size_t)64 * 524288 * 2);
constexpr size_t O_rope = O_mod + al256((size_t)2 * 9 * 6144 * 4);
constexpr size_t O_tw = O_rope + al256(128 * 16 * 8);
constexpr size_t O_DA = O_tw + al256(8192 * 8);
constexpr size_t O_DB = O_DA + al256(16384 * 2);
constexpr size_t O_DC = O_DB + al256(32768 * 2);
constexpr size_t O_consts = O_DC + al256(131072 * 2);
constexpr size_t O_cnt = O_consts + 256;
constexpr size_t O_qctr = O_cnt + 256;
constexpr size_t O_bar = O_qctr + 256;
constexpr size_t O_tokW = O_bar + 256;
constexpr size_t O_list = O_tokW + al256((size_t)2 * TA * 4);
constexpr size_t O_xcbuf = O_list + al256((size_t)32 * LCAP * 4);
constexpr size_t O_WrT = O_xcbuf + al256((size_t)TC * D * 4);
constexpr size_t O_hx = O_WrT + al256((size_t)2 * 2 * 48 * 1024 * 2);
constexpr size_t O_mix = O_hx + al256((size_t)TA * D * 2);
constexpr size_t O_regB = O_mix + al256((size_t)TA * D * 2);
constexpr size_t O_q = O_regB;
constexpr size_t O_kall = O_q + al256((size_t)TA * 512 * 2);
constexpr size_t O_vT = O_kall + al256((size_t)NB_ * KV * 512 * 2);
constexpr size_t O_QF = O_vT + al256((size_t)NB_ * 4 * 128 * KV * 2);
constexpr size_t O_gy = O_QF + al256((size_t)TA * 512 * 2);
constexpr size_t O_rr = O_gy + al256((size_t)TA * 256 * 2);
constexpr size_t O_lsum = O_rr + al256((size_t)TA * 256 * 2);
constexpr size_t O_lcar = O_lsum + al256((size_t)16 * 132 * 256 * 8);
constexpr size_t O_GA = O_lcar + al256((size_t)16 * 132 * 256 * 4);
constexpr size_t O_mixer_end = O_GA + al256((size_t)NB_ * 64 * 256 * 256 * 2);
constexpr size_t O_H = O_regB;
constexpr size_t O_yA = O_H + al256((size_t)(2 * TA + 32 * 256) * 512 * 2);
constexpr size_t O_moe_end = O_yA + al256((size_t)2 * TA * D * 2);
constexpr size_t WS_NEED = O_mixer_end > O_moe_end ? O_mixer_end : O_moe_end;
DI void bind_ws(Params& P) {
  char* w = P.ws;
  P.WtIn = (half_t*)(w + O_WtIn); P.WtOut = (half_t*)(w + O_WtOut); P.Wt1 = (half_t*)(w + O_Wt1); P.Wt3 = (half_t*)(w + O_Wt3); P.Wt2 = (half_t*)(w + O_Wt2);
  P.mod = (float*)(w + O_mod); P.rope = (float2*)(w + O_rope); P.tw = (float2*)(w + O_tw); P.DA = (half_t*)(w + O_DA); P.DB = (half_t*)(w + O_DB); P.DC = (half_t*)(w + O_DC);
  P.consts = (float*)(w + O_consts); P.cnt = (int*)(w + O_cnt); P.qctr = (int*)(w + O_qctr); P.tokW = (float*)(w + O_tokW); P.list = (int*)(w + O_list);
  P.xcbuf = (float*)(w + O_xcbuf); P.WrH = (half_t*)(w + O_WrT); P.hx = (half_t*)(w + O_hx); P.mix = (half_t*)(w + O_mix);
  P.q = (half_t*)(w + O_q); P.kall = (half_t*)(w + O_kall); P.vT = (half_t*)(w + O_vT); P.QF = (half_t*)(w + O_QF); P.gy = (half_t*)(w + O_gy); P.rr = (half_t*)(w + O_rr);
  P.lsum = (float2*)(w + O_lsum); P.lcar = (float*)(w + O_lcar); P.GA = (half_t*)(w + O_GA); P.H = (half_t*)(w + O_H); P.yA = (half_t*)(w + O_yA);
}
DI float shx(float v, int o) { int ln = TIDX & 63; return __builtin_bit_cast(float, __builtin_amdgcn_ds_bpermute((ln ^ o) << 2, __builtin_bit_cast(int, v))); }
DI float shi(float v, int idx) { return __builtin_bit_cast(float, __builtin_amdgcn_ds_bpermute(idx << 2, __builtin_bit_cast(int, v))); }
DI float wave_sum(float v) {
#pragma unroll
  for (int o = 32; o; o >>= 1) v += shx(v, o);
  return v;
}
DI void glds16(const void* g, void* l) {
  __builtin_amdgcn_global_load_lds((const unsigned*)g, (unsigned*)l, 16, 0, 0);
}
DI void wait_vm0() { asm volatile("s_waitcnt vmcnt(0)" ::: "memory"); }
DI f4 mfma16(h8 a, h8 b, f4 c) { return __builtin_amdgcn_mfma_f32_16x16x32_f16(a, b, c, 0, 0, 0); }
DI f16v mfma32(h8 a, h8 b, f16v c) { return __builtin_amdgcn_mfma_f32_32x32x16_f16(a, b, c, 0, 0, 0); }
DI unsigned pk2(float a, float b) { fp16x2 r = __builtin_amdgcn_cvt_pkrtz(a, b); return __builtin_bit_cast(unsigned, r); }
DI float sigmoidf_(float x) { return 1.f / (1.f + __expf(-x)); }
DI float gelu_tanh(float x) {
  float u = 0.7978845608028654f * (x + 0.044715f * x * x * x);
  float e = __expf(2.f * u);
  float t = 1.f - 2.f / (e + 1.f);
  return 0.5f * x * (1.f + t);
}
DI int row_mod(int r) { return r < TC ? 8 : ((r - TC) >> 13); }

DI void transpose_tile4(const float* src, int lds_, half_t* dst, int ldd, float* tile) {
  const int tid = TIDX;
  {
    const int k0 = tid >> 6, c4 = tid & 63;
    const float* sp = src + (size_t)k0 * lds_ + c4 * 4;
    float* tp = tile + (c4 >> 4) * 4352 + k0 * 68 + (c4 & 15) * 4;
#pragma unroll
    for (int i = 0; i < 16; i++) *(float4*)(tp + i * 4 * 68) = *(const float4*)(sp + (size_t)i * 4 * lds_);
  }
  __syncthreads();
#pragma unroll
  for (int i = 0; i < 8; i++) {
    int idx = i * 256 + tid, j = idx >> 9, r = idx & 511, kc = r >> 6, n = r & 63;
    const float* t = tile + j * 4352 + kc * 8 * 68 + n;
    h8 o;
#pragma unroll
    for (int u = 0; u < 8; u++) o[u] = (half_t)t[u * 68];
    *(h8*)(dst + (size_t)(j * 64 + n) * ldd + kc * 8) = o;
  }
  __syncthreads();
}

DI void phase0(const Params& P, char* smem) {
  float* tile = (float*)smem;
  const int tid = TIDX;
  constexpr int NT = 6528, NF = 128, NM = 192, NX = 6;
  for (int t = blockIdx.x; t < NT + NF + NM + NX; t += gridDim.x) {
    if (t < NT) {
      const float* src; half_t* dst; int lds_, ldd;
      if (t < 256) {
        int l = t / 128, r = t % 128, kt = r / 8, nt = (r % 8) * 4;
        src = P.w_in + (size_t)l * 1024 * 2304 + (size_t)kt * 64 * 2304 + 256 + nt * 64; lds_ = 2304;
        dst = P.WtIn + (size_t)l * NIN * 1024 + (size_t)(512 + nt * 64) * 1024 + kt * 64; ldd = 1024;
      } else if (t < 384) {
        int u = t - 256, l = u / 64, r = u % 64, kt = r / 4, nt = (r % 4) * 4;
        src = P.w_out + (size_t)l * 1048576 + (size_t)kt * 64 * 1024 + nt * 64; lds_ = 1024;
        dst = P.WtOut + (size_t)l * 1048576 + (size_t)nt * 64 * 1024 + kt * 64; ldd = 1024;
      } else if (t < 384 + 4096) {
        int u = t - 384; const float* w = P.w1; half_t* o = P.Wt1;
        if (u >= 2048) { u -= 2048; w = P.w3; o = P.Wt3; }
        int le = u / 32, r = u % 32, kt = r / 2, nt = (r % 2) * 4;
        src = w + (size_t)le * 524288 + (size_t)kt * 64 * 512 + nt * 64; lds_ = 512;
        dst = o + (size_t)le * 524288 + (size_t)nt * 64 * 1024 + kt * 64; ldd = 1024;
      } else {
        int u = t - 384 - 4096, le = u / 32, r = u % 32, kt = r / 4, nt = (r % 4) * 4;
        src = P.w2 + (size_t)le * 524288 + (size_t)kt * 64 * 1024 + nt * 64; lds_ = 1024;
        dst = P.Wt2 + (size_t)le * 524288 + (size_t)nt * 64 * 512 + kt * 64; ldd = 512;
      }
      transpose_tile4(src, lds_, dst, ldd, tile);
    } else if (t < NT + NF) {
      int f = t - NT, l = f / 64, r = f % 64, kt = r / 4, g = r % 4;
      float* cst = tile + 64 * 65; float* snt = cst + 64;
      const float* src = P.w_in + (size_t)l * 1024 * 2304 + (size_t)kt * 64 * 2304 + g * 64;
      { int n = tid & 63, kq = tid >> 6;
        for (int i = 0; i < 16; i++) { int k = i * 4 + kq; tile[k * 65 + n] = src[(size_t)k * 2304 + n]; } }
      if (tid < 64) { float s, c; sincospif((float)tid / 32.f, &s, &c); cst[tid] = c; snt[tid] = s; }
      __syncthreads();
      int k = tid & 63, jq = tid >> 6;
      half_t* o = P.WtIn + (size_t)l * NIN * 1024 + kt * 64 + k;
      for (int jj = 0; jj < 16; jj++) {
        int j = jq * 16 + jj; float ac = 0.f, as = 0.f;
        for (int c = 0; c < 64; c++) { float v = tile[k * 65 + c]; int idx = (c * j) & 63; ac += v * cst[idx]; as += v * snt[idx]; }
        o[(size_t)(g * 64 + j) * 1024] = (half_t)(ac * 0.125f);
        o[(size_t)(256 + g * 64 + j) * 1024] = (half_t)(-as * 0.125f);
      }
      __syncthreads();
    } else if (t < NT + NF + NM) {
      int mi = t - NT - NF, l = mi / 96, col0 = (mi % 96) * 64;
      float* scond = tile; float* red = tile + 9216;
      for (int idx = tid; idx < 9216; idx += 256) {
        int n = idx >> 10, k = idx & 1023; float v = n < 8 ? P.c[n * 1024 + k] : P.c_ctx[k];
        scond[idx] = v / (1.f + expf(-v));
      }
      __syncthreads();
      int col = tid & 63, kq = tid >> 6; float acc[9];
#pragma unroll
      for (int n = 0; n < 9; n++) acc[n] = 0.f;
      const float* w = P.w_mod + ((size_t)l * 1024 + kq * 256) * 6144 + col0 + col;
#pragma unroll 16
      for (int k = 0; k < 256; k++) {
        float wv = w[(size_t)k * 6144];
#pragma unroll
        for (int n = 0; n < 9; n++) acc[n] += scond[n * 1024 + kq * 256 + k] * wv;
      }
#pragma unroll
      for (int n = 0; n < 9; n++) red[(kq * 9 + n) * 64 + col] = acc[n];
      __syncthreads();
      for (int idx = tid; idx < 576; idx += 256) {
        int n = idx / 64, cc = idx % 64;
        float s = red[(0 * 9 + n) * 64 + cc] + red[(1 * 9 + n) * 64 + cc] + red[(2 * 9 + n) * 64 + cc] + red[(3 * 9 + n) * 64 + cc];
        P.mod[(size_t)(l * 9 + n) * 6144 + col0 + cc] = s + P.b_mod[l * 6144 + col0 + cc];
      }
      __syncthreads();
    } else {
      int m = t - NT - NF - NM;
      if (m == 0) {
        for (int idx = tid; idx < 128 * 16; idx += 256) {
          int pos = idx >> 4, i = idx & 15; float f = powf(10000.f, -(float)i / 16.f); float ang = (float)pos * f;
          float s, c; sincosf(ang, &s, &c); P.rope[idx] = make_float2(c, s);
        }
      } else if (m == 1) {
        for (int j = tid; j < 8192; j += 256) { float s, c; sincospif((float)j / 4096.f, &s, &c); P.tw[j] = make_float2(c, s); }
      } else if (m == 2) {
        for (int idx = tid; idx < 16384; idx += 256) {
          int mm = idx >> 7, k = idx & 127, part = mm >> 6, f1 = mm & 63, pp = k >> 6, a = k & 63;
          float s, c; sincospif((float)((a * f1) & 63) / 32.f, &s, &c);
          float v = part == 0 ? (pp == 0 ? c : s) : (pp == 0 ? -s : c);
          P.DA[idx] = (half_t)(v * 0.125f);
        }
      } else if (m == 3) {
        for (int idx = tid; idx < 32768; idx += 256) {
          int mm = idx >> 8, k = idx & 255, part = k >> 7, bb = k & 127;
          float s, c; sincospif((float)((bb * mm) & 127) / 64.f, &s, &c);
          P.DB[idx] = (half_t)((part == 0 ? c : s) * 0.08838834764831845f);
        }
      } else if (m == 4) {
        for (int idx = tid; idx < 131072; idx += 256) {
          int mm = idx >> 9, k = idx & 511, part = k >> 8, tt = k & 255;
          float s, c; sincospif((float)((tt * mm) & 255) / 128.f, &s, &c);
          P.DC[idx] = (half_t)((part == 0 ? c : s) * 0.0625f);
        }
      } else {
        for (int idx = tid; idx < 2 * 48 * 1024; idx += 256) {
          int l = idx / 49152, r = idx % 49152, col = r >> 10, k = r & 1023;
          float w = col < 4 ? P.w_group[((size_t)l * 1024 + k) * 4 + col] : (col < 36 ? P.w_router[((size_t)l * 1024 + k) * 32 + col - 4] : 0.f);
          half_t hi = (half_t)w, lo = (half_t)(w - (float)hi);
          P.WrH[(size_t)(l * 2) * 49152 + r] = hi; P.WrH[(size_t)(l * 2 + 1) * 49152 + r] = lo;
        }
        if (tid < 2) {
          int l = tid; float s1 = 0.f, s2 = 0.f, mq = 0.f, mk = 0.f;
          for (int i = 0; i < 64; i++) {
            s1 += P.lq1[l * 64 + i] * P.lk1[l * 64 + i]; s2 += P.lq2[l * 64 + i] * P.lk2[l * 64 + i];
            mq = fmaxf(mq, fabsf(P.q_norm_g[l * 64 + i])); mk = fmaxf(mk, fabsf(P.k_norm_g[l * 64 + i]));
          }
          float lam_init = 0.8f - 0.6f * expf(-0.3f * (float)l);
          P.consts[l * 4 + 0] = expf(s1) - expf(s2) + lam_init;
          P.consts[l * 4 + 1] = 8.f * mq * mk * 1.4426950408889634f * 1.002f - 15.f;
          P.consts[l * 4 + 2] = lam_init;
        }
        if (tid < 64) P.cnt[tid] = 0;
        if (tid < 64) P.qctr[tid] = 0;
      }
    }
  }
}

DI void row1_phase(const Params& P, int combine_l, int norm_l, int r_begin) {
  const int lane = TIDX & 63, gw = blockIdx.x * 4 + (TIDX >> 6), nw = gridDim.x * 4;
  for (int r = r_begin + gw; r < TA; r += nw) {
    const int n = row_mod(r);
    float v[16];
    if (combine_l < 0) {
      const float* src = r < TC ? P.ctx + (size_t)r * D : P.x + (size_t)(r - TC) * D;
#pragma unroll
      for (int i = 0; i < 4; i++) { float4 t = *(const float4*)(src + i * 256 + lane * 4); v[i*4] = t.x; v[i*4+1] = t.y; v[i*4+2] = t.z; v[i*4+3] = t.w; }
    } else {
      float* xm = r < TC ? P.xcbuf + (size_t)r * D : P.out + (size_t)(r - TC) * D;
      const float* g2 = P.mod + (size_t)(combine_l * 9 + n) * 6144 + 5 * 1024;
      const half_t* y0 = P.yA + (size_t)(2 * r) * D; const half_t* y1 = y0 + D;
#pragma unroll
      for (int i = 0; i < 4; i++) {
        int c = i * 256 + lane * 4;
        float4 t = *(const float4*)(xm + c); float4 g = *(const float4*)(g2 + c);
        h4 a = *(const h4*)(y0 + c); h4 b = *(const h4*)(y1 + c);
        t.x += g.x * ((float)a[0] + (float)b[0]); t.y += g.y * ((float)a[1] + (float)b[1]);
        t.z += g.z * ((float)a[2] + (float)b[2]); t.w += g.w * ((float)a[3] + (float)b[3]);
        *(float4*)(xm + c) = t;
        v[i*4] = t.x; v[i*4+1] = t.y; v[i*4+2] = t.z; v[i*4+3] = t.w;
      }
    }
    if (norm_l >= 0) {
      float ss = 0.f;
#pragma unroll
      for (int i = 0; i < 16; i++) ss += v[i] * v[i];
      ss = wave_sum(ss);
      const float rstd = rsqrtf(ss * (1.f / 1024.f) + EPS);
      const float* g = P.norm1_g + norm_l * 1024;
      const float* sh = P.mod + (size_t)(norm_l * 9 + n) * 6144; const float* sc = sh + 1024;
#pragma unroll
      for (int i = 0; i < 4; i++) {
        int c = i * 256 + lane * 4;
        float4 gg = *(const float4*)(g + c), s1 = *(const float4*)(sc + c), s0 = *(const float4*)(sh + c);
        h4 o;
        o[0] = (half_t)(v[i*4] * rstd * gg.x * (1.f + s1.x) + s0.x); o[1] = (half_t)(v[i*4+1] * rstd * gg.y * (1.f + s1.y) + s0.y);
        o[2] = (half_t)(v[i*4+2] * rstd * gg.z * (1.f + s1.z) + s0.z); o[3] = (half_t)(v[i*4+3] * rstd * gg.w * (1.f + s1.w) + s0.w);
        *(h4*)(P.hx + (size_t)r * D + c) = o;
      }
    }
  }
}

DI void row2_phase(const Params& P, int l, int r_begin, char* smem) {
  const int tid = TIDX, lane = tid & 63, wave = tid >> 6, fr = lane & 15, fq = lane >> 4;
  float* lg = (float*)smem + wave * 16 * 48;
  const half_t* Whi = P.WrH + (size_t)(l * 2) * 49152; const half_t* Wlo = Whi + 49152;
  const int ngroups = (TA - r_begin) >> 4, gw = blockIdx.x * 4 + wave, nw = gridDim.x * 4;
  const float* gam = P.norm2_g + l * 1024;
#pragma unroll 1
  for (int grp = gw; grp < ngroups; grp += nw) {
    const int r0 = r_begin + grp * 16, row = r0 + fr, n = row_mod(r0);
    const float* xm = (row < TC ? P.xcbuf + (size_t)row * D : P.out + (size_t)(row - TC) * D) + fq * 8;
    float ss = 0.f;
#pragma unroll 16
    for (int kk = 0; kk < 32; kk++) {
      const float4 a = *(const float4*)(xm + kk * 32), b = *(const float4*)(xm + kk * 32 + 4);
      ss += a.x * a.x + a.y * a.y + a.z * a.z + a.w * a.w + b.x * b.x + b.y * b.y + b.z * b.z + b.w * b.w;
    }
    ss += shx(ss, 16); ss += shx(ss, 32);
    const float rstd = rsqrtf(ss * (1.f / 1024.f) + EPS);
    const float* sh = P.mod + (size_t)(l * 9 + n) * 6144 + 3 * 1024 + fq * 8; const float* sc = sh + 1024;
    f4 acc[3];
#pragma unroll
    for (int i = 0; i < 3; i++) acc[i] = (f4){0.f, 0.f, 0.f, 0.f};
    half_t* hxo = P.hx + (size_t)row * D + fq * 8;
#pragma unroll 4
    for (int kk = 0; kk < 32; kk++) {
      const int k0 = kk * 32;
      float x[8], g[8], s1[8], s0[8];
      *(float4*)&x[0] = *(const float4*)(xm + k0); *(float4*)&x[4] = *(const float4*)(xm + k0 + 4);
      *(float4*)&g[0] = *(const float4*)(gam + fq * 8 + k0); *(float4*)&g[4] = *(const float4*)(gam + fq * 8 + k0 + 4);
      *(float4*)&s1[0] = *(const float4*)(sc + k0); *(float4*)&s1[4] = *(const float4*)(sc + k0 + 4);
      *(float4*)&s0[0] = *(const float4*)(sh + k0); *(float4*)&s0[4] = *(const float4*)(sh + k0 + 4);
      h8 hi, lo;
#pragma unroll
      for (int i = 0; i < 8; i++) {
        float v = x[i] * rstd * g[i] * (1.f + s1[i]) + s0[i];
        hi[i] = (half_t)v; lo[i] = (half_t)(v - (float)hi[i]);
      }
      *(h8*)(hxo + k0) = hi;
#pragma unroll
      for (int n3 = 0; n3 < 3; n3++) {
        h8 bh = *(const h8*)(Whi + (size_t)(n3 * 16 + fr) * 1024 + k0 + fq * 8);
        h8 bl = *(const h8*)(Wlo + (size_t)(n3 * 16 + fr) * 1024 + k0 + fq * 8);
        acc[n3] = mfma16(hi, bh, acc[n3]); acc[n3] = mfma16(lo, bh, acc[n3]); acc[n3] = mfma16(hi, bl, acc[n3]);
      }
    }
    __builtin_amdgcn_wave_barrier();
#pragma unroll
    for (int n3 = 0; n3 < 3; n3++)
#pragma unroll
      for (int j = 0; j < 4; j++) lg[(fq * 4 + j) * 48 + n3 * 16 + fr] = acc[n3][j];
    __builtin_amdgcn_wave_barrier();
    if (lane < 16) {
      const int r = r0 + lane;
      const float* L = lg + lane * 48;
      float gl[4]; int gi = 0;
#pragma unroll
      for (int j = 0; j < 4; j++) gl[j] = L[j] + P.b_group[l * 4 + j];
      float gm = gl[0];
#pragma unroll
      for (int j = 1; j < 4; j++) if (gl[j] > gm) { gm = gl[j]; gi = j; }
      float gs = 0.f;
#pragma unroll
      for (int j = 0; j < 4; j++) gs += expf(gl[j] - gm);
      const float pg = 1.f / gs;
      float el[8];
#pragma unroll
      for (int j = 0; j < 8; j++) el[j] = L[4 + gi * 8 + j] + P.b_router[l * 32 + gi * 8 + j];
      int i0 = 0; float v0 = el[0];
#pragma unroll
      for (int j = 1; j < 8; j++) if (el[j] > v0) { v0 = el[j]; i0 = j; }
      int i1 = -1; float v1 = -3.0e38f;
#pragma unroll
      for (int j = 0; j < 8; j++) if (j != i0 && el[j] > v1) { v1 = el[j]; i1 = j; }
      const float ex = expf(v1 - v0);
      const float w0 = pg / (1.f + ex), w1 = pg * ex / (1.f + ex);
      const int e0 = gi * 8 + i0, e1 = gi * 8 + i1;
      int p0 = atomicAdd(&P.cnt[l * 32 + e0], 1); P.list[(size_t)e0 * LCAP + p0] = 2 * r;
      int p1 = atomicAdd(&P.cnt[l * 32 + e1], 1); P.list[(size_t)e1 * LCAP + p1] = 2 * r + 1;
      P.tokW[2 * r] = w0; P.tokW[2 * r + 1] = w1;
    }
    __builtin_amdgcn_wave_barrier();
  }
}

DI h8 lds128(unsigned a) { h8 r; asm volatile("ds_read_b128 %0, %1" : "=v"(r) : "v"(a)); return r; }
DI void tie(h8& x) { asm volatile("" : "+v"(x)); }
DI unsigned lds_addr(const void* p) { return (unsigned)(size_t)p; }
#define WAIT_LGKM(n) asm volatile("s_waitcnt lgkmcnt(" #n ")" ::: "memory")
DI void raw_barrier() { asm volatile("" ::: "memory"); __builtin_amdgcn_s_barrier(); asm volatile("" ::: "memory"); }
DI void slot_rc(int i, int& row, int& coff) { int s = i * 256 + TIDX; row = s >> 3; coff = ((s & 7) ^ ((row >> 1) & 7)) * 8; }

template <class AF, class BF>
DI void gemm_prologue(AF aptr, BF bptr, int nk, char* smem) {
  const int tid = TIDX;
#pragma unroll
  for (int st = 0; st < 2; st++) {
    if (st < nk) {
      char* d = smem + st * 49152 + tid * 16;
#pragma unroll
      for (int i = 0; i < 8; i++) glds16(aptr(i) + st * 64, d + i * 4096);
#pragma unroll
      for (int i = 0; i < 4; i++) glds16(bptr(i) + st * 64, d + 32768 + i * 4096);
    }
  }
}
template <bool PRE = false, class AF, class BF>
DI void gemm256(AF aptr, BF bptr, int nk, char* smem, f4 (&acc)[8][4]) {
  const int tid = TIDX, lane = tid & 63, wave = tid >> 6, fr = lane & 15, fq = lane >> 4, wr = wave >> 1, wc = wave & 1;
#pragma unroll
  for (int m = 0; m < 8; m++)
#pragma unroll
    for (int n = 0; n < 4; n++) acc[m][n] = (f4){0.f, 0.f, 0.f, 0.f};
  auto issue = [&](int kt, int st) {
    char* d = smem + st * 49152 + tid * 16;
#pragma unroll
    for (int i = 0; i < 8; i++) glds16(aptr(i) + kt * 64, d + i * 4096);
#pragma unroll
    for (int i = 0; i < 4; i++) glds16(bptr(i) + kt * 64, d + 32768 + i * 4096);
  };
  const unsigned sw = (unsigned)((fq ^ (fr >> 1)) << 4);
  const unsigned offA = (wr * 128 + fr) * 128 + sw, offB = 32768 + (wc * 64 + fr) * 128 + sw;
  const unsigned sbase = lds_addr(smem);
  if (!PRE) { issue(0, 0); if (nk > 1) issue(1, 1); }
  int st = 0;
#pragma unroll 1
  for (int kt = 0; kt < nk; kt++) {
    if (kt + 1 < nk) asm volatile("s_waitcnt vmcnt(12)" ::: "memory"); else wait_vm0();
    raw_barrier();
    if (kt + 2 < nk) issue(kt + 2, st == 0 ? 2 : st - 1);
    const unsigned base = sbase + st * 49152;
    st = st == 2 ? 0 : st + 1;
    h8 a0[8], b0[4], a1[8], b1[4];
#pragma unroll
    for (int m = 0; m < 8; m++) a0[m] = lds128(base + offA + m * 2048);
#pragma unroll
    for (int n = 0; n < 4; n++) b0[n] = lds128(base + offB + n * 2048);
#pragma unroll
    for (int m = 0; m < 8; m++) a1[m] = lds128(base + (offA ^ 64) + m * 2048);
#pragma unroll
    for (int n = 0; n < 4; n++) b1[n] = lds128(base + (offB ^ 64) + n * 2048);
    WAIT_LGKM(12);
#pragma unroll
    for (int m = 0; m < 8; m++) tie(a0[m]);
#pragma unroll
    for (int n = 0; n < 4; n++) tie(b0[n]);
#pragma unroll
    for (int m = 0; m < 8; m++)
#pragma unroll
      for (int n = 0; n < 4; n++) acc[m][n] = mfma16(a0[m], b0[n], acc[m][n]);
    WAIT_LGKM(0);
#pragma unroll
    for (int m = 0; m < 8; m++) tie(a1[m]);
#pragma unroll
    for (int n = 0; n < 4; n++) tie(b1[n]);
#pragma unroll
    for (int m = 0; m < 8; m++)
#pragma unroll
      for (int n = 0; n < 4; n++) acc[m][n] = mfma16(a1[m], b1[n], acc[m][n]);
  }
  raw_barrier();
}
DI bool xcd_tile(int it, int MT, int NT, int& mt, int& nt) {
  const int x = blockIdx.x & 7, j = blockIdx.x >> 3;
  const int nsn = NT >> 2, nsm = (MT + 7) >> 3;
  const int s = x + 8 * it;
  if (s >= nsm * nsn) return false;
  const int sm = s / nsn, sn = s % nsn;
  mt = sm * 8 + (j >> 2); nt = sn * 4 + (j & 3);
  return true;
}
DI bool next_tile(int& it, int MT, int NT, int& mt, int& nt) {
  for (;; it++) {
    if (!xcd_tile(it, MT, NT, mt, nt)) return false;
    if (mt < MT) return true;
  }
}
DI int slot_col() { int t = TIDX; return ((t & 7) ^ ((t >> 4) & 7)) * 8; }

DI float dpp_row_sum(float v) {
  v += __builtin_bit_cast(float, __builtin_amdgcn_update_dpp(0, __builtin_bit_cast(int, v), 0x128, 0xf, 0xf, false));
  v += __builtin_bit_cast(float, __builtin_amdgcn_update_dpp(0, __builtin_bit_cast(int, v), 0x124, 0xf, 0xf, false));
  v += __builtin_bit_cast(float, __builtin_amdgcn_update_dpp(0, __builtin_bit_cast(int, v), 0x122, 0xf, 0xf, false));
  v += __builtin_bit_cast(float, __builtin_amdgcn_update_dpp(0, __builtin_bit_cast(int, v), 0x121, 0xf, 0xf, false));
  return v;
}
DI void stage_put(char* stg, int ml, int n, int j, int fr, int fq, float v) { *(half_t*)(stg + (ml * 16 + fq * 4 + j) * 144 + (n * 16 + fr) * 2) = (half_t)v; }
template <class RP, class SC>
DI void stage_flush(char* stg, int h, RP rowptr, SC rowscale) {
  const int lane = TIDX & 63;
  __builtin_amdgcn_wave_barrier();
#pragma unroll
  for (int i = 0; i < 8; i++) {
    const int c = i * 64 + lane, row = c >> 3, c16 = c & 7;
    h8 v = *(const h8*)(stg + row * 144 + c16 * 16);
    half_t* d = rowptr(h * 64 + row);
    if (d) { rowscale(h * 64 + row, v); *(h8*)(d + c16 * 8) = v; }
  }
  __builtin_amdgcn_wave_barrier();
}
template <class VF, class RP, class SC>
DI void wave_store_tile(VF val, char* stg, RP rowptr, SC rowscale) {
  const int lane = TIDX & 63, fr = lane & 15, fq = lane >> 4;
#pragma unroll
  for (int h = 0; h < 2; h++) {
#pragma unroll
    for (int ml = 0; ml < 4; ml++)
#pragma unroll
      for (int n = 0; n < 4; n++)
#pragma unroll
        for (int j = 0; j < 4; j++) stage_put(stg, ml, n, j, fr, fq, val(h * 4 + ml, n, j));
    stage_flush(stg, h, rowptr, rowscale);
  }
}
DI void gemm_in_phase(const Params& P, int l, char* smem) {
  const int tid = TIDX;
  const half_t* Wt = P.WtIn + (size_t)l * NIN * 1024;
  const int sc = slot_col(), srow = tid >> 3;
  {
    float2* rcl = (float2*)(smem + 147456);
    for (int i = tid; i < 1024; i += 256) rcl[i] = P.rope[i];
    __syncthreads();
  }
  int it = 0, mt, nt;
  bool have = next_tile(it, 264, 20, mt, nt);
  const half_t* a0 = nullptr; const half_t* b0 = nullptr;
  if (have) {
    asm volatile("" : "+s"(mt), "+s"(nt));
    a0 = P.hx + (size_t)(mt * 256 + srow) * D + sc; b0 = Wt + (size_t)(nt * 128 + srow) * D + sc;
    gemm_prologue([&](int i) { return a0 + (size_t)i * 32 * D; }, [&](int i) { return b0 + (size_t)i * 32 * D; }, 16, smem);
  }
#pragma unroll 1
  while (have) {
    f4 acc[8][4];
    gemm256<true>([&](int i) { return a0 + (size_t)i * 32 * D; }, [&](int i) { return b0 + (size_t)i * 32 * D; }, 16, smem, acc);
    const int tid2 = TIDX, lane = tid2 & 63, wave = tid2 >> 6, fr = lane & 15, fq = lane >> 4, wr = wave >> 1, wc = wave & 1;
    const int r0 = mt * 256 + wr * 128;
    const bool isctx = r0 < TC;
    int b, pos0;
    if (isctx) { b = r0 >> 8; pos0 = r0 & 255; } else { b = (r0 - TC) >> 13; pos0 = 256 + ((r0 - TC) & 8191); }
    const bool isqk = nt >= 4 && nt < 12;
    float gg[4] = {0.f, 0.f, 0.f, 0.f}; float2 rr2[2] = {make_float2(1.f, 0.f), make_float2(1.f, 0.f)};
    if (isqk) {
      const float* gvec = (nt < 8 ? P.q_norm_g : P.k_norm_g) + l * 64;
      const float qs = nt < 8 ? 0.125f * 1.4426950408889634f : 1.f;
#pragma unroll
      for (int n = 0; n < 4; n++) gg[n] = gvec[n * 16 + fr] * qs;
      if (!isctx) { const int tp0 = pos0 - 256; rr2[0] = P.rope[(tp0 >> 6) * 16 + fr]; rr2[1] = P.rope[((tp0 >> 6) + 1) * 16 + fr]; }
    }
#pragma unroll
    for (int n = 0; n < 4; n++) asm volatile("" : "+v"(gg[n]));
    asm volatile("" : "+v"(rr2[0].x), "+v"(rr2[0].y), "+v"(rr2[1].x), "+v"(rr2[1].y));
    int it2 = it + 1, mt2, nt2;
    const bool have2 = next_tile(it2, 264, 20, mt2, nt2);
    const half_t* a1 = a0; const half_t* b1 = b0;
    if (have2) {
      asm volatile("" : "+s"(mt2), "+s"(nt2));
      a1 = P.hx + (size_t)(mt2 * 256 + srow) * D + sc; b1 = Wt + (size_t)(nt2 * 128 + srow) * D + sc;
      gemm_prologue([&](int i) { return a1 + (size_t)i * 32 * D; }, [&](int i) { return b1 + (size_t)i * 32 * D; }, 16, smem);
    }
    char* stg = smem + 98304 + wave * 12288;
    auto noscale = [](int, h8&) {};
    if (nt < 4 || nt >= 16) {
      half_t* dst; int ld, c0; bool gel = false;
      if (nt < 4) { dst = P.QF; ld = 512; c0 = nt * 128; }
      else if (nt < 18) { dst = P.gy; ld = 256; c0 = (nt - 16) * 128; gel = true; }
      else { dst = P.rr; ld = 256; c0 = (nt - 18) * 128; }
      half_t* base = dst + (size_t)r0 * ld + c0 + wc * 64;
      if (gel) wave_store_tile([&](int m, int n, int j) { return gelu_tanh(acc[m][n][j]); }, stg, [&](int r) { return base + (size_t)r * ld; }, noscale);
      else wave_store_tile([&](int m, int n, int j) { return acc[m][n][j]; }, stg, [&](int r) { return base + (size_t)r * ld; }, noscale);
    } else if (nt < 12) {
      const bool isq = nt < 8; const int head = isq ? nt - 4 : nt - 8;
      const float2* rcl = (const float2*)(smem + 147456);
      half_t* base = (isq ? P.q + (size_t)r0 * 512 : P.kall + ((size_t)b * KV + pos0) * 512) + head * 128 + wc * 64;
#pragma unroll
      for (int mh = 0; mh < 2; mh++) {
#pragma unroll
        for (int mm = 0; mm < 4; mm++) {
          const int m = mh * 4 + mm;
#pragma unroll
          for (int j = 0; j < 4; j++) {
            float ss = 0.f;
#pragma unroll
            for (int n = 0; n < 4; n++) ss += acc[m][n][j] * acc[m][n][j];
            ss = dpp_row_sum(ss);
            const float rstd = rsqrtf(ss * (1.f / 64.f) + EPS);
            float o[4];
#pragma unroll
            for (int n = 0; n < 4; n++) o[n] = acc[m][n][j] * rstd * gg[n];
            if (!isctx) {
              const float2 cr = rr2[mh], cc = rcl[(mm * 16 + fq * 4 + j) * 16 + fr];
              float a0 = o[0] * cr.x - o[1] * cr.y, a1 = o[1] * cr.x + o[0] * cr.y;
              float a2 = o[2] * cc.x - o[3] * cc.y, a3 = o[3] * cc.x + o[2] * cc.y;
              o[0] = a0; o[1] = a1; o[2] = a2; o[3] = a3;
            }
#pragma unroll
            for (int n = 0; n < 4; n++) stage_put(stg, mm, n, j, fr, fq, o[n]);
          }
        }
        stage_flush(stg, mh, [&](int r) { return base + (size_t)r * 512; }, noscale);
      }
    } else {
      const int head = nt - 12;
#pragma unroll
      for (int m = 0; m < 8; m++)
#pragma unroll
        for (int n = 0; n < 4; n++) {
          h4 o; o[0] = (half_t)acc[m][n][0]; o[1] = (half_t)acc[m][n][1]; o[2] = (half_t)acc[m][n][2]; o[3] = (half_t)acc[m][n][3];
          int d = wc * 64 + n * 16 + fr;
          asm volatile("" : "+v"(d) :: "memory");
          *(h4*)(P.vT + ((size_t)(b * 4 + head) * 128 + d) * KV + pos0 + m * 16 + fq * 4) = o;
        }
    }
    mt = mt2; nt = nt2; it = it2; have = have2; a0 = a1; b0 = b1;
  }
}

DI void gemm_out_phase(const Params& P, int l, char* smem) {
  const int tid = TIDX, lane = tid & 63, wave = tid >> 6, fr = lane & 15, fq = lane >> 4, wr = wave >> 1, wc = wave & 1;
  const half_t* Wt = P.WtOut + (size_t)l * 1048576;
  const int mt0 = l == 0 ? 0 : TC / 256;
  const int sc = slot_col(), srow = tid >> 3;
#pragma unroll 1
  for (int it = 0;; it++) {
    int mt, nt;
    if (!xcd_tile(it, 264 - mt0, 8, mt, nt)) break;
    mt += mt0;
    if (mt >= 264) continue;
    asm volatile("" : "+s"(mt), "+s"(nt));
    f4 acc[8][4];
    {
      const half_t* a0 = P.mix + (size_t)(mt * 256 + srow) * D + sc; const half_t* b0 = Wt + (size_t)(nt * 128 + srow) * D + sc;
      gemm256([&](int i) { return a0 + (size_t)i * 32 * D; }, [&](int i) { return b0 + (size_t)i * 32 * D; }, 16, smem, acc);
    }
    const int r0 = mt * 256 + wr * 128;
    const int n = row_mod(r0);
    const float* g1 = P.mod + (size_t)(l * 9 + n) * 6144 + 2 * 1024;
    const float* res; float* dst;
    if (r0 < TC) { res = P.ctx + (size_t)r0 * D; dst = P.xcbuf + (size_t)r0 * D; }
    else { dst = P.out + (size_t)(r0 - TC) * D; res = l == 0 ? P.x + (size_t)(r0 - TC) * D : dst; }
#pragma unroll
    for (int m = 0; m < 8; m++) {
      int rb = m * 16 + fq * 4;
      asm volatile("" : "+v"(rb) :: "memory");
#pragma unroll
      for (int nn = 0; nn < 4; nn++) {
        const int c = nt * 128 + wc * 64 + nn * 16 + fr; const float g = g1[c];
#pragma unroll
        for (int j = 0; j < 4; j++) { size_t o = (size_t)(rb + j) * D + c; dst[o] = res[o] + g * acc[m][nn][j]; }
      }
    }
  }
}

DI void moe_prefix(const Params& P, int l, int* tb) {
  __syncthreads();
  if (TIDX == 0) { int s = 0; for (int e = 0; e < 32; e++) { tb[e] = s; s += (P.cnt[l * 32 + e] + 255) >> 8; } tb[32] = s; }
  __syncthreads();
}
DI void moe_e1_phase(const Params& P, int l, char* smem, int* tb) {
  const int tid = TIDX;
  moe_prefix(P, l, tb);
  const int sc = slot_col(), srow = tid >> 3;
  const int MT = tb[32];
  auto setup = [&](int rt, int nt, int (&tok)[8], const half_t*& w1, const half_t*& w3) {
    int e = 0;
    while (tb[e + 1] <= rt) e++;
    const int rl = rt - tb[e], cnt = P.cnt[l * 32 + e];
    const int* lst = P.list + (size_t)e * LCAP;
    w1 = P.Wt1 + ((size_t)(l * 32 + e) * 512 + nt * 64) * 1024 + sc;
    w3 = P.Wt3 + ((size_t)(l * 32 + e) * 512 + nt * 64) * 1024 + sc;
#pragma unroll
    for (int i = 0; i < 8; i++) tok[i] = lst[min(rl * 256 + i * 32 + srow, cnt - 1)] >> 1;
  };
  int it = 0, rt, nt;
  bool have = next_tile(it, MT, 8, rt, nt);
  int tok[8]; const half_t* w1 = nullptr; const half_t* w3 = nullptr;
  if (have) {
    asm volatile("" : "+s"(rt), "+s"(nt));
    setup(rt, nt, tok, w1, w3);
    gemm_prologue([&](int i) { return P.hx + (size_t)tok[i] * D + sc; }, [&](int i) { return ((i & 1) ? w3 : w1) + (size_t)((i >> 1) * 32 + srow) * 1024; }, 16, smem);
  }
#pragma unroll 1
  while (have) {
    f4 acc[8][4];
    gemm256<true>([&](int i) { return P.hx + (size_t)tok[i] * D + sc; },
                  [&](int i) { return ((i & 1) ? w3 : w1) + (size_t)((i >> 1) * 32 + srow) * 1024; }, 16, smem, acc);
    int it2 = it + 1, rt2, nt2;
    const bool have2 = next_tile(it2, MT, 8, rt2, nt2);
    int tok2[8]; const half_t* w1n = w1; const half_t* w3n = w3;
#pragma unroll
    for (int i = 0; i < 8; i++) tok2[i] = tok[i];
    if (have2) {
      asm volatile("" : "+s"(rt2), "+s"(nt2));
      setup(rt2, nt2, tok2, w1n, w3n);
      gemm_prologue([&](int i) { return P.hx + (size_t)tok2[i] * D + sc; }, [&](int i) { return ((i & 1) ? w3n : w1n) + (size_t)((i >> 1) * 32 + srow) * 1024; }, 16, smem);
    }
    {
      const int tid2 = TIDX, lane2 = tid2 & 63, wave2 = tid2 >> 6, fr2 = lane2 & 15, fq2 = lane2 >> 4, wr2 = wave2 >> 1, wc2 = wave2 & 1;
      char* stg = smem + 98304 + wave2 * 12288;
      half_t* Hd = P.H + ((size_t)rt * 256 + wr2 * 128) * 512 + nt * 64 + wc2 * 32;
#pragma unroll
      for (int h = 0; h < 2; h++) {
#pragma unroll
        for (int ml = 0; ml < 4; ml++)
#pragma unroll
          for (int n = 0; n < 2; n++)
#pragma unroll
            for (int j = 0; j < 4; j++) {
              float a1 = acc[h * 4 + ml][n][j], a3 = acc[h * 4 + ml][n + 2][j];
              *(half_t*)(stg + (ml * 16 + fq2 * 4 + j) * 80 + (n * 16 + fr2) * 2) = (half_t)(a1 * sigmoidf_(a1) * a3);
            }
        __builtin_amdgcn_wave_barrier();
#pragma unroll
        for (int i = 0; i < 4; i++) {
          const int c = i * 64 + lane2, row = c >> 2, c16 = c & 3;
          h8 v = *(const h8*)(stg + row * 80 + c16 * 16);
          *(h8*)(Hd + (size_t)(h * 64 + row) * 512 + c16 * 8) = v;
        }
        __builtin_amdgcn_wave_barrier();
      }
    }
    rt = rt2; nt = nt2; it = it2; have = have2; w1 = w1n; w3 = w3n;
#pragma unroll
    for (int i = 0; i < 8; i++) tok[i] = tok2[i];
  }
}
DI void moe_e2_phase(const Params& P, int l, char* smem, int* tb) {
  const int tid = TIDX;
  moe_prefix(P, l, tb);
  const int sc = slot_col(), srow = tid >> 3;
  const int MT = tb[32];
  auto ptrs = [&](int rt, int nt, const half_t*& a0, const half_t*& b0) {
    int e = 0;
    while (tb[e + 1] <= rt) e++;
    a0 = P.H + ((size_t)rt * 256 + srow) * 512 + sc;
    b0 = P.Wt2 + ((size_t)(l * 32 + e) * 1024 + nt * 128 + srow) * 512 + sc;
  };
  int it = 0, rt, nt;
  bool have = next_tile(it, MT, 8, rt, nt);
  const half_t* a0 = nullptr; const half_t* b0 = nullptr;
  if (have) {
    asm volatile("" : "+s"(rt), "+s"(nt));
    ptrs(rt, nt, a0, b0);
    gemm_prologue([&](int i) { return a0 + (size_t)i * 32 * 512; }, [&](int i) { return b0 + (size_t)i * 32 * 512; }, 8, smem);
  }
#pragma unroll 1
  while (have) {
    f4 acc[8][4];
    gemm256<true>([&](int i) { return a0 + (size_t)i * 32 * 512; }, [&](int i) { return b0 + (size_t)i * 32 * 512; }, 8, smem, acc);
    const int tid2 = TIDX, lane2 = tid2 & 63, wave2 = tid2 >> 6, wr2 = wave2 >> 1, wc2 = wave2 & 1;
    int e = 0;
    while (tb[e + 1] <= rt) e++;
    const int rl = rt - tb[e], cnt = P.cnt[l * 32 + e];
    const int* lst = P.list + (size_t)e * LCAP;
    int aa[2][8]; float ww[2][8];
#pragma unroll
    for (int h = 0; h < 2; h++)
#pragma unroll
      for (int i = 0; i < 8; i++) {
        const int idx = rl * 256 + wr2 * 128 + h * 64 + ((i * 64 + lane2) >> 3);
        aa[h][i] = idx < cnt ? lst[idx] : -1;
      }
#pragma unroll
    for (int h = 0; h < 2; h++)
#pragma unroll
      for (int i = 0; i < 8; i++) ww[h][i] = aa[h][i] >= 0 ? P.tokW[aa[h][i]] : 0.f;
#pragma unroll
    for (int h = 0; h < 2; h++)
#pragma unroll
      for (int i = 0; i < 8; i++) asm volatile("" : "+v"(ww[h][i]), "+v"(aa[h][i]));
    int it2 = it + 1, rt2, nt2;
    const bool have2 = next_tile(it2, MT, 8, rt2, nt2);
    const half_t* a1 = a0; const half_t* b1 = b0;
    if (have2) {
      asm volatile("" : "+s"(rt2), "+s"(nt2));
      ptrs(rt2, nt2, a1, b1);
      gemm_prologue([&](int i) { return a1 + (size_t)i * 32 * 512; }, [&](int i) { return b1 + (size_t)i * 32 * 512; }, 8, smem);
    }
    {
      char* stg = smem + 98304 + wave2 * 12288;
      const int fr2 = lane2 & 15, fq2 = lane2 >> 4;
#pragma unroll
      for (int h = 0; h < 2; h++) {
#pragma unroll
        for (int ml = 0; ml < 4; ml++)
#pragma unroll
          for (int n = 0; n < 4; n++)
#pragma unroll
            for (int j = 0; j < 4; j++) stage_put(stg, ml, n, j, fr2, fq2, acc[h * 4 + ml][n][j]);
        __builtin_amdgcn_wave_barrier();
#pragma unroll
        for (int i = 0; i < 8; i++) {
          const int c = i * 64 + lane2, row = c >> 3, c16 = c & 7;
          h8 v = *(const h8*)(stg + row * 144 + c16 * 16);
          if (aa[h][i] >= 0) {
            const float w = ww[h][i];
#pragma unroll
            for (int u = 0; u < 8; u++) v[u] = (half_t)(w * (float)v[u]);
            *(h8*)(P.yA + (size_t)aa[h][i] * D + nt * 128 + wc2 * 64 + c16 * 8) = v;
          }
        }
        __builtin_amdgcn_wave_barrier();
      }
    }
    rt = rt2; nt = nt2; it = it2; have = have2; a0 = a1; b0 = b1;
  }
}

DI int swap23(int x) { return (x & ~12) | ((x & 4) << 1) | ((x & 8) >> 1); }
DI void attn_item(const Params& P, int l, int b, int head, int row0, int nkeys, char* smem) {
  const int tid = TIDX, lane = tid & 63, wave = tid >> 6, ql = lane & 31, hh = lane >> 5;
  const float lam = P.consts[l * 4 + 0], negc = -P.consts[l * 4 + 1], lam_init = P.consts[l * 4 + 2];
  const int myrow = row0 + wave * 32 + ql;
  h8 qf[2][4];
  {
    const half_t* qp = P.q + (size_t)myrow * 512 + head * 128 + hh * 8;
#pragma unroll
    for (int m = 0; m < 2; m++)
#pragma unroll
      for (int s = 0; s < 4; s++) { qf[m][s] = *(const h8*)(qp + m * 64 + s * 16); }
#pragma unroll
    for (int m = 0; m < 2; m++)
#pragma unroll
      for (int s = 0; s < 4; s++) tie(qf[m][s]);
  }
  f16v o0[4], o1[4];
#pragma unroll
  for (int dt = 0; dt < 4; dt++)
#pragma unroll
    for (int i = 0; i < 16; i++) { o0[dt][i] = 0.f; o1[dt][i] = 0.f; }
  float ls0 = 0.f, ls1 = 0.f;
  const half_t* kp[4]; const half_t* vp[4];
  {
    const half_t* kbase = P.kall + (size_t)b * KV * 512 + head * 128;
    const half_t* vbase = P.vT + (size_t)(b * 4 + head) * 128 * KV;
#pragma unroll
    for (int i = 0; i < 4; i++) {
      int s = i * 256 + tid;
      int row = s >> 4, c = (s & 15) ^ (row & 15); kp[i] = kbase + (size_t)row * 512 + c * 8;
      int vr = s >> 3, vc = (s & 7) ^ ((vr >> 1) & 7); vp[i] = vbase + (size_t)vr * KV + vc * 8;
    }
  }
  const int ntile = nkeys >> 6;
  const unsigned sbase = lds_addr(smem);
  auto issue = [&](int t) {
    char* d = smem + (t % 3) * 32768 + tid * 16;
#pragma unroll
    for (int i = 0; i < 4; i++) { glds16(kp[i] + (size_t)t * 64 * 512, d + i * 4096); glds16(vp[i] + t * 64, d + 16384 + i * 4096); }
  };
  unsigned koff[2];
  const int kr_lo = swap23(ql), ksw = kr_lo & 15;
  koff[0] = kr_lo * 256; koff[1] = (32 + kr_lo) * 256;
  unsigned voff[4];
#pragma unroll
  for (int dt = 0; dt < 4; dt++) { int vrow = dt * 32 + ql; voff[dt] = 16384 + vrow * 128; }
  const int vsw = (ql >> 1) & 7;
  f16v negcv;
#pragma unroll
  for (int i = 0; i < 16; i++) negcv[i] = negc;
  h8 pp0[2], pp1[2];
  unsigned pendV = 0; int pendkt = 0; bool pend = false;
  auto half_step = [&](h8 (&kf)[8], unsigned cur, int kt) {
    h8 vf[8];
    if (pend) {
#pragma unroll
      for (int sp = 0; sp < 2; sp++)
#pragma unroll
        for (int dt = 0; dt < 4; dt++) vf[sp * 4 + dt] = lds128(pendV + voff[dt] + (((pendkt * 4 + sp * 2 + hh) ^ vsw) << 4));
    }
    f16v s0 = mfma32(kf[0], qf[0][0], negcv), s1 = mfma32(kf[4], qf[1][0], negcv);
#pragma unroll
    for (int st = 1; st < 4; st++) { s0 = mfma32(kf[st], qf[0][st], s0); s1 = mfma32(kf[4 + st], qf[1][st], s1); }
    if (pend) {
      WAIT_LGKM(0);
#pragma unroll
      for (int i = 0; i < 8; i++) tie(vf[i]);
#pragma unroll
      for (int sp = 0; sp < 2; sp++)
#pragma unroll
        for (int dt = 0; dt < 4; dt++) { o0[dt] = mfma32(vf[sp * 4 + dt], pp0[sp], o0[dt]); o1[dt] = mfma32(vf[sp * 4 + dt], pp1[sp], o1[dt]); }
    }
#pragma unroll
    for (int i = 0; i < 16; i++) { s0[i] = __builtin_amdgcn_exp2f(s0[i]); ls0 += s0[i]; s1[i] = __builtin_amdgcn_exp2f(s1[i]); ls1 += s1[i]; }
#pragma unroll
    for (int sp = 0; sp < 2; sp++) {
      u4 a, c;
      a[0] = pk2(s0[8*sp+0], s0[8*sp+1]); a[1] = pk2(s0[8*sp+2], s0[8*sp+3]); a[2] = pk2(s0[8*sp+4], s0[8*sp+5]); a[3] = pk2(s0[8*sp+6], s0[8*sp+7]);
      c[0] = pk2(s1[8*sp+0], s1[8*sp+1]); c[1] = pk2(s1[8*sp+2], s1[8*sp+3]); c[2] = pk2(s1[8*sp+4], s1[8*sp+5]); c[3] = pk2(s1[8*sp+6], s1[8*sp+7]);
      pp0[sp] = __builtin_bit_cast(h8, a); pp1[sp] = __builtin_bit_cast(h8, c);
    }
    pend = true; pendV = cur; pendkt = kt;
  };
  issue(0);
#pragma unroll 1
  for (int t = 0; t < ntile; t++) {
    wait_vm0();
    raw_barrier();
    if (t + 1 < ntile) issue(t + 1);
    const unsigned cur = sbase + (t % 3) * 32768;
    h8 kfa[8], kfb[8];
#pragma unroll
    for (int st = 0; st < 4; st++) {
      kfa[st] = lds128(cur + koff[0] + (((st * 2 + hh) ^ ksw) << 4));
      kfa[4 + st] = lds128(cur + koff[0] + (((8 + st * 2 + hh) ^ ksw) << 4));
    }
#pragma unroll
    for (int st = 0; st < 4; st++) {
      kfb[st] = lds128(cur + koff[1] + (((st * 2 + hh) ^ ksw) << 4));
      kfb[4 + st] = lds128(cur + koff[1] + (((8 + st * 2 + hh) ^ ksw) << 4));
    }
    WAIT_LGKM(8);
#pragma unroll
    for (int i = 0; i < 8; i++) tie(kfa[i]);
    half_step(kfa, cur, 0);
    WAIT_LGKM(0);
#pragma unroll
    for (int i = 0; i < 8; i++) tie(kfb[i]);
    half_step(kfb, cur, 1);
  }
  {
    h8 vf[8];
#pragma unroll
    for (int sp = 0; sp < 2; sp++)
#pragma unroll
      for (int dt = 0; dt < 4; dt++) vf[sp * 4 + dt] = lds128(pendV + voff[dt] + (((pendkt * 4 + sp * 2 + hh) ^ vsw) << 4));
    WAIT_LGKM(0);
#pragma unroll
    for (int i = 0; i < 8; i++) tie(vf[i]);
#pragma unroll
    for (int sp = 0; sp < 2; sp++)
#pragma unroll
      for (int dt = 0; dt < 4; dt++) { o0[dt] = mfma32(vf[sp * 4 + dt], pp0[sp], o0[dt]); o1[dt] = mfma32(vf[sp * 4 + dt], pp1[sp], o1[dt]); }
  }
  raw_barrier();
  ls0 += shx(ls0, 32); ls1 += shx(ls1, 32);
  const float i0 = 1.f / ls0, i1 = lam / ls1;
  float ss = 0.f;
#pragma unroll
  for (int dt = 0; dt < 4; dt++)
#pragma unroll
    for (int i = 0; i < 16; i++) { float v = o0[dt][i] * i0 - o1[dt][i] * i1; o0[dt][i] = v; ss += v * v; }
  ss += shx(ss, 32);
  const float mult = rsqrtf(ss * (1.f / 128.f) + EPS) * (1.f - lam_init);
  const float* sg = P.subln_g + l * 128;
  half_t* dst = P.mix + (size_t)myrow * D + 256 + head * 128;
#pragma unroll
  for (int dt = 0; dt < 4; dt++)
#pragma unroll
    for (int g = 0; g < 4; g++) {
      const int d0 = dt * 32 + 8 * g + 4 * hh;
      float4 gv = *(const float4*)(sg + d0);
      h4 o; o[0] = (half_t)(o0[dt][4*g] * mult * gv.x); o[1] = (half_t)(o0[dt][4*g+1] * mult * gv.y);
      o[2] = (half_t)(o0[dt][4*g+2] * mult * gv.z); o[3] = (half_t)(o0[dt][4*g+3] * mult * gv.w);
      *(h4*)(dst + d0) = o;
    }
}

DI int swz128(int row, int colh) { return row * 128 + ((((colh >> 3)) ^ ((row >> 1) & 7)) << 4) + (colh & 7) * 2; }
DI void lru_load_w(const Params& P, int l, int g, char* Wt) {
  const int tid = TIDX;
  for (int dg = 0; dg < 4; dg++) {
    const int dir = dg >> 1;
    const float* w = ((dg & 1) ? P.gate_x_w : P.gate_a_w) + ((size_t)((l * 2 + dir) * 4 + g)) * 4096;
    for (int idx = tid; idx < 4096; idx += 256) { int i = idx >> 6, o = idx & 63; *(half_t*)(Wt + dg * 8192 + swz128(o, i)) = (half_t)w[idx]; }
  }
}
DI void lru_tile(const Params& P, int l, int b, int tile, int g, char* smem, bool final) {
  const int tid = TIDX, lane = tid & 63, wave = tid >> 6, fr = lane & 15, fq = lane >> 4;
  char* Wt = smem;
  char* xr16 = smem + 32768;
  float2* ab = (float2*)(smem + 40960);
  half_t* raw = (half_t*)(smem + 40960);
  float2* subst = (float2*)(smem + 73728);
  const int ch = tid & 63, tq = tid >> 6, gc = g * 64 + ch;
  const int T = tile < 4 ? CL : SEQ;
  const int t0 = tile < 4 ? tile * 64 : (tile - 4) * 64;
  const int rowbase = tile < 4 ? b * CL : TC + b * SEQ;
  unsigned* lab = (unsigned*)P.hx;
  __syncthreads();
  if (final) {
    float gyv[16], hsum[16];
#pragma unroll
    for (int e = 0; e < 16; e++) { gyv[e] = (float)P.gy[(size_t)(rowbase + t0 + tq * 16 + e) * 256 + gc]; hsum[e] = 0.f; }
#pragma unroll 1
    for (int dir = 0; dir < 2; dir++) {
      unsigned pk[16];
#pragma unroll
      for (int e = 0; e < 16; e++) pk[e] = lab[((size_t)dir * TA + rowbase + t0 + tq * 16 + e) * 256 + gc];
      float2 av[16];
      float A = 1.f, h = 0.f;
#pragma unroll
      for (int e = 0; e < 16; e++) {
        const int ee = dir == 0 ? e : 15 - e;
        unsigned u = pk[0];
#pragma unroll
        for (int q = 1; q < 16; q++) u = (q == ee) ? pk[q] : u;
        fp16x2 hv = __builtin_bit_cast(fp16x2, u);
        av[e] = make_float2(__expf((float)hv[0]), (float)hv[1]);
        h = av[e].x * h + av[e].y; A *= av[e].x;
      }
      subst[tq * 64 + ch] = make_float2(A, h);
      __syncthreads();
      h = P.lcar[((size_t)((b * 2 + dir) * 132 + tile)) * 256 + gc];
      if (dir == 0) { for (int s2 = 0; s2 < tq; s2++) { float2 ss = subst[s2 * 64 + ch]; h = ss.x * h + ss.y; } }
      else { for (int s2 = 3; s2 > tq; s2--) { float2 ss = subst[s2 * 64 + ch]; h = ss.x * h + ss.y; } }
#pragma unroll
      for (int e = 0; e < 16; e++) {
        const int ee = dir == 0 ? e : 15 - e;
        h = av[e].x * h + av[e].y;
#pragma unroll
        for (int q = 0; q < 16; q++) hsum[q] += (q == ee) ? h : 0.f;
      }
      __syncthreads();
    }
#pragma unroll
    for (int e = 0; e < 16; e++)
      P.mix[(size_t)(rowbase + t0 + tq * 16 + e) * D + 768 + gc] = (half_t)(gyv[e] * hsum[e]);
    return;
  }
  for (int idx = tid; idx < 67 * 8; idx += 256) {
    int row = idx >> 3, c = idx & 7, tt = t0 - 1 + row;
    h8 v = {0, 0, 0, 0, 0, 0, 0, 0};
    if (tt >= 0 && tt < T) v = *(const h8*)(P.rr + (size_t)(rowbase + tt) * 256 + g * 64 + c * 8);
    *(h8*)(raw + row * 64 + c * 8) = v;
  }
  const float cw0 = P.conv_w[(l * 4 + 0) * 256 + gc], cw1 = P.conv_w[(l * 4 + 1) * 256 + gc], cw2 = P.conv_w[(l * 4 + 2) * 256 + gc],
              cw3 = P.conv_w[(l * 4 + 3) * 256 + gc], cb = P.conv_b[l * 256 + gc];
  __syncthreads();
  {
    float v[19];
#pragma unroll
    for (int e = 0; e < 19; e++) v[e] = (float)raw[(tq * 16 + e) * 64 + ch];
    __syncthreads();
#pragma unroll
    for (int e = 0; e < 16; e++) {
      float xv = cb + cw0 * v[e] + cw1 * v[e + 1] + cw2 * v[e + 2] + cw3 * v[e + 3];
      *(half_t*)(xr16 + swz128(tq * 16 + e, ch)) = (half_t)xv;
    }
  }
  __syncthreads();
#pragma unroll 1
  for (int dir = 0; dir < 2; dir++) {
    {
      f4 acc[2][4];
#pragma unroll
      for (int gt = 0; gt < 2; gt++)
#pragma unroll
        for (int n = 0; n < 4; n++) acc[gt][n] = (f4){0.f, 0.f, 0.f, 0.f};
#pragma unroll
      for (int kk = 0; kk < 2; kk++) {
        int row = wave * 16 + fr;
        h8 af = *(const h8*)(xr16 + row * 128 + (((kk * 4 + fq) ^ ((row >> 1) & 7)) << 4));
#pragma unroll
        for (int gt = 0; gt < 2; gt++)
#pragma unroll
          for (int n = 0; n < 4; n++) {
            int orow = n * 16 + fr;
            h8 bf = *(const h8*)(Wt + (dir * 2 + gt) * 8192 + orow * 128 + (((kk * 4 + fq) ^ ((orow >> 1) & 7)) << 4));
            acc[gt][n] = mfma16(af, bf, acc[gt][n]);
          }
      }
#pragma unroll
      for (int n = 0; n < 4; n++) {
        const int cc = (l * 2 + dir) * 256 + g * 64 + n * 16 + fr;
        const float ba = P.gate_a_b[cc], bx = P.gate_x_b[cc];
        const float sp8 = -8.f * log1pf(__expf(-P.lru_lambda[cc]));
#pragma unroll
        for (int j = 0; j < 4; j++) {
          int tl = wave * 16 + fq * 4 + j, c2 = n * 16 + fr;
          float xv = (float)*(const half_t*)(xr16 + swz128(tl, c2));
          float rg = sigmoidf_(acc[0][n][j] + ba), ig = sigmoidf_(acc[1][n][j] + bx);
          float log_a = rg * sp8;
          float x2 = 2.f * log_a;
          float om = -x2 * (1.f + x2 * (0.5f + x2 * (0.16666667f + x2 * (0.041666668f + x2 * (0.008333334f + x2 * 0.0013888889f)))));
          if (x2 < -0.4f) { float a = __expf(log_a); om = 1.f - a * a; }
          ab[tl * 64 + c2] = make_float2(log_a, sqrtf(om) * (ig * xv));
        }
      }
    }
    __syncthreads();
    {
      float A = 1.f, h = 0.f;
#pragma unroll
      for (int e = 0; e < 16; e++) {
        const int ee = dir == 0 ? e : 15 - e;
        const float2 lb = ab[(tq * 16 + ee) * 64 + ch];
        fp16x2 hv; hv[0] = (__fp16)lb.x; hv[1] = (__fp16)lb.y;
        lab[((size_t)dir * TA + rowbase + t0 + tq * 16 + ee) * 256 + gc] = __builtin_bit_cast(unsigned, hv);
        const float a = __expf((float)hv[0]), bt = (float)hv[1];
        h = a * h + bt; A *= a;
      }
      subst[tq * 64 + ch] = make_float2(A, h);
    }
    __syncthreads();
    if (tq == 0) {
      float A = 1.f, h = 0.f;
#pragma unroll
      for (int s2 = 0; s2 < 4; s2++) { float2 ss = subst[(dir == 0 ? s2 : 3 - s2) * 64 + ch]; h = ss.x * h + ss.y; A *= ss.x; }
      P.lsum[((size_t)((b * 2 + dir) * 132 + tile)) * 256 + gc] = make_float2(A, h);
    }
    __syncthreads();
  }
}
DI void lru_carry_item(const Params& P, int it) {
  const int ch = TIDX, dir = it & 1;
  const size_t base = (size_t)it * 132 * 256 + ch;
  float c = 0.f;
#pragma unroll 4
  for (int k = 0; k < 132; k++) {
    int tile = dir == 0 ? k : (k < 4 ? 3 - k : 135 - k);
    float2 s = P.lsum[base + (size_t)tile * 256];
    P.lcar[base + (size_t)tile * 256] = c;
    c = s.x * c + s.y;
  }
}

DI void fft_load(const half_t* src, size_t rs, int nrows, char* Bt, int rowbytes, int k0) {
  for (int idx = TIDX; idx < nrows * 16; idx += 256) {
    int kr = idx >> 4, cc = idx & 15, k = k0 + kr;
    h8 v = *(const h8*)(src + (size_t)kr * rs + cc * 8);
#pragma unroll
    for (int u = 0; u < 8; u++) { int n = cc * 8 + u; *(half_t*)(Bt + n * rowbytes + ((((k >> 3)) ^ (n & 15)) << 4) + (k & 7) * 2) = v[u]; }
  }
}
template <class RF>
DI void fft_mma(const half_t* Dm, int ldD, int nkk, const char* Bt, int rowbytes, f4 (&acc)[4][4], RF arow) {
  const int lane = TIDX & 63, wave = TIDX >> 6, fr = lane & 15, fq = lane >> 4, wc = wave & 1;
#pragma unroll 1
  for (int kk = 0; kk < nkk; kk++) {
    h8 af[4], bf[4];
#pragma unroll
    for (int ms = 0; ms < 4; ms++) af[ms] = *(const h8*)(Dm + (size_t)arow(ms) * ldD + kk * 32 + fq * 8);
#pragma unroll
    for (int ns = 0; ns < 4; ns++) { int n = wc * 64 + ns * 16 + fr; bf[ns] = *(const h8*)(Bt + n * rowbytes + (((kk * 4 + fq) ^ (n & 15)) << 4)); }
#pragma unroll
    for (int ms = 0; ms < 4; ms++)
#pragma unroll
      for (int ns = 0; ns < 4; ns++) acc[ms][ns] = mfma16(af[ms], bf[ns], acc[ms][ns]);
  }
}
DI void zero44(f4 (&acc)[4][4]) {
#pragma unroll
  for (int m = 0; m < 4; m++)
#pragma unroll
    for (int n = 0; n < 4; n++) acc[m][n] = (f4){0.f, 0.f, 0.f, 0.f};
}
DI void fftA_item(const Params& P, int it, char* smem) {
  const int b = it >> 8, bb = (it >> 1) & 127, chh = it & 1;
  const int lane = TIDX & 63, wave = TIDX >> 6, fr = lane & 15, fq = lane >> 4, wr = wave >> 1, wc = wave & 1;
  __syncthreads();
  fft_load(P.QF + (size_t)(TC + b * SEQ + bb) * 512 + chh * 128, (size_t)128 * 512, 64, smem, 256, 0);
  fft_load(P.QF + (size_t)(TC + b * SEQ + bb) * 512 + 256 + chh * 128, (size_t)128 * 512, 64, smem, 256, 64);
  __syncthreads();
  f4 acc[4][4]; zero44(acc);
  fft_mma(P.DA, 128, 4, smem, 256, acc, [&](int ms) { return (ms >> 1) * 64 + wr * 32 + (ms & 1) * 16 + fr; });
#pragma unroll
  for (int ms = 0; ms < 2; ms++)
#pragma unroll
    for (int j = 0; j < 4; j++) {
      const int f1 = wr * 32 + ms * 16 + fq * 4 + j;
      const float2 w = P.tw[(bb * f1) & 8191];
      half_t* d0 = P.GA + ((size_t)(b * 64 + f1) * 256 + bb) * 256 + chh * 128 + wc * 64 + fr;
#pragma unroll
      for (int ns = 0; ns < 4; ns++) {
        float gr = acc[ms][ns][j], gi = acc[ms + 2][ns][j];
        d0[ns * 16] = (half_t)(gr * w.x + gi * w.y);
        d0[(size_t)128 * 256 + ns * 16] = (half_t)(gi * w.x - gr * w.y);
      }
    }
}
DI void fftB_item(const Params& P, int it, char* smem) {
  const int b = it >> 7, f1 = (it >> 1) & 63, chh = it & 1;
  const int lane = TIDX & 63, wave = TIDX >> 6, fr = lane & 15, fq = lane >> 4, wr = wave >> 1, wc = wave & 1;
  __syncthreads();
  fft_load(P.GA + (size_t)(b * 64 + f1) * 256 * 256 + chh * 128, 256, 256, smem, 512, 0);
  __syncthreads();
  f4 acc[4][4]; zero44(acc);
  fft_mma(P.DB, 256, 8, smem, 512, acc, [&](int ms) { return wr * 64 + ms * 16 + fr; });
#pragma unroll
  for (int ms = 0; ms < 4; ms++)
#pragma unroll
    for (int j = 0; j < 4; j++) {
      const int f2 = wr * 64 + ms * 16 + fq * 4 + j;
      half_t* d0 = P.mix + (size_t)(TC + b * SEQ + f1 + 64 * f2) * D + chh * 128 + wc * 64 + fr;
#pragma unroll
      for (int ns = 0; ns < 4; ns++) d0[ns * 16] = (half_t)acc[ms][ns][j];
    }
}
DI void fftC_item(const Params& P, int it, char* smem) {
  const int b = it >> 1, chh = it & 1;
  const int lane = TIDX & 63, wave = TIDX >> 6, fr = lane & 15, fq = lane >> 4, wr = wave >> 1, wc = wave & 1;
#pragma unroll 1
  for (int mh = 0; mh < 2; mh++) {
    f4 acc[4][4]; zero44(acc);
#pragma unroll 1
    for (int part = 0; part < 2; part++) {
      __syncthreads();
      fft_load(P.QF + (size_t)(b * CL) * 512 + part * 256 + chh * 128, 512, 256, smem, 512, 0);
      __syncthreads();
      fft_mma(P.DC + part * 256, 512, 8, smem, 512, acc, [&](int ms) { return mh * 128 + wr * 64 + ms * 16 + fr; });
    }
#pragma unroll
    for (int ms = 0; ms < 4; ms++)
#pragma unroll
      for (int j = 0; j < 4; j++) {
        const int f = mh * 128 + wr * 64 + ms * 16 + fq * 4 + j;
        half_t* d0 = P.mix + (size_t)(b * CL + f) * D + chh * 128 + wc * 64 + fr;
#pragma unroll
        for (int ns = 0; ns < 4; ns++) d0[ns * 16] = (half_t)acc[ms][ns][j];
      }
  }
}

#ifndef MX
#define MX 15
#endif
DI void mix_phase(const Params& P, int l, char* smem, int* s_item, int qi) {
  const int nL = 0, nA = 0, nC = l == 0 ? 64 : 0, nFA = 2048, nFC = l == 0 ? 16 : 0;
  const int total = nL + nA + nC + nFA + nFC;
  {
    const int g = blockIdx.x & 3;
    lru_load_w(P, l, g, smem);
    for (int u = blockIdx.x >> 2; u < NB_ * 132; u += gridDim.x >> 2) lru_tile(P, l, u / 132, u % 132, g, smem, false);
  }
  int stage = 0;
  for (;;) {
    __syncthreads();
    if (TIDX == 0) *s_item = stage == 0 ? atomicAdd(&P.qctr[8 + qi * 8 + (blockIdx.x & 7)], 1) : atomicAdd(&P.qctr[qi], 1);
    __syncthreads();
    int it = *s_item;
    int kind = -1, b = 0, head = 0, row0 = 0, nk = 0;
    if (stage == 0) {
      if (it >= 256) { stage = 1; continue; }
      const int pair = (blockIdx.x & 7) + 8 * (it >> 6);
      b = pair >> 2; head = pair & 3; row0 = TC + b * SEQ + (it & 63) * 128; nk = KV; kind = 0;
    } else {
      if (it >= total) break;
      if (it < nC) { b = it >> 3; head = (it >> 1) & 3; row0 = b * CL + (it & 1) * 128; nk = CL; kind = 0; }
      else if (it < nC + nFA) { kind = 1; it -= nC; }
      else { kind = 2; it -= nC + nFA; }
    }
    if (kind == 0) attn_item(P, l, b, head, row0, nk, smem);
    else if (kind == 1) fftA_item(P, it, smem);
    else fftC_item(P, it, smem);
  }
}

DI void grid_barrier(unsigned* ctr, unsigned target) {
  asm volatile("s_waitcnt vmcnt(0)" ::: "memory");
  __syncthreads();
  if (threadIdx.x == 0) {
    __builtin_amdgcn_fence(__ATOMIC_RELEASE, "agent");
    asm volatile("s_waitcnt vmcnt(0)" ::: "memory");
    __hip_atomic_fetch_add(ctr, 1u, __ATOMIC_RELAXED, __HIP_MEMORY_SCOPE_AGENT);
    while (__hip_atomic_load(ctr, __ATOMIC_RELAXED, __HIP_MEMORY_SCOPE_AGENT) < target) __builtin_amdgcn_s_sleep(1);
    __builtin_amdgcn_fence(__ATOMIC_ACQUIRE, "agent");
    asm volatile("s_waitcnt vmcnt(0)" ::: "memory");
  }
  __syncthreads();
}
__global__ void __launch_bounds__(256, 1) fwd_megakernel(Params Pin) {
  Params P = Pin; bind_ws(P);
  __shared__ __attribute__((aligned(16))) char smem[147456 + 8192];
  __shared__ int tb[33];
  __shared__ int s_item;
  cg::grid_group grid = cg::this_grid();
  unsigned* bar = (unsigned*)(P.ws + O_bar); unsigned bk = 0;
#ifndef PH
#define PH 0xFFFF
#endif
#if PH & 1
  phase0(P, smem);
#endif
  grid.sync();
  for (int l = 0; l < 2; l++) {
#if PH & 2
    row1_phase(P, l == 0 ? -1 : 0, l, 0);
#endif
    grid_barrier(bar, (++bk) * gridDim.x);
#if PH & 4
    gemm_in_phase(P, l, smem);
#ifdef DUP_GEMM
    grid_barrier(bar, (++bk) * gridDim.x);
    gemm_in_phase(P, l, smem);
#endif
#endif
    grid_barrier(bar, (++bk) * gridDim.x);
#if PH & 8
    mix_phase(P, l, smem, &s_item, l);
#ifdef DUP_MIX
    grid_barrier(bar, (++bk) * gridDim.x);
    mix_phase(P, l, smem, &s_item, 2 + l);
#endif
#endif
    grid_barrier(bar, (++bk) * gridDim.x);
#if PH & 16
    if (blockIdx.x >= gridDim.x - 16) lru_carry_item(P, gridDim.x - 1 - blockIdx.x);
    for (int it = blockIdx.x; it < 1024; it += gridDim.x) fftB_item(P, it, smem);
#endif
    grid_barrier(bar, (++bk) * gridDim.x);
#if PH & 512
    {
      const int g = blockIdx.x & 3;
      for (int u = blockIdx.x >> 2; u < NB_ * 132; u += gridDim.x >> 2) lru_tile(P, l, u / 132, u % 132, g, smem, true);
    }
#endif
    grid_barrier(bar, (++bk) * gridDim.x);
#if PH & 32
    gemm_out_phase(P, l, smem);
#endif
    grid_barrier(bar, (++bk) * gridDim.x);
#if PH & 64
    row2_phase(P, l, l == 0 ? 0 : TC, smem);
#endif
    grid_barrier(bar, (++bk) * gridDim.x);
#if PH & 128
    moe_e1_phase(P, l, smem, tb);
#ifdef DUP_GEMM
    grid_barrier(bar, (++bk) * gridDim.x);
    moe_e1_phase(P, l, smem, tb);
#endif
#endif
    grid_barrier(bar, (++bk) * gridDim.x);
#if PH & 256
    moe_e2_phase(P, l, smem, tb);
#ifdef DUP_GEMM
    grid_barrier(bar, (++bk) * gridDim.x);
    moe_e2_phase(P, l, smem, tb);
#endif
#endif
    grid_barrier(bar, (++bk) * gridDim.x);
  }
#if PH & 2
  row1_phase(P, 1, -1, TC);
#endif
}

extern "C" void kernel_launch(void* const* d_in, const int* in_sizes, int n_in, void* d_out, int out_size, void* d_ws, size_t ws_size,
                              hipStream_t stream) {
  static int grid_blocks = 0;
  if (!grid_blocks) {
    int dev = 0, cus = 0, per_cu = 0;
    hipGetDevice(&dev);
    hipDeviceGetAttribute(&cus, hipDeviceAttributeMultiprocessorCount, dev);
    hipOccupancyMaxActiveBlocksPerMultiprocessor(&per_cu, fwd_megakernel, 256, 0);
    if (per_cu > 2) per_cu = 2;
    grid_blocks = cus * per_cu;
  }
  Params p{};
  const float** pin = (const float**)&p;
  for (int i = 0; i < 31; i++) pin[i] = (const float*)d_in[i];
  p.out = (float*)d_out;
  p.ws = (char*)d_ws;
  if (WS_NEED > ws_size) { fprintf(stderr, "workspace too small: need %zu have %zu\n", (size_t)WS_NEED, ws_size); return; }
  hipMemsetAsync((char*)d_ws + O_bar, 0, 256, stream);
  void* args[] = {&p};
  hipError_t e = hipLaunchCooperativeKernel((void*)fwd_megakernel, dim3(grid_blocks), dim3(256), args, 0, stream);
  if (e != hipSuccess) fprintf(stderr, "cooperative launch failed: %s (grid %d)\n", hipGetErrorString(e), grid_blocks);
}
```

```cpp
#include <hip/hip_runtime.h>
#include <hip/hip_cooperative_groups.h>
#include <cstdio>
namespace cg = cooperative_groups;

typedef _Float16 half_t;
typedef _Float16 h8 __attribute__((ext_vector_type(8)));
typedef _Float16 h4 __attribute__((ext_vector_type(4)));
typedef __fp16 fp16x2 __attribute__((ext_vector_type(2)));
typedef unsigned u4 __attribute__((ext_vector_type(4)));
typedef float f4 __attribute__((ext_vector_type(4)));
typedef float f16v __attribute__((ext_vector_type(16)));
#define DI __device__ __forceinline__
__device__ __forceinline__ int tid_opaque() { int t = threadIdx.x; asm volatile("" : "+v"(t)); return t; }
#define TIDX tid_opaque()

constexpr int D = 1024, NB_ = 8, SEQ = 8192, CL = 256;
constexpr int TC = NB_ * CL;
constexpr int TX = NB_ * SEQ;
constexpr int TA = TC + TX;
constexpr int KV = CL + SEQ;
constexpr int NIN = 2560;
constexpr int LCAP = 2 * TA;
constexpr float EPS = 1e-6f;

struct Params {
  const float *x, *c, *ctx, *c_ctx, *w_mod, *b_mod, *norm1_g, *norm2_g, *w_in, *q_norm_g, *k_norm_g, *lq1, *lk1, *lq2, *lk2,
      *subln_g, *conv_w, *conv_b, *gate_a_w, *gate_a_b, *gate_x_w, *gate_x_b, *lru_lambda, *w_out, *w_group, *b_group,
      *w_router, *b_router, *w1, *w3, *w2;
  float* out; char* ws;
  half_t *WtIn, *WtOut, *Wt1, *Wt3, *Wt2;
  float* mod; float2* rope; float2* tw; half_t *DA, *DB, *DC; float* consts; int* cnt; int* qctr; float* tokW; int* list;
  float* xcbuf; half_t* WrH;
  half_t *hx, *mix, *q, *kall, *vT, *QF, *gy, *rr; float2* lsum; float* lcar; half_t* GA; half_t *H, *yA;
};


constexpr size_t al256(size_t x) { return (x + 255) & ~(size_t)255; }
constexpr size_t O_WtIn = 0;
constexpr size_t O_WtOut = O_WtIn + al256((size_t)2 * NIN * 1024 * 2);
constexpr size_t O_Wt1 = O_WtOut + al256((size_t)2 * 1024 * 1024 * 2);
constexpr size_t O_Wt3 = O_Wt1 + al256((size_t)64 * 524288 * 2);
constexpr size_t O_Wt2 = O_Wt3 + al256((size_t)64 * 524288 * 2);
constexpr size_t O_mod = O_Wt2 + al256((size_t)64 * 524288 * 2);
constexpr size_t O_rope = O_mod + al256((size_t)2 * 9 * 6144 * 4);
constexpr size_t O_tw = O_rope + al256(128 * 16 * 8);
constexpr size_t O_DA = O_tw + al256(8192 * 8);
constexpr size_t O_DB = O_DA + al256(16384 * 2);
constexpr size_t O_DC = O_DB + al256(32768 * 2);
constexpr size_t O_consts = O_DC + al256(131072 * 2);
constexpr size_t O_cnt = O_consts + 256;
constexpr size_t O_qctr = O_cnt + 256;
constexpr size_t O_bar = O_qctr + 256;
constexpr size_t O_tokW = O_bar + 256;
constexpr size_t O_list = O_tokW + al256((size_t)2 * TA * 4);
constexpr size_t O_xcbuf = O_list + al256((size_t)32 * LCAP * 4);
constexpr size_t O_WrT = O_xcbuf + al256((size_t)TC * D * 4);
constexpr size_t O_hx = O_WrT + al256((size_t)2 * 2 * 48 * 1024 * 2);
constexpr size_t O_mix = O_hx + al256((size_t)TA * D * 2);
constexpr size_t O_regB = O_mix + al256((size_t)TA * D * 2);
constexpr size_t O_q = O_regB;
constexpr size_t O_kall = O_q + al256((size_t)TA * 512 * 2);
constexpr size_t O_vT = O_kall + al256((size_t)NB_ * KV * 512 * 2);
constexpr size_t O_QF = O_vT + al256((size_t)NB_ * 4 * 128 * KV * 2);
constexpr size_t O_gy = O_QF + al256((size_t)TA * 512 * 2);
constexpr size_t O_rr = O_gy + al256((size_t)TA * 256 * 2);
constexpr size_t O_lsum = O_rr + al256((size_t)TA * 256 * 2);
constexpr size_t O_lcar = O_lsum + al256((size_t)16 * 132 * 256 * 8);
constexpr size_t O_GA = O_lcar + al256((size_t)16 * 132 * 256 * 4);
constexpr size_t O_mixer_end = O_GA + al256((size_t)NB_ * 64 * 256 * 256 * 2);
constexpr size_t O_H = O_regB;
constexpr size_t O_yA = O_H + al256((size_t)(2 * TA + 32 * 256) * 512 * 2);
constexpr size_t O_moe_end = O_yA + al256((size_t)2 * TA * D * 2);
constexpr size_t WS_NEED = O_mixer_end > O_moe_end ? O_mixer_end : O_moe_end;
DI void bind_ws(Params& P) {
  char* w = P.ws;
  P.WtIn = (half_t*)(w + O_WtIn); P.WtOut = (half_t*)(w + O_WtOut); P.Wt1 = (half_t*)(w + O_Wt1); P.Wt3 = (half_t*)(w + O_Wt3); P.Wt2 = (half_t*)(w + O_Wt2);
  P.mod = (float*)(w + O_mod); P.rope = (float2*)(w + O_rope); P.tw = (float2*)(w + O_tw); P.DA = (half_t*)(w + O_DA); P.DB = (half_t*)(w + O_DB); P.DC = (half_t*)(w + O_DC);
  P.consts = (float*)(w + O_consts); P.cnt = (int*)(w + O_cnt); P.qctr = (int*)(w + O_qctr); P.tokW = (float*)(w + O_tokW); P.list = (int*)(w + O_list);
  P.xcbuf = (float*)(w + O_xcbuf); P.WrH = (half_t*)(w + O_WrT); P.hx = (half_t*)(w + O_hx); P.mix = (half_t*)(w + O_mix);
  P.q = (half_t*)(w + O_q); P.kall = (half_t*)(w + O_kall); P.vT = (half_t*)(w + O_vT); P.QF = (half_t*)(w + O_QF); P.gy = (half_t*)(w + O_gy); P.rr = (half_t*)(w + O_rr);
  P.lsum = (float2*)(w + O_lsum); P.lcar = (float*)(w + O_lcar); P.GA = (half_t*)(w + O_GA); P.H = (half_t*)(w + O_H); P.yA = (half_t*)(w + O_yA);
}
DI float shx(float v, int o) { int ln = TIDX & 63; return __builtin_bit_cast(float, __builtin_amdgcn_ds_bpermute((ln ^ o) << 2, __builtin_bit_cast(int, v))); }
DI float shi(float v, int idx) { return __builtin_bit_cast(float, __builtin_amdgcn_ds_bpermute(idx << 2, __builtin_bit_cast(int, v))); }
DI float wave_sum(float v) {
#pragma unroll
  for (int o = 32; o; o >>= 1) v += shx(v, o);
  return v;
}
DI void glds16(const void* g, void* l) {
  __builtin_amdgcn_global_load_lds((const unsigned*)g, (unsigned*)l, 16, 0, 0);
}
DI void wait_vm0() { asm volatile("s_waitcnt vmcnt(0)" ::: "memory"); }
DI f4 mfma16(h8 a, h8 b, f4 c) { return __builtin_amdgcn_mfma_f32_16x16x32_f16(a, b, c, 0, 0, 0); }
DI f16v mfma32(h8 a, h8 b, f16v c) { return __builtin_amdgcn_mfma_f32_32x32x16_f16(a, b, c, 0, 0, 0); }
DI unsigned pk2(float a, float b) { fp16x2 r = __builtin_amdgcn_cvt_pkrtz(a, b); return __builtin_bit_cast(unsigned, r); }
DI float sigmoidf_(float x) { return 1.f / (1.f + __expf(-x)); }
DI float gelu_tanh(float x) {
  float u = 0.7978845608028654f * (x + 0.044715f * x * x * x);
  float e = __expf(2.f * u);
  float t = 1.f - 2.f / (e + 1.f);
  return 0.5f * x * (1.f + t);
}
DI int row_mod(int r) { return r < TC ? 8 : ((r - TC) >> 13); }

DI void transpose_tile4(const float* src, int lds_, half_t* dst, int ldd, float* tile) {
  const int tid = TIDX;
  {
    const int k0 = tid >> 6, c4 = tid & 63;
    const float* sp = src + (size_t)k0 * lds_ + c4 * 4;
    float* tp = tile + (c4 >> 4) * 4352 + k0 * 68 + (c4 & 15) * 4;
#pragma unroll
    for (int i = 0; i < 16; i++) *(float4*)(tp + i * 4 * 68) = *(const float4*)(sp + (size_t)i * 4 * lds_);
  }
  __syncthreads();
#pragma unroll
  for (int i = 0; i < 8; i++) {
    int idx = i * 256 + tid, j = idx >> 9, r = idx & 511, kc = r >> 6, n = r & 63;
    const float* t = tile + j * 4352 + kc * 8 * 68 + n;
    h8 o;
#pragma unroll
    for (int u = 0; u < 8; u++) o[u] = (half_t)t[u * 68];
    *(h8*)(dst + (size_t)(j * 64 + n) * ldd + kc * 8) = o;
  }
  __syncthreads();
}

DI void phase0(const Params& P, char* smem) {
  float* tile = (float*)smem;
  const int tid = TIDX;
  constexpr int NT = 6528, NF = 128, NM = 192, NX = 6;
  for (int t = blockIdx.x; t < NT + NF + NM + NX; t += gridDim.x) {
    if (t < NT) {
      const float* src; half_t* dst; int lds_, ldd;
      if (t < 256) {
        int l = t / 128, r = t % 128, kt = r / 8, nt = (r % 8) * 4;
        src = P.w_in + (size_t)l * 1024 * 2304 + (size_t)kt * 64 * 2304 + 256 + nt * 64; lds_ = 2304;
        dst = P.WtIn + (size_t)l * NIN * 1024 + (size_t)(512 + nt * 64) * 1024 + kt * 64; ldd = 1024;
      } else if (t < 384) {
        int u = t - 256, l = u / 64, r = u % 64, kt = r / 4, nt = (r % 4) * 4;
        src = P.w_out + (size_t)l * 1048576 + (size_t)kt * 64 * 1024 + nt * 64; lds_ = 1024;
        dst = P.WtOut + (size_t)l * 1048576 + (size_t)nt * 64 * 1024 + kt * 64; ldd = 1024;
      } else if (t < 384 + 4096) {
        int u = t - 384; const float* w = P.w1; half_t* o = P.Wt1;
        if (u >= 2048) { u -= 2048; w = P.w3; o = P.Wt3; }
        int le = u / 32, r = u % 32, kt = r / 2, nt = (r % 2) * 4;
        src = w + (size_t)le * 524288 + (size_t)kt * 64 * 512 + nt * 64; lds_ = 512;
        dst = o + (size_t)le * 524288 + (size_t)nt * 64 * 1024 + kt * 64; ldd = 1024;
      } else {
        int u = t - 384 - 4096, le = u / 32, r = u % 32, kt = r / 4, nt = (r % 4) * 4;
        src = P.w2 + (size_t)le * 524288 + (size_t)kt * 64 * 1024 + nt * 64; lds_ = 1024;
        dst = P.Wt2 + (size_t)le * 524288 + (size_t)nt * 64 * 512 + kt * 64; ldd = 512;
      }
      transpose_tile4(src, lds_, dst, ldd, tile);
    } else if (t < NT + NF) {
      int f = t - NT, l = f / 64, r = f % 64, kt = r / 4, g = r % 4;
      float* cst = tile + 64 * 65; float* snt = cst + 64;
      const float* src = P.w_in + (size_t)l * 1024 * 2304 + (size_t)kt * 64 * 2304 + g * 64;
      { int n = tid & 63, kq = tid >> 6;
        for (int i = 0; i < 16; i++) { int k = i * 4 + kq; tile[k * 65 + n] = src[(size_t)k * 2304 + n]; } }
      if (tid < 64) { float s, c; sincospif((float)tid / 32.f, &s, &c); cst[tid] = c; snt[tid] = s; }
      __syncthreads();
      int k = tid & 63, jq = tid >> 6;
      half_t* o = P.WtIn + (size_t)l * NIN * 1024 + kt * 64 + k;
      for (int jj = 0; jj < 16; jj++) {
        int j = jq * 16 + jj; float ac = 0.f, as = 0.f;
        for (int c = 0; c < 64; c++) { float v = tile[k * 65 + c]; int idx = (c * j) & 63; ac += v * cst[idx]; as += v * snt[idx]; }
        o[(size_t)(g * 64 + j) * 1024] = (half_t)(ac * 0.125f);
        o[(size_t)(256 + g * 64 + j) * 1024] = (half_t)(-as * 0.125f);
      }
      __syncthreads();
    } else if (t < NT + NF + NM) {
      int mi = t - NT - NF, l = mi / 96, col0 = (mi % 96) * 64;
      float* scond = tile; float* red = tile + 9216;
      for (int idx = tid; idx < 9216; idx += 256) {
        int n = idx >> 10, k = idx & 1023; float v = n < 8 ? P.c[n * 1024 + k] : P.c_ctx[k];
        scond[idx] = v / (1.f + expf(-v));
      }
      __syncthreads();
      int col = tid & 63, kq = tid >> 6; float acc[9];
#pragma unroll
      for (int n = 0; n < 9; n++) acc[n] = 0.f;
      const float* w = P.w_mod + ((size_t)l * 1024 + kq * 256) * 6144 + col0 + col;
#pragma unroll 16
      for (int k = 0; k < 256; k++) {
        float wv = w[(size_t)k * 6144];
#pragma unroll
        for (int n = 0; n < 9; n++) acc[n] += scond[n * 1024 + kq * 256 + k] * wv;
      }
#pragma unroll
      for (int n = 0; n < 9; n++) red[(kq * 9 + n) * 64 + col] = acc[n];
      __syncthreads();
      for (int idx = tid; idx < 576; idx += 256) {
        int n = idx / 64, cc = idx % 64;
        float s = red[(0 * 9 + n) * 64 + cc] + red[(1 * 9 + n) * 64 + cc] + red[(2 * 9 + n) * 64 + cc] + red[(3 * 9 + n) * 64 + cc];
        P.mod[(size_t)(l * 9 + n) * 6144 + col0 + cc] = s + P.b_mod[l * 6144 + col0 + cc];
      }
      __syncthreads();
    } else {
      int m = t - NT - NF - NM;
      if (m == 0) {
        for (int idx = tid; idx < 128 * 16; idx += 256) {
          int pos = idx >> 4, i = idx & 15; float f = powf(10000.f, -(float)i / 16.f); float ang = (float)pos * f;
          float s, c; sincosf(ang, &s, &c); P.rope[idx] = make_float2(c, s);
        }
      } else if (m == 1) {
        for (int j = tid; j < 8192; j += 256) { float s, c; sincospif((float)j / 4096.f, &s, &c); P.tw[j] = make_float2(c, s); }
      } else if (m == 2) {
        for (int idx = tid; idx < 16384; idx += 256) {
          int mm = idx >> 7, k = idx & 127, part = mm >> 6, f1 = mm & 63, pp = k >> 6, a = k & 63;
          float s, c; sincospif((float)((a * f1) & 63) / 32.f, &s, &c);
          float v = part == 0 ? (pp == 0 ? c : s) : (pp == 0 ? -s : c);
          P.DA[idx] = (half_t)(v * 0.125f);
        }
      } else if (m == 3) {
        for (int idx = tid; idx < 32768; idx += 256) {
          int mm = idx >> 8, k = idx & 255, part = k >> 7, bb = k & 127;
          float s, c; sincospif((float)((bb * mm) & 127) / 64.f, &s, &c);
          P.DB[idx] = (half_t)((part == 0 ? c : s) * 0.08838834764831845f);
        }
      } else if (m == 4) {
        for (int idx = tid; idx < 131072; idx += 256) {
          int mm = idx >> 9, k = idx & 511, part = k >> 8, tt = k & 255;
          float s, c; sincospif((float)((tt * mm) & 255) / 128.f, &s, &c);
          P.DC[idx] = (half_t)((part == 0 ? c : s) * 0.0625f);
        }
      } else {
        for (int idx = tid; idx < 2 * 48 * 1024; idx += 256) {
          int l = idx / 49152, r = idx % 49152, col = r >> 10, k = r & 1023;
          float w = col < 4 ? P.w_group[((size_t)l * 1024 + k) * 4 + col] : (col < 36 ? P.w_router[((size_t)l * 1024 + k) * 32 + col - 4] : 0.f);
          half_t hi = (half_t)w, lo = (half_t)(w - (float)hi);
          P.WrH[(size_t)(l * 2) * 49152 + r] = hi; P.WrH[(size_t)(l * 2 + 1) * 49152 + r] = lo;
        }
        if (tid < 2) {
          int l = tid; float s1 = 0.f, s2 = 0.f, mq = 0.f, mk = 0.f;
          for (int i = 0; i < 64; i++) {
            s1 += P.lq1[l * 64 + i] * P.lk1[l * 64 + i]; s2 += P.lq2[l * 64 + i] * P.lk2[l * 64 + i];
            mq = fmaxf(mq, fabsf(P.q_norm_g[l * 64 + i])); mk = fmaxf(mk, fabsf(P.k_norm_g[l * 64 + i]));
          }
          float lam_init = 0.8f - 0.6f * expf(-0.3f * (float)l);
          P.consts[l * 4 + 0] = expf(s1) - expf(s2) + lam_init;
          P.consts[l * 4 + 1] = 8.f * mq * mk * 1.4426950408889634f * 1.002f - 15.f;
          P.consts[l * 4 + 2] = lam_init;
        }
        if (tid < 64) P.cnt[tid] = 0;
        if (tid < 64) P.qctr[tid] = 0;
      }
    }
  }
}

DI void row1_phase(const Params& P, int combine_l, int norm_l, int r_begin) {
  const int lane = TIDX & 63, gw = blockIdx.x * 4 + (TIDX >> 6), nw = gridDim.x * 4;
  auto load_row = [&](int r, float4 (&xv)[4], h4 (&ya)[4], h4 (&yb)[4]) {
    if (combine_l < 0) {
      const float* src = r < TC ? P.ctx + (size_t)r * D : P.x + (size_t)(r - TC) * D;
#pragma unroll
      for (int i = 0; i < 4; i++) xv[i] = *(const float4*)(src + i * 256 + lane * 4);
    } else {
      const float* xm = r < TC ? P.xcbuf + (size_t)r * D : P.out + (size_t)(r - TC) * D;
      const half_t* y0 = P.yA + (size_t)(2 * r) * D; const half_t* y1 = y0 + D;
#pragma unroll
      for (int i = 0; i < 4; i++) { int c = i * 256 + lane * 4; xv[i] = *(const float4*)(xm + c); ya[i] = *(const h4*)(y0 + c); yb[i] = *(const h4*)(y1 + c); }
    }
  };
  auto process = [&](int r, float4 (&xv)[4], h4 (&ya)[4], h4 (&yb)[4]) {
    const int n = row_mod(r);
    if (combine_l >= 0) {
      float* xm = r < TC ? P.xcbuf + (size_t)r * D : P.out + (size_t)(r - TC) * D;
      const float* g2 = P.mod + (size_t)(combine_l * 9 + n) * 6144 + 5 * 1024;
#pragma unroll
      for (int i = 0; i < 4; i++) {
        int c = i * 256 + lane * 4;
        float4 g = *(const float4*)(g2 + c); float4 t = xv[i];
        t.x += g.x * ((float)ya[i][0] + (float)yb[i][0]); t.y += g.y * ((float)ya[i][1] + (float)yb[i][1]);
        t.z += g.z * ((float)ya[i][2] + (float)yb[i][2]); t.w += g.w * ((float)ya[i][3] + (float)yb[i][3]);
        *(float4*)(xm + c) = t; xv[i] = t;
      }
    }
    if (norm_l >= 0) {
      float ss = 0.f;
#pragma unroll
      for (int i = 0; i < 4; i++) ss += xv[i].x * xv[i].x + xv[i].y * xv[i].y + xv[i].z * xv[i].z + xv[i].w * xv[i].w;
      ss = wave_sum(ss);
      const float rstd = rsqrtf(ss * (1.f / 1024.f) + EPS);
      const float* g = P.norm1_g + norm_l * 1024;
      const float* sh = P.mod + (size_t)(norm_l * 9 + n) * 6144; const float* sc = sh + 1024;
#pragma unroll
      for (int i = 0; i < 4; i++) {
        int c = i * 256 + lane * 4;
        float4 gg = *(const float4*)(g + c), s1 = *(const float4*)(sc + c), s0 = *(const float4*)(sh + c);
        h4 o;
        o[0] = (half_t)(xv[i].x * rstd * gg.x * (1.f + s1.x) + s0.x); o[1] = (half_t)(xv[i].y * rstd * gg.y * (1.f + s1.y) + s0.y);
        o[2] = (half_t)(xv[i].z * rstd * gg.z * (1.f + s1.z) + s0.z); o[3] = (half_t)(xv[i].w * rstd * gg.w * (1.f + s1.w) + s0.w);
        *(h4*)(P.hx + (size_t)r * D + c) = o;
      }
    }
  };
#pragma unroll 1
  for (int r = r_begin + gw; r < TA; r += 4 * nw) {
    float4 x0[4], x1[4], x2[4], x3[4]; h4 a0[4], b0[4], a1[4], b1[4], a2[4], b2[4], a3[4], b3[4];
    const int r1 = r + nw, r2 = r + 2 * nw, r3 = r + 3 * nw;
    load_row(r, x0, a0, b0);
    if (r1 < TA) load_row(r1, x1, a1, b1);
    if (r2 < TA) load_row(r2, x2, a2, b2);
    if (r3 < TA) load_row(r3, x3, a3, b3);
    process(r, x0, a0, b0);
    if (r1 < TA) process(r1, x1, a1, b1);
    if (r2 < TA) process(r2, x2, a2, b2);
    if (r3 < TA) process(r3, x3, a3, b3);
  }
}

DI void row2_phase(const Params& P, int l, int r_begin, char* smem) {
  const int tid = TIDX, lane = tid & 63, wave = tid >> 6, fr = lane & 15, fq = lane >> 4;
  float* lg = (float*)smem + wave * 16 * 48;
  const half_t* Whi = P.WrH + (size_t)(l * 2) * 49152; const half_t* Wlo = Whi + 49152;
  const int ngroups = (TA - r_begin) >> 4, gw = blockIdx.x * 4 + wave, nw = gridDim.x * 4;
  const float* gam = P.norm2_g + l * 1024;
#pragma unroll 1
  for (int grp = gw; grp < ngroups; grp += nw) {
    const int r0 = r_begin + grp * 16, row = r0 + fr, n = row_mod(r0);
    const float* xm = (row < TC ? P.xcbuf + (size_t)row * D : P.out + (size_t)(row - TC) * D) + fq * 8;
    float ss = 0.f;
#pragma unroll 16
    for (int kk = 0; kk < 32; kk++) {
      const float4 a = *(const float4*)(xm + kk * 32), b = *(const float4*)(xm + kk * 32 + 4);
      ss += a.x * a.x + a.y * a.y + a.z * a.z + a.w * a.w + b.x * b.x + b.y * b.y + b.z * b.z + b.w * b.w;
    }
    ss += shx(ss, 16); ss += shx(ss, 32);
    const float rstd = rsqrtf(ss * (1.f / 1024.f) + EPS);
    const float* sh = P.mod + (size_t)(l * 9 + n) * 6144 + 3 * 1024 + fq * 8; const float* sc = sh + 1024;
    f4 acc[3];
#pragma unroll
    for (int i = 0; i < 3; i++) acc[i] = (f4){0.f, 0.f, 0.f, 0.f};
    half_t* hxo = P.hx + (size_t)row * D + fq * 8;
#pragma unroll 4
    for (int kk = 0; kk < 32; kk++) {
      const int k0 = kk * 32;
      float x[8], g[8], s1[8], s0[8];
      *(float4*)&x[0] = *(const float4*)(xm + k0); *(float4*)&x[4] = *(const float4*)(xm + k0 + 4);
      *(float4*)&g[0] = *(const float4*)(gam + fq * 8 + k0); *(float4*)&g[4] = *(const float4*)(gam + fq * 8 + k0 + 4);
      *(float4*)&s1[0] = *(const float4*)(sc + k0); *(float4*)&s1[4] = *(const float4*)(sc + k0 + 4);
      *(float4*)&s0[0] = *(const float4*)(sh + k0); *(float4*)&s0[4] = *(const float4*)(sh + k0 + 4);
      h8 hi, lo;
#pragma unroll
      for (int i = 0; i < 8; i++) {
        float v = x[i] * rstd * g[i] * (1.f + s1[i]) + s0[i];
        hi[i] = (half_t)v; lo[i] = (half_t)(v - (float)hi[i]);
      }
      *(h8*)(hxo + k0) = hi;
#pragma unroll
      for (int n3 = 0; n3 < 3; n3++) {
        h8 bh = *(const h8*)(Whi + (size_t)(n3 * 16 + fr) * 1024 + k0 + fq * 8);
        h8 bl = *(const h8*)(Wlo + (size_t)(n3 * 16 + fr) * 1024 + k0 + fq * 8);
        acc[n3] = mfma16(hi, bh, acc[n3]); acc[n3] = mfma16(lo, bh, acc[n3]); acc[n3] = mfma16(hi, bl, acc[n3]);
      }
    }
    __builtin_amdgcn_wave_barrier();
#pragma unroll
    for (int n3 = 0; n3 < 3; n3++)
#pragma unroll
      for (int j = 0; j < 4; j++) lg[(fq * 4 + j) * 48 + n3 * 16 + fr] = acc[n3][j];
    __builtin_amdgcn_wave_barrier();
    if (lane < 16) {
      const int r = r0 + lane;
      const float* L = lg + lane * 48;
      float gl[4]; int gi = 0;
#pragma unroll
      for (int j = 0; j < 4; j++) gl[j] = L[j] + P.b_group[l * 4 + j];
      float gm = gl[0];
#pragma unroll
      for (int j = 1; j < 4; j++) if (gl[j] > gm) { gm = gl[j]; gi = j; }
      float gs = 0.f;
#pragma unroll
      for (int j = 0; j < 4; j++) gs += expf(gl[j] - gm);
      const float pg = 1.f / gs;
      float el[8];
#pragma unroll
      for (int j = 0; j < 8; j++) el[j] = L[4 + gi * 8 + j] + P.b_router[l * 32 + gi * 8 + j];
      int i0 = 0; float v0 = el[0];
#pragma unroll
      for (int j = 1; j < 8; j++) if (el[j] > v0) { v0 = el[j]; i0 = j; }
      int i1 = -1; float v1 = -3.0e38f;
#pragma unroll
      for (int j = 0; j < 8; j++) if (j != i0 && el[j] > v1) { v1 = el[j]; i1 = j; }
      const float ex = expf(v1 - v0);
      const float w0 = pg / (1.f + ex), w1 = pg * ex / (1.f + ex);
      const int e0 = gi * 8 + i0, e1 = gi * 8 + i1;
      int p0 = atomicAdd(&P.cnt[l * 32 + e0], 1); P.list[(size_t)e0 * LCAP + p0] = 2 * r;
      int p1 = atomicAdd(&P.cnt[l * 32 + e1], 1); P.list[(size_t)e1 * LCAP + p1] = 2 * r + 1;
      P.tokW[2 * r] = w0; P.tokW[2 * r + 1] = w1;
    }
    __builtin_amdgcn_wave_barrier();
  }
}

DI h8 lds128(unsigned a) { h8 r; asm volatile("ds_read_b128 %0, %1" : "=v"(r) : "v"(a)); return r; }
DI void tie(h8& x) { asm volatile("" : "+v"(x)); }
DI unsigned lds_addr(const void* p) { return (unsigned)(size_t)p; }
#define WAIT_LGKM(n) asm volatile("s_waitcnt lgkmcnt(" #n ")" ::: "memory")
DI void raw_barrier() { asm volatile("" ::: "memory"); __builtin_amdgcn_s_barrier(); asm volatile("" ::: "memory"); }
DI void slot_rc(int i, int& row, int& coff) { int s = i * 256 + TIDX; row = s >> 3; coff = ((s & 7) ^ ((row >> 1) & 7)) * 8; }

template <class AF, class BF>
DI void gemm_prologue(AF aptr, BF bptr, int nk, char* smem) {
  const int tid = TIDX;
#pragma unroll
  for (int st = 0; st < 2; st++) {
    if (st < nk) {
      char* d = smem + st * 49152 + tid * 16;
#pragma unroll
      for (int i = 0; i < 8; i++) glds16(aptr(i) + st * 64, d + i * 4096);
#pragma unroll
      for (int i = 0; i < 4; i++) glds16(bptr(i) + st * 64, d + 32768 + i * 4096);
    }
  }
}
template <bool PRE = false, class AF, class BF>
DI void gemm256(AF aptr, BF bptr, int nk, char* smem, f4 (&acc)[8][4]) {
  const int tid = TIDX, lane = tid & 63, wave = tid >> 6, fr = lane & 15, fq = lane >> 4, wr = wave >> 1, wc = wave & 1;
#pragma unroll
  for (int m = 0; m < 8; m++)
#pragma unroll
    for (int n = 0; n < 4; n++) acc[m][n] = (f4){0.f, 0.f, 0.f, 0.f};
  auto issue = [&](int kt, int st) {
    char* d = smem + st * 49152 + tid * 16;
#pragma unroll
    for (int i = 0; i < 8; i++) glds16(aptr(i) + kt * 64, d + i * 4096);
#pragma unroll
    for (int i = 0; i < 4; i++) glds16(bptr(i) + kt * 64, d + 32768 + i * 4096);
  };
  const unsigned sw = (unsigned)((fq ^ (fr >> 1)) << 4);
  const unsigned offA = (wr * 128 + fr) * 128 + sw, offB = 32768 + (wc * 64 + fr) * 128 + sw;
  const unsigned sbase = lds_addr(smem);
  if (!PRE) { issue(0, 0); if (nk > 1) issue(1, 1); }
  int st = 0;
#pragma unroll 1
  for (int kt = 0; kt < nk; kt++) {
    if (kt + 1 < nk) asm volatile("s_waitcnt vmcnt(12)" ::: "memory"); else wait_vm0();
    raw_barrier();
    if (kt + 2 < nk) issue(kt + 2, st == 0 ? 2 : st - 1);
    const unsigned base = sbase + st * 49152;
    st = st == 2 ? 0 : st + 1;
    h8 a0[8], b0[4], a1[8], b1[4];
#pragma unroll
    for (int m = 0; m < 8; m++) a0[m] = lds128(base + offA + m * 2048);
#pragma unroll
    for (int n = 0; n < 4; n++) b0[n] = lds128(base + offB + n * 2048);
#pragma unroll
    for (int m = 0; m < 8; m++) a1[m] = lds128(base + (offA ^ 64) + m * 2048);
#pragma unroll
    for (int n = 0; n < 4; n++) b1[n] = lds128(base + (offB ^ 64) + n * 2048);
    WAIT_LGKM(12);
#pragma unroll
    for (int m = 0; m < 8; m++) tie(a0[m]);
#pragma unroll
    for (int n = 0; n < 4; n++) tie(b0[n]);
#pragma unroll
    for (int m = 0; m < 8; m++)
#pragma unroll
      for (int n = 0; n < 4; n++) acc[m][n] = mfma16(a0[m], b0[n], acc[m][n]);
    WAIT_LGKM(0);
#pragma unroll
    for (int m = 0; m < 8; m++) tie(a1[m]);
#pragma unroll
    for (int n = 0; n < 4; n++) tie(b1[n]);
#pragma unroll
    for (int m = 0; m < 8; m++)
#pragma unroll
      for (int n = 0; n < 4; n++) acc[m][n] = mfma16(a1[m], b1[n], acc[m][n]);
  }
  raw_barrier();
}
DI bool xcd_tile(int it, int MT, int NT, int& mt, int& nt) {
  const int x = blockIdx.x & 7, j = blockIdx.x >> 3;
  const int nsn = NT >> 2, nsm = (MT + 7) >> 3;
  const int s = x + 8 * it;
  if (s >= nsm * nsn) return false;
  const int sm = s / nsn, sn = s % nsn;
  mt = sm * 8 + (j >> 2); nt = sn * 4 + (j & 3);
  return true;
}
DI bool next_tile(int& it, int MT, int NT, int& mt, int& nt) {
  for (;; it++) {
    if (!xcd_tile(it, MT, NT, mt, nt)) return false;
    if (mt < MT) return true;
  }
}
DI int slot_col() { int t = TIDX; return ((t & 7) ^ ((t >> 4) & 7)) * 8; }

DI float dpp_row_sum(float v) {
  v += __builtin_bit_cast(float, __builtin_amdgcn_update_dpp(0, __builtin_bit_cast(int, v), 0x128, 0xf, 0xf, false));
  v += __builtin_bit_cast(float, __builtin_amdgcn_update_dpp(0, __builtin_bit_cast(int, v), 0x124, 0xf, 0xf, false));
  v += __builtin_bit_cast(float, __builtin_amdgcn_update_dpp(0, __builtin_bit_cast(int, v), 0x122, 0xf, 0xf, false));
  v += __builtin_bit_cast(float, __builtin_amdgcn_update_dpp(0, __builtin_bit_cast(int, v), 0x121, 0xf, 0xf, false));
  return v;
}
DI void stage_put(char* stg, int ml, int n, int j, int fr, int fq, float v) { *(half_t*)(stg + (ml * 16 + fq * 4 + j) * 144 + (n * 16 + fr) * 2) = (half_t)v; }
template <class RP, class SC>
DI void stage_flush(char* stg, int h, RP rowptr, SC rowscale) {
  const int lane = TIDX & 63;
  __builtin_amdgcn_wave_barrier();
#pragma unroll
  for (int i = 0; i < 8; i++) {
    const int c = i * 64 + lane, row = c >> 3, c16 = c & 7;
    h8 v = *(const h8*)(stg + row * 144 + c16 * 16);
    half_t* d = rowptr(h * 64 + row);
    if (d) { rowscale(h * 64 + row, v); *(h8*)(d + c16 * 8) = v; }
  }
  __builtin_amdgcn_wave_barrier();
}
template <class VF, class RP, class SC>
DI void wave_store_tile(VF val, char* stg, RP rowptr, SC rowscale) {
  const int lane = TIDX & 63, fr = lane & 15, fq = lane >> 4;
#pragma unroll
  for (int h = 0; h < 2; h++) {
#pragma unroll
    for (int ml = 0; ml < 4; ml++)
#pragma unroll
      for (int n = 0; n < 4; n++)
#pragma unroll
        for (int j = 0; j < 4; j++) stage_put(stg, ml, n, j, fr, fq, val(h * 4 + ml, n, j));
    stage_flush(stg, h, rowptr, rowscale);
  }
}
DI void gemm_in_phase(const Params& P, int l, char* smem) {
  const int tid = TIDX;
  const half_t* Wt = P.WtIn + (size_t)l * NIN * 1024;
  const int sc = slot_col(), srow = tid >> 3;
  {
    float2* rcl = (float2*)(smem + 147456);
    for (int i = tid; i < 1024; i += 256) rcl[i] = P.rope[i];
    __syncthreads();
  }
  int it = 0, mt, nt;
  bool have = next_tile(it, 264, 20, mt, nt);
  const half_t* a0 = nullptr; const half_t* b0 = nullptr;
  if (have) {
    asm volatile("" : "+s"(mt), "+s"(nt));
    a0 = P.hx + (size_t)(mt * 256 + srow) * D + sc; b0 = Wt + (size_t)(nt * 128 + srow) * D + sc;
    gemm_prologue([&](int i) { return a0 + (size_t)i * 32 * D; }, [&](int i) { return b0 + (size_t)i * 32 * D; }, 16, smem);
  }
#pragma unroll 1
  while (have) {
    f4 acc[8][4];
    gemm256<true>([&](int i) { return a0 + (size_t)i * 32 * D; }, [&](int i) { return b0 + (size_t)i * 32 * D; }, 16, smem, acc);
    const int tid2 = TIDX, lane = tid2 & 63, wave = tid2 >> 6, fr = lane & 15, fq = lane >> 4, wr = wave >> 1, wc = wave & 1;
    const int r0 = mt * 256 + wr * 128;
    const bool isctx = r0 < TC;
    int b, pos0;
    if (isctx) { b = r0 >> 8; pos0 = r0 & 255; } else { b = (r0 - TC) >> 13; pos0 = 256 + ((r0 - TC) & 8191); }
    const bool isqk = nt >= 4 && nt < 12;
    float gg[4] = {0.f, 0.f, 0.f, 0.f}; float2 rr2[2] = {make_float2(1.f, 0.f), make_float2(1.f, 0.f)};
    if (isqk) {
      const float* gvec = (nt < 8 ? P.q_norm_g : P.k_norm_g) + l * 64;
      const float qs = nt < 8 ? 0.125f * 1.4426950408889634f : 1.f;
#pragma unroll
      for (int n = 0; n < 4; n++) gg[n] = gvec[n * 16 + fr] * qs;
      if (!isctx) { const int tp0 = pos0 - 256; rr2[0] = P.rope[(tp0 >> 6) * 16 + fr]; rr2[1] = P.rope[((tp0 >> 6) + 1) * 16 + fr]; }
    }
#pragma unroll
    for (int n = 0; n < 4; n++) asm volatile("" : "+v"(gg[n]));
    asm volatile("" : "+v"(rr2[0].x), "+v"(rr2[0].y), "+v"(rr2[1].x), "+v"(rr2[1].y));
    int it2 = it + 1, mt2, nt2;
    const bool have2 = next_tile(it2, 264, 20, mt2, nt2);
    const half_t* a1 = a0; const half_t* b1 = b0;
    if (have2) {
      asm volatile("" : "+s"(mt2), "+s"(nt2));
      a1 = P.hx + (size_t)(mt2 * 256 + srow) * D + sc; b1 = Wt + (size_t)(nt2 * 128 + srow) * D + sc;
      gemm_prologue([&](int i) { return a1 + (size_t)i * 32 * D; }, [&](int i) { return b1 + (size_t)i * 32 * D; }, 16, smem);
    }
    char* stg = smem + 98304 + wave * 12288;
    auto noscale = [](int, h8&) {};
    if (nt < 4 || nt >= 16) {
      half_t* dst; int ld, c0; bool gel = false;
      if (nt < 4) { dst = P.QF; ld = 512; c0 = nt * 128; }
      else if (nt < 18) { dst = P.gy; ld = 256; c0 = (nt - 16) * 128; gel = true; }
      else { dst = P.rr; ld = 256; c0 = (nt - 18) * 128; }
      half_t* base = dst + (size_t)r0 * ld + c0 + wc * 64;
      if (gel) wave_store_tile([&](int m, int n, int j) { return gelu_tanh(acc[m][n][j]); }, stg, [&](int r) { return base + (size_t)r * ld; }, noscale);
      else wave_store_tile([&](int m, int n, int j) { return acc[m][n][j]; }, stg, [&](int r) { return base + (size_t)r * ld; }, noscale);
    } else if (nt < 12) {
      const bool isq = nt < 8; const int head = isq ? nt - 4 : nt - 8;
      const float2* rcl = (const float2*)(smem + 147456);
      half_t* base = (isq ? P.q + (size_t)r0 * 512 : P.kall + ((size_t)b * KV + pos0) * 512) + head * 128 + wc * 64;
#pragma unroll
      for (int mh = 0; mh < 2; mh++) {
#pragma unroll
        for (int mm = 0; mm < 4; mm++) {
          const int m = mh * 4 + mm;
#pragma unroll
          for (int j = 0; j < 4; j++) {
            float ss = 0.f;
#pragma unroll
            for (int n = 0; n < 4; n++) ss += acc[m][n][j] * acc[m][n][j];
            ss = dpp_row_sum(ss);
            const float rstd = rsqrtf(ss * (1.f / 64.f) + EPS);
            float o[4];
#pragma unroll
            for (int n = 0; n < 4; n++) o[n] = acc[m][n][j] * rstd * gg[n];
            if (!isctx) {
              const float2 cr = rr2[mh], cc = rcl[(mm * 16 + fq * 4 + j) * 16 + fr];
              float a0 = o[0] * cr.x - o[1] * cr.y, a1 = o[1] * cr.x + o[0] * cr.y;
              float a2 = o[2] * cc.x - o[3] * cc.y, a3 = o[3] * cc.x + o[2] * cc.y;
              o[0] = a0; o[1] = a1; o[2] = a2; o[3] = a3;
            }
#pragma unroll
            for (int n = 0; n < 4; n++) stage_put(stg, mm, n, j, fr, fq, o[n]);
          }
        }
        stage_flush(stg, mh, [&](int r) { return base + (size_t)r * 512; }, noscale);
      }
    } else {
      const int head = nt - 12;
#pragma unroll
      for (int m = 0; m < 8; m++)
#pragma unroll
        for (int n = 0; n < 4; n++) {
          h4 o; o[0] = (half_t)acc[m][n][0]; o[1] = (half_t)acc[m][n][1]; o[2] = (half_t)acc[m][n][2]; o[3] = (half_t)acc[m][n][3];
          int d = wc * 64 + n * 16 + fr;
          asm volatile("" : "+v"(d) :: "memory");
          *(h4*)(P.vT + ((size_t)(b * 4 + head) * 128 + d) * KV + pos0 + m * 16 + fq * 4) = o;
        }
    }
    mt = mt2; nt = nt2; it = it2; have = have2; a0 = a1; b0 = b1;
  }
}

DI void gemm_out_phase(const Params& P, int l, char* smem) {
  const int tid = TIDX, lane = tid & 63, wave = tid >> 6, fr = lane & 15, fq = lane >> 4, wr = wave >> 1, wc = wave & 1;
  const half_t* Wt = P.WtOut + (size_t)l * 1048576;
  const int mt0 = l == 0 ? 0 : TC / 256;
  const int sc = slot_col(), srow = tid >> 3;
#pragma unroll 1
  for (int it = 0;; it++) {
    int mt, nt;
    if (!xcd_tile(it, 264 - mt0, 8, mt, nt)) break;
    mt += mt0;
    if (mt >= 264) continue;
    asm volatile("" : "+s"(mt), "+s"(nt));
    f4 acc[8][4];
    {
      const half_t* a0 = P.mix + (size_t)(mt * 256 + srow) * D + sc; const half_t* b0 = Wt + (size_t)(nt * 128 + srow) * D + sc;
      gemm256([&](int i) { return a0 + (size_t)i * 32 * D; }, [&](int i) { return b0 + (size_t)i * 32 * D; }, 16, smem, acc);
    }
    const int r0 = mt * 256 + wr * 128;
    const int n = row_mod(r0);
    const float* g1 = P.mod + (size_t)(l * 9 + n) * 6144 + 2 * 1024;
    const float* res; float* dst;
    if (r0 < TC) { res = P.ctx + (size_t)r0 * D; dst = P.xcbuf + (size_t)r0 * D; }
    else { dst = P.out + (size_t)(r0 - TC) * D; res = l == 0 ? P.x + (size_t)(r0 - TC) * D : dst; }
#pragma unroll
    for (int m = 0; m < 8; m++) {
      int rb = m * 16 + fq * 4;
      asm volatile("" : "+v"(rb) :: "memory");
#pragma unroll
      for (int nn = 0; nn < 4; nn++) {
        const int c = nt * 128 + wc * 64 + nn * 16 + fr; const float g = g1[c];
#pragma unroll
        for (int j = 0; j < 4; j++) { size_t o = (size_t)(rb + j) * D + c; dst[o] = res[o] + g * acc[m][nn][j]; }
      }
    }
  }
}

DI void moe_prefix(const Params& P, int l, int* tb) {
  __syncthreads();
  if (TIDX == 0) { int s = 0; for (int e = 0; e < 32; e++) { tb[e] = s; s += (P.cnt[l * 32 + e] + 255) >> 8; } tb[32] = s; }
  __syncthreads();
}
DI void moe_e1_phase(const Params& P, int l, char* smem, int* tb) {
  const int tid = TIDX;
  moe_prefix(P, l, tb);
  const int sc = slot_col(), srow = tid >> 3;
  const int MT = tb[32];
  auto setup = [&](int rt, int nt, int (&tok)[8], const half_t*& w1, const half_t*& w3) {
    int e = 0;
    while (tb[e + 1] <= rt) e++;
    const int rl = rt - tb[e], cnt = P.cnt[l * 32 + e];
    const int* lst = P.list + (size_t)e * LCAP;
    w1 = P.Wt1 + ((size_t)(l * 32 + e) * 512 + nt * 64) * 1024 + sc;
    w3 = P.Wt3 + ((size_t)(l * 32 + e) * 512 + nt * 64) * 1024 + sc;
#pragma unroll
    for (int i = 0; i < 8; i++) tok[i] = lst[min(rl * 256 + i * 32 + srow, cnt - 1)] >> 1;
  };
  int it = 0, rt, nt;
  bool have = next_tile(it, MT, 8, rt, nt);
  int tok[8]; const half_t* w1 = nullptr; const half_t* w3 = nullptr;
  if (have) {
    asm volatile("" : "+s"(rt), "+s"(nt));
    setup(rt, nt, tok, w1, w3);
    gemm_prologue([&](int i) { return P.hx + (size_t)tok[i] * D + sc; }, [&](int i) { return ((i & 1) ? w3 : w1) + (size_t)((i >> 1) * 32 + srow) * 1024; }, 16, smem);
  }
#pragma unroll 1
  while (have) {
    f4 acc[8][4];
    gemm256<true>([&](int i) { return P.hx + (size_t)tok[i] * D + sc; },
                  [&](int i) { return ((i & 1) ? w3 : w1) + (size_t)((i >> 1) * 32 + srow) * 1024; }, 16, smem, acc);
    int it2 = it + 1, rt2, nt2;
    const bool have2 = next_tile(it2, MT, 8, rt2, nt2);
    int tok2[8]; const half_t* w1n = w1; const half_t* w3n = w3;
#pragma unroll
    for (int i = 0; i < 8; i++) tok2[i] = tok[i];
    if (have2) {
      asm volatile("" : "+s"(rt2), "+s"(nt2));
      setup(rt2, nt2, tok2, w1n, w3n);
      gemm_prologue([&](int i) { return P.hx + (size_t)tok2[i] * D + sc; }, [&](int i) { return ((i & 1) ? w3n : w1n) + (size_t)((i >> 1) * 32 + srow) * 1024; }, 16, smem);
    }
    {
      const int tid2 = TIDX, lane2 = tid2 & 63, wave2 = tid2 >> 6, fr2 = lane2 & 15, fq2 = lane2 >> 4, wr2 = wave2 >> 1, wc2 = wave2 & 1;
      char* stg = smem + 98304 + wave2 * 12288;
      half_t* Hd = P.H + ((size_t)rt * 256 + wr2 * 128) * 512 + nt * 64 + wc2 * 32;
#pragma unroll
      for (int h = 0; h < 2; h++) {
#pragma unroll
        for (int ml = 0; ml < 4; ml++)
#pragma unroll
          for (int n = 0; n < 2; n++)
#pragma unroll
            for (int j = 0; j < 4; j++) {
              float a1 = acc[h * 4 + ml][n][j], a3 = acc[h * 4 + ml][n + 2][j];
              *(half_t*)(stg + (ml * 16 + fq2 * 4 + j) * 80 + (n * 16 + fr2) * 2) = (half_t)(a1 * sigmoidf_(a1) * a3);
            }
        __builtin_amdgcn_wave_barrier();
#pragma unroll
        for (int i = 0; i < 4; i++) {
          const int c = i * 64 + lane2, row = c >> 2, c16 = c & 3;
          h8 v = *(const h8*)(stg + row * 80 + c16 * 16);
          *(h8*)(Hd + (size_t)(h * 64 + row) * 512 + c16 * 8) = v;
        }
        __builtin_amdgcn_wave_barrier();
      }
    }
    rt = rt2; nt = nt2; it = it2; have = have2; w1 = w1n; w3 = w3n;
#pragma unroll
    for (int i = 0; i < 8; i++) tok[i] = tok2[i];
  }
}
DI void moe_e2_phase(const Params& P, int l, char* smem, int* tb) {
  const int tid = TIDX;
  moe_prefix(P, l, tb);
  const int sc = slot_col(), srow = tid >> 3;
  const int MT = tb[32];
  auto ptrs = [&](int rt, int nt, const half_t*& a0, const half_t*& b0) {
    int e = 0;
    while (tb[e + 1] <= rt) e++;
    a0 = P.H + ((size_t)rt * 256 + srow) * 512 + sc;
    b0 = P.Wt2 + ((size_t)(l * 32 + e) * 1024 + nt * 128 + srow) * 512 + sc;
  };
  int it = 0, rt, nt;
  bool have = next_tile(it, MT, 8, rt, nt);
  const half_t* a0 = nullptr; const half_t* b0 = nullptr;
  if (have) {
    asm volatile("" : "+s"(rt), "+s"(nt));
    ptrs(rt, nt, a0, b0);
    gemm_prologue([&](int i) { return a0 + (size_t)i * 32 * 512; }, [&](int i) { return b0 + (size_t)i * 32 * 512; }, 8, smem);
  }
#pragma unroll 1
  while (have) {
    f4 acc[8][4];
    gemm256<true>([&](int i) { return a0 + (size_t)i * 32 * 512; }, [&](int i) { return b0 + (size_t)i * 32 * 512; }, 8, smem, acc);
    const int tid2 = TIDX, lane2 = tid2 & 63, wave2 = tid2 >> 6, wr2 = wave2 >> 1, wc2 = wave2 & 1;
    int e = 0;
    while (tb[e + 1] <= rt) e++;
    const int rl = rt - tb[e], cnt = P.cnt[l * 32 + e];
    const int* lst = P.list + (size_t)e * LCAP;
    int aa[2][8]; float ww[2][8];
#pragma unroll
    for (int h = 0; h < 2; h++)
#pragma unroll
      for (int i = 0; i < 8; i++) {
        const int idx = rl * 256 + wr2 * 128 + h * 64 + ((i * 64 + lane2) >> 3);
        aa[h][i] = idx < cnt ? lst[idx] : -1;
      }
#pragma unroll
    for (int h = 0; h < 2; h++)
#pragma unroll
      for (int i = 0; i < 8; i++) ww[h][i] = aa[h][i] >= 0 ? P.tokW[aa[h][i]] : 0.f;
#pragma unroll
    for (int h = 0; h < 2; h++)
#pragma unroll
      for (int i = 0; i < 8; i++) asm volatile("" : "+v"(ww[h][i]), "+v"(aa[h][i]));
    int it2 = it + 1, rt2, nt2;
    const bool have2 = next_tile(it2, MT, 8, rt2, nt2);
    const half_t* a1 = a0; const half_t* b1 = b0;
    if (have2) {
      asm volatile("" : "+s"(rt2), "+s"(nt2));
      ptrs(rt2, nt2, a1, b1);
      gemm_prologue([&](int i) { return a1 + (size_t)i * 32 * 512; }, [&](int i) { return b1 + (size_t)i * 32 * 512; }, 8, smem);
    }
    {
      char* stg = smem + 98304 + wave2 * 12288;
      const int fr2 = lane2 & 15, fq2 = lane2 >> 4;
#pragma unroll
      for (int h = 0; h < 2; h++) {
#pragma unroll
        for (int ml = 0; ml < 4; ml++)
#pragma unroll
          for (int n = 0; n < 4; n++)
#pragma unroll
            for (int j = 0; j < 4; j++) stage_put(stg, ml, n, j, fr2, fq2, acc[h * 4 + ml][n][j]);
        __builtin_amdgcn_wave_barrier();
#pragma unroll
        for (int i = 0; i < 8; i++) {
          const int c = i * 64 + lane2, row = c >> 3, c16 = c & 7;
          h8 v = *(const h8*)(stg + row * 144 + c16 * 16);
          if (aa[h][i] >= 0) {
            const float w = ww[h][i];
#pragma unroll
            for (int u = 0; u < 8; u++) v[u] = (half_t)(w * (float)v[u]);
            *(h8*)(P.yA + (size_t)aa[h][i] * D + nt * 128 + wc2 * 64 + c16 * 8) = v;
          }
        }
        __builtin_amdgcn_wave_barrier();
      }
    }
    rt = rt2; nt = nt2; it = it2; have = have2; a0 = a1; b0 = b1;
  }
}

DI int swap23(int x) { return (x & ~12) | ((x & 4) << 1) | ((x & 8) >> 1); }
DI void attn_item(const Params& P, int l, int b, int head, int row0, int nkeys, char* smem) {
  const int tid = TIDX, lane = tid & 63, wave = tid >> 6, ql = lane & 31, hh = lane >> 5;
  const float lam = P.consts[l * 4 + 0], negc = -P.consts[l * 4 + 1], lam_init = P.consts[l * 4 + 2];
  const int myrow = row0 + wave * 32 + ql;
  h8 qf[2][4];
  {
    const half_t* qp = P.q + (size_t)myrow * 512 + head * 128 + hh * 8;
#pragma unroll
    for (int m = 0; m < 2; m++)
#pragma unroll
      for (int s = 0; s < 4; s++) { qf[m][s] = *(const h8*)(qp + m * 64 + s * 16); }
#pragma unroll
    for (int m = 0; m < 2; m++)
#pragma unroll
      for (int s = 0; s < 4; s++) tie(qf[m][s]);
  }
  f16v o0[4], o1[4];
#pragma unroll
  for (int dt = 0; dt < 4; dt++)
#pragma unroll
    for (int i = 0; i < 16; i++) { o0[dt][i] = 0.f; o1[dt][i] = 0.f; }
  float ls0 = 0.f, ls1 = 0.f;
  const half_t* kp[4]; const half_t* vp[4];
  {
    const half_t* kbase = P.kall + (size_t)b * KV * 512 + head * 128;
    const half_t* vbase = P.vT + (size_t)(b * 4 + head) * 128 * KV;
#pragma unroll
    for (int i = 0; i < 4; i++) {
      int s = i * 256 + tid;
      int row = s >> 4, c = (s & 15) ^ (row & 15); kp[i] = kbase + (size_t)row * 512 + c * 8;
      int vr = s >> 3, vc = (s & 7) ^ ((vr >> 1) & 7); vp[i] = vbase + (size_t)vr * KV + vc * 8;
    }
  }
  const int ntile = nkeys >> 6;
  const unsigned sbase = lds_addr(smem);
  auto issue = [&](int t) {
    char* d = smem + (t % 3) * 32768 + tid * 16;
#pragma unroll
    for (int i = 0; i < 4; i++) { glds16(kp[i] + (size_t)t * 64 * 512, d + i * 4096); glds16(vp[i] + t * 64, d + 16384 + i * 4096); }
  };
  unsigned koff[2];
  const int kr_lo = swap23(ql), ksw = kr_lo & 15;
  koff[0] = kr_lo * 256; koff[1] = (32 + kr_lo) * 256;
  unsigned voff[4];
#pragma unroll
  for (int dt = 0; dt < 4; dt++) { int vrow = dt * 32 + ql; voff[dt] = 16384 + vrow * 128; }
  const int vsw = (ql >> 1) & 7;
  f16v negcv;
#pragma unroll
  for (int i = 0; i < 16; i++) negcv[i] = negc;
  h8 pp0[2], pp1[2];
  unsigned pendV = 0; int pendkt = 0; bool pend = false;
  auto half_step = [&](h8 (&kf)[8], unsigned cur, int kt) {
    h8 vf[8];
    if (pend) {
#pragma unroll
      for (int sp = 0; sp < 2; sp++)
#pragma unroll
        for (int dt = 0; dt < 4; dt++) vf[sp * 4 + dt] = lds128(pendV + voff[dt] + (((pendkt * 4 + sp * 2 + hh) ^ vsw) << 4));
    }
    f16v s0 = mfma32(kf[0], qf[0][0], negcv), s1 = mfma32(kf[4], qf[1][0], negcv);
#pragma unroll
    for (int st = 1; st < 4; st++) { s0 = mfma32(kf[st], qf[0][st], s0); s1 = mfma32(kf[4 + st], qf[1][st], s1); }
    if (pend) {
      WAIT_LGKM(0);
#pragma unroll
      for (int i = 0; i < 8; i++) tie(vf[i]);
#pragma unroll
      for (int sp = 0; sp < 2; sp++)
#pragma unroll
        for (int dt = 0; dt < 4; dt++) { o0[dt] = mfma32(vf[sp * 4 + dt], pp0[sp], o0[dt]); o1[dt] = mfma32(vf[sp * 4 + dt], pp1[sp], o1[dt]); }
    }
#pragma unroll
    for (int i = 0; i < 16; i++) { s0[i] = __builtin_amdgcn_exp2f(s0[i]); ls0 += s0[i]; s1[i] = __builtin_amdgcn_exp2f(s1[i]); ls1 += s1[i]; }
#pragma unroll
    for (int sp = 0; sp < 2; sp++) {
      u4 a, c;
      a[0] = pk2(s0[8*sp+0], s0[8*sp+1]); a[1] = pk2(s0[8*sp+2], s0[8*sp+3]); a[2] = pk2(s0[8*sp+4], s0[8*sp+5]); a[3] = pk2(s0[8*sp+6], s0[8*sp+7]);
      c[0] = pk2(s1[8*sp+0], s1[8*sp+1]); c[1] = pk2(s1[8*sp+2], s1[8*sp+3]); c[2] = pk2(s1[8*sp+4], s1[8*sp+5]); c[3] = pk2(s1[8*sp+6], s1[8*sp+7]);
      pp0[sp] = __builtin_bit_cast(h8, a); pp1[sp] = __builtin_bit_cast(h8, c);
    }
    pend = true; pendV = cur; pendkt = kt;
  };
  issue(0);
#pragma unroll 1
  for (int t = 0; t < ntile; t++) {
    wait_vm0();
    raw_barrier();
    if (t + 1 < ntile) issue(t + 1);
    const unsigned cur = sbase + (t % 3) * 32768;
    h8 kfa[8], kfb[8];
#pragma unroll
    for (int st = 0; st < 4; st++) {
      kfa[st] = lds128(cur + koff[0] + (((st * 2 + hh) ^ ksw) << 4));
      kfa[4 + st] = lds128(cur + koff[0] + (((8 + st * 2 + hh) ^ ksw) << 4));
    }
#pragma unroll
    for (int st = 0; st < 4; st++) {
      kfb[st] = lds128(cur + koff[1] + (((st * 2 + hh) ^ ksw) << 4));
      kfb[4 + st] = lds128(cur + koff[1] + (((8 + st * 2 + hh) ^ ksw) << 4));
    }
    WAIT_LGKM(8);
#pragma unroll
    for (int i = 0; i < 8; i++) tie(kfa[i]);
    half_step(kfa, cur, 0);
    WAIT_LGKM(0);
#pragma unroll
    for (int i = 0; i < 8; i++) tie(kfb[i]);
    half_step(kfb, cur, 1);
  }
  {
    h8 vf[8];
#pragma unroll
    for (int sp = 0; sp < 2; sp++)
#pragma unroll
      for (int dt = 0; dt < 4; dt++) vf[sp * 4 + dt] = lds128(pendV + voff[dt] + (((pendkt * 4 + sp * 2 + hh) ^ vsw) << 4));
    WAIT_LGKM(0);
#pragma unroll
    for (int i = 0; i < 8; i++) tie(vf[i]);
#pragma unroll
    for (int sp = 0; sp < 2; sp++)
#pragma unroll
      for (int dt = 0; dt < 4; dt++) { o0[dt] = mfma32(vf[sp * 4 + dt], pp0[sp], o0[dt]); o1[dt] = mfma32(vf[sp * 4 + dt], pp1[sp], o1[dt]); }
  }
  raw_barrier();
  ls0 += shx(ls0, 32); ls1 += shx(ls1, 32);
  const float i0 = 1.f / ls0, i1 = lam / ls1;
  float ss = 0.f;
#pragma unroll
  for (int dt = 0; dt < 4; dt++)
#pragma unroll
    for (int i = 0; i < 16; i++) { float v = o0[dt][i] * i0 - o1[dt][i] * i1; o0[dt][i] = v; ss += v * v; }
  ss += shx(ss, 32);
  const float mult = rsqrtf(ss * (1.f / 128.f) + EPS) * (1.f - lam_init);
  const float* sg = P.subln_g + l * 128;
  half_t* dst = P.mix + (size_t)myrow * D + 256 + head * 128;
#pragma unroll
  for (int dt = 0; dt < 4; dt++)
#pragma unroll
    for (int g = 0; g < 4; g++) {
      const int d0 = dt * 32 + 8 * g + 4 * hh;
      float4 gv = *(const float4*)(sg + d0);
      h4 o; o[0] = (half_t)(o0[dt][4*g] * mult * gv.x); o[1] = (half_t)(o0[dt][4*g+1] * mult * gv.y);
      o[2] = (half_t)(o0[dt][4*g+2] * mult * gv.z); o[3] = (half_t)(o0[dt][4*g+3] * mult * gv.w);
      *(h4*)(dst + d0) = o;
    }
}

DI int swz128(int row, int colh) { return row * 128 + ((((colh >> 3)) ^ ((row >> 1) & 7)) << 4) + (colh & 7) * 2; }
DI void lru_load_w(const Params& P, int l, int g, char* Wt) {
  const int tid = TIDX;
  for (int dg = 0; dg < 4; dg++) {
    const int dir = dg >> 1;
    const float* w = ((dg & 1) ? P.gate_x_w : P.gate_a_w) + ((size_t)((l * 2 + dir) * 4 + g)) * 4096;
    for (int idx = tid; idx < 4096; idx += 256) { int i = idx >> 6, o = idx & 63; *(half_t*)(Wt + dg * 8192 + swz128(o, i)) = (half_t)w[idx]; }
  }
}
DI void lru_tile(const Params& P, int l, int b, int tile, int g, char* smem, bool final) {
  const int tid = TIDX, lane = tid & 63, wave = tid >> 6, fr = lane & 15, fq = lane >> 4;
  char* Wt = smem;
  char* xr16 = smem + 32768;
  float2* ab = (float2*)(smem + 40960);
  half_t* raw = (half_t*)(smem + 40960);
  float2* subst = (float2*)(smem + 73728);
  const int ch = tid & 63, tq = tid >> 6, gc = g * 64 + ch;
  const int T = tile < 4 ? CL : SEQ;
  const int t0 = tile < 4 ? tile * 64 : (tile - 4) * 64;
  const int rowbase = tile < 4 ? b * CL : TC + b * SEQ;
  unsigned* lab = (unsigned*)P.hx;
  __syncthreads();
  if (final) {
    float gyv[16], hsum[16];
#pragma unroll
    for (int e = 0; e < 16; e++) { gyv[e] = (float)P.gy[(size_t)(rowbase + t0 + tq * 16 + e) * 256 + gc]; hsum[e] = 0.f; }
#pragma unroll 1
    for (int dir = 0; dir < 2; dir++) {
      unsigned pk[16];
#pragma unroll
      for (int e = 0; e < 16; e++) pk[e] = lab[((size_t)dir * TA + rowbase + t0 + tq * 16 + e) * 256 + gc];
      float2 av[16];
      float A = 1.f, h = 0.f;
#pragma unroll
      for (int e = 0; e < 16; e++) {
        const int ee = dir == 0 ? e : 15 - e;
        unsigned u = pk[0];
#pragma unroll
        for (int q = 1; q < 16; q++) u = (q == ee) ? pk[q] : u;
        fp16x2 hv = __builtin_bit_cast(fp16x2, u);
        av[e] = make_float2(__expf((float)hv[0]), (float)hv[1]);
        h = av[e].x * h + av[e].y; A *= av[e].x;
      }
      subst[tq * 64 + ch] = make_float2(A, h);
      __syncthreads();
      h = P.lcar[((size_t)((b * 2 + dir) * 132 + tile)) * 256 + gc];
      if (dir == 0) { for (int s2 = 0; s2 < tq; s2++) { float2 ss = subst[s2 * 64 + ch]; h = ss.x * h + ss.y; } }
      else { for (int s2 = 3; s2 > tq; s2--) { float2 ss = subst[s2 * 64 + ch]; h = ss.x * h + ss.y; } }
#pragma unroll
      for (int e = 0; e < 16; e++) {
        const int ee = dir == 0 ? e : 15 - e;
        h = av[e].x * h + av[e].y;
#pragma unroll
        for (int q = 0; q < 16; q++) hsum[q] += (q == ee) ? h : 0.f;
      }
      __syncthreads();
    }
#pragma unroll
    for (int e = 0; e < 16; e++)
      P.mix[(size_t)(rowbase + t0 + tq * 16 + e) * D + 768 + gc] = (half_t)(gyv[e] * hsum[e]);
    return;
  }
  for (int idx = tid; idx < 67 * 8; idx += 256) {
    int row = idx >> 3, c = idx & 7, tt = t0 - 1 + row;
    h8 v = {0, 0, 0, 0, 0, 0, 0, 0};
    if (tt >= 0 && tt < T) v = *(const h8*)(P.rr + (size_t)(rowbase + tt) * 256 + g * 64 + c * 8);
    *(h8*)(raw + row * 64 + c * 8) = v;
  }
  const float cw0 = P.conv_w[(l * 4 + 0) * 256 + gc], cw1 = P.conv_w[(l * 4 + 1) * 256 + gc], cw2 = P.conv_w[(l * 4 + 2) * 256 + gc],
              cw3 = P.conv_w[(l * 4 + 3) * 256 + gc], cb = P.conv_b[l * 256 + gc];
  __syncthreads();
  {
    float v[19];
#pragma unroll
    for (int e = 0; e < 19; e++) v[e] = (float)raw[(tq * 16 + e) * 64 + ch];
    __syncthreads();
#pragma unroll
    for (int e = 0; e < 16; e++) {
      float xv = cb + cw0 * v[e] + cw1 * v[e + 1] + cw2 * v[e + 2] + cw3 * v[e + 3];
      *(half_t*)(xr16 + swz128(tq * 16 + e, ch)) = (half_t)xv;
    }
  }
  __syncthreads();
#pragma unroll 1
  for (int dir = 0; dir < 2; dir++) {
    {
      f4 acc[2][4];
#pragma unroll
      for (int gt = 0; gt < 2; gt++)
#pragma unroll
        for (int n = 0; n < 4; n++) acc[gt][n] = (f4){0.f, 0.f, 0.f, 0.f};
#pragma unroll
      for (int kk = 0; kk < 2; kk++) {
        int row = wave * 16 + fr;
        h8 af = *(const h8*)(xr16 + row * 128 + (((kk * 4 + fq) ^ ((row >> 1) & 7)) << 4));
#pragma unroll
        for (int gt = 0; gt < 2; gt++)
#pragma unroll
          for (int n = 0; n < 4; n++) {
            int orow = n * 16 + fr;
            h8 bf = *(const h8*)(Wt + (dir * 2 + gt) * 8192 + orow * 128 + (((kk * 4 + fq) ^ ((orow >> 1) & 7)) << 4));
            acc[gt][n] = mfma16(af, bf, acc[gt][n]);
          }
      }
#pragma unroll
      for (int n = 0; n < 4; n++) {
        const int cc = (l * 2 + dir) * 256 + g * 64 + n * 16 + fr;
        const float ba = P.gate_a_b[cc], bx = P.gate_x_b[cc];
        const float sp8 = -8.f * log1pf(__expf(-P.lru_lambda[cc]));
#pragma unroll
        for (int j = 0; j < 4; j++) {
          int tl = wave * 16 + fq * 4 + j, c2 = n * 16 + fr;
          float xv = (float)*(const half_t*)(xr16 + swz128(tl, c2));
          float rg = sigmoidf_(acc[0][n][j] + ba), ig = sigmoidf_(acc[1][n][j] + bx);
          float log_a = rg * sp8;
          float x2 = 2.f * log_a;
          float om = -x2 * (1.f + x2 * (0.5f + x2 * (0.16666667f + x2 * (0.041666668f + x2 * (0.008333334f + x2 * 0.0013888889f)))));
          if (x2 < -0.4f) { float a = __expf(log_a); om = 1.f - a * a; }
          ab[tl * 64 + c2] = make_float2(log_a, sqrtf(om) * (ig * xv));
        }
      }
    }
    __syncthreads();
    {
      float A = 1.f, h = 0.f;
#pragma unroll
      for (int e = 0; e < 16; e++) {
        const int ee = dir == 0 ? e : 15 - e;
        const float2 lb = ab[(tq * 16 + ee) * 64 + ch];
        fp16x2 hv; hv[0] = (__fp16)lb.x; hv[1] = (__fp16)lb.y;
        lab[((size_t)dir * TA + rowbase + t0 + tq * 16 + ee) * 256 + gc] = __builtin_bit_cast(unsigned, hv);
        const float a = __expf((float)hv[0]), bt = (float)hv[1];
        h = a * h + bt; A *= a;
      }
      subst[tq * 64 + ch] = make_float2(A, h);
    }
    __syncthreads();
    if (tq == 0) {
      float A = 1.f, h = 0.f;
#pragma unroll
      for (int s2 = 0; s2 < 4; s2++) { float2 ss = subst[(dir == 0 ? s2 : 3 - s2) * 64 + ch]; h = ss.x * h + ss.y; A *= ss.x; }
      P.lsum[((size_t)((b * 2 + dir) * 132 + tile)) * 256 + gc] = make_float2(A, h);
    }
    __syncthreads();
  }
}
DI void lru_carry_item(const Params& P, int it) {
  const int ch = TIDX, dir = it & 1;
  const size_t base = (size_t)it * 132 * 256 + ch;
  float c = 0.f;
#pragma unroll 4
  for (int k = 0; k < 132; k++) {
    int tile = dir == 0 ? k : (k < 4 ? 3 - k : 135 - k);
    float2 s = P.lsum[base + (size_t)tile * 256];
    P.lcar[base + (size_t)tile * 256] = c;
    c = s.x * c + s.y;
  }
}

DI void fft_load(const half_t* src, size_t rs, int nrows, char* Bt, int rowbytes, int k0) {
  for (int idx = TIDX; idx < nrows * 16; idx += 256) {
    int kr = idx >> 4, cc = idx & 15, k = k0 + kr;
    h8 v = *(const h8*)(src + (size_t)kr * rs + cc * 8);
#pragma unroll
    for (int u = 0; u < 8; u++) { int n = cc * 8 + u; *(half_t*)(Bt + n * rowbytes + ((((k >> 3)) ^ (n & 15)) << 4) + (k & 7) * 2) = v[u]; }
  }
}
template <class RF>
DI void fft_mma(const half_t* Dm, int ldD, int nkk, const char* Bt, int rowbytes, f4 (&acc)[4][4], RF arow) {
  const int lane = TIDX & 63, wave = TIDX >> 6, fr = lane & 15, fq = lane >> 4, wc = wave & 1;
#pragma unroll 1
  for (int kk = 0; kk < nkk; kk++) {
    h8 af[4], bf[4];
#pragma unroll
    for (int ms = 0; ms < 4; ms++) af[ms] = *(const h8*)(Dm + (size_t)arow(ms) * ldD + kk * 32 + fq * 8);
#pragma unroll
    for (int ns = 0; ns < 4; ns++) { int n = wc * 64 + ns * 16 + fr; bf[ns] = *(const h8*)(Bt + n * rowbytes + (((kk * 4 + fq) ^ (n & 15)) << 4)); }
#pragma unroll
    for (int ms = 0; ms < 4; ms++)
#pragma unroll
      for (int ns = 0; ns < 4; ns++) acc[ms][ns] = mfma16(af[ms], bf[ns], acc[ms][ns]);
  }
}
DI void zero44(f4 (&acc)[4][4]) {
#pragma unroll
  for (int m = 0; m < 4; m++)
#pragma unroll
    for (int n = 0; n < 4; n++) acc[m][n] = (f4){0.f, 0.f, 0.f, 0.f};
}
DI void fftA_item(const Params& P, int it, char* smem) {
  const int b = it >> 8, bb = (it >> 1) & 127, chh = it & 1;
  const int lane = TIDX & 63, wave = TIDX >> 6, fr = lane & 15, fq = lane >> 4, wr = wave >> 1, wc = wave & 1;
  __syncthreads();
  fft_load(P.QF + (size_t)(TC + b * SEQ + bb) * 512 + chh * 128, (size_t)128 * 512, 64, smem, 256, 0);
  fft_load(P.QF + (size_t)(TC + b * SEQ + bb) * 512 + 256 + chh * 128, (size_t)128 * 512, 64, smem, 256, 64);
  __syncthreads();
  f4 acc[4][4]; zero44(acc);
  fft_mma(P.DA, 128, 4, smem, 256, acc, [&](int ms) { return (ms >> 1) * 64 + wr * 32 + (ms & 1) * 16 + fr; });
#pragma unroll
  for (int ms = 0; ms < 2; ms++)
#pragma unroll
    for (int j = 0; j < 4; j++) {
      const int f1 = wr * 32 + ms * 16 + fq * 4 + j;
      const float2 w = P.tw[(bb * f1) & 8191];
      half_t* d0 = P.GA + ((size_t)(b * 64 + f1) * 256 + bb) * 256 + chh * 128 + wc * 64 + fr;
#pragma unroll
      for (int ns = 0; ns < 4; ns++) {
        float gr = acc[ms][ns][j], gi = acc[ms + 2][ns][j];
        d0[ns * 16] = (half_t)(gr * w.x + gi * w.y);
        d0[(size_t)128 * 256 + ns * 16] = (half_t)(gi * w.x - gr * w.y);
      }
    }
}
DI void fftB_item(const Params& P, int it, char* smem) {
  const int b = it >> 7, f1 = (it >> 1) & 63, chh = it & 1;
  const int lane = TIDX & 63, wave = TIDX >> 6, fr = lane & 15, fq = lane >> 4, wr = wave >> 1, wc = wave & 1;
  __syncthreads();
  fft_load(P.GA + (size_t)(b * 64 + f1) * 256 * 256 + chh * 128, 256, 256, smem, 512, 0);
  __syncthreads();
  f4 acc[4][4]; zero44(acc);
  fft_mma(P.DB, 256, 8, smem, 512, acc, [&](int ms) { return wr * 64 + ms * 16 + fr; });
#pragma unroll
  for (int ms = 0; ms < 4; ms++)
#pragma unroll
    for (int j = 0; j < 4; j++) {
      const int f2 = wr * 64 + ms * 16 + fq * 4 + j;
      half_t* d0 = P.mix + (size_t)(TC + b * SEQ + f1 + 64 * f2) * D + chh * 128 + wc * 64 + fr;
#pragma unroll
      for (int ns = 0; ns < 4; ns++) d0[ns * 16] = (half_t)acc[ms][ns][j];
    }
}
DI void fftC_item(const Params& P, int it, char* smem) {
  const int b = it >> 1, chh = it & 1;
  const int lane = TIDX & 63, wave = TIDX >> 6, fr = lane & 15, fq = lane >> 4, wr = wave >> 1, wc = wave & 1;
#pragma unroll 1
  for (int mh = 0; mh < 2; mh++) {
    f4 acc[4][4]; zero44(acc);
#pragma unroll 1
    for (int part = 0; part < 2; part++) {
      __syncthreads();
      fft_load(P.QF + (size_t)(b * CL) * 512 + part * 256 + chh * 128, 512, 256, smem, 512, 0);
      __syncthreads();
      fft_mma(P.DC + part * 256, 512, 8, smem, 512, acc, [&](int ms) { return mh * 128 + wr * 64 + ms * 16 + fr; });
    }
#pragma unroll
    for (int ms = 0; ms < 4; ms++)
#pragma unroll
      for (int j = 0; j < 4; j++) {
        const int f = mh * 128 + wr * 64 + ms * 16 + fq * 4 + j;
        half_t* d0 = P.mix + (size_t)(b * CL + f) * D + chh * 128 + wc * 64 + fr;
#pragma unroll
        for (int ns = 0; ns < 4; ns++) d0[ns * 16] = (half_t)acc[ms][ns][j];
      }
  }
}

#ifndef MX
#define MX 15
#endif
DI void mix_phase(const Params& P, int l, char* smem, int* s_item, int qi) {
  const int nL = 0, nA = 0, nC = l == 0 ? 64 : 0, nFA = 2048, nFC = l == 0 ? 16 : 0;
  const int total = nL + nA + nC + nFA + nFC;
  {
    const int g = blockIdx.x & 3;
    lru_load_w(P, l, g, smem);
    for (int u = blockIdx.x >> 2; u < NB_ * 132; u += gridDim.x >> 2) lru_tile(P, l, u / 132, u % 132, g, smem, false);
  }
  int stage = 0;
  for (;;) {
    __syncthreads();
    if (TIDX == 0) *s_item = stage == 0 ? atomicAdd(&P.qctr[8 + qi * 8 + (blockIdx.x & 7)], 1) : atomicAdd(&P.qctr[qi], 1);
    __syncthreads();
    int it = *s_item;
    int kind = -1, b = 0, head = 0, row0 = 0, nk = 0;
    if (stage == 0) {
      if (it >= 256) { stage = 1; continue; }
      const int pair = (blockIdx.x & 7) + 8 * (it >> 6);
      b = pair >> 2; head = pair & 3; row0 = TC + b * SEQ + (it & 63) * 128; nk = KV; kind = 0;
    } else {
      if (it >= total) break;
      if (it < nC) { b = it >> 3; head = (it >> 1) & 3; row0 = b * CL + (it & 1) * 128; nk = CL; kind = 0; }
      else if (it < nC + nFA) { kind = 1; it -= nC; }
      else { kind = 2; it -= nC + nFA; }
    }
    if (kind == 0) attn_item(P, l, b, head, row0, nk, smem);
    else if (kind == 1) fftA_item(P, it, smem);
    else fftC_item(P, it, smem);
  }
}

DI void grid_barrier(unsigned* ctr, unsigned target) {
  asm volatile("s_waitcnt vmcnt(0)" ::: "memory");
  __syncthreads();
  if (threadIdx.x == 0) {
    __builtin_amdgcn_fence(__ATOMIC_RELEASE, "agent");
    asm volatile("s_waitcnt vmcnt(0)" ::: "memory");
    __hip_atomic_fetch_add(ctr, 1u, __ATOMIC_RELAXED, __HIP_MEMORY_SCOPE_AGENT);
    while (__hip_atomic_load(ctr, __ATOMIC_RELAXED, __HIP_MEMORY_SCOPE_AGENT) < target) __builtin_amdgcn_s_sleep(1);
    __builtin_amdgcn_fence(__ATOMIC_ACQUIRE, "agent");
    asm volatile("s_waitcnt vmcnt(0)" ::: "memory");
  }
  __syncthreads();
}
__global__ void __launch_bounds__(256, 1) fwd_megakernel(Params Pin) {
  Params P = Pin; bind_ws(P);
  __shared__ __attribute__((aligned(16))) char smem[147456 + 8192];
  __shared__ int tb[33];
  __shared__ int s_item;
  cg::grid_group grid = cg::this_grid();
  unsigned* bar = (unsigned*)(P.ws + O_bar); unsigned bk = 0;
#ifndef PH
#define PH 0xFFFF
#endif
#if PH & 1
  phase0(P, smem);
#endif
  grid.sync();
  for (int l = 0; l < 2; l++) {
#if PH & 2
    row1_phase(P, l == 0 ? -1 : 0, l, 0);
#endif
    grid_barrier(bar, (++bk) * gridDim.x);
#if PH & 4
    gemm_in_phase(P, l, smem);
#ifdef DUP_GEMM
    grid_barrier(bar, (++bk) * gridDim.x);
    gemm_in_phase(P, l, smem);
#endif
#endif
    grid_barrier(bar, (++bk) * gridDim.x);
#if PH & 8
    mix_phase(P, l, smem, &s_item, l);
#ifdef DUP_MIX
    grid_barrier(bar, (++bk) * gridDim.x);
    mix_phase(P, l, smem, &s_item, 2 + l);
#endif
#endif
    grid_barrier(bar, (++bk) * gridDim.x);
#if PH & 16
    if (blockIdx.x >= gridDim.x - 16) lru_carry_item(P, gridDim.x - 1 - blockIdx.x);
    for (int it = blockIdx.x; it < 1024; it += gridDim.x) fftB_item(P, it, smem);
#endif
    grid_barrier(bar, (++bk) * gridDim.x);
#if PH & 512
    {
      const int g = blockIdx.x & 3;
      for (int u = blockIdx.x >> 2; u < NB_ * 132; u += gridDim.x >> 2) lru_tile(P, l, u / 132, u % 132, g, smem, true);
    }
#endif
    grid_barrier(bar, (++bk) * gridDim.x);
#if PH & 32
    gemm_out_phase(P, l, smem);
#endif
    grid_barrier(bar, (++bk) * gridDim.x);
#if PH & 64
    row2_phase(P, l, l == 0 ? 0 : TC, smem);
#endif
    grid_barrier(bar, (++bk) * gridDim.x);
#if PH & 128
    moe_e1_phase(P, l, smem, tb);
#ifdef DUP_GEMM
    grid_barrier(bar, (++bk) * gridDim.x);
    moe_e1_phase(P, l, smem, tb);
#endif
#endif
    grid_barrier(bar, (++bk) * gridDim.x);
#if PH & 256
    moe_e2_phase(P, l, smem, tb);
#ifdef DUP_GEMM
    grid_barrier(bar, (++bk) * gridDim.x);
    moe_e2_phase(P, l, smem, tb);
#endif
#endif
    grid_barrier(bar, (++bk) * gridDim.x);
  }
#if PH & 2
  row1_phase(P, 1, -1, TC);
#endif
}

extern "C" void kernel_launch(void* const* d_in, const int* in_sizes, int n_in, void* d_out, int out_size, void* d_ws, size_t ws_size,
                              hipStream_t stream) {
  static int grid_blocks = 0;
  if (!grid_blocks) {
    int dev = 0, cus = 0, per_cu = 0;
    hipGetDevice(&dev);
    hipDeviceGetAttribute(&cus, hipDeviceAttributeMultiprocessorCount, dev);
    hipOccupancyMaxActiveBlocksPerMultiprocessor(&per_cu, fwd_megakernel, 256, 0);
    if (per_cu > 2) per_cu = 2;
    grid_blocks = cus * per_cu;
  }
  Params p{};
  const float** pin = (const float**)&p;
  for (int i = 0; i < 31; i++) pin[i] = (const float*)d_in[i];
  p.out = (float*)d_out;
  p.ws = (char*)d_ws;
  if (WS_NEED > ws_size) { fprintf(stderr, "workspace too small: need %zu have %zu\n", (size_t)WS_NEED, ws_size); return; }
  hipMemsetAsync((char*)d_ws + O_bar, 0, 256, stream);
  void* args[] = {&p};
  hipError_t e = hipLaunchCooperativeKernel((void*)fwd_megakernel, dim3(grid_blocks), dim3(256), args, 0, stream);
  if (e != hipSuccess) fprintf(stderr, "cooperative launch failed: %s (grid %d)\n", hipGetErrorString(e), grid_blocks);
}
```

```cpp
#include <hip/hip_runtime.h>
#include <hip/hip_cooperative_groups.h>
#include <cstdio>
namespace cg = cooperative_groups;

typedef _Float16 half_t;
typedef _Float16 h8 __attribute__((ext_vector_type(8)));
typedef _Float16 h4 __attribute__((ext_vector_type(4)));
typedef __fp16 fp16x2 __attribute__((ext_vector_type(2)));
typedef unsigned u4 __attribute__((ext_vector_type(4)));
typedef float f4 __attribute__((ext_vector_type(4)));
typedef float f16v __attribute__((ext_vector_type(16)));
#define DI __device__ __forceinline__
__device__ __forceinline__ int tid_opaque() { int t = threadIdx.x; asm volatile("" : "+v"(t)); return t; }
#define TIDX tid_opaque()

constexpr int D = 1024, NB_ = 8, SEQ = 8192, CL = 256;
constexpr int TC = NB_ * CL;
constexpr int TX = NB_ * SEQ;
constexpr int TA = TC + TX;
constexpr int KV = CL + SEQ;
constexpr int NIN = 2560;
constexpr int LCAP = 2 * TA;
constexpr float EPS = 1e-6f;

struct Params {
  const float *x, *c, *ctx, *c_ctx, *w_mod, *b_mod, *norm1_g, *norm2_g, *w_in, *q_norm_g, *k_norm_g, *lq1, *lk1, *lq2, *lk2,
      *subln_g, *conv_w, *conv_b, *gate_a_w, *gate_a_b, *gate_x_w, *gate_x_b, *lru_lambda, *w_out, *w_group, *b_group,
      *w_router, *b_router, *w1, *w3, *w2;
  float* out; char* ws;
  half_t *WtIn, *WtOut, *Wt1, *Wt3, *Wt2;
  float* mod; float2* rope; float2* tw; half_t *DA, *DB, *DC; float* consts; int* cnt; int* qctr; float* tokW; int* list; float* listW;
  float* xcbuf; half_t* WrH;
  half_t *hx, *mix, *q, *kall, *vT, *QF, *gy, *rr; float2* lsum; float* lcar; half_t* GA; half_t *H, *yA;
};


constexpr size_t al256(size_t x) { return (x + 255) & ~(size_t)255; }
constexpr size_t O_WtIn = 0;
constexpr size_t O_WtOut = O_WtIn + al256((size_t)2 * NIN * 1024 * 2);
constexpr size_t O_Wt1 = O_WtOut + al256((size_t)2 * 1024 * 1024 * 2);
constexpr size_t O_Wt3 = O_Wt1 + al256((size_t)64 * 524288 * 2);
constexpr size_t O_Wt2 = O_Wt3 + al256((size_t)64 * 524288 * 2);
constexpr size_t O_mod = O_Wt2 + al256((size_t)64 * 524288 * 2);
constexpr size_t O_rope = O_mod + al256((size_t)2 * 9 * 6144 * 4);
constexpr size_t O_tw = O_rope + al256(128 * 16 * 8);
constexpr size_t O_DA = O_tw + al256(8192 * 8);
constexpr size_t O_DB = O_DA + al256(16384 * 2);
constexpr size_t O_DC = O_DB + al256(32768 * 2);
constexpr size_t O_consts = O_DC + al256(131072 * 2);
constexpr size_t O_cnt = O_consts + 256;
constexpr size_t O_qctr = O_cnt + 256;
constexpr size_t O_bar = O_qctr + 256;
constexpr size_t O_tokW = O_bar + 256;
constexpr size_t O_list = O_tokW + al256((size_t)2 * TA * 4);
constexpr size_t O_listW = O_list + al256((size_t)32 * LCAP * 4);
constexpr size_t O_xcbuf = O_listW + al256((size_t)32 * LCAP * 4);
constexpr size_t O_WrT = O_xcbuf + al256((size_t)TC * D * 4);
constexpr size_t O_hx = O_WrT + al256((size_t)2 * 2 * 48 * 1024 * 2);
constexpr size_t O_mix = O_hx + al256((size_t)TA * D * 2);
constexpr size_t O_regB = O_mix + al256((size_t)TA * D * 2);
constexpr size_t O_q = O_regB;
constexpr size_t O_kall = O_q + al256((size_t)TA * 512 * 2);
constexpr size_t O_vT = O_kall + al256((size_t)NB_ * KV * 512 * 2);
constexpr size_t O_QF = O_vT + al256((size_t)NB_ * 4 * 128 * KV * 2);
constexpr size_t O_gy = O_QF + al256((size_t)TA * 512 * 2);
constexpr size_t O_rr = O_gy + al256((size_t)TA * 256 * 2);
constexpr size_t O_lsum = O_rr + al256((size_t)TA * 256 * 2);
constexpr size_t O_lcar = O_lsum + al256((size_t)16 * 132 * 256 * 8);
constexpr size_t O_GA = O_lcar + al256((size_t)16 * 132 * 256 * 4);
constexpr size_t O_mixer_end = O_GA + al256((size_t)NB_ * 64 * 256 * 256 * 2);
constexpr size_t O_H = O_regB;
constexpr size_t O_yA = O_H + al256((size_t)(2 * TA + 32 * 256) * 512 * 2);
constexpr size_t O_moe_end = O_yA + al256((size_t)2 * TA * D * 2);
constexpr size_t WS_NEED = O_mixer_end > O_moe_end ? O_mixer_end : O_moe_end;
DI void bind_ws(Params& P) {
  char* w = P.ws;
  P.WtIn = (half_t*)(w + O_WtIn); P.WtOut = (half_t*)(w + O_WtOut); P.Wt1 = (half_t*)(w + O_Wt1); P.Wt3 = (half_t*)(w + O_Wt3); P.Wt2 = (half_t*)(w + O_Wt2);
  P.mod = (float*)(w + O_mod); P.rope = (float2*)(w + O_rope); P.tw = (float2*)(w + O_tw); P.DA = (half_t*)(w + O_DA); P.DB = (half_t*)(w + O_DB); P.DC = (half_t*)(w + O_DC);
  P.consts = (float*)(w + O_consts); P.cnt = (int*)(w + O_cnt); P.qctr = (int*)(w + O_qctr); P.tokW = (float*)(w + O_tokW); P.list = (int*)(w + O_list); P.listW = (float*)(w + O_listW);
  P.xcbuf = (float*)(w + O_xcbuf); P.WrH = (half_t*)(w + O_WrT); P.hx = (half_t*)(w + O_hx); P.mix = (half_t*)(w + O_mix);
  P.q = (half_t*)(w + O_q); P.kall = (half_t*)(w + O_kall); P.vT = (half_t*)(w + O_vT); P.QF = (half_t*)(w + O_QF); P.gy = (half_t*)(w + O_gy); P.rr = (half_t*)(w + O_rr);
  P.lsum = (float2*)(w + O_lsum); P.lcar = (float*)(w + O_lcar); P.GA = (half_t*)(w + O_GA); P.H = (half_t*)(w + O_H); P.yA = (half_t*)(w + O_yA);
}
DI float shx(float v, int o) { int ln = TIDX & 63; return __builtin_bit_cast(float, __builtin_amdgcn_ds_bpermute((ln ^ o) << 2, __builtin_bit_cast(int, v))); }
DI float shi(float v, int idx) { return __builtin_bit_cast(float, __builtin_amdgcn_ds_bpermute(idx << 2, __builtin_bit_cast(int, v))); }
DI float wave_sum(float v) {
#pragma unroll
  for (int o = 32; o; o >>= 1) v += shx(v, o);
  return v;
}
DI void glds16(const void* g, void* l) {
  __builtin_amdgcn_global_load_lds((const unsigned*)g, (unsigned*)l, 16, 0, 0);
}
DI void wait_vm0() { asm volatile("s_waitcnt vmcnt(0)" ::: "memory"); }
DI f4 mfma16(h8 a, h8 b, f4 c) { return __builtin_amdgcn_mfma_f32_16x16x32_f16(a, b, c, 0, 0, 0); }
DI f16v mfma32(h8 a, h8 b, f16v c) { return __builtin_amdgcn_mfma_f32_32x32x16_f16(a, b, c, 0, 0, 0); }
DI unsigned pk2(float a, float b) { fp16x2 r = __builtin_amdgcn_cvt_pkrtz(a, b); return __builtin_bit_cast(unsigned, r); }
DI float sigmoidf_(float x) { return 1.f / (1.f + __expf(-x)); }
DI float gelu_tanh(float x) {
  float u = 0.7978845608028654f * (x + 0.044715f * x * x * x);
  float e = __expf(2.f * u);
  float t = 1.f - 2.f / (e + 1.f);
  return 0.5f * x * (1.f + t);
}
DI int row_mod(int r) { return r < TC ? 8 : ((r - TC) >> 13); }

DI void transpose_tile4(const float* src, int lds_, half_t* dst, int ldd, float* tile) {
  const int tid = TIDX;
  {
    const int k0 = tid >> 6, c4 = tid & 63;
    const float* sp = src + (size_t)k0 * lds_ + c4 * 4;
    float* tp = tile + (c4 >> 4) * 4352 + k0 * 68 + (c4 & 15) * 4;
#pragma unroll
    for (int i = 0; i < 16; i++) *(float4*)(tp + i * 4 * 68) = *(const float4*)(sp + (size_t)i * 4 * lds_);
  }
  __syncthreads();
#pragma unroll
  for (int i = 0; i < 8; i++) {
    int idx = i * 256 + tid, j = idx >> 9, r = idx & 511, kc = r >> 6, n = r & 63;
    const float* t = tile + j * 4352 + kc * 8 * 68 + n;
    h8 o;
#pragma unroll
    for (int u = 0; u < 8; u++) o[u] = (half_t)t[u * 68];
    *(h8*)(dst + (size_t)(j * 64 + n) * ldd + kc * 8) = o;
  }
  __syncthreads();
}

DI void phase0(const Params& P, char* smem) {
  float* tile = (float*)smem;
  const int tid = TIDX;
  constexpr int NT = 6528, NF = 128, NM = 192, NX = 6;
  for (int t = blockIdx.x; t < NT + NF + NM + NX; t += gridDim.x) {
    if (t < NT) {
      const float* src; half_t* dst; int lds_, ldd;
      if (t < 256) {
        int l = t / 128, r = t % 128, kt = r / 8, nt = (r % 8) * 4;
        src = P.w_in + (size_t)l * 1024 * 2304 + (size_t)kt * 64 * 2304 + 256 + nt * 64; lds_ = 2304;
        dst = P.WtIn + (size_t)l * NIN * 1024 + (size_t)(512 + nt * 64) * 1024 + kt * 64; ldd = 1024;
      } else if (t < 384) {
        int u = t - 256, l = u / 64, r = u % 64, kt = r / 4, nt = (r % 4) * 4;
        src = P.w_out + (size_t)l * 1048576 + (size_t)kt * 64 * 1024 + nt * 64; lds_ = 1024;
        dst = P.WtOut + (size_t)l * 1048576 + (size_t)nt * 64 * 1024 + kt * 64; ldd = 1024;
      } else if (t < 384 + 4096) {
        int u = t - 384; const float* w = P.w1; half_t* o = P.Wt1;
        if (u >= 2048) { u -= 2048; w = P.w3; o = P.Wt3; }
        int le = u / 32, r = u % 32, kt = r / 2, nt = (r % 2) * 4;
        src = w + (size_t)le * 524288 + (size_t)kt * 64 * 512 + nt * 64; lds_ = 512;
        dst = o + (size_t)le * 524288 + (size_t)nt * 64 * 1024 + kt * 64; ldd = 1024;
      } else {
        int u = t - 384 - 4096, le = u / 32, r = u % 32, kt = r / 4, nt = (r % 4) * 4;
        src = P.w2 + (size_t)le * 524288 + (size_t)kt * 64 * 1024 + nt * 64; lds_ = 1024;
        dst = P.Wt2 + (size_t)le * 524288 + (size_t)nt * 64 * 512 + kt * 64; ldd = 512;
      }
      transpose_tile4(src, lds_, dst, ldd, tile);
    } else if (t < NT + NF) {
      int f = t - NT, l = f / 64, r = f % 64, kt = r / 4, g = r % 4;
      float* cst = tile + 64 * 65; float* snt = cst + 64;
      const float* src = P.w_in + (size_t)l * 1024 * 2304 + (size_t)kt * 64 * 2304 + g * 64;
      { int n = tid & 63, kq = tid >> 6;
        for (int i = 0; i < 16; i++) { int k = i * 4 + kq; tile[k * 65 + n] = src[(size_t)k * 2304 + n]; } }
      if (tid < 64) { float s, c; sincospif((float)tid / 32.f, &s, &c); cst[tid] = c; snt[tid] = s; }
      __syncthreads();
      int k = tid & 63, jq = tid >> 6;
      half_t* o = P.WtIn + (size_t)l * NIN * 1024 + kt * 64 + k;
      for (int jj = 0; jj < 16; jj++) {
        int j = jq * 16 + jj; float ac = 0.f, as = 0.f;
        for (int c = 0; c < 64; c++) { float v = tile[k * 65 + c]; int idx = (c * j) & 63; ac += v * cst[idx]; as += v * snt[idx]; }
        o[(size_t)(g * 64 + j) * 1024] = (half_t)(ac * 0.125f);
        o[(size_t)(256 + g * 64 + j) * 1024] = (half_t)(-as * 0.125f);
      }
      __syncthreads();
    } else if (t < NT + NF + NM) {
      int mi = t - NT - NF, l = mi / 96, col0 = (mi % 96) * 64;
      float* scond = tile; float* red = tile + 9216;
      for (int idx = tid; idx < 9216; idx += 256) {
        int n = idx >> 10, k = idx & 1023; float v = n < 8 ? P.c[n * 1024 + k] : P.c_ctx[k];
        scond[idx] = v / (1.f + expf(-v));
      }
      __syncthreads();
      int col = tid & 63, kq = tid >> 6; float acc[9];
#pragma unroll
      for (int n = 0; n < 9; n++) acc[n] = 0.f;
      const float* w = P.w_mod + ((size_t)l * 1024 + kq * 256) * 6144 + col0 + col;
#pragma unroll 16
      for (int k = 0; k < 256; k++) {
        float wv = w[(size_t)k * 6144];
#pragma unroll
        for (int n = 0; n < 9; n++) acc[n] += scond[n * 1024 + kq * 256 + k] * wv;
      }
#pragma unroll
      for (int n = 0; n < 9; n++) red[(kq * 9 + n) * 64 + col] = acc[n];
      __syncthreads();
      for (int idx = tid; idx < 576; idx += 256) {
        int n = idx / 64, cc = idx % 64;
        float s = red[(0 * 9 + n) * 64 + cc] + red[(1 * 9 + n) * 64 + cc] + red[(2 * 9 + n) * 64 + cc] + red[(3 * 9 + n) * 64 + cc];
        P.mod[(size_t)(l * 9 + n) * 6144 + col0 + cc] = s + P.b_mod[l * 6144 + col0 + cc];
      }
      __syncthreads();
    } else {
      int m = t - NT - NF - NM;
      if (m == 0) {
        for (int idx = tid; idx < 128 * 16; idx += 256) {
          int pos = idx >> 4, i = idx & 15; float f = powf(10000.f, -(float)i / 16.f); float ang = (float)pos * f;
          float s, c; sincosf(ang, &s, &c); P.rope[idx] = make_float2(c, s);
        }
      } else if (m == 1) {
        for (int j = tid; j < 8192; j += 256) { float s, c; sincospif((float)j / 4096.f, &s, &c); P.tw[j] = make_float2(c, s); }
      } else if (m == 2) {
        for (int idx = tid; idx < 16384; idx += 256) {
          int mm = idx >> 7, k = idx & 127, part = mm >> 6, f1 = mm & 63, pp = k >> 6, a = k & 63;
          float s, c; sincospif((float)((a * f1) & 63) / 32.f, &s, &c);
          float v = part == 0 ? (pp == 0 ? c : s) : (pp == 0 ? -s : c);
          P.DA[idx] = (half_t)(v * 0.125f);
        }
      } else if (m == 3) {
        for (int idx = tid; idx < 32768; idx += 256) {
          int mm = idx >> 8, k = idx & 255, part = k >> 7, bb = k & 127;
          float s, c; sincospif((float)((bb * mm) & 127) / 64.f, &s, &c);
          P.DB[idx] = (half_t)((part == 0 ? c : s) * 0.08838834764831845f);
        }
      } else if (m == 4) {
        for (int idx = tid; idx < 131072; idx += 256) {
          int mm = idx >> 9, k = idx & 511, part = k >> 8, tt = k & 255;
          float s, c; sincospif((float)((tt * mm) & 255) / 128.f, &s, &c);
          P.DC[idx] = (half_t)((part == 0 ? c : s) * 0.0625f);
        }
      } else {
        for (int idx = tid; idx < 2 * 48 * 1024; idx += 256) {
          int l = idx / 49152, r = idx % 49152, col = r >> 10, k = r & 1023;
          float w = col < 4 ? P.w_group[((size_t)l * 1024 + k) * 4 + col] : (col < 36 ? P.w_router[((size_t)l * 1024 + k) * 32 + col - 4] : 0.f);
          half_t hi = (half_t)w, lo = (half_t)(w - (float)hi);
          P.WrH[(size_t)(l * 2) * 49152 + r] = hi; P.WrH[(size_t)(l * 2 + 1) * 49152 + r] = lo;
        }
        if (tid < 2) {
          int l = tid; float s1 = 0.f, s2 = 0.f, mq = 0.f, mk = 0.f;
          for (int i = 0; i < 64; i++) {
            s1 += P.lq1[l * 64 + i] * P.lk1[l * 64 + i]; s2 += P.lq2[l * 64 + i] * P.lk2[l * 64 + i];
            mq = fmaxf(mq, fabsf(P.q_norm_g[l * 64 + i])); mk = fmaxf(mk, fabsf(P.k_norm_g[l * 64 + i]));
          }
          float lam_init = 0.8f - 0.6f * expf(-0.3f * (float)l);
          P.consts[l * 4 + 0] = expf(s1) - expf(s2) + lam_init;
          P.consts[l * 4 + 1] = 8.f * mq * mk * 1.4426950408889634f * 1.002f - 15.f;
          P.consts[l * 4 + 2] = lam_init;
        }
        if (tid < 64) P.cnt[tid] = 0;
        if (tid < 64) P.qctr[tid] = 0;
      }
    }
  }
}

DI void row1_phase(const Params& P, int combine_l, int norm_l, int r_begin) {
  const int lane = TIDX & 63, gw = blockIdx.x * 4 + (TIDX >> 6), nw = gridDim.x * 4;
  auto load_row = [&](int r, float4 (&xv)[4], h4 (&ya)[4], h4 (&yb)[4]) {
    if (combine_l < 0) {
      const float* src = r < TC ? P.ctx + (size_t)r * D : P.x + (size_t)(r - TC) * D;
#pragma unroll
      for (int i = 0; i < 4; i++) xv[i] = *(const float4*)(src + i * 256 + lane * 4);
    } else {
      const float* xm = r < TC ? P.xcbuf + (size_t)r * D : P.out + (size_t)(r - TC) * D;
      const half_t* y0 = P.yA + (size_t)(2 * r) * D; const half_t* y1 = y0 + D;
#pragma unroll
      for (int i = 0; i < 4; i++) { int c = i * 256 + lane * 4; xv[i] = *(const float4*)(xm + c); ya[i] = *(const h4*)(y0 + c); yb[i] = *(const h4*)(y1 + c); }
    }
  };
  auto process = [&](int r, float4 (&xv)[4], h4 (&ya)[4], h4 (&yb)[4]) {
    const int n = row_mod(r);
    if (combine_l >= 0) {
      float* xm = r < TC ? P.xcbuf + (size_t)r * D : P.out + (size_t)(r - TC) * D;
      const float* g2 = P.mod + (size_t)(combine_l * 9 + n) * 6144 + 5 * 1024;
#pragma unroll
      for (int i = 0; i < 4; i++) {
        int c = i * 256 + lane * 4;
        float4 g = *(const float4*)(g2 + c); float4 t = xv[i];
        t.x += g.x * ((float)ya[i][0] + (float)yb[i][0]); t.y += g.y * ((float)ya[i][1] + (float)yb[i][1]);
        t.z += g.z * ((float)ya[i][2] + (float)yb[i][2]); t.w += g.w * ((float)ya[i][3] + (float)yb[i][3]);
        *(float4*)(xm + c) = t; xv[i] = t;
      }
    }
    if (norm_l >= 0) {
      float ss = 0.f;
#pragma unroll
      for (int i = 0; i < 4; i++) ss += xv[i].x * xv[i].x + xv[i].y * xv[i].y + xv[i].z * xv[i].z + xv[i].w * xv[i].w;
      ss = wave_sum(ss);
      const float rstd = rsqrtf(ss * (1.f / 1024.f) + EPS);
      const float* g = P.norm1_g + norm_l * 1024;
      const float* sh = P.mod + (size_t)(norm_l * 9 + n) * 6144; const float* sc = sh + 1024;
#pragma unroll
      for (int i = 0; i < 4; i++) {
        int c = i * 256 + lane * 4;
        float4 gg = *(const float4*)(g + c), s1 = *(const float4*)(sc + c), s0 = *(const float4*)(sh + c);
        h4 o;
        o[0] = (half_t)(xv[i].x * rstd * gg.x * (1.f + s1.x) + s0.x); o[1] = (half_t)(xv[i].y * rstd * gg.y * (1.f + s1.y) + s0.y);
        o[2] = (half_t)(xv[i].z * rstd * gg.z * (1.f + s1.z) + s0.z); o[3] = (half_t)(xv[i].w * rstd * gg.w * (1.f + s1.w) + s0.w);
        *(h4*)(P.hx + (size_t)r * D + c) = o;
      }
    }
  };
#pragma unroll 1
  for (int r = r_begin + gw; r < TA; r += 4 * nw) {
    float4 x0[4], x1[4], x2[4], x3[4]; h4 a0[4], b0[4], a1[4], b1[4], a2[4], b2[4], a3[4], b3[4];
    const int r1 = r + nw, r2 = r + 2 * nw, r3 = r + 3 * nw;
    load_row(r, x0, a0, b0);
    if (r1 < TA) load_row(r1, x1, a1, b1);
    if (r2 < TA) load_row(r2, x2, a2, b2);
    if (r3 < TA) load_row(r3, x3, a3, b3);
    process(r, x0, a0, b0);
    if (r1 < TA) process(r1, x1, a1, b1);
    if (r2 < TA) process(r2, x2, a2, b2);
    if (r3 < TA) process(r3, x3, a3, b3);
  }
}

DI void row2_phase(const Params& P, int l, int r_begin, char* smem) {
  const int tid = TIDX, lane = tid & 63, wave = tid >> 6, fr = lane & 15, fq = lane >> 4;
  float* lg = (float*)smem + wave * 16 * 48;
  const half_t* Whi = P.WrH + (size_t)(l * 2) * 49152; const half_t* Wlo = Whi + 49152;
  const int ngroups = (TA - r_begin) >> 4, gw = blockIdx.x * 4 + wave, nw = gridDim.x * 4;
  const float* gam = P.norm2_g + l * 1024;
#pragma unroll 1
  for (int grp = gw; grp < ngroups; grp += nw) {
    const int r0 = r_begin + grp * 16, row = r0 + fr, n = row_mod(r0);
    const float* xm = (row < TC ? P.xcbuf + (size_t)row * D : P.out + (size_t)(row - TC) * D) + fq * 8;
    float ss = 0.f;
#pragma unroll 16
    for (int kk = 0; kk < 32; kk++) {
      const float4 a = *(const float4*)(xm + kk * 32), b = *(const float4*)(xm + kk * 32 + 4);
      ss += a.x * a.x + a.y * a.y + a.z * a.z + a.w * a.w + b.x * b.x + b.y * b.y + b.z * b.z + b.w * b.w;
    }
    ss += shx(ss, 16); ss += shx(ss, 32);
    const float rstd = rsqrtf(ss * (1.f / 1024.f) + EPS);
    const float* sh = P.mod + (size_t)(l * 9 + n) * 6144 + 3 * 1024 + fq * 8; const float* sc = sh + 1024;
    f4 acc[3];
#pragma unroll
    for (int i = 0; i < 3; i++) acc[i] = (f4){0.f, 0.f, 0.f, 0.f};
    half_t* hxo = P.hx + (size_t)row * D + fq * 8;
#pragma unroll 4
    for (int kk = 0; kk < 32; kk++) {
      const int k0 = kk * 32;
      float x[8], g[8], s1[8], s0[8];
      *(float4*)&x[0] = *(const float4*)(xm + k0); *(float4*)&x[4] = *(const float4*)(xm + k0 + 4);
      *(float4*)&g[0] = *(const float4*)(gam + fq * 8 + k0); *(float4*)&g[4] = *(const float4*)(gam + fq * 8 + k0 + 4);
      *(float4*)&s1[0] = *(const float4*)(sc + k0); *(float4*)&s1[4] = *(const float4*)(sc + k0 + 4);
      *(float4*)&s0[0] = *(const float4*)(sh + k0); *(float4*)&s0[4] = *(const float4*)(sh + k0 + 4);
      h8 hi, lo;
#pragma unroll
      for (int i = 0; i < 8; i++) {
        float v = x[i] * rstd * g[i] * (1.f + s1[i]) + s0[i];
        hi[i] = (half_t)v; lo[i] = (half_t)(v - (float)hi[i]);
      }
      *(h8*)(hxo + k0) = hi;
#pragma unroll
      for (int n3 = 0; n3 < 3; n3++) {
        h8 bh = *(const h8*)(Whi + (size_t)(n3 * 16 + fr) * 1024 + k0 + fq * 8);
        h8 bl = *(const h8*)(Wlo + (size_t)(n3 * 16 + fr) * 1024 + k0 + fq * 8);
        acc[n3] = mfma16(hi, bh, acc[n3]); acc[n3] = mfma16(lo, bh, acc[n3]); acc[n3] = mfma16(hi, bl, acc[n3]);
      }
    }
    __builtin_amdgcn_wave_barrier();
#pragma unroll
    for (int n3 = 0; n3 < 3; n3++)
#pragma unroll
      for (int j = 0; j < 4; j++) lg[(fq * 4 + j) * 48 + n3 * 16 + fr] = acc[n3][j];
    __builtin_amdgcn_wave_barrier();
    if (lane < 16) {
      const int r = r0 + lane;
      const float* L = lg + lane * 48;
      float gl[4]; int gi = 0;
#pragma unroll
      for (int j = 0; j < 4; j++) gl[j] = L[j] + P.b_group[l * 4 + j];
      float gm = gl[0];
#pragma unroll
      for (int j = 1; j < 4; j++) if (gl[j] > gm) { gm = gl[j]; gi = j; }
      float gs = 0.f;
#pragma unroll
      for (int j = 0; j < 4; j++) gs += expf(gl[j] - gm);
      const float pg = 1.f / gs;
      float el[8];
#pragma unroll
      for (int j = 0; j < 8; j++) el[j] = L[4 + gi * 8 + j] + P.b_router[l * 32 + gi * 8 + j];
      int i0 = 0; float v0 = el[0];
#pragma unroll
      for (int j = 1; j < 8; j++) if (el[j] > v0) { v0 = el[j]; i0 = j; }
      int i1 = -1; float v1 = -3.0e38f;
#pragma unroll
      for (int j = 0; j < 8; j++) if (j != i0 && el[j] > v1) { v1 = el[j]; i1 = j; }
      const float ex = expf(v1 - v0);
      const float w0 = pg / (1.f + ex), w1 = pg * ex / (1.f + ex);
      const int e0 = gi * 8 + i0, e1 = gi * 8 + i1;
      int p0 = atomicAdd(&P.cnt[l * 32 + e0], 1); P.list[(size_t)e0 * LCAP + p0] = 2 * r; P.listW[(size_t)e0 * LCAP + p0] = w0;
      int p1 = atomicAdd(&P.cnt[l * 32 + e1], 1); P.list[(size_t)e1 * LCAP + p1] = 2 * r + 1; P.listW[(size_t)e1 * LCAP + p1] = w1;
    }
    __builtin_amdgcn_wave_barrier();
  }
}

DI h8 lds128(unsigned a) { h8 r; asm volatile("ds_read_b128 %0, %1" : "=v"(r) : "v"(a)); return r; }
DI void tie(h8& x) { asm volatile("" : "+v"(x)); }
DI unsigned lds_addr(const void* p) { return (unsigned)(size_t)p; }
#define WAIT_LGKM(n) asm volatile("s_waitcnt lgkmcnt(" #n ")" ::: "memory")
DI void raw_barrier() { asm volatile("" ::: "memory"); __builtin_amdgcn_s_barrier(); asm volatile("" ::: "memory"); }
DI void slot_rc(int i, int& row, int& coff) { int s = i * 256 + TIDX; row = s >> 3; coff = ((s & 7) ^ ((row >> 1) & 7)) * 8; }

template <class AF, class BF>
DI void gemm_prologue(AF aptr, BF bptr, int nk, char* smem) {
  const int tid = TIDX;
#pragma unroll
  for (int st = 0; st < 2; st++) {
    if (st < nk) {
      char* d = smem + st * 49152 + tid * 16;
#pragma unroll
      for (int i = 0; i < 8; i++) glds16(aptr(i) + st * 64, d + i * 4096);
#pragma unroll
      for (int i = 0; i < 4; i++) glds16(bptr(i) + st * 64, d + 32768 + i * 4096);
    }
  }
}
template <bool PRE = false, class AF, class BF>
DI void gemm256(AF aptr, BF bptr, int nk, char* smem, f4 (&acc)[8][4]) {
  const int tid = TIDX, lane = tid & 63, wave = tid >> 6, fr = lane & 15, fq = lane >> 4, wr = wave >> 1, wc = wave & 1;
#pragma unroll
  for (int m = 0; m < 8; m++)
#pragma unroll
    for (int n = 0; n < 4; n++) acc[m][n] = (f4){0.f, 0.f, 0.f, 0.f};
  auto issue = [&](int kt, int st) {
    char* d = smem + st * 49152 + tid * 16;
#pragma unroll
    for (int i = 0; i < 8; i++) glds16(aptr(i) + kt * 64, d + i * 4096);
#pragma unroll
    for (int i = 0; i < 4; i++) glds16(bptr(i) + kt * 64, d + 32768 + i * 4096);
  };
  const unsigned sw = (unsigned)((fq ^ (fr >> 1)) << 4);
  const unsigned offA = (wr * 128 + fr) * 128 + sw, offB = 32768 + (wc * 64 + fr) * 128 + sw;
  const unsigned sbase = lds_addr(smem);
  if (!PRE) { issue(0, 0); if (nk > 1) issue(1, 1); }
  int st = 0;
#pragma unroll 1
  for (int kt = 0; kt < nk; kt++) {
    if (kt + 1 < nk) asm volatile("s_waitcnt vmcnt(12)" ::: "memory"); else wait_vm0();
    raw_barrier();
    if (kt + 2 < nk) issue(kt + 2, st == 0 ? 2 : st - 1);
    const unsigned base = sbase + st * 49152;
    st = st == 2 ? 0 : st + 1;
    h8 a0[8], b0[4], a1[8], b1[4];
#pragma unroll
    for (int m = 0; m < 8; m++) a0[m] = lds128(base + offA + m * 2048);
#pragma unroll
    for (int n = 0; n < 4; n++) b0[n] = lds128(base + offB + n * 2048);
#pragma unroll
    for (int m = 0; m < 8; m++) a1[m] = lds128(base + (offA ^ 64) + m * 2048);
#pragma unroll
    for (int n = 0; n < 4; n++) b1[n] = lds128(base + (offB ^ 64) + n * 2048);
    WAIT_LGKM(12);
#pragma unroll
    for (int m = 0; m < 8; m++) tie(a0[m]);
#pragma unroll
    for (int n = 0; n < 4; n++) tie(b0[n]);
#pragma unroll
    for (int m = 0; m < 8; m++)
#pragma unroll
      for (int n = 0; n < 4; n++) acc[m][n] = mfma16(a0[m], b0[n], acc[m][n]);
    WAIT_LGKM(0);
#pragma unroll
    for (int m = 0; m < 8; m++) tie(a1[m]);
#pragma unroll
    for (int n = 0; n < 4; n++) tie(b1[n]);
#pragma unroll
    for (int m = 0; m < 8; m++)
#pragma unroll
      for (int n = 0; n < 4; n++) acc[m][n] = mfma16(a1[m], b1[n], acc[m][n]);
  }
  raw_barrier();
}
DI bool xcd_tile(int it, int MT, int NT, int& mt, int& nt) {
  const int x = blockIdx.x & 7, j = blockIdx.x >> 3;
  const int nsn = NT >> 2, nsm = (MT + 7) >> 3;
  const int s = x + 8 * it;
  if (s >= nsm * nsn) return false;
  const int sm = s / nsn, sn = s % nsn;
  mt = sm * 8 + (j >> 2); nt = sn * 4 + (j & 3);
  return true;
}
DI bool next_tile(int& it, int MT, int NT, int& mt, int& nt) {
  for (;; it++) {
    if (!xcd_tile(it, MT, NT, mt, nt)) return false;
    if (mt < MT) return true;
  }
}
DI int slot_col() { int t = TIDX; return ((t & 7) ^ ((t >> 4) & 7)) * 8; }

DI float dpp_row_sum(float v) {
  v += __builtin_bit_cast(float, __builtin_amdgcn_update_dpp(0, __builtin_bit_cast(int, v), 0x128, 0xf, 0xf, false));
  v += __builtin_bit_cast(float, __builtin_amdgcn_update_dpp(0, __builtin_bit_cast(int, v), 0x124, 0xf, 0xf, false));
  v += __builtin_bit_cast(float, __builtin_amdgcn_update_dpp(0, __builtin_bit_cast(int, v), 0x122, 0xf, 0xf, false));
  v += __builtin_bit_cast(float, __builtin_amdgcn_update_dpp(0, __builtin_bit_cast(int, v), 0x121, 0xf, 0xf, false));
  return v;
}
DI void stage_put(char* stg, int ml, int n, int j, int fr, int fq, float v) { *(half_t*)(stg + (ml * 16 + fq * 4 + j) * 144 + (n * 16 + fr) * 2) = (half_t)v; }
template <class RP, class SC>
DI void stage_flush(char* stg, int h, RP rowptr, SC rowscale) {
  const int lane = TIDX & 63;
  __builtin_amdgcn_wave_barrier();
#pragma unroll
  for (int i = 0; i < 8; i++) {
    const int c = i * 64 + lane, row = c >> 3, c16 = c & 7;
    h8 v = *(const h8*)(stg + row * 144 + c16 * 16);
    half_t* d = rowptr(h * 64 + row);
    if (d) { rowscale(h * 64 + row, v); *(h8*)(d + c16 * 8) = v; }
  }
  __builtin_amdgcn_wave_barrier();
}
template <class VF, class RP, class SC>
DI void wave_store_tile(VF val, char* stg, RP rowptr, SC rowscale) {
  const int lane = TIDX & 63, fr = lane & 15, fq = lane >> 4;
#pragma unroll
  for (int h = 0; h < 2; h++) {
#pragma unroll
    for (int ml = 0; ml < 4; ml++)
#pragma unroll
      for (int n = 0; n < 4; n++)
#pragma unroll
        for (int j = 0; j < 4; j++) stage_put(stg, ml, n, j, fr, fq, val(h * 4 + ml, n, j));
    stage_flush(stg, h, rowptr, rowscale);
  }
}
DI void gemm_in_phase(const Params& P, int l, char* smem) {
  const int tid = TIDX;
  const half_t* Wt = P.WtIn + (size_t)l * NIN * 1024;
  const int sc = slot_col(), srow = tid >> 3;
  {
    float2* rcl = (float2*)(smem + 147456);
    for (int i = tid; i < 1024; i += 256) rcl[i] = P.rope[i];
    __syncthreads();
  }
  int it = 0, mt, nt;
  bool have = next_tile(it, 264, 20, mt, nt);
  const half_t* a0 = nullptr; const half_t* b0 = nullptr;
  if (have) {
    asm volatile("" : "+s"(mt), "+s"(nt));
    a0 = P.hx + (size_t)(mt * 256 + srow) * D + sc; b0 = Wt + (size_t)(nt * 128 + srow) * D + sc;
    gemm_prologue([&](int i) { return a0 + (size_t)i * 32 * D; }, [&](int i) { return b0 + (size_t)i * 32 * D; }, 16, smem);
  }
#pragma unroll 1
  while (have) {
    f4 acc[8][4];
    gemm256<true>([&](int i) { return a0 + (size_t)i * 32 * D; }, [&](int i) { return b0 + (size_t)i * 32 * D; }, 16, smem, acc);
    const int tid2 = TIDX, lane = tid2 & 63, wave = tid2 >> 6, fr = lane & 15, fq = lane >> 4, wr = wave >> 1, wc = wave & 1;
    const int r0 = mt * 256 + wr * 128;
    const bool isctx = r0 < TC;
    int b, pos0;
    if (isctx) { b = r0 >> 8; pos0 = r0 & 255; } else { b = (r0 - TC) >> 13; pos0 = 256 + ((r0 - TC) & 8191); }
    const bool isqk = nt >= 4 && nt < 12;
    float gg[4] = {0.f, 0.f, 0.f, 0.f}; float2 rr2[2] = {make_float2(1.f, 0.f), make_float2(1.f, 0.f)};
    if (isqk) {
      const float* gvec = (nt < 8 ? P.q_norm_g : P.k_norm_g) + l * 64;
      const float qs = nt < 8 ? 0.125f * 1.4426950408889634f : 1.f;
#pragma unroll
      for (int n = 0; n < 4; n++) gg[n] = gvec[n * 16 + fr] * qs;
      if (!isctx) { const int tp0 = pos0 - 256; rr2[0] = P.rope[(tp0 >> 6) * 16 + fr]; rr2[1] = P.rope[((tp0 >> 6) + 1) * 16 + fr]; }
    }
#pragma unroll
    for (int n = 0; n < 4; n++) asm volatile("" : "+v"(gg[n]));
    asm volatile("" : "+v"(rr2[0].x), "+v"(rr2[0].y), "+v"(rr2[1].x), "+v"(rr2[1].y));
    int it2 = it + 1, mt2, nt2;
    const bool have2 = next_tile(it2, 264, 20, mt2, nt2);
    const half_t* a1 = a0; const half_t* b1 = b0;
    if (have2) {
      asm volatile("" : "+s"(mt2), "+s"(nt2));
      a1 = P.hx + (size_t)(mt2 * 256 + srow) * D + sc; b1 = Wt + (size_t)(nt2 * 128 + srow) * D + sc;
      gemm_prologue([&](int i) { return a1 + (size_t)i * 32 * D; }, [&](int i) { return b1 + (size_t)i * 32 * D; }, 16, smem);
    }
    char* stg = smem + 98304 + wave * 12288;
    auto noscale = [](int, h8&) {};
    if (nt < 4 || nt >= 16) {
      half_t* dst; int ld, c0; bool gel = false;
      if (nt < 4) { dst = P.QF; ld = 512; c0 = nt * 128; }
      else if (nt < 18) { dst = P.gy; ld = 256; c0 = (nt - 16) * 128; gel = true; }
      else { dst = P.rr; ld = 256; c0 = (nt - 18) * 128; }
      half_t* base = dst + (size_t)r0 * ld + c0 + wc * 64;
      if (gel) wave_store_tile([&](int m, int n, int j) { return gelu_tanh(acc[m][n][j]); }, stg, [&](int r) { return base + (size_t)r * ld; }, noscale);
      else wave_store_tile([&](int m, int n, int j) { return acc[m][n][j]; }, stg, [&](int r) { return base + (size_t)r * ld; }, noscale);
    } else if (nt < 12) {
      const bool isq = nt < 8; const int head = isq ? nt - 4 : nt - 8;
      const float2* rcl = (const float2*)(smem + 147456);
      half_t* base = (isq ? P.q + (size_t)r0 * 512 : P.kall + ((size_t)b * KV + pos0) * 512) + head * 128 + wc * 64;
#pragma unroll
      for (int mh = 0; mh < 2; mh++) {
#pragma unroll
        for (int mm = 0; mm < 4; mm++) {
          const int m = mh * 4 + mm;
#pragma unroll
          for (int j = 0; j < 4; j++) {
            float ss = 0.f;
#pragma unroll
            for (int n = 0; n < 4; n++) ss += acc[m][n][j] * acc[m][n][j];
            ss = dpp_row_sum(ss);
            const float rstd = rsqrtf(ss * (1.f / 64.f) + EPS);
            float o[4];
#pragma unroll
            for (int n = 0; n < 4; n++) o[n] = acc[m][n][j] * rstd * gg[n];
            if (!isctx) {
              const float2 cr = rr2[mh], cc = rcl[(mm * 16 + fq * 4 + j) * 16 + fr];
              float a0 = o[0] * cr.x - o[1] * cr.y, a1 = o[1] * cr.x + o[0] * cr.y;
              float a2 = o[2] * cc.x - o[3] * cc.y, a3 = o[3] * cc.x + o[2] * cc.y;
              o[0] = a0; o[1] = a1; o[2] = a2; o[3] = a3;
            }
#pragma unroll
            for (int n = 0; n < 4; n++) stage_put(stg, mm, n, j, fr, fq, o[n]);
          }
        }
        stage_flush(stg, mh, [&](int r) { return base + (size_t)r * 512; }, noscale);
      }
    } else {
      const int head = nt - 12;
#pragma unroll
      for (int m = 0; m < 8; m++)
#pragma unroll
        for (int n = 0; n < 4; n++) {
          h4 o; o[0] = (half_t)acc[m][n][0]; o[1] = (half_t)acc[m][n][1]; o[2] = (half_t)acc[m][n][2]; o[3] = (half_t)acc[m][n][3];
          int d = wc * 64 + n * 16 + fr;
          asm volatile("" : "+v"(d) :: "memory");
          *(h4*)(P.vT + ((size_t)(b * 4 + head) * 128 + d) * KV + pos0 + m * 16 + fq * 4) = o;
        }
    }
    mt = mt2; nt = nt2; it = it2; have = have2; a0 = a1; b0 = b1;
  }
}

DI void gemm_out_phase(const Params& P, int l, char* smem) {
  const int tid = TIDX, lane = tid & 63, wave = tid >> 6, fr = lane & 15, fq = lane >> 4, wr = wave >> 1, wc = wave & 1;
  const half_t* Wt = P.WtOut + (size_t)l * 1048576;
  const int mt0 = l == 0 ? 0 : TC / 256;
  const int sc = slot_col(), srow = tid >> 3;
#pragma unroll 1
  for (int it = 0;; it++) {
    int mt, nt;
    if (!xcd_tile(it, 264 - mt0, 8, mt, nt)) break;
    mt += mt0;
    if (mt >= 264) continue;
    asm volatile("" : "+s"(mt), "+s"(nt));
    f4 acc[8][4];
    {
      const half_t* a0 = P.mix + (size_t)(mt * 256 + srow) * D + sc; const half_t* b0 = Wt + (size_t)(nt * 128 + srow) * D + sc;
      gemm256([&](int i) { return a0 + (size_t)i * 32 * D; }, [&](int i) { return b0 + (size_t)i * 32 * D; }, 16, smem, acc);
    }
    {
      const int tid2 = TIDX, lane2 = tid2 & 63, wave2 = tid2 >> 6, fr2 = lane2 & 15, fq2 = lane2 >> 4, wr2 = wave2 >> 1, wc2 = wave2 & 1;
      const int r0 = mt * 256 + wr2 * 128;
      const int n = row_mod(r0);
      const int cbase = nt * 128 + wc2 * 64;
      const float4 g4 = *(const float4*)(P.mod + (size_t)(l * 9 + n) * 6144 + 2 * 1024 + cbase + fr2 * 4);
      const float* res; float* dst;
      if (r0 < TC) { res = P.ctx + (size_t)r0 * D; dst = P.xcbuf + (size_t)r0 * D; }
      else { dst = P.out + (size_t)(r0 - TC) * D; res = l == 0 ? P.x + (size_t)(r0 - TC) * D : dst; }
      res += cbase + fr2 * 4; dst += cbase + fr2 * 4;
      float* stg = (float*)(smem + 98304 + wave2 * 12288);
#pragma unroll
      for (int q = 0; q < 4; q++) {
#pragma unroll
        for (int ml = 0; ml < 2; ml++)
#pragma unroll
          for (int nn = 0; nn < 4; nn++)
#pragma unroll
            for (int j = 0; j < 4; j++) stg[(ml * 16 + fq2 * 4 + j) * 68 + nn * 16 + fr2] = acc[q * 2 + ml][nn][j];
        __builtin_amdgcn_wave_barrier();
#pragma unroll
        for (int i = 0; i < 8; i++) {
          const int row = i * 4 + fq2;
          const float4 a = *(const float4*)(stg + row * 68 + fr2 * 4);
          const size_t o = (size_t)(q * 32 + row) * D;
          float4 r = *(const float4*)(res + o);
          r.x += g4.x * a.x; r.y += g4.y * a.y; r.z += g4.z * a.z; r.w += g4.w * a.w;
          *(float4*)(dst + o) = r;
        }
        __builtin_amdgcn_wave_barrier();
      }
    }
  }
}

DI void moe_prefix(const Params& P, int l, int* tb) {
  __syncthreads();
  if (TIDX == 0) { int s = 0; for (int e = 0; e < 32; e++) { tb[e] = s; s += (P.cnt[l * 32 + e] + 255) >> 8; } tb[32] = s; }
  __syncthreads();
}
DI void moe_e1_phase(const Params& P, int l, char* smem, int* tb) {
  const int tid = TIDX;
  moe_prefix(P, l, tb);
  const int sc = slot_col(), srow = tid >> 3;
  const int MT = tb[32];
  auto setup = [&](int rt, int nt, int (&tok)[8], const half_t*& w1, const half_t*& w3) {
    int e = 0;
    while (tb[e + 1] <= rt) e++;
    const int rl = rt - tb[e], cnt = P.cnt[l * 32 + e];
    const int* lst = P.list + (size_t)e * LCAP;
    w1 = P.Wt1 + ((size_t)(l * 32 + e) * 512 + nt * 64) * 1024 + sc;
    w3 = P.Wt3 + ((size_t)(l * 32 + e) * 512 + nt * 64) * 1024 + sc;
#pragma unroll
    for (int i = 0; i < 8; i++) tok[i] = lst[min(rl * 256 + i * 32 + srow, cnt - 1)] >> 1;
  };
  int it = 0, rt, nt;
  bool have = next_tile(it, MT, 8, rt, nt);
  int tok[8]; const half_t* w1 = nullptr; const half_t* w3 = nullptr;
  if (have) {
    asm volatile("" : "+s"(rt), "+s"(nt));
    setup(rt, nt, tok, w1, w3);
    gemm_prologue([&](int i) { return P.hx + (size_t)tok[i] * D + sc; }, [&](int i) { return ((i & 1) ? w3 : w1) + (size_t)((i >> 1) * 32 + srow) * 1024; }, 16, smem);
  }
#pragma unroll 1
  while (have) {
    f4 acc[8][4];
    gemm256<true>([&](int i) { return P.hx + (size_t)tok[i] * D + sc; },
                  [&](int i) { return ((i & 1) ? w3 : w1) + (size_t)((i >> 1) * 32 + srow) * 1024; }, 16, smem, acc);
    int it2 = it + 1, rt2, nt2;
    const bool have2 = next_tile(it2, MT, 8, rt2, nt2);
    int tok2[8]; const half_t* w1n = w1; const half_t* w3n = w3;
#pragma unroll
    for (int i = 0; i < 8; i++) tok2[i] = tok[i];
    if (have2) {
      asm volatile("" : "+s"(rt2), "+s"(nt2));
      setup(rt2, nt2, tok2, w1n, w3n);
      gemm_prologue([&](int i) { return P.hx + (size_t)tok2[i] * D + sc; }, [&](int i) { return ((i & 1) ? w3n : w1n) + (size_t)((i >> 1) * 32 + srow) * 1024; }, 16, smem);
    }
    {
      const int tid2 = TIDX, lane2 = tid2 & 63, wave2 = tid2 >> 6, fr2 = lane2 & 15, fq2 = lane2 >> 4, wr2 = wave2 >> 1, wc2 = wave2 & 1;
      char* stg = smem + 98304 + wave2 * 12288;
      half_t* Hd = P.H + ((size_t)rt * 256 + wr2 * 128) * 512 + nt * 64 + wc2 * 32;
#pragma unroll
      for (int h = 0; h < 2; h++) {
#pragma unroll
        for (int ml = 0; ml < 4; ml++)
#pragma unroll
          for (int n = 0; n < 2; n++)
#pragma unroll
            for (int j = 0; j < 4; j++) {
              float a1 = acc[h * 4 + ml][n][j], a3 = acc[h * 4 + ml][n + 2][j];
              *(half_t*)(stg + (ml * 16 + fq2 * 4 + j) * 80 + (n * 16 + fr2) * 2) = (half_t)(a1 * sigmoidf_(a1) * a3);
            }
        __builtin_amdgcn_wave_barrier();
#pragma unroll
        for (int i = 0; i < 4; i++) {
          const int c = i * 64 + lane2, row = c >> 2, c16 = c & 3;
          h8 v = *(const h8*)(stg + row * 80 + c16 * 16);
          *(h8*)(Hd + (size_t)(h * 64 + row) * 512 + c16 * 8) = v;
        }
        __builtin_amdgcn_wave_barrier();
      }
    }
    rt = rt2; nt = nt2; it = it2; have = have2; w1 = w1n; w3 = w3n;
#pragma unroll
    for (int i = 0; i < 8; i++) tok[i] = tok2[i];
  }
}
DI void moe_e2_phase(const Params& P, int l, char* smem, int* tb) {
  const int tid = TIDX;
  moe_prefix(P, l, tb);
  const int sc = slot_col(), srow = tid >> 3;
  const int MT = tb[32];
  auto ptrs = [&](int rt, int nt, const half_t*& a0, const half_t*& b0) {
    int e = 0;
    while (tb[e + 1] <= rt) e++;
    a0 = P.H + ((size_t)rt * 256 + srow) * 512 + sc;
    b0 = P.Wt2 + ((size_t)(l * 32 + e) * 1024 + nt * 128 + srow) * 512 + sc;
  };
  int it = 0, rt, nt;
  bool have = next_tile(it, MT, 8, rt, nt);
  const half_t* a0 = nullptr; const half_t* b0 = nullptr;
  if (have) {
    asm volatile("" : "+s"(rt), "+s"(nt));
    ptrs(rt, nt, a0, b0);
    gemm_prologue([&](int i) { return a0 + (size_t)i * 32 * 512; }, [&](int i) { return b0 + (size_t)i * 32 * 512; }, 8, smem);
  }
#pragma unroll 1
  while (have) {
    const int tid2 = TIDX, lane2 = tid2 & 63, wave2 = tid2 >> 6, wr2 = wave2 >> 1, wc2 = wave2 & 1;
    int e = 0;
    while (tb[e + 1] <= rt) e++;
    const int rl = rt - tb[e], cnt = P.cnt[l * 32 + e];
    const int* lst = P.list + (size_t)e * LCAP; const float* lstw = P.listW + (size_t)e * LCAP;
    int aa[2][8]; float ww[2][8];
#pragma unroll
    for (int h = 0; h < 2; h++)
#pragma unroll
      for (int i = 0; i < 8; i++) {
        const int idx = rl * 256 + wr2 * 128 + h * 64 + ((i * 64 + lane2) >> 3);
        const int ic = min(idx, cnt - 1);
        const int av = lst[ic]; const float wv = lstw[ic];
        aa[h][i] = idx < cnt ? av : -1; ww[h][i] = wv;
      }
    f4 acc[8][4];
    gemm256<true>([&](int i) { return a0 + (size_t)i * 32 * 512; }, [&](int i) { return b0 + (size_t)i * 32 * 512; }, 8, smem, acc);
    int it2 = it + 1, rt2, nt2;
    const bool have2 = next_tile(it2, MT, 8, rt2, nt2);
    const half_t* a1 = a0; const half_t* b1 = b0;
    if (have2) {
      asm volatile("" : "+s"(rt2), "+s"(nt2));
      ptrs(rt2, nt2, a1, b1);
      gemm_prologue([&](int i) { return a1 + (size_t)i * 32 * 512; }, [&](int i) { return b1 + (size_t)i * 32 * 512; }, 8, smem);
    }
    {
      char* stg = smem + 98304 + wave2 * 12288;
      const int fr2 = lane2 & 15, fq2 = lane2 >> 4;
#pragma unroll
      for (int h = 0; h < 2; h++) {
#pragma unroll
        for (int ml = 0; ml < 4; ml++)
#pragma unroll
          for (int n = 0; n < 4; n++)
#pragma unroll
            for (int j = 0; j < 4; j++) stage_put(stg, ml, n, j, fr2, fq2, acc[h * 4 + ml][n][j]);
        __builtin_amdgcn_wave_barrier();
#pragma unroll
        for (int i = 0; i < 8; i++) {
          const int c = i * 64 + lane2, row = c >> 3, c16 = c & 7;
          h8 v = *(const h8*)(stg + row * 144 + c16 * 16);
          if (aa[h][i] >= 0) {
            const float w = ww[h][i];
#pragma unroll
            for (int u = 0; u < 8; u++) v[u] = (half_t)(w * (float)v[u]);
            *(h8*)(P.yA + (size_t)aa[h][i] * D + nt * 128 + wc2 * 64 + c16 * 8) = v;
          }
        }
        __builtin_amdgcn_wave_barrier();
      }
    }
    rt = rt2; nt = nt2; it = it2; have = have2; a0 = a1; b0 = b1;
  }
}

DI int swap23(int x) { return (x & ~12) | ((x & 4) << 1) | ((x & 8) >> 1); }
DI void attn_item(const Params& P, int l, int b, int head, int row0, int nkeys, char* smem) {
  const int tid = TIDX, lane = tid & 63, wave = tid >> 6, ql = lane & 31, hh = lane >> 5;
  const float lam = P.consts[l * 4 + 0], negc = -P.consts[l * 4 + 1], lam_init = P.consts[l * 4 + 2];
  const int myrow = row0 + wave * 32 + ql;
  h8 qf[2][4];
  {
    const half_t* qp = P.q + (size_t)myrow * 512 + head * 128 + hh * 8;
#pragma unroll
    for (int m = 0; m < 2; m++)
#pragma unroll
      for (int s = 0; s < 4; s++) { qf[m][s] = *(const h8*)(qp + m * 64 + s * 16); }
#pragma unroll
    for (int m = 0; m < 2; m++)
#pragma unroll
      for (int s = 0; s < 4; s++) tie(qf[m][s]);
  }
  f16v o0[4], o1[4];
#pragma unroll
  for (int dt = 0; dt < 4; dt++)
#pragma unroll
    for (int i = 0; i < 16; i++) { o0[dt][i] = 0.f; o1[dt][i] = 0.f; }
  float ls0 = 0.f, ls1 = 0.f;
  const half_t* kp[4]; const half_t* vp[4];
  {
    const half_t* kbase = P.kall + (size_t)b * KV * 512 + head * 128;
    const half_t* vbase = P.vT + (size_t)(b * 4 + head) * 128 * KV;
#pragma unroll
    for (int i = 0; i < 4; i++) {
      int s = i * 256 + tid;
      int row = s >> 4, c = (s & 15) ^ (row & 15); kp[i] = kbase + (size_t)row * 512 + c * 8;
      int vr = s >> 3, vc = (s & 7) ^ ((vr >> 1) & 7); vp[i] = vbase + (size_t)vr * KV + vc * 8;
    }
  }
  const int ntile = nkeys >> 6;
  const unsigned sbase = lds_addr(smem);
  auto issue = [&](int t) {
    char* d = smem + (t & 3) * 32768 + tid * 16;
#pragma unroll
    for (int i = 0; i < 4; i++) { glds16(kp[i] + (size_t)t * 64 * 512, d + i * 4096); glds16(vp[i] + t * 64, d + 16384 + i * 4096); }
  };
  unsigned koff[2];
  const int kr_lo = swap23(ql), ksw = kr_lo & 15;
  koff[0] = kr_lo * 256; koff[1] = (32 + kr_lo) * 256;
  unsigned voff[4];
#pragma unroll
  for (int dt = 0; dt < 4; dt++) { int vrow = dt * 32 + ql; voff[dt] = 16384 + vrow * 128; }
  const int vsw = (ql >> 1) & 7;
  f16v negcv;
#pragma unroll
  for (int i = 0; i < 16; i++) negcv[i] = negc;
  h8 pp0[2], pp1[2];
  unsigned pendV = 0; int pendkt = 0; bool pend = false;
  auto half_step = [&](h8 (&kf)[8], unsigned cur, int kt) {
    h8 vf[8];
    if (pend) {
#pragma unroll
      for (int sp = 0; sp < 2; sp++)
#pragma unroll
        for (int dt = 0; dt < 4; dt++) vf[sp * 4 + dt] = lds128(pendV + voff[dt] + (((pendkt * 4 + sp * 2 + hh) ^ vsw) << 4));
    }
    f16v s0 = mfma32(kf[0], qf[0][0], negcv), s1 = mfma32(kf[4], qf[1][0], negcv);
#pragma unroll
    for (int st = 1; st < 4; st++) { s0 = mfma32(kf[st], qf[0][st], s0); s1 = mfma32(kf[4 + st], qf[1][st], s1); }
    if (pend) {
      WAIT_LGKM(0);
#pragma unroll
      for (int i = 0; i < 8; i++) tie(vf[i]);
#pragma unroll
      for (int sp = 0; sp < 2; sp++)
#pragma unroll
        for (int dt = 0; dt < 4; dt++) { o0[dt] = mfma32(vf[sp * 4 + dt], pp0[sp], o0[dt]); o1[dt] = mfma32(vf[sp * 4 + dt], pp1[sp], o1[dt]); }
    }
#pragma unroll
    for (int i = 0; i < 16; i++) { s0[i] = __builtin_amdgcn_exp2f(s0[i]); ls0 += s0[i]; s1[i] = __builtin_amdgcn_exp2f(s1[i]); ls1 += s1[i]; }
#pragma unroll
    for (int sp = 0; sp < 2; sp++) {
      u4 a, c;
      a[0] = pk2(s0[8*sp+0], s0[8*sp+1]); a[1] = pk2(s0[8*sp+2], s0[8*sp+3]); a[2] = pk2(s0[8*sp+4], s0[8*sp+5]); a[3] = pk2(s0[8*sp+6], s0[8*sp+7]);
      c[0] = pk2(s1[8*sp+0], s1[8*sp+1]); c[1] = pk2(s1[8*sp+2], s1[8*sp+3]); c[2] = pk2(s1[8*sp+4], s1[8*sp+5]); c[3] = pk2(s1[8*sp+6], s1[8*sp+7]);
      pp0[sp] = __builtin_bit_cast(h8, a); pp1[sp] = __builtin_bit_cast(h8, c);
    }
    pend = true; pendV = cur; pendkt = kt;
  };
  issue(0);
  if (ntile > 1) issue(1);
#pragma unroll 1
  for (int t = 0; t < ntile; t++) {
    if (t + 1 < ntile) asm volatile("s_waitcnt vmcnt(8)" ::: "memory"); else wait_vm0();
    raw_barrier();
    if (t + 2 < ntile) issue(t + 2);
    const unsigned cur = sbase + (t & 3) * 32768;
    h8 kfa[8], kfb[8];
#pragma unroll
    for (int st = 0; st < 4; st++) {
      kfa[st] = lds128(cur + koff[0] + (((st * 2 + hh) ^ ksw) << 4));
      kfa[4 + st] = lds128(cur + koff[0] + (((8 + st * 2 + hh) ^ ksw) << 4));
    }
#pragma unroll
    for (int st = 0; st < 4; st++) {
      kfb[st] = lds128(cur + koff[1] + (((st * 2 + hh) ^ ksw) << 4));
      kfb[4 + st] = lds128(cur + koff[1] + (((8 + st * 2 + hh) ^ ksw) << 4));
    }
    WAIT_LGKM(8);
#pragma unroll
    for (int i = 0; i < 8; i++) tie(kfa[i]);
    half_step(kfa, cur, 0);
    WAIT_LGKM(0);
#pragma unroll
    for (int i = 0; i < 8; i++) tie(kfb[i]);
    half_step(kfb, cur, 1);
  }
  {
    h8 vf[8];
#pragma unroll
    for (int sp = 0; sp < 2; sp++)
#pragma unroll
      for (int dt = 0; dt < 4; dt++) vf[sp * 4 + dt] = lds128(pendV + voff[dt] + (((pendkt * 4 + sp * 2 + hh) ^ vsw) << 4));
    WAIT_LGKM(0);
#pragma unroll
    for (int i = 0; i < 8; i++) tie(vf[i]);
#pragma unroll
    for (int sp = 0; sp < 2; sp++)
#pragma unroll
      for (int dt = 0; dt < 4; dt++) { o0[dt] = mfma32(vf[sp * 4 + dt], pp0[sp], o0[dt]); o1[dt] = mfma32(vf[sp * 4 + dt], pp1[sp], o1[dt]); }
  }
  raw_barrier();
  ls0 += shx(ls0, 32); ls1 += shx(ls1, 32);
  const float i0 = 1.f / ls0, i1 = lam / ls1;
  float ss = 0.f;
#pragma unroll
  for (int dt = 0; dt < 4; dt++)
#pragma unroll
    for (int i = 0; i < 16; i++) { float v = o0[dt][i] * i0 - o1[dt][i] * i1; o0[dt][i] = v; ss += v * v; }
  ss += shx(ss, 32);
  const float mult = rsqrtf(ss * (1.f / 128.f) + EPS) * (1.f - lam_init);
  const float* sg = P.subln_g + l * 128;
  half_t* dst = P.mix + (size_t)myrow * D + 256 + head * 128;
#pragma unroll
  for (int dt = 0; dt < 4; dt++)
#pragma unroll
    for (int g = 0; g < 4; g++) {
      const int d0 = dt * 32 + 8 * g + 4 * hh;
      float4 gv = *(const float4*)(sg + d0);
      h4 o; o[0] = (half_t)(o0[dt][4*g] * mult * gv.x); o[1] = (half_t)(o0[dt][4*g+1] * mult * gv.y);
      o[2] = (half_t)(o0[dt][4*g+2] * mult * gv.z); o[3] = (half_t)(o0[dt][4*g+3] * mult * gv.w);
      *(h4*)(dst + d0) = o;
    }
}

DI int swz128(int row, int colh) { return row * 128 + ((((colh >> 3)) ^ ((row >> 1) & 7)) << 4) + (colh & 7) * 2; }
DI void lru_load_w(const Params& P, int l, int g, char* Wt) {
  const int tid = TIDX;
  for (int dg = 0; dg < 4; dg++) {
    const int dir = dg >> 1;
    const float* w = ((dg & 1) ? P.gate_x_w : P.gate_a_w) + ((size_t)((l * 2 + dir) * 4 + g)) * 4096;
    for (int idx = tid; idx < 4096; idx += 256) { int i = idx >> 6, o = idx & 63; *(half_t*)(Wt + dg * 8192 + swz128(o, i)) = (half_t)w[idx]; }
  }
}
DI void lru_tile(const Params& P, int l, int b, int tile, int g, char* smem, bool final) {
  const int tid = TIDX, lane = tid & 63, wave = tid >> 6, fr = lane & 15, fq = lane >> 4;
  char* Wt = smem;
  char* xr16 = smem + 32768;
  float2* ab = (float2*)(smem + 40960);
  half_t* raw = (half_t*)(smem + 40960);
  float2* subst = (float2*)(smem + 73728);
  const int ch = tid & 63, tq = tid >> 6, gc = g * 64 + ch;
  const int T = tile < 4 ? CL : SEQ;
  const int t0 = tile < 4 ? tile * 64 : (tile - 4) * 64;
  const int rowbase = tile < 4 ? b * CL : TC + b * SEQ;
  unsigned* lab = (unsigned*)P.hx;
  __syncthreads();
  if (final) {
    float gyv[16], hsum[16];
#pragma unroll
    for (int e = 0; e < 16; e++) { gyv[e] = (float)P.gy[(size_t)(rowbase + t0 + tq * 16 + e) * 256 + gc]; hsum[e] = 0.f; }
#pragma unroll 1
    for (int dir = 0; dir < 2; dir++) {
      unsigned pk[16];
#pragma unroll
      for (int e = 0; e < 16; e++) pk[e] = lab[((size_t)dir * TA + rowbase + t0 + tq * 16 + e) * 256 + gc];
      float2 av[16];
      float A = 1.f, h = 0.f;
#pragma unroll
      for (int e = 0; e < 16; e++) {
        const int ee = dir == 0 ? e : 15 - e;
        unsigned u = pk[0];
#pragma unroll
        for (int q = 1; q < 16; q++) u = (q == ee) ? pk[q] : u;
        fp16x2 hv = __builtin_bit_cast(fp16x2, u);
        av[e] = make_float2(__expf((float)hv[0]), (float)hv[1]);
        h = av[e].x * h + av[e].y; A *= av[e].x;
      }
      subst[tq * 64 + ch] = make_float2(A, h);
      __syncthreads();
      h = P.lcar[((size_t)((b * 2 + dir) * 132 + tile)) * 256 + gc];
      if (dir == 0) { for (int s2 = 0; s2 < tq; s2++) { float2 ss = subst[s2 * 64 + ch]; h = ss.x * h + ss.y; } }
      else { for (int s2 = 3; s2 > tq; s2--) { float2 ss = subst[s2 * 64 + ch]; h = ss.x * h + ss.y; } }
#pragma unroll
      for (int e = 0; e < 16; e++) {
        const int ee = dir == 0 ? e : 15 - e;
        h = av[e].x * h + av[e].y;
#pragma unroll
        for (int q = 0; q < 16; q++) hsum[q] += (q == ee) ? h : 0.f;
      }
      __syncthreads();
    }
#pragma unroll
    for (int e = 0; e < 16; e++)
      P.mix[(size_t)(rowbase + t0 + tq * 16 + e) * D + 768 + gc] = (half_t)(gyv[e] * hsum[e]);
    return;
  }
  for (int idx = tid; idx < 67 * 8; idx += 256) {
    int row = idx >> 3, c = idx & 7, tt = t0 - 1 + row;
    h8 v = {0, 0, 0, 0, 0, 0, 0, 0};
    if (tt >= 0 && tt < T) v = *(const h8*)(P.rr + (size_t)(rowbase + tt) * 256 + g * 64 + c * 8);
    *(h8*)(raw + row * 64 + c * 8) = v;
  }
  const float cw0 = P.conv_w[(l * 4 + 0) * 256 + gc], cw1 = P.conv_w[(l * 4 + 1) * 256 + gc], cw2 = P.conv_w[(l * 4 + 2) * 256 + gc],
              cw3 = P.conv_w[(l * 4 + 3) * 256 + gc], cb = P.conv_b[l * 256 + gc];
  __syncthreads();
  {
    float v[19];
#pragma unroll
    for (int e = 0; e < 19; e++) v[e] = (float)raw[(tq * 16 + e) * 64 + ch];
    __syncthreads();
#pragma unroll
    for (int e = 0; e < 16; e++) {
      float xv = cb + cw0 * v[e] + cw1 * v[e + 1] + cw2 * v[e + 2] + cw3 * v[e + 3];
      *(half_t*)(xr16 + swz128(tq * 16 + e, ch)) = (half_t)xv;
    }
  }
  __syncthreads();
#pragma unroll 1
  for (int dir = 0; dir < 2; dir++) {
    {
      f4 acc[2][4];
#pragma unroll
      for (int gt = 0; gt < 2; gt++)
#pragma unroll
        for (int n = 0; n < 4; n++) acc[gt][n] = (f4){0.f, 0.f, 0.f, 0.f};
#pragma unroll
      for (int kk = 0; kk < 2; kk++) {
        int row = wave * 16 + fr;
        h8 af = *(const h8*)(xr16 + row * 128 + (((kk * 4 + fq) ^ ((row >> 1) & 7)) << 4));
#pragma unroll
        for (int gt = 0; gt < 2; gt++)
#pragma unroll
          for (int n = 0; n < 4; n++) {
            int orow = n * 16 + fr;
            h8 bf = *(const h8*)(Wt + (dir * 2 + gt) * 8192 + orow * 128 + (((kk * 4 + fq) ^ ((orow >> 1) & 7)) << 4));
            acc[gt][n] = mfma16(af, bf, acc[gt][n]);
          }
      }
#pragma unroll
      for (int n = 0; n < 4; n++) {
        const int cc = (l * 2 + dir) * 256 + g * 64 + n * 16 + fr;
        const float ba = P.gate_a_b[cc], bx = P.gate_x_b[cc];
        const float sp8 = -8.f * log1pf(__expf(-P.lru_lambda[cc]));
#pragma unroll
        for (int j = 0; j < 4; j++) {
          int tl = wave * 16 + fq * 4 + j, c2 = n * 16 + fr;
          float xv = (float)*(const half_t*)(xr16 + swz128(tl, c2));
          float rg = sigmoidf_(acc[0][n][j] + ba), ig = sigmoidf_(acc[1][n][j] + bx);
          float log_a = rg * sp8;
          float x2 = 2.f * log_a;
          float om = -x2 * (1.f + x2 * (0.5f + x2 * (0.16666667f + x2 * (0.041666668f + x2 * (0.008333334f + x2 * 0.0013888889f)))));
          if (x2 < -0.4f) { float a = __expf(log_a); om = 1.f - a * a; }
          ab[tl * 64 + c2] = make_float2(log_a, sqrtf(om) * (ig * xv));
        }
      }
    }
    __syncthreads();
    {
      float A = 1.f, h = 0.f;
#pragma unroll
      for (int e = 0; e < 16; e++) {
        const int ee = dir == 0 ? e : 15 - e;
        const float2 lb = ab[(tq * 16 + ee) * 64 + ch];
        fp16x2 hv; hv[0] = (__fp16)lb.x; hv[1] = (__fp16)lb.y;
        lab[((size_t)dir * TA + rowbase + t0 + tq * 16 + ee) * 256 + gc] = __builtin_bit_cast(unsigned, hv);
        const float a = __expf((float)hv[0]), bt = (float)hv[1];
        h = a * h + bt; A *= a;
      }
      subst[tq * 64 + ch] = make_float2(A, h);
    }
    __syncthreads();
    if (tq == 0) {
      float A = 1.f, h = 0.f;
#pragma unroll
      for (int s2 = 0; s2 < 4; s2++) { float2 ss = subst[(dir == 0 ? s2 : 3 - s2) * 64 + ch]; h = ss.x * h + ss.y; A *= ss.x; }
      P.lsum[((size_t)((b * 2 + dir) * 132 + tile)) * 256 + gc] = make_float2(A, h);
    }
    __syncthreads();
  }
}
DI void lru_carry_item(const Params& P, int it) {
  const int ch = TIDX, dir = it & 1;
  const size_t base = (size_t)it * 132 * 256 + ch;
  float c = 0.f;
#pragma unroll 4
  for (int k = 0; k < 132; k++) {
    int tile = dir == 0 ? k : (k < 4 ? 3 - k : 135 - k);
    float2 s = P.lsum[base + (size_t)tile * 256];
    P.lcar[base + (size_t)tile * 256] = c;
    c = s.x * c + s.y;
  }
}

DI void fft_load(const half_t* src, size_t rs, int nrows, char* Bt, int rowbytes, int k0) {
  for (int idx = TIDX; idx < nrows * 16; idx += 256) {
    int kr = idx >> 4, cc = idx & 15, k = k0 + kr;
    h8 v = *(const h8*)(src + (size_t)kr * rs + cc * 8);
#pragma unroll
    for (int u = 0; u < 8; u++) { int n = cc * 8 + u; *(half_t*)(Bt + n * rowbytes + ((((k >> 3)) ^ (n & 15)) << 4) + (k & 7) * 2) = v[u]; }
  }
}
template <class RF>
DI void fft_mma(const half_t* Dm, int ldD, int nkk, const char* Bt, int rowbytes, f4 (&acc)[4][4], RF arow) {
  const int lane = TIDX & 63, wave = TIDX >> 6, fr = lane & 15, fq = lane >> 4, wc = wave & 1;
#pragma unroll 1
  for (int kk = 0; kk < nkk; kk++) {
    h8 af[4], bf[4];
#pragma unroll
    for (int ms = 0; ms < 4; ms++) af[ms] = *(const h8*)(Dm + (size_t)arow(ms) * ldD + kk * 32 + fq * 8);
#pragma unroll
    for (int ns = 0; ns < 4; ns++) { int n = wc * 64 + ns * 16 + fr; bf[ns] = *(const h8*)(Bt + n * rowbytes + (((kk * 4 + fq) ^ (n & 15)) << 4)); }
#pragma unroll
    for (int ms = 0; ms < 4; ms++)
#pragma unroll
      for (int ns = 0; ns < 4; ns++) acc[ms][ns] = mfma16(af[ms], bf[ns], acc[ms][ns]);
  }
}
DI void zero44(f4 (&acc)[4][4]) {
#pragma unroll
  for (int m = 0; m < 4; m++)
#pragma unroll
    for (int n = 0; n < 4; n++) acc[m][n] = (f4){0.f, 0.f, 0.f, 0.f};
}
DI void fftA_item(const Params& P, int it, char* smem) {
  const int b = it >> 8, bb = (it >> 1) & 127, chh = it & 1;
  const int lane = TIDX & 63, wave = TIDX >> 6, fr = lane & 15, fq = lane >> 4, wr = wave >> 1, wc = wave & 1;
  __syncthreads();
  fft_load(P.QF + (size_t)(TC + b * SEQ + bb) * 512 + chh * 128, (size_t)128 * 512, 64, smem, 256, 0);
  fft_load(P.QF + (size_t)(TC + b * SEQ + bb) * 512 + 256 + chh * 128, (size_t)128 * 512, 64, smem, 256, 64);
  __syncthreads();
  f4 acc[4][4]; zero44(acc);
  fft_mma(P.DA, 128, 4, smem, 256, acc, [&](int ms) { return (ms >> 1) * 64 + wr * 32 + (ms & 1) * 16 + fr; });
#pragma unroll
  for (int ms = 0; ms < 2; ms++)
#pragma unroll
    for (int j = 0; j < 4; j++) {
      const int f1 = wr * 32 + ms * 16 + fq * 4 + j;
      const float2 w = P.tw[(bb * f1) & 8191];
      half_t* d0 = P.GA + ((size_t)(b * 64 + f1) * 256 + bb) * 256 + chh * 128 + wc * 64 + fr;
#pragma unroll
      for (int ns = 0; ns < 4; ns++) {
        float gr = acc[ms][ns][j], gi = acc[ms + 2][ns][j];
        d0[ns * 16] = (half_t)(gr * w.x + gi * w.y);
        d0[(size_t)128 * 256 + ns * 16] = (half_t)(gi * w.x - gr * w.y);
      }
    }
}
DI void fftB_item(const Params& P, int it, char* smem) {
  const int b = it >> 7, f1 = (it >> 1) & 63, chh = it & 1;
  const int lane = TIDX & 63, wave = TIDX >> 6, fr = lane & 15, fq = lane >> 4, wr = wave >> 1, wc = wave & 1;
  __syncthreads();
  fft_load(P.GA + (size_t)(b * 64 + f1) * 256 * 256 + chh * 128, 256, 256, smem, 512, 0);
  __syncthreads();
  f4 acc[4][4]; zero44(acc);
  fft_mma(P.DB, 256, 8, smem, 512, acc, [&](int ms) { return wr * 64 + ms * 16 + fr; });
#pragma unroll
  for (int ms = 0; ms < 4; ms++)
#pragma unroll
    for (int j = 0; j < 4; j++) {
      const int f2 = wr * 64 + ms * 16 + fq * 4 + j;
      half_t* d0 = P.mix + (size_t)(TC + b * SEQ + f1 + 64 * f2) * D + chh * 128 + wc * 64 + fr;
#pragma unroll
      for (int ns = 0; ns < 4; ns++) d0[ns * 16] = (half_t)acc[ms][ns][j];
    }
}
DI void fftC_item(const Params& P, int it, char* smem) {
  const int b = it >> 1, chh = it & 1;
  const int lane = TIDX & 63, wave = TIDX >> 6, fr = lane & 15, fq = lane >> 4, wr = wave >> 1, wc = wave & 1;
#pragma unroll 1
  for (int mh = 0; mh < 2; mh++) {
    f4 acc[4][4]; zero44(acc);
#pragma unroll 1
    for (int part = 0; part < 2; part++) {
      __syncthreads();
      fft_load(P.QF + (size_t)(b * CL) * 512 + part * 256 + chh * 128, 512, 256, smem, 512, 0);
      __syncthreads();
      fft_mma(P.DC + part * 256, 512, 8, smem, 512, acc, [&](int ms) { return mh * 128 + wr * 64 + ms * 16 + fr; });
    }
#pragma unroll
    for (int ms = 0; ms < 4; ms++)
#pragma unroll
      for (int j = 0; j < 4; j++) {
        const int f = mh * 128 + wr * 64 + ms * 16 + fq * 4 + j;
        half_t* d0 = P.mix + (size_t)(b * CL + f) * D + chh * 128 + wc * 64 + fr;
#pragma unroll
        for (int ns = 0; ns < 4; ns++) d0[ns * 16] = (half_t)acc[ms][ns][j];
      }
  }
}

#ifndef MX
#define MX 15
#endif
DI void mix_phase(const Params& P, int l, char* smem, int* s_item, int qi) {
  const int nL = 0, nA = 0, nC = l == 0 ? 64 : 0, nFA = 2048, nFC = l == 0 ? 16 : 0;
  const int total = nL + nA + nC + nFA + nFC;
  {
    const int g = blockIdx.x & 3;
    lru_load_w(P, l, g, smem);
    for (int u = blockIdx.x >> 2; u < NB_ * 132; u += gridDim.x >> 2) lru_tile(P, l, u / 132, u % 132, g, smem, false);
  }
  int stage = 0;
  for (;;) {
    __syncthreads();
    if (TIDX == 0) *s_item = stage == 0 ? atomicAdd(&P.qctr[8 + qi * 8 + (blockIdx.x & 7)], 1) : atomicAdd(&P.qctr[qi], 1);
    __syncthreads();
    int it = *s_item;
    int kind = -1, b = 0, head = 0, row0 = 0, nk = 0;
    if (stage == 0) {
      if (it >= 256) { stage = 1; continue; }
      const int pair = (blockIdx.x & 7) + 8 * (it >> 6);
      b = pair >> 2; head = pair & 3; row0 = TC + b * SEQ + (it & 63) * 128; nk = KV; kind = 0;
    } else {
      if (it >= total) break;
      if (it < nC) { b = it >> 3; head = (it >> 1) & 3; row0 = b * CL + (it & 1) * 128; nk = CL; kind = 0; }
      else if (it < nC + nFA) { kind = 1; it -= nC; }
      else { kind = 2; it -= nC + nFA; }
    }
    if (kind == 0) attn_item(P, l, b, head, row0, nk, smem);
    else if (kind == 1) fftA_item(P, it, smem);
    else fftC_item(P, it, smem);
  }
}

DI void grid_barrier(unsigned* ctr, unsigned target) {
  asm volatile("s_waitcnt vmcnt(0)" ::: "memory");
  __syncthreads();
  if (threadIdx.x == 0) {
    __builtin_amdgcn_fence(__ATOMIC_RELEASE, "agent");
    asm volatile("s_waitcnt vmcnt(0)" ::: "memory");
    __hip_atomic_fetch_add(ctr, 1u, __ATOMIC_RELAXED, __HIP_MEMORY_SCOPE_AGENT);
    while (__hip_atomic_load(ctr, __ATOMIC_RELAXED, __HIP_MEMORY_SCOPE_AGENT) < target) __builtin_amdgcn_s_sleep(1);
    __builtin_amdgcn_fence(__ATOMIC_ACQUIRE, "agent");
    asm volatile("s_waitcnt vmcnt(0)" ::: "memory");
  }
  __syncthreads();
}
__global__ void __launch_bounds__(256, 1) fwd_megakernel(Params Pin) {
  Params P = Pin; bind_ws(P);
  __shared__ __attribute__((aligned(16))) char smem[147456 + 8192];
  __shared__ int tb[33];
  __shared__ int s_item;
  cg::grid_group grid = cg::this_grid();
  unsigned* bar = (unsigned*)(P.ws + O_bar); unsigned bk = 0;
#ifndef PH
#define PH 0xFFFF
#endif
#if PH & 1
  phase0(P, smem);
#endif
  grid.sync();
  for (int l = 0; l < 2; l++) {
#if PH & 2
    row1_phase(P, l == 0 ? -1 : 0, l, 0);
#endif
    grid_barrier(bar, (++bk) * gridDim.x);
#if PH & 4
    gemm_in_phase(P, l, smem);
#ifdef DUP_GEMM
    grid_barrier(bar, (++bk) * gridDim.x);
    gemm_in_phase(P, l, smem);
#endif
#endif
    grid_barrier(bar, (++bk) * gridDim.x);
#if PH & 8
    mix_phase(P, l, smem, &s_item, l);
#ifdef DUP_MIX
    grid_barrier(bar, (++bk) * gridDim.x);
    mix_phase(P, l, smem, &s_item, 2 + l);
#endif
#endif
    grid_barrier(bar, (++bk) * gridDim.x);
#if PH & 16
    if (blockIdx.x >= gridDim.x - 16) lru_carry_item(P, gridDim.x - 1 - blockIdx.x);
    for (int it = blockIdx.x; it < 1024; it += gridDim.x) fftB_item(P, it, smem);
#endif
    grid_barrier(bar, (++bk) * gridDim.x);
#if PH & 512
    {
      const int g = blockIdx.x & 3;
      for (int u = blockIdx.x >> 2; u < NB_ * 132; u += gridDim.x >> 2) lru_tile(P, l, u / 132, u % 132, g, smem, true);
    }
#endif
    grid_barrier(bar, (++bk) * gridDim.x);
#if PH & 32
    gemm_out_phase(P, l, smem);
#endif
    grid_barrier(bar, (++bk) * gridDim.x);
#if PH & 64
    row2_phase(P, l, l == 0 ? 0 : TC, smem);
#endif
    grid_barrier(bar, (++bk) * gridDim.x);
#if PH & 128
    moe_e1_phase(P, l, smem, tb);
#ifdef DUP_GEMM
    grid_barrier(bar, (++bk) * gridDim.x);
    moe_e1_phase(P, l, smem, tb);
#endif
#endif
    grid_barrier(bar, (++bk) * gridDim.x);
#if PH & 256
    moe_e2_phase(P, l, smem, tb);
#ifdef DUP_GEMM
    grid_barrier(bar, (++bk) * gridDim.x);
    moe_e2_phase(P, l, smem, tb);
#endif
#endif
    grid_barrier(bar, (++bk) * gridDim.x);
  }
#if PH & 2
  row1_phase(P, 1, -1, TC);
#endif
}

extern "C" void kernel_launch(void* const* d_in, const int* in_sizes, int n_in, void* d_out, int out_size, void* d_ws, size_t ws_size,
                              hipStream_t stream) {
  static int grid_blocks = 0;
  if (!grid_blocks) {
    int dev = 0, cus = 0, per_cu = 0;
    hipGetDevice(&dev);
    hipDeviceGetAttribute(&cus, hipDeviceAttributeMultiprocessorCount, dev);
    hipOccupancyMaxActiveBlocksPerMultiprocessor(&per_cu, fwd_megakernel, 256, 0);
    if (per_cu > 2) per_cu = 2;
    grid_blocks = cus * per_cu;
    if (grid_blocks > 256) grid_blocks = 256;
  }
  if (grid_blocks != 256) { fprintf(stderr, "need 256 co-resident blocks, have %d\n", grid_blocks); return; }
  Params p{};
  const float** pin = (const float**)&p;
  for (int i = 0; i < 31; i++) pin[i] = (const float*)d_in[i];
  p.out = (float*)d_out;
  p.ws = (char*)d_ws;
  if (WS_NEED > ws_size) { fprintf(stderr, "workspace too small: need %zu have %zu\n", (size_t)WS_NEED, ws_size); return; }
  hipMemsetAsync((char*)d_ws + O_bar, 0, 256, stream);
  void* args[] = {&p};
  hipError_t e = hipLaunchCooperativeKernel((void*)fwd_megakernel, dim3(grid_blocks), dim3(256), args, 0, stream);
  if (e != hipSuccess) fprintf(stderr, "cooperative launch failed: %s (grid %d)\n", hipGetErrorString(e), grid_blocks);
}
```

```cpp
#include <hip/hip_runtime.h>
#include <hip/hip_cooperative_groups.h>
#include <cstdio>
namespace cg = cooperative_groups;

typedef _Float16 half_t;
typedef _Float16 h8 __attribute__((ext_vector_type(8)));
typedef _Float16 h4 __attribute__((ext_vector_type(4)));
typedef __fp16 fp16x2 __attribute__((ext_vector_type(2)));
typedef unsigned u4 __attribute__((ext_vector_type(4)));
typedef float f4 __attribute__((ext_vector_type(4)));
typedef float f16v __attribute__((ext_vector_type(16)));
#define DI __device__ __forceinline__
__device__ __forceinline__ int tid_opaque() { int t = threadIdx.x; asm volatile("" : "+v"(t)); return t; }
#define TIDX tid_opaque()

constexpr int D = 1024, NB_ = 8, SEQ = 8192, CL = 256;
constexpr int TC = NB_ * CL;
constexpr int TX = NB_ * SEQ;
constexpr int TA = TC + TX;
constexpr int KV = CL + SEQ;
constexpr int NIN = 2560;
constexpr int LCAP = 2 * TA;
constexpr float EPS = 1e-6f;

struct Params {
  const float *x, *c, *ctx, *c_ctx, *w_mod, *b_mod, *norm1_g, *norm2_g, *w_in, *q_norm_g, *k_norm_g, *lq1, *lk1, *lq2, *lk2,
      *subln_g, *conv_w, *conv_b, *gate_a_w, *gate_a_b, *gate_x_w, *gate_x_b, *lru_lambda, *w_out, *w_group, *b_group,
      *w_router, *b_router, *w1, *w3, *w2;
  float* out; char* ws;
  half_t *WtIn, *WtOut, *Wt1, *Wt3, *Wt2;
  float* mod; float2* rope; float2* tw; half_t *DA, *DB, *DC; float* consts; int* cnt; int* qctr; float* tokW; int* list; float* listW;
  float* xcbuf; half_t* WrH;
  half_t *hx, *mix, *q, *kall, *vT, *QF, *gy, *rr; float2* lsum; float* lcar; half_t* GA; half_t *H, *yA;
};


constexpr size_t al256(size_t x) { return (x + 255) & ~(size_t)255; }
constexpr size_t O_WtIn = 0;
constexpr size_t O_WtOut = O_WtIn + al256((size_t)2 * NIN * 1024 * 2);
constexpr size_t O_Wt1 = O_WtOut + al256((size_t)2 * 1024 * 1024 * 2);
constexpr size_t O_Wt3 = O_Wt1 + al256((size_t)64 * 524288 * 2);
constexpr size_t O_Wt2 = O_Wt3 + al256((size_t)64 * 524288 * 2);
constexpr size_t O_mod = O_Wt2 + al256((size_t)64 * 524288 * 2);
constexpr size_t O_rope = O_mod + al256((size_t)2 * 9 * 6144 * 4);
constexpr size_t O_tw = O_rope + al256(128 * 16 * 8);
constexpr size_t O_DA = O_tw + al256(8192 * 8);
constexpr size_t O_DB = O_DA + al256(16384 * 2);
constexpr size_t O_DC = O_DB + al256(32768 * 2);
constexpr size_t O_consts = O_DC + al256(131072 * 2);
constexpr size_t O_cnt = O_consts + 256;
constexpr size_t O_qctr = O_cnt + 256;
constexpr size_t O_bar = O_qctr + 256;
constexpr size_t O_tokW = O_bar + 256;
constexpr size_t O_list = O_tokW + al256((size_t)2 * TA * 4);
constexpr size_t O_listW = O_list + al256((size_t)32 * LCAP * 4);
constexpr size_t O_xcbuf = O_listW + al256((size_t)32 * LCAP * 4);
constexpr size_t O_WrT = O_xcbuf + al256((size_t)TC * D * 4);
constexpr size_t O_hx = O_WrT + al256((size_t)2 * 2 * 48 * 1024 * 2);
constexpr size_t O_mix = O_hx + al256((size_t)TA * D * 2);
constexpr size_t O_regB = O_mix + al256((size_t)TA * D * 2);
constexpr size_t O_q = O_regB;
constexpr size_t O_kall = O_q + al256((size_t)TA * 512 * 2);
constexpr size_t O_vT = O_kall + al256((size_t)NB_ * KV * 512 * 2);
constexpr size_t O_QF = O_vT + al256((size_t)NB_ * 4 * 128 * KV * 2);
constexpr size_t O_gy = O_QF + al256((size_t)TA * 512 * 2);
constexpr size_t O_rr = O_gy + al256((size_t)TA * 256 * 2);
constexpr size_t O_lsum = O_rr + al256((size_t)TA * 256 * 2);
constexpr size_t O_lcar = O_lsum + al256((size_t)16 * 132 * 256 * 8);
constexpr size_t O_GA = O_lcar + al256((size_t)16 * 132 * 256 * 4);
constexpr size_t O_mixer_end = O_GA + al256((size_t)NB_ * 64 * 256 * 256 * 2);
constexpr size_t O_H = O_regB;
constexpr size_t O_yA = O_H + al256((size_t)(2 * TA + 32 * 256) * 512 * 2);
constexpr size_t O_moe_end = O_yA + al256((size_t)2 * TA * D * 2);
constexpr size_t WS_NEED = O_mixer_end > O_moe_end ? O_mixer_end : O_moe_end;
DI void bind_ws(Params& P) {
  char* w = P.ws;
  P.WtIn = (half_t*)(w + O_WtIn); P.WtOut = (half_t*)(w + O_WtOut); P.Wt1 = (half_t*)(w + O_Wt1); P.Wt3 = (half_t*)(w + O_Wt3); P.Wt2 = (half_t*)(w + O_Wt2);
  P.mod = (float*)(w + O_mod); P.rope = (float2*)(w + O_rope); P.tw = (float2*)(w + O_tw); P.DA = (half_t*)(w + O_DA); P.DB = (half_t*)(w + O_DB); P.DC = (half_t*)(w + O_DC);
  P.consts = (float*)(w + O_consts); P.cnt = (int*)(w + O_cnt); P.qctr = (int*)(w + O_qctr); P.tokW = (float*)(w + O_tokW); P.list = (int*)(w + O_list); P.listW = (float*)(w + O_listW);
  P.xcbuf = (float*)(w + O_xcbuf); P.WrH = (half_t*)(w + O_WrT); P.hx = (half_t*)(w + O_hx); P.mix = (half_t*)(w + O_mix);
  P.q = (half_t*)(w + O_q); P.kall = (half_t*)(w + O_kall); P.vT = (half_t*)(w + O_vT); P.QF = (half_t*)(w + O_QF); P.gy = (half_t*)(w + O_gy); P.rr = (half_t*)(w + O_rr);
  P.lsum = (float2*)(w + O_lsum); P.lcar = (float*)(w + O_lcar); P.GA = (half_t*)(w + O_GA); P.H = (half_t*)(w + O_H); P.yA = (half_t*)(w + O_yA);
}
DI float shx(float v, int o) { int ln = TIDX & 63; return __builtin_bit_cast(float, __builtin_amdgcn_ds_bpermute((ln ^ o) << 2, __builtin_bit_cast(int, v))); }
DI float shi(float v, int idx) { return __builtin_bit_cast(float, __builtin_amdgcn_ds_bpermute(idx << 2, __builtin_bit_cast(int, v))); }
DI float wave_sum(float v) {
#pragma unroll
  for (int o = 32; o; o >>= 1) v += shx(v, o);
  return v;
}
DI void glds16(const void* g, void* l) {
  __builtin_amdgcn_global_load_lds((const unsigned*)g, (unsigned*)l, 16, 0, 0);
}
DI void wait_vm0() { asm volatile("s_waitcnt vmcnt(0)" ::: "memory"); }
DI f4 mfma16(h8 a, h8 b, f4 c) { return __builtin_amdgcn_mfma_f32_16x16x32_f16(a, b, c, 0, 0, 0); }
DI f16v mfma32(h8 a, h8 b, f16v c) { return __builtin_amdgcn_mfma_f32_32x32x16_f16(a, b, c, 0, 0, 0); }
DI unsigned pk2(float a, float b) { fp16x2 r = __builtin_amdgcn_cvt_pkrtz(a, b); return __builtin_bit_cast(unsigned, r); }
DI float sigmoidf_(float x) { return 1.f / (1.f + __expf(-x)); }
DI float gelu_tanh(float x) {
  float u = 0.7978845608028654f * (x + 0.044715f * x * x * x);
  float e = __expf(2.f * u);
  float t = 1.f - 2.f / (e + 1.f);
  return 0.5f * x * (1.f + t);
}
DI int row_mod(int r) { return r < TC ? 8 : ((r - TC) >> 13); }

DI void transpose_tile4(const float* src, int lds_, half_t* dst, int ldd, float* tile) {
  const int tid = TIDX;
  {
    const int k0 = tid >> 6, c4 = tid & 63;
    const float* sp = src + (size_t)k0 * lds_ + c4 * 4;
    float* tp = tile + (c4 >> 4) * 4352 + k0 * 68 + (c4 & 15) * 4;
#pragma unroll
    for (int i = 0; i < 16; i++) *(float4*)(tp + i * 4 * 68) = *(const float4*)(sp + (size_t)i * 4 * lds_);
  }
  __syncthreads();
#pragma unroll
  for (int i = 0; i < 8; i++) {
    int idx = i * 256 + tid, j = idx >> 9, r = idx & 511, kc = r >> 6, n = r & 63;
    const float* t = tile + j * 4352 + kc * 8 * 68 + n;
    h8 o;
#pragma unroll
    for (int u = 0; u < 8; u++) o[u] = (half_t)t[u * 68];
    *(h8*)(dst + (size_t)(j * 64 + n) * ldd + kc * 8) = o;
  }
  __syncthreads();
}

DI void phase0(const Params& P, char* smem) {
  float* tile = (float*)smem;
  const int tid = TIDX;
  constexpr int NT = 6528, NF = 128, NM = 192, NX = 6;
  for (int t = blockIdx.x; t < NT + NF + NM + NX; t += gridDim.x) {
    if (t < NT) {
      const float* src; half_t* dst; int lds_, ldd;
      if (t < 256) {
        int l = t / 128, r = t % 128, kt = r / 8, nt = (r % 8) * 4;
        src = P.w_in + (size_t)l * 1024 * 2304 + (size_t)kt * 64 * 2304 + 256 + nt * 64; lds_ = 2304;
        dst = P.WtIn + (size_t)l * NIN * 1024 + (size_t)(512 + nt * 64) * 1024 + kt * 64; ldd = 1024;
      } else if (t < 384) {
        int u = t - 256, l = u / 64, r = u % 64, kt = r / 4, nt = (r % 4) * 4;
        src = P.w_out + (size_t)l * 1048576 + (size_t)kt * 64 * 1024 + nt * 64; lds_ = 1024;
        dst = P.WtOut + (size_t)l * 1048576 + (size_t)nt * 64 * 1024 + kt * 64; ldd = 1024;
      } else if (t < 384 + 4096) {
        int u = t - 384; const float* w = P.w1; half_t* o = P.Wt1;
        if (u >= 2048) { u -= 2048; w = P.w3; o = P.Wt3; }
        int le = u / 32, r = u % 32, kt = r / 2, nt = (r % 2) * 4;
        src = w + (size_t)le * 524288 + (size_t)kt * 64 * 512 + nt * 64; lds_ = 512;
        dst = o + (size_t)le * 524288 + (size_t)nt * 64 * 1024 + kt * 64; ldd = 1024;
      } else {
        int u = t - 384 - 4096, le = u / 32, r = u % 32, kt = r / 4, nt = (r % 4) * 4;
        src = P.w2 + (size_t)le * 524288 + (size_t)kt * 64 * 1024 + nt * 64; lds_ = 1024;
        dst = P.Wt2 + (size_t)le * 524288 + (size_t)nt * 64 * 512 + kt * 64; ldd = 512;
      }
      transpose_tile4(src, lds_, dst, ldd, tile);
    } else if (t < NT + NF) {
      int f = t - NT, l = f / 64, r = f % 64, kt = r / 4, g = r % 4;
      float* cst = tile + 64 * 65; float* snt = cst + 64;
      const float* src = P.w_in + (size_t)l * 1024 * 2304 + (size_t)kt * 64 * 2304 + g * 64;
      { int n = tid & 63, kq = tid >> 6;
        for (int i = 0; i < 16; i++) { int k = i * 4 + kq; tile[k * 65 + n] = src[(size_t)k * 2304 + n]; } }
      if (tid < 64) { float s, c; sincospif((float)tid / 32.f, &s, &c); cst[tid] = c; snt[tid] = s; }
      __syncthreads();
      int k = tid & 63, jq = tid >> 6;
      half_t* o = P.WtIn + (size_t)l * NIN * 1024 + kt * 64 + k;
      for (int jj = 0; jj < 16; jj++) {
        int j = jq * 16 + jj; float ac = 0.f, as = 0.f;
        for (int c = 0; c < 64; c++) { float v = tile[k * 65 + c]; int idx = (c * j) & 63; ac += v * cst[idx]; as += v * snt[idx]; }
        o[(size_t)(g * 64 + j) * 1024] = (half_t)(ac * 0.125f);
        o[(size_t)(256 + g * 64 + j) * 1024] = (half_t)(-as * 0.125f);
      }
      __syncthreads();
    } else if (t < NT + NF + NM) {
      int mi = t - NT - NF, l = mi / 96, col0 = (mi % 96) * 64;
      float* scond = tile; float* red = tile + 9216;
      for (int idx = tid; idx < 9216; idx += 256) {
        int n = idx >> 10, k = idx & 1023; float v = n < 8 ? P.c[n * 1024 + k] : P.c_ctx[k];
        scond[idx] = v / (1.f + expf(-v));
      }
      __syncthreads();
      int col = tid & 63, kq = tid >> 6; float acc[9];
#pragma unroll
      for (int n = 0; n < 9; n++) acc[n] = 0.f;
      const float* w = P.w_mod + ((size_t)l * 1024 + kq * 256) * 6144 + col0 + col;
#pragma unroll 16
      for (int k = 0; k < 256; k++) {
        float wv = w[(size_t)k * 6144];
#pragma unroll
        for (int n = 0; n < 9; n++) acc[n] += scond[n * 1024 + kq * 256 + k] * wv;
      }
#pragma unroll
      for (int n = 0; n < 9; n++) red[(kq * 9 + n) * 64 + col] = acc[n];
      __syncthreads();
      for (int idx = tid; idx < 576; idx += 256) {
        int n = idx / 64, cc = idx % 64;
        float s = red[(0 * 9 + n) * 64 + cc] + red[(1 * 9 + n) * 64 + cc] + red[(2 * 9 + n) * 64 + cc] + red[(3 * 9 + n) * 64 + cc];
        P.mod[(size_t)(l * 9 + n) * 6144 + col0 + cc] = s + P.b_mod[l * 6144 + col0 + cc];
      }
      __syncthreads();
    } else {
      int m = t - NT - NF - NM;
      if (m == 0) {
        for (int idx = tid; idx < 128 * 16; idx += 256) {
          int pos = idx >> 4, i = idx & 15; float f = powf(10000.f, -(float)i / 16.f); float ang = (float)pos * f;
          float s, c; sincosf(ang, &s, &c); P.rope[idx] = make_float2(c, s);
        }
      } else if (m == 1) {
        for (int j = tid; j < 8192; j += 256) { float s, c; sincospif((float)j / 4096.f, &s, &c); P.tw[j] = make_float2(c, s); }
      } else if (m == 2) {
        for (int idx = tid; idx < 16384; idx += 256) {
          int mm = idx >> 7, k = idx & 127, part = mm >> 6, f1 = mm & 63, pp = k >> 6, a = k & 63;
          float s, c; sincospif((float)((a * f1) & 63) / 32.f, &s, &c);
          float v = part == 0 ? (pp == 0 ? c : s) : (pp == 0 ? -s : c);
          P.DA[idx] = (half_t)(v * 0.125f);
        }
      } else if (m == 3) {
        for (int idx = tid; idx < 32768; idx += 256) {
          int mm = idx >> 8, k = idx & 255, part = k >> 7, bb = k & 127;
          float s, c; sincospif((float)((bb * mm) & 127) / 64.f, &s, &c);
          P.DB[idx] = (half_t)((part == 0 ? c : s) * 0.08838834764831845f);
        }
      } else if (m == 4) {
        for (int idx = tid; idx < 131072; idx += 256) {
          int mm = idx >> 9, k = idx & 511, part = k >> 8, tt = k & 255;
          float s, c; sincospif((float)((tt * mm) & 255) / 128.f, &s, &c);
          P.DC[idx] = (half_t)((part == 0 ? c : s) * 0.0625f);
        }
      } else {
        for (int idx = tid; idx < 2 * 48 * 1024; idx += 256) {
          int l = idx / 49152, r = idx % 49152, col = r >> 10, k = r & 1023;
          float w = col < 4 ? P.w_group[((size_t)l * 1024 + k) * 4 + col] : (col < 36 ? P.w_router[((size_t)l * 1024 + k) * 32 + col - 4] : 0.f);
          half_t hi = (half_t)w, lo = (half_t)(w - (float)hi);
          P.WrH[(size_t)(l * 2) * 49152 + r] = hi; P.WrH[(size_t)(l * 2 + 1) * 49152 + r] = lo;
        }
        if (tid < 2) {
          int l = tid; float s1 = 0.f, s2 = 0.f, mq = 0.f, mk = 0.f;
          for (int i = 0; i < 64; i++) {
            s1 += P.lq1[l * 64 + i] * P.lk1[l * 64 + i]; s2 += P.lq2[l * 64 + i] * P.lk2[l * 64 + i];
            mq = fmaxf(mq, fabsf(P.q_norm_g[l * 64 + i])); mk = fmaxf(mk, fabsf(P.k_norm_g[l * 64 + i]));
          }
          float lam_init = 0.8f - 0.6f * expf(-0.3f * (float)l);
          P.consts[l * 4 + 0] = expf(s1) - expf(s2) + lam_init;
          P.consts[l * 4 + 1] = 8.f * mq * mk * 1.4426950408889634f * 1.002f - 15.f;
          P.consts[l * 4 + 2] = lam_init;
        }
        if (tid < 64) P.cnt[tid] = 0;
        if (tid < 64) P.qctr[tid] = 0;
      }
    }
  }
}

DI void row1_phase(const Params& P, int combine_l, int norm_l, int r_begin) {
  const int lane = TIDX & 63, gw = blockIdx.x * 4 + (TIDX >> 6), nw = gridDim.x * 4;
  auto load_row = [&](int r, float4 (&xv)[4], h4 (&ya)[4], h4 (&yb)[4]) {
    if (combine_l < 0) {
      const float* src = r < TC ? P.ctx + (size_t)r * D : P.x + (size_t)(r - TC) * D;
#pragma unroll
      for (int i = 0; i < 4; i++) xv[i] = *(const float4*)(src + i * 256 + lane * 4);
    } else {
      const float* xm = r < TC ? P.xcbuf + (size_t)r * D : P.out + (size_t)(r - TC) * D;
      const half_t* y0 = P.yA + (size_t)(2 * r) * D; const half_t* y1 = y0 + D;
#pragma unroll
      for (int i = 0; i < 4; i++) { int c = i * 256 + lane * 4; xv[i] = *(const float4*)(xm + c); ya[i] = *(const h4*)(y0 + c); yb[i] = *(const h4*)(y1 + c); }
    }
  };
  auto process = [&](int r, float4 (&xv)[4], h4 (&ya)[4], h4 (&yb)[4]) {
    const int n = row_mod(r);
    if (combine_l >= 0) {
      float* xm = r < TC ? P.xcbuf + (size_t)r * D : P.out + (size_t)(r - TC) * D;
      const float* g2 = P.mod + (size_t)(combine_l * 9 + n) * 6144 + 5 * 1024;
#pragma unroll
      for (int i = 0; i < 4; i++) {
        int c = i * 256 + lane * 4;
        float4 g = *(const float4*)(g2 + c); float4 t = xv[i];
        t.x += g.x * ((float)ya[i][0] + (float)yb[i][0]); t.y += g.y * ((float)ya[i][1] + (float)yb[i][1]);
        t.z += g.z * ((float)ya[i][2] + (float)yb[i][2]); t.w += g.w * ((float)ya[i][3] + (float)yb[i][3]);
        *(float4*)(xm + c) = t; xv[i] = t;
      }
    }
    if (norm_l >= 0) {
      float ss = 0.f;
#pragma unroll
      for (int i = 0; i < 4; i++) ss += xv[i].x * xv[i].x + xv[i].y * xv[i].y + xv[i].z * xv[i].z + xv[i].w * xv[i].w;
      ss = wave_sum(ss);
      const float rstd = rsqrtf(ss * (1.f / 1024.f) + EPS);
      const float* g = P.norm1_g + norm_l * 1024;
      const float* sh = P.mod + (size_t)(norm_l * 9 + n) * 6144; const float* sc = sh + 1024;
#pragma unroll
      for (int i = 0; i < 4; i++) {
        int c = i * 256 + lane * 4;
        float4 gg = *(const float4*)(g + c), s1 = *(const float4*)(sc + c), s0 = *(const float4*)(sh + c);
        h4 o;
        o[0] = (half_t)(xv[i].x * rstd * gg.x * (1.f + s1.x) + s0.x); o[1] = (half_t)(xv[i].y * rstd * gg.y * (1.f + s1.y) + s0.y);
        o[2] = (half_t)(xv[i].z * rstd * gg.z * (1.f + s1.z) + s0.z); o[3] = (half_t)(xv[i].w * rstd * gg.w * (1.f + s1.w) + s0.w);
        *(h4*)(P.hx + (size_t)r * D + c) = o;
      }
    }
  };
#pragma unroll 1
  for (int r = r_begin + gw; r < TA; r += 4 * nw) {
    float4 x0[4], x1[4], x2[4], x3[4]; h4 a0[4], b0[4], a1[4], b1[4], a2[4], b2[4], a3[4], b3[4];
    const int r1 = r + nw, r2 = r + 2 * nw, r3 = r + 3 * nw;
    load_row(r, x0, a0, b0);
    if (r1 < TA) load_row(r1, x1, a1, b1);
    if (r2 < TA) load_row(r2, x2, a2, b2);
    if (r3 < TA) load_row(r3, x3, a3, b3);
    process(r, x0, a0, b0);
    if (r1 < TA) process(r1, x1, a1, b1);
    if (r2 < TA) process(r2, x2, a2, b2);
    if (r3 < TA) process(r3, x3, a3, b3);
  }
}

DI void row2_phase(const Params& P, int l, int r_begin, char* smem) {
  const int tid = TIDX, lane = tid & 63, wave = tid >> 6, fr = lane & 15, fq = lane >> 4;
  float* lg = (float*)smem + wave * 16 * 48;
  const half_t* Whi = P.WrH + (size_t)(l * 2) * 49152; const half_t* Wlo = Whi + 49152;
  const int ngroups = (TA - r_begin) >> 4, gw = blockIdx.x * 4 + wave, nw = gridDim.x * 4;
  const float* gam = P.norm2_g + l * 1024;
#pragma unroll 1
  for (int grp = gw; grp < ngroups; grp += nw) {
    const int r0 = r_begin + grp * 16, row = r0 + fr, n = row_mod(r0);
    const float* xm = (row < TC ? P.xcbuf + (size_t)row * D : P.out + (size_t)(row - TC) * D) + fq * 8;
    float ss = 0.f;
#pragma unroll 16
    for (int kk = 0; kk < 32; kk++) {
      const float4 a = *(const float4*)(xm + kk * 32), b = *(const float4*)(xm + kk * 32 + 4);
      ss += a.x * a.x + a.y * a.y + a.z * a.z + a.w * a.w + b.x * b.x + b.y * b.y + b.z * b.z + b.w * b.w;
    }
    ss += shx(ss, 16); ss += shx(ss, 32);
    const float rstd = rsqrtf(ss * (1.f / 1024.f) + EPS);
    const float* sh = P.mod + (size_t)(l * 9 + n) * 6144 + 3 * 1024 + fq * 8; const float* sc = sh + 1024;
    f4 acc[3];
#pragma unroll
    for (int i = 0; i < 3; i++) acc[i] = (f4){0.f, 0.f, 0.f, 0.f};
    half_t* hxo = P.hx + (size_t)row * D + fq * 8;
#pragma unroll 4
    for (int kk = 0; kk < 32; kk++) {
      const int k0 = kk * 32;
      float x[8], g[8], s1[8], s0[8];
      *(float4*)&x[0] = *(const float4*)(xm + k0); *(float4*)&x[4] = *(const float4*)(xm + k0 + 4);
      *(float4*)&g[0] = *(const float4*)(gam + fq * 8 + k0); *(float4*)&g[4] = *(const float4*)(gam + fq * 8 + k0 + 4);
      *(float4*)&s1[0] = *(const float4*)(sc + k0); *(float4*)&s1[4] = *(const float4*)(sc + k0 + 4);
      *(float4*)&s0[0] = *(const float4*)(sh + k0); *(float4*)&s0[4] = *(const float4*)(sh + k0 + 4);
      h8 hi, lo;
#pragma unroll
      for (int i = 0; i < 8; i++) {
        float v = x[i] * rstd * g[i] * (1.f + s1[i]) + s0[i];
        hi[i] = (half_t)v; lo[i] = (half_t)(v - (float)hi[i]);
      }
      *(h8*)(hxo + k0) = hi;
#pragma unroll
      for (int n3 = 0; n3 < 3; n3++) {
        h8 bh = *(const h8*)(Whi + (size_t)(n3 * 16 + fr) * 1024 + k0 + fq * 8);
        h8 bl = *(const h8*)(Wlo + (size_t)(n3 * 16 + fr) * 1024 + k0 + fq * 8);
        acc[n3] = mfma16(hi, bh, acc[n3]); acc[n3] = mfma16(lo, bh, acc[n3]); acc[n3] = mfma16(hi, bl, acc[n3]);
      }
    }
    __builtin_amdgcn_wave_barrier();
#pragma unroll
    for (int n3 = 0; n3 < 3; n3++)
#pragma unroll
      for (int j = 0; j < 4; j++) lg[(fq * 4 + j) * 48 + n3 * 16 + fr] = acc[n3][j];
    __builtin_amdgcn_wave_barrier();
    if (lane < 16) {
      const int r = r0 + lane;
      const float* L = lg + lane * 48;
      float gl[4]; int gi = 0;
#pragma unroll
      for (int j = 0; j < 4; j++) gl[j] = L[j] + P.b_group[l * 4 + j];
      float gm = gl[0];
#pragma unroll
      for (int j = 1; j < 4; j++) if (gl[j] > gm) { gm = gl[j]; gi = j; }
      float gs = 0.f;
#pragma unroll
      for (int j = 0; j < 4; j++) gs += expf(gl[j] - gm);
      const float pg = 1.f / gs;
      float el[8];
#pragma unroll
      for (int j = 0; j < 8; j++) el[j] = L[4 + gi * 8 + j] + P.b_router[l * 32 + gi * 8 + j];
      int i0 = 0; float v0 = el[0];
#pragma unroll
      for (int j = 1; j < 8; j++) if (el[j] > v0) { v0 = el[j]; i0 = j; }
      int i1 = -1; float v1 = -3.0e38f;
#pragma unroll
      for (int j = 0; j < 8; j++) if (j != i0 && el[j] > v1) { v1 = el[j]; i1 = j; }
      const float ex = expf(v1 - v0);
      const float w0 = pg / (1.f + ex), w1 = pg * ex / (1.f + ex);
      const int e0 = gi * 8 + i0, e1 = gi * 8 + i1;
      int p0 = atomicAdd(&P.cnt[l * 32 + e0], 1); P.list[(size_t)e0 * LCAP + p0] = 2 * r; P.listW[(size_t)e0 * LCAP + p0] = w0;
      int p1 = atomicAdd(&P.cnt[l * 32 + e1], 1); P.list[(size_t)e1 * LCAP + p1] = 2 * r + 1; P.listW[(size_t)e1 * LCAP + p1] = w1;
    }
    __builtin_amdgcn_wave_barrier();
  }
}

DI h8 lds128(unsigned a) { h8 r; asm volatile("ds_read_b128 %0, %1" : "=v"(r) : "v"(a)); return r; }
DI void tie(h8& x) { asm volatile("" : "+v"(x)); }
DI unsigned lds_addr(const void* p) { return (unsigned)(size_t)p; }
#define WAIT_LGKM(n) asm volatile("s_waitcnt lgkmcnt(" #n ")" ::: "memory")
DI void raw_barrier() { asm volatile("" ::: "memory"); __builtin_amdgcn_s_barrier(); asm volatile("" ::: "memory"); }
DI void slot_rc(int i, int& row, int& coff) { int s = i * 256 + TIDX; row = s >> 3; coff = ((s & 7) ^ ((row >> 1) & 7)) * 8; }

template <class AF, class BF>
DI void gemm_prologue(AF aptr, BF bptr, int nk, char* smem) {
  const int tid = TIDX;
#pragma unroll
  for (int st = 0; st < 2; st++) {
    if (st < nk) {
      char* d = smem + st * 49152 + tid * 16;
#pragma unroll
      for (int i = 0; i < 8; i++) glds16(aptr(i) + st * 64, d + i * 4096);
#pragma unroll
      for (int i = 0; i < 4; i++) glds16(bptr(i) + st * 64, d + 32768 + i * 4096);
    }
  }
}
template <bool PRE = false, class AF, class BF>
DI void gemm256(AF aptr, BF bptr, int nk, char* smem, f4 (&acc)[8][4]) {
  const int tid = TIDX, lane = tid & 63, wave = tid >> 6, fr = lane & 15, fq = lane >> 4, wr = wave >> 1, wc = wave & 1;
#pragma unroll
  for (int m = 0; m < 8; m++)
#pragma unroll
    for (int n = 0; n < 4; n++) acc[m][n] = (f4){0.f, 0.f, 0.f, 0.f};
  auto issue = [&](int kt, int st) {
    char* d = smem + st * 49152 + tid * 16;
#pragma unroll
    for (int i = 0; i < 8; i++) glds16(aptr(i) + kt * 64, d + i * 4096);
#pragma unroll
    for (int i = 0; i < 4; i++) glds16(bptr(i) + kt * 64, d + 32768 + i * 4096);
  };
  const unsigned sw = (unsigned)((fq ^ (fr >> 1)) << 4);
  const unsigned offA = (wr * 128 + fr) * 128 + sw, offB = 32768 + (wc * 64 + fr) * 128 + sw;
  const unsigned sbase = lds_addr(smem);
  if (!PRE) { issue(0, 0); if (nk > 1) issue(1, 1); }
  int st = 0;
#pragma unroll 1
  for (int kt = 0; kt < nk; kt++) {
    if (kt + 1 < nk) asm volatile("s_waitcnt vmcnt(12)" ::: "memory"); else wait_vm0();
    raw_barrier();
    if (kt + 2 < nk) issue(kt + 2, st == 0 ? 2 : st - 1);
    const unsigned base = sbase + st * 49152;
    st = st == 2 ? 0 : st + 1;
    h8 a0[8], b0[4], a1[8], b1[4];
#pragma unroll
    for (int m = 0; m < 8; m++) a0[m] = lds128(base + offA + m * 2048);
#pragma unroll
    for (int n = 0; n < 4; n++) b0[n] = lds128(base + offB + n * 2048);
#pragma unroll
    for (int m = 0; m < 8; m++) a1[m] = lds128(base + (offA ^ 64) + m * 2048);
#pragma unroll
    for (int n = 0; n < 4; n++) b1[n] = lds128(base + (offB ^ 64) + n * 2048);
    WAIT_LGKM(12);
#pragma unroll
    for (int m = 0; m < 8; m++) tie(a0[m]);
#pragma unroll
    for (int n = 0; n < 4; n++) tie(b0[n]);
#pragma unroll
    for (int m = 0; m < 8; m++)
#pragma unroll
      for (int n = 0; n < 4; n++) acc[m][n] = mfma16(a0[m], b0[n], acc[m][n]);
    WAIT_LGKM(0);
#pragma unroll
    for (int m = 0; m < 8; m++) tie(a1[m]);
#pragma unroll
    for (int n = 0; n < 4; n++) tie(b1[n]);
#pragma unroll
    for (int m = 0; m < 8; m++)
#pragma unroll
      for (int n = 0; n < 4; n++) acc[m][n] = mfma16(a1[m], b1[n], acc[m][n]);
  }
  raw_barrier();
}
DI bool xcd_tile(int it, int MT, int NT, int& mt, int& nt) {
  const int x = blockIdx.x & 7, j = blockIdx.x >> 3;
  const int nsn = NT >> 2, nsm = (MT + 7) >> 3;
  const int s = x + 8 * it;
  if (s >= nsm * nsn) return false;
  const int sm = s / nsn, sn = s % nsn;
  mt = sm * 8 + (j >> 2); nt = sn * 4 + (j & 3);
  return true;
}
DI bool next_tile(int& it, int MT, int NT, int& mt, int& nt) {
  for (;; it++) {
    if (!xcd_tile(it, MT, NT, mt, nt)) return false;
    if (mt < MT) return true;
  }
}
DI int slot_col() { int t = TIDX; return ((t & 7) ^ ((t >> 4) & 7)) * 8; }

DI float dpp_row_sum(float v) {
  v += __builtin_bit_cast(float, __builtin_amdgcn_update_dpp(0, __builtin_bit_cast(int, v), 0x128, 0xf, 0xf, false));
  v += __builtin_bit_cast(float, __builtin_amdgcn_update_dpp(0, __builtin_bit_cast(int, v), 0x124, 0xf, 0xf, false));
  v += __builtin_bit_cast(float, __builtin_amdgcn_update_dpp(0, __builtin_bit_cast(int, v), 0x122, 0xf, 0xf, false));
  v += __builtin_bit_cast(float, __builtin_amdgcn_update_dpp(0, __builtin_bit_cast(int, v), 0x121, 0xf, 0xf, false));
  return v;
}
DI void stage_put(char* stg, int ml, int n, int j, int fr, int fq, float v) { *(half_t*)(stg + (ml * 16 + fq * 4 + j) * 144 + (n * 16 + fr) * 2) = (half_t)v; }
template <class RP, class SC>
DI void stage_flush(char* stg, int h, RP rowptr, SC rowscale) {
  const int lane = TIDX & 63;
  __builtin_amdgcn_wave_barrier();
#pragma unroll
  for (int i = 0; i < 8; i++) {
    const int c = i * 64 + lane, row = c >> 3, c16 = c & 7;
    h8 v = *(const h8*)(stg + row * 144 + c16 * 16);
    half_t* d = rowptr(h * 64 + row);
    if (d) { rowscale(h * 64 + row, v); *(h8*)(d + c16 * 8) = v; }
  }
  __builtin_amdgcn_wave_barrier();
}
template <class VF, class RP, class SC>
DI void wave_store_tile(VF val, char* stg, RP rowptr, SC rowscale) {
  const int lane = TIDX & 63, fr = lane & 15, fq = lane >> 4;
#pragma unroll
  for (int h = 0; h < 2; h++) {
#pragma unroll
    for (int ml = 0; ml < 4; ml++)
#pragma unroll
      for (int n = 0; n < 4; n++)
#pragma unroll
        for (int j = 0; j < 4; j++) stage_put(stg, ml, n, j, fr, fq, val(h * 4 + ml, n, j));
    stage_flush(stg, h, rowptr, rowscale);
  }
}
DI void gemm_in_phase(const Params& P, int l, char* smem) {
  const int tid = TIDX;
  const half_t* Wt = P.WtIn + (size_t)l * NIN * 1024;
  const int sc = slot_col(), srow = tid >> 3;
  {
    float2* rcl = (float2*)(smem + 147456);
    for (int i = tid; i < 1024; i += 256) rcl[i] = P.rope[i];
    __syncthreads();
  }
  int it = 0, mt, nt;
  bool have = next_tile(it, 264, 20, mt, nt);
  const half_t* a0 = nullptr; const half_t* b0 = nullptr;
  if (have) {
    asm volatile("" : "+s"(mt), "+s"(nt));
    a0 = P.hx + (size_t)(mt * 256 + srow) * D + sc; b0 = Wt + (size_t)(nt * 128 + srow) * D + sc;
    gemm_prologue([&](int i) { return a0 + (size_t)i * 32 * D; }, [&](int i) { return b0 + (size_t)i * 32 * D; }, 16, smem);
  }
#pragma unroll 1
  while (have) {
    f4 acc[8][4];
    gemm256<true>([&](int i) { return a0 + (size_t)i * 32 * D; }, [&](int i) { return b0 + (size_t)i * 32 * D; }, 16, smem, acc);
    const int tid2 = TIDX, lane = tid2 & 63, wave = tid2 >> 6, fr = lane & 15, fq = lane >> 4, wr = wave >> 1, wc = wave & 1;
    const int r0 = mt * 256 + wr * 128;
    const bool isctx = r0 < TC;
    int b, pos0;
    if (isctx) { b = r0 >> 8; pos0 = r0 & 255; } else { b = (r0 - TC) >> 13; pos0 = 256 + ((r0 - TC) & 8191); }
    const bool isqk = nt >= 4 && nt < 12;
    float gg[4] = {0.f, 0.f, 0.f, 0.f}; float2 rr2[2] = {make_float2(1.f, 0.f), make_float2(1.f, 0.f)};
    if (isqk) {
      const float* gvec = (nt < 8 ? P.q_norm_g : P.k_norm_g) + l * 64;
      const float qs = nt < 8 ? 0.125f * 1.4426950408889634f : 1.f;
#pragma unroll
      for (int n = 0; n < 4; n++) gg[n] = gvec[n * 16 + fr] * qs;
      if (!isctx) { const int tp0 = pos0 - 256; rr2[0] = P.rope[(tp0 >> 6) * 16 + fr]; rr2[1] = P.rope[((tp0 >> 6) + 1) * 16 + fr]; }
    }
#pragma unroll
    for (int n = 0; n < 4; n++) asm volatile("" : "+v"(gg[n]));
    asm volatile("" : "+v"(rr2[0].x), "+v"(rr2[0].y), "+v"(rr2[1].x), "+v"(rr2[1].y));
    int it2 = it + 1, mt2, nt2;
    const bool have2 = next_tile(it2, 264, 20, mt2, nt2);
    const half_t* a1 = a0; const half_t* b1 = b0;
    if (have2) {
      asm volatile("" : "+s"(mt2), "+s"(nt2));
      a1 = P.hx + (size_t)(mt2 * 256 + srow) * D + sc; b1 = Wt + (size_t)(nt2 * 128 + srow) * D + sc;
      gemm_prologue([&](int i) { return a1 + (size_t)i * 32 * D; }, [&](int i) { return b1 + (size_t)i * 32 * D; }, 16, smem);
    }
    char* stg = smem + 98304 + wave * 12288;
    auto noscale = [](int, h8&) {};
    if (nt < 4 || nt >= 16) {
      half_t* dst; int ld, c0; bool gel = false;
      if (nt < 4) { dst = P.QF; ld = 512; c0 = nt * 128; }
      else if (nt < 18) { dst = P.gy; ld = 256; c0 = (nt - 16) * 128; gel = true; }
      else { dst = P.rr; ld = 256; c0 = (nt - 18) * 128; }
      half_t* base = dst + (size_t)r0 * ld + c0 + wc * 64;
      if (gel) wave_store_tile([&](int m, int n, int j) { return gelu_tanh(acc[m][n][j]); }, stg, [&](int r) { return base + (size_t)r * ld; }, noscale);
      else wave_store_tile([&](int m, int n, int j) { return acc[m][n][j]; }, stg, [&](int r) { return base + (size_t)r * ld; }, noscale);
    } else if (nt < 12) {
      const bool isq = nt < 8; const int head = isq ? nt - 4 : nt - 8;
      const float2* rcl = (const float2*)(smem + 147456);
      half_t* base = (isq ? P.q + (size_t)r0 * 512 : P.kall + ((size_t)b * KV + pos0) * 512) + head * 128 + wc * 64;
#pragma unroll
      for (int mh = 0; mh < 2; mh++) {
#pragma unroll
        for (int mm = 0; mm < 4; mm++) {
          const int m = mh * 4 + mm;
#pragma unroll
          for (int j = 0; j < 4; j++) {
            float ss = 0.f;
#pragma unroll
            for (int n = 0; n < 4; n++) ss += acc[m][n][j] * acc[m][n][j];
            ss = dpp_row_sum(ss);
            const float rstd = rsqrtf(ss * (1.f / 64.f) + EPS);
            float o[4];
#pragma unroll
            for (int n = 0; n < 4; n++) o[n] = acc[m][n][j] * rstd * gg[n];
            if (!isctx) {
              const float2 cr = rr2[mh], cc = rcl[(mm * 16 + fq * 4 + j) * 16 + fr];
              float a0 = o[0] * cr.x - o[1] * cr.y, a1 = o[1] * cr.x + o[0] * cr.y;
              float a2 = o[2] * cc.x - o[3] * cc.y, a3 = o[3] * cc.x + o[2] * cc.y;
              o[0] = a0; o[1] = a1; o[2] = a2; o[3] = a3;
            }
#pragma unroll
            for (int n = 0; n < 4; n++) stage_put(stg, mm, n, j, fr, fq, o[n]);
          }
        }
        stage_flush(stg, mh, [&](int r) { return base + (size_t)r * 512; }, noscale);
      }
    } else {
      const int head = nt - 12;
#pragma unroll
      for (int m = 0; m < 8; m++)
#pragma unroll
        for (int n = 0; n < 4; n++) {
          h4 o; o[0] = (half_t)acc[m][n][0]; o[1] = (half_t)acc[m][n][1]; o[2] = (half_t)acc[m][n][2]; o[3] = (half_t)acc[m][n][3];
          int d = wc * 64 + n * 16 + fr;
          asm volatile("" : "+v"(d) :: "memory");
          *(h4*)(P.vT + ((size_t)(b * 4 + head) * 128 + d) * KV + pos0 + m * 16 + fq * 4) = o;
        }
    }
    mt = mt2; nt = nt2; it = it2; have = have2; a0 = a1; b0 = b1;
  }
}

DI void gemm_out_phase(const Params& P, int l, char* smem) {
  const int tid = TIDX, lane = tid & 63, wave = tid >> 6, fr = lane & 15, fq = lane >> 4, wr = wave >> 1, wc = wave & 1;
  const half_t* Wt = P.WtOut + (size_t)l * 1048576;
  const int mt0 = l == 0 ? 0 : TC / 256;
  const int sc = slot_col(), srow = tid >> 3;
#pragma unroll 1
  for (int it = 0;; it++) {
    int mt, nt;
    if (!xcd_tile(it, 264 - mt0, 8, mt, nt)) break;
    mt += mt0;
    if (mt >= 264) continue;
    asm volatile("" : "+s"(mt), "+s"(nt));
    f4 acc[8][4];
    {
      const half_t* a0 = P.mix + (size_t)(mt * 256 + srow) * D + sc; const half_t* b0 = Wt + (size_t)(nt * 128 + srow) * D + sc;
      gemm256([&](int i) { return a0 + (size_t)i * 32 * D; }, [&](int i) { return b0 + (size_t)i * 32 * D; }, 16, smem, acc);
    }
    {
      const int tid2 = TIDX, lane2 = tid2 & 63, wave2 = tid2 >> 6, fr2 = lane2 & 15, fq2 = lane2 >> 4, wr2 = wave2 >> 1, wc2 = wave2 & 1;
      const int r0 = mt * 256 + wr2 * 128;
      const int n = row_mod(r0);
      const int cbase = nt * 128 + wc2 * 64;
      const float4 g4 = *(const float4*)(P.mod + (size_t)(l * 9 + n) * 6144 + 2 * 1024 + cbase + fr2 * 4);
      const float* res; float* dst;
      if (r0 < TC) { res = P.ctx + (size_t)r0 * D; dst = P.xcbuf + (size_t)r0 * D; }
      else { dst = P.out + (size_t)(r0 - TC) * D; res = l == 0 ? P.x + (size_t)(r0 - TC) * D : dst; }
      res += cbase + fr2 * 4; dst += cbase + fr2 * 4;
      float* stg = (float*)(smem + 98304 + wave2 * 12288);
#pragma unroll
      for (int q = 0; q < 4; q++) {
#pragma unroll
        for (int ml = 0; ml < 2; ml++)
#pragma unroll
          for (int nn = 0; nn < 4; nn++)
#pragma unroll
            for (int j = 0; j < 4; j++) stg[(ml * 16 + fq2 * 4 + j) * 68 + nn * 16 + fr2] = acc[q * 2 + ml][nn][j];
        __builtin_amdgcn_wave_barrier();
#pragma unroll
        for (int i = 0; i < 8; i++) {
          const int row = i * 4 + fq2;
          const float4 a = *(const float4*)(stg + row * 68 + fr2 * 4);
          const size_t o = (size_t)(q * 32 + row) * D;
          float4 r = *(const float4*)(res + o);
          r.x += g4.x * a.x; r.y += g4.y * a.y; r.z += g4.z * a.z; r.w += g4.w * a.w;
          *(float4*)(dst + o) = r;
        }
        __builtin_amdgcn_wave_barrier();
      }
    }
  }
}

DI void moe_prefix(const Params& P, int l, int* tb) {
  __syncthreads();
  if (TIDX == 0) { int s = 0; for (int e = 0; e < 32; e++) { tb[e] = s; s += (P.cnt[l * 32 + e] + 255) >> 8; } tb[32] = s; }
  __syncthreads();
}
DI void moe_e1_phase(const Params& P, int l, char* smem, int* tb) {
  const int tid = TIDX;
  moe_prefix(P, l, tb);
  const int sc = slot_col(), srow = tid >> 3;
  const int MT = tb[32];
  auto setup = [&](int rt, int nt, int (&tok)[8], const half_t*& w1, const half_t*& w3) {
    int e = 0;
    while (tb[e + 1] <= rt) e++;
    const int rl = rt - tb[e], cnt = P.cnt[l * 32 + e];
    const int* lst = P.list + (size_t)e * LCAP;
    w1 = P.Wt1 + ((size_t)(l * 32 + e) * 512 + nt * 64) * 1024 + sc;
    w3 = P.Wt3 + ((size_t)(l * 32 + e) * 512 + nt * 64) * 1024 + sc;
#pragma unroll
    for (int i = 0; i < 8; i++) tok[i] = lst[min(rl * 256 + i * 32 + srow, cnt - 1)] >> 1;
  };
  int it = 0, rt, nt;
  bool have = next_tile(it, MT, 8, rt, nt);
  int tok[8]; const half_t* w1 = nullptr; const half_t* w3 = nullptr;
  if (have) {
    asm volatile("" : "+s"(rt), "+s"(nt));
    setup(rt, nt, tok, w1, w3);
    gemm_prologue([&](int i) { return P.hx + (size_t)tok[i] * D + sc; }, [&](int i) { return ((i & 1) ? w3 : w1) + (size_t)((i >> 1) * 32 + srow) * 1024; }, 16, smem);
  }
#pragma unroll 1
  while (have) {
    int it2 = it + 1, rt2, nt2;
    const bool have2 = next_tile(it2, MT, 8, rt2, nt2);
    int tok2[8]; const half_t* w1n = w1; const half_t* w3n = w3;
#pragma unroll
    for (int i = 0; i < 8; i++) tok2[i] = tok[i];
    if (have2) {
      asm volatile("" : "+s"(rt2), "+s"(nt2));
      setup(rt2, nt2, tok2, w1n, w3n);
    }
    f4 acc[8][4];
    gemm256<true>([&](int i) { return P.hx + (size_t)tok[i] * D + sc; },
                  [&](int i) { return ((i & 1) ? w3 : w1) + (size_t)((i >> 1) * 32 + srow) * 1024; }, 16, smem, acc);
    if (have2) {
      gemm_prologue([&](int i) { return P.hx + (size_t)tok2[i] * D + sc; }, [&](int i) { return ((i & 1) ? w3n : w1n) + (size_t)((i >> 1) * 32 + srow) * 1024; }, 16, smem);
    }
    {
      const int tid2 = TIDX, lane2 = tid2 & 63, wave2 = tid2 >> 6, fr2 = lane2 & 15, fq2 = lane2 >> 4, wr2 = wave2 >> 1, wc2 = wave2 & 1;
      char* stg = smem + 98304 + wave2 * 12288;
      half_t* Hd = P.H + ((size_t)rt * 256 + wr2 * 128) * 512 + nt * 64 + wc2 * 32;
#pragma unroll
      for (int h = 0; h < 2; h++) {
#pragma unroll
        for (int ml = 0; ml < 4; ml++)
#pragma unroll
          for (int n = 0; n < 2; n++)
#pragma unroll
            for (int j = 0; j < 4; j++) {
              float a1 = acc[h * 4 + ml][n][j], a3 = acc[h * 4 + ml][n + 2][j];
              *(half_t*)(stg + (ml * 16 + fq2 * 4 + j) * 80 + (n * 16 + fr2) * 2) = (half_t)(a1 * sigmoidf_(a1) * a3);
            }
        __builtin_amdgcn_wave_barrier();
#pragma unroll
        for (int i = 0; i < 4; i++) {
          const int c = i * 64 + lane2, row = c >> 2, c16 = c & 3;
          h8 v = *(const h8*)(stg + row * 80 + c16 * 16);
          *(h8*)(Hd + (size_t)(h * 64 + row) * 512 + c16 * 8) = v;
        }
        __builtin_amdgcn_wave_barrier();
      }
    }
    rt = rt2; nt = nt2; it = it2; have = have2; w1 = w1n; w3 = w3n;
#pragma unroll
    for (int i = 0; i < 8; i++) tok[i] = tok2[i];
  }
}
DI void moe_e2_phase(const Params& P, int l, char* smem, int* tb) {
  const int tid = TIDX;
  moe_prefix(P, l, tb);
  const int sc = slot_col(), srow = tid >> 3;
  const int MT = tb[32];
  auto ptrs = [&](int rt, int nt, const half_t*& a0, const half_t*& b0) {
    int e = 0;
    while (tb[e + 1] <= rt) e++;
    a0 = P.H + ((size_t)rt * 256 + srow) * 512 + sc;
    b0 = P.Wt2 + ((size_t)(l * 32 + e) * 1024 + nt * 128 + srow) * 512 + sc;
  };
  int it = 0, rt, nt;
  bool have = next_tile(it, MT, 8, rt, nt);
  const half_t* a0 = nullptr; const half_t* b0 = nullptr;
  if (have) {
    asm volatile("" : "+s"(rt), "+s"(nt));
    ptrs(rt, nt, a0, b0);
    gemm_prologue([&](int i) { return a0 + (size_t)i * 32 * 512; }, [&](int i) { return b0 + (size_t)i * 32 * 512; }, 8, smem);
  }
#pragma unroll 1
  while (have) {
    const int tid2 = TIDX, lane2 = tid2 & 63, wave2 = tid2 >> 6, wr2 = wave2 >> 1, wc2 = wave2 & 1;
    int e = 0;
    while (tb[e + 1] <= rt) e++;
    const int rl = rt - tb[e], cnt = P.cnt[l * 32 + e];
    const int* lst = P.list + (size_t)e * LCAP; const float* lstw = P.listW + (size_t)e * LCAP;
    int aa[2][8]; float ww[2][8];
#pragma unroll
    for (int h = 0; h < 2; h++)
#pragma unroll
      for (int i = 0; i < 8; i++) {
        const int idx = rl * 256 + wr2 * 128 + h * 64 + ((i * 64 + lane2) >> 3);
        const int ic = min(idx, cnt - 1);
        const int av = lst[ic]; const float wv = lstw[ic];
        aa[h][i] = idx < cnt ? av : -1; ww[h][i] = wv;
      }
    f4 acc[8][4];
    gemm256<true>([&](int i) { return a0 + (size_t)i * 32 * 512; }, [&](int i) { return b0 + (size_t)i * 32 * 512; }, 8, smem, acc);
    int it2 = it + 1, rt2, nt2;
    const bool have2 = next_tile(it2, MT, 8, rt2, nt2);
    const half_t* a1 = a0; const half_t* b1 = b0;
    if (have2) {
      asm volatile("" : "+s"(rt2), "+s"(nt2));
      ptrs(rt2, nt2, a1, b1);
      gemm_prologue([&](int i) { return a1 + (size_t)i * 32 * 512; }, [&](int i) { return b1 + (size_t)i * 32 * 512; }, 8, smem);
    }
    {
      char* stg = smem + 98304 + wave2 * 12288;
      const int fr2 = lane2 & 15, fq2 = lane2 >> 4;
#pragma unroll
      for (int h = 0; h < 2; h++) {
#pragma unroll
        for (int ml = 0; ml < 4; ml++)
#pragma unroll
          for (int n = 0; n < 4; n++)
#pragma unroll
            for (int j = 0; j < 4; j++) stage_put(stg, ml, n, j, fr2, fq2, acc[h * 4 + ml][n][j]);
        __builtin_amdgcn_wave_barrier();
#pragma unroll
        for (int i = 0; i < 8; i++) {
          const int c = i * 64 + lane2, row = c >> 3, c16 = c & 7;
          h8 v = *(const h8*)(stg + row * 144 + c16 * 16);
          if (aa[h][i] >= 0) {
            const float w = ww[h][i];
#pragma unroll
            for (int u = 0; u < 8; u++) v[u] = (half_t)(w * (float)v[u]);
            *(h8*)(P.yA + (size_t)aa[h][i] * D + nt * 128 + wc2 * 64 + c16 * 8) = v;
          }
        }
        __builtin_amdgcn_wave_barrier();
      }
    }
    rt = rt2; nt = nt2; it = it2; have = have2; a0 = a1; b0 = b1;
  }
}

DI int swap23(int x) { return (x & ~12) | ((x & 4) << 1) | ((x & 8) >> 1); }
DI void attn_item(const Params& P, int l, int b, int head, int row0, int nkeys, char* smem) {
  const int tid = TIDX, lane = tid & 63, wave = tid >> 6, ql = lane & 31, hh = lane >> 5;
  const float lam = P.consts[l * 4 + 0], negc = -P.consts[l * 4 + 1], lam_init = P.consts[l * 4 + 2];
  const int myrow = row0 + wave * 32 + ql;
  h8 qf[2][4];
  {
    const half_t* qp = P.q + (size_t)myrow * 512 + head * 128 + hh * 8;
#pragma unroll
    for (int m = 0; m < 2; m++)
#pragma unroll
      for (int s = 0; s < 4; s++) { qf[m][s] = *(const h8*)(qp + m * 64 + s * 16); }
#pragma unroll
    for (int m = 0; m < 2; m++)
#pragma unroll
      for (int s = 0; s < 4; s++) tie(qf[m][s]);
  }
  f16v o0[4], o1[4];
#pragma unroll
  for (int dt = 0; dt < 4; dt++)
#pragma unroll
    for (int i = 0; i < 16; i++) { o0[dt][i] = 0.f; o1[dt][i] = 0.f; }
  float ls0 = 0.f, ls1 = 0.f;
  const half_t* kp[4]; const half_t* vp[4];
  {
    const half_t* kbase = P.kall + (size_t)b * KV * 512 + head * 128;
    const half_t* vbase = P.vT + (size_t)(b * 4 + head) * 128 * KV;
#pragma unroll
    for (int i = 0; i < 4; i++) {
      int s = i * 256 + tid;
      int row = s >> 4, c = (s & 15) ^ (row & 15); kp[i] = kbase + (size_t)row * 512 + c * 8;
      int vr = s >> 3, vc = (s & 7) ^ ((vr >> 1) & 7); vp[i] = vbase + (size_t)vr * KV + vc * 8;
    }
  }
  const int ntile = nkeys >> 6;
  const unsigned sbase = lds_addr(smem);
  auto issue = [&](int t) {
    char* d = smem + (t & 3) * 32768 + tid * 16;
#pragma unroll
    for (int i = 0; i < 4; i++) { glds16(kp[i] + (size_t)t * 64 * 512, d + i * 4096); glds16(vp[i] + t * 64, d + 16384 + i * 4096); }
  };
  unsigned koff[2];
  const int kr_lo = swap23(ql), ksw = kr_lo & 15;
  koff[0] = kr_lo * 256; koff[1] = (32 + kr_lo) * 256;
  unsigned voff[4];
#pragma unroll
  for (int dt = 0; dt < 4; dt++) { int vrow = dt * 32 + ql; voff[dt] = 16384 + vrow * 128; }
  const int vsw = (ql >> 1) & 7;
  f16v negcv;
#pragma unroll
  for (int i = 0; i < 16; i++) negcv[i] = negc;
  h8 pp0[2], pp1[2];
  unsigned pendV = 0; int pendkt = 0; bool pend = false;
  auto half_step = [&](h8 (&kf)[8], unsigned cur, int kt) {
    h8 vf[8];
    if (pend) {
#pragma unroll
      for (int sp = 0; sp < 2; sp++)
#pragma unroll
        for (int dt = 0; dt < 4; dt++) vf[sp * 4 + dt] = lds128(pendV + voff[dt] + (((pendkt * 4 + sp * 2 + hh) ^ vsw) << 4));
    }
    f16v s0 = mfma32(kf[0], qf[0][0], negcv), s1 = mfma32(kf[4], qf[1][0], negcv);
#pragma unroll
    for (int st = 1; st < 4; st++) { s0 = mfma32(kf[st], qf[0][st], s0); s1 = mfma32(kf[4 + st], qf[1][st], s1); }
    if (pend) {
      WAIT_LGKM(0);
#pragma unroll
      for (int i = 0; i < 8; i++) tie(vf[i]);
#pragma unroll
      for (int sp = 0; sp < 2; sp++)
#pragma unroll
        for (int dt = 0; dt < 4; dt++) { o0[dt] = mfma32(vf[sp * 4 + dt], pp0[sp], o0[dt]); o1[dt] = mfma32(vf[sp * 4 + dt], pp1[sp], o1[dt]); }
    }
#pragma unroll
    for (int i = 0; i < 16; i++) { s0[i] = __builtin_amdgcn_exp2f(s0[i]); ls0 += s0[i]; s1[i] = __builtin_amdgcn_exp2f(s1[i]); ls1 += s1[i]; }
#pragma unroll
    for (int sp = 0; sp < 2; sp++) {
      u4 a, c;
      a[0] = pk2(s0[8*sp+0], s0[8*sp+1]); a[1] = pk2(s0[8*sp+2], s0[8*sp+3]); a[2] = pk2(s0[8*sp+4], s0[8*sp+5]); a[3] = pk2(s0[8*sp+6], s0[8*sp+7]);
      c[0] = pk2(s1[8*sp+0], s1[8*sp+1]); c[1] = pk2(s1[8*sp+2], s1[8*sp+3]); c[2] = pk2(s1[8*sp+4], s1[8*sp+5]); c[3] = pk2(s1[8*sp+6], s1[8*sp+7]);
      pp0[sp] = __builtin_bit_cast(h8, a); pp1[sp] = __builtin_bit_cast(h8, c);
    }
    pend = true; pendV = cur; pendkt = kt;
  };
  issue(0);
  if (ntile > 1) issue(1);
#pragma unroll 1
  for (int t = 0; t < ntile; t++) {
    if (t + 1 < ntile) asm volatile("s_waitcnt vmcnt(8)" ::: "memory"); else wait_vm0();
    raw_barrier();
    if (t + 2 < ntile) issue(t + 2);
    const unsigned cur = sbase + (t & 3) * 32768;
    h8 kfa[8], kfb[8];
#pragma unroll
    for (int st = 0; st < 4; st++) {
      kfa[st] = lds128(cur + koff[0] + (((st * 2 + hh) ^ ksw) << 4));
      kfa[4 + st] = lds128(cur + koff[0] + (((8 + st * 2 + hh) ^ ksw) << 4));
    }
#pragma unroll
    for (int st = 0; st < 4; st++) {
      kfb[st] = lds128(cur + koff[1] + (((st * 2 + hh) ^ ksw) << 4));
      kfb[4 + st] = lds128(cur + koff[1] + (((8 + st * 2 + hh) ^ ksw) << 4));
    }
    WAIT_LGKM(8);
#pragma unroll
    for (int i = 0; i < 8; i++) tie(kfa[i]);
    half_step(kfa, cur, 0);
    WAIT_LGKM(0);
#pragma unroll
    for (int i = 0; i < 8; i++) tie(kfb[i]);
    half_step(kfb, cur, 1);
  }
  {
    h8 vf[8];
#pragma unroll
    for (int sp = 0; sp < 2; sp++)
#pragma unroll
      for (int dt = 0; dt < 4; dt++) vf[sp * 4 + dt] = lds128(pendV + voff[dt] + (((pendkt * 4 + sp * 2 + hh) ^ vsw) << 4));
    WAIT_LGKM(0);
#pragma unroll
    for (int i = 0; i < 8; i++) tie(vf[i]);
#pragma unroll
    for (int sp = 0; sp < 2; sp++)
#pragma unroll
      for (int dt = 0; dt < 4; dt++) { o0[dt] = mfma32(vf[sp * 4 + dt], pp0[sp], o0[dt]); o1[dt] = mfma32(vf[sp * 4 + dt], pp1[sp], o1[dt]); }
  }
  raw_barrier();
  ls0 += shx(ls0, 32); ls1 += shx(ls1, 32);
  const float i0 = 1.f / ls0, i1 = lam / ls1;
  float ss = 0.f;
#pragma unroll
  for (int dt = 0; dt < 4; dt++)
#pragma unroll
    for (int i = 0; i < 16; i++) { float v = o0[dt][i] * i0 - o1[dt][i] * i1; o0[dt][i] = v; ss += v * v; }
  ss += shx(ss, 32);
  const float mult = rsqrtf(ss * (1.f / 128.f) + EPS) * (1.f - lam_init);
  const float* sg = P.subln_g + l * 128;
  half_t* dst = P.mix + (size_t)myrow * D + 256 + head * 128;
#pragma unroll
  for (int dt = 0; dt < 4; dt++)
#pragma unroll
    for (int g = 0; g < 4; g++) {
      const int d0 = dt * 32 + 8 * g + 4 * hh;
      float4 gv = *(const float4*)(sg + d0);
      h4 o; o[0] = (half_t)(o0[dt][4*g] * mult * gv.x); o[1] = (half_t)(o0[dt][4*g+1] * mult * gv.y);
      o[2] = (half_t)(o0[dt][4*g+2] * mult * gv.z); o[3] = (half_t)(o0[dt][4*g+3] * mult * gv.w);
      *(h4*)(dst + d0) = o;
    }
}

DI int swz128(int row, int colh) { return row * 128 + ((((colh >> 3)) ^ ((row >> 1) & 7)) << 4) + (colh & 7) * 2; }
DI void lru_load_w(const Params& P, int l, int g, char* Wt) {
  const int tid = TIDX;
  for (int dg = 0; dg < 4; dg++) {
    const int dir = dg >> 1;
    const float* w = ((dg & 1) ? P.gate_x_w : P.gate_a_w) + ((size_t)((l * 2 + dir) * 4 + g)) * 4096;
    for (int idx = tid; idx < 4096; idx += 256) { int i = idx >> 6, o = idx & 63; *(half_t*)(Wt + dg * 8192 + swz128(o, i)) = (half_t)w[idx]; }
  }
}
DI void lru_tile(const Params& P, int l, int b, int tile, int g, char* smem, bool final) {
  const int tid = TIDX, lane = tid & 63, wave = tid >> 6, fr = lane & 15, fq = lane >> 4;
  char* Wt = smem;
  char* xr16 = smem + 32768;
  float2* ab = (float2*)(smem + 40960);
  half_t* raw = (half_t*)(smem + 40960);
  float2* subst = (float2*)(smem + 73728);
  const int ch = tid & 63, tq = tid >> 6, gc = g * 64 + ch;
  const int T = tile < 4 ? CL : SEQ;
  const int t0 = tile < 4 ? tile * 64 : (tile - 4) * 64;
  const int rowbase = tile < 4 ? b * CL : TC + b * SEQ;
  unsigned* lab = (unsigned*)P.hx;
  __syncthreads();
  if (final) {
    float gyv[16], hsum[16];
#pragma unroll
    for (int e = 0; e < 16; e++) { gyv[e] = (float)P.gy[(size_t)(rowbase + t0 + tq * 16 + e) * 256 + gc]; hsum[e] = 0.f; }
#pragma unroll 1
    for (int dir = 0; dir < 2; dir++) {
      unsigned pk[16];
#pragma unroll
      for (int e = 0; e < 16; e++) pk[e] = lab[((size_t)dir * TA + rowbase + t0 + tq * 16 + e) * 256 + gc];
      float2 av[16];
      float A = 1.f, h = 0.f;
#pragma unroll
      for (int e = 0; e < 16; e++) {
        const int ee = dir == 0 ? e : 15 - e;
        unsigned u = pk[0];
#pragma unroll
        for (int q = 1; q < 16; q++) u = (q == ee) ? pk[q] : u;
        fp16x2 hv = __builtin_bit_cast(fp16x2, u);
        av[e] = make_float2(__expf((float)hv[0]), (float)hv[1]);
        h = av[e].x * h + av[e].y; A *= av[e].x;
      }
      subst[tq * 64 + ch] = make_float2(A, h);
      __syncthreads();
      h = P.lcar[((size_t)((b * 2 + dir) * 132 + tile)) * 256 + gc];
      if (dir == 0) { for (int s2 = 0; s2 < tq; s2++) { float2 ss = subst[s2 * 64 + ch]; h = ss.x * h + ss.y; } }
      else { for (int s2 = 3; s2 > tq; s2--) { float2 ss = subst[s2 * 64 + ch]; h = ss.x * h + ss.y; } }
#pragma unroll
      for (int e = 0; e < 16; e++) {
        const int ee = dir == 0 ? e : 15 - e;
        h = av[e].x * h + av[e].y;
#pragma unroll
        for (int q = 0; q < 16; q++) hsum[q] += (q == ee) ? h : 0.f;
      }
      __syncthreads();
    }
#pragma unroll
    for (int e = 0; e < 16; e++)
      P.mix[(size_t)(rowbase + t0 + tq * 16 + e) * D + 768 + gc] = (half_t)(gyv[e] * hsum[e]);
    return;
  }
  for (int idx = tid; idx < 67 * 8; idx += 256) {
    int row = idx >> 3, c = idx & 7, tt = t0 - 1 + row;
    h8 v = {0, 0, 0, 0, 0, 0, 0, 0};
    if (tt >= 0 && tt < T) v = *(const h8*)(P.rr + (size_t)(rowbase + tt) * 256 + g * 64 + c * 8);
    *(h8*)(raw + row * 64 + c * 8) = v;
  }
  const float cw0 = P.conv_w[(l * 4 + 0) * 256 + gc], cw1 = P.conv_w[(l * 4 + 1) * 256 + gc], cw2 = P.conv_w[(l * 4 + 2) * 256 + gc],
              cw3 = P.conv_w[(l * 4 + 3) * 256 + gc], cb = P.conv_b[l * 256 + gc];
  __syncthreads();
  {
    float v[19];
#pragma unroll
    for (int e = 0; e < 19; e++) v[e] = (float)raw[(tq * 16 + e) * 64 + ch];
    __syncthreads();
#pragma unroll
    for (int e = 0; e < 16; e++) {
      float xv = cb + cw0 * v[e] + cw1 * v[e + 1] + cw2 * v[e + 2] + cw3 * v[e + 3];
      *(half_t*)(xr16 + swz128(tq * 16 + e, ch)) = (half_t)xv;
    }
  }
  __syncthreads();
#pragma unroll 1
  for (int dir = 0; dir < 2; dir++) {
    {
      f4 acc[2][4];
#pragma unroll
      for (int gt = 0; gt < 2; gt++)
#pragma unroll
        for (int n = 0; n < 4; n++) acc[gt][n] = (f4){0.f, 0.f, 0.f, 0.f};
#pragma unroll
      for (int kk = 0; kk < 2; kk++) {
        int row = wave * 16 + fr;
        h8 af = *(const h8*)(xr16 + row * 128 + (((kk * 4 + fq) ^ ((row >> 1) & 7)) << 4));
#pragma unroll
        for (int gt = 0; gt < 2; gt++)
#pragma unroll
          for (int n = 0; n < 4; n++) {
            int orow = n * 16 + fr;
            h8 bf = *(const h8*)(Wt + (dir * 2 + gt) * 8192 + orow * 128 + (((kk * 4 + fq) ^ ((orow >> 1) & 7)) << 4));
            acc[gt][n] = mfma16(af, bf, acc[gt][n]);
          }
      }
#pragma unroll
      for (int n = 0; n < 4; n++) {
        const int cc = (l * 2 + dir) * 256 + g * 64 + n * 16 + fr;
        const float ba = P.gate_a_b[cc], bx = P.gate_x_b[cc];
        const float sp8 = -8.f * log1pf(__expf(-P.lru_lambda[cc]));
#pragma unroll
        for (int j = 0; j < 4; j++) {
          int tl = wave * 16 + fq * 4 + j, c2 = n * 16 + fr;
          float xv = (float)*(const half_t*)(xr16 + swz128(tl, c2));
          float rg = sigmoidf_(acc[0][n][j] + ba), ig = sigmoidf_(acc[1][n][j] + bx);
          float log_a = rg * sp8;
          float x2 = 2.f * log_a;
          float om = -x2 * (1.f + x2 * (0.5f + x2 * (0.16666667f + x2 * (0.041666668f + x2 * (0.008333334f + x2 * 0.0013888889f)))));
          if (x2 < -0.4f) { float a = __expf(log_a); om = 1.f - a * a; }
          ab[tl * 64 + c2] = make_float2(log_a, sqrtf(om) * (ig * xv));
        }
      }
    }
    __syncthreads();
    {
      float A = 1.f, h = 0.f;
#pragma unroll
      for (int e = 0; e < 16; e++) {
        const int ee = dir == 0 ? e : 15 - e;
        const float2 lb = ab[(tq * 16 + ee) * 64 + ch];
        fp16x2 hv; hv[0] = (__fp16)lb.x; hv[1] = (__fp16)lb.y;
        lab[((size_t)dir * TA + rowbase + t0 + tq * 16 + ee) * 256 + gc] = __builtin_bit_cast(unsigned, hv);
        const float a = __expf((float)hv[0]), bt = (float)hv[1];
        h = a * h + bt; A *= a;
      }
      subst[tq * 64 + ch] = make_float2(A, h);
    }
    __syncthreads();
    if (tq == 0) {
      float A = 1.f, h = 0.f;
#pragma unroll
      for (int s2 = 0; s2 < 4; s2++) { float2 ss = subst[(dir == 0 ? s2 : 3 - s2) * 64 + ch]; h = ss.x * h + ss.y; A *= ss.x; }
      P.lsum[((size_t)((b * 2 + dir) * 132 + tile)) * 256 + gc] = make_float2(A, h);
    }
    __syncthreads();
  }
}
DI void lru_carry_item(const Params& P, int it) {
  const int ch = TIDX, dir = it & 1;
  const size_t base = (size_t)it * 132 * 256 + ch;
  float c = 0.f;
#pragma unroll 4
  for (int k = 0; k < 132; k++) {
    int tile = dir == 0 ? k : (k < 4 ? 3 - k : 135 - k);
    float2 s = P.lsum[base + (size_t)tile * 256];
    P.lcar[base + (size_t)tile * 256] = c;
    c = s.x * c + s.y;
  }
}

DI void fft_load(const half_t* src, size_t rs, int nrows, char* Bt, int rowbytes, int k0) {
  for (int idx = TIDX; idx < nrows * 16; idx += 256) {
    int kr = idx >> 4, cc = idx & 15, k = k0 + kr;
    h8 v = *(const h8*)(src + (size_t)kr * rs + cc * 8);
#pragma unroll
    for (int u = 0; u < 8; u++) { int n = cc * 8 + u; *(half_t*)(Bt + n * rowbytes + ((((k >> 3)) ^ (n & 15)) << 4) + (k & 7) * 2) = v[u]; }
  }
}
template <class RF>
DI void fft_mma(const half_t* Dm, int ldD, int nkk, const char* Bt, int rowbytes, f4 (&acc)[4][4], RF arow) {
  const int lane = TIDX & 63, wave = TIDX >> 6, fr = lane & 15, fq = lane >> 4, wc = wave & 1;
#pragma unroll 1
  for (int kk = 0; kk < nkk; kk++) {
    h8 af[4], bf[4];
#pragma unroll
    for (int ms = 0; ms < 4; ms++) af[ms] = *(const h8*)(Dm + (size_t)arow(ms) * ldD + kk * 32 + fq * 8);
#pragma unroll
    for (int ns = 0; ns < 4; ns++) { int n = wc * 64 + ns * 16 + fr; bf[ns] = *(const h8*)(Bt + n * rowbytes + (((kk * 4 + fq) ^ (n & 15)) << 4)); }
#pragma unroll
    for (int ms = 0; ms < 4; ms++)
#pragma unroll
      for (int ns = 0; ns < 4; ns++) acc[ms][ns] = mfma16(af[ms], bf[ns], acc[ms][ns]);
  }
}
DI void zero44(f4 (&acc)[4][4]) {
#pragma unroll
  for (int m = 0; m < 4; m++)
#pragma unroll
    for (int n = 0; n < 4; n++) acc[m][n] = (f4){0.f, 0.f, 0.f, 0.f};
}
DI void fftA_item(const Params& P, int it, char* smem) {
  const int b = it >> 8, bb = (it >> 1) & 127, chh = it & 1;
  const int lane = TIDX & 63, wave = TIDX >> 6, fr = lane & 15, fq = lane >> 4, wr = wave >> 1, wc = wave & 1;
  __syncthreads();
  fft_load(P.QF + (size_t)(TC + b * SEQ + bb) * 512 + chh * 128, (size_t)128 * 512, 64, smem, 256, 0);
  fft_load(P.QF + (size_t)(TC + b * SEQ + bb) * 512 + 256 + chh * 128, (size_t)128 * 512, 64, smem, 256, 64);
  __syncthreads();
  f4 acc[4][4]; zero44(acc);
  fft_mma(P.DA, 128, 4, smem, 256, acc, [&](int ms) { return (ms >> 1) * 64 + wr * 32 + (ms & 1) * 16 + fr; });
#pragma unroll
  for (int ms = 0; ms < 2; ms++)
#pragma unroll
    for (int j = 0; j < 4; j++) {
      const int f1 = wr * 32 + ms * 16 + fq * 4 + j;
      const float2 w = P.tw[(bb * f1) & 8191];
      half_t* d0 = P.GA + ((size_t)(b * 64 + f1) * 256 + bb) * 256 + chh * 128 + wc * 64 + fr;
#pragma unroll
      for (int ns = 0; ns < 4; ns++) {
        float gr = acc[ms][ns][j], gi = acc[ms + 2][ns][j];
        d0[ns * 16] = (half_t)(gr * w.x + gi * w.y);
        d0[(size_t)128 * 256 + ns * 16] = (half_t)(gi * w.x - gr * w.y);
      }
    }
}
DI void fftB_item(const Params& P, int it, char* smem) {
  const int b = it >> 7, f1 = (it >> 1) & 63, chh = it & 1;
  const int lane = TIDX & 63, wave = TIDX >> 6, fr = lane & 15, fq = lane >> 4, wr = wave >> 1, wc = wave & 1;
  __syncthreads();
  fft_load(P.GA + (size_t)(b * 64 + f1) * 256 * 256 + chh * 128, 256, 256, smem, 512, 0);
  __syncthreads();
  f4 acc[4][4]; zero44(acc);
  fft_mma(P.DB, 256, 8, smem, 512, acc, [&](int ms) { return wr * 64 + ms * 16 + fr; });
#pragma unroll
  for (int ms = 0; ms < 4; ms++)
#pragma unroll
    for (int j = 0; j < 4; j++) {
      const int f2 = wr * 64 + ms * 16 + fq * 4 + j;
      half_t* d0 = P.mix + (size_t)(TC + b * SEQ + f1 + 64 * f2) * D + chh * 128 + wc * 64 + fr;
#pragma unroll
      for (int ns = 0; ns < 4; ns++) d0[ns * 16] = (half_t)acc[ms][ns][j];
    }
}
DI void fftC_item(const Params& P, int it, char* smem) {
  const int b = it >> 1, chh = it & 1;
  const int lane = TIDX & 63, wave = TIDX >> 6, fr = lane & 15, fq = lane >> 4, wr = wave >> 1, wc = wave & 1;
#pragma unroll 1
  for (int mh = 0; mh < 2; mh++) {
    f4 acc[4][4]; zero44(acc);
#pragma unroll 1
    for (int part = 0; part < 2; part++) {
      __syncthreads();
      fft_load(P.QF + (size_t)(b * CL) * 512 + part * 256 + chh * 128, 512, 256, smem, 512, 0);
      __syncthreads();
      fft_mma(P.DC + part * 256, 512, 8, smem, 512, acc, [&](int ms) { return mh * 128 + wr * 64 + ms * 16 + fr; });
    }
#pragma unroll
    for (int ms = 0; ms < 4; ms++)
#pragma unroll
      for (int j = 0; j < 4; j++) {
        const int f = mh * 128 + wr * 64 + ms * 16 + fq * 4 + j;
        half_t* d0 = P.mix + (size_t)(b * CL + f) * D + chh * 128 + wc * 64 + fr;
#pragma unroll
        for (int ns = 0; ns < 4; ns++) d0[ns * 16] = (half_t)acc[ms][ns][j];
      }
  }
}

#ifndef MX
#define MX 15
#endif
DI void mix_phase(const Params& P, int l, char* smem, int* s_item, int qi) {
  const int nL = 0, nA = 0, nC = l == 0 ? 64 : 0, nFA = 2048, nFC = l == 0 ? 16 : 0;
  const int total = nL + nA + nC + nFA + nFC;
  {
    const int g = blockIdx.x & 3;
    lru_load_w(P, l, g, smem);
    for (int u = blockIdx.x >> 2; u < NB_ * 132; u += gridDim.x >> 2) lru_tile(P, l, u / 132, u % 132, g, smem, false);
  }
  int stage = 0;
  for (;;) {
    __syncthreads();
    if (TIDX == 0) *s_item = stage == 0 ? atomicAdd(&P.qctr[8 + qi * 8 + (blockIdx.x & 7)], 1) : atomicAdd(&P.qctr[qi], 1);
    __syncthreads();
    int it = *s_item;
    int kind = -1, b = 0, head = 0, row0 = 0, nk = 0;
    if (stage == 0) {
      if (it >= 256) { stage = 1; continue; }
      const int pair = (blockIdx.x & 7) + 8 * (it >> 6);
      b = pair >> 2; head = pair & 3; row0 = TC + b * SEQ + (it & 63) * 128; nk = KV; kind = 0;
    } else {
      if (it >= total) break;
      if (it < nC) { b = it >> 3; head = (it >> 1) & 3; row0 = b * CL + (it & 1) * 128; nk = CL; kind = 0; }
      else if (it < nC + nFA) { kind = 1; it -= nC; }
      else { kind = 2; it -= nC + nFA; }
    }
    if (kind == 0) attn_item(P, l, b, head, row0, nk, smem);
    else if (kind == 1) fftA_item(P, it, smem);
    else fftC_item(P, it, smem);
  }
}

DI void grid_barrier(unsigned* ctr, unsigned target) {
  asm volatile("s_waitcnt vmcnt(0)" ::: "memory");
  __syncthreads();
  if (threadIdx.x == 0) {
    __builtin_amdgcn_fence(__ATOMIC_RELEASE, "agent");
    asm volatile("s_waitcnt vmcnt(0)" ::: "memory");
    __hip_atomic_fetch_add(ctr, 1u, __ATOMIC_RELAXED, __HIP_MEMORY_SCOPE_AGENT);
    while (__hip_atomic_load(ctr, __ATOMIC_RELAXED, __HIP_MEMORY_SCOPE_AGENT) < target) __builtin_amdgcn_s_sleep(1);
    __builtin_amdgcn_fence(__ATOMIC_ACQUIRE, "agent");
    asm volatile("s_waitcnt vmcnt(0)" ::: "memory");
  }
  __syncthreads();
}
__global__ void __launch_bounds__(256, 1) fwd_megakernel(Params Pin) {
  Params P = Pin; bind_ws(P);
  __shared__ __attribute__((aligned(16))) char smem[147456 + 8192];
  __shared__ int tb[33];
  __shared__ int s_item;
  cg::grid_group grid = cg::this_grid();
  unsigned* bar = (unsigned*)(P.ws + O_bar); unsigned bk = 0;
#ifndef PH
#define PH 0xFFFF
#endif
#if PH & 1
  phase0(P, smem);
#endif
  grid.sync();
  for (int l = 0; l < 2; l++) {
#if PH & 2
    row1_phase(P, l == 0 ? -1 : 0, l, 0);
#endif
    grid_barrier(bar, (++bk) * gridDim.x);
#if PH & 4
    gemm_in_phase(P, l, smem);
#ifdef DUP_GEMM
    grid_barrier(bar, (++bk) * gridDim.x);
    gemm_in_phase(P, l, smem);
#endif
#endif
    grid_barrier(bar, (++bk) * gridDim.x);
#if PH & 8
    mix_phase(P, l, smem, &s_item, l);
#ifdef DUP_MIX
    grid_barrier(bar, (++bk) * gridDim.x);
    mix_phase(P, l, smem, &s_item, 2 + l);
#endif
#endif
    grid_barrier(bar, (++bk) * gridDim.x);
#if PH & 16
    if (blockIdx.x >= gridDim.x - 16) lru_carry_item(P, gridDim.x - 1 - blockIdx.x);
    for (int it = blockIdx.x; it < 1024; it += gridDim.x) fftB_item(P, it, smem);
#endif
    grid_barrier(bar, (++bk) * gridDim.x);
#if PH & 512
    {
      const int g = blockIdx.x & 3;
      for (int u = blockIdx.x >> 2; u < NB_ * 132; u += gridDim.x >> 2) lru_tile(P, l, u / 132, u % 132, g, smem, true);
    }
#endif
    grid_barrier(bar, (++bk) * gridDim.x);
#if PH & 32
    gemm_out_phase(P, l, smem);
#endif
    grid_barrier(bar, (++bk) * gridDim.x);
#if PH & 64
    row2_phase(P, l, l == 0 ? 0 : TC, smem);
#endif
    grid_barrier(bar, (++bk) * gridDim.x);
#if PH & 128
    moe_e1_phase(P, l, smem, tb);
#ifdef DUP_GEMM
    grid_barrier(bar, (++bk) * gridDim.x);
    moe_e1_phase(P, l, smem, tb);
#endif
#endif
    grid_barrier(bar, (++bk) * gridDim.x);
#if PH & 256
    moe_e2_phase(P, l, smem, tb);
#ifdef DUP_GEMM
    grid_barrier(bar, (++bk) * gridDim.x);
    moe_e2_phase(P, l, smem, tb);
#endif
#endif
    grid_barrier(bar, (++bk) * gridDim.x);
  }
#if PH & 2
  row1_phase(P, 1, -1, TC);
#endif
}

extern "C" void kernel_launch(void* const* d_in, const int* in_sizes, int n_in, void* d_out, int out_size, void* d_ws, size_t ws_size,
                              hipStream_t stream) {
  static int grid_blocks = 0;
  if (!grid_blocks) {
    int dev = 0, cus = 0, per_cu = 0;
    hipGetDevice(&dev);
    hipDeviceGetAttribute(&cus, hipDeviceAttributeMultiprocessorCount, dev);
    hipOccupancyMaxActiveBlocksPerMultiprocessor(&per_cu, fwd_megakernel, 256, 0);
    if (per_cu > 2) per_cu = 2;
    grid_blocks = cus * per_cu;
    if (grid_blocks > 256) grid_blocks = 256;
  }
  if (grid_blocks != 256) { fprintf(stderr, "need 256 co-resident blocks, have %d\n", grid_blocks); return; }
  Params p{};
  const float** pin = (const float**)&p;
  for (int i = 0; i < 31; i++) pin[i] = (const float*)d_in[i];
  p.out = (float*)d_out;
  p.ws = (char*)d_ws;
  if (WS_NEED > ws_size) { fprintf(stderr, "workspace too small: need %zu have %zu\n", (size_t)WS_NEED, ws_size); return; }
  hipMemsetAsync((char*)d_ws + O_bar, 0, 256, stream);
  void* args[] = {&p};
  hipError_t e = hipLaunchCooperativeKernel((void*)fwd_megakernel, dim3(grid_blocks), dim3(256), args, 0, stream);
  if (e != hipSuccess) fprintf(stderr, "cooperative launch failed: %s (grid %d)\n", hipGetErrorString(e), grid_blocks);
}
```

```cpp
#include <hip/hip_runtime.h>
#include <hip/hip_cooperative_groups.h>
#include <cstdio>
namespace cg = cooperative_groups;

typedef _Float16 half_t;
typedef _Float16 h8 __attribute__((ext_vector_type(8)));
typedef _Float16 h4 __attribute__((ext_vector_type(4)));
typedef __fp16 fp16x2 __attribute__((ext_vector_type(2)));
typedef unsigned u4 __attribute__((ext_vector_type(4)));
typedef float f4 __attribute__((ext_vector_type(4)));
typedef float f16v __attribute__((ext_vector_type(16)));
#define DI __device__ __forceinline__
__device__ __forceinline__ int tid_opaque() { int t = threadIdx.x; asm volatile("" : "+v"(t)); return t; }
#define TIDX tid_opaque()

constexpr int D = 1024, NB_ = 8, SEQ = 8192, CL = 256;
constexpr int TC = NB_ * CL;
constexpr int TX = NB_ * SEQ;
constexpr int TA = TC + TX;
constexpr int KV = CL + SEQ;
constexpr int NIN = 2560;
constexpr int LCAP = 2 * TA;
constexpr float EPS = 1e-6f;

struct Params {
  const float *x, *c, *ctx, *c_ctx, *w_mod, *b_mod, *norm1_g, *norm2_g, *w_in, *q_norm_g, *k_norm_g, *lq1, *lk1, *lq2, *lk2,
      *subln_g, *conv_w, *conv_b, *gate_a_w, *gate_a_b, *gate_x_w, *gate_x_b, *lru_lambda, *w_out, *w_group, *b_group,
      *w_router, *b_router, *w1, *w3, *w2;
  float* out; char* ws;
  half_t *WtIn, *WtOut, *Wt1, *Wt3, *Wt2;
  float* mod; float2* rope; float2* tw; half_t *DA, *DB, *DC; float* consts; int* cnt; int* qctr; float* tokW; int* list; float* listW;
  float* xcbuf; half_t* WrH;
  half_t *hx, *mix, *q, *kall, *vT, *QF, *gy, *rr; float2* lsum; float* lcar; half_t* GA; half_t *H, *yA;
};


constexpr size_t al256(size_t x) { return (x + 255) & ~(size_t)255; }
constexpr size_t O_WtIn = 0;
constexpr size_t O_WtOut = O_WtIn + al256((size_t)2 * NIN * 1024 * 2);
constexpr size_t O_Wt1 = O_WtOut + al256((size_t)2 * 1024 * 1024 * 2);
constexpr size_t O_Wt3 = O_Wt1 + al256((size_t)64 * 524288 * 2);
constexpr size_t O_Wt2 = O_Wt3 + al256((size_t)64 * 524288 * 2);
constexpr size_t O_mod = O_Wt2 + al256((size_t)64 * 524288 * 2);
constexpr size_t O_rope = O_mod + al256((size_t)2 * 9 * 6144 * 4);
constexpr size_t O_tw = O_rope + al256(128 * 16 * 8);
constexpr size_t O_DA = O_tw + al256(8192 * 8);
constexpr size_t O_DB = O_DA + al256(16384 * 2);
constexpr size_t O_DC = O_DB + al256(32768 * 2);
constexpr size_t O_consts = O_DC + al256(131072 * 2);
constexpr size_t O_cnt = O_consts + 256;
constexpr size_t O_qctr = O_cnt + 256;
constexpr size_t O_bar = O_qctr + 256;
constexpr size_t O_tokW = O_bar + 256;
constexpr size_t O_list = O_tokW + al256((size_t)2 * TA * 4);
constexpr size_t O_listW = O_list + al256((size_t)32 * LCAP * 4);
constexpr size_t O_xcbuf = O_listW + al256((size_t)32 * LCAP * 4);
constexpr size_t O_WrT = O_xcbuf + al256((size_t)TC * D * 4);
constexpr size_t O_hx = O_WrT + al256((size_t)2 * 2 * 48 * 1024 * 2);
constexpr size_t O_mix = O_hx + al256((size_t)TA * D * 2);
constexpr size_t O_regB = O_mix + al256((size_t)TA * D * 2);
constexpr size_t O_q = O_regB;
constexpr size_t O_kall = O_q + al256((size_t)TA * 512 * 2);
constexpr size_t O_vT = O_kall + al256((size_t)NB_ * KV * 512 * 2);
constexpr size_t O_QF = O_vT + al256((size_t)NB_ * 4 * 128 * KV * 2);
constexpr size_t O_gy = O_QF + al256((size_t)TA * 512 * 2);
constexpr size_t O_rr = O_gy + al256((size_t)TA * 256 * 2);
constexpr size_t O_lsum = O_rr + al256((size_t)TA * 256 * 2);
constexpr size_t O_lcar = O_lsum + al256((size_t)16 * 132 * 256 * 8);
constexpr size_t O_GA = O_lcar + al256((size_t)16 * 132 * 256 * 4);
constexpr size_t O_mixer_end = O_GA + al256((size_t)NB_ * 64 * 256 * 256 * 2);
constexpr size_t O_H = O_regB;
constexpr size_t O_yA = O_H + al256((size_t)(2 * TA + 32 * 256) * 512 * 2);
constexpr size_t O_moe_end = O_yA + al256((size_t)2 * TA * D * 2);
constexpr size_t WS_NEED = O_mixer_end > O_moe_end ? O_mixer_end : O_moe_end;
DI void bind_ws(Params& P) {
  char* w = P.ws;
  P.WtIn = (half_t*)(w + O_WtIn); P.WtOut = (half_t*)(w + O_WtOut); P.Wt1 = (half_t*)(w + O_Wt1); P.Wt3 = (half_t*)(w + O_Wt3); P.Wt2 = (half_t*)(w + O_Wt2);
  P.mod = (float*)(w + O_mod); P.rope = (float2*)(w + O_rope); P.tw = (float2*)(w + O_tw); P.DA = (half_t*)(w + O_DA); P.DB = (half_t*)(w + O_DB); P.DC = (half_t*)(w + O_DC);
  P.consts = (float*)(w + O_consts); P.cnt = (int*)(w + O_cnt); P.qctr = (int*)(w + O_qctr); P.tokW = (float*)(w + O_tokW); P.list = (int*)(w + O_list); P.listW = (float*)(w + O_listW);
  P.xcbuf = (float*)(w + O_xcbuf); P.WrH = (half_t*)(w + O_WrT); P.hx = (half_t*)(w + O_hx); P.mix = (half_t*)(w + O_mix);
  P.q = (half_t*)(w + O_q); P.kall = (half_t*)(w + O_kall); P.vT = (half_t*)(w + O_vT); P.QF = (half_t*)(w + O_QF); P.gy = (half_t*)(w + O_gy); P.rr = (half_t*)(w + O_rr);
  P.lsum = (float2*)(w + O_lsum); P.lcar = (float*)(w + O_lcar); P.GA = (half_t*)(w + O_GA); P.H = (half_t*)(w + O_H); P.yA = (half_t*)(w + O_yA);
}
DI float shx(float v, int o) { int ln = TIDX & 63; return __builtin_bit_cast(float, __builtin_amdgcn_ds_bpermute((ln ^ o) << 2, __builtin_bit_cast(int, v))); }
DI float shi(float v, int idx) { return __builtin_bit_cast(float, __builtin_amdgcn_ds_bpermute(idx << 2, __builtin_bit_cast(int, v))); }
DI float wave_sum(float v) {
#pragma unroll
  for (int o = 32; o; o >>= 1) v += shx(v, o);
  return v;
}
DI void glds16(const void* g, void* l) {
  __builtin_amdgcn_global_load_lds((const unsigned*)g, (unsigned*)l, 16, 0, 0);
}
DI void wait_vm0() { asm volatile("s_waitcnt vmcnt(0)" ::: "memory"); }
DI f4 mfma16(h8 a, h8 b, f4 c) { return __builtin_amdgcn_mfma_f32_16x16x32_f16(a, b, c, 0, 0, 0); }
DI f16v mfma32(h8 a, h8 b, f16v c) { return __builtin_amdgcn_mfma_f32_32x32x16_f16(a, b, c, 0, 0, 0); }
DI unsigned pk2(float a, float b) { fp16x2 r = __builtin_amdgcn_cvt_pkrtz(a, b); return __builtin_bit_cast(unsigned, r); }
DI float sigmoidf_(float x) { return 1.f / (1.f + __expf(-x)); }
DI float gelu_tanh(float x) {
  float u = 0.7978845608028654f * (x + 0.044715f * x * x * x);
  float e = __expf(2.f * u);
  float t = 1.f - 2.f / (e + 1.f);
  return 0.5f * x * (1.f + t);
}
DI int row_mod(int r) { return r < TC ? 8 : ((r - TC) >> 13); }

DI void transpose_tile4(const float* src, int lds_, half_t* dst, int ldd, float* tile) {
  const int tid = TIDX;
  {
    const int k0 = tid >> 6, c4 = tid & 63;
    const float* sp = src + (size_t)k0 * lds_ + c4 * 4;
    float* tp = tile + (c4 >> 4) * 4352 + k0 * 68 + (c4 & 15) * 4;
#pragma unroll
    for (int i = 0; i < 16; i++) *(float4*)(tp + i * 4 * 68) = *(const float4*)(sp + (size_t)i * 4 * lds_);
  }
  __syncthreads();
#pragma unroll
  for (int i = 0; i < 8; i++) {
    int idx = i * 256 + tid, j = idx >> 9, r = idx & 511, kc = r >> 6, n = r & 63;
    const float* t = tile + j * 4352 + kc * 8 * 68 + n;
    h8 o;
#pragma unroll
    for (int u = 0; u < 8; u++) o[u] = (half_t)t[u * 68];
    *(h8*)(dst + (size_t)(j * 64 + n) * ldd + kc * 8) = o;
  }
  __syncthreads();
}

DI void phase0(const Params& P, char* smem) {
  float* tile = (float*)smem;
  const int tid = TIDX;
  constexpr int NT = 6528, NF = 128, NM = 192, NX = 6;
  for (int t = blockIdx.x; t < NT + NF + NM + NX; t += gridDim.x) {
    if (t < NT) {
      const float* src; half_t* dst; int lds_, ldd;
      if (t < 256) {
        int l = t / 128, r = t % 128, kt = r / 8, nt = (r % 8) * 4;
        src = P.w_in + (size_t)l * 1024 * 2304 + (size_t)kt * 64 * 2304 + 256 + nt * 64; lds_ = 2304;
        dst = P.WtIn + (size_t)l * NIN * 1024 + (size_t)(512 + nt * 64) * 1024 + kt * 64; ldd = 1024;
      } else if (t < 384) {
        int u = t - 256, l = u / 64, r = u % 64, kt = r / 4, nt = (r % 4) * 4;
        src = P.w_out + (size_t)l * 1048576 + (size_t)kt * 64 * 1024 + nt * 64; lds_ = 1024;
        dst = P.WtOut + (size_t)l * 1048576 + (size_t)nt * 64 * 1024 + kt * 64; ldd = 1024;
      } else if (t < 384 + 4096) {
        int u = t - 384; const float* w = P.w1; half_t* o = P.Wt1;
        if (u >= 2048) { u -= 2048; w = P.w3; o = P.Wt3; }
        int le = u / 32, r = u % 32, kt = r / 2, nt = (r % 2) * 4;
        src = w + (size_t)le * 524288 + (size_t)kt * 64 * 512 + nt * 64; lds_ = 512;
        dst = o + (size_t)le * 524288 + (size_t)nt * 64 * 1024 + kt * 64; ldd = 1024;
      } else {
        int u = t - 384 - 4096, le = u / 32, r = u % 32, kt = r / 4, nt = (r % 4) * 4;
        src = P.w2 + (size_t)le * 524288 + (size_t)kt * 64 * 1024 + nt * 64; lds_ = 1024;
        dst = P.Wt2 + (size_t)le * 524288 + (size_t)nt * 64 * 512 + kt * 64; ldd = 512;
      }
      transpose_tile4(src, lds_, dst, ldd, tile);
    } else if (t < NT + NF) {
      int f = t - NT, l = f / 64, r = f % 64, kt = r / 4, g = r % 4;
      float* cst = tile + 64 * 65; float* snt = cst + 64;
      const float* src = P.w_in + (size_t)l * 1024 * 2304 + (size_t)kt * 64 * 2304 + g * 64;
      { int n = tid & 63, kq = tid >> 6;
        for (int i = 0; i < 16; i++) { int k = i * 4 + kq; tile[k * 65 + n] = src[(size_t)k * 2304 + n]; } }
      if (tid < 64) { float s, c; sincospif((float)tid / 32.f, &s, &c); cst[tid] = c; snt[tid] = s; }
      __syncthreads();
      int k = tid & 63, jq = tid >> 6;
      half_t* o = P.WtIn + (size_t)l * NIN * 1024 + kt * 64 + k;
      for (int jj = 0; jj < 16; jj++) {
        int j = jq * 16 + jj; float ac = 0.f, as = 0.f;
        for (int c = 0; c < 64; c++) { float v = tile[k * 65 + c]; int idx = (c * j) & 63; ac += v * cst[idx]; as += v * snt[idx]; }
        o[(size_t)(g * 64 + j) * 1024] = (half_t)(ac * 0.125f);
        o[(size_t)(256 + g * 64 + j) * 1024] = (half_t)(-as * 0.125f);
      }
      __syncthreads();
    } else if (t < NT + NF + NM) {
      int mi = t - NT - NF, l = mi / 96, col0 = (mi % 96) * 64;
      float* scond = tile; float* red = tile + 9216;
      for (int idx = tid; idx < 9216; idx += 256) {
        int n = idx >> 10, k = idx & 1023; float v = n < 8 ? P.c[n * 1024 + k] : P.c_ctx[k];
        scond[idx] = v / (1.f + expf(-v));
      }
      __syncthreads();
      int col = tid & 63, kq = tid >> 6; float acc[9];
#pragma unroll
      for (int n = 0; n < 9; n++) acc[n] = 0.f;
      const float* w = P.w_mod + ((size_t)l * 1024 + kq * 256) * 6144 + col0 + col;
#pragma unroll 16
      for (int k = 0; k < 256; k++) {
        float wv = w[(size_t)k * 6144];
#pragma unroll
        for (int n = 0; n < 9; n++) acc[n] += scond[n * 1024 + kq * 256 + k] * wv;
      }
#pragma unroll
      for (int n = 0; n < 9; n++) red[(kq * 9 + n) * 64 + col] = acc[n];
      __syncthreads();
      for (int idx = tid; idx < 576; idx += 256) {
        int n = idx / 64, cc = idx % 64;
        float s = red[(0 * 9 + n) * 64 + cc] + red[(1 * 9 + n) * 64 + cc] + red[(2 * 9 + n) * 64 + cc] + red[(3 * 9 + n) * 64 + cc];
        P.mod[(size_t)(l * 9 + n) * 6144 + col0 + cc] = s + P.b_mod[l * 6144 + col0 + cc];
      }
      __syncthreads();
    } else {
      int m = t - NT - NF - NM;
      if (m == 0) {
        for (int idx = tid; idx < 128 * 16; idx += 256) {
          int pos = idx >> 4, i = idx & 15; float f = powf(10000.f, -(float)i / 16.f); float ang = (float)pos * f;
          float s, c; sincosf(ang, &s, &c); P.rope[idx] = make_float2(c, s);
        }
      } else if (m == 1) {
        for (int j = tid; j < 8192; j += 256) { float s, c; sincospif((float)j / 4096.f, &s, &c); P.tw[j] = make_float2(c, s); }
      } else if (m == 2) {
        for (int idx = tid; idx < 16384; idx += 256) {
          int mm = idx >> 7, k = idx & 127, part = mm >> 6, f1 = mm & 63, pp = k >> 6, a = k & 63;
          float s, c; sincospif((float)((a * f1) & 63) / 32.f, &s, &c);
          float v = part == 0 ? (pp == 0 ? c : s) : (pp == 0 ? -s : c);
          P.DA[idx] = (half_t)(v * 0.125f);
        }
      } else if (m == 3) {
        for (int idx = tid; idx < 32768; idx += 256) {
          int mm = idx >> 8, k = idx & 255, part = k >> 7, bb = k & 127;
          float s, c; sincospif((float)((bb * mm) & 127) / 64.f, &s, &c);
          P.DB[idx] = (half_t)((part == 0 ? c : s) * 0.08838834764831845f);
        }
      } else if (m == 4) {
        for (int idx = tid; idx < 131072; idx += 256) {
          int mm = idx >> 9, k = idx & 511, part = k >> 8, tt = k & 255;
          float s, c; sincospif((float)((tt * mm) & 255) / 128.f, &s, &c);
          P.DC[idx] = (half_t)((part == 0 ? c : s) * 0.0625f);
        }
      } else {
        for (int idx = tid; idx < 2 * 48 * 1024; idx += 256) {
          int l = idx / 49152, r = idx % 49152, col = r >> 10, k = r & 1023;
          float w = col < 4 ? P.w_group[((size_t)l * 1024 + k) * 4 + col] : (col < 36 ? P.w_router[((size_t)l * 1024 + k) * 32 + col - 4] : 0.f);
          half_t hi = (half_t)w, lo = (half_t)(w - (float)hi);
          P.WrH[(size_t)(l * 2) * 49152 + r] = hi; P.WrH[(size_t)(l * 2 + 1) * 49152 + r] = lo;
        }
        if (tid < 2) {
          int l = tid; float s1 = 0.f, s2 = 0.f, mq = 0.f, mk = 0.f;
          for (int i = 0; i < 64; i++) {
            s1 += P.lq1[l * 64 + i] * P.lk1[l * 64 + i]; s2 += P.lq2[l * 64 + i] * P.lk2[l * 64 + i];
            mq = fmaxf(mq, fabsf(P.q_norm_g[l * 64 + i])); mk = fmaxf(mk, fabsf(P.k_norm_g[l * 64 + i]));
          }
          float lam_init = 0.8f - 0.6f * expf(-0.3f * (float)l);
          P.consts[l * 4 + 0] = expf(s1) - expf(s2) + lam_init;
          P.consts[l * 4 + 1] = 8.f * mq * mk * 1.4426950408889634f * 1.002f - 15.f;
          P.consts[l * 4 + 2] = lam_init;
        }
        if (tid < 64) P.cnt[tid] = 0;
        if (tid < 64) P.qctr[tid] = 0;
      }
    }
  }
}

DI void row1_phase(const Params& P, int combine_l, int norm_l, int r_begin) {
  const int lane = TIDX & 63, gw = blockIdx.x * 4 + (TIDX >> 6), nw = gridDim.x * 4;
  auto load_row = [&](int r, float4 (&xv)[4], h4 (&ya)[4], h4 (&yb)[4]) {
    if (combine_l < 0) {
      const float* src = r < TC ? P.ctx + (size_t)r * D : P.x + (size_t)(r - TC) * D;
#pragma unroll
      for (int i = 0; i < 4; i++) xv[i] = *(const float4*)(src + i * 256 + lane * 4);
    } else {
      const float* xm = r < TC ? P.xcbuf + (size_t)r * D : P.out + (size_t)(r - TC) * D;
      const half_t* y0 = P.yA + (size_t)(2 * r) * D; const half_t* y1 = y0 + D;
#pragma unroll
      for (int i = 0; i < 4; i++) { int c = i * 256 + lane * 4; xv[i] = *(const float4*)(xm + c); ya[i] = *(const h4*)(y0 + c); yb[i] = *(const h4*)(y1 + c); }
    }
  };
  auto process = [&](int r, float4 (&xv)[4], h4 (&ya)[4], h4 (&yb)[4]) {
    const int n = row_mod(r);
    if (combine_l >= 0) {
      float* xm = r < TC ? P.xcbuf + (size_t)r * D : P.out + (size_t)(r - TC) * D;
      const float* g2 = P.mod + (size_t)(combine_l * 9 + n) * 6144 + 5 * 1024;
#pragma unroll
      for (int i = 0; i < 4; i++) {
        int c = i * 256 + lane * 4;
        float4 g = *(const float4*)(g2 + c); float4 t = xv[i];
        t.x += g.x * ((float)ya[i][0] + (float)yb[i][0]); t.y += g.y * ((float)ya[i][1] + (float)yb[i][1]);
        t.z += g.z * ((float)ya[i][2] + (float)yb[i][2]); t.w += g.w * ((float)ya[i][3] + (float)yb[i][3]);
        *(float4*)(xm + c) = t; xv[i] = t;
      }
    }
    if (norm_l >= 0) {
      float ss = 0.f;
#pragma unroll
      for (int i = 0; i < 4; i++) ss += xv[i].x * xv[i].x + xv[i].y * xv[i].y + xv[i].z * xv[i].z + xv[i].w * xv[i].w;
      ss = wave_sum(ss);
      const float rstd = rsqrtf(ss * (1.f / 1024.f) + EPS);
      const float* g = P.norm1_g + norm_l * 1024;
      const float* sh = P.mod + (size_t)(norm_l * 9 + n) * 6144; const float* sc = sh + 1024;
#pragma unroll
      for (int i = 0; i < 4; i++) {
        int c = i * 256 + lane * 4;
        float4 gg = *(const float4*)(g + c), s1 = *(const float4*)(sc + c), s0 = *(const float4*)(sh + c);
        h4 o;
        o[0] = (half_t)(xv[i].x * rstd * gg.x * (1.f + s1.x) + s0.x); o[1] = (half_t)(xv[i].y * rstd * gg.y * (1.f + s1.y) + s0.y);
        o[2] = (half_t)(xv[i].z * rstd * gg.z * (1.f + s1.z) + s0.z); o[3] = (half_t)(xv[i].w * rstd * gg.w * (1.f + s1.w) + s0.w);
        *(h4*)(P.hx + (size_t)r * D + c) = o;
      }
    }
  };
#pragma unroll 1
  for (int r = r_begin + gw; r < TA; r += 4 * nw) {
    float4 x0[4], x1[4], x2[4], x3[4]; h4 a0[4], b0[4], a1[4], b1[4], a2[4], b2[4], a3[4], b3[4];
    const int r1 = r + nw, r2 = r + 2 * nw, r3 = r + 3 * nw;
    load_row(r, x0, a0, b0);
    if (r1 < TA) load_row(r1, x1, a1, b1);
    if (r2 < TA) load_row(r2, x2, a2, b2);
    if (r3 < TA) load_row(r3, x3, a3, b3);
    process(r, x0, a0, b0);
    if (r1 < TA) process(r1, x1, a1, b1);
    if (r2 < TA) process(r2, x2, a2, b2);
    if (r3 < TA) process(r3, x3, a3, b3);
  }
}

DI void row2_phase(const Params& P, int l, int r_begin, char* smem) {
  const int tid = TIDX, lane = tid & 63, wave = tid >> 6, fr = lane & 15, fq = lane >> 4;
  float* lg = (float*)smem + wave * 16 * 48;
  const half_t* Whi = P.WrH + (size_t)(l * 2) * 49152; const half_t* Wlo = Whi + 49152;
  const int ngroups = (TA - r_begin) >> 4, gw = blockIdx.x * 4 + wave, nw = gridDim.x * 4;
  const float* gam = P.norm2_g + l * 1024;
#pragma unroll 1
  for (int grp = gw; grp < ngroups; grp += nw) {
    const int r0 = r_begin + grp * 16, row = r0 + fr, n = row_mod(r0);
    const float* xm = (row < TC ? P.xcbuf + (size_t)row * D : P.out + (size_t)(row - TC) * D) + fq * 8;
    float ss = 0.f;
#pragma unroll 16
    for (int kk = 0; kk < 32; kk++) {
      const float4 a = *(const float4*)(xm + kk * 32), b = *(const float4*)(xm + kk * 32 + 4);
      ss += a.x * a.x + a.y * a.y + a.z * a.z + a.w * a.w + b.x * b.x + b.y * b.y + b.z * b.z + b.w * b.w;
    }
    ss += shx(ss, 16); ss += shx(ss, 32);
    const float rstd = rsqrtf(ss * (1.f / 1024.f) + EPS);
    const float* sh = P.mod + (size_t)(l * 9 + n) * 6144 + 3 * 1024 + fq * 8; const float* sc = sh + 1024;
    f4 acc[3];
#pragma unroll
    for (int i = 0; i < 3; i++) acc[i] = (f4){0.f, 0.f, 0.f, 0.f};
    half_t* hxo = P.hx + (size_t)row * D + fq * 8;
#pragma unroll 4
    for (int kk = 0; kk < 32; kk++) {
      const int k0 = kk * 32;
      float x[8], g[8], s1[8], s0[8];
      *(float4*)&x[0] = *(const float4*)(xm + k0); *(float4*)&x[4] = *(const float4*)(xm + k0 + 4);
      *(float4*)&g[0] = *(const float4*)(gam + fq * 8 + k0); *(float4*)&g[4] = *(const float4*)(gam + fq * 8 + k0 + 4);
      *(float4*)&s1[0] = *(const float4*)(sc + k0); *(float4*)&s1[4] = *(const float4*)(sc + k0 + 4);
      *(float4*)&s0[0] = *(const float4*)(sh + k0); *(float4*)&s0[4] = *(const float4*)(sh + k0 + 4);
      h8 hi, lo;
#pragma unroll
      for (int i = 0; i < 8; i++) {
        float v = x[i] * rstd * g[i] * (1.f + s1[i]) + s0[i];
        hi[i] = (half_t)v; lo[i] = (half_t)(v - (float)hi[i]);
      }
      *(h8*)(hxo + k0) = hi;
#pragma unroll
      for (int n3 = 0; n3 < 3; n3++) {
        h8 bh = *(const h8*)(Whi + (size_t)(n3 * 16 + fr) * 1024 + k0 + fq * 8);
        h8 bl = *(const h8*)(Wlo + (size_t)(n3 * 16 + fr) * 1024 + k0 + fq * 8);
        acc[n3] = mfma16(hi, bh, acc[n3]); acc[n3] = mfma16(lo, bh, acc[n3]); acc[n3] = mfma16(hi, bl, acc[n3]);
      }
    }
    __builtin_amdgcn_wave_barrier();
#pragma unroll
    for (int n3 = 0; n3 < 3; n3++)
#pragma unroll
      for (int j = 0; j < 4; j++) lg[(fq * 4 + j) * 48 + n3 * 16 + fr] = acc[n3][j];
    __builtin_amdgcn_wave_barrier();
    if (lane < 16) {
      const int r = r0 + lane;
      const float* L = lg + lane * 48;
      float gl[4]; int gi = 0;
#pragma unroll
      for (int j = 0; j < 4; j++) gl[j] = L[j] + P.b_group[l * 4 + j];
      float gm = gl[0];
#pragma unroll
      for (int j = 1; j < 4; j++) if (gl[j] > gm) { gm = gl[j]; gi = j; }
      float gs = 0.f;
#pragma unroll
      for (int j = 0; j < 4; j++) gs += expf(gl[j] - gm);
      const float pg = 1.f / gs;
      float el[8];
#pragma unroll
      for (int j = 0; j < 8; j++) el[j] = L[4 + gi * 8 + j] + P.b_router[l * 32 + gi * 8 + j];
      int i0 = 0; float v0 = el[0];
#pragma unroll
      for (int j = 1; j < 8; j++) if (el[j] > v0) { v0 = el[j]; i0 = j; }
      int i1 = -1; float v1 = -3.0e38f;
#pragma unroll
      for (int j = 0; j < 8; j++) if (j != i0 && el[j] > v1) { v1 = el[j]; i1 = j; }
      const float ex = expf(v1 - v0);
      const float w0 = pg / (1.f + ex), w1 = pg * ex / (1.f + ex);
      const int e0 = gi * 8 + i0, e1 = gi * 8 + i1;
      int p0 = atomicAdd(&P.cnt[l * 32 + e0], 1); P.list[(size_t)e0 * LCAP + p0] = 2 * r; P.listW[(size_t)e0 * LCAP + p0] = w0;
      int p1 = atomicAdd(&P.cnt[l * 32 + e1], 1); P.list[(size_t)e1 * LCAP + p1] = 2 * r + 1; P.listW[(size_t)e1 * LCAP + p1] = w1;
    }
    __builtin_amdgcn_wave_barrier();
  }
}

DI h8 lds128(unsigned a) { h8 r; asm volatile("ds_read_b128 %0, %1" : "=v"(r) : "v"(a)); return r; }
DI void tie(h8& x) { asm volatile("" : "+v"(x)); }
DI unsigned lds_addr(const void* p) { return (unsigned)(size_t)p; }
#define WAIT_LGKM(n) asm volatile("s_waitcnt lgkmcnt(" #n ")" ::: "memory")
DI void raw_barrier() { asm volatile("" ::: "memory"); __builtin_amdgcn_s_barrier(); asm volatile("" ::: "memory"); }
DI void slot_rc(int i, int& row, int& coff) { int s = i * 256 + TIDX; row = s >> 3; coff = ((s & 7) ^ ((row >> 1) & 7)) * 8; }

template <class AF, class BF>
DI void gemm_prologue(AF aptr, BF bptr, int nk, char* smem) {
  const int tid = TIDX;
#pragma unroll
  for (int st = 0; st < 2; st++) {
    if (st < nk) {
      char* d = smem + st * 49152 + tid * 16;
#pragma unroll
      for (int i = 0; i < 8; i++) glds16(aptr(i) + st * 64, d + i * 4096);
#pragma unroll
      for (int i = 0; i < 4; i++) glds16(bptr(i) + st * 64, d + 32768 + i * 4096);
    }
  }
}
template <bool PRE = false, class AF, class BF>
DI void gemm256(AF aptr, BF bptr, int nk, char* smem, f4 (&acc)[8][4]) {
  const int tid = TIDX, lane = tid & 63, wave = tid >> 6, fr = lane & 15, fq = lane >> 4, wr = wave >> 1, wc = wave & 1;
#pragma unroll
  for (int m = 0; m < 8; m++)
#pragma unroll
    for (int n = 0; n < 4; n++) acc[m][n] = (f4){0.f, 0.f, 0.f, 0.f};
  auto issue = [&](int kt, int st) {
    char* d = smem + st * 49152 + tid * 16;
#pragma unroll
    for (int i = 0; i < 8; i++) glds16(aptr(i) + kt * 64, d + i * 4096);
#pragma unroll
    for (int i = 0; i < 4; i++) glds16(bptr(i) + kt * 64, d + 32768 + i * 4096);
  };
  const unsigned sw = (unsigned)((fq ^ (fr >> 1)) << 4);
  const unsigned offA = (wr * 128 + fr) * 128 + sw, offB = 32768 + (wc * 64 + fr) * 128 + sw;
  const unsigned sbase = lds_addr(smem);
  if (!PRE) { issue(0, 0); if (nk > 1) issue(1, 1); }
  int st = 0;
#pragma unroll 1
  for (int kt = 0; kt < nk; kt++) {
    if (kt + 1 < nk) asm volatile("s_waitcnt vmcnt(12)" ::: "memory"); else wait_vm0();
    raw_barrier();
    if (kt + 2 < nk) issue(kt + 2, st == 0 ? 2 : st - 1);
    const unsigned base = sbase + st * 49152;
    st = st == 2 ? 0 : st + 1;
    h8 a0[8], b0[4], a1[8], b1[4];
#pragma unroll
    for (int m = 0; m < 8; m++) a0[m] = lds128(base + offA + m * 2048);
#pragma unroll
    for (int n = 0; n < 4; n++) b0[n] = lds128(base + offB + n * 2048);
#pragma unroll
    for (int m = 0; m < 8; m++) a1[m] = lds128(base + (offA ^ 64) + m * 2048);
#pragma unroll
    for (int n = 0; n < 4; n++) b1[n] = lds128(base + (offB ^ 64) + n * 2048);
    WAIT_LGKM(12);
#pragma unroll
    for (int m = 0; m < 8; m++) tie(a0[m]);
#pragma unroll
    for (int n = 0; n < 4; n++) tie(b0[n]);
#pragma unroll
    for (int m = 0; m < 8; m++)
#pragma unroll
      for (int n = 0; n < 4; n++) acc[m][n] = mfma16(a0[m], b0[n], acc[m][n]);
    WAIT_LGKM(0);
#pragma unroll
    for (int m = 0; m < 8; m++) tie(a1[m]);
#pragma unroll
    for (int n = 0; n < 4; n++) tie(b1[n]);
#pragma unroll
    for (int m = 0; m < 8; m++)
#pragma unroll
      for (int n = 0; n < 4; n++) acc[m][n] = mfma16(a1[m], b1[n], acc[m][n]);
  }
  raw_barrier();
}
DI bool xcd_tile(int it, int MT, int NT, int& mt, int& nt) {
  const int x = blockIdx.x & 7, j = blockIdx.x >> 3;
  const int nsn = NT >> 2, nsm = (MT + 7) >> 3;
  const int s = x + 8 * it;
  if (s >= nsm * nsn) return false;
  const int sm = s / nsn, sn = s % nsn;
  mt = sm * 8 + (j >> 2); nt = sn * 4 + (j & 3);
  return true;
}
DI bool next_tile(int& it, int MT, int NT, int& mt, int& nt) {
  for (;; it++) {
    if (!xcd_tile(it, MT, NT, mt, nt)) return false;
    if (mt < MT) return true;
  }
}
DI int slot_col() { int t = TIDX; return ((t & 7) ^ ((t >> 4) & 7)) * 8; }

DI float dpp_row_sum(float v) {
  v += __builtin_bit_cast(float, __builtin_amdgcn_update_dpp(0, __builtin_bit_cast(int, v), 0x128, 0xf, 0xf, false));
  v += __builtin_bit_cast(float, __builtin_amdgcn_update_dpp(0, __builtin_bit_cast(int, v), 0x124, 0xf, 0xf, false));
  v += __builtin_bit_cast(float, __builtin_amdgcn_update_dpp(0, __builtin_bit_cast(int, v), 0x122, 0xf, 0xf, false));
  v += __builtin_bit_cast(float, __builtin_amdgcn_update_dpp(0, __builtin_bit_cast(int, v), 0x121, 0xf, 0xf, false));
  return v;
}
DI void stage_put(char* stg, int ml, int n, int j, int fr, int fq, float v) { *(half_t*)(stg + (ml * 16 + fq * 4 + j) * 144 + (n * 16 + fr) * 2) = (half_t)v; }
template <class RP, class SC>
DI void stage_flush(char* stg, int h, RP rowptr, SC rowscale) {
  const int lane = TIDX & 63;
  __builtin_amdgcn_wave_barrier();
#pragma unroll
  for (int i = 0; i < 8; i++) {
    const int c = i * 64 + lane, row = c >> 3, c16 = c & 7;
    h8 v = *(const h8*)(stg + row * 144 + c16 * 16);
    half_t* d = rowptr(h * 64 + row);
    if (d) { rowscale(h * 64 + row, v); *(h8*)(d + c16 * 8) = v; }
  }
  __builtin_amdgcn_wave_barrier();
}
template <class VF, class RP, class SC>
DI void wave_store_tile(VF val, char* stg, RP rowptr, SC rowscale) {
  const int lane = TIDX & 63, fr = lane & 15, fq = lane >> 4;
#pragma unroll
  for (int h = 0; h < 2; h++) {
#pragma unroll
    for (int ml = 0; ml < 4; ml++)
#pragma unroll
      for (int n = 0; n < 4; n++)
#pragma unroll
        for (int j = 0; j < 4; j++) stage_put(stg, ml, n, j, fr, fq, val(h * 4 + ml, n, j));
    stage_flush(stg, h, rowptr, rowscale);
  }
}
DI void gemm_in_phase(const Params& P, int l, char* smem) {
  const int tid = TIDX;
  const half_t* Wt = P.WtIn + (size_t)l * NIN * 1024;
  const int sc = slot_col(), srow = tid >> 3;
  {
    float2* rcl = (float2*)(smem + 147456);
    for (int i = tid; i < 1024; i += 256) rcl[i] = P.rope[i];
    __syncthreads();
  }
  int it = 0, mt, nt;
  bool have = next_tile(it, 264, 20, mt, nt);
  const half_t* a0 = nullptr; const half_t* b0 = nullptr;
  if (have) {
    asm volatile("" : "+s"(mt), "+s"(nt));
    a0 = P.hx + (size_t)(mt * 256 + srow) * D + sc; b0 = Wt + (size_t)(nt * 128 + srow) * D + sc;
    gemm_prologue([&](int i) { return a0 + (size_t)i * 32 * D; }, [&](int i) { return b0 + (size_t)i * 32 * D; }, 16, smem);
  }
#pragma unroll 1
  while (have) {
    f4 acc[8][4];
    gemm256<true>([&](int i) { return a0 + (size_t)i * 32 * D; }, [&](int i) { return b0 + (size_t)i * 32 * D; }, 16, smem, acc);
    const int tid2 = TIDX, lane = tid2 & 63, wave = tid2 >> 6, fr = lane & 15, fq = lane >> 4, wr = wave >> 1, wc = wave & 1;
    const int r0 = mt * 256 + wr * 128;
    const bool isctx = r0 < TC;
    int b, pos0;
    if (isctx) { b = r0 >> 8; pos0 = r0 & 255; } else { b = (r0 - TC) >> 13; pos0 = 256 + ((r0 - TC) & 8191); }
    const bool isqk = nt >= 4 && nt < 12;
    float gg[4] = {0.f, 0.f, 0.f, 0.f}; float2 rr2[2] = {make_float2(1.f, 0.f), make_float2(1.f, 0.f)};
    if (isqk) {
      const float* gvec = (nt < 8 ? P.q_norm_g : P.k_norm_g) + l * 64;
      const float qs = nt < 8 ? 0.125f * 1.4426950408889634f : 1.f;
#pragma unroll
      for (int n = 0; n < 4; n++) gg[n] = gvec[n * 16 + fr] * qs;
      if (!isctx) { const int tp0 = pos0 - 256; rr2[0] = P.rope[(tp0 >> 6) * 16 + fr]; rr2[1] = P.rope[((tp0 >> 6) + 1) * 16 + fr]; }
    }
#pragma unroll
    for (int n = 0; n < 4; n++) asm volatile("" : "+v"(gg[n]));
    asm volatile("" : "+v"(rr2[0].x), "+v"(rr2[0].y), "+v"(rr2[1].x), "+v"(rr2[1].y));
    int it2 = it + 1, mt2, nt2;
    const bool have2 = next_tile(it2, 264, 20, mt2, nt2);
    const half_t* a1 = a0; const half_t* b1 = b0;
    if (have2) {
      asm volatile("" : "+s"(mt2), "+s"(nt2));
      a1 = P.hx + (size_t)(mt2 * 256 + srow) * D + sc; b1 = Wt + (size_t)(nt2 * 128 + srow) * D + sc;
      gemm_prologue([&](int i) { return a1 + (size_t)i * 32 * D; }, [&](int i) { return b1 + (size_t)i * 32 * D; }, 16, smem);
    }
    char* stg = smem + 98304 + wave * 12288;
    auto noscale = [](int, h8&) {};
    if (nt < 4 || nt >= 16) {
      half_t* dst; int ld, c0; bool gel = false;
      if (nt < 4) { dst = P.QF; ld = 512; c0 = nt * 128; }
      else if (nt < 18) { dst = P.gy; ld = 256; c0 = (nt - 16) * 128; gel = true; }
      else { dst = P.rr; ld = 256; c0 = (nt - 18) * 128; }
      half_t* base = dst + (size_t)r0 * ld + c0 + wc * 64;
      if (gel) wave_store_tile([&](int m, int n, int j) { return gelu_tanh(acc[m][n][j]); }, stg, [&](int r) { return base + (size_t)r * ld; }, noscale);
      else wave_store_tile([&](int m, int n, int j) { return acc[m][n][j]; }, stg, [&](int r) { return base + (size_t)r * ld; }, noscale);
    } else if (nt < 12) {
      const bool isq = nt < 8; const int head = isq ? nt - 4 : nt - 8;
      const float2* rcl = (const float2*)(smem + 147456);
      half_t* base = (isq ? P.q + (size_t)r0 * 512 : P.kall + ((size_t)b * KV + pos0) * 512) + head * 128 + wc * 64;
#pragma unroll
      for (int mh = 0; mh < 2; mh++) {
#pragma unroll
        for (int mm = 0; mm < 4; mm++) {
          const int m = mh * 4 + mm;
#pragma unroll
          for (int j = 0; j < 4; j++) {
            float ss = 0.f;
#pragma unroll
            for (int n = 0; n < 4; n++) ss += acc[m][n][j] * acc[m][n][j];
            ss = dpp_row_sum(ss);
            const float rstd = rsqrtf(ss * (1.f / 64.f) + EPS);
            float o[4];
#pragma unroll
            for (int n = 0; n < 4; n++) o[n] = acc[m][n][j] * rstd * gg[n];
            if (!isctx) {
              const float2 cr = rr2[mh], cc = rcl[(mm * 16 + fq * 4 + j) * 16 + fr];
              float a0 = o[0] * cr.x - o[1] * cr.y, a1 = o[1] * cr.x + o[0] * cr.y;
              float a2 = o[2] * cc.x - o[3] * cc.y, a3 = o[3] * cc.x + o[2] * cc.y;
              o[0] = a0; o[1] = a1; o[2] = a2; o[3] = a3;
            }
#pragma unroll
            for (int n = 0; n < 4; n++) stage_put(stg, mm, n, j, fr, fq, o[n]);
          }
        }
        stage_flush(stg, mh, [&](int r) { return base + (size_t)r * 512; }, noscale);
      }
    } else {
      const int head = nt - 12;
#pragma unroll
      for (int m = 0; m < 8; m++)
#pragma unroll
        for (int n = 0; n < 4; n++) {
          h4 o; o[0] = (half_t)acc[m][n][0]; o[1] = (half_t)acc[m][n][1]; o[2] = (half_t)acc[m][n][2]; o[3] = (half_t)acc[m][n][3];
          int d = wc * 64 + n * 16 + fr;
          asm volatile("" : "+v"(d) :: "memory");
          *(h4*)(P.vT + ((size_t)(b * 4 + head) * 128 + d) * KV + pos0 + m * 16 + fq * 4) = o;
        }
    }
    mt = mt2; nt = nt2; it = it2; have = have2; a0 = a1; b0 = b1;
  }
}

DI void gemm_out_phase(const Params& P, int l, char* smem) {
  const int tid = TIDX;
  const half_t* Wt = P.WtOut + (size_t)l * 1048576;
  const int mt0 = l == 0 ? 0 : TC / 256;
  const int MT = 264 - mt0;
  const int sc = slot_col(), srow = tid >> 3;
  int it = 0, mt, nt;
  bool have = next_tile(it, MT, 8, mt, nt);
  const half_t* a0 = nullptr; const half_t* b0 = nullptr;
  if (have) {
    asm volatile("" : "+s"(mt), "+s"(nt));
    a0 = P.mix + (size_t)((mt + mt0) * 256 + srow) * D + sc; b0 = Wt + (size_t)(nt * 128 + srow) * D + sc;
    gemm_prologue([&](int i) { return a0 + (size_t)i * 32 * D; }, [&](int i) { return b0 + (size_t)i * 32 * D; }, 16, smem);
  }
#pragma unroll 1
  while (have) {
    f4 acc[8][4];
    gemm256<true>([&](int i) { return a0 + (size_t)i * 32 * D; }, [&](int i) { return b0 + (size_t)i * 32 * D; }, 16, smem, acc);
    const int tid2 = TIDX, lane2 = tid2 & 63, wave2 = tid2 >> 6, fr2 = lane2 & 15, fq2 = lane2 >> 4, wr2 = wave2 >> 1, wc2 = wave2 & 1;
    const int r0 = (mt + mt0) * 256 + wr2 * 128;
    const int n = row_mod(r0);
    const int cbase = nt * 128 + wc2 * 64;
    const float* res; float* dst;
    if (r0 < TC) { res = P.ctx + (size_t)r0 * D; dst = P.xcbuf + (size_t)r0 * D; }
    else { dst = P.out + (size_t)(r0 - TC) * D; res = l == 0 ? P.x + (size_t)(r0 - TC) * D : dst; }
    res += cbase + fr2 * 4; dst += cbase + fr2 * 4;
    const float4 g4 = *(const float4*)(P.mod + (size_t)(l * 9 + n) * 6144 + 2 * 1024 + cbase + fr2 * 4);
    float4 rres[4][8];
#pragma unroll
    for (int q = 0; q < 4; q++)
#pragma unroll
      for (int i = 0; i < 8; i++) rres[q][i] = *(const float4*)(res + (size_t)(q * 32 + i * 4 + fq2) * D);
    int it2 = it + 1, mt2, nt2;
    const bool have2 = next_tile(it2, MT, 8, mt2, nt2);
    const half_t* a1 = a0; const half_t* b1 = b0;
    if (have2) {
      asm volatile("" : "+s"(mt2), "+s"(nt2));
      a1 = P.mix + (size_t)((mt2 + mt0) * 256 + srow) * D + sc; b1 = Wt + (size_t)(nt2 * 128 + srow) * D + sc;
      gemm_prologue([&](int i) { return a1 + (size_t)i * 32 * D; }, [&](int i) { return b1 + (size_t)i * 32 * D; }, 16, smem);
    }
    {
      float* stg = (float*)(smem + 98304 + wave2 * 12288);
#pragma unroll
      for (int q = 0; q < 4; q++) {
#pragma unroll
        for (int ml = 0; ml < 2; ml++)
#pragma unroll
          for (int nn = 0; nn < 4; nn++)
#pragma unroll
            for (int j = 0; j < 4; j++) stg[(ml * 16 + fq2 * 4 + j) * 68 + nn * 16 + fr2] = acc[q * 2 + ml][nn][j];
        __builtin_amdgcn_wave_barrier();
#pragma unroll
        for (int i = 0; i < 8; i++) {
          const int row = i * 4 + fq2;
          const float4 a = *(const float4*)(stg + row * 68 + fr2 * 4);
          float4 r = rres[q][i];
          r.x += g4.x * a.x; r.y += g4.y * a.y; r.z += g4.z * a.z; r.w += g4.w * a.w;
          *(float4*)(dst + (size_t)(q * 32 + row) * D) = r;
        }
        __builtin_amdgcn_wave_barrier();
      }
    }
    mt = mt2; nt = nt2; it = it2; have = have2; a0 = a1; b0 = b1;
  }
}

DI void moe_prefix(const Params& P, int l, int* tb) {
  __syncthreads();
  if (TIDX == 0) { int s = 0; for (int e = 0; e < 32; e++) { tb[e] = s; s += (P.cnt[l * 32 + e] + 255) >> 8; } tb[32] = s; }
  __syncthreads();
}
DI void moe_e1_phase(const Params& P, int l, char* smem, int* tb) {
  const int tid = TIDX;
  moe_prefix(P, l, tb);
  const int sc = slot_col(), srow = tid >> 3;
  const int MT = tb[32];
  auto setup = [&](int rt, int nt, int (&tok)[8], const half_t*& w1, const half_t*& w3) {
    int e = 0;
    while (tb[e + 1] <= rt) e++;
    const int rl = rt - tb[e], cnt = P.cnt[l * 32 + e];
    const int* lst = P.list + (size_t)e * LCAP;
    w1 = P.Wt1 + ((size_t)(l * 32 + e) * 512 + nt * 64) * 1024 + sc;
    w3 = P.Wt3 + ((size_t)(l * 32 + e) * 512 + nt * 64) * 1024 + sc;
#pragma unroll
    for (int i = 0; i < 8; i++) tok[i] = lst[min(rl * 256 + i * 32 + srow, cnt - 1)] >> 1;
  };
  int it = 0, rt, nt;
  bool have = next_tile(it, MT, 8, rt, nt);
  int tok[8]; const half_t* w1 = nullptr; const half_t* w3 = nullptr;
  if (have) {
    asm volatile("" : "+s"(rt), "+s"(nt));
    setup(rt, nt, tok, w1, w3);
    gemm_prologue([&](int i) { return P.hx + (size_t)tok[i] * D + sc; }, [&](int i) { return ((i & 1) ? w3 : w1) + (size_t)((i >> 1) * 32 + srow) * 1024; }, 16, smem);
  }
#pragma unroll 1
  while (have) {
    int it2 = it + 1, rt2, nt2;
    const bool have2 = next_tile(it2, MT, 8, rt2, nt2);
    int tok2[8]; const half_t* w1n = w1; const half_t* w3n = w3;
#pragma unroll
    for (int i = 0; i < 8; i++) tok2[i] = tok[i];
    if (have2) {
      asm volatile("" : "+s"(rt2), "+s"(nt2));
      setup(rt2, nt2, tok2, w1n, w3n);
    }
    f4 acc[8][4];
    gemm256<true>([&](int i) { return P.hx + (size_t)tok[i] * D + sc; },
                  [&](int i) { return ((i & 1) ? w3 : w1) + (size_t)((i >> 1) * 32 + srow) * 1024; }, 16, smem, acc);
    if (have2) {
      gemm_prologue([&](int i) { return P.hx + (size_t)tok2[i] * D + sc; }, [&](int i) { return ((i & 1) ? w3n : w1n) + (size_t)((i >> 1) * 32 + srow) * 1024; }, 16, smem);
    }
    {
      const int tid2 = TIDX, lane2 = tid2 & 63, wave2 = tid2 >> 6, fr2 = lane2 & 15, fq2 = lane2 >> 4, wr2 = wave2 >> 1, wc2 = wave2 & 1;
      char* stg = smem + 98304 + wave2 * 12288;
      half_t* Hd = P.H + ((size_t)rt * 256 + wr2 * 128) * 512 + nt * 64 + wc2 * 32;
#pragma unroll
      for (int h = 0; h < 2; h++) {
#pragma unroll
        for (int ml = 0; ml < 4; ml++)
#pragma unroll
          for (int n = 0; n < 2; n++)
#pragma unroll
            for (int j = 0; j < 4; j++) {
              float a1 = acc[h * 4 + ml][n][j], a3 = acc[h * 4 + ml][n + 2][j];
              *(half_t*)(stg + (ml * 16 + fq2 * 4 + j) * 80 + (n * 16 + fr2) * 2) = (half_t)(a1 * sigmoidf_(a1) * a3);
            }
        __builtin_amdgcn_wave_barrier();
#pragma unroll
        for (int i = 0; i < 4; i++) {
          const int c = i * 64 + lane2, row = c >> 2, c16 = c & 3;
          h8 v = *(const h8*)(stg + row * 80 + c16 * 16);
          *(h8*)(Hd + (size_t)(h * 64 + row) * 512 + c16 * 8) = v;
        }
        __builtin_amdgcn_wave_barrier();
      }
    }
    rt = rt2; nt = nt2; it = it2; have = have2; w1 = w1n; w3 = w3n;
#pragma unroll
    for (int i = 0; i < 8; i++) tok[i] = tok2[i];
  }
}
DI void moe_e2_phase(const Params& P, int l, char* smem, int* tb) {
  const int tid = TIDX;
  moe_prefix(P, l, tb);
  const int sc = slot_col(), srow = tid >> 3;
  const int MT = tb[32];
  auto ptrs = [&](int rt, int nt, const half_t*& a0, const half_t*& b0) {
    int e = 0;
    while (tb[e + 1] <= rt) e++;
    a0 = P.H + ((size_t)rt * 256 + srow) * 512 + sc;
    b0 = P.Wt2 + ((size_t)(l * 32 + e) * 1024 + nt * 128 + srow) * 512 + sc;
  };
  int it = 0, rt, nt;
  bool have = next_tile(it, MT, 8, rt, nt);
  const half_t* a0 = nullptr; const half_t* b0 = nullptr;
  if (have) {
    asm volatile("" : "+s"(rt), "+s"(nt));
    ptrs(rt, nt, a0, b0);
    gemm_prologue([&](int i) { return a0 + (size_t)i * 32 * 512; }, [&](int i) { return b0 + (size_t)i * 32 * 512; }, 8, smem);
  }
#pragma unroll 1
  while (have) {
    const int tid2 = TIDX, lane2 = tid2 & 63, wave2 = tid2 >> 6, wr2 = wave2 >> 1, wc2 = wave2 & 1;
    int e = 0;
    while (tb[e + 1] <= rt) e++;
    const int rl = rt - tb[e], cnt = P.cnt[l * 32 + e];
    const int* lst = P.list + (size_t)e * LCAP; const float* lstw = P.listW + (size_t)e * LCAP;
    int aa[2][8]; float ww[2][8];
#pragma unroll
    for (int h = 0; h < 2; h++)
#pragma unroll
      for (int i = 0; i < 8; i++) {
        const int idx = rl * 256 + wr2 * 128 + h * 64 + ((i * 64 + lane2) >> 3);
        const int ic = min(idx, cnt - 1);
        const int av = lst[ic]; const float wv = lstw[ic];
        aa[h][i] = idx < cnt ? av : -1; ww[h][i] = wv;
      }
    f4 acc[8][4];
    gemm256<true>([&](int i) { return a0 + (size_t)i * 32 * 512; }, [&](int i) { return b0 + (size_t)i * 32 * 512; }, 8, smem, acc);
    int it2 = it + 1, rt2, nt2;
    const bool have2 = next_tile(it2, MT, 8, rt2, nt2);
    const half_t* a1 = a0; const half_t* b1 = b0;
    if (have2) {
      asm volatile("" : "+s"(rt2), "+s"(nt2));
      ptrs(rt2, nt2, a1, b1);
      gemm_prologue([&](int i) { return a1 + (size_t)i * 32 * 512; }, [&](int i) { return b1 + (size_t)i * 32 * 512; }, 8, smem);
    }
    {
      char* stg = smem + 98304 + wave2 * 12288;
      const int fr2 = lane2 & 15, fq2 = lane2 >> 4;
#pragma unroll
      for (int h = 0; h < 2; h++) {
#pragma unroll
        for (int ml = 0; ml < 4; ml++)
#pragma unroll
          for (int n = 0; n < 4; n++)
#pragma unroll
            for (int j = 0; j < 4; j++) stage_put(stg, ml, n, j, fr2, fq2, acc[h * 4 + ml][n][j]);
        __builtin_amdgcn_wave_barrier();
#pragma unroll
        for (int i = 0; i < 8; i++) {
          const int c = i * 64 + lane2, row = c >> 3, c16 = c & 7;
          h8 v = *(const h8*)(stg + row * 144 + c16 * 16);
          if (aa[h][i] >= 0) {
            const float w = ww[h][i];
#pragma unroll
            for (int u = 0; u < 8; u++) v[u] = (half_t)(w * (float)v[u]);
            *(h8*)(P.yA + (size_t)aa[h][i] * D + nt * 128 + wc2 * 64 + c16 * 8) = v;
          }
        }
        __builtin_amdgcn_wave_barrier();
      }
    }
    rt = rt2; nt = nt2; it = it2; have = have2; a0 = a1; b0 = b1;
  }
}

DI int swap23(int x) { return (x & ~12) | ((x & 4) << 1) | ((x & 8) >> 1); }
DI void attn_item(const Params& P, int l, int b, int head, int row0, int nkeys, char* smem) {
  const int tid = TIDX, lane = tid & 63, wave = tid >> 6, ql = lane & 31, hh = lane >> 5;
  const float lam = P.consts[l * 4 + 0], negc = -P.consts[l * 4 + 1], lam_init = P.consts[l * 4 + 2];
  const int myrow = row0 + wave * 32 + ql;
  h8 qf[2][4];
  {
    const half_t* qp = P.q + (size_t)myrow * 512 + head * 128 + hh * 8;
#pragma unroll
    for (int m = 0; m < 2; m++)
#pragma unroll
      for (int s = 0; s < 4; s++) { qf[m][s] = *(const h8*)(qp + m * 64 + s * 16); }
#pragma unroll
    for (int m = 0; m < 2; m++)
#pragma unroll
      for (int s = 0; s < 4; s++) tie(qf[m][s]);
  }
  f16v o0[4], o1[4];
#pragma unroll
  for (int dt = 0; dt < 4; dt++)
#pragma unroll
    for (int i = 0; i < 16; i++) { o0[dt][i] = 0.f; o1[dt][i] = 0.f; }
  float ls0 = 0.f, ls1 = 0.f;
  const half_t* kp[4]; const half_t* vp[4];
  {
    const half_t* kbase = P.kall + (size_t)b * KV * 512 + head * 128;
    const half_t* vbase = P.vT + (size_t)(b * 4 + head) * 128 * KV;
#pragma unroll
    for (int i = 0; i < 4; i++) {
      int s = i * 256 + tid;
      int row = s >> 4, c = (s & 15) ^ (row & 15); kp[i] = kbase + (size_t)row * 512 + c * 8;
      int vr = s >> 3, vc = (s & 7) ^ ((vr >> 1) & 7); vp[i] = vbase + (size_t)vr * KV + vc * 8;
    }
  }
  const int ntile = nkeys >> 6;
  const unsigned sbase = lds_addr(smem);
  auto issue = [&](int t) {
    char* d = smem + (t & 3) * 32768 + tid * 16;
#pragma unroll
    for (int i = 0; i < 4; i++) { glds16(kp[i] + (size_t)t * 64 * 512, d + i * 4096); glds16(vp[i] + t * 64, d + 16384 + i * 4096); }
  };
  unsigned koff[2];
  const int kr_lo = swap23(ql), ksw = kr_lo & 15;
  koff[0] = kr_lo * 256; koff[1] = (32 + kr_lo) * 256;
  unsigned voff[4];
#pragma unroll
  for (int dt = 0; dt < 4; dt++) { int vrow = dt * 32 + ql; voff[dt] = 16384 + vrow * 128; }
  const int vsw = (ql >> 1) & 7;
  f16v negcv;
#pragma unroll
  for (int i = 0; i < 16; i++) negcv[i] = negc;
  h8 pp0[2], pp1[2];
  unsigned pendV = 0; int pendkt = 0; bool pend = false;
  auto half_step = [&](h8 (&kf)[8], unsigned cur, int kt) {
    h8 vf[8];
    if (pend) {
#pragma unroll
      for (int sp = 0; sp < 2; sp++)
#pragma unroll
        for (int dt = 0; dt < 4; dt++) vf[sp * 4 + dt] = lds128(pendV + voff[dt] + (((pendkt * 4 + sp * 2 + hh) ^ vsw) << 4));
    }
    f16v s0 = mfma32(kf[0], qf[0][0], negcv), s1 = mfma32(kf[4], qf[1][0], negcv);
#pragma unroll
    for (int st = 1; st < 4; st++) { s0 = mfma32(kf[st], qf[0][st], s0); s1 = mfma32(kf[4 + st], qf[1][st], s1); }
    if (pend) {
      WAIT_LGKM(0);
#pragma unroll
      for (int i = 0; i < 8; i++) tie(vf[i]);
#pragma unroll
      for (int sp = 0; sp < 2; sp++)
#pragma unroll
        for (int dt = 0; dt < 4; dt++) { o0[dt] = mfma32(vf[sp * 4 + dt], pp0[sp], o0[dt]); o1[dt] = mfma32(vf[sp * 4 + dt], pp1[sp], o1[dt]); }
    }
#pragma unroll
    for (int i = 0; i < 16; i++) { s0[i] = __builtin_amdgcn_exp2f(s0[i]); ls0 += s0[i]; s1[i] = __builtin_amdgcn_exp2f(s1[i]); ls1 += s1[i]; }
#pragma unroll
    for (int sp = 0; sp < 2; sp++) {
      u4 a, c;
      a[0] = pk2(s0[8*sp+0], s0[8*sp+1]); a[1] = pk2(s0[8*sp+2], s0[8*sp+3]); a[2] = pk2(s0[8*sp+4], s0[8*sp+5]); a[3] = pk2(s0[8*sp+6], s0[8*sp+7]);
      c[0] = pk2(s1[8*sp+0], s1[8*sp+1]); c[1] = pk2(s1[8*sp+2], s1[8*sp+3]); c[2] = pk2(s1[8*sp+4], s1[8*sp+5]); c[3] = pk2(s1[8*sp+6], s1[8*sp+7]);
      pp0[sp] = __builtin_bit_cast(h8, a); pp1[sp] = __builtin_bit_cast(h8, c);
    }
    pend = true; pendV = cur; pendkt = kt;
  };
  issue(0);
  if (ntile > 1) issue(1);
#pragma unroll 1
  for (int t = 0; t < ntile; t++) {
    if (t + 1 < ntile) asm volatile("s_waitcnt vmcnt(8)" ::: "memory"); else wait_vm0();
    raw_barrier();
    if (t + 2 < ntile) issue(t + 2);
    const unsigned cur = sbase + (t & 3) * 32768;
    h8 kfa[8], kfb[8];
#pragma unroll
    for (int st = 0; st < 4; st++) {
      kfa[st] = lds128(cur + koff[0] + (((st * 2 + hh) ^ ksw) << 4));
      kfa[4 + st] = lds128(cur + koff[0] + (((8 + st * 2 + hh) ^ ksw) << 4));
    }
#pragma unroll
    for (int st = 0; st < 4; st++) {
      kfb[st] = lds128(cur + koff[1] + (((st * 2 + hh) ^ ksw) << 4));
      kfb[4 + st] = lds128(cur + koff[1] + (((8 + st * 2 + hh) ^ ksw) << 4));
    }
    WAIT_LGKM(8);
#pragma unroll
    for (int i = 0; i < 8; i++) tie(kfa[i]);
    half_step(kfa, cur, 0);
    WAIT_LGKM(0);
#pragma unroll
    for (int i = 0; i < 8; i++) tie(kfb[i]);
    half_step(kfb, cur, 1);
  }
  {
    h8 vf[8];
#pragma unroll
    for (int sp = 0; sp < 2; sp++)
#pragma unroll
      for (int dt = 0; dt < 4; dt++) vf[sp * 4 + dt] = lds128(pendV + voff[dt] + (((pendkt * 4 + sp * 2 + hh) ^ vsw) << 4));
    WAIT_LGKM(0);
#pragma unroll
    for (int i = 0; i < 8; i++) tie(vf[i]);
#pragma unroll
    for (int sp = 0; sp < 2; sp++)
#pragma unroll
      for (int dt = 0; dt < 4; dt++) { o0[dt] = mfma32(vf[sp * 4 + dt], pp0[sp], o0[dt]); o1[dt] = mfma32(vf[sp * 4 + dt], pp1[sp], o1[dt]); }
  }
  raw_barrier();
  ls0 += shx(ls0, 32); ls1 += shx(ls1, 32);
  const float i0 = 1.f / ls0, i1 = lam / ls1;
  float ss = 0.f;
#pragma unroll
  for (int dt = 0; dt < 4; dt++)
#pragma unroll
    for (int i = 0; i < 16; i++) { float v = o0[dt][i] * i0 - o1[dt][i] * i1; o0[dt][i] = v; ss += v * v; }
  ss += shx(ss, 32);
  const float mult = rsqrtf(ss * (1.f / 128.f) + EPS) * (1.f - lam_init);
  const float* sg = P.subln_g + l * 128;
  half_t* dst = P.mix + (size_t)myrow * D + 256 + head * 128;
#pragma unroll
  for (int dt = 0; dt < 4; dt++)
#pragma unroll
    for (int g = 0; g < 4; g++) {
      const int d0 = dt * 32 + 8 * g + 4 * hh;
      float4 gv = *(const float4*)(sg + d0);
      h4 o; o[0] = (half_t)(o0[dt][4*g] * mult * gv.x); o[1] = (half_t)(o0[dt][4*g+1] * mult * gv.y);
      o[2] = (half_t)(o0[dt][4*g+2] * mult * gv.z); o[3] = (half_t)(o0[dt][4*g+3] * mult * gv.w);
      *(h4*)(dst + d0) = o;
    }
}

DI int swz128(int row, int colh) { return row * 128 + ((((colh >> 3)) ^ ((row >> 1) & 7)) << 4) + (colh & 7) * 2; }
DI void lru_load_w(const Params& P, int l, int g, char* Wt) {
  const int tid = TIDX;
  for (int dg = 0; dg < 4; dg++) {
    const int dir = dg >> 1;
    const float* w = ((dg & 1) ? P.gate_x_w : P.gate_a_w) + ((size_t)((l * 2 + dir) * 4 + g)) * 4096;
    for (int idx = tid; idx < 4096; idx += 256) { int i = idx >> 6, o = idx & 63; *(half_t*)(Wt + dg * 8192 + swz128(o, i)) = (half_t)w[idx]; }
  }
}
struct LruK { float ba[2][4], bx[2][4], sp8[2][4], cw[5]; };
DI void lru_consts(const Params& P, int l, int g, LruK& K) {
  const int tid = TIDX, fr = tid & 15, gc = g * 64 + (tid & 63);
#pragma unroll
  for (int dir = 0; dir < 2; dir++)
#pragma unroll
    for (int n = 0; n < 4; n++) {
      const int cc = (l * 2 + dir) * 256 + g * 64 + n * 16 + fr;
      K.ba[dir][n] = P.gate_a_b[cc]; K.bx[dir][n] = P.gate_x_b[cc]; K.sp8[dir][n] = -8.f * log1pf(__expf(-P.lru_lambda[cc]));
    }
#pragma unroll
  for (int k = 0; k < 4; k++) K.cw[k] = P.conv_w[(l * 4 + k) * 256 + gc];
  K.cw[4] = P.conv_b[l * 256 + gc];
}
DI void lru_tile(const Params& P, int l, int b, int tile, int g, char* smem, bool final, const LruK& K) {
  const int tid = TIDX, lane = tid & 63, wave = tid >> 6, fr = lane & 15, fq = lane >> 4;
  char* Wt = smem;
  char* xr16 = smem + 32768;
  float2* ab = (float2*)(smem + 40960);
  half_t* raw = (half_t*)(smem + 40960);
  float2* subst = (float2*)(smem + 73728);
  const int ch = tid & 63, tq = tid >> 6, gc = g * 64 + ch;
  const int T = tile < 4 ? CL : SEQ;
  const int t0 = tile < 4 ? tile * 64 : (tile - 4) * 64;
  const int rowbase = tile < 4 ? b * CL : TC + b * SEQ;
  unsigned* lab = (unsigned*)P.hx;
  __syncthreads();
  if (final) {
    float gyv[16], hsum[16];
#pragma unroll
    for (int e = 0; e < 16; e++) { gyv[e] = (float)P.gy[(size_t)(rowbase + t0 + tq * 16 + e) * 256 + gc]; hsum[e] = 0.f; }
    unsigned pk0[16], pk1[16];
#pragma unroll
    for (int e = 0; e < 16; e++) { pk0[e] = lab[((size_t)rowbase + t0 + tq * 16 + e) * 256 + gc]; pk1[e] = lab[((size_t)TA + rowbase + t0 + tq * 16 + e) * 256 + gc]; }
    const float car0 = P.lcar[((size_t)((b * 2 + 0) * 132 + tile)) * 256 + gc], car1 = P.lcar[((size_t)((b * 2 + 1) * 132 + tile)) * 256 + gc];
#pragma unroll 1
    for (int dir = 0; dir < 2; dir++) {
      unsigned pk[16];
#pragma unroll
      for (int e = 0; e < 16; e++) pk[e] = dir == 0 ? pk0[e] : pk1[e];
      float2 av[16];
      float A = 1.f, h = 0.f;
#pragma unroll
      for (int e = 0; e < 16; e++) {
        const int ee = dir == 0 ? e : 15 - e;
        unsigned u = pk[0];
#pragma unroll
        for (int q = 1; q < 16; q++) u = (q == ee) ? pk[q] : u;
        fp16x2 hv = __builtin_bit_cast(fp16x2, u);
        av[e] = make_float2(__expf((float)hv[0]), (float)hv[1]);
        h = av[e].x * h + av[e].y; A *= av[e].x;
      }
      subst[tq * 64 + ch] = make_float2(A, h);
      __syncthreads();
      h = dir == 0 ? car0 : car1;
      if (dir == 0) { for (int s2 = 0; s2 < tq; s2++) { float2 ss = subst[s2 * 64 + ch]; h = ss.x * h + ss.y; } }
      else { for (int s2 = 3; s2 > tq; s2--) { float2 ss = subst[s2 * 64 + ch]; h = ss.x * h + ss.y; } }
#pragma unroll
      for (int e = 0; e < 16; e++) {
        const int ee = dir == 0 ? e : 15 - e;
        h = av[e].x * h + av[e].y;
#pragma unroll
        for (int q = 0; q < 16; q++) hsum[q] += (q == ee) ? h : 0.f;
      }
      __syncthreads();
    }
#pragma unroll
    for (int e = 0; e < 16; e++)
      P.mix[(size_t)(rowbase + t0 + tq * 16 + e) * D + 768 + gc] = (half_t)(gyv[e] * hsum[e]);
    return;
  }
  for (int idx = tid; idx < 67 * 8; idx += 256) {
    int row = idx >> 3, c = idx & 7, tt = t0 - 1 + row;
    h8 v = {0, 0, 0, 0, 0, 0, 0, 0};
    if (tt >= 0 && tt < T) v = *(const h8*)(P.rr + (size_t)(rowbase + tt) * 256 + g * 64 + c * 8);
    *(h8*)(raw + row * 64 + c * 8) = v;
  }
  const float cw0 = K.cw[0], cw1 = K.cw[1], cw2 = K.cw[2], cw3 = K.cw[3], cb = K.cw[4];
  __syncthreads();
  {
    float v[19];
#pragma unroll
    for (int e = 0; e < 19; e++) v[e] = (float)raw[(tq * 16 + e) * 64 + ch];
    __syncthreads();
#pragma unroll
    for (int e = 0; e < 16; e++) {
      float xv = cb + cw0 * v[e] + cw1 * v[e + 1] + cw2 * v[e + 2] + cw3 * v[e + 3];
      *(half_t*)(xr16 + swz128(tq * 16 + e, ch)) = (half_t)xv;
    }
  }
  __syncthreads();
#pragma unroll 1
  for (int dir = 0; dir < 2; dir++) {
    {
      f4 acc[2][4];
#pragma unroll
      for (int gt = 0; gt < 2; gt++)
#pragma unroll
        for (int n = 0; n < 4; n++) acc[gt][n] = (f4){0.f, 0.f, 0.f, 0.f};
#pragma unroll
      for (int kk = 0; kk < 2; kk++) {
        int row = wave * 16 + fr;
        h8 af = *(const h8*)(xr16 + row * 128 + (((kk * 4 + fq) ^ ((row >> 1) & 7)) << 4));
#pragma unroll
        for (int gt = 0; gt < 2; gt++)
#pragma unroll
          for (int n = 0; n < 4; n++) {
            int orow = n * 16 + fr;
            h8 bf = *(const h8*)(Wt + (dir * 2 + gt) * 8192 + orow * 128 + (((kk * 4 + fq) ^ ((orow >> 1) & 7)) << 4));
            acc[gt][n] = mfma16(af, bf, acc[gt][n]);
          }
      }
#pragma unroll
      for (int n = 0; n < 4; n++) {
        const float ba = dir == 0 ? K.ba[0][n] : K.ba[1][n], bx = dir == 0 ? K.bx[0][n] : K.bx[1][n], sp8 = dir == 0 ? K.sp8[0][n] : K.sp8[1][n];
#pragma unroll
        for (int j = 0; j < 4; j++) {
          int tl = wave * 16 + fq * 4 + j, c2 = n * 16 + fr;
          float xv = (float)*(const half_t*)(xr16 + swz128(tl, c2));
          float rg = sigmoidf_(acc[0][n][j] + ba), ig = sigmoidf_(acc[1][n][j] + bx);
          float log_a = rg * sp8;
          float x2 = 2.f * log_a;
          float om = -x2 * (1.f + x2 * (0.5f + x2 * (0.16666667f + x2 * (0.041666668f + x2 * (0.008333334f + x2 * 0.0013888889f)))));
          if (x2 < -0.4f) { float a = __expf(log_a); om = 1.f - a * a; }
          ab[tl * 64 + c2] = make_float2(log_a, sqrtf(om) * (ig * xv));
        }
      }
    }
    __syncthreads();
    {
      float A = 1.f, h = 0.f;
#pragma unroll
      for (int e = 0; e < 16; e++) {
        const int ee = dir == 0 ? e : 15 - e;
        const float2 lb = ab[(tq * 16 + ee) * 64 + ch];
        fp16x2 hv; hv[0] = (__fp16)lb.x; hv[1] = (__fp16)lb.y;
        lab[((size_t)dir * TA + rowbase + t0 + tq * 16 + ee) * 256 + gc] = __builtin_bit_cast(unsigned, hv);
        const float a = __expf((float)hv[0]), bt = (float)hv[1];
        h = a * h + bt; A *= a;
      }
      subst[tq * 64 + ch] = make_float2(A, h);
    }
    __syncthreads();
    if (tq == 0) {
      float A = 1.f, h = 0.f;
#pragma unroll
      for (int s2 = 0; s2 < 4; s2++) { float2 ss = subst[(dir == 0 ? s2 : 3 - s2) * 64 + ch]; h = ss.x * h + ss.y; A *= ss.x; }
      P.lsum[((size_t)((b * 2 + dir) * 132 + tile)) * 256 + gc] = make_float2(A, h);
    }
    __syncthreads();
  }
}
DI void lru_carry_item(const Params& P, int it) {
  const int ch = TIDX, dir = it & 1;
  const size_t base = (size_t)it * 132 * 256 + ch;
  float c = 0.f;
#pragma unroll 4
  for (int k = 0; k < 132; k++) {
    int tile = dir == 0 ? k : (k < 4 ? 3 - k : 135 - k);
    float2 s = P.lsum[base + (size_t)tile * 256];
    P.lcar[base + (size_t)tile * 256] = c;
    c = s.x * c + s.y;
  }
}

DI void fft_load(const half_t* src, size_t rs, int nrows, char* Bt, int rowbytes, int k0) {
  for (int idx = TIDX; idx < nrows * 16; idx += 256) {
    int kr = idx >> 4, cc = idx & 15, k = k0 + kr;
    h8 v = *(const h8*)(src + (size_t)kr * rs + cc * 8);
#pragma unroll
    for (int u = 0; u < 8; u++) { int n = cc * 8 + u; *(half_t*)(Bt + n * rowbytes + ((((k >> 3)) ^ (n & 15)) << 4) + (k & 7) * 2) = v[u]; }
  }
}
template <class RF>
DI void fft_mma(const half_t* Dm, int ldD, int nkk, const char* Bt, int rowbytes, f4 (&acc)[4][4], RF arow) {
  const int lane = TIDX & 63, wave = TIDX >> 6, fr = lane & 15, fq = lane >> 4, wc = wave & 1;
#pragma unroll 1
  for (int kk = 0; kk < nkk; kk++) {
    h8 af[4], bf[4];
#pragma unroll
    for (int ms = 0; ms < 4; ms++) af[ms] = *(const h8*)(Dm + (size_t)arow(ms) * ldD + kk * 32 + fq * 8);
#pragma unroll
    for (int ns = 0; ns < 4; ns++) { int n = wc * 64 + ns * 16 + fr; bf[ns] = *(const h8*)(Bt + n * rowbytes + (((kk * 4 + fq) ^ (n & 15)) << 4)); }
#pragma unroll
    for (int ms = 0; ms < 4; ms++)
#pragma unroll
      for (int ns = 0; ns < 4; ns++) acc[ms][ns] = mfma16(af[ms], bf[ns], acc[ms][ns]);
  }
}
DI void zero44(f4 (&acc)[4][4]) {
#pragma unroll
  for (int m = 0; m < 4; m++)
#pragma unroll
    for (int n = 0; n < 4; n++) acc[m][n] = (f4){0.f, 0.f, 0.f, 0.f};
}
DI void fftA_item(const Params& P, int it, char* smem) {
  const int b = it >> 8, bb = (it >> 1) & 127, chh = it & 1;
  const int lane = TIDX & 63, wave = TIDX >> 6, fr = lane & 15, fq = lane >> 4, wr = wave >> 1, wc = wave & 1;
  __syncthreads();
  fft_load(P.QF + (size_t)(TC + b * SEQ + bb) * 512 + chh * 128, (size_t)128 * 512, 64, smem, 256, 0);
  fft_load(P.QF + (size_t)(TC + b * SEQ + bb) * 512 + 256 + chh * 128, (size_t)128 * 512, 64, smem, 256, 64);
  __syncthreads();
  f4 acc[4][4]; zero44(acc);
  fft_mma(P.DA, 128, 4, smem, 256, acc, [&](int ms) { return (ms >> 1) * 64 + wr * 32 + (ms & 1) * 16 + fr; });
#pragma unroll
  for (int ms = 0; ms < 2; ms++)
#pragma unroll
    for (int j = 0; j < 4; j++) {
      const int f1 = wr * 32 + ms * 16 + fq * 4 + j;
      const float2 w = P.tw[(bb * f1) & 8191];
      half_t* d0 = P.GA + ((size_t)(b * 64 + f1) * 256 + bb) * 256 + chh * 128 + wc * 64 + fr;
#pragma unroll
      for (int ns = 0; ns < 4; ns++) {
        float gr = acc[ms][ns][j], gi = acc[ms + 2][ns][j];
        d0[ns * 16] = (half_t)(gr * w.x + gi * w.y);
        d0[(size_t)128 * 256 + ns * 16] = (half_t)(gi * w.x - gr * w.y);
      }
    }
}
DI void fftB_item(const Params& P, int it, char* smem) {
  const int b = it >> 7, f1 = (it >> 1) & 63, chh = it & 1;
  const int lane = TIDX & 63, wave = TIDX >> 6, fr = lane & 15, fq = lane >> 4, wr = wave >> 1, wc = wave & 1;
  __syncthreads();
  fft_load(P.GA + (size_t)(b * 64 + f1) * 256 * 256 + chh * 128, 256, 256, smem, 512, 0);
  __syncthreads();
  f4 acc[4][4]; zero44(acc);
  fft_mma(P.DB, 256, 8, smem, 512, acc, [&](int ms) { return wr * 64 + ms * 16 + fr; });
#pragma unroll
  for (int ms = 0; ms < 4; ms++)
#pragma unroll
    for (int j = 0; j < 4; j++) {
      const int f2 = wr * 64 + ms * 16 + fq * 4 + j;
      half_t* d0 = P.mix + (size_t)(TC + b * SEQ + f1 + 64 * f2) * D + chh * 128 + wc * 64 + fr;
#pragma unroll
      for (int ns = 0; ns < 4; ns++) d0[ns * 16] = (half_t)acc[ms][ns][j];
    }
}
DI void fftC_item(const Params& P, int it, char* smem) {
  const int b = it >> 1, chh = it & 1;
  const int lane = TIDX & 63, wave = TIDX >> 6, fr = lane & 15, fq = lane >> 4, wr = wave >> 1, wc = wave & 1;
#pragma unroll 1
  for (int mh = 0; mh < 2; mh++) {
    f4 acc[4][4]; zero44(acc);
#pragma unroll 1
    for (int part = 0; part < 2; part++) {
      __syncthreads();
      fft_load(P.QF + (size_t)(b * CL) * 512 + part * 256 + chh * 128, 512, 256, smem, 512, 0);
      __syncthreads();
      fft_mma(P.DC + part * 256, 512, 8, smem, 512, acc, [&](int ms) { return mh * 128 + wr * 64 + ms * 16 + fr; });
    }
#pragma unroll
    for (int ms = 0; ms < 4; ms++)
#pragma unroll
      for (int j = 0; j < 4; j++) {
        const int f = mh * 128 + wr * 64 + ms * 16 + fq * 4 + j;
        half_t* d0 = P.mix + (size_t)(b * CL + f) * D + chh * 128 + wc * 64 + fr;
#pragma unroll
        for (int ns = 0; ns < 4; ns++) d0[ns * 16] = (half_t)acc[ms][ns][j];
      }
  }
}

#ifndef MX
#define MX 15
#endif
DI void mix_phase(const Params& P, int l, char* smem, int* s_item, int qi) {
  const int nL = 0, nA = 0, nC = l == 0 ? 64 : 0, nFA = 2048, nFC = l == 0 ? 16 : 0;
  const int total = nL + nA + nC + nFA + nFC;
  {
    const int g = blockIdx.x & 3;
    lru_load_w(P, l, g, smem);
    LruK K; lru_consts(P, l, g, K);
    for (int u = blockIdx.x >> 2; u < NB_ * 132; u += gridDim.x >> 2) lru_tile(P, l, u / 132, u % 132, g, smem, false, K);
  }
  int stage = 0;
  for (;;) {
    __syncthreads();
    if (TIDX == 0) *s_item = stage == 0 ? atomicAdd(&P.qctr[8 + qi * 8 + (blockIdx.x & 7)], 1) : atomicAdd(&P.qctr[qi], 1);
    __syncthreads();
    int it = *s_item;
    int kind = -1, b = 0, head = 0, row0 = 0, nk = 0;
    if (stage == 0) {
      if (it >= 256) { stage = 1; continue; }
      const int pair = (blockIdx.x & 7) + 8 * (it >> 6);
      b = pair >> 2; head = pair & 3; row0 = TC + b * SEQ + (it & 63) * 128; nk = KV; kind = 0;
    } else {
      if (it >= total) break;
      if (it < nC) { b = it >> 3; head = (it >> 1) & 3; row0 = b * CL + (it & 1) * 128; nk = CL; kind = 0; }
      else if (it < nC + nFA) { kind = 1; it -= nC; }
      else { kind = 2; it -= nC + nFA; }
    }
    if (kind == 0) attn_item(P, l, b, head, row0, nk, smem);
    else if (kind == 1) fftA_item(P, it, smem);
    else fftC_item(P, it, smem);
  }
}

DI void grid_barrier(unsigned* ctr, unsigned target) {
  asm volatile("s_waitcnt vmcnt(0)" ::: "memory");
  __syncthreads();
  if (threadIdx.x == 0) {
    __builtin_amdgcn_fence(__ATOMIC_RELEASE, "agent");
    asm volatile("s_waitcnt vmcnt(0)" ::: "memory");
    __hip_atomic_fetch_add(ctr, 1u, __ATOMIC_RELAXED, __HIP_MEMORY_SCOPE_AGENT);
    while (__hip_atomic_load(ctr, __ATOMIC_RELAXED, __HIP_MEMORY_SCOPE_AGENT) < target) __builtin_amdgcn_s_sleep(1);
    __builtin_amdgcn_fence(__ATOMIC_ACQUIRE, "agent");
    asm volatile("s_waitcnt vmcnt(0)" ::: "memory");
  }
  __syncthreads();
}
__global__ void __launch_bounds__(256, 1) fwd_megakernel(Params Pin) {
  Params P = Pin; bind_ws(P);
  __shared__ __attribute__((aligned(16))) char smem[147456 + 8192];
  __shared__ int tb[33];
  __shared__ int s_item;
  cg::grid_group grid = cg::this_grid();
  unsigned* bar = (unsigned*)(P.ws + O_bar); unsigned bk = 0;
#ifndef PH
#define PH 0xFFFF
#endif
#if PH & 1
  phase0(P, smem);
#endif
  grid.sync();
  for (int l = 0; l < 2; l++) {
#if PH & 2
    row1_phase(P, l == 0 ? -1 : 0, l, 0);
#endif
    grid_barrier(bar, (++bk) * gridDim.x);
#if PH & 4
    gemm_in_phase(P, l, smem);
#ifdef DUP_GEMM
    grid_barrier(bar, (++bk) * gridDim.x);
    gemm_in_phase(P, l, smem);
#endif
#endif
    grid_barrier(bar, (++bk) * gridDim.x);
#if PH & 8
    mix_phase(P, l, smem, &s_item, l);
#ifdef DUP_MIX
    grid_barrier(bar, (++bk) * gridDim.x);
    mix_phase(P, l, smem, &s_item, 2 + l);
#endif
#endif
    grid_barrier(bar, (++bk) * gridDim.x);
#if PH & 16
    if (blockIdx.x >= gridDim.x - 16) lru_carry_item(P, gridDim.x - 1 - blockIdx.x);
    for (int it = blockIdx.x; it < 1024; it += gridDim.x) fftB_item(P, it, smem);
#endif
    grid_barrier(bar, (++bk) * gridDim.x);
#if PH & 512
    {
      const int g = blockIdx.x & 3;
      LruK K{};
      for (int u = blockIdx.x >> 2; u < NB_ * 132; u += gridDim.x >> 2) lru_tile(P, l, u / 132, u % 132, g, smem, true, K);
    }
#endif
    grid_barrier(bar, (++bk) * gridDim.x);
#if PH & 32
    gemm_out_phase(P, l, smem);
#endif
    grid_barrier(bar, (++bk) * gridDim.x);
#if PH & 64
    row2_phase(P, l, l == 0 ? 0 : TC, smem);
#endif
    grid_barrier(bar, (++bk) * gridDim.x);
#if PH & 128
    moe_e1_phase(P, l, smem, tb);
#ifdef DUP_GEMM
    grid_barrier(bar, (++bk) * gridDim.x);
    moe_e1_phase(P, l, smem, tb);
#endif
#endif
    grid_barrier(bar, (++bk) * gridDim.x);
#if PH & 256
    moe_e2_phase(P, l, smem, tb);
#ifdef DUP_GEMM
    grid_barrier(bar, (++bk) * gridDim.x);
    moe_e2_phase(P, l, smem, tb);
#endif
#endif
    grid_barrier(bar, (++bk) * gridDim.x);
  }
#if PH & 2
  row1_phase(P, 1, -1, TC);
#endif
}

extern "C" void kernel_launch(void* const* d_in, const int* in_sizes, int n_in, void* d_out, int out_size, void* d_ws, size_t ws_size,
                              hipStream_t stream) {
  static int grid_blocks = 0;
  if (!grid_blocks) {
    int dev = 0, cus = 0, per_cu = 0;
    hipGetDevice(&dev);
    hipDeviceGetAttribute(&cus, hipDeviceAttributeMultiprocessorCount, dev);
    hipOccupancyMaxActiveBlocksPerMultiprocessor(&per_cu, fwd_megakernel, 256, 0);
    if (per_cu > 2) per_cu = 2;
    grid_blocks = cus * per_cu;
    if (grid_blocks > 256) grid_blocks = 256;
  }
  if (grid_blocks != 256) { fprintf(stderr, "need 256 co-resident blocks, have %d\n", grid_blocks); return; }
  Params p{};
  const float** pin = (const float**)&p;
  for (int i = 0; i < 31; i++) pin[i] = (const float*)d_in[i];
  p.out = (float*)d_out;
  p.ws = (char*)d_ws;
  if (WS_NEED > ws_size) { fprintf(stderr, "workspace too small: need %zu have %zu\n", (size_t)WS_NEED, ws_size); return; }
  hipMemsetAsync((char*)d_ws + O_bar, 0, 256, stream);
  void* args[] = {&p};
  hipError_t e = hipLaunchCooperativeKernel((void*)fwd_megakernel, dim3(grid_blocks), dim3(256), args, 0, stream);
  if (e != hipSuccess) fprintf(stderr, "cooperative launch failed: %s (grid %d)\n", hipGetErrorString(e), grid_blocks);
}
```

```cpp
#include <hip/hip_runtime.h>
#include <hip/hip_cooperative_groups.h>
#include <cstdio>
namespace cg = cooperative_groups;

typedef _Float16 half_t;
typedef _Float16 h8 __attribute__((ext_vector_type(8)));
typedef _Float16 h4 __attribute__((ext_vector_type(4)));
typedef __fp16 fp16x2 __attribute__((ext_vector_type(2)));
typedef unsigned u4 __attribute__((ext_vector_type(4)));
typedef float f4 __attribute__((ext_vector_type(4)));
typedef float f16v __attribute__((ext_vector_type(16)));
#define DI __device__ __forceinline__
__device__ __forceinline__ int tid_opaque() { int t = threadIdx.x; asm volatile("" : "+v"(t)); return t; }
#define TIDX tid_opaque()

constexpr int D = 1024, NB_ = 8, SEQ = 8192, CL = 256;
constexpr int TC = NB_ * CL;
constexpr int TX = NB_ * SEQ;
constexpr int TA = TC + TX;
constexpr int KV = CL + SEQ;
constexpr int NIN = 2560;
constexpr int LCAP = 2 * TA;
constexpr float EPS = 1e-6f;

struct Params {
  const float *x, *c, *ctx, *c_ctx, *w_mod, *b_mod, *norm1_g, *norm2_g, *w_in, *q_norm_g, *k_norm_g, *lq1, *lk1, *lq2, *lk2,
      *subln_g, *conv_w, *conv_b, *gate_a_w, *gate_a_b, *gate_x_w, *gate_x_b, *lru_lambda, *w_out, *w_group, *b_group,
      *w_router, *b_router, *w1, *w3, *w2;
  float* out; char* ws;
  half_t *WtIn, *WtOut, *Wt1, *Wt3, *Wt2;
  float* mod; float2* rope; float2* tw; half_t *DA, *DB, *DC; float* consts; int* cnt; int* qctr; float* tokW; int* list; float* listW;
  float* xcbuf; half_t* WrH;
  half_t *hx, *mix, *q, *kall, *vT, *QF, *gy, *rr; float2* lsum; float* lcar; half_t* GA; half_t *H, *yA;
};


constexpr size_t al256(size_t x) { return (x + 255) & ~(size_t)255; }
constexpr size_t O_WtIn = 0;
constexpr size_t O_WtOut = O_WtIn + al256((size_t)2 * NIN * 1024 * 2);
constexpr size_t O_Wt1 = O_WtOut + al256((size_t)2 * 1024 * 1024 * 2);
constexpr size_t O_Wt3 = O_Wt1 + al256((size_t)64 * 524288 * 2);
constexpr size_t O_Wt2 = O_Wt3 + al256((size_t)64 * 524288 * 2);
constexpr size_t O_mod = O_Wt2 + al256((size_t)64 * 524288 * 2);
constexpr size_t O_rope = O_mod + al256((size_t)2 * 9 * 6144 * 4);
constexpr size_t O_tw = O_rope + al256(128 * 16 * 8);
constexpr size_t O_DA = O_tw + al256(8192 * 8);
constexpr size_t O_DB = O_DA + al256(16384 * 2);
constexpr size_t O_DC = O_DB + al256(32768 * 2);
constexpr size_t O_consts = O_DC + al256(131072 * 2);
constexpr size_t O_cnt = O_consts + 256;
constexpr size_t O_qctr = O_cnt + 256;
constexpr size_t O_bar = O_qctr + 256;
constexpr size_t O_tokW = O_bar + 256;
constexpr size_t O_list = O_tokW + al256((size_t)2 * TA * 4);
constexpr size_t O_listW = O_list + al256((size_t)32 * LCAP * 4);
constexpr size_t O_xcbuf = O_listW + al256((size_t)32 * LCAP * 4);
constexpr size_t O_WrT = O_xcbuf + al256((size_t)TC * D * 4);
constexpr size_t O_hx = O_WrT + al256((size_t)2 * 2 * 48 * 1024 * 2);
constexpr size_t O_mix = O_hx + al256((size_t)TA * D * 2);
constexpr size_t O_regB = O_mix + al256((size_t)TA * D * 2);
constexpr size_t O_q = O_regB;
constexpr size_t O_kall = O_q + al256((size_t)TA * 512 * 2);
constexpr size_t O_vT = O_kall + al256((size_t)NB_ * KV * 512 * 2);
constexpr size_t O_QF = O_vT + al256((size_t)NB_ * 4 * 128 * KV * 2);
constexpr size_t O_gy = O_QF + al256((size_t)TA * 512 * 2);
constexpr size_t O_rr = O_gy + al256((size_t)TA * 256 * 2);
constexpr size_t O_lsum = O_rr + al256((size_t)TA * 256 * 2);
constexpr size_t O_lcar = O_lsum + al256((size_t)16 * 132 * 256 * 8);
constexpr size_t O_GA = O_lcar + al256((size_t)16 * 132 * 256 * 4);
constexpr size_t O_mixer_end = O_GA + al256((size_t)NB_ * 64 * 256 * 256 * 2);
constexpr size_t O_H = O_regB;
constexpr size_t O_yA = O_H + al256((size_t)(2 * TA + 32 * 256) * 512 * 2);
constexpr size_t O_moe_end = O_yA + al256((size_t)2 * TA * D * 2);
constexpr size_t WS_NEED = O_mixer_end > O_moe_end ? O_mixer_end : O_moe_end;
DI void bind_ws(Params& P) {
  char* w = P.ws;
  P.WtIn = (half_t*)(w + O_WtIn); P.WtOut = (half_t*)(w + O_WtOut); P.Wt1 = (half_t*)(w + O_Wt1); P.Wt3 = (half_t*)(w + O_Wt3); P.Wt2 = (half_t*)(w + O_Wt2);
  P.mod = (float*)(w + O_mod); P.rope = (float2*)(w + O_rope); P.tw = (float2*)(w + O_tw); P.DA = (half_t*)(w + O_DA); P.DB = (half_t*)(w + O_DB); P.DC = (half_t*)(w + O_DC);
  P.consts = (float*)(w + O_consts); P.cnt = (int*)(w + O_cnt); P.qctr = (int*)(w + O_qctr); P.tokW = (float*)(w + O_tokW); P.list = (int*)(w + O_list); P.listW = (float*)(w + O_listW);
  P.xcbuf = (float*)(w + O_xcbuf); P.WrH = (half_t*)(w + O_WrT); P.hx = (half_t*)(w + O_hx); P.mix = (half_t*)(w + O_mix);
  P.q = (half_t*)(w + O_q); P.kall = (half_t*)(w + O_kall); P.vT = (half_t*)(w + O_vT); P.QF = (half_t*)(w + O_QF); P.gy = (half_t*)(w + O_gy); P.rr = (half_t*)(w + O_rr);
  P.lsum = (float2*)(w + O_lsum); P.lcar = (float*)(w + O_lcar); P.GA = (half_t*)(w + O_GA); P.H = (half_t*)(w + O_H); P.yA = (half_t*)(w + O_yA);
}
DI float shx(float v, int o) { int ln = TIDX & 63; return __builtin_bit_cast(float, __builtin_amdgcn_ds_bpermute((ln ^ o) << 2, __builtin_bit_cast(int, v))); }
DI float shi(float v, int idx) { return __builtin_bit_cast(float, __builtin_amdgcn_ds_bpermute(idx << 2, __builtin_bit_cast(int, v))); }
DI float wave_sum(float v) {
#pragma unroll
  for (int o = 32; o; o >>= 1) v += shx(v, o);
  return v;
}
DI void glds16(const void* g, void* l) {
  __builtin_amdgcn_global_load_lds((const unsigned*)g, (unsigned*)l, 16, 0, 0);
}
DI void wait_vm0() { asm volatile("s_waitcnt vmcnt(0)" ::: "memory"); }
DI f4 mfma16(h8 a, h8 b, f4 c) { return __builtin_amdgcn_mfma_f32_16x16x32_f16(a, b, c, 0, 0, 0); }
DI f16v mfma32(h8 a, h8 b, f16v c) { return __builtin_amdgcn_mfma_f32_32x32x16_f16(a, b, c, 0, 0, 0); }
DI unsigned pk2(float a, float b) { fp16x2 r = __builtin_amdgcn_cvt_pkrtz(a, b); return __builtin_bit_cast(unsigned, r); }
DI float sigmoidf_(float x) { return 1.f / (1.f + __expf(-x)); }
DI float gelu_tanh(float x) {
  float u = 0.7978845608028654f * (x + 0.044715f * x * x * x);
  float e = __expf(2.f * u);
  float t = 1.f - 2.f / (e + 1.f);
  return 0.5f * x * (1.f + t);
}
DI int row_mod(int r) { return r < TC ? 8 : ((r - TC) >> 13); }

DI void transpose_tile4(const float* src, int lds_, half_t* dst, int ldd, float* tile) {
  const int tid = TIDX;
  {
    const int k0 = tid >> 6, c4 = tid & 63;
    const float* sp = src + (size_t)k0 * lds_ + c4 * 4;
    float* tp = tile + (c4 >> 4) * 4352 + k0 * 68 + (c4 & 15) * 4;
#pragma unroll
    for (int i = 0; i < 16; i++) *(float4*)(tp + i * 4 * 68) = *(const float4*)(sp + (size_t)i * 4 * lds_);
  }
  __syncthreads();
#pragma unroll
  for (int i = 0; i < 8; i++) {
    int idx = i * 256 + tid, j = idx >> 9, r = idx & 511, kc = r >> 6, n = r & 63;
    const float* t = tile + j * 4352 + kc * 8 * 68 + n;
    h8 o;
#pragma unroll
    for (int u = 0; u < 8; u++) o[u] = (half_t)t[u * 68];
    *(h8*)(dst + (size_t)(j * 64 + n) * ldd + kc * 8) = o;
  }
  __syncthreads();
}

DI void phase0(const Params& P, char* smem) {
  float* tile = (float*)smem;
  const int tid = TIDX;
  constexpr int NT = 6528, NF = 128, NM = 192, NX = 6;
  for (int t = blockIdx.x; t < NT + NF + NM + NX; t += gridDim.x) {
    if (t < NT) {
      const float* src; half_t* dst; int lds_, ldd;
      if (t < 256) {
        int l = t / 128, r = t % 128, kt = r / 8, nt = (r % 8) * 4;
        src = P.w_in + (size_t)l * 1024 * 2304 + (size_t)kt * 64 * 2304 + 256 + nt * 64; lds_ = 2304;
        dst = P.WtIn + (size_t)l * NIN * 1024 + (size_t)(512 + nt * 64) * 1024 + kt * 64; ldd = 1024;
      } else if (t < 384) {
        int u = t - 256, l = u / 64, r = u % 64, kt = r / 4, nt = (r % 4) * 4;
        src = P.w_out + (size_t)l * 1048576 + (size_t)kt * 64 * 1024 + nt * 64; lds_ = 1024;
        dst = P.WtOut + (size_t)l * 1048576 + (size_t)nt * 64 * 1024 + kt * 64; ldd = 1024;
      } else if (t < 384 + 4096) {
        int u = t - 384; const float* w = P.w1; half_t* o = P.Wt1;
        if (u >= 2048) { u -= 2048; w = P.w3; o = P.Wt3; }
        int le = u / 32, r = u % 32, kt = r / 2, nt = (r % 2) * 4;
        src = w + (size_t)le * 524288 + (size_t)kt * 64 * 512 + nt * 64; lds_ = 512;
        dst = o + (size_t)le * 524288 + (size_t)nt * 64 * 1024 + kt * 64; ldd = 1024;
      } else {
        int u = t - 384 - 4096, le = u / 32, r = u % 32, kt = r / 4, nt = (r % 4) * 4;
        src = P.w2 + (size_t)le * 524288 + (size_t)kt * 64 * 1024 + nt * 64; lds_ = 1024;
        dst = P.Wt2 + (size_t)le * 524288 + (size_t)nt * 64 * 512 + kt * 64; ldd = 512;
      }
      transpose_tile4(src, lds_, dst, ldd, tile);
    } else if (t < NT + NF) {
      int f = t - NT, l = f / 64, r = f % 64, kt = r / 4, g = r % 4;
      float* cst = tile + 64 * 65; float* snt = cst + 64;
      const float* src = P.w_in + (size_t)l * 1024 * 2304 + (size_t)kt * 64 * 2304 + g * 64;
      { int n = tid & 63, kq = tid >> 6;
        for (int i = 0; i < 16; i++) { int k = i * 4 + kq; tile[k * 65 + n] = src[(size_t)k * 2304 + n]; } }
      if (tid < 64) { float s, c; sincospif((float)tid / 32.f, &s, &c); cst[tid] = c; snt[tid] = s; }
      __syncthreads();
      int k = tid & 63, jq = tid >> 6;
      half_t* o = P.WtIn + (size_t)l * NIN * 1024 + kt * 64 + k;
      for (int jj = 0; jj < 16; jj++) {
        int j = jq * 16 + jj; float ac = 0.f, as = 0.f;
        for (int c = 0; c < 64; c++) { float v = tile[k * 65 + c]; int idx = (c * j) & 63; ac += v * cst[idx]; as += v * snt[idx]; }
        o[(size_t)(g * 64 + j) * 1024] = (half_t)(ac * 0.125f);
        o[(size_t)(256 + g * 64 + j) * 1024] = (half_t)(-as * 0.125f);
      }
      __syncthreads();
    } else if (t < NT + NF + NM) {
      int mi = t - NT - NF, l = mi / 96, col0 = (mi % 96) * 64;
      float* scond = tile; float* red = tile + 9216;
      for (int idx = tid; idx < 9216; idx += 256) {
        int n = idx >> 10, k = idx & 1023; float v = n < 8 ? P.c[n * 1024 + k] : P.c_ctx[k];
        scond[idx] = v / (1.f + expf(-v));
      }
      __syncthreads();
      int col = tid & 63, kq = tid >> 6; float acc[9];
#pragma unroll
      for (int n = 0; n < 9; n++) acc[n] = 0.f;
      const float* w = P.w_mod + ((size_t)l * 1024 + kq * 256) * 6144 + col0 + col;
#pragma unroll 16
      for (int k = 0; k < 256; k++) {
        float wv = w[(size_t)k * 6144];
#pragma unroll
        for (int n = 0; n < 9; n++) acc[n] += scond[n * 1024 + kq * 256 + k] * wv;
      }
#pragma unroll
      for (int n = 0; n < 9; n++) red[(kq * 9 + n) * 64 + col] = acc[n];
      __syncthreads();
      for (int idx = tid; idx < 576; idx += 256) {
        int n = idx / 64, cc = idx % 64;
        float s = red[(0 * 9 + n) * 64 + cc] + red[(1 * 9 + n) * 64 + cc] + red[(2 * 9 + n) * 64 + cc] + red[(3 * 9 + n) * 64 + cc];
        P.mod[(size_t)(l * 9 + n) * 6144 + col0 + cc] = s + P.b_mod[l * 6144 + col0 + cc];
      }
      __syncthreads();
    } else {
      int m = t - NT - NF - NM;
      if (m == 0) {
        for (int idx = tid; idx < 128 * 16; idx += 256) {
          int pos = idx >> 4, i = idx & 15; float f = powf(10000.f, -(float)i / 16.f); float ang = (float)pos * f;
          float s, c; sincosf(ang, &s, &c); P.rope[idx] = make_float2(c, s);
        }
      } else if (m == 1) {
        for (int j = tid; j < 8192; j += 256) { float s, c; sincospif((float)j / 4096.f, &s, &c); P.tw[j] = make_float2(c, s); }
      } else if (m == 2) {
        for (int idx = tid; idx < 16384; idx += 256) {
          int mm = idx >> 7, k = idx & 127, part = mm >> 6, f1 = mm & 63, pp = k >> 6, a = k & 63;
          float s, c; sincospif((float)((a * f1) & 63) / 32.f, &s, &c);
          float v = part == 0 ? (pp == 0 ? c : s) : (pp == 0 ? -s : c);
          P.DA[idx] = (half_t)(v * 0.125f);
        }
      } else if (m == 3) {
        for (int idx = tid; idx < 32768; idx += 256) {
          int mm = idx >> 8, k = idx & 255, part = k >> 7, bb = k & 127;
          float s, c; sincospif((float)((bb * mm) & 127) / 64.f, &s, &c);
          P.DB[idx] = (half_t)((part == 0 ? c : s) * 0.08838834764831845f);
        }
      } else if (m == 4) {
        for (int idx = tid; idx < 131072; idx += 256) {
          int mm = idx >> 9, k = idx & 511, part = k >> 8, tt = k & 255;
          float s, c; sincospif((float)((tt * mm) & 255) / 128.f, &s, &c);
          P.DC[idx] = (half_t)((part == 0 ? c : s) * 0.0625f);
        }
      } else {
        for (int idx = tid; idx < 2 * 48 * 1024; idx += 256) {
          int l = idx / 49152, r = idx % 49152, col = r >> 10, k = r & 1023;
          float w = col < 4 ? P.w_group[((size_t)l * 1024 + k) * 4 + col] : (col < 36 ? P.w_router[((size_t)l * 1024 + k) * 32 + col - 4] : 0.f);
          half_t hi = (half_t)w, lo = (half_t)(w - (float)hi);
          P.WrH[(size_t)(l * 2) * 49152 + r] = hi; P.WrH[(size_t)(l * 2 + 1) * 49152 + r] = lo;
        }
        if (tid < 2) {
          int l = tid; float s1 = 0.f, s2 = 0.f, mq = 0.f, mk = 0.f;
          for (int i = 0; i < 64; i++) {
            s1 += P.lq1[l * 64 + i] * P.lk1[l * 64 + i]; s2 += P.lq2[l * 64 + i] * P.lk2[l * 64 + i];
            mq = fmaxf(mq, fabsf(P.q_norm_g[l * 64 + i])); mk = fmaxf(mk, fabsf(P.k_norm_g[l * 64 + i]));
          }
          float lam_init = 0.8f - 0.6f * expf(-0.3f * (float)l);
          P.consts[l * 4 + 0] = expf(s1) - expf(s2) + lam_init;
          P.consts[l * 4 + 1] = 8.f * mq * mk * 1.4426950408889634f * 1.002f - 15.f;
          P.consts[l * 4 + 2] = lam_init;
        }
        if (tid < 64) P.cnt[tid] = 0;
        if (tid < 64) P.qctr[tid] = 0;
      }
    }
  }
}

DI void row1_phase(const Params& P, int combine_l, int norm_l, int r_begin) {
  const int lane = TIDX & 63, gw = blockIdx.x * 4 + (TIDX >> 6), nw = gridDim.x * 4;
  auto load_row = [&](int r, float4 (&xv)[4], h4 (&ya)[4], h4 (&yb)[4]) {
    if (combine_l < 0) {
      const float* src = r < TC ? P.ctx + (size_t)r * D : P.x + (size_t)(r - TC) * D;
#pragma unroll
      for (int i = 0; i < 4; i++) xv[i] = *(const float4*)(src + i * 256 + lane * 4);
    } else {
      const float* xm = r < TC ? P.xcbuf + (size_t)r * D : P.out + (size_t)(r - TC) * D;
      const half_t* y0 = P.yA + (size_t)(2 * r) * D; const half_t* y1 = y0 + D;
#pragma unroll
      for (int i = 0; i < 4; i++) { int c = i * 256 + lane * 4; xv[i] = *(const float4*)(xm + c); ya[i] = *(const h4*)(y0 + c); yb[i] = *(const h4*)(y1 + c); }
    }
  };
  auto process = [&](int r, float4 (&xv)[4], h4 (&ya)[4], h4 (&yb)[4]) {
    const int n = row_mod(r);
    if (combine_l >= 0) {
      float* xm = r < TC ? P.xcbuf + (size_t)r * D : P.out + (size_t)(r - TC) * D;
      const float* g2 = P.mod + (size_t)(combine_l * 9 + n) * 6144 + 5 * 1024;
#pragma unroll
      for (int i = 0; i < 4; i++) {
        int c = i * 256 + lane * 4;
        float4 g = *(const float4*)(g2 + c); float4 t = xv[i];
        t.x += g.x * ((float)ya[i][0] + (float)yb[i][0]); t.y += g.y * ((float)ya[i][1] + (float)yb[i][1]);
        t.z += g.z * ((float)ya[i][2] + (float)yb[i][2]); t.w += g.w * ((float)ya[i][3] + (float)yb[i][3]);
        *(float4*)(xm + c) = t; xv[i] = t;
      }
    }
    if (norm_l >= 0) {
      float ss = 0.f;
#pragma unroll
      for (int i = 0; i < 4; i++) ss += xv[i].x * xv[i].x + xv[i].y * xv[i].y + xv[i].z * xv[i].z + xv[i].w * xv[i].w;
      ss = wave_sum(ss);
      const float rstd = rsqrtf(ss * (1.f / 1024.f) + EPS);
      const float* g = P.norm1_g + norm_l * 1024;
      const float* sh = P.mod + (size_t)(norm_l * 9 + n) * 6144; const float* sc = sh + 1024;
#pragma unroll
      for (int i = 0; i < 4; i++) {
        int c = i * 256 + lane * 4;
        float4 gg = *(const float4*)(g + c), s1 = *(const float4*)(sc + c), s0 = *(const float4*)(sh + c);
        h4 o;
        o[0] = (half_t)(xv[i].x * rstd * gg.x * (1.f + s1.x) + s0.x); o[1] = (half_t)(xv[i].y * rstd * gg.y * (1.f + s1.y) + s0.y);
        o[2] = (half_t)(xv[i].z * rstd * gg.z * (1.f + s1.z) + s0.z); o[3] = (half_t)(xv[i].w * rstd * gg.w * (1.f + s1.w) + s0.w);
        *(h4*)(P.hx + (size_t)r * D + c) = o;
      }
    }
  };
#pragma unroll 1
  for (int r = r_begin + gw; r < TA; r += 4 * nw) {
    float4 x0[4], x1[4], x2[4], x3[4]; h4 a0[4], b0[4], a1[4], b1[4], a2[4], b2[4], a3[4], b3[4];
    const int r1 = r + nw, r2 = r + 2 * nw, r3 = r + 3 * nw;
    load_row(r, x0, a0, b0);
    if (r1 < TA) load_row(r1, x1, a1, b1);
    if (r2 < TA) load_row(r2, x2, a2, b2);
    if (r3 < TA) load_row(r3, x3, a3, b3);
    process(r, x0, a0, b0);
    if (r1 < TA) process(r1, x1, a1, b1);
    if (r2 < TA) process(r2, x2, a2, b2);
    if (r3 < TA) process(r3, x3, a3, b3);
  }
}

DI void row2_phase(const Params& P, int l, int r_begin, char* smem) {
  const int tid = TIDX, lane = tid & 63, wave = tid >> 6, fr = lane & 15, fq = lane >> 4;
  float* lg = (float*)smem + wave * 16 * 48;
  const half_t* Whi = P.WrH + (size_t)(l * 2) * 49152; const half_t* Wlo = Whi + 49152;
  const int ngroups = (TA - r_begin) >> 4, gw = blockIdx.x * 4 + wave, nw = gridDim.x * 4;
  const float* gam = P.norm2_g + l * 1024;
#pragma unroll 1
  for (int grp = gw; grp < ngroups; grp += nw) {
    const int r0 = r_begin + grp * 16, row = r0 + fr, n = row_mod(r0);
    const float* xm = (row < TC ? P.xcbuf + (size_t)row * D : P.out + (size_t)(row - TC) * D) + fq * 8;
    float ss = 0.f;
#pragma unroll 16
    for (int kk = 0; kk < 32; kk++) {
      const float4 a = *(const float4*)(xm + kk * 32), b = *(const float4*)(xm + kk * 32 + 4);
      ss += a.x * a.x + a.y * a.y + a.z * a.z + a.w * a.w + b.x * b.x + b.y * b.y + b.z * b.z + b.w * b.w;
    }
    ss += shx(ss, 16); ss += shx(ss, 32);
    const float rstd = rsqrtf(ss * (1.f / 1024.f) + EPS);
    const float* sh = P.mod + (size_t)(l * 9 + n) * 6144 + 3 * 1024 + fq * 8; const float* sc = sh + 1024;
    f4 acc[3];
#pragma unroll
    for (int i = 0; i < 3; i++) acc[i] = (f4){0.f, 0.f, 0.f, 0.f};
    half_t* hxo = P.hx + (size_t)row * D + fq * 8;
#pragma unroll 4
    for (int kk = 0; kk < 32; kk++) {
      const int k0 = kk * 32;
      float x[8], g[8], s1[8], s0[8];
      *(float4*)&x[0] = *(const float4*)(xm + k0); *(float4*)&x[4] = *(const float4*)(xm + k0 + 4);
      *(float4*)&g[0] = *(const float4*)(gam + fq * 8 + k0); *(float4*)&g[4] = *(const float4*)(gam + fq * 8 + k0 + 4);
      *(float4*)&s1[0] = *(const float4*)(sc + k0); *(float4*)&s1[4] = *(const float4*)(sc + k0 + 4);
      *(float4*)&s0[0] = *(const float4*)(sh + k0); *(float4*)&s0[4] = *(const float4*)(sh + k0 + 4);
      h8 hi, lo;
#pragma unroll
      for (int i = 0; i < 8; i++) {
        float v = x[i] * rstd * g[i] * (1.f + s1[i]) + s0[i];
        hi[i] = (half_t)v; lo[i] = (half_t)(v - (float)hi[i]);
      }
      *(h8*)(hxo + k0) = hi;
#pragma unroll
      for (int n3 = 0; n3 < 3; n3++) {
        h8 bh = *(const h8*)(Whi + (size_t)(n3 * 16 + fr) * 1024 + k0 + fq * 8);
        h8 bl = *(const h8*)(Wlo + (size_t)(n3 * 16 + fr) * 1024 + k0 + fq * 8);
        acc[n3] = mfma16(hi, bh, acc[n3]); acc[n3] = mfma16(lo, bh, acc[n3]); acc[n3] = mfma16(hi, bl, acc[n3]);
      }
    }
    __builtin_amdgcn_wave_barrier();
#pragma unroll
    for (int n3 = 0; n3 < 3; n3++)
#pragma unroll
      for (int j = 0; j < 4; j++) lg[(fq * 4 + j) * 48 + n3 * 16 + fr] = acc[n3][j];
    __builtin_amdgcn_wave_barrier();
    if (lane < 16) {
      const int r = r0 + lane;
      const float* L = lg + lane * 48;
      float gl[4]; int gi = 0;
#pragma unroll
      for (int j = 0; j < 4; j++) gl[j] = L[j] + P.b_group[l * 4 + j];
      float gm = gl[0];
#pragma unroll
      for (int j = 1; j < 4; j++) if (gl[j] > gm) { gm = gl[j]; gi = j; }
      float gs = 0.f;
#pragma unroll
      for (int j = 0; j < 4; j++) gs += expf(gl[j] - gm);
      const float pg = 1.f / gs;
      float el[8];
#pragma unroll
      for (int j = 0; j < 8; j++) el[j] = L[4 + gi * 8 + j] + P.b_router[l * 32 + gi * 8 + j];
      int i0 = 0; float v0 = el[0];
#pragma unroll
      for (int j = 1; j < 8; j++) if (el[j] > v0) { v0 = el[j]; i0 = j; }
      int i1 = -1; float v1 = -3.0e38f;
#pragma unroll
      for (int j = 0; j < 8; j++) if (j != i0 && el[j] > v1) { v1 = el[j]; i1 = j; }
      const float ex = expf(v1 - v0);
      const float w0 = pg / (1.f + ex), w1 = pg * ex / (1.f + ex);
      const int e0 = gi * 8 + i0, e1 = gi * 8 + i1;
      int p0 = atomicAdd(&P.cnt[l * 32 + e0], 1); P.list[(size_t)e0 * LCAP + p0] = 2 * r; P.listW[(size_t)e0 * LCAP + p0] = w0;
      int p1 = atomicAdd(&P.cnt[l * 32 + e1], 1); P.list[(size_t)e1 * LCAP + p1] = 2 * r + 1; P.listW[(size_t)e1 * LCAP + p1] = w1;
    }
    __builtin_amdgcn_wave_barrier();
  }
}

DI h8 lds128(unsigned a) { h8 r; asm volatile("ds_read_b128 %0, %1" : "=v"(r) : "v"(a)); return r; }
DI void tie(h8& x) { asm volatile("" : "+v"(x)); }
DI unsigned lds_addr(const void* p) { return (unsigned)(size_t)p; }
#define WAIT_LGKM(n) asm volatile("s_waitcnt lgkmcnt(" #n ")" ::: "memory")
DI void raw_barrier() { asm volatile("" ::: "memory"); __builtin_amdgcn_s_barrier(); asm volatile("" ::: "memory"); }
DI void slot_rc(int i, int& row, int& coff) { int s = i * 256 + TIDX; row = s >> 3; coff = ((s & 7) ^ ((row >> 1) & 7)) * 8; }

template <class AF, class BF>
DI void gemm_prologue(AF aptr, BF bptr, int nk, char* smem) {
  const int tid = TIDX;
#pragma unroll
  for (int st = 0; st < 2; st++) {
    if (st < nk) {
      char* d = smem + st * 49152 + tid * 16;
#pragma unroll
      for (int i = 0; i < 8; i++) glds16(aptr(i) + st * 64, d + i * 4096);
#pragma unroll
      for (int i = 0; i < 4; i++) glds16(bptr(i) + st * 64, d + 32768 + i * 4096);
    }
  }
}
template <bool PRE = false, class AF, class BF>
DI void gemm256(AF aptr, BF bptr, int nk, char* smem, f4 (&acc)[8][4]) {
  const int tid = TIDX, lane = tid & 63, wave = tid >> 6, fr = lane & 15, fq = lane >> 4, wr = wave >> 1, wc = wave & 1;
#pragma unroll
  for (int m = 0; m < 8; m++)
#pragma unroll
    for (int n = 0; n < 4; n++) acc[m][n] = (f4){0.f, 0.f, 0.f, 0.f};
  auto issue = [&](int kt, int st) {
    char* d = smem + st * 49152 + tid * 16;
#pragma unroll
    for (int i = 0; i < 8; i++) glds16(aptr(i) + kt * 64, d + i * 4096);
#pragma unroll
    for (int i = 0; i < 4; i++) glds16(bptr(i) + kt * 64, d + 32768 + i * 4096);
  };
  const unsigned sw = (unsigned)((fq ^ (fr >> 1)) << 4);
  const unsigned offA = (wr * 128 + fr) * 128 + sw, offB = 32768 + (wc * 64 + fr) * 128 + sw;
  const unsigned sbase = lds_addr(smem);
  if (!PRE) { issue(0, 0); if (nk > 1) issue(1, 1); }
  int st = 0;
#pragma unroll 1
  for (int kt = 0; kt < nk; kt++) {
    if (kt + 1 < nk) asm volatile("s_waitcnt vmcnt(12)" ::: "memory"); else wait_vm0();
    raw_barrier();
    if (kt + 2 < nk) issue(kt + 2, st == 0 ? 2 : st - 1);
    const unsigned base = sbase + st * 49152;
    st = st == 2 ? 0 : st + 1;
    h8 a0[8], b0[4], a1[8], b1[4];
#pragma unroll
    for (int m = 0; m < 8; m++) a0[m] = lds128(base + offA + m * 2048);
#pragma unroll
    for (int n = 0; n < 4; n++) b0[n] = lds128(base + offB + n * 2048);
#pragma unroll
    for (int m = 0; m < 8; m++) a1[m] = lds128(base + (offA ^ 64) + m * 2048);
#pragma unroll
    for (int n = 0; n < 4; n++) b1[n] = lds128(base + (offB ^ 64) + n * 2048);
    WAIT_LGKM(12);
#pragma unroll
    for (int m = 0; m < 8; m++) tie(a0[m]);
#pragma unroll
    for (int n = 0; n < 4; n++) tie(b0[n]);
#pragma unroll
    for (int m = 0; m < 8; m++)
#pragma unroll
      for (int n = 0; n < 4; n++) acc[m][n] = mfma16(a0[m], b0[n], acc[m][n]);
    WAIT_LGKM(0);
#pragma unroll
    for (int m = 0; m < 8; m++) tie(a1[m]);
#pragma unroll
    for (int n = 0; n < 4; n++) tie(b1[n]);
#pragma unroll
    for (int m = 0; m < 8; m++)
#pragma unroll
      for (int n = 0; n < 4; n++) acc[m][n] = mfma16(a1[m], b1[n], acc[m][n]);
  }
  raw_barrier();
}
DI bool xcd_tile(int it, int MT, int NT, int& mt, int& nt) {
  const int x = blockIdx.x & 7, j = blockIdx.x >> 3;
  const int nsn = NT >> 2, nsm = (MT + 7) >> 3;
  const int s = x + 8 * it;
  if (s >= nsm * nsn) return false;
  const int sm = s / nsn, sn = s % nsn;
  mt = sm * 8 + (j >> 2); nt = sn * 4 + (j & 3);
  return true;
}
DI bool next_tile(int& it, int MT, int NT, int& mt, int& nt) {
  for (;; it++) {
    if (!xcd_tile(it, MT, NT, mt, nt)) return false;
    if (mt < MT) return true;
  }
}
DI int slot_col() { int t = TIDX; return ((t & 7) ^ ((t >> 4) & 7)) * 8; }

DI float dpp_row_sum(float v) {
  v += __builtin_bit_cast(float, __builtin_amdgcn_update_dpp(0, __builtin_bit_cast(int, v), 0x128, 0xf, 0xf, false));
  v += __builtin_bit_cast(float, __builtin_amdgcn_update_dpp(0, __builtin_bit_cast(int, v), 0x124, 0xf, 0xf, false));
  v += __builtin_bit_cast(float, __builtin_amdgcn_update_dpp(0, __builtin_bit_cast(int, v), 0x122, 0xf, 0xf, false));
  v += __builtin_bit_cast(float, __builtin_amdgcn_update_dpp(0, __builtin_bit_cast(int, v), 0x121, 0xf, 0xf, false));
  return v;
}
DI void stage_put(char* stg, int ml, int n, int j, int fr, int fq, float v) { *(half_t*)(stg + (ml * 16 + fq * 4 + j) * 144 + (n * 16 + fr) * 2) = (half_t)v; }
template <class RP, class SC>
DI void stage_flush(char* stg, int h, RP rowptr, SC rowscale) {
  const int lane = TIDX & 63;
  __builtin_amdgcn_wave_barrier();
#pragma unroll
  for (int i = 0; i < 8; i++) {
    const int c = i * 64 + lane, row = c >> 3, c16 = c & 7;
    h8 v = *(const h8*)(stg + row * 144 + c16 * 16);
    half_t* d = rowptr(h * 64 + row);
    if (d) { rowscale(h * 64 + row, v); *(h8*)(d + c16 * 8) = v; }
  }
  __builtin_amdgcn_wave_barrier();
}
template <class VF, class RP, class SC>
DI void wave_store_tile(VF val, char* stg, RP rowptr, SC rowscale) {
  const int lane = TIDX & 63, fr = lane & 15, fq = lane >> 4;
#pragma unroll
  for (int h = 0; h < 2; h++) {
#pragma unroll
    for (int ml = 0; ml < 4; ml++)
#pragma unroll
      for (int n = 0; n < 4; n++)
#pragma unroll
        for (int j = 0; j < 4; j++) stage_put(stg, ml, n, j, fr, fq, val(h * 4 + ml, n, j));
    stage_flush(stg, h, rowptr, rowscale);
  }
}
DI void gemm_in_phase(const Params& P, int l, char* smem) {
  const int tid = TIDX;
  const half_t* Wt = P.WtIn + (size_t)l * NIN * 1024;
  const int sc = slot_col(), srow = tid >> 3;
  {
    float2* rcl = (float2*)(smem + 147456);
    for (int i = tid; i < 1024; i += 256) rcl[i] = P.rope[i];
    __syncthreads();
  }
  int it = 0, mt, nt;
  bool have = next_tile(it, 264, 20, mt, nt);
  const half_t* a0 = nullptr; const half_t* b0 = nullptr;
  if (have) {
    asm volatile("" : "+s"(mt), "+s"(nt));
    a0 = P.hx + (size_t)(mt * 256 + srow) * D + sc; b0 = Wt + (size_t)(nt * 128 + srow) * D + sc;
    gemm_prologue([&](int i) { return a0 + (size_t)i * 32 * D; }, [&](int i) { return b0 + (size_t)i * 32 * D; }, 16, smem);
  }
#pragma unroll 1
  while (have) {
    f4 acc[8][4];
    gemm256<true>([&](int i) { return a0 + (size_t)i * 32 * D; }, [&](int i) { return b0 + (size_t)i * 32 * D; }, 16, smem, acc);
    const int tid2 = TIDX, lane = tid2 & 63, wave = tid2 >> 6, fr = lane & 15, fq = lane >> 4, wr = wave >> 1, wc = wave & 1;
    const int r0 = mt * 256 + wr * 128;
    const bool isctx = r0 < TC;
    int b, pos0;
    if (isctx) { b = r0 >> 8; pos0 = r0 & 255; } else { b = (r0 - TC) >> 13; pos0 = 256 + ((r0 - TC) & 8191); }
    const bool isqk = nt >= 4 && nt < 12;
    float gg[4] = {0.f, 0.f, 0.f, 0.f}; float2 rr2[2] = {make_float2(1.f, 0.f), make_float2(1.f, 0.f)};
    if (isqk) {
      const float* gvec = (nt < 8 ? P.q_norm_g : P.k_norm_g) + l * 64;
      const float qs = nt < 8 ? 0.125f * 1.4426950408889634f : 1.f;
#pragma unroll
      for (int n = 0; n < 4; n++) gg[n] = gvec[n * 16 + fr] * qs;
      if (!isctx) { const int tp0 = pos0 - 256; rr2[0] = P.rope[(tp0 >> 6) * 16 + fr]; rr2[1] = P.rope[((tp0 >> 6) + 1) * 16 + fr]; }
    }
#pragma unroll
    for (int n = 0; n < 4; n++) asm volatile("" : "+v"(gg[n]));
    asm volatile("" : "+v"(rr2[0].x), "+v"(rr2[0].y), "+v"(rr2[1].x), "+v"(rr2[1].y));
    int it2 = it + 1, mt2, nt2;
    const bool have2 = next_tile(it2, 264, 20, mt2, nt2);
    const half_t* a1 = a0; const half_t* b1 = b0;
    if (have2) {
      asm volatile("" : "+s"(mt2), "+s"(nt2));
      a1 = P.hx + (size_t)(mt2 * 256 + srow) * D + sc; b1 = Wt + (size_t)(nt2 * 128 + srow) * D + sc;
      gemm_prologue([&](int i) { return a1 + (size_t)i * 32 * D; }, [&](int i) { return b1 + (size_t)i * 32 * D; }, 16, smem);
    }
    char* stg = smem + 98304 + wave * 12288;
    auto noscale = [](int, h8&) {};
    if (nt < 4 || nt >= 16) {
      half_t* dst; int ld, c0; bool gel = false;
      if (nt < 4) { dst = P.QF; ld = 512; c0 = nt * 128; }
      else if (nt < 18) { dst = P.gy; ld = 256; c0 = (nt - 16) * 128; gel = true; }
      else { dst = P.rr; ld = 256; c0 = (nt - 18) * 128; }
      half_t* base = dst + (size_t)r0 * ld + c0 + wc * 64;
      if (gel) wave_store_tile([&](int m, int n, int j) { return gelu_tanh(acc[m][n][j]); }, stg, [&](int r) { return base + (size_t)r * ld; }, noscale);
      else wave_store_tile([&](int m, int n, int j) { return acc[m][n][j]; }, stg, [&](int r) { return base + (size_t)r * ld; }, noscale);
    } else if (nt < 12) {
      const bool isq = nt < 8; const int head = isq ? nt - 4 : nt - 8;
      const float2* rcl = (const float2*)(smem + 147456);
      half_t* base = (isq ? P.q + (size_t)r0 * 512 : P.kall + ((size_t)b * KV + pos0) * 512) + head * 128 + wc * 64;
#pragma unroll
      for (int mh = 0; mh < 2; mh++) {
#pragma unroll
        for (int mm = 0; mm < 4; mm++) {
          const int m = mh * 4 + mm;
#pragma unroll
          for (int j = 0; j < 4; j++) {
            float ss = 0.f;
#pragma unroll
            for (int n = 0; n < 4; n++) ss += acc[m][n][j] * acc[m][n][j];
            ss = dpp_row_sum(ss);
            const float rstd = rsqrtf(ss * (1.f / 64.f) + EPS);
            float o[4];
#pragma unroll
            for (int n = 0; n < 4; n++) o[n] = acc[m][n][j] * rstd * gg[n];
            if (!isctx) {
              const float2 cr = rr2[mh], cc = rcl[(mm * 16 + fq * 4 + j) * 16 + fr];
              float a0 = o[0] * cr.x - o[1] * cr.y, a1 = o[1] * cr.x + o[0] * cr.y;
              float a2 = o[2] * cc.x - o[3] * cc.y, a3 = o[3] * cc.x + o[2] * cc.y;
              o[0] = a0; o[1] = a1; o[2] = a2; o[3] = a3;
            }
#pragma unroll
            for (int n = 0; n < 4; n++) stage_put(stg, mm, n, j, fr, fq, o[n]);
          }
        }
        stage_flush(stg, mh, [&](int r) { return base + (size_t)r * 512; }, noscale);
      }
    } else {
      const int head = nt - 12;
#pragma unroll
      for (int m = 0; m < 8; m++)
#pragma unroll
        for (int n = 0; n < 4; n++) {
          h4 o; o[0] = (half_t)acc[m][n][0]; o[1] = (half_t)acc[m][n][1]; o[2] = (half_t)acc[m][n][2]; o[3] = (half_t)acc[m][n][3];
          int d = wc * 64 + n * 16 + fr;
          asm volatile("" : "+v"(d) :: "memory");
          *(h4*)(P.vT + ((size_t)(b * 4 + head) * 128 + d) * KV + pos0 + m * 16 + fq * 4) = o;
        }
    }
    mt = mt2; nt = nt2; it = it2; have = have2; a0 = a1; b0 = b1;
  }
}

DI void gemm_out_phase(const Params& P, int l, char* smem) {
  const int tid = TIDX;
  const half_t* Wt = P.WtOut + (size_t)l * 1048576;
  const int mt0 = l == 0 ? 0 : TC / 256;
  const int MT = 264 - mt0;
  const int sc = slot_col(), srow = tid >> 3;
  int it = 0, mt, nt;
  bool have = next_tile(it, MT, 8, mt, nt);
  const half_t* a0 = nullptr; const half_t* b0 = nullptr;
  if (have) {
    asm volatile("" : "+s"(mt), "+s"(nt));
    a0 = P.mix + (size_t)((mt + mt0) * 256 + srow) * D + sc; b0 = Wt + (size_t)(nt * 128 + srow) * D + sc;
    gemm_prologue([&](int i) { return a0 + (size_t)i * 32 * D; }, [&](int i) { return b0 + (size_t)i * 32 * D; }, 16, smem);
  }
#pragma unroll 1
  while (have) {
    f4 acc[8][4];
    gemm256<true>([&](int i) { return a0 + (size_t)i * 32 * D; }, [&](int i) { return b0 + (size_t)i * 32 * D; }, 16, smem, acc);
    const int tid2 = TIDX, lane2 = tid2 & 63, wave2 = tid2 >> 6, fr2 = lane2 & 15, fq2 = lane2 >> 4, wr2 = wave2 >> 1, wc2 = wave2 & 1;
    const int r0 = (mt + mt0) * 256 + wr2 * 128;
    const int n = row_mod(r0);
    const int cbase = nt * 128 + wc2 * 64;
    const float* res; float* dst;
    if (r0 < TC) { res = P.ctx + (size_t)r0 * D; dst = P.xcbuf + (size_t)r0 * D; }
    else { dst = P.out + (size_t)(r0 - TC) * D; res = l == 0 ? P.x + (size_t)(r0 - TC) * D : dst; }
    res += cbase + fr2 * 4; dst += cbase + fr2 * 4;
    const float4 g4 = *(const float4*)(P.mod + (size_t)(l * 9 + n) * 6144 + 2 * 1024 + cbase + fr2 * 4);
    float4 rres[4][8];
#pragma unroll
    for (int q = 0; q < 4; q++)
#pragma unroll
      for (int i = 0; i < 8; i++) rres[q][i] = *(const float4*)(res + (size_t)(q * 32 + i * 4 + fq2) * D);
    int it2 = it + 1, mt2, nt2;
    const bool have2 = next_tile(it2, MT, 8, mt2, nt2);
    const half_t* a1 = a0; const half_t* b1 = b0;
    if (have2) {
      asm volatile("" : "+s"(mt2), "+s"(nt2));
      a1 = P.mix + (size_t)((mt2 + mt0) * 256 + srow) * D + sc; b1 = Wt + (size_t)(nt2 * 128 + srow) * D + sc;
      gemm_prologue([&](int i) { return a1 + (size_t)i * 32 * D; }, [&](int i) { return b1 + (size_t)i * 32 * D; }, 16, smem);
    }
    {
      float* stg = (float*)(smem + 98304 + wave2 * 12288);
#pragma unroll
      for (int q = 0; q < 4; q++) {
#pragma unroll
        for (int ml = 0; ml < 2; ml++)
#pragma unroll
          for (int nn = 0; nn < 4; nn++)
#pragma unroll
            for (int j = 0; j < 4; j++) stg[(ml * 16 + fq2 * 4 + j) * 68 + nn * 16 + fr2] = acc[q * 2 + ml][nn][j];
        __builtin_amdgcn_wave_barrier();
#pragma unroll
        for (int i = 0; i < 8; i++) {
          const int row = i * 4 + fq2;
          const float4 a = *(const float4*)(stg + row * 68 + fr2 * 4);
          float4 r = rres[q][i];
          r.x += g4.x * a.x; r.y += g4.y * a.y; r.z += g4.z * a.z; r.w += g4.w * a.w;
          *(float4*)(dst + (size_t)(q * 32 + row) * D) = r;
        }
        __builtin_amdgcn_wave_barrier();
      }
    }
    mt = mt2; nt = nt2; it = it2; have = have2; a0 = a1; b0 = b1;
  }
}

DI void moe_prefix(const Params& P, int l, int* tb) {
  __syncthreads();
  if (TIDX == 0) { int s = 0; for (int e = 0; e < 32; e++) { tb[e] = s; s += (P.cnt[l * 32 + e] + 255) >> 8; } tb[32] = s; }
  __syncthreads();
}
DI void moe_e1_phase(const Params& P, int l, char* smem, int* tb) {
  const int tid = TIDX;
  moe_prefix(P, l, tb);
  const int sc = slot_col(), srow = tid >> 3;
  const int MT = tb[32];
  auto setup = [&](int rt, int nt, int (&tok)[8], const half_t*& w1, const half_t*& w3) {
    int e = 0;
    while (tb[e + 1] <= rt) e++;
    const int rl = rt - tb[e], cnt = P.cnt[l * 32 + e];
    const int* lst = P.list + (size_t)e * LCAP;
    w1 = P.Wt1 + ((size_t)(l * 32 + e) * 512 + nt * 64) * 1024 + sc;
    w3 = P.Wt3 + ((size_t)(l * 32 + e) * 512 + nt * 64) * 1024 + sc;
#pragma unroll
    for (int i = 0; i < 8; i++) tok[i] = lst[min(rl * 256 + i * 32 + srow, cnt - 1)] >> 1;
  };
  int it = 0, rt, nt;
  bool have = next_tile(it, MT, 8, rt, nt);
  int tok[8]; const half_t* w1 = nullptr; const half_t* w3 = nullptr;
  if (have) {
    asm volatile("" : "+s"(rt), "+s"(nt));
    setup(rt, nt, tok, w1, w3);
    gemm_prologue([&](int i) { return P.hx + (size_t)tok[i] * D + sc; }, [&](int i) { return ((i & 1) ? w3 : w1) + (size_t)((i >> 1) * 32 + srow) * 1024; }, 16, smem);
  }
#pragma unroll 1
  while (have) {
    int it2 = it + 1, rt2, nt2;
    const bool have2 = next_tile(it2, MT, 8, rt2, nt2);
    int tok2[8]; const half_t* w1n = w1; const half_t* w3n = w3;
#pragma unroll
    for (int i = 0; i < 8; i++) tok2[i] = tok[i];
    if (have2) {
      asm volatile("" : "+s"(rt2), "+s"(nt2));
      setup(rt2, nt2, tok2, w1n, w3n);
    }
    f4 acc[8][4];
    gemm256<true>([&](int i) { return P.hx + (size_t)tok[i] * D + sc; },
                  [&](int i) { return ((i & 1) ? w3 : w1) + (size_t)((i >> 1) * 32 + srow) * 1024; }, 16, smem, acc);
    if (have2) {
      gemm_prologue([&](int i) { return P.hx + (size_t)tok2[i] * D + sc; }, [&](int i) { return ((i & 1) ? w3n : w1n) + (size_t)((i >> 1) * 32 + srow) * 1024; }, 16, smem);
    }
    {
      const int tid2 = TIDX, lane2 = tid2 & 63, wave2 = tid2 >> 6, fr2 = lane2 & 15, fq2 = lane2 >> 4, wr2 = wave2 >> 1, wc2 = wave2 & 1;
      char* stg = smem + 98304 + wave2 * 12288;
      half_t* Hd = P.H + ((size_t)rt * 256 + wr2 * 128) * 512 + nt * 64 + wc2 * 32;
#pragma unroll
      for (int h = 0; h < 2; h++) {
#pragma unroll
        for (int ml = 0; ml < 4; ml++)
#pragma unroll
          for (int n = 0; n < 2; n++)
#pragma unroll
            for (int j = 0; j < 4; j++) {
              float a1 = acc[h * 4 + ml][n][j], a3 = acc[h * 4 + ml][n + 2][j];
              *(half_t*)(stg + (ml * 16 + fq2 * 4 + j) * 80 + (n * 16 + fr2) * 2) = (half_t)(a1 * sigmoidf_(a1) * a3);
            }
        __builtin_amdgcn_wave_barrier();
#pragma unroll
        for (int i = 0; i < 4; i++) {
          const int c = i * 64 + lane2, row = c >> 2, c16 = c & 3;
          h8 v = *(const h8*)(stg + row * 80 + c16 * 16);
          *(h8*)(Hd + (size_t)(h * 64 + row) * 512 + c16 * 8) = v;
        }
        __builtin_amdgcn_wave_barrier();
      }
    }
    rt = rt2; nt = nt2; it = it2; have = have2; w1 = w1n; w3 = w3n;
#pragma unroll
    for (int i = 0; i < 8; i++) tok[i] = tok2[i];
  }
}
DI void moe_e2_phase(const Params& P, int l, char* smem, int* tb) {
  const int tid = TIDX;
  moe_prefix(P, l, tb);
  const int sc = slot_col(), srow = tid >> 3;
  const int MT = tb[32];
  auto ptrs = [&](int rt, int nt, const half_t*& a0, const half_t*& b0) {
    int e = 0;
    while (tb[e + 1] <= rt) e++;
    a0 = P.H + ((size_t)rt * 256 + srow) * 512 + sc;
    b0 = P.Wt2 + ((size_t)(l * 32 + e) * 1024 + nt * 128 + srow) * 512 + sc;
  };
  int it = 0, rt, nt;
  bool have = next_tile(it, MT, 8, rt, nt);
  const half_t* a0 = nullptr; const half_t* b0 = nullptr;
  if (have) {
    asm volatile("" : "+s"(rt), "+s"(nt));
    ptrs(rt, nt, a0, b0);
    gemm_prologue([&](int i) { return a0 + (size_t)i * 32 * 512; }, [&](int i) { return b0 + (size_t)i * 32 * 512; }, 8, smem);
  }
#pragma unroll 1
  while (have) {
    const int tid2 = TIDX, lane2 = tid2 & 63, wave2 = tid2 >> 6, wr2 = wave2 >> 1, wc2 = wave2 & 1;
    int e = 0;
    while (tb[e + 1] <= rt) e++;
    const int rl = rt - tb[e], cnt = P.cnt[l * 32 + e];
    const int* lst = P.list + (size_t)e * LCAP; const float* lstw = P.listW + (size_t)e * LCAP;
    int aa[2][8]; float ww[2][8];
#pragma unroll
    for (int h = 0; h < 2; h++)
#pragma unroll
      for (int i = 0; i < 8; i++) {
        const int idx = rl * 256 + wr2 * 128 + h * 64 + ((i * 64 + lane2) >> 3);
        const int ic = min(idx, cnt - 1);
        const int av = lst[ic]; const float wv = lstw[ic];
        aa[h][i] = idx < cnt ? av : -1; ww[h][i] = wv;
      }
    f4 acc[8][4];
    gemm256<true>([&](int i) { return a0 + (size_t)i * 32 * 512; }, [&](int i) { return b0 + (size_t)i * 32 * 512; }, 8, smem, acc);
    int it2 = it + 1, rt2, nt2;
    const bool have2 = next_tile(it2, MT, 8, rt2, nt2);
    const half_t* a1 = a0; const half_t* b1 = b0;
    if (have2) {
      asm volatile("" : "+s"(rt2), "+s"(nt2));
      ptrs(rt2, nt2, a1, b1);
      gemm_prologue([&](int i) { return a1 + (size_t)i * 32 * 512; }, [&](int i) { return b1 + (size_t)i * 32 * 512; }, 8, smem);
    }
    {
      char* stg = smem + 98304 + wave2 * 12288;
      const int fr2 = lane2 & 15, fq2 = lane2 >> 4;
#pragma unroll
      for (int h = 0; h < 2; h++) {
#pragma unroll
        for (int ml = 0; ml < 4; ml++)
#pragma unroll
          for (int n = 0; n < 4; n++)
#pragma unroll
            for (int j = 0; j < 4; j++) stage_put(stg, ml, n, j, fr2, fq2, acc[h * 4 + ml][n][j]);
        __builtin_amdgcn_wave_barrier();
#pragma unroll
        for (int i = 0; i < 8; i++) {
          const int c = i * 64 + lane2, row = c >> 3, c16 = c & 7;
          h8 v = *(const h8*)(stg + row * 144 + c16 * 16);
          if (aa[h][i] >= 0) {
            const float w = ww[h][i];
#pragma unroll
            for (int u = 0; u < 8; u++) v[u] = (half_t)(w * (float)v[u]);
            *(h8*)(P.yA + (size_t)aa[h][i] * D + nt * 128 + wc2 * 64 + c16 * 8) = v;
          }
        }
        __builtin_amdgcn_wave_barrier();
      }
    }
    rt = rt2; nt = nt2; it = it2; have = have2; a0 = a1; b0 = b1;
  }
}

DI int swap23(int x) { return (x & ~12) | ((x & 4) << 1) | ((x & 8) >> 1); }
DI void attn_item(const Params& P, int l, int b, int head, int row0, int nkeys, char* smem) {
  const int tid = TIDX, lane = tid & 63, wave = tid >> 6, ql = lane & 31, hh = lane >> 5;
  const float lam = P.consts[l * 4 + 0], negc = -P.consts[l * 4 + 1], lam_init = P.consts[l * 4 + 2];
  const int myrow = row0 + wave * 32 + ql;
  h8 qf[2][4];
  {
    const half_t* qp = P.q + (size_t)myrow * 512 + head * 128 + hh * 8;
#pragma unroll
    for (int m = 0; m < 2; m++)
#pragma unroll
      for (int s = 0; s < 4; s++) { qf[m][s] = *(const h8*)(qp + m * 64 + s * 16); }
#pragma unroll
    for (int m = 0; m < 2; m++)
#pragma unroll
      for (int s = 0; s < 4; s++) tie(qf[m][s]);
  }
  f16v o0[4], o1[4];
#pragma unroll
  for (int dt = 0; dt < 4; dt++)
#pragma unroll
    for (int i = 0; i < 16; i++) { o0[dt][i] = 0.f; o1[dt][i] = 0.f; }
  float ls0 = 0.f, ls1 = 0.f;
  const half_t* kp[4]; const half_t* vp[4];
  {
    const half_t* kbase = P.kall + (size_t)b * KV * 512 + head * 128;
    const half_t* vbase = P.vT + (size_t)(b * 4 + head) * 128 * KV;
#pragma unroll
    for (int i = 0; i < 4; i++) {
      int s = i * 256 + tid;
      int row = s >> 4, c = (s & 15) ^ (row & 15); kp[i] = kbase + (size_t)row * 512 + c * 8;
      int vr = s >> 3, vc = (s & 7) ^ ((vr >> 1) & 7); vp[i] = vbase + (size_t)vr * KV + vc * 8;
    }
  }
  const int ntile = nkeys >> 6;
  const unsigned sbase = lds_addr(smem);
  auto issue = [&](int t) {
    char* d = smem + (t & 3) * 32768 + tid * 16;
#pragma unroll
    for (int i = 0; i < 4; i++) { glds16(kp[i] + (size_t)t * 64 * 512, d + i * 4096); glds16(vp[i] + t * 64, d + 16384 + i * 4096); }
  };
  unsigned koff[2];
  const int kr_lo = swap23(ql), ksw = kr_lo & 15;
  koff[0] = kr_lo * 256; koff[1] = (32 + kr_lo) * 256;
  unsigned voff[4];
#pragma unroll
  for (int dt = 0; dt < 4; dt++) { int vrow = dt * 32 + ql; voff[dt] = 16384 + vrow * 128; }
  const int vsw = (ql >> 1) & 7;
  f16v negcv;
#pragma unroll
  for (int i = 0; i < 16; i++) negcv[i] = negc;
  h8 pp0[2], pp1[2];
  unsigned pendV = 0; int pendkt = 0; bool pend = false;
  auto half_step = [&](h8 (&kf)[8], unsigned cur, int kt) {
    h8 vf[8];
    if (pend) {
#pragma unroll
      for (int sp = 0; sp < 2; sp++)
#pragma unroll
        for (int dt = 0; dt < 4; dt++) vf[sp * 4 + dt] = lds128(pendV + voff[dt] + (((pendkt * 4 + sp * 2 + hh) ^ vsw) << 4));
    }
    f16v s0 = mfma32(kf[0], qf[0][0], negcv), s1 = mfma32(kf[4], qf[1][0], negcv);
#pragma unroll
    for (int st = 1; st < 4; st++) { s0 = mfma32(kf[st], qf[0][st], s0); s1 = mfma32(kf[4 + st], qf[1][st], s1); }
    if (pend) {
      WAIT_LGKM(0);
#pragma unroll
      for (int i = 0; i < 8; i++) tie(vf[i]);
#pragma unroll
      for (int sp = 0; sp < 2; sp++)
#pragma unroll
        for (int dt = 0; dt < 4; dt++) { o0[dt] = mfma32(vf[sp * 4 + dt], pp0[sp], o0[dt]); o1[dt] = mfma32(vf[sp * 4 + dt], pp1[sp], o1[dt]); }
    }
#pragma unroll
    for (int i = 0; i < 16; i++) { s0[i] = __builtin_amdgcn_exp2f(s0[i]); ls0 += s0[i]; s1[i] = __builtin_amdgcn_exp2f(s1[i]); ls1 += s1[i]; }
#pragma unroll
    for (int sp = 0; sp < 2; sp++) {
      u4 a, c;
      a[0] = pk2(s0[8*sp+0], s0[8*sp+1]); a[1] = pk2(s0[8*sp+2], s0[8*sp+3]); a[2] = pk2(s0[8*sp+4], s0[8*sp+5]); a[3] = pk2(s0[8*sp+6], s0[8*sp+7]);
      c[0] = pk2(s1[8*sp+0], s1[8*sp+1]); c[1] = pk2(s1[8*sp+2], s1[8*sp+3]); c[2] = pk2(s1[8*sp+4], s1[8*sp+5]); c[3] = pk2(s1[8*sp+6], s1[8*sp+7]);
      pp0[sp] = __builtin_bit_cast(h8, a); pp1[sp] = __builtin_bit_cast(h8, c);
    }
    pend = true; pendV = cur; pendkt = kt;
  };
  issue(0);
  if (ntile > 1) issue(1);
#pragma unroll 1
  for (int t = 0; t < ntile; t++) {
    if (t + 1 < ntile) asm volatile("s_waitcnt vmcnt(8)" ::: "memory"); else wait_vm0();
    raw_barrier();
    if (t + 2 < ntile) issue(t + 2);
    const unsigned cur = sbase + (t & 3) * 32768;
    h8 kfa[8], kfb[8];
#pragma unroll
    for (int st = 0; st < 4; st++) {
      kfa[st] = lds128(cur + koff[0] + (((st * 2 + hh) ^ ksw) << 4));
      kfa[4 + st] = lds128(cur + koff[0] + (((8 + st * 2 + hh) ^ ksw) << 4));
    }
#pragma unroll
    for (int st = 0; st < 4; st++) {
      kfb[st] = lds128(cur + koff[1] + (((st * 2 + hh) ^ ksw) << 4));
      kfb[4 + st] = lds128(cur + koff[1] + (((8 + st * 2 + hh) ^ ksw) << 4));
    }
    WAIT_LGKM(8);
#pragma unroll
    for (int i = 0; i < 8; i++) tie(kfa[i]);
    half_step(kfa, cur, 0);
    WAIT_LGKM(0);
#pragma unroll
    for (int i = 0; i < 8; i++) tie(kfb[i]);
    half_step(kfb, cur, 1);
  }
  {
    h8 vf[8];
#pragma unroll
    for (int sp = 0; sp < 2; sp++)
#pragma unroll
      for (int dt = 0; dt < 4; dt++) vf[sp * 4 + dt] = lds128(pendV + voff[dt] + (((pendkt * 4 + sp * 2 + hh) ^ vsw) << 4));
    WAIT_LGKM(0);
#pragma unroll
    for (int i = 0; i < 8; i++) tie(vf[i]);
#pragma unroll
    for (int sp = 0; sp < 2; sp++)
#pragma unroll
      for (int dt = 0; dt < 4; dt++) { o0[dt] = mfma32(vf[sp * 4 + dt], pp0[sp], o0[dt]); o1[dt] = mfma32(vf[sp * 4 + dt], pp1[sp], o1[dt]); }
  }
  raw_barrier();
  ls0 += shx(ls0, 32); ls1 += shx(ls1, 32);
  const float i0 = 1.f / ls0, i1 = lam / ls1;
  float ss = 0.f;
#pragma unroll
  for (int dt = 0; dt < 4; dt++)
#pragma unroll
    for (int i = 0; i < 16; i++) { float v = o0[dt][i] * i0 - o1[dt][i] * i1; o0[dt][i] = v; ss += v * v; }
  ss += shx(ss, 32);
  const float mult = rsqrtf(ss * (1.f / 128.f) + EPS) * (1.f - lam_init);
  const float* sg = P.subln_g + l * 128;
  half_t* dst = P.mix + (size_t)myrow * D + 256 + head * 128;
#pragma unroll
  for (int dt = 0; dt < 4; dt++)
#pragma unroll
    for (int g = 0; g < 4; g++) {
      const int d0 = dt * 32 + 8 * g + 4 * hh;
      float4 gv = *(const float4*)(sg + d0);
      h4 o; o[0] = (half_t)(o0[dt][4*g] * mult * gv.x); o[1] = (half_t)(o0[dt][4*g+1] * mult * gv.y);
      o[2] = (half_t)(o0[dt][4*g+2] * mult * gv.z); o[3] = (half_t)(o0[dt][4*g+3] * mult * gv.w);
      *(h4*)(dst + d0) = o;
    }
}

DI int swz128(int row, int colh) { return row * 128 + ((((colh >> 3)) ^ ((row >> 1) & 7)) << 4) + (colh & 7) * 2; }
DI void lru_load_w(const Params& P, int l, int g, char* Wt) {
  const int tid = TIDX;
  for (int dg = 0; dg < 4; dg++) {
    const int dir = dg >> 1;
    const float* w = ((dg & 1) ? P.gate_x_w : P.gate_a_w) + ((size_t)((l * 2 + dir) * 4 + g)) * 4096;
    for (int idx = tid; idx < 4096; idx += 256) { int i = idx >> 6, o = idx & 63; *(half_t*)(Wt + dg * 8192 + swz128(o, i)) = (half_t)w[idx]; }
  }
}
struct LruK { float ba[2][4], bx[2][4], sp8[2][4], cw[5]; };
DI void lru_consts(const Params& P, int l, int g, LruK& K) {
  const int tid = TIDX, fr = tid & 15, gc = g * 64 + (tid & 63);
#pragma unroll
  for (int dir = 0; dir < 2; dir++)
#pragma unroll
    for (int n = 0; n < 4; n++) {
      const int cc = (l * 2 + dir) * 256 + g * 64 + n * 16 + fr;
      K.ba[dir][n] = P.gate_a_b[cc]; K.bx[dir][n] = P.gate_x_b[cc]; K.sp8[dir][n] = -8.f * log1pf(__expf(-P.lru_lambda[cc]));
    }
#pragma unroll
  for (int k = 0; k < 4; k++) K.cw[k] = P.conv_w[(l * 4 + k) * 256 + gc];
  K.cw[4] = P.conv_b[l * 256 + gc];
}
DI void lru_tile(const Params& P, int l, int b, int tile, int g, char* smem, bool final, const LruK& K) {
  const int tid = TIDX, lane = tid & 63, wave = tid >> 6, fr = lane & 15, fq = lane >> 4;
  char* Wt = smem;
  char* xr16 = smem + 32768;
  float2* ab = (float2*)(smem + 40960);
  half_t* raw = (half_t*)(smem + 40960);
  float2* subst = (float2*)(smem + 73728);
  const int ch = tid & 63, tq = tid >> 6, gc = g * 64 + ch;
  const int T = tile < 4 ? CL : SEQ;
  const int t0 = tile < 4 ? tile * 64 : (tile - 4) * 64;
  const int rowbase = tile < 4 ? b * CL : TC + b * SEQ;
  unsigned* lab = (unsigned*)P.hx;
  __syncthreads();
  if (final) {
    float gyv[16], hsum[16];
#pragma unroll
    for (int e = 0; e < 16; e++) { gyv[e] = (float)P.gy[(size_t)(rowbase + t0 + tq * 16 + e) * 256 + gc]; hsum[e] = 0.f; }
    unsigned pk0[16], pk1[16];
#pragma unroll
    for (int e = 0; e < 16; e++) { pk0[e] = lab[((size_t)rowbase + t0 + tq * 16 + e) * 256 + gc]; pk1[e] = lab[((size_t)TA + rowbase + t0 + tq * 16 + e) * 256 + gc]; }
    const float car0 = P.lcar[((size_t)((b * 2 + 0) * 132 + tile)) * 256 + gc], car1 = P.lcar[((size_t)((b * 2 + 1) * 132 + tile)) * 256 + gc];
#pragma unroll 1
    for (int dir = 0; dir < 2; dir++) {
      unsigned pk[16];
#pragma unroll
      for (int e = 0; e < 16; e++) pk[e] = dir == 0 ? pk0[e] : pk1[e];
      float2 av[16];
      float A = 1.f, h = 0.f;
#pragma unroll
      for (int e = 0; e < 16; e++) {
        const int ee = dir == 0 ? e : 15 - e;
        unsigned u = pk[0];
#pragma unroll
        for (int q = 1; q < 16; q++) u = (q == ee) ? pk[q] : u;
        fp16x2 hv = __builtin_bit_cast(fp16x2, u);
        av[e] = make_float2(__expf((float)hv[0]), (float)hv[1]);
        h = av[e].x * h + av[e].y; A *= av[e].x;
      }
      subst[tq * 64 + ch] = make_float2(A, h);
      __syncthreads();
      h = dir == 0 ? car0 : car1;
      if (dir == 0) { for (int s2 = 0; s2 < tq; s2++) { float2 ss = subst[s2 * 64 + ch]; h = ss.x * h + ss.y; } }
      else { for (int s2 = 3; s2 > tq; s2--) { float2 ss = subst[s2 * 64 + ch]; h = ss.x * h + ss.y; } }
#pragma unroll
      for (int e = 0; e < 16; e++) {
        const int ee = dir == 0 ? e : 15 - e;
        h = av[e].x * h + av[e].y;
#pragma unroll
        for (int q = 0; q < 16; q++) hsum[q] += (q == ee) ? h : 0.f;
      }
      __syncthreads();
    }
#pragma unroll
    for (int e = 0; e < 16; e++)
      P.mix[(size_t)(rowbase + t0 + tq * 16 + e) * D + 768 + gc] = (half_t)(gyv[e] * hsum[e]);
    return;
  }
  for (int idx = tid; idx < 67 * 8; idx += 256) {
    int row = idx >> 3, c = idx & 7, tt = t0 - 1 + row;
    h8 v = {0, 0, 0, 0, 0, 0, 0, 0};
    if (tt >= 0 && tt < T) v = *(const h8*)(P.rr + (size_t)(rowbase + tt) * 256 + g * 64 + c * 8);
    *(h8*)(raw + row * 64 + c * 8) = v;
  }
  const float cw0 = K.cw[0], cw1 = K.cw[1], cw2 = K.cw[2], cw3 = K.cw[3], cb = K.cw[4];
  __syncthreads();
  {
    float v[19];
#pragma unroll
    for (int e = 0; e < 19; e++) v[e] = (float)raw[(tq * 16 + e) * 64 + ch];
    __syncthreads();
#pragma unroll
    for (int e = 0; e < 16; e++) {
      float xv = cb + cw0 * v[e] + cw1 * v[e + 1] + cw2 * v[e + 2] + cw3 * v[e + 3];
      *(half_t*)(xr16 + swz128(tq * 16 + e, ch)) = (half_t)xv;
    }
  }
  __syncthreads();
#pragma unroll 1
  for (int dir = 0; dir < 2; dir++) {
    {
      f4 acc[2][4];
#pragma unroll
      for (int gt = 0; gt < 2; gt++)
#pragma unroll
        for (int n = 0; n < 4; n++) acc[gt][n] = (f4){0.f, 0.f, 0.f, 0.f};
#pragma unroll
      for (int kk = 0; kk < 2; kk++) {
        int row = wave * 16 + fr;
        h8 af = *(const h8*)(xr16 + row * 128 + (((kk * 4 + fq) ^ ((row >> 1) & 7)) << 4));
#pragma unroll
        for (int gt = 0; gt < 2; gt++)
#pragma unroll
          for (int n = 0; n < 4; n++) {
            int orow = n * 16 + fr;
            h8 bf = *(const h8*)(Wt + (dir * 2 + gt) * 8192 + orow * 128 + (((kk * 4 + fq) ^ ((orow >> 1) & 7)) << 4));
            acc[gt][n] = mfma16(af, bf, acc[gt][n]);
          }
      }
#pragma unroll
      for (int n = 0; n < 4; n++) {
        const float ba = dir == 0 ? K.ba[0][n] : K.ba[1][n], bx = dir == 0 ? K.bx[0][n] : K.bx[1][n], sp8 = dir == 0 ? K.sp8[0][n] : K.sp8[1][n];
#pragma unroll
        for (int j = 0; j < 4; j++) {
          int tl = wave * 16 + fq * 4 + j, c2 = n * 16 + fr;
          float xv = (float)*(const half_t*)(xr16 + swz128(tl, c2));
          float rg = sigmoidf_(acc[0][n][j] + ba), ig = sigmoidf_(acc[1][n][j] + bx);
          float log_a = rg * sp8;
          float x2 = 2.f * log_a;
          float om = -x2 * (1.f + x2 * (0.5f + x2 * (0.16666667f + x2 * (0.041666668f + x2 * (0.008333334f + x2 * 0.0013888889f)))));
          if (x2 < -0.4f) { float a = __expf(log_a); om = 1.f - a * a; }
          ab[tl * 64 + c2] = make_float2(log_a, sqrtf(om) * (ig * xv));
        }
      }
    }
    __syncthreads();
    {
      float A = 1.f, h = 0.f;
#pragma unroll
      for (int e = 0; e < 16; e++) {
        const int ee = dir == 0 ? e : 15 - e;
        const float2 lb = ab[(tq * 16 + ee) * 64 + ch];
        fp16x2 hv; hv[0] = (__fp16)lb.x; hv[1] = (__fp16)lb.y;
        lab[((size_t)dir * TA + rowbase + t0 + tq * 16 + ee) * 256 + gc] = __builtin_bit_cast(unsigned, hv);
        const float a = __expf((float)hv[0]), bt = (float)hv[1];
        h = a * h + bt; A *= a;
      }
      subst[tq * 64 + ch] = make_float2(A, h);
    }
    __syncthreads();
    if (tq == 0) {
      float A = 1.f, h = 0.f;
#pragma unroll
      for (int s2 = 0; s2 < 4; s2++) { float2 ss = subst[(dir == 0 ? s2 : 3 - s2) * 64 + ch]; h = ss.x * h + ss.y; A *= ss.x; }
      P.lsum[((size_t)((b * 2 + dir) * 132 + tile)) * 256 + gc] = make_float2(A, h);
    }
    __syncthreads();
  }
}
DI void lru_carry_item(const Params& P, int it) {
  const int ch = TIDX, dir = it & 1;
  const size_t base = (size_t)it * 132 * 256 + ch;
  float c = 0.f;
#pragma unroll 4
  for (int k = 0; k < 132; k++) {
    int tile = dir == 0 ? k : (k < 4 ? 3 - k : 135 - k);
    float2 s = P.lsum[base + (size_t)tile * 256];
    P.lcar[base + (size_t)tile * 256] = c;
    c = s.x * c + s.y;
  }
}

template <int NROWS>
DI void fft_load(const half_t* src, size_t rs, char* Bt, int rowbytes, int k0) {
  const int tid = TIDX;
  h8 v[NROWS / 16];
#pragma unroll
  for (int i = 0; i < NROWS / 16; i++) { int idx = i * 256 + tid; v[i] = *(const h8*)(src + (size_t)(idx >> 4) * rs + (idx & 15) * 8); }
#pragma unroll
  for (int i = 0; i < NROWS / 16; i++) {
    int idx = i * 256 + tid, kr = idx >> 4, cc = idx & 15, k = k0 + kr;
#pragma unroll
    for (int u = 0; u < 8; u++) { int n = cc * 8 + u; *(half_t*)(Bt + n * rowbytes + ((((k >> 3)) ^ (n & 15)) << 4) + (k & 7) * 2) = v[i][u]; }
  }
}
template <class RF>
DI void fft_mma(const half_t* Dm, int ldD, int nkk, const char* Bt, int rowbytes, f4 (&acc)[4][4], RF arow) {
  const int lane = TIDX & 63, wave = TIDX >> 6, fr = lane & 15, fq = lane >> 4, wc = wave & 1;
#pragma unroll 4
  for (int kk = 0; kk < nkk; kk++) {
    h8 af[4], bf[4];
#pragma unroll
    for (int ms = 0; ms < 4; ms++) af[ms] = *(const h8*)(Dm + (size_t)arow(ms) * ldD + kk * 32 + fq * 8);
#pragma unroll
    for (int ns = 0; ns < 4; ns++) { int n = wc * 64 + ns * 16 + fr; bf[ns] = *(const h8*)(Bt + n * rowbytes + (((kk * 4 + fq) ^ (n & 15)) << 4)); }
#pragma unroll
    for (int ms = 0; ms < 4; ms++)
#pragma unroll
      for (int ns = 0; ns < 4; ns++) acc[ms][ns] = mfma16(af[ms], bf[ns], acc[ms][ns]);
  }
}
DI void zero44(f4 (&acc)[4][4]) {
#pragma unroll
  for (int m = 0; m < 4; m++)
#pragma unroll
    for (int n = 0; n < 4; n++) acc[m][n] = (f4){0.f, 0.f, 0.f, 0.f};
}
DI void fftA_item(const Params& P, int it, char* smem) {
  const int b = it >> 8, bb = (it >> 1) & 127, chh = it & 1;
  const int lane = TIDX & 63, wave = TIDX >> 6, fr = lane & 15, fq = lane >> 4, wr = wave >> 1, wc = wave & 1;
  __syncthreads();
  fft_load<64>(P.QF + (size_t)(TC + b * SEQ + bb) * 512 + chh * 128, (size_t)128 * 512, smem, 256, 0);
  fft_load<64>(P.QF + (size_t)(TC + b * SEQ + bb) * 512 + 256 + chh * 128, (size_t)128 * 512, smem, 256, 64);
  __syncthreads();
  f4 acc[4][4]; zero44(acc);
  fft_mma(P.DA, 128, 4, smem, 256, acc, [&](int ms) { return (ms >> 1) * 64 + wr * 32 + (ms & 1) * 16 + fr; });
#pragma unroll
  for (int ms = 0; ms < 2; ms++)
#pragma unroll
    for (int j = 0; j < 4; j++) {
      const int f1 = wr * 32 + ms * 16 + fq * 4 + j;
      const float2 w = P.tw[(bb * f1) & 8191];
      half_t* d0 = P.GA + ((size_t)(b * 64 + f1) * 256 + bb) * 256 + chh * 128 + wc * 64 + fr;
#pragma unroll
      for (int ns = 0; ns < 4; ns++) {
        float gr = acc[ms][ns][j], gi = acc[ms + 2][ns][j];
        d0[ns * 16] = (half_t)(gr * w.x + gi * w.y);
        d0[(size_t)128 * 256 + ns * 16] = (half_t)(gi * w.x - gr * w.y);
      }
    }
}
DI void fftB_item(const Params& P, int it, char* smem) {
  const int b = it >> 7, f1 = (it >> 1) & 63, chh = it & 1;
  const int lane = TIDX & 63, wave = TIDX >> 6, fr = lane & 15, fq = lane >> 4, wr = wave >> 1, wc = wave & 1;
  __syncthreads();
  fft_load<256>(P.GA + (size_t)(b * 64 + f1) * 256 * 256 + chh * 128, 256, smem, 512, 0);
  __syncthreads();
  f4 acc[4][4]; zero44(acc);
  fft_mma(P.DB, 256, 8, smem, 512, acc, [&](int ms) { return wr * 64 + ms * 16 + fr; });
#pragma unroll
  for (int ms = 0; ms < 4; ms++)
#pragma unroll
    for (int j = 0; j < 4; j++) {
      const int f2 = wr * 64 + ms * 16 + fq * 4 + j;
      half_t* d0 = P.mix + (size_t)(TC + b * SEQ + f1 + 64 * f2) * D + chh * 128 + wc * 64 + fr;
#pragma unroll
      for (int ns = 0; ns < 4; ns++) d0[ns * 16] = (half_t)acc[ms][ns][j];
    }
}
DI void fftC_item(const Params& P, int it, char* smem) {
  const int b = it >> 1, chh = it & 1;
  const int lane = TIDX & 63, wave = TIDX >> 6, fr = lane & 15, fq = lane >> 4, wr = wave >> 1, wc = wave & 1;
#pragma unroll 1
  for (int mh = 0; mh < 2; mh++) {
    f4 acc[4][4]; zero44(acc);
#pragma unroll 1
    for (int part = 0; part < 2; part++) {
      __syncthreads();
      fft_load<256>(P.QF + (size_t)(b * CL) * 512 + part * 256 + chh * 128, 512, smem, 512, 0);
      __syncthreads();
      fft_mma(P.DC + part * 256, 512, 8, smem, 512, acc, [&](int ms) { return mh * 128 + wr * 64 + ms * 16 + fr; });
    }
#pragma unroll
    for (int ms = 0; ms < 4; ms++)
#pragma unroll
      for (int j = 0; j < 4; j++) {
        const int f = mh * 128 + wr * 64 + ms * 16 + fq * 4 + j;
        half_t* d0 = P.mix + (size_t)(b * CL + f) * D + chh * 128 + wc * 64 + fr;
#pragma unroll
        for (int ns = 0; ns < 4; ns++) d0[ns * 16] = (half_t)acc[ms][ns][j];
      }
  }
}

#ifndef MX
#define MX 15
#endif
DI void mix_phase(const Params& P, int l, char* smem, int* s_item, int qi) {
  const int nL = 0, nA = 0, nC = l == 0 ? 64 : 0, nFA = 2048, nFC = l == 0 ? 16 : 0;
  const int total = nL + nA + nC + nFA + nFC;
  {
    const int g = blockIdx.x & 3;
    lru_load_w(P, l, g, smem);
    LruK K; lru_consts(P, l, g, K);
    for (int u = blockIdx.x >> 2; u < NB_ * 132; u += gridDim.x >> 2) lru_tile(P, l, u / 132, u % 132, g, smem, false, K);
  }
  int stage = 0;
  for (;;) {
    __syncthreads();
    if (TIDX == 0) *s_item = stage == 0 ? atomicAdd(&P.qctr[8 + qi * 8 + (blockIdx.x & 7)], 1) : atomicAdd(&P.qctr[qi], 1);
    __syncthreads();
    int it = *s_item;
    int kind = -1, b = 0, head = 0, row0 = 0, nk = 0;
    if (stage == 0) {
      if (it >= 256) { stage = 1; continue; }
      const int pair = (blockIdx.x & 7) + 8 * (it >> 6);
      b = pair >> 2; head = pair & 3; row0 = TC + b * SEQ + (it & 63) * 128; nk = KV; kind = 0;
    } else {
      if (it >= total) break;
      if (it < nC) { b = it >> 3; head = (it >> 1) & 3; row0 = b * CL + (it & 1) * 128; nk = CL; kind = 0; }
      else if (it < nC + nFA) { kind = 1; it -= nC; }
      else { kind = 2; it -= nC + nFA; }
    }
    if (kind == 0) attn_item(P, l, b, head, row0, nk, smem);
    else if (kind == 1) fftA_item(P, it, smem);
    else fftC_item(P, it, smem);
  }
}

DI void grid_barrier(unsigned* ctr, unsigned target) {
  asm volatile("s_waitcnt vmcnt(0)" ::: "memory");
  __syncthreads();
  if (threadIdx.x == 0) {
    __builtin_amdgcn_fence(__ATOMIC_RELEASE, "agent");
    asm volatile("s_waitcnt vmcnt(0)" ::: "memory");
    __hip_atomic_fetch_add(ctr, 1u, __ATOMIC_RELAXED, __HIP_MEMORY_SCOPE_AGENT);
    while (__hip_atomic_load(ctr, __ATOMIC_RELAXED, __HIP_MEMORY_SCOPE_AGENT) < target) __builtin_amdgcn_s_sleep(1);
    __builtin_amdgcn_fence(__ATOMIC_ACQUIRE, "agent");
    asm volatile("s_waitcnt vmcnt(0)" ::: "memory");
  }
  __syncthreads();
}
__global__ void __launch_bounds__(256, 1) fwd_megakernel(Params Pin) {
  Params P = Pin; bind_ws(P);
  __shared__ __attribute__((aligned(16))) char smem[147456 + 8192];
  __shared__ int tb[33];
  __shared__ int s_item;
  cg::grid_group grid = cg::this_grid();
  unsigned* bar = (unsigned*)(P.ws + O_bar); unsigned bk = 0;
#ifndef PH
#define PH 0xFFFF
#endif
#if PH & 1
  phase0(P, smem);
#endif
  grid.sync();
  for (int l = 0; l < 2; l++) {
#if PH & 2
    row1_phase(P, l == 0 ? -1 : 0, l, 0);
#endif
    grid_barrier(bar, (++bk) * gridDim.x);
#if PH & 4
    gemm_in_phase(P, l, smem);
#ifdef DUP_GEMM
    grid_barrier(bar, (++bk) * gridDim.x);
    gemm_in_phase(P, l, smem);
#endif
#endif
    grid_barrier(bar, (++bk) * gridDim.x);
#if PH & 8
    mix_phase(P, l, smem, &s_item, l);
#ifdef DUP_MIX
    grid_barrier(bar, (++bk) * gridDim.x);
    mix_phase(P, l, smem, &s_item, 2 + l);
#endif
#endif
    grid_barrier(bar, (++bk) * gridDim.x);
#if PH & 16
    if (blockIdx.x >= gridDim.x - 16) lru_carry_item(P, gridDim.x - 1 - blockIdx.x);
    for (int it = blockIdx.x; it < 1024; it += gridDim.x) fftB_item(P, it, smem);
#endif
    grid_barrier(bar, (++bk) * gridDim.x);
#if PH & 512
    {
      const int g = blockIdx.x & 3;
      LruK K{};
      for (int u = blockIdx.x >> 2; u < NB_ * 132; u += gridDim.x >> 2) lru_tile(P, l, u / 132, u % 132, g, smem, true, K);
    }
#endif
    grid_barrier(bar, (++bk) * gridDim.x);
#if PH & 32
    gemm_out_phase(P, l, smem);
#endif
    grid_barrier(bar, (++bk) * gridDim.x);
#if PH & 64
    row2_phase(P, l, l == 0 ? 0 : TC, smem);
#endif
    grid_barrier(bar, (++bk) * gridDim.x);
#if PH & 128
    moe_e1_phase(P, l, smem, tb);
#ifdef DUP_GEMM
    grid_barrier(bar, (++bk) * gridDim.x);
    moe_e1_phase(P, l, smem, tb);
#endif
#endif
    grid_barrier(bar, (++bk) * gridDim.x);
#if PH & 256
    moe_e2_phase(P, l, smem, tb);
#ifdef DUP_GEMM
    grid_barrier(bar, (++bk) * gridDim.x);
    moe_e2_phase(P, l, smem, tb);
#endif
#endif
    grid_barrier(bar, (++bk) * gridDim.x);
  }
#if PH & 2
  row1_phase(P, 1, -1, TC);
#endif
}

extern "C" void kernel_launch(void* const* d_in, const int* in_sizes, int n_in, void* d_out, int out_size, void* d_ws, size_t ws_size,
                              hipStream_t stream) {
  static int grid_blocks = 0;
  if (!grid_blocks) {
    int dev = 0, cus = 0, per_cu = 0;
    hipGetDevice(&dev);
    hipDeviceGetAttribute(&cus, hipDeviceAttributeMultiprocessorCount, dev);
    hipOccupancyMaxActiveBlocksPerMultiprocessor(&per_cu, fwd_megakernel, 256, 0);
    if (per_cu > 2) per_cu = 2;
    grid_blocks = cus * per_cu;
    if (grid_blocks > 256) grid_blocks = 256;
  }
  if (grid_blocks != 256) { fprintf(stderr, "need 256 co-resident blocks, have %d\n", grid_blocks); return; }
  Params p{};
  const float** pin = (const float**)&p;
  for (int i = 0; i < 31; i++) pin[i] = (const float*)d_in[i];
  p.out = (float*)d_out;
  p.ws = (char*)d_ws;
  if (WS_NEED > ws_size) { fprintf(stderr, "workspace too small: need %zu have %zu\n", (size_t)WS_NEED, ws_size); return; }
  hipMemsetAsync((char*)d_ws + O_bar, 0, 256, stream);
  void* args[] = {&p};
  hipError_t e = hipLaunchCooperativeKernel((void*)fwd_megakernel, dim3(grid_blocks), dim3(256), args, 0, stream);
  if (e != hipSuccess) fprintf(stderr, "cooperative launch failed: %s (grid %d)\n", hipGetErrorString(e), grid_blocks);
}
```

```cpp
#include <hip/hip_runtime.h>
#include <hip/hip_cooperative_groups.h>
#include <cstdio>
namespace cg = cooperative_groups;

typedef _Float16 half_t;
typedef _Float16 h8 __attribute__((ext_vector_type(8)));
typedef _Float16 h4 __attribute__((ext_vector_type(4)));
typedef __fp16 fp16x2 __attribute__((ext_vector_type(2)));
typedef unsigned u4 __attribute__((ext_vector_type(4)));
typedef float f4 __attribute__((ext_vector_type(4)));
typedef float f16v __attribute__((ext_vector_type(16)));
#define DI __device__ __forceinline__
__device__ __forceinline__ int tid_opaque() { int t = threadIdx.x; asm volatile("" : "+v"(t)); return t; }
#define TIDX tid_opaque()

constexpr int D = 1024, NB_ = 8, SEQ = 8192, CL = 256;
constexpr int TC = NB_ * CL;
constexpr int TX = NB_ * SEQ;
constexpr int TA = TC + TX;
constexpr int KV = CL + SEQ;
constexpr int NIN = 2560;
constexpr int LCAP = 2 * TA;
constexpr float EPS = 1e-6f;

struct Params {
  const float *x, *c, *ctx, *c_ctx, *w_mod, *b_mod, *norm1_g, *norm2_g, *w_in, *q_norm_g, *k_norm_g, *lq1, *lk1, *lq2, *lk2,
      *subln_g, *conv_w, *conv_b, *gate_a_w, *gate_a_b, *gate_x_w, *gate_x_b, *lru_lambda, *w_out, *w_group, *b_group,
      *w_router, *b_router, *w1, *w3, *w2;
  float* out; char* ws;
  half_t *WtIn, *WtOut, *Wt1, *Wt3, *Wt2;
  float* mod; float2* rope; float2* tw; half_t *DA, *DB, *DC; float* consts; int* cnt; int* qctr; float* tokW; int* list; float* listW;
  float* xcbuf; half_t* WrH;
  half_t *hx, *mix, *q, *kall, *vT, *QF, *gy, *rr; float2* lsum; float* lcar; half_t* GA; half_t *H, *yA;
};


constexpr size_t al256(size_t x) { return (x + 255) & ~(size_t)255; }
constexpr size_t O_WtIn = 0;
constexpr size_t O_WtOut = O_WtIn + al256((size_t)2 * NIN * 1024 * 2);
constexpr size_t O_Wt1 = O_WtOut + al256((size_t)2 * 1024 * 1024 * 2);
constexpr size_t O_Wt3 = O_Wt1 + al256((size_t)64 * 524288 * 2);
constexpr size_t O_Wt2 = O_Wt3 + al256((size_t)64 * 524288 * 2);
constexpr size_t O_mod = O_Wt2 + al256((size_t)64 * 524288 * 2);
constexpr size_t O_rope = O_mod + al256((size_t)2 * 9 * 6144 * 4);
constexpr size_t O_tw = O_rope + al256(128 * 16 * 8);
constexpr size_t O_DA = O_tw + al256(8192 * 8);
constexpr size_t O_DB = O_DA + al256(16384 * 2);
constexpr size_t O_DC = O_DB + al256(32768 * 2);
constexpr size_t O_consts = O_DC + al256(131072 * 2);
constexpr size_t O_cnt = O_consts + 256;
constexpr size_t O_qctr = O_cnt + 256;
constexpr size_t O_bar = O_qctr + 256;
constexpr size_t O_tokW = O_bar + 1024;
constexpr size_t O_list = O_tokW + al256((size_t)2 * TA * 4);
constexpr size_t O_listW = O_list + al256((size_t)32 * LCAP * 4);
constexpr size_t O_xcbuf = O_listW + al256((size_t)32 * LCAP * 4);
constexpr size_t O_WrT = O_xcbuf + al256((size_t)TC * D * 4);
constexpr size_t O_hx = O_WrT + al256((size_t)2 * 2 * 48 * 1024 * 2);
constexpr size_t O_mix = O_hx + al256((size_t)TA * D * 2);
constexpr size_t O_regB = O_mix + al256((size_t)TA * D * 2);
constexpr size_t O_q = O_regB;
constexpr size_t O_kall = O_q + al256((size_t)TA * 512 * 2);
constexpr size_t O_vT = O_kall + al256((size_t)NB_ * KV * 512 * 2);
constexpr size_t O_QF = O_vT + al256((size_t)NB_ * 4 * 128 * KV * 2);
constexpr size_t O_gy = O_QF + al256((size_t)TA * 512 * 2);
constexpr size_t O_rr = O_gy + al256((size_t)TA * 256 * 2);
constexpr size_t O_lsum = O_rr + al256((size_t)TA * 256 * 2);
constexpr size_t O_lcar = O_lsum + al256((size_t)16 * 132 * 256 * 8);
constexpr size_t O_GA = O_lcar + al256((size_t)16 * 132 * 256 * 4);
constexpr size_t O_mixer_end = O_GA + al256((size_t)NB_ * 64 * 256 * 256 * 2);
constexpr size_t O_H = O_regB;
constexpr size_t O_yA = O_H + al256((size_t)(2 * TA + 32 * 256) * 512 * 2);
constexpr size_t O_moe_end = O_yA + al256((size_t)2 * TA * D * 2);
constexpr size_t WS_NEED = O_mixer_end > O_moe_end ? O_mixer_end : O_moe_end;
DI void bind_ws(Params& P) {
  char* w = P.ws;
  P.WtIn = (half_t*)(w + O_WtIn); P.WtOut = (half_t*)(w + O_WtOut); P.Wt1 = (half_t*)(w + O_Wt1); P.Wt3 = (half_t*)(w + O_Wt3); P.Wt2 = (half_t*)(w + O_Wt2);
  P.mod = (float*)(w + O_mod); P.rope = (float2*)(w + O_rope); P.tw = (float2*)(w + O_tw); P.DA = (half_t*)(w + O_DA); P.DB = (half_t*)(w + O_DB); P.DC = (half_t*)(w + O_DC);
  P.consts = (float*)(w + O_consts); P.cnt = (int*)(w + O_cnt); P.qctr = (int*)(w + O_qctr); P.tokW = (float*)(w + O_tokW); P.list = (int*)(w + O_list); P.listW = (float*)(w + O_listW);
  P.xcbuf = (float*)(w + O_xcbuf); P.WrH = (half_t*)(w + O_WrT); P.hx = (half_t*)(w + O_hx); P.mix = (half_t*)(w + O_mix);
  P.q = (half_t*)(w + O_q); P.kall = (half_t*)(w + O_kall); P.vT = (half_t*)(w + O_vT); P.QF = (half_t*)(w + O_QF); P.gy = (half_t*)(w + O_gy); P.rr = (half_t*)(w + O_rr);
  P.lsum = (float2*)(w + O_lsum); P.lcar = (float*)(w + O_lcar); P.GA = (half_t*)(w + O_GA); P.H = (half_t*)(w + O_H); P.yA = (half_t*)(w + O_yA);
}
DI float shx(float v, int o) { int ln = TIDX & 63; return __builtin_bit_cast(float, __builtin_amdgcn_ds_bpermute((ln ^ o) << 2, __builtin_bit_cast(int, v))); }
DI float shi(float v, int idx) { return __builtin_bit_cast(float, __builtin_amdgcn_ds_bpermute(idx << 2, __builtin_bit_cast(int, v))); }
DI float wave_sum(float v) {
#pragma unroll
  for (int o = 32; o; o >>= 1) v += shx(v, o);
  return v;
}
DI void glds16(const void* g, void* l) {
  __builtin_amdgcn_global_load_lds((const unsigned*)g, (unsigned*)l, 16, 0, 0);
}
DI void wait_vm0() { asm volatile("s_waitcnt vmcnt(0)" ::: "memory"); }
DI f4 mfma16(h8 a, h8 b, f4 c) { return __builtin_amdgcn_mfma_f32_16x16x32_f16(a, b, c, 0, 0, 0); }
DI f16v mfma32(h8 a, h8 b, f16v c) { return __builtin_amdgcn_mfma_f32_32x32x16_f16(a, b, c, 0, 0, 0); }
DI unsigned pk2(float a, float b) { fp16x2 r = __builtin_amdgcn_cvt_pkrtz(a, b); return __builtin_bit_cast(unsigned, r); }
DI float sigmoidf_(float x) { return 1.f / (1.f + __expf(-x)); }
DI float gelu_tanh(float x) {
  float u = 0.7978845608028654f * (x + 0.044715f * x * x * x);
  float e = __expf(2.f * u);
  float t = 1.f - 2.f / (e + 1.f);
  return 0.5f * x * (1.f + t);
}
DI int row_mod(int r) { return r < TC ? 8 : ((r - TC) >> 13); }

DI void transpose_tile4(const float* src, int lds_, half_t* dst, int ldd, float* tile) {
  const int tid = TIDX;
  {
    const int k0 = tid >> 6, c4 = tid & 63;
    const float* sp = src + (size_t)k0 * lds_ + c4 * 4;
    float* tp = tile + (c4 >> 4) * 4352 + k0 * 68 + (c4 & 15) * 4;
#pragma unroll
    for (int i = 0; i < 16; i++) *(float4*)(tp + i * 4 * 68) = *(const float4*)(sp + (size_t)i * 4 * lds_);
  }
  __syncthreads();
#pragma unroll
  for (int i = 0; i < 8; i++) {
    int idx = i * 256 + tid, j = idx >> 9, r = idx & 511, kc = r >> 6, n = r & 63;
    const float* t = tile + j * 4352 + kc * 8 * 68 + n;
    h8 o;
#pragma unroll
    for (int u = 0; u < 8; u++) o[u] = (half_t)t[u * 68];
    *(h8*)(dst + (size_t)(j * 64 + n) * ldd + kc * 8) = o;
  }
  __syncthreads();
}

DI void phase0(const Params& P, char* smem) {
  float* tile = (float*)smem;
  const int tid = TIDX;
  constexpr int NT = 6528, NF = 128, NM = 192, NX = 6;
  for (int t = blockIdx.x; t < NT + NF + NM + NX; t += gridDim.x) {
    if (t < NT) {
      const float* src; half_t* dst; int lds_, ldd;
      if (t < 256) {
        int l = t / 128, r = t % 128, kt = r / 8, nt = (r % 8) * 4;
        src = P.w_in + (size_t)l * 1024 * 2304 + (size_t)kt * 64 * 2304 + 256 + nt * 64; lds_ = 2304;
        dst = P.WtIn + (size_t)l * NIN * 1024 + (size_t)(512 + nt * 64) * 1024 + kt * 64; ldd = 1024;
      } else if (t < 384) {
        int u = t - 256, l = u / 64, r = u % 64, kt = r / 4, nt = (r % 4) * 4;
        src = P.w_out + (size_t)l * 1048576 + (size_t)kt * 64 * 1024 + nt * 64; lds_ = 1024;
        dst = P.WtOut + (size_t)l * 1048576 + (size_t)nt * 64 * 1024 + kt * 64; ldd = 1024;
      } else if (t < 384 + 4096) {
        int u = t - 384; const float* w = P.w1; half_t* o = P.Wt1;
        if (u >= 2048) { u -= 2048; w = P.w3; o = P.Wt3; }
        int le = u / 32, r = u % 32, kt = r / 2, nt = (r % 2) * 4;
        src = w + (size_t)le * 524288 + (size_t)kt * 64 * 512 + nt * 64; lds_ = 512;
        dst = o + (size_t)le * 524288 + (size_t)nt * 64 * 1024 + kt * 64; ldd = 1024;
      } else {
        int u = t - 384 - 4096, le = u / 32, r = u % 32, kt = r / 4, nt = (r % 4) * 4;
        src = P.w2 + (size_t)le * 524288 + (size_t)kt * 64 * 1024 + nt * 64; lds_ = 1024;
        dst = P.Wt2 + (size_t)le * 524288 + (size_t)nt * 64 * 512 + kt * 64; ldd = 512;
      }
      transpose_tile4(src, lds_, dst, ldd, tile);
    } else if (t < NT + NF) {
      int f = t - NT, l = f / 64, r = f % 64, kt = r / 4, g = r % 4;
      float* cst = tile + 64 * 65; float* snt = cst + 64;
      const float* src = P.w_in + (size_t)l * 1024 * 2304 + (size_t)kt * 64 * 2304 + g * 64;
      { int n = tid & 63, kq = tid >> 6;
        for (int i = 0; i < 16; i++) { int k = i * 4 + kq; tile[k * 65 + n] = src[(size_t)k * 2304 + n]; } }
      if (tid < 64) { float s, c; sincospif((float)tid / 32.f, &s, &c); cst[tid] = c; snt[tid] = s; }
      __syncthreads();
      int k = tid & 63, jq = tid >> 6;
      half_t* o = P.WtIn + (size_t)l * NIN * 1024 + kt * 64 + k;
      for (int jj = 0; jj < 16; jj++) {
        int j = jq * 16 + jj; float ac = 0.f, as = 0.f;
        for (int c = 0; c < 64; c++) { float v = tile[k * 65 + c]; int idx = (c * j) & 63; ac += v * cst[idx]; as += v * snt[idx]; }
        o[(size_t)(g * 64 + j) * 1024] = (half_t)(ac * 0.125f);
        o[(size_t)(256 + g * 64 + j) * 1024] = (half_t)(-as * 0.125f);
      }
      __syncthreads();
    } else if (t < NT + NF + NM) {
      int mi = t - NT - NF, l = mi / 96, col0 = (mi % 96) * 64;
      float* scond = tile; float* red = tile + 9216;
      for (int idx = tid; idx < 9216; idx += 256) {
        int n = idx >> 10, k = idx & 1023; float v = n < 8 ? P.c[n * 1024 + k] : P.c_ctx[k];
        scond[idx] = v / (1.f + expf(-v));
      }
      __syncthreads();
      int col = tid & 63, kq = tid >> 6; float acc[9];
#pragma unroll
      for (int n = 0; n < 9; n++) acc[n] = 0.f;
      const float* w = P.w_mod + ((size_t)l * 1024 + kq * 256) * 6144 + col0 + col;
#pragma unroll 16
      for (int k = 0; k < 256; k++) {
        float wv = w[(size_t)k * 6144];
#pragma unroll
        for (int n = 0; n < 9; n++) acc[n] += scond[n * 1024 + kq * 256 + k] * wv;
      }
#pragma unroll
      for (int n = 0; n < 9; n++) red[(kq * 9 + n) * 64 + col] = acc[n];
      __syncthreads();
      for (int idx = tid; idx < 576; idx += 256) {
        int n = idx / 64, cc = idx % 64;
        float s = red[(0 * 9 + n) * 64 + cc] + red[(1 * 9 + n) * 64 + cc] + red[(2 * 9 + n) * 64 + cc] + red[(3 * 9 + n) * 64 + cc];
        P.mod[(size_t)(l * 9 + n) * 6144 + col0 + cc] = s + P.b_mod[l * 6144 + col0 + cc];
      }
      __syncthreads();
    } else {
      int m = t - NT - NF - NM;
      if (m == 0) {
        for (int idx = tid; idx < 128 * 16; idx += 256) {
          int pos = idx >> 4, i = idx & 15; float f = powf(10000.f, -(float)i / 16.f); float ang = (float)pos * f;
          float s, c; sincosf(ang, &s, &c); P.rope[idx] = make_float2(c, s);
        }
      } else if (m == 1) {
        for (int j = tid; j < 8192; j += 256) { float s, c; sincospif((float)j / 4096.f, &s, &c); P.tw[j] = make_float2(c, s); }
      } else if (m == 2) {
        for (int idx = tid; idx < 16384; idx += 256) {
          int mm = idx >> 7, k = idx & 127, part = mm >> 6, f1 = mm & 63, pp = k >> 6, a = k & 63;
          float s, c; sincospif((float)((a * f1) & 63) / 32.f, &s, &c);
          float v = part == 0 ? (pp == 0 ? c : s) : (pp == 0 ? -s : c);
          P.DA[idx] = (half_t)(v * 0.125f);
        }
      } else if (m == 3) {
        for (int idx = tid; idx < 32768; idx += 256) {
          int mm = idx >> 8, k = idx & 255, part = k >> 7, bb = k & 127;
          float s, c; sincospif((float)((bb * mm) & 127) / 64.f, &s, &c);
          P.DB[idx] = (half_t)((part == 0 ? c : s) * 0.08838834764831845f);
        }
      } else if (m == 4) {
        for (int idx = tid; idx < 131072; idx += 256) {
          int mm = idx >> 9, k = idx & 511, part = k >> 8, tt = k & 255;
          float s, c; sincospif((float)((tt * mm) & 255) / 128.f, &s, &c);
          P.DC[idx] = (half_t)((part == 0 ? c : s) * 0.0625f);
        }
      } else {
        for (int idx = tid; idx < 2 * 48 * 1024; idx += 256) {
          int l = idx / 49152, r = idx % 49152, col = r >> 10, k = r & 1023;
          float w = col < 4 ? P.w_group[((size_t)l * 1024 + k) * 4 + col] : (col < 36 ? P.w_router[((size_t)l * 1024 + k) * 32 + col - 4] : 0.f);
          half_t hi = (half_t)w, lo = (half_t)(w - (float)hi);
          P.WrH[(size_t)(l * 2) * 49152 + r] = hi; P.WrH[(size_t)(l * 2 + 1) * 49152 + r] = lo;
        }
        if (tid < 2) {
          int l = tid; float s1 = 0.f, s2 = 0.f, mq = 0.f, mk = 0.f;
          for (int i = 0; i < 64; i++) {
            s1 += P.lq1[l * 64 + i] * P.lk1[l * 64 + i]; s2 += P.lq2[l * 64 + i] * P.lk2[l * 64 + i];
            mq = fmaxf(mq, fabsf(P.q_norm_g[l * 64 + i])); mk = fmaxf(mk, fabsf(P.k_norm_g[l * 64 + i]));
          }
          float lam_init = 0.8f - 0.6f * expf(-0.3f * (float)l);
          P.consts[l * 4 + 0] = expf(s1) - expf(s2) + lam_init;
          P.consts[l * 4 + 1] = 8.f * mq * mk * 1.4426950408889634f * 1.002f - 15.f;
          P.consts[l * 4 + 2] = lam_init;
        }
        if (tid < 64) P.cnt[tid] = 0;
        if (tid < 64) P.qctr[tid] = 0;
      }
    }
  }
}

DI void row1_phase(const Params& P, int combine_l, int norm_l, int r_begin) {
  const int lane = TIDX & 63, gw = blockIdx.x * 4 + (TIDX >> 6), nw = gridDim.x * 4;
  auto load_row = [&](int r, float4 (&xv)[4], h4 (&ya)[4], h4 (&yb)[4]) {
    if (combine_l < 0) {
      const float* src = r < TC ? P.ctx + (size_t)r * D : P.x + (size_t)(r - TC) * D;
#pragma unroll
      for (int i = 0; i < 4; i++) xv[i] = *(const float4*)(src + i * 256 + lane * 4);
    } else {
      const float* xm = r < TC ? P.xcbuf + (size_t)r * D : P.out + (size_t)(r - TC) * D;
      const half_t* y0 = P.yA + (size_t)(2 * r) * D; const half_t* y1 = y0 + D;
#pragma unroll
      for (int i = 0; i < 4; i++) { int c = i * 256 + lane * 4; xv[i] = *(const float4*)(xm + c); ya[i] = *(const h4*)(y0 + c); yb[i] = *(const h4*)(y1 + c); }
    }
  };
  auto process = [&](int r, float4 (&xv)[4], h4 (&ya)[4], h4 (&yb)[4]) {
    const int n = row_mod(r);
    if (combine_l >= 0) {
      float* xm = r < TC ? P.xcbuf + (size_t)r * D : P.out + (size_t)(r - TC) * D;
      const float* g2 = P.mod + (size_t)(combine_l * 9 + n) * 6144 + 5 * 1024;
#pragma unroll
      for (int i = 0; i < 4; i++) {
        int c = i * 256 + lane * 4;
        float4 g = *(const float4*)(g2 + c); float4 t = xv[i];
        t.x += g.x * ((float)ya[i][0] + (float)yb[i][0]); t.y += g.y * ((float)ya[i][1] + (float)yb[i][1]);
        t.z += g.z * ((float)ya[i][2] + (float)yb[i][2]); t.w += g.w * ((float)ya[i][3] + (float)yb[i][3]);
        *(float4*)(xm + c) = t; xv[i] = t;
      }
    }
    if (norm_l >= 0) {
      float ss = 0.f;
#pragma unroll
      for (int i = 0; i < 4; i++) ss += xv[i].x * xv[i].x + xv[i].y * xv[i].y + xv[i].z * xv[i].z + xv[i].w * xv[i].w;
      ss = wave_sum(ss);
      const float rstd = rsqrtf(ss * (1.f / 1024.f) + EPS);
      const float* g = P.norm1_g + norm_l * 1024;
      const float* sh = P.mod + (size_t)(norm_l * 9 + n) * 6144; const float* sc = sh + 1024;
#pragma unroll
      for (int i = 0; i < 4; i++) {
        int c = i * 256 + lane * 4;
        float4 gg = *(const float4*)(g + c), s1 = *(const float4*)(sc + c), s0 = *(const float4*)(sh + c);
        h4 o;
        o[0] = (half_t)(xv[i].x * rstd * gg.x * (1.f + s1.x) + s0.x); o[1] = (half_t)(xv[i].y * rstd * gg.y * (1.f + s1.y) + s0.y);
        o[2] = (half_t)(xv[i].z * rstd * gg.z * (1.f + s1.z) + s0.z); o[3] = (half_t)(xv[i].w * rstd * gg.w * (1.f + s1.w) + s0.w);
        *(h4*)(P.hx + (size_t)r * D + c) = o;
      }
    }
  };
#pragma unroll 1
  for (int r = r_begin + gw; r < TA; r += 4 * nw) {
    float4 x0[4], x1[4], x2[4], x3[4]; h4 a0[4], b0[4], a1[4], b1[4], a2[4], b2[4], a3[4], b3[4];
    const int r1 = r + nw, r2 = r + 2 * nw, r3 = r + 3 * nw;
    load_row(r, x0, a0, b0);
    if (r1 < TA) load_row(r1, x1, a1, b1);
    if (r2 < TA) load_row(r2, x2, a2, b2);
    if (r3 < TA) load_row(r3, x3, a3, b3);
    process(r, x0, a0, b0);
    if (r1 < TA) process(r1, x1, a1, b1);
    if (r2 < TA) process(r2, x2, a2, b2);
    if (r3 < TA) process(r3, x3, a3, b3);
  }
}

DI void row2_phase(const Params& P, int l, int r_begin, char* smem) {
  const int tid = TIDX, lane = tid & 63, wave = tid >> 6, fr = lane & 15, fq = lane >> 4;
  float* lg = (float*)smem + wave * 16 * 48;
  const half_t* Whi = P.WrH + (size_t)(l * 2) * 49152; const half_t* Wlo = Whi + 49152;
  const int ngroups = (TA - r_begin) >> 4, gw = blockIdx.x * 4 + wave, nw = gridDim.x * 4;
  const float* gam = P.norm2_g + l * 1024;
#pragma unroll 1
  for (int grp = gw; grp < ngroups; grp += nw) {
    const int r0 = r_begin + grp * 16, row = r0 + fr, n = row_mod(r0);
    const float* xm = (row < TC ? P.xcbuf + (size_t)row * D : P.out + (size_t)(row - TC) * D) + fq * 8;
    float ss = 0.f;
#pragma unroll 16
    for (int kk = 0; kk < 32; kk++) {
      const float4 a = *(const float4*)(xm + kk * 32), b = *(const float4*)(xm + kk * 32 + 4);
      ss += a.x * a.x + a.y * a.y + a.z * a.z + a.w * a.w + b.x * b.x + b.y * b.y + b.z * b.z + b.w * b.w;
    }
    ss += shx(ss, 16); ss += shx(ss, 32);
    const float rstd = rsqrtf(ss * (1.f / 1024.f) + EPS);
    const float* sh = P.mod + (size_t)(l * 9 + n) * 6144 + 3 * 1024 + fq * 8; const float* sc = sh + 1024;
    f4 acc[3];
#pragma unroll
    for (int i = 0; i < 3; i++) acc[i] = (f4){0.f, 0.f, 0.f, 0.f};
    half_t* hxo = P.hx + (size_t)row * D + fq * 8;
#pragma unroll 4
    for (int kk = 0; kk < 32; kk++) {
      const int k0 = kk * 32;
      float x[8], g[8], s1[8], s0[8];
      *(float4*)&x[0] = *(const float4*)(xm + k0); *(float4*)&x[4] = *(const float4*)(xm + k0 + 4);
      *(float4*)&g[0] = *(const float4*)(gam + fq * 8 + k0); *(float4*)&g[4] = *(const float4*)(gam + fq * 8 + k0 + 4);
      *(float4*)&s1[0] = *(const float4*)(sc + k0); *(float4*)&s1[4] = *(const float4*)(sc + k0 + 4);
      *(float4*)&s0[0] = *(const float4*)(sh + k0); *(float4*)&s0[4] = *(const float4*)(sh + k0 + 4);
      h8 hi, lo;
#pragma unroll
      for (int i = 0; i < 8; i++) {
        float v = x[i] * rstd * g[i] * (1.f + s1[i]) + s0[i];
        hi[i] = (half_t)v; lo[i] = (half_t)(v - (float)hi[i]);
      }
      *(h8*)(hxo + k0) = hi;
#pragma unroll
      for (int n3 = 0; n3 < 3; n3++) {
        h8 bh = *(const h8*)(Whi + (size_t)(n3 * 16 + fr) * 1024 + k0 + fq * 8);
        h8 bl = *(const h8*)(Wlo + (size_t)(n3 * 16 + fr) * 1024 + k0 + fq * 8);
        acc[n3] = mfma16(hi, bh, acc[n3]); acc[n3] = mfma16(lo, bh, acc[n3]); acc[n3] = mfma16(hi, bl, acc[n3]);
      }
    }
    __builtin_amdgcn_wave_barrier();
#pragma unroll
    for (int n3 = 0; n3 < 3; n3++)
#pragma unroll
      for (int j = 0; j < 4; j++) lg[(fq * 4 + j) * 48 + n3 * 16 + fr] = acc[n3][j];
    __builtin_amdgcn_wave_barrier();
    if (lane < 16) {
      const int r = r0 + lane;
      const float* L = lg + lane * 48;
      float gl[4]; int gi = 0;
#pragma unroll
      for (int j = 0; j < 4; j++) gl[j] = L[j] + P.b_group[l * 4 + j];
      float gm = gl[0];
#pragma unroll
      for (int j = 1; j < 4; j++) if (gl[j] > gm) { gm = gl[j]; gi = j; }
      float gs = 0.f;
#pragma unroll
      for (int j = 0; j < 4; j++) gs += expf(gl[j] - gm);
      const float pg = 1.f / gs;
      float el[8];
#pragma unroll
      for (int j = 0; j < 8; j++) el[j] = L[4 + gi * 8 + j] + P.b_router[l * 32 + gi * 8 + j];
      int i0 = 0; float v0 = el[0];
#pragma unroll
      for (int j = 1; j < 8; j++) if (el[j] > v0) { v0 = el[j]; i0 = j; }
      int i1 = -1; float v1 = -3.0e38f;
#pragma unroll
      for (int j = 0; j < 8; j++) if (j != i0 && el[j] > v1) { v1 = el[j]; i1 = j; }
      const float ex = expf(v1 - v0);
      const float w0 = pg / (1.f + ex), w1 = pg * ex / (1.f + ex);
      const int e0 = gi * 8 + i0, e1 = gi * 8 + i1;
      int p0 = atomicAdd(&P.cnt[l * 32 + e0], 1); P.list[(size_t)e0 * LCAP + p0] = 2 * r; P.listW[(size_t)e0 * LCAP + p0] = w0;
      int p1 = atomicAdd(&P.cnt[l * 32 + e1], 1); P.list[(size_t)e1 * LCAP + p1] = 2 * r + 1; P.listW[(size_t)e1 * LCAP + p1] = w1;
    }
    __builtin_amdgcn_wave_barrier();
  }
}

DI h8 lds128(unsigned a) { h8 r; asm volatile("ds_read_b128 %0, %1" : "=v"(r) : "v"(a)); return r; }
DI void tie(h8& x) { asm volatile("" : "+v"(x)); }
DI unsigned lds_addr(const void* p) { return (unsigned)(size_t)p; }
#define WAIT_LGKM(n) asm volatile("s_waitcnt lgkmcnt(" #n ")" ::: "memory")
DI void raw_barrier() { asm volatile("" ::: "memory"); __builtin_amdgcn_s_barrier(); asm volatile("" ::: "memory"); }
DI void slot_rc(int i, int& row, int& coff) { int s = i * 256 + TIDX; row = s >> 3; coff = ((s & 7) ^ ((row >> 1) & 7)) * 8; }

template <class AF, class BF>
DI void gemm_prologue(AF aptr, BF bptr, int nk, char* smem) {
  const int tid = TIDX;
#pragma unroll
  for (int st = 0; st < 2; st++) {
    if (st < nk) {
      char* d = smem + st * 49152 + tid * 16;
#pragma unroll
      for (int i = 0; i < 8; i++) glds16(aptr(i) + st * 64, d + i * 4096);
#pragma unroll
      for (int i = 0; i < 4; i++) glds16(bptr(i) + st * 64, d + 32768 + i * 4096);
    }
  }
}
template <bool PRE = false, class AF, class BF>
DI void gemm256(AF aptr, BF bptr, int nk, char* smem, f4 (&acc)[8][4]) {
  const int tid = TIDX, lane = tid & 63, wave = tid >> 6, fr = lane & 15, fq = lane >> 4, wr = wave >> 1, wc = wave & 1;
#pragma unroll
  for (int m = 0; m < 8; m++)
#pragma unroll
    for (int n = 0; n < 4; n++) acc[m][n] = (f4){0.f, 0.f, 0.f, 0.f};
  auto issue = [&](int kt, int st) {
    char* d = smem + st * 49152 + tid * 16;
#pragma unroll
    for (int i = 0; i < 8; i++) glds16(aptr(i) + kt * 64, d + i * 4096);
#pragma unroll
    for (int i = 0; i < 4; i++) glds16(bptr(i) + kt * 64, d + 32768 + i * 4096);
  };
  const unsigned sw = (unsigned)((fq ^ (fr >> 1)) << 4);
  const unsigned offA = (wr * 128 + fr) * 128 + sw, offB = 32768 + (wc * 64 + fr) * 128 + sw;
  const unsigned sbase = lds_addr(smem);
  if (!PRE) { issue(0, 0); if (nk > 1) issue(1, 1); }
  int st = 0;
#pragma unroll 1
  for (int kt = 0; kt < nk; kt++) {
    if (kt + 1 < nk) asm volatile("s_waitcnt vmcnt(12)" ::: "memory"); else wait_vm0();
    raw_barrier();
    if (kt + 2 < nk) issue(kt + 2, st == 0 ? 2 : st - 1);
    const unsigned base = sbase + st * 49152;
    st = st == 2 ? 0 : st + 1;
    h8 a0[8], b0[4], a1[8], b1[4];
#pragma unroll
    for (int m = 0; m < 8; m++) a0[m] = lds128(base + offA + m * 2048);
#pragma unroll
    for (int n = 0; n < 4; n++) b0[n] = lds128(base + offB + n * 2048);
#pragma unroll
    for (int m = 0; m < 8; m++) a1[m] = lds128(base + (offA ^ 64) + m * 2048);
#pragma unroll
    for (int n = 0; n < 4; n++) b1[n] = lds128(base + (offB ^ 64) + n * 2048);
    WAIT_LGKM(12);
#pragma unroll
    for (int m = 0; m < 8; m++) tie(a0[m]);
#pragma unroll
    for (int n = 0; n < 4; n++) tie(b0[n]);
#pragma unroll
    for (int m = 0; m < 8; m++)
#pragma unroll
      for (int n = 0; n < 4; n++) acc[m][n] = mfma16(a0[m], b0[n], acc[m][n]);
    WAIT_LGKM(0);
#pragma unroll
    for (int m = 0; m < 8; m++) tie(a1[m]);
#pragma unroll
    for (int n = 0; n < 4; n++) tie(b1[n]);
#pragma unroll
    for (int m = 0; m < 8; m++)
#pragma unroll
      for (int n = 0; n < 4; n++) acc[m][n] = mfma16(a1[m], b1[n], acc[m][n]);
  }
  raw_barrier();
}
DI bool xcd_tile(int it, int MT, int NT, int& mt, int& nt) {
  const int x = blockIdx.x & 7, j = blockIdx.x >> 3;
  const int nsn = NT >> 2, nsm = (MT + 7) >> 3;
  const int s = x + 8 * it;
  if (s >= nsm * nsn) return false;
  const int sm = s / nsn, sn = s % nsn;
  mt = sm * 8 + (j >> 2); nt = sn * 4 + (j & 3);
  return true;
}
DI bool next_tile(int& it, int MT, int NT, int& mt, int& nt) {
  for (;; it++) {
    if (!xcd_tile(it, MT, NT, mt, nt)) return false;
    if (mt < MT) return true;
  }
}
DI int slot_col() { int t = TIDX; return ((t & 7) ^ ((t >> 4) & 7)) * 8; }

DI float dpp_row_sum(float v) {
  v += __builtin_bit_cast(float, __builtin_amdgcn_update_dpp(0, __builtin_bit_cast(int, v), 0x128, 0xf, 0xf, false));
  v += __builtin_bit_cast(float, __builtin_amdgcn_update_dpp(0, __builtin_bit_cast(int, v), 0x124, 0xf, 0xf, false));
  v += __builtin_bit_cast(float, __builtin_amdgcn_update_dpp(0, __builtin_bit_cast(int, v), 0x122, 0xf, 0xf, false));
  v += __builtin_bit_cast(float, __builtin_amdgcn_update_dpp(0, __builtin_bit_cast(int, v), 0x121, 0xf, 0xf, false));
  return v;
}
DI void stage_put(char* stg, int ml, int n, int j, int fr, int fq, float v) { *(half_t*)(stg + (ml * 16 + fq * 4 + j) * 144 + (n * 16 + fr) * 2) = (half_t)v; }
template <class RP, class SC>
DI void stage_flush(char* stg, int h, RP rowptr, SC rowscale) {
  const int lane = TIDX & 63;
  __builtin_amdgcn_wave_barrier();
#pragma unroll
  for (int i = 0; i < 8; i++) {
    const int c = i * 64 + lane, row = c >> 3, c16 = c & 7;
    h8 v = *(const h8*)(stg + row * 144 + c16 * 16);
    half_t* d = rowptr(h * 64 + row);
    if (d) { rowscale(h * 64 + row, v); *(h8*)(d + c16 * 8) = v; }
  }
  __builtin_amdgcn_wave_barrier();
}
template <class VF, class RP, class SC>
DI void wave_store_tile(VF val, char* stg, RP rowptr, SC rowscale) {
  const int lane = TIDX & 63, fr = lane & 15, fq = lane >> 4;
#pragma unroll
  for (int h = 0; h < 2; h++) {
#pragma unroll
    for (int ml = 0; ml < 4; ml++)
#pragma unroll
      for (int n = 0; n < 4; n++)
#pragma unroll
        for (int j = 0; j < 4; j++) stage_put(stg, ml, n, j, fr, fq, val(h * 4 + ml, n, j));
    stage_flush(stg, h, rowptr, rowscale);
  }
}
DI void gemm_in_phase(const Params& P, int l, char* smem) {
  const int tid = TIDX;
  const half_t* Wt = P.WtIn + (size_t)l * NIN * 1024;
  const int sc = slot_col(), srow = tid >> 3;
  {
    float2* rcl = (float2*)(smem + 147456);
    for (int i = tid; i < 1024; i += 256) rcl[i] = P.rope[i];
    __syncthreads();
  }
  int it = 0, mt, nt;
  bool have = next_tile(it, 264, 20, mt, nt);
  const half_t* a0 = nullptr; const half_t* b0 = nullptr;
  if (have) {
    asm volatile("" : "+s"(mt), "+s"(nt));
    a0 = P.hx + (size_t)(mt * 256 + srow) * D + sc; b0 = Wt + (size_t)(nt * 128 + srow) * D + sc;
    gemm_prologue([&](int i) { return a0 + (size_t)i * 32 * D; }, [&](int i) { return b0 + (size_t)i * 32 * D; }, 16, smem);
  }
#pragma unroll 1
  while (have) {
    f4 acc[8][4];
    gemm256<true>([&](int i) { return a0 + (size_t)i * 32 * D; }, [&](int i) { return b0 + (size_t)i * 32 * D; }, 16, smem, acc);
    const int tid2 = TIDX, lane = tid2 & 63, wave = tid2 >> 6, fr = lane & 15, fq = lane >> 4, wr = wave >> 1, wc = wave & 1;
    const int r0 = mt * 256 + wr * 128;
    const bool isctx = r0 < TC;
    int b, pos0;
    if (isctx) { b = r0 >> 8; pos0 = r0 & 255; } else { b = (r0 - TC) >> 13; pos0 = 256 + ((r0 - TC) & 8191); }
    const bool isqk = nt >= 4 && nt < 12;
    float gg[4] = {0.f, 0.f, 0.f, 0.f}; float2 rr2[2] = {make_float2(1.f, 0.f), make_float2(1.f, 0.f)};
    if (isqk) {
      const float* gvec = (nt < 8 ? P.q_norm_g : P.k_norm_g) + l * 64;
      const float qs = nt < 8 ? 0.125f * 1.4426950408889634f : 1.f;
#pragma unroll
      for (int n = 0; n < 4; n++) gg[n] = gvec[n * 16 + fr] * qs;
      if (!isctx) { const int tp0 = pos0 - 256; rr2[0] = P.rope[(tp0 >> 6) * 16 + fr]; rr2[1] = P.rope[((tp0 >> 6) + 1) * 16 + fr]; }
    }
#pragma unroll
    for (int n = 0; n < 4; n++) asm volatile("" : "+v"(gg[n]));
    asm volatile("" : "+v"(rr2[0].x), "+v"(rr2[0].y), "+v"(rr2[1].x), "+v"(rr2[1].y));
    int it2 = it + 1, mt2, nt2;
    const bool have2 = next_tile(it2, 264, 20, mt2, nt2);
    const half_t* a1 = a0; const half_t* b1 = b0;
    if (have2) {
      asm volatile("" : "+s"(mt2), "+s"(nt2));
      a1 = P.hx + (size_t)(mt2 * 256 + srow) * D + sc; b1 = Wt + (size_t)(nt2 * 128 + srow) * D + sc;
      gemm_prologue([&](int i) { return a1 + (size_t)i * 32 * D; }, [&](int i) { return b1 + (size_t)i * 32 * D; }, 16, smem);
    }
    char* stg = smem + 98304 + wave * 12288;
    auto noscale = [](int, h8&) {};
    if (nt < 4 || nt >= 16) {
      half_t* dst; int ld, c0; bool gel = false;
      if (nt < 4) { dst = P.QF; ld = 512; c0 = nt * 128; }
      else if (nt < 18) { dst = P.gy; ld = 256; c0 = (nt - 16) * 128; gel = true; }
      else { dst = P.rr; ld = 256; c0 = (nt - 18) * 128; }
      half_t* base = dst + (size_t)r0 * ld + c0 + wc * 64;
      if (gel) wave_store_tile([&](int m, int n, int j) { return gelu_tanh(acc[m][n][j]); }, stg, [&](int r) { return base + (size_t)r * ld; }, noscale);
      else wave_store_tile([&](int m, int n, int j) { return acc[m][n][j]; }, stg, [&](int r) { return base + (size_t)r * ld; }, noscale);
    } else if (nt < 12) {
      const bool isq = nt < 8; const int head = isq ? nt - 4 : nt - 8;
      const float2* rcl = (const float2*)(smem + 147456);
      half_t* base = (isq ? P.q + (size_t)r0 * 512 : P.kall + ((size_t)b * KV + pos0) * 512) + head * 128 + wc * 64;
#pragma unroll
      for (int mh = 0; mh < 2; mh++) {
#pragma unroll
        for (int mm = 0; mm < 4; mm++) {
          const int m = mh * 4 + mm;
#pragma unroll
          for (int j = 0; j < 4; j++) {
            float ss = 0.f;
#pragma unroll
            for (int n = 0; n < 4; n++) ss += acc[m][n][j] * acc[m][n][j];
            ss = dpp_row_sum(ss);
            const float rstd = rsqrtf(ss * (1.f / 64.f) + EPS);
            float o[4];
#pragma unroll
            for (int n = 0; n < 4; n++) o[n] = acc[m][n][j] * rstd * gg[n];
            if (!isctx) {
              const float2 cr = rr2[mh], cc = rcl[(mm * 16 + fq * 4 + j) * 16 + fr];
              float a0 = o[0] * cr.x - o[1] * cr.y, a1 = o[1] * cr.x + o[0] * cr.y;
              float a2 = o[2] * cc.x - o[3] * cc.y, a3 = o[3] * cc.x + o[2] * cc.y;
              o[0] = a0; o[1] = a1; o[2] = a2; o[3] = a3;
            }
#pragma unroll
            for (int n = 0; n < 4; n++) stage_put(stg, mm, n, j, fr, fq, o[n]);
          }
        }
        stage_flush(stg, mh, [&](int r) { return base + (size_t)r * 512; }, noscale);
      }
    } else {
      const int head = nt - 12;
#pragma unroll
      for (int m = 0; m < 8; m++)
#pragma unroll
        for (int n = 0; n < 4; n++) {
          h4 o; o[0] = (half_t)acc[m][n][0]; o[1] = (half_t)acc[m][n][1]; o[2] = (half_t)acc[m][n][2]; o[3] = (half_t)acc[m][n][3];
          int d = wc * 64 + n * 16 + fr;
          asm volatile("" : "+v"(d) :: "memory");
          *(h4*)(P.vT + ((size_t)(b * 4 + head) * 128 + d) * KV + pos0 + m * 16 + fq * 4) = o;
        }
    }
    mt = mt2; nt = nt2; it = it2; have = have2; a0 = a1; b0 = b1;
  }
}

DI void gemm_out_phase(const Params& P, int l, char* smem) {
  const int tid = TIDX;
  const half_t* Wt = P.WtOut + (size_t)l * 1048576;
  const int mt0 = l == 0 ? 0 : TC / 256;
  const int MT = 264 - mt0;
  const int sc = slot_col(), srow = tid >> 3;
  int it = 0, mt, nt;
  bool have = next_tile(it, MT, 8, mt, nt);
  const half_t* a0 = nullptr; const half_t* b0 = nullptr;
  if (have) {
    asm volatile("" : "+s"(mt), "+s"(nt));
    a0 = P.mix + (size_t)((mt + mt0) * 256 + srow) * D + sc; b0 = Wt + (size_t)(nt * 128 + srow) * D + sc;
    gemm_prologue([&](int i) { return a0 + (size_t)i * 32 * D; }, [&](int i) { return b0 + (size_t)i * 32 * D; }, 16, smem);
  }
#pragma unroll 1
  while (have) {
    f4 acc[8][4];
    gemm256<true>([&](int i) { return a0 + (size_t)i * 32 * D; }, [&](int i) { return b0 + (size_t)i * 32 * D; }, 16, smem, acc);
    const int tid2 = TIDX, lane2 = tid2 & 63, wave2 = tid2 >> 6, fr2 = lane2 & 15, fq2 = lane2 >> 4, wr2 = wave2 >> 1, wc2 = wave2 & 1;
    const int r0 = (mt + mt0) * 256 + wr2 * 128;
    const int n = row_mod(r0);
    const int cbase = nt * 128 + wc2 * 64;
    const float* res; float* dst;
    if (r0 < TC) { res = P.ctx + (size_t)r0 * D; dst = P.xcbuf + (size_t)r0 * D; }
    else { dst = P.out + (size_t)(r0 - TC) * D; res = l == 0 ? P.x + (size_t)(r0 - TC) * D : dst; }
    res += cbase + fr2 * 4; dst += cbase + fr2 * 4;
    const float4 g4 = *(const float4*)(P.mod + (size_t)(l * 9 + n) * 6144 + 2 * 1024 + cbase + fr2 * 4);
    float4 rres[4][8];
#pragma unroll
    for (int q = 0; q < 4; q++)
#pragma unroll
      for (int i = 0; i < 8; i++) rres[q][i] = *(const float4*)(res + (size_t)(q * 32 + i * 4 + fq2) * D);
    int it2 = it + 1, mt2, nt2;
    const bool have2 = next_tile(it2, MT, 8, mt2, nt2);
    const half_t* a1 = a0; const half_t* b1 = b0;
    if (have2) {
      asm volatile("" : "+s"(mt2), "+s"(nt2));
      a1 = P.mix + (size_t)((mt2 + mt0) * 256 + srow) * D + sc; b1 = Wt + (size_t)(nt2 * 128 + srow) * D + sc;
      gemm_prologue([&](int i) { return a1 + (size_t)i * 32 * D; }, [&](int i) { return b1 + (size_t)i * 32 * D; }, 16, smem);
    }
    {
      float* stg = (float*)(smem + 98304 + wave2 * 12288);
#pragma unroll
      for (int q = 0; q < 4; q++) {
#pragma unroll
        for (int ml = 0; ml < 2; ml++)
#pragma unroll
          for (int nn = 0; nn < 4; nn++)
#pragma unroll
            for (int j = 0; j < 4; j++) stg[(ml * 16 + fq2 * 4 + j) * 68 + nn * 16 + fr2] = acc[q * 2 + ml][nn][j];
        __builtin_amdgcn_wave_barrier();
#pragma unroll
        for (int i = 0; i < 8; i++) {
          const int row = i * 4 + fq2;
          const float4 a = *(const float4*)(stg + row * 68 + fr2 * 4);
          float4 r = rres[q][i];
          r.x += g4.x * a.x; r.y += g4.y * a.y; r.z += g4.z * a.z; r.w += g4.w * a.w;
          *(float4*)(dst + (size_t)(q * 32 + row) * D) = r;
        }
        __builtin_amdgcn_wave_barrier();
      }
    }
    mt = mt2; nt = nt2; it = it2; have = have2; a0 = a1; b0 = b1;
  }
}

DI void moe_prefix(const Params& P, int l, int* tb) {
  __syncthreads();
  if (TIDX == 0) { int s = 0; for (int e = 0; e < 32; e++) { tb[e] = s; s += (P.cnt[l * 32 + e] + 255) >> 8; } tb[32] = s; }
  __syncthreads();
}
DI void moe_e1_phase(const Params& P, int l, char* smem, int* tb) {
  const int tid = TIDX;
  moe_prefix(P, l, tb);
  const int sc = slot_col(), srow = tid >> 3;
  const int MT = tb[32];
  auto setup = [&](int rt, int nt, int (&tok)[8], const half_t*& w1, const half_t*& w3) {
    int e = 0;
    while (tb[e + 1] <= rt) e++;
    const int rl = rt - tb[e], cnt = P.cnt[l * 32 + e];
    const int* lst = P.list + (size_t)e * LCAP;
    w1 = P.Wt1 + ((size_t)(l * 32 + e) * 512 + nt * 64) * 1024 + sc;
    w3 = P.Wt3 + ((size_t)(l * 32 + e) * 512 + nt * 64) * 1024 + sc;
#pragma unroll
    for (int i = 0; i < 8; i++) tok[i] = lst[min(rl * 256 + i * 32 + srow, cnt - 1)] >> 1;
  };
  int it = 0, rt, nt;
  bool have = next_tile(it, MT, 8, rt, nt);
  int tok[8]; const half_t* w1 = nullptr; const half_t* w3 = nullptr;
  if (have) {
    asm volatile("" : "+s"(rt), "+s"(nt));
    setup(rt, nt, tok, w1, w3);
    gemm_prologue([&](int i) { return P.hx + (size_t)tok[i] * D + sc; }, [&](int i) { return ((i & 1) ? w3 : w1) + (size_t)((i >> 1) * 32 + srow) * 1024; }, 16, smem);
  }
#pragma unroll 1
  while (have) {
    int it2 = it + 1, rt2, nt2;
    const bool have2 = next_tile(it2, MT, 8, rt2, nt2);
    int tok2[8]; const half_t* w1n = w1; const half_t* w3n = w3;
#pragma unroll
    for (int i = 0; i < 8; i++) tok2[i] = tok[i];
    if (have2) {
      asm volatile("" : "+s"(rt2), "+s"(nt2));
      setup(rt2, nt2, tok2, w1n, w3n);
    }
    f4 acc[8][4];
    gemm256<true>([&](int i) { return P.hx + (size_t)tok[i] * D + sc; },
                  [&](int i) { return ((i & 1) ? w3 : w1) + (size_t)((i >> 1) * 32 + srow) * 1024; }, 16, smem, acc);
    if (have2) {
      gemm_prologue([&](int i) { return P.hx + (size_t)tok2[i] * D + sc; }, [&](int i) { return ((i & 1) ? w3n : w1n) + (size_t)((i >> 1) * 32 + srow) * 1024; }, 16, smem);
    }
    {
      const int tid2 = TIDX, lane2 = tid2 & 63, wave2 = tid2 >> 6, fr2 = lane2 & 15, fq2 = lane2 >> 4, wr2 = wave2 >> 1, wc2 = wave2 & 1;
      char* stg = smem + 98304 + wave2 * 12288;
      half_t* Hd = P.H + ((size_t)rt * 256 + wr2 * 128) * 512 + nt * 64 + wc2 * 32;
#pragma unroll
      for (int h = 0; h < 2; h++) {
#pragma unroll
        for (int ml = 0; ml < 4; ml++)
#pragma unroll
          for (int n = 0; n < 2; n++)
#pragma unroll
            for (int j = 0; j < 4; j++) {
              float a1 = acc[h * 4 + ml][n][j], a3 = acc[h * 4 + ml][n + 2][j];
              *(half_t*)(stg + (ml * 16 + fq2 * 4 + j) * 80 + (n * 16 + fr2) * 2) = (half_t)(a1 * sigmoidf_(a1) * a3);
            }
        __builtin_amdgcn_wave_barrier();
#pragma unroll
        for (int i = 0; i < 4; i++) {
          const int c = i * 64 + lane2, row = c >> 2, c16 = c & 3;
          h8 v = *(const h8*)(stg + row * 80 + c16 * 16);
          *(h8*)(Hd + (size_t)(h * 64 + row) * 512 + c16 * 8) = v;
        }
        __builtin_amdgcn_wave_barrier();
      }
    }
    rt = rt2; nt = nt2; it = it2; have = have2; w1 = w1n; w3 = w3n;
#pragma unroll
    for (int i = 0; i < 8; i++) tok[i] = tok2[i];
  }
}
DI void moe_e2_phase(const Params& P, int l, char* smem, int* tb) {
  const int tid = TIDX;
  moe_prefix(P, l, tb);
  const int sc = slot_col(), srow = tid >> 3;
  const int MT = tb[32];
  auto ptrs = [&](int rt, int nt, const half_t*& a0, const half_t*& b0) {
    int e = 0;
    while (tb[e + 1] <= rt) e++;
    a0 = P.H + ((size_t)rt * 256 + srow) * 512 + sc;
    b0 = P.Wt2 + ((size_t)(l * 32 + e) * 1024 + nt * 128 + srow) * 512 + sc;
  };
  int it = 0, rt, nt;
  bool have = next_tile(it, MT, 8, rt, nt);
  const half_t* a0 = nullptr; const half_t* b0 = nullptr;
  if (have) {
    asm volatile("" : "+s"(rt), "+s"(nt));
    ptrs(rt, nt, a0, b0);
    gemm_prologue([&](int i) { return a0 + (size_t)i * 32 * 512; }, [&](int i) { return b0 + (size_t)i * 32 * 512; }, 8, smem);
  }
#pragma unroll 1
  while (have) {
    const int tid2 = TIDX, lane2 = tid2 & 63, wave2 = tid2 >> 6, wr2 = wave2 >> 1, wc2 = wave2 & 1;
    int e = 0;
    while (tb[e + 1] <= rt) e++;
    const int rl = rt - tb[e], cnt = P.cnt[l * 32 + e];
    const int* lst = P.list + (size_t)e * LCAP; const float* lstw = P.listW + (size_t)e * LCAP;
    int aa[2][8]; float ww[2][8];
#pragma unroll
    for (int h = 0; h < 2; h++)
#pragma unroll
      for (int i = 0; i < 8; i++) {
        const int idx = rl * 256 + wr2 * 128 + h * 64 + ((i * 64 + lane2) >> 3);
        const int ic = min(idx, cnt - 1);
        const int av = lst[ic]; const float wv = lstw[ic];
        aa[h][i] = idx < cnt ? av : -1; ww[h][i] = wv;
      }
    f4 acc[8][4];
    gemm256<true>([&](int i) { return a0 + (size_t)i * 32 * 512; }, [&](int i) { return b0 + (size_t)i * 32 * 512; }, 8, smem, acc);
    int it2 = it + 1, rt2, nt2;
    const bool have2 = next_tile(it2, MT, 8, rt2, nt2);
    const half_t* a1 = a0; const half_t* b1 = b0;
    if (have2) {
      asm volatile("" : "+s"(rt2), "+s"(nt2));
      ptrs(rt2, nt2, a1, b1);
      gemm_prologue([&](int i) { return a1 + (size_t)i * 32 * 512; }, [&](int i) { return b1 + (size_t)i * 32 * 512; }, 8, smem);
    }
    {
      char* stg = smem + 98304 + wave2 * 12288;
      const int fr2 = lane2 & 15, fq2 = lane2 >> 4;
#pragma unroll
      for (int h = 0; h < 2; h++) {
#pragma unroll
        for (int ml = 0; ml < 4; ml++)
#pragma unroll
          for (int n = 0; n < 4; n++)
#pragma unroll
            for (int j = 0; j < 4; j++) stage_put(stg, ml, n, j, fr2, fq2, acc[h * 4 + ml][n][j]);
        __builtin_amdgcn_wave_barrier();
#pragma unroll
        for (int i = 0; i < 8; i++) {
          const int c = i * 64 + lane2, row = c >> 3, c16 = c & 7;
          h8 v = *(const h8*)(stg + row * 144 + c16 * 16);
          if (aa[h][i] >= 0) {
            const float w = ww[h][i];
#pragma unroll
            for (int u = 0; u < 8; u++) v[u] = (half_t)(w * (float)v[u]);
            *(h8*)(P.yA + (size_t)aa[h][i] * D + nt * 128 + wc2 * 64 + c16 * 8) = v;
          }
        }
        __builtin_amdgcn_wave_barrier();
      }
    }
    rt = rt2; nt = nt2; it = it2; have = have2; a0 = a1; b0 = b1;
  }
}

DI int swap23(int x) { return (x & ~12) | ((x & 4) << 1) | ((x & 8) >> 1); }
DI void attn_item(const Params& P, int l, int b, int head, int row0, int nkeys, char* smem) {
  const int tid = TIDX, lane = tid & 63, wave = tid >> 6, ql = lane & 31, hh = lane >> 5;
  const float lam = P.consts[l * 4 + 0], negc = -P.consts[l * 4 + 1], lam_init = P.consts[l * 4 + 2];
  const int myrow = row0 + wave * 32 + ql;
  h8 qf[2][4];
  {
    const half_t* qp = P.q + (size_t)myrow * 512 + head * 128 + hh * 8;
#pragma unroll
    for (int m = 0; m < 2; m++)
#pragma unroll
      for (int s = 0; s < 4; s++) { qf[m][s] = *(const h8*)(qp + m * 64 + s * 16); }
#pragma unroll
    for (int m = 0; m < 2; m++)
#pragma unroll
      for (int s = 0; s < 4; s++) tie(qf[m][s]);
  }
  f16v o0[4], o1[4];
#pragma unroll
  for (int dt = 0; dt < 4; dt++)
#pragma unroll
    for (int i = 0; i < 16; i++) { o0[dt][i] = 0.f; o1[dt][i] = 0.f; }
  float ls0 = 0.f, ls1 = 0.f;
  const half_t* kp[4]; const half_t* vp[4];
  {
    const half_t* kbase = P.kall + (size_t)b * KV * 512 + head * 128;
    const half_t* vbase = P.vT + (size_t)(b * 4 + head) * 128 * KV;
#pragma unroll
    for (int i = 0; i < 4; i++) {
      int s = i * 256 + tid;
      int row = s >> 4, c = (s & 15) ^ (row & 15); kp[i] = kbase + (size_t)row * 512 + c * 8;
      int vr = s >> 3, vc = (s & 7) ^ ((vr >> 1) & 7); vp[i] = vbase + (size_t)vr * KV + vc * 8;
    }
  }
  const int ntile = nkeys >> 6;
  const unsigned sbase = lds_addr(smem);
  auto issue = [&](int t) {
    char* d = smem + (t & 3) * 32768 + tid * 16;
#pragma unroll
    for (int i = 0; i < 4; i++) { glds16(kp[i] + (size_t)t * 64 * 512, d + i * 4096); glds16(vp[i] + t * 64, d + 16384 + i * 4096); }
  };
  unsigned koff[2];
  const int kr_lo = swap23(ql), ksw = kr_lo & 15;
  koff[0] = kr_lo * 256; koff[1] = (32 + kr_lo) * 256;
  unsigned voff[4];
#pragma unroll
  for (int dt = 0; dt < 4; dt++) { int vrow = dt * 32 + ql; voff[dt] = 16384 + vrow * 128; }
  const int vsw = (ql >> 1) & 7;
  f16v negcv;
#pragma unroll
  for (int i = 0; i < 16; i++) negcv[i] = negc;
  h8 pp0[2], pp1[2];
  unsigned pendV = 0; int pendkt = 0; bool pend = false;
  auto half_step = [&](h8 (&kf)[8], unsigned cur, int kt) {
    h8 vf[8];
    if (pend) {
#pragma unroll
      for (int sp = 0; sp < 2; sp++)
#pragma unroll
        for (int dt = 0; dt < 4; dt++) vf[sp * 4 + dt] = lds128(pendV + voff[dt] + (((pendkt * 4 + sp * 2 + hh) ^ vsw) << 4));
    }
    f16v s0 = mfma32(kf[0], qf[0][0], negcv), s1 = mfma32(kf[4], qf[1][0], negcv);
#pragma unroll
    for (int st = 1; st < 4; st++) { s0 = mfma32(kf[st], qf[0][st], s0); s1 = mfma32(kf[4 + st], qf[1][st], s1); }
    if (pend) {
      WAIT_LGKM(0);
#pragma unroll
      for (int i = 0; i < 8; i++) tie(vf[i]);
#pragma unroll
      for (int sp = 0; sp < 2; sp++)
#pragma unroll
        for (int dt = 0; dt < 4; dt++) { o0[dt] = mfma32(vf[sp * 4 + dt], pp0[sp], o0[dt]); o1[dt] = mfma32(vf[sp * 4 + dt], pp1[sp], o1[dt]); }
    }
#pragma unroll
    for (int i = 0; i < 16; i++) { s0[i] = __builtin_amdgcn_exp2f(s0[i]); ls0 += s0[i]; s1[i] = __builtin_amdgcn_exp2f(s1[i]); ls1 += s1[i]; }
#pragma unroll
    for (int sp = 0; sp < 2; sp++) {
      u4 a, c;
      a[0] = pk2(s0[8*sp+0], s0[8*sp+1]); a[1] = pk2(s0[8*sp+2], s0[8*sp+3]); a[2] = pk2(s0[8*sp+4], s0[8*sp+5]); a[3] = pk2(s0[8*sp+6], s0[8*sp+7]);
      c[0] = pk2(s1[8*sp+0], s1[8*sp+1]); c[1] = pk2(s1[8*sp+2], s1[8*sp+3]); c[2] = pk2(s1[8*sp+4], s1[8*sp+5]); c[3] = pk2(s1[8*sp+6], s1[8*sp+7]);
      pp0[sp] = __builtin_bit_cast(h8, a); pp1[sp] = __builtin_bit_cast(h8, c);
    }
    pend = true; pendV = cur; pendkt = kt;
  };
  issue(0);
  if (ntile > 1) issue(1);
#pragma unroll 1
  for (int t = 0; t < ntile; t++) {
    if (t + 1 < ntile) asm volatile("s_waitcnt vmcnt(8)" ::: "memory"); else wait_vm0();
    raw_barrier();
    if (t + 2 < ntile) issue(t + 2);
    const unsigned cur = sbase + (t & 3) * 32768;
    h8 kfa[8], kfb[8];
#pragma unroll
    for (int st = 0; st < 4; st++) {
      kfa[st] = lds128(cur + koff[0] + (((st * 2 + hh) ^ ksw) << 4));
      kfa[4 + st] = lds128(cur + koff[0] + (((8 + st * 2 + hh) ^ ksw) << 4));
    }
#pragma unroll
    for (int st = 0; st < 4; st++) {
      kfb[st] = lds128(cur + koff[1] + (((st * 2 + hh) ^ ksw) << 4));
      kfb[4 + st] = lds128(cur + koff[1] + (((8 + st * 2 + hh) ^ ksw) << 4));
    }
    WAIT_LGKM(8);
#pragma unroll
    for (int i = 0; i < 8; i++) tie(kfa[i]);
    half_step(kfa, cur, 0);
    WAIT_LGKM(0);
#pragma unroll
    for (int i = 0; i < 8; i++) tie(kfb[i]);
    half_step(kfb, cur, 1);
  }
  {
    h8 vf[8];
#pragma unroll
    for (int sp = 0; sp < 2; sp++)
#pragma unroll
      for (int dt = 0; dt < 4; dt++) vf[sp * 4 + dt] = lds128(pendV + voff[dt] + (((pendkt * 4 + sp * 2 + hh) ^ vsw) << 4));
    WAIT_LGKM(0);
#pragma unroll
    for (int i = 0; i < 8; i++) tie(vf[i]);
#pragma unroll
    for (int sp = 0; sp < 2; sp++)
#pragma unroll
      for (int dt = 0; dt < 4; dt++) { o0[dt] = mfma32(vf[sp * 4 + dt], pp0[sp], o0[dt]); o1[dt] = mfma32(vf[sp * 4 + dt], pp1[sp], o1[dt]); }
  }
  raw_barrier();
  ls0 += shx(ls0, 32); ls1 += shx(ls1, 32);
  const float i0 = 1.f / ls0, i1 = lam / ls1;
  float ss = 0.f;
#pragma unroll
  for (int dt = 0; dt < 4; dt++)
#pragma unroll
    for (int i = 0; i < 16; i++) { float v = o0[dt][i] * i0 - o1[dt][i] * i1; o0[dt][i] = v; ss += v * v; }
  ss += shx(ss, 32);
  const float mult = rsqrtf(ss * (1.f / 128.f) + EPS) * (1.f - lam_init);
  const float* sg = P.subln_g + l * 128;
  half_t* dst = P.mix + (size_t)myrow * D + 256 + head * 128;
#pragma unroll
  for (int dt = 0; dt < 4; dt++)
#pragma unroll
    for (int g = 0; g < 4; g++) {
      const int d0 = dt * 32 + 8 * g + 4 * hh;
      float4 gv = *(const float4*)(sg + d0);
      h4 o; o[0] = (half_t)(o0[dt][4*g] * mult * gv.x); o[1] = (half_t)(o0[dt][4*g+1] * mult * gv.y);
      o[2] = (half_t)(o0[dt][4*g+2] * mult * gv.z); o[3] = (half_t)(o0[dt][4*g+3] * mult * gv.w);
      *(h4*)(dst + d0) = o;
    }
}

DI int swz128(int row, int colh) { return row * 128 + ((((colh >> 3)) ^ ((row >> 1) & 7)) << 4) + (colh & 7) * 2; }
DI void lru_load_w(const Params& P, int l, int g, char* Wt) {
  const int tid = TIDX;
  for (int dg = 0; dg < 4; dg++) {
    const int dir = dg >> 1;
    const float* w = ((dg & 1) ? P.gate_x_w : P.gate_a_w) + ((size_t)((l * 2 + dir) * 4 + g)) * 4096;
    for (int idx = tid; idx < 4096; idx += 256) { int i = idx >> 6, o = idx & 63; *(half_t*)(Wt + dg * 8192 + swz128(o, i)) = (half_t)w[idx]; }
  }
}
struct LruK { float ba[2][4], bx[2][4], sp8[2][4], cw[5]; };
DI void lru_consts(const Params& P, int l, int g, LruK& K) {
  const int tid = TIDX, fr = tid & 15, gc = g * 64 + (tid & 63);
#pragma unroll
  for (int dir = 0; dir < 2; dir++)
#pragma unroll
    for (int n = 0; n < 4; n++) {
      const int cc = (l * 2 + dir) * 256 + g * 64 + n * 16 + fr;
      K.ba[dir][n] = P.gate_a_b[cc]; K.bx[dir][n] = P.gate_x_b[cc]; K.sp8[dir][n] = -8.f * log1pf(__expf(-P.lru_lambda[cc]));
    }
#pragma unroll
  for (int k = 0; k < 4; k++) K.cw[k] = P.conv_w[(l * 4 + k) * 256 + gc];
  K.cw[4] = P.conv_b[l * 256 + gc];
}
DI void lru_tile(const Params& P, int l, int b, int tile, int g, char* smem, bool final, const LruK& K) {
  const int tid = TIDX, lane = tid & 63, wave = tid >> 6, fr = lane & 15, fq = lane >> 4;
  char* Wt = smem;
  char* xr16 = smem + 32768;
  float2* ab = (float2*)(smem + 40960);
  half_t* raw = (half_t*)(smem + 40960);
  float2* subst = (float2*)(smem + 73728);
  const int ch = tid & 63, tq = tid >> 6, gc = g * 64 + ch;
  const int T = tile < 4 ? CL : SEQ;
  const int t0 = tile < 4 ? tile * 64 : (tile - 4) * 64;
  const int rowbase = tile < 4 ? b * CL : TC + b * SEQ;
  unsigned* lab = (unsigned*)P.hx;
  __syncthreads();
  if (final) {
    float gyv[16], hsum[16];
#pragma unroll
    for (int e = 0; e < 16; e++) { gyv[e] = (float)P.gy[(size_t)(rowbase + t0 + tq * 16 + e) * 256 + gc]; hsum[e] = 0.f; }
    unsigned pk0[16], pk1[16];
#pragma unroll
    for (int e = 0; e < 16; e++) { pk0[e] = lab[((size_t)rowbase + t0 + tq * 16 + e) * 256 + gc]; pk1[e] = lab[((size_t)TA + rowbase + t0 + tq * 16 + e) * 256 + gc]; }
    const float car0 = P.lcar[((size_t)((b * 2 + 0) * 132 + tile)) * 256 + gc], car1 = P.lcar[((size_t)((b * 2 + 1) * 132 + tile)) * 256 + gc];
#pragma unroll 1
    for (int dir = 0; dir < 2; dir++) {
      unsigned pk[16];
#pragma unroll
      for (int e = 0; e < 16; e++) pk[e] = dir == 0 ? pk0[e] : pk1[e];
      float2 av[16];
      float A = 1.f, h = 0.f;
#pragma unroll
      for (int e = 0; e < 16; e++) {
        const int ee = dir == 0 ? e : 15 - e;
        unsigned u = pk[0];
#pragma unroll
        for (int q = 1; q < 16; q++) u = (q == ee) ? pk[q] : u;
        fp16x2 hv = __builtin_bit_cast(fp16x2, u);
        av[e] = make_float2(__expf((float)hv[0]), (float)hv[1]);
        h = av[e].x * h + av[e].y; A *= av[e].x;
      }
      subst[tq * 64 + ch] = make_float2(A, h);
      __syncthreads();
      h = dir == 0 ? car0 : car1;
      if (dir == 0) { for (int s2 = 0; s2 < tq; s2++) { float2 ss = subst[s2 * 64 + ch]; h = ss.x * h + ss.y; } }
      else { for (int s2 = 3; s2 > tq; s2--) { float2 ss = subst[s2 * 64 + ch]; h = ss.x * h + ss.y; } }
#pragma unroll
      for (int e = 0; e < 16; e++) {
        const int ee = dir == 0 ? e : 15 - e;
        h = av[e].x * h + av[e].y;
#pragma unroll
        for (int q = 0; q < 16; q++) hsum[q] += (q == ee) ? h : 0.f;
      }
      __syncthreads();
    }
#pragma unroll
    for (int e = 0; e < 16; e++)
      P.mix[(size_t)(rowbase + t0 + tq * 16 + e) * D + 768 + gc] = (half_t)(gyv[e] * hsum[e]);
    return;
  }
  for (int idx = tid; idx < 67 * 8; idx += 256) {
    int row = idx >> 3, c = idx & 7, tt = t0 - 1 + row;
    h8 v = {0, 0, 0, 0, 0, 0, 0, 0};
    if (tt >= 0 && tt < T) v = *(const h8*)(P.rr + (size_t)(rowbase + tt) * 256 + g * 64 + c * 8);
    *(h8*)(raw + row * 64 + c * 8) = v;
  }
  const float cw0 = K.cw[0], cw1 = K.cw[1], cw2 = K.cw[2], cw3 = K.cw[3], cb = K.cw[4];
  __syncthreads();
  {
    float v[19];
#pragma unroll
    for (int e = 0; e < 19; e++) v[e] = (float)raw[(tq * 16 + e) * 64 + ch];
    __syncthreads();
#pragma unroll
    for (int e = 0; e < 16; e++) {
      float xv = cb + cw0 * v[e] + cw1 * v[e + 1] + cw2 * v[e + 2] + cw3 * v[e + 3];
      *(half_t*)(xr16 + swz128(tq * 16 + e, ch)) = (half_t)xv;
    }
  }
  __syncthreads();
#pragma unroll 1
  for (int dir = 0; dir < 2; dir++) {
    {
      f4 acc[2][4];
#pragma unroll
      for (int gt = 0; gt < 2; gt++)
#pragma unroll
        for (int n = 0; n < 4; n++) acc[gt][n] = (f4){0.f, 0.f, 0.f, 0.f};
#pragma unroll
      for (int kk = 0; kk < 2; kk++) {
        int row = wave * 16 + fr;
        h8 af = *(const h8*)(xr16 + row * 128 + (((kk * 4 + fq) ^ ((row >> 1) & 7)) << 4));
#pragma unroll
        for (int gt = 0; gt < 2; gt++)
#pragma unroll
          for (int n = 0; n < 4; n++) {
            int orow = n * 16 + fr;
            h8 bf = *(const h8*)(Wt + (dir * 2 + gt) * 8192 + orow * 128 + (((kk * 4 + fq) ^ ((orow >> 1) & 7)) << 4));
            acc[gt][n] = mfma16(af, bf, acc[gt][n]);
          }
      }
#pragma unroll
      for (int n = 0; n < 4; n++) {
        const float ba = dir == 0 ? K.ba[0][n] : K.ba[1][n], bx = dir == 0 ? K.bx[0][n] : K.bx[1][n], sp8 = dir == 0 ? K.sp8[0][n] : K.sp8[1][n];
#pragma unroll
        for (int j = 0; j < 4; j++) {
          int tl = wave * 16 + fq * 4 + j, c2 = n * 16 + fr;
          float xv = (float)*(const half_t*)(xr16 + swz128(tl, c2));
          float rg = sigmoidf_(acc[0][n][j] + ba), ig = sigmoidf_(acc[1][n][j] + bx);
          float log_a = rg * sp8;
          float x2 = 2.f * log_a;
          float om = -x2 * (1.f + x2 * (0.5f + x2 * (0.16666667f + x2 * (0.041666668f + x2 * (0.008333334f + x2 * 0.0013888889f)))));
          if (x2 < -0.4f) { float a = __expf(log_a); om = 1.f - a * a; }
          ab[tl * 64 + c2] = make_float2(log_a, sqrtf(om) * (ig * xv));
        }
      }
    }
    __syncthreads();
    {
      float A = 1.f, h = 0.f;
#pragma unroll
      for (int e = 0; e < 16; e++) {
        const int ee = dir == 0 ? e : 15 - e;
        const float2 lb = ab[(tq * 16 + ee) * 64 + ch];
        fp16x2 hv; hv[0] = (__fp16)lb.x; hv[1] = (__fp16)lb.y;
        lab[((size_t)dir * TA + rowbase + t0 + tq * 16 + ee) * 256 + gc] = __builtin_bit_cast(unsigned, hv);
        const float a = __expf((float)hv[0]), bt = (float)hv[1];
        h = a * h + bt; A *= a;
      }
      subst[tq * 64 + ch] = make_float2(A, h);
    }
    __syncthreads();
    if (tq == 0) {
      float A = 1.f, h = 0.f;
#pragma unroll
      for (int s2 = 0; s2 < 4; s2++) { float2 ss = subst[(dir == 0 ? s2 : 3 - s2) * 64 + ch]; h = ss.x * h + ss.y; A *= ss.x; }
      P.lsum[((size_t)((b * 2 + dir) * 132 + tile)) * 256 + gc] = make_float2(A, h);
    }
    __syncthreads();
  }
}
DI void lru_carry_item(const Params& P, int it) {
  const int ch = TIDX, dir = it & 1;
  const size_t base = (size_t)it * 132 * 256 + ch;
  float c = 0.f;
#pragma unroll 4
  for (int k = 0; k < 132; k++) {
    int tile = dir == 0 ? k : (k < 4 ? 3 - k : 135 - k);
    float2 s = P.lsum[base + (size_t)tile * 256];
    P.lcar[base + (size_t)tile * 256] = c;
    c = s.x * c + s.y;
  }
}

template <int NROWS>
DI void fft_load(const half_t* src, size_t rs, char* Bt, int rowbytes, int k0) {
  const int tid = TIDX;
  h8 v[NROWS / 16];
#pragma unroll
  for (int i = 0; i < NROWS / 16; i++) { int idx = i * 256 + tid; v[i] = *(const h8*)(src + (size_t)(idx >> 4) * rs + (idx & 15) * 8); }
#pragma unroll
  for (int i = 0; i < NROWS / 16; i++) {
    int idx = i * 256 + tid, kr = idx >> 4, cc = idx & 15, k = k0 + kr;
#pragma unroll
    for (int u = 0; u < 8; u++) { int n = cc * 8 + u; *(half_t*)(Bt + n * rowbytes + ((((k >> 3)) ^ (n & 15)) << 4) + (k & 7) * 2) = v[i][u]; }
  }
}
template <class RF>
DI void fft_mma(const half_t* Dm, int ldD, int nkk, const char* Bt, int rowbytes, f4 (&acc)[4][4], RF arow) {
  const int lane = TIDX & 63, wave = TIDX >> 6, fr = lane & 15, fq = lane >> 4, wc = wave & 1;
#pragma unroll 4
  for (int kk = 0; kk < nkk; kk++) {
    h8 af[4], bf[4];
#pragma unroll
    for (int ms = 0; ms < 4; ms++) af[ms] = *(const h8*)(Dm + (size_t)arow(ms) * ldD + kk * 32 + fq * 8);
#pragma unroll
    for (int ns = 0; ns < 4; ns++) { int n = wc * 64 + ns * 16 + fr; bf[ns] = *(const h8*)(Bt + n * rowbytes + (((kk * 4 + fq) ^ (n & 15)) << 4)); }
#pragma unroll
    for (int ms = 0; ms < 4; ms++)
#pragma unroll
      for (int ns = 0; ns < 4; ns++) acc[ms][ns] = mfma16(af[ms], bf[ns], acc[ms][ns]);
  }
}
DI void zero44(f4 (&acc)[4][4]) {
#pragma unroll
  for (int m = 0; m < 4; m++)
#pragma unroll
    for (int n = 0; n < 4; n++) acc[m][n] = (f4){0.f, 0.f, 0.f, 0.f};
}
DI void fftA_item(const Params& P, int it, char* smem) {
  const int b = it >> 8, bb = (it >> 1) & 127, chh = it & 1;
  const int lane = TIDX & 63, wave = TIDX >> 6, fr = lane & 15, fq = lane >> 4, wr = wave >> 1, wc = wave & 1;
  __syncthreads();
  fft_load<64>(P.QF + (size_t)(TC + b * SEQ + bb) * 512 + chh * 128, (size_t)128 * 512, smem, 256, 0);
  fft_load<64>(P.QF + (size_t)(TC + b * SEQ + bb) * 512 + 256 + chh * 128, (size_t)128 * 512, smem, 256, 64);
  __syncthreads();
  f4 acc[4][4]; zero44(acc);
  fft_mma(P.DA, 128, 4, smem, 256, acc, [&](int ms) { return (ms >> 1) * 64 + wr * 32 + (ms & 1) * 16 + fr; });
#pragma unroll
  for (int ms = 0; ms < 2; ms++)
#pragma unroll
    for (int j = 0; j < 4; j++) {
      const int f1 = wr * 32 + ms * 16 + fq * 4 + j;
      const float2 w = P.tw[(bb * f1) & 8191];
      half_t* d0 = P.GA + ((size_t)(b * 64 + f1) * 256 + bb) * 256 + chh * 128 + wc * 64 + fr;
#pragma unroll
      for (int ns = 0; ns < 4; ns++) {
        float gr = acc[ms][ns][j], gi = acc[ms + 2][ns][j];
        d0[ns * 16] = (half_t)(gr * w.x + gi * w.y);
        d0[(size_t)128 * 256 + ns * 16] = (half_t)(gi * w.x - gr * w.y);
      }
    }
}
DI void fftB_item(const Params& P, int it, char* smem) {
  const int b = it >> 7, f1 = (it >> 1) & 63, chh = it & 1;
  const int lane = TIDX & 63, wave = TIDX >> 6, fr = lane & 15, fq = lane >> 4, wr = wave >> 1, wc = wave & 1;
  __syncthreads();
  fft_load<256>(P.GA + (size_t)(b * 64 + f1) * 256 * 256 + chh * 128, 256, smem, 512, 0);
  __syncthreads();
  f4 acc[4][4]; zero44(acc);
  fft_mma(P.DB, 256, 8, smem, 512, acc, [&](int ms) { return wr * 64 + ms * 16 + fr; });
#pragma unroll
  for (int ms = 0; ms < 4; ms++)
#pragma unroll
    for (int j = 0; j < 4; j++) {
      const int f2 = wr * 64 + ms * 16 + fq * 4 + j;
      half_t* d0 = P.mix + (size_t)(TC + b * SEQ + f1 + 64 * f2) * D + chh * 128 + wc * 64 + fr;
#pragma unroll
      for (int ns = 0; ns < 4; ns++) d0[ns * 16] = (half_t)acc[ms][ns][j];
    }
}
DI void fftC_item(const Params& P, int it, char* smem) {
  const int b = it >> 1, chh = it & 1;
  const int lane = TIDX & 63, wave = TIDX >> 6, fr = lane & 15, fq = lane >> 4, wr = wave >> 1, wc = wave & 1;
#pragma unroll 1
  for (int mh = 0; mh < 2; mh++) {
    f4 acc[4][4]; zero44(acc);
#pragma unroll 1
    for (int part = 0; part < 2; part++) {
      __syncthreads();
      fft_load<256>(P.QF + (size_t)(b * CL) * 512 + part * 256 + chh * 128, 512, smem, 512, 0);
      __syncthreads();
      fft_mma(P.DC + part * 256, 512, 8, smem, 512, acc, [&](int ms) { return mh * 128 + wr * 64 + ms * 16 + fr; });
    }
#pragma unroll
    for (int ms = 0; ms < 4; ms++)
#pragma unroll
      for (int j = 0; j < 4; j++) {
        const int f = mh * 128 + wr * 64 + ms * 16 + fq * 4 + j;
        half_t* d0 = P.mix + (size_t)(b * CL + f) * D + chh * 128 + wc * 64 + fr;
#pragma unroll
        for (int ns = 0; ns < 4; ns++) d0[ns * 16] = (half_t)acc[ms][ns][j];
      }
  }
}

#ifndef MX
#define MX 15
#endif
DI void mix_phase(const Params& P, int l, char* smem, int* s_item, int qi) {
  const int nL = 0, nA = 0, nC = l == 0 ? 64 : 0, nFA = 2048, nFC = l == 0 ? 16 : 0;
  const int total = nL + nA + nC + nFA + nFC;
  {
    const int g = blockIdx.x & 3;
    lru_load_w(P, l, g, smem);
    LruK K; lru_consts(P, l, g, K);
    for (int u = blockIdx.x >> 2; u < NB_ * 132; u += gridDim.x >> 2) lru_tile(P, l, u / 132, u % 132, g, smem, false, K);
  }
  int stage = 0;
  for (;;) {
    __syncthreads();
    if (TIDX == 0) *s_item = stage == 0 ? atomicAdd(&P.qctr[8 + qi * 8 + (blockIdx.x & 7)], 1) : atomicAdd(&P.qctr[qi], 1);
    __syncthreads();
    int it = *s_item;
    int kind = -1, b = 0, head = 0, row0 = 0, nk = 0;
    if (stage == 0) {
      if (it >= 256) { stage = 1; continue; }
      const int pair = (blockIdx.x & 7) + 8 * (it >> 6);
      b = pair >> 2; head = pair & 3; row0 = TC + b * SEQ + (it & 63) * 128; nk = KV; kind = 0;
    } else {
      if (it >= total) break;
      if (it < nC) { b = it >> 3; head = (it >> 1) & 3; row0 = b * CL + (it & 1) * 128; nk = CL; kind = 0; }
      else if (it < nC + nFA) { kind = 1; it -= nC; }
      else { kind = 2; it -= nC + nFA; }
    }
    if (kind == 0) attn_item(P, l, b, head, row0, nk, smem);
    else if (kind == 1) fftA_item(P, it, smem);
    else fftC_item(P, it, smem);
  }
}

DI void grid_barrier(unsigned* bar, unsigned k, unsigned xn, unsigned nx) {
  asm volatile("s_waitcnt vmcnt(0)" ::: "memory");
  __syncthreads();
  if (threadIdx.x == 0) {
    const unsigned x = (unsigned)__builtin_amdgcn_s_getreg((3 << 11) | 20) & 0x7u;
    unsigned* xc = bar + 16 + x * 16; unsigned* top = bar;
    const unsigned old = __hip_atomic_fetch_add(xc, 1u, __ATOMIC_RELAXED, __HIP_MEMORY_SCOPE_AGENT);
    if (old == k * xn - 1u) {
      __builtin_amdgcn_fence(__ATOMIC_RELEASE, "agent");
      asm volatile("s_waitcnt vmcnt(0)" ::: "memory");
      __hip_atomic_fetch_add(top, 1u, __ATOMIC_RELAXED, __HIP_MEMORY_SCOPE_AGENT);
    }
    while (__hip_atomic_load(top, __ATOMIC_RELAXED, __HIP_MEMORY_SCOPE_AGENT) < k * nx) __builtin_amdgcn_s_sleep(1);
    __builtin_amdgcn_fence(__ATOMIC_ACQUIRE, "agent");
    asm volatile("s_waitcnt vmcnt(0)" ::: "memory");
  }
  __syncthreads();
}
__global__ void __launch_bounds__(256, 1) fwd_megakernel(Params Pin) {
  Params P = Pin; bind_ws(P);
  __shared__ __attribute__((aligned(16))) char smem[147456 + 8192];
  __shared__ int tb[33];
  __shared__ int s_item;
  cg::grid_group grid = cg::this_grid();
  unsigned* bar = (unsigned*)(P.ws + O_bar); unsigned bk = 0;
  if (threadIdx.x == 0) __hip_atomic_fetch_add(bar + 160 + ((unsigned)__builtin_amdgcn_s_getreg((3 << 11) | 20) & 0x7u), 1u, __ATOMIC_RELAXED, __HIP_MEMORY_SCOPE_AGENT);
#ifndef PH
#define PH 0xFFFF
#endif
#if PH & 1
  phase0(P, smem);
#endif
  grid.sync();
  unsigned xn, nx = 0;
  {
    const unsigned myx = (unsigned)__builtin_amdgcn_s_getreg((3 << 11) | 20) & 0x7u;
    xn = __hip_atomic_load(bar + 160 + myx, __ATOMIC_RELAXED, __HIP_MEMORY_SCOPE_AGENT);
#pragma unroll
    for (int x = 0; x < 8; x++) nx += __hip_atomic_load(bar + 160 + x, __ATOMIC_RELAXED, __HIP_MEMORY_SCOPE_AGENT) != 0u;
  }
  for (int l = 0; l < 2; l++) {
#if PH & 2
    row1_phase(P, l == 0 ? -1 : 0, l, 0);
#endif
    grid_barrier(bar, ++bk, xn, nx);
#if PH & 4
    gemm_in_phase(P, l, smem);
#ifdef DUP_GEMM
    grid_barrier(bar, ++bk, xn, nx);
    gemm_in_phase(P, l, smem);
#endif
#endif
    grid_barrier(bar, ++bk, xn, nx);
#if PH & 8
    mix_phase(P, l, smem, &s_item, l);
#ifdef DUP_MIX
    grid_barrier(bar, ++bk, xn, nx);
    mix_phase(P, l, smem, &s_item, 2 + l);
#endif
#endif
    grid_barrier(bar, ++bk, xn, nx);
#if PH & 16
    if (blockIdx.x >= gridDim.x - 16) lru_carry_item(P, gridDim.x - 1 - blockIdx.x);
    for (int it = blockIdx.x; it < 1024; it += gridDim.x) fftB_item(P, it, smem);
#endif
    grid_barrier(bar, ++bk, xn, nx);
#if PH & 512
    {
      const int g = blockIdx.x & 3;
      LruK K{};
      for (int u = blockIdx.x >> 2; u < NB_ * 132; u += gridDim.x >> 2) lru_tile(P, l, u / 132, u % 132, g, smem, true, K);
    }
#endif
    grid_barrier(bar, ++bk, xn, nx);
#if PH & 32
    gemm_out_phase(P, l, smem);
#endif
    grid_barrier(bar, ++bk, xn, nx);
#if PH & 64
    row2_phase(P, l, l == 0 ? 0 : TC, smem);
#endif
    grid_barrier(bar, ++bk, xn, nx);
#if PH & 128
    moe_e1_phase(P, l, smem, tb);
#ifdef DUP_GEMM
    grid_barrier(bar, ++bk, xn, nx);
    moe_e1_phase(P, l, smem, tb);
#endif
#endif
    grid_barrier(bar, ++bk, xn, nx);
#if PH & 256
    moe_e2_phase(P, l, smem, tb);
#ifdef DUP_GEMM
    grid_barrier(bar, ++bk, xn, nx);
    moe_e2_phase(P, l, smem, tb);
#endif
#endif
    grid_barrier(bar, ++bk, xn, nx);
  }
#if PH & 2
  row1_phase(P, 1, -1, TC);
#endif
}

extern "C" void kernel_launch(void* const* d_in, const int* in_sizes, int n_in, void* d_out, int out_size, void* d_ws, size_t ws_size,
                              hipStream_t stream) {
  static int grid_blocks = 0;
  if (!grid_blocks) {
    int dev = 0, cus = 0, per_cu = 0;
    hipGetDevice(&dev);
    hipDeviceGetAttribute(&cus, hipDeviceAttributeMultiprocessorCount, dev);
    hipOccupancyMaxActiveBlocksPerMultiprocessor(&per_cu, fwd_megakernel, 256, 0);
    if (per_cu > 2) per_cu = 2;
    grid_blocks = cus * per_cu;
    if (grid_blocks > 256) grid_blocks = 256;
  }
  if (grid_blocks != 256) { fprintf(stderr, "need 256 co-resident blocks, have %d\n", grid_blocks); return; }
  Params p{};
  const float** pin = (const float**)&p;
  for (int i = 0; i < 31; i++) pin[i] = (const float*)d_in[i];
  p.out = (float*)d_out;
  p.ws = (char*)d_ws;
  if (WS_NEED > ws_size) { fprintf(stderr, "workspace too small: need %zu have %zu\n", (size_t)WS_NEED, ws_size); return; }
  hipMemsetAsync((char*)d_ws + O_bar, 0, 1024, stream);
  void* args[] = {&p};
  hipError_t e = hipLaunchCooperativeKernel((void*)fwd_megakernel, dim3(grid_blocks), dim3(256), args, 0, stream);
  if (e != hipSuccess) fprintf(stderr, "cooperative launch failed: %s (grid %d)\n", hipGetErrorString(e), grid_blocks);
}
```

```cpp
#include <hip/hip_runtime.h>
#include <hip/hip_cooperative_groups.h>
#include <cstdio>
namespace cg = cooperative_groups;

typedef _Float16 half_t;
typedef _Float16 h8 __attribute__((ext_vector_type(8)));
typedef _Float16 h4 __attribute__((ext_vector_type(4)));
typedef __fp16 fp16x2 __attribute__((ext_vector_type(2)));
typedef unsigned u4 __attribute__((ext_vector_type(4)));
typedef float f4 __attribute__((ext_vector_type(4)));
typedef float f16v __attribute__((ext_vector_type(16)));
#define DI __device__ __forceinline__
__device__ __forceinline__ int tid_opaque() { int t = threadIdx.x; asm volatile("" : "+v"(t)); return t; }
#define TIDX tid_opaque()

constexpr int D = 1024, NB_ = 8, SEQ = 8192, CL = 256;
constexpr int TC = NB_ * CL;
constexpr int TX = NB_ * SEQ;
constexpr int TA = TC + TX;
constexpr int KV = CL + SEQ;
constexpr int NIN = 2560;
constexpr int LCAP = 2 * TA;
constexpr float EPS = 1e-6f;

struct Params {
  const float *x, *c, *ctx, *c_ctx, *w_mod, *b_mod, *norm1_g, *norm2_g, *w_in, *q_norm_g, *k_norm_g, *lq1, *lk1, *lq2, *lk2,
      *subln_g, *conv_w, *conv_b, *gate_a_w, *gate_a_b, *gate_x_w, *gate_x_b, *lru_lambda, *w_out, *w_group, *b_group,
      *w_router, *b_router, *w1, *w3, *w2;
  float* out; char* ws;
  half_t *WtIn, *WtOut, *Wt1, *Wt3, *Wt2;
  float* mod; float2* rope; float2* tw; half_t *DA, *DB, *DC; float* consts; int* cnt; int* qctr; float* tokW; int* list; float* listW;
  float* xcbuf; half_t* WrH;
  half_t *hx, *mix, *q, *kall, *vT, *QF, *gy, *rr; float2* lsum; float* lcar; half_t* GA; half_t *H, *yA;
};


constexpr size_t al256(size_t x) { return (x + 255) & ~(size_t)255; }
constexpr size_t O_WtIn = 0;
constexpr size_t O_WtOut = O_WtIn + al256((size_t)2 * NIN * 1024 * 2);
constexpr size_t O_Wt1 = O_WtOut + al256((size_t)2 * 1024 * 1024 * 2);
constexpr size_t O_Wt3 = O_Wt1 + al256((size_t)64 * 524288 * 2);
constexpr size_t O_Wt2 = O_Wt3 + al256((size_t)64 * 524288 * 2);
constexpr size_t O_mod = O_Wt2 + al256((size_t)64 * 524288 * 2);
constexpr size_t O_rope = O_mod + al256((size_t)2 * 9 * 6144 * 4);
constexpr size_t O_tw = O_rope + al256(128 * 16 * 8);
constexpr size_t O_DA = O_tw + al256(8192 * 8);
constexpr size_t O_DB = O_DA + al256(16384 * 2);
constexpr size_t O_DC = O_DB + al256(32768 * 2);
constexpr size_t O_consts = O_DC + al256(131072 * 2);
constexpr size_t O_cnt = O_consts + 256;
constexpr size_t O_qctr = O_cnt + 256;
constexpr size_t O_bar = O_qctr + 256;
constexpr size_t O_tokW = O_bar + 1024;
constexpr size_t O_list = O_tokW + al256((size_t)2 * TA * 4);
constexpr size_t O_listW = O_list + al256((size_t)32 * LCAP * 4);
constexpr size_t O_xcbuf = O_listW + al256((size_t)32 * LCAP * 4);
constexpr size_t O_WrT = O_xcbuf + al256((size_t)TC * D * 4);
constexpr size_t O_hx = O_WrT + al256((size_t)2 * 2 * 48 * 1024 * 2);
constexpr size_t O_mix = O_hx + al256((size_t)TA * D * 2);
constexpr size_t O_regB = O_mix + al256((size_t)TA * D * 2);
constexpr size_t O_q = O_regB;
constexpr size_t O_kall = O_q + al256((size_t)TA * 512 * 2);
constexpr size_t O_vT = O_kall + al256((size_t)NB_ * KV * 512 * 2);
constexpr size_t O_QF = O_vT + al256((size_t)NB_ * 4 * 128 * KV * 2);
constexpr size_t O_gy = O_QF + al256((size_t)TA * 512 * 2);
constexpr size_t O_rr = O_gy + al256((size_t)TA * 256 * 2);
constexpr size_t O_lsum = O_rr + al256((size_t)TA * 256 * 2);
constexpr size_t O_lcar = O_lsum + al256((size_t)16 * 132 * 256 * 8);
constexpr size_t O_GA = O_lcar + al256((size_t)16 * 132 * 256 * 4);
constexpr size_t O_mixer_end = O_GA + al256((size_t)NB_ * 64 * 256 * 256 * 2);
constexpr size_t O_H = O_regB;
constexpr size_t O_yA = O_H + al256((size_t)(2 * TA + 32 * 256) * 512 * 2);
constexpr size_t O_moe_end = O_yA + al256((size_t)2 * TA * D * 2);
constexpr size_t WS_NEED = O_mixer_end > O_moe_end ? O_mixer_end : O_moe_end;
DI void bind_ws(Params& P) {
  char* w = P.ws;
  P.WtIn = (half_t*)(w + O_WtIn); P.WtOut = (half_t*)(w + O_WtOut); P.Wt1 = (half_t*)(w + O_Wt1); P.Wt3 = (half_t*)(w + O_Wt3); P.Wt2 = (half_t*)(w + O_Wt2);
  P.mod = (float*)(w + O_mod); P.rope = (float2*)(w + O_rope); P.tw = (float2*)(w + O_tw); P.DA = (half_t*)(w + O_DA); P.DB = (half_t*)(w + O_DB); P.DC = (half_t*)(w + O_DC);
  P.consts = (float*)(w + O_consts); P.cnt = (int*)(w + O_cnt); P.qctr = (int*)(w + O_qctr); P.tokW = (float*)(w + O_tokW); P.list = (int*)(w + O_list); P.listW = (float*)(w + O_listW);
  P.xcbuf = (float*)(w + O_xcbuf); P.WrH = (half_t*)(w + O_WrT); P.hx = (half_t*)(w + O_hx); P.mix = (half_t*)(w + O_mix);
  P.q = (half_t*)(w + O_q); P.kall = (half_t*)(w + O_kall); P.vT = (half_t*)(w + O_vT); P.QF = (half_t*)(w + O_QF); P.gy = (half_t*)(w + O_gy); P.rr = (half_t*)(w + O_rr);
  P.lsum = (float2*)(w + O_lsum); P.lcar = (float*)(w + O_lcar); P.GA = (half_t*)(w + O_GA); P.H = (half_t*)(w + O_H); P.yA = (half_t*)(w + O_yA);
}
DI float shx(float v, int o) { int ln = TIDX & 63; return __builtin_bit_cast(float, __builtin_amdgcn_ds_bpermute((ln ^ o) << 2, __builtin_bit_cast(int, v))); }
DI float shi(float v, int idx) { return __builtin_bit_cast(float, __builtin_amdgcn_ds_bpermute(idx << 2, __builtin_bit_cast(int, v))); }
DI float wave_sum(float v) {
#pragma unroll
  for (int o = 32; o; o >>= 1) v += shx(v, o);
  return v;
}
DI void glds16(const void* g, void* l) {
  __builtin_amdgcn_global_load_lds((const unsigned*)g, (unsigned*)l, 16, 0, 0);
}
DI void wait_vm0() { asm volatile("s_waitcnt vmcnt(0)" ::: "memory"); }
DI f4 mfma16(h8 a, h8 b, f4 c) { return __builtin_amdgcn_mfma_f32_16x16x32_f16(a, b, c, 0, 0, 0); }
DI f16v mfma32(h8 a, h8 b, f16v c) { return __builtin_amdgcn_mfma_f32_32x32x16_f16(a, b, c, 0, 0, 0); }
DI unsigned pk2(float a, float b) { fp16x2 r = __builtin_amdgcn_cvt_pkrtz(a, b); return __builtin_bit_cast(unsigned, r); }
DI float sigmoidf_(float x) { return 1.f / (1.f + __expf(-x)); }
DI float gelu_tanh(float x) {
  float u = 0.7978845608028654f * (x + 0.044715f * x * x * x);
  float e = __expf(2.f * u);
  float t = 1.f - 2.f / (e + 1.f);
  return 0.5f * x * (1.f + t);
}
DI int row_mod(int r) { return r < TC ? 8 : ((r - TC) >> 13); }

DI void transpose_tile4(const float* src, int lds_, half_t* dst, int ldd, float* tile) {
  const int tid = TIDX;
  {
    const int k0 = tid >> 6, c4 = tid & 63;
    const float* sp = src + (size_t)k0 * lds_ + c4 * 4;
    float* tp = tile + (c4 >> 4) * 4352 + k0 * 68 + (c4 & 15) * 4;
#pragma unroll
    for (int i = 0; i < 16; i++) *(float4*)(tp + i * 4 * 68) = *(const float4*)(sp + (size_t)i * 4 * lds_);
  }
  __syncthreads();
#pragma unroll
  for (int i = 0; i < 8; i++) {
    int idx = i * 256 + tid, j = idx >> 9, r = idx & 511, kc = r >> 6, n = r & 63;
    const float* t = tile + j * 4352 + kc * 8 * 68 + n;
    h8 o;
#pragma unroll
    for (int u = 0; u < 8; u++) o[u] = (half_t)t[u * 68];
    *(h8*)(dst + (size_t)(j * 64 + n) * ldd + kc * 8) = o;
  }
  __syncthreads();
}

DI void phase0(const Params& P, char* smem) {
  float* tile = (float*)smem;
  const int tid = TIDX;
  constexpr int NT = 6528, NF = 128, NM = 192, NX = 6;
  for (int t = blockIdx.x; t < NT + NF + NM + NX; t += gridDim.x) {
    if (t < NT) {
      const float* src; half_t* dst; int lds_, ldd;
      if (t < 256) {
        int l = t / 128, r = t % 128, kt = r / 8, nt = (r % 8) * 4;
        src = P.w_in + (size_t)l * 1024 * 2304 + (size_t)kt * 64 * 2304 + 256 + nt * 64; lds_ = 2304;
        dst = P.WtIn + (size_t)l * NIN * 1024 + (size_t)(512 + nt * 64) * 1024 + kt * 64; ldd = 1024;
      } else if (t < 384) {
        int u = t - 256, l = u / 64, r = u % 64, kt = r / 4, nt = (r % 4) * 4;
        src = P.w_out + (size_t)l * 1048576 + (size_t)kt * 64 * 1024 + nt * 64; lds_ = 1024;
        dst = P.WtOut + (size_t)l * 1048576 + (size_t)nt * 64 * 1024 + kt * 64; ldd = 1024;
      } else if (t < 384 + 4096) {
        int u = t - 384; const float* w = P.w1; half_t* o = P.Wt1;
        if (u >= 2048) { u -= 2048; w = P.w3; o = P.Wt3; }
        int le = u / 32, r = u % 32, kt = r / 2, nt = (r % 2) * 4;
        src = w + (size_t)le * 524288 + (size_t)kt * 64 * 512 + nt * 64; lds_ = 512;
        dst = o + (size_t)le * 524288 + (size_t)nt * 64 * 1024 + kt * 64; ldd = 1024;
      } else {
        int u = t - 384 - 4096, le = u / 32, r = u % 32, kt = r / 4, nt = (r % 4) * 4;
        src = P.w2 + (size_t)le * 524288 + (size_t)kt * 64 * 1024 + nt * 64; lds_ = 1024;
        dst = P.Wt2 + (size_t)le * 524288 + (size_t)nt * 64 * 512 + kt * 64; ldd = 512;
      }
      transpose_tile4(src, lds_, dst, ldd, tile);
    } else if (t < NT + NF) {
      int f = t - NT, l = f / 64, r = f % 64, kt = r / 4, g = r % 4;
      float* cst = tile + 64 * 65; float* snt = cst + 64;
      const float* src = P.w_in + (size_t)l * 1024 * 2304 + (size_t)kt * 64 * 2304 + g * 64;
      { int n = tid & 63, kq = tid >> 6;
        for (int i = 0; i < 16; i++) { int k = i * 4 + kq; tile[k * 65 + n] = src[(size_t)k * 2304 + n]; } }
      if (tid < 64) { float s, c; sincospif((float)tid / 32.f, &s, &c); cst[tid] = c; snt[tid] = s; }
      __syncthreads();
      int k = tid & 63, jq = tid >> 6;
      half_t* o = P.WtIn + (size_t)l * NIN * 1024 + kt * 64 + k;
      for (int jj = 0; jj < 16; jj++) {
        int j = jq * 16 + jj; float ac = 0.f, as = 0.f;
        for (int c = 0; c < 64; c++) { float v = tile[k * 65 + c]; int idx = (c * j) & 63; ac += v * cst[idx]; as += v * snt[idx]; }
        o[(size_t)(g * 64 + j) * 1024] = (half_t)(ac * 0.125f);
        o[(size_t)(256 + g * 64 + j) * 1024] = (half_t)(-as * 0.125f);
      }
      __syncthreads();
    } else if (t < NT + NF + NM) {
      int mi = t - NT - NF, l = mi / 96, col0 = (mi % 96) * 64;
      float* scond = tile; float* red = tile + 9216;
      for (int idx = tid; idx < 9216; idx += 256) {
        int n = idx >> 10, k = idx & 1023; float v = n < 8 ? P.c[n * 1024 + k] : P.c_ctx[k];
        scond[idx] = v / (1.f + expf(-v));
      }
      __syncthreads();
      int col = tid & 63, kq = tid >> 6; float acc[9];
#pragma unroll
      for (int n = 0; n < 9; n++) acc[n] = 0.f;
      const float* w = P.w_mod + ((size_t)l * 1024 + kq * 256) * 6144 + col0 + col;
#pragma unroll 16
      for (int k = 0; k < 256; k++) {
        float wv = w[(size_t)k * 6144];
#pragma unroll
        for (int n = 0; n < 9; n++) acc[n] += scond[n * 1024 + kq * 256 + k] * wv;
      }
#pragma unroll
      for (int n = 0; n < 9; n++) red[(kq * 9 + n) * 64 + col] = acc[n];
      __syncthreads();
      for (int idx = tid; idx < 576; idx += 256) {
        int n = idx / 64, cc = idx % 64;
        float s = red[(0 * 9 + n) * 64 + cc] + red[(1 * 9 + n) * 64 + cc] + red[(2 * 9 + n) * 64 + cc] + red[(3 * 9 + n) * 64 + cc];
        P.mod[(size_t)(l * 9 + n) * 6144 + col0 + cc] = s + P.b_mod[l * 6144 + col0 + cc];
      }
      __syncthreads();
    } else {
      int m = t - NT - NF - NM;
      if (m == 0) {
        for (int idx = tid; idx < 128 * 16; idx += 256) {
          int pos = idx >> 4, i = idx & 15; float f = powf(10000.f, -(float)i / 16.f); float ang = (float)pos * f;
          float s, c; sincosf(ang, &s, &c); P.rope[idx] = make_float2(c, s);
        }
      } else if (m == 1) {
        for (int j = tid; j < 8192; j += 256) { float s, c; sincospif((float)j / 4096.f, &s, &c); P.tw[j] = make_float2(c, s); }
      } else if (m == 2) {
        for (int idx = tid; idx < 16384; idx += 256) {
          int mm = idx >> 7, k = idx & 127, part = mm >> 6, f1 = mm & 63, pp = k >> 6, a = k & 63;
          float s, c; sincospif((float)((a * f1) & 63) / 32.f, &s, &c);
          float v = part == 0 ? (pp == 0 ? c : s) : (pp == 0 ? -s : c);
          P.DA[idx] = (half_t)(v * 0.125f);
        }
      } else if (m == 3) {
        for (int idx = tid; idx < 32768; idx += 256) {
          int mm = idx >> 8, k = idx & 255, part = k >> 7, bb = k & 127;
          float s, c; sincospif((float)((bb * mm) & 127) / 64.f, &s, &c);
          P.DB[idx] = (half_t)((part == 0 ? c : s) * 0.08838834764831845f);
        }
      } else if (m == 4) {
        for (int idx = tid; idx < 131072; idx += 256) {
          int mm = idx >> 9, k = idx & 511, part = k >> 8, tt = k & 255;
          float s, c; sincospif((float)((tt * mm) & 255) / 128.f, &s, &c);
          P.DC[idx] = (half_t)((part == 0 ? c : s) * 0.0625f);
        }
      } else {
        for (int idx = tid; idx < 2 * 48 * 1024; idx += 256) {
          int l = idx / 49152, r = idx % 49152, col = r >> 10, k = r & 1023;
          float w = col < 4 ? P.w_group[((size_t)l * 1024 + k) * 4 + col] : (col < 36 ? P.w_router[((size_t)l * 1024 + k) * 32 + col - 4] : 0.f);
          half_t hi = (half_t)w, lo = (half_t)(w - (float)hi);
          P.WrH[(size_t)(l * 2) * 49152 + r] = hi; P.WrH[(size_t)(l * 2 + 1) * 49152 + r] = lo;
        }
        if (tid < 2) {
          int l = tid; float s1 = 0.f, s2 = 0.f, mq = 0.f, mk = 0.f;
          for (int i = 0; i < 64; i++) {
            s1 += P.lq1[l * 64 + i] * P.lk1[l * 64 + i]; s2 += P.lq2[l * 64 + i] * P.lk2[l * 64 + i];
            mq = fmaxf(mq, fabsf(P.q_norm_g[l * 64 + i])); mk = fmaxf(mk, fabsf(P.k_norm_g[l * 64 + i]));
          }
          float lam_init = 0.8f - 0.6f * expf(-0.3f * (float)l);
          P.consts[l * 4 + 0] = expf(s1) - expf(s2) + lam_init;
          P.consts[l * 4 + 1] = 8.f * mq * mk * 1.4426950408889634f * 1.002f - 15.f;
          P.consts[l * 4 + 2] = lam_init;
        }
        if (tid < 64) P.cnt[tid] = 0;
        if (tid < 64) P.qctr[tid] = 0;
      }
    }
  }
}

DI void row1_phase(const Params& P, int combine_l, int norm_l, int r_begin) {
  const int lane = TIDX & 63, gw = blockIdx.x * 4 + (TIDX >> 6), nw = gridDim.x * 4;
  auto load_row = [&](int r, float4 (&xv)[4], h4 (&ya)[4], h4 (&yb)[4]) {
    if (combine_l < 0) {
      const float* src = r < TC ? P.ctx + (size_t)r * D : P.x + (size_t)(r - TC) * D;
#pragma unroll
      for (int i = 0; i < 4; i++) xv[i] = *(const float4*)(src + i * 256 + lane * 4);
    } else {
      const float* xm = r < TC ? P.xcbuf + (size_t)r * D : P.out + (size_t)(r - TC) * D;
      const half_t* y0 = P.yA + (size_t)(2 * r) * D; const half_t* y1 = y0 + D;
#pragma unroll
      for (int i = 0; i < 4; i++) { int c = i * 256 + lane * 4; xv[i] = *(const float4*)(xm + c); ya[i] = *(const h4*)(y0 + c); yb[i] = *(const h4*)(y1 + c); }
    }
  };
  auto process = [&](int r, float4 (&xv)[4], h4 (&ya)[4], h4 (&yb)[4]) {
    const int n = row_mod(r);
    if (combine_l >= 0) {
      float* xm = r < TC ? P.xcbuf + (size_t)r * D : P.out + (size_t)(r - TC) * D;
      const float* g2 = P.mod + (size_t)(combine_l * 9 + n) * 6144 + 5 * 1024;
#pragma unroll
      for (int i = 0; i < 4; i++) {
        int c = i * 256 + lane * 4;
        float4 g = *(const float4*)(g2 + c); float4 t = xv[i];
        t.x += g.x * ((float)ya[i][0] + (float)yb[i][0]); t.y += g.y * ((float)ya[i][1] + (float)yb[i][1]);
        t.z += g.z * ((float)ya[i][2] + (float)yb[i][2]); t.w += g.w * ((float)ya[i][3] + (float)yb[i][3]);
        *(float4*)(xm + c) = t; xv[i] = t;
      }
    }
    if (norm_l >= 0) {
      float ss = 0.f;
#pragma unroll
      for (int i = 0; i < 4; i++) ss += xv[i].x * xv[i].x + xv[i].y * xv[i].y + xv[i].z * xv[i].z + xv[i].w * xv[i].w;
      ss = wave_sum(ss);
      const float rstd = rsqrtf(ss * (1.f / 1024.f) + EPS);
      const float* g = P.norm1_g + norm_l * 1024;
      const float* sh = P.mod + (size_t)(norm_l * 9 + n) * 6144; const float* sc = sh + 1024;
#pragma unroll
      for (int i = 0; i < 4; i++) {
        int c = i * 256 + lane * 4;
        float4 gg = *(const float4*)(g + c), s1 = *(const float4*)(sc + c), s0 = *(const float4*)(sh + c);
        h4 o;
        o[0] = (half_t)(xv[i].x * rstd * gg.x * (1.f + s1.x) + s0.x); o[1] = (half_t)(xv[i].y * rstd * gg.y * (1.f + s1.y) + s0.y);
        o[2] = (half_t)(xv[i].z * rstd * gg.z * (1.f + s1.z) + s0.z); o[3] = (half_t)(xv[i].w * rstd * gg.w * (1.f + s1.w) + s0.w);
        *(h4*)(P.hx + (size_t)r * D + c) = o;
      }
    }
  };
#pragma unroll 1
  for (int r = r_begin + gw; r < TA; r += 4 * nw) {
    float4 x0[4], x1[4], x2[4], x3[4]; h4 a0[4], b0[4], a1[4], b1[4], a2[4], b2[4], a3[4], b3[4];
    const int r1 = r + nw, r2 = r + 2 * nw, r3 = r + 3 * nw;
    load_row(r, x0, a0, b0);
    if (r1 < TA) load_row(r1, x1, a1, b1);
    if (r2 < TA) load_row(r2, x2, a2, b2);
    if (r3 < TA) load_row(r3, x3, a3, b3);
    process(r, x0, a0, b0);
    if (r1 < TA) process(r1, x1, a1, b1);
    if (r2 < TA) process(r2, x2, a2, b2);
    if (r3 < TA) process(r3, x3, a3, b3);
  }
}

DI void row2_phase(const Params& P, int l, int r_begin, char* smem) {
  const int tid = TIDX, lane = tid & 63, wave = tid >> 6, fr = lane & 15, fq = lane >> 4;
  float* lg = (float*)smem + wave * 16 * 48;
  const half_t* Whi = P.WrH + (size_t)(l * 2) * 49152; const half_t* Wlo = Whi + 49152;
  const int ngroups = (TA - r_begin) >> 4, gw = blockIdx.x * 4 + wave, nw = gridDim.x * 4;
  const float* gam = P.norm2_g + l * 1024;
#pragma unroll 1
  for (int grp = gw; grp < ngroups; grp += nw) {
    const int r0 = r_begin + grp * 16, row = r0 + fr, n = row_mod(r0);
    const float* xm = (row < TC ? P.xcbuf + (size_t)row * D : P.out + (size_t)(row - TC) * D) + fq * 8;
    float ss = 0.f;
#pragma unroll 16
    for (int kk = 0; kk < 32; kk++) {
      const float4 a = *(const float4*)(xm + kk * 32), b = *(const float4*)(xm + kk * 32 + 4);
      ss += a.x * a.x + a.y * a.y + a.z * a.z + a.w * a.w + b.x * b.x + b.y * b.y + b.z * b.z + b.w * b.w;
    }
    ss += shx(ss, 16); ss += shx(ss, 32);
    const float rstd = rsqrtf(ss * (1.f / 1024.f) + EPS);
    const float* sh = P.mod + (size_t)(l * 9 + n) * 6144 + 3 * 1024 + fq * 8; const float* sc = sh + 1024;
    f4 acc[3];
#pragma unroll
    for (int i = 0; i < 3; i++) acc[i] = (f4){0.f, 0.f, 0.f, 0.f};
    half_t* hxo = P.hx + (size_t)row * D + fq * 8;
#pragma unroll 4
    for (int kk = 0; kk < 32; kk++) {
      const int k0 = kk * 32;
      float x[8], g[8], s1[8], s0[8];
      *(float4*)&x[0] = *(const float4*)(xm + k0); *(float4*)&x[4] = *(const float4*)(xm + k0 + 4);
      *(float4*)&g[0] = *(const float4*)(gam + fq * 8 + k0); *(float4*)&g[4] = *(const float4*)(gam + fq * 8 + k0 + 4);
      *(float4*)&s1[0] = *(const float4*)(sc + k0); *(float4*)&s1[4] = *(const float4*)(sc + k0 + 4);
      *(float4*)&s0[0] = *(const float4*)(sh + k0); *(float4*)&s0[4] = *(const float4*)(sh + k0 + 4);
      h8 hi, lo;
#pragma unroll
      for (int i = 0; i < 8; i++) {
        float v = x[i] * rstd * g[i] * (1.f + s1[i]) + s0[i];
        hi[i] = (half_t)v; lo[i] = (half_t)(v - (float)hi[i]);
      }
      *(h8*)(hxo + k0) = hi;
#pragma unroll
      for (int n3 = 0; n3 < 3; n3++) {
        h8 bh = *(const h8*)(Whi + (size_t)(n3 * 16 + fr) * 1024 + k0 + fq * 8);
        h8 bl = *(const h8*)(Wlo + (size_t)(n3 * 16 + fr) * 1024 + k0 + fq * 8);
        acc[n3] = mfma16(hi, bh, acc[n3]); acc[n3] = mfma16(lo, bh, acc[n3]); acc[n3] = mfma16(hi, bl, acc[n3]);
      }
    }
    __builtin_amdgcn_wave_barrier();
#pragma unroll
    for (int n3 = 0; n3 < 3; n3++)
#pragma unroll
      for (int j = 0; j < 4; j++) lg[(fq * 4 + j) * 48 + n3 * 16 + fr] = acc[n3][j];
    __builtin_amdgcn_wave_barrier();
    if (lane < 16) {
      const int r = r0 + lane;
      const float* L = lg + lane * 48;
      float gl[4]; int gi = 0;
#pragma unroll
      for (int j = 0; j < 4; j++) gl[j] = L[j] + P.b_group[l * 4 + j];
      float gm = gl[0];
#pragma unroll
      for (int j = 1; j < 4; j++) if (gl[j] > gm) { gm = gl[j]; gi = j; }
      float gs = 0.f;
#pragma unroll
      for (int j = 0; j < 4; j++) gs += expf(gl[j] - gm);
      const float pg = 1.f / gs;
      float el[8];
#pragma unroll
      for (int j = 0; j < 8; j++) el[j] = L[4 + gi * 8 + j] + P.b_router[l * 32 + gi * 8 + j];
      int i0 = 0; float v0 = el[0];
#pragma unroll
      for (int j = 1; j < 8; j++) if (el[j] > v0) { v0 = el[j]; i0 = j; }
      int i1 = -1; float v1 = -3.0e38f;
#pragma unroll
      for (int j = 0; j < 8; j++) if (j != i0 && el[j] > v1) { v1 = el[j]; i1 = j; }
      const float ex = expf(v1 - v0);
      const float w0 = pg / (1.f + ex), w1 = pg * ex / (1.f + ex);
      const int e0 = gi * 8 + i0, e1 = gi * 8 + i1;
      int p0 = atomicAdd(&P.cnt[l * 32 + e0], 1); P.list[(size_t)e0 * LCAP + p0] = 2 * r; P.listW[(size_t)e0 * LCAP + p0] = w0;
      int p1 = atomicAdd(&P.cnt[l * 32 + e1], 1); P.list[(size_t)e1 * LCAP + p1] = 2 * r + 1; P.listW[(size_t)e1 * LCAP + p1] = w1;
    }
    __builtin_amdgcn_wave_barrier();
  }
}

DI h8 lds128(unsigned a) { h8 r; asm volatile("ds_read_b128 %0, %1" : "=v"(r) : "v"(a)); return r; }
DI void tie(h8& x) { asm volatile("" : "+v"(x)); }
DI unsigned lds_addr(const void* p) { return (unsigned)(size_t)p; }
#define WAIT_LGKM(n) asm volatile("s_waitcnt lgkmcnt(" #n ")" ::: "memory")
DI void raw_barrier() { asm volatile("" ::: "memory"); __builtin_amdgcn_s_barrier(); asm volatile("" ::: "memory"); }
DI void slot_rc(int i, int& row, int& coff) { int s = i * 256 + TIDX; row = s >> 3; coff = ((s & 7) ^ ((row >> 1) & 7)) * 8; }

template <class AF, class BF>
DI void gemm_prologue(AF aptr, BF bptr, int nk, char* smem) {
  const int tid = TIDX;
#pragma unroll
  for (int st = 0; st < 2; st++) {
    if (st < nk) {
      char* d = smem + st * 49152 + tid * 16;
#pragma unroll
      for (int i = 0; i < 8; i++) glds16(aptr(i) + st * 64, d + i * 4096);
#pragma unroll
      for (int i = 0; i < 4; i++) glds16(bptr(i) + st * 64, d + 32768 + i * 4096);
    }
  }
}
template <bool PRE = false, class AF, class BF>
DI void gemm256(AF aptr, BF bptr, int nk, char* smem, f4 (&acc)[8][4]) {
  const int tid = TIDX, lane = tid & 63, wave = tid >> 6, fr = lane & 15, fq = lane >> 4, wr = wave >> 1, wc = wave & 1;
#pragma unroll
  for (int m = 0; m < 8; m++)
#pragma unroll
    for (int n = 0; n < 4; n++) acc[m][n] = (f4){0.f, 0.f, 0.f, 0.f};
  auto issue = [&](int kt, int st) {
    char* d = smem + st * 49152 + tid * 16;
#pragma unroll
    for (int i = 0; i < 8; i++) glds16(aptr(i) + kt * 64, d + i * 4096);
#pragma unroll
    for (int i = 0; i < 4; i++) glds16(bptr(i) + kt * 64, d + 32768 + i * 4096);
  };
  const unsigned sw = (unsigned)((fq ^ (fr >> 1)) << 4);
  const unsigned offA = (wr * 128 + fr) * 128 + sw, offB = 32768 + (wc * 64 + fr) * 128 + sw;
  const unsigned sbase = lds_addr(smem);
  if (!PRE) { issue(0, 0); if (nk > 1) issue(1, 1); }
  int st = 0;
#pragma unroll 1
  for (int kt = 0; kt < nk; kt++) {
    if (kt + 1 < nk) asm volatile("s_waitcnt vmcnt(12)" ::: "memory"); else wait_vm0();
    raw_barrier();
    if (kt + 2 < nk) issue(kt + 2, st == 0 ? 2 : st - 1);
    const unsigned base = sbase + st * 49152;
    st = st == 2 ? 0 : st + 1;
    h8 a0[8], b0[4], a1[8], b1[4];
#pragma unroll
    for (int m = 0; m < 8; m++) a0[m] = lds128(base + offA + m * 2048);
#pragma unroll
    for (int n = 0; n < 4; n++) b0[n] = lds128(base + offB + n * 2048);
#pragma unroll
    for (int m = 0; m < 8; m++) a1[m] = lds128(base + (offA ^ 64) + m * 2048);
#pragma unroll
    for (int n = 0; n < 4; n++) b1[n] = lds128(base + (offB ^ 64) + n * 2048);
    WAIT_LGKM(12);
#pragma unroll
    for (int m = 0; m < 8; m++) tie(a0[m]);
#pragma unroll
    for (int n = 0; n < 4; n++) tie(b0[n]);
#pragma unroll
    for (int m = 0; m < 8; m++)
#pragma unroll
      for (int n = 0; n < 4; n++) acc[m][n] = mfma16(a0[m], b0[n], acc[m][n]);
    WAIT_LGKM(0);
#pragma unroll
    for (int m = 0; m < 8; m++) tie(a1[m]);
#pragma unroll
    for (int n = 0; n < 4; n++) tie(b1[n]);
#pragma unroll
    for (int m = 0; m < 8; m++)
#pragma unroll
      for (int n = 0; n < 4; n++) acc[m][n] = mfma16(a1[m], b1[n], acc[m][n]);
  }
  raw_barrier();
}
DI bool xcd_tile(int it, int MT, int NT, int& mt, int& nt) {
  const int x = blockIdx.x & 7, j = blockIdx.x >> 3;
  const int nsn = NT >> 2, nsm = (MT + 7) >> 3;
  const int s = x + 8 * it;
  if (s >= nsm * nsn) return false;
  const int sm = s / nsn, sn = s % nsn;
  mt = sm * 8 + (j >> 2); nt = sn * 4 + (j & 3);
  return true;
}
DI bool next_tile(int& it, int MT, int NT, int& mt, int& nt) {
  for (;; it++) {
    if (!xcd_tile(it, MT, NT, mt, nt)) return false;
    if (mt < MT) return true;
  }
}
DI int slot_col() { int t = TIDX; return ((t & 7) ^ ((t >> 4) & 7)) * 8; }

DI float dpp_row_sum(float v) {
  v += __builtin_bit_cast(float, __builtin_amdgcn_update_dpp(0, __builtin_bit_cast(int, v), 0x128, 0xf, 0xf, false));
  v += __builtin_bit_cast(float, __builtin_amdgcn_update_dpp(0, __builtin_bit_cast(int, v), 0x124, 0xf, 0xf, false));
  v += __builtin_bit_cast(float, __builtin_amdgcn_update_dpp(0, __builtin_bit_cast(int, v), 0x122, 0xf, 0xf, false));
  v += __builtin_bit_cast(float, __builtin_amdgcn_update_dpp(0, __builtin_bit_cast(int, v), 0x121, 0xf, 0xf, false));
  return v;
}
DI void stage_put(char* stg, int ml, int n, int j, int fr, int fq, float v) { *(half_t*)(stg + (ml * 16 + fq * 4 + j) * 144 + (n * 16 + fr) * 2) = (half_t)v; }
template <class RP, class SC>
DI void stage_flush(char* stg, int h, RP rowptr, SC rowscale) {
  const int lane = TIDX & 63;
  __builtin_amdgcn_wave_barrier();
#pragma unroll
  for (int i = 0; i < 8; i++) {
    const int c = i * 64 + lane, row = c >> 3, c16 = c & 7;
    h8 v = *(const h8*)(stg + row * 144 + c16 * 16);
    half_t* d = rowptr(h * 64 + row);
    if (d) { rowscale(h * 64 + row, v); *(h8*)(d + c16 * 8) = v; }
  }
  __builtin_amdgcn_wave_barrier();
}
template <class VF, class RP, class SC>
DI void wave_store_tile(VF val, char* stg, RP rowptr, SC rowscale) {
  const int lane = TIDX & 63, fr = lane & 15, fq = lane >> 4;
#pragma unroll
  for (int h = 0; h < 2; h++) {
#pragma unroll
    for (int ml = 0; ml < 4; ml++)
#pragma unroll
      for (int n = 0; n < 4; n++)
#pragma unroll
        for (int j = 0; j < 4; j++) stage_put(stg, ml, n, j, fr, fq, val(h * 4 + ml, n, j));
    stage_flush(stg, h, rowptr, rowscale);
  }
}
DI void gemm_in_phase(const Params& P, int l, char* smem) {
  const int tid = TIDX;
  const half_t* Wt = P.WtIn + (size_t)l * NIN * 1024;
  const int sc = slot_col(), srow = tid >> 3;
  {
    float2* rcl = (float2*)(smem + 147456);
    for (int i = tid; i < 1024; i += 256) rcl[i] = P.rope[i];
    __syncthreads();
  }
  int it = 0, mt, nt;
  bool have = next_tile(it, 264, 20, mt, nt);
  const half_t* a0 = nullptr; const half_t* b0 = nullptr;
  if (have) {
    asm volatile("" : "+s"(mt), "+s"(nt));
    a0 = P.hx + (size_t)(mt * 256 + srow) * D + sc; b0 = Wt + (size_t)(nt * 128 + srow) * D + sc;
    gemm_prologue([&](int i) { return a0 + (size_t)i * 32 * D; }, [&](int i) { return b0 + (size_t)i * 32 * D; }, 16, smem);
  }
#pragma unroll 1
  while (have) {
    f4 acc[8][4];
    gemm256<true>([&](int i) { return a0 + (size_t)i * 32 * D; }, [&](int i) { return b0 + (size_t)i * 32 * D; }, 16, smem, acc);
    const int tid2 = TIDX, lane = tid2 & 63, wave = tid2 >> 6, fr = lane & 15, fq = lane >> 4, wr = wave >> 1, wc = wave & 1;
    const int r0 = mt * 256 + wr * 128;
    const bool isctx = r0 < TC;
    int b, pos0;
    if (isctx) { b = r0 >> 8; pos0 = r0 & 255; } else { b = (r0 - TC) >> 13; pos0 = 256 + ((r0 - TC) & 8191); }
    const bool isqk = nt >= 4 && nt < 12;
    float gg[4] = {0.f, 0.f, 0.f, 0.f}; float2 rr2[2] = {make_float2(1.f, 0.f), make_float2(1.f, 0.f)};
    if (isqk) {
      const float* gvec = (nt < 8 ? P.q_norm_g : P.k_norm_g) + l * 64;
      const float qs = nt < 8 ? 0.125f * 1.4426950408889634f : 1.f;
#pragma unroll
      for (int n = 0; n < 4; n++) gg[n] = gvec[n * 16 + fr] * qs;
      if (!isctx) { const int tp0 = pos0 - 256; rr2[0] = P.rope[(tp0 >> 6) * 16 + fr]; rr2[1] = P.rope[((tp0 >> 6) + 1) * 16 + fr]; }
    }
#pragma unroll
    for (int n = 0; n < 4; n++) asm volatile("" : "+v"(gg[n]));
    asm volatile("" : "+v"(rr2[0].x), "+v"(rr2[0].y), "+v"(rr2[1].x), "+v"(rr2[1].y));
    int it2 = it + 1, mt2, nt2;
    const bool have2 = next_tile(it2, 264, 20, mt2, nt2);
    const half_t* a1 = a0; const half_t* b1 = b0;
    if (have2) {
      asm volatile("" : "+s"(mt2), "+s"(nt2));
      a1 = P.hx + (size_t)(mt2 * 256 + srow) * D + sc; b1 = Wt + (size_t)(nt2 * 128 + srow) * D + sc;
      gemm_prologue([&](int i) { return a1 + (size_t)i * 32 * D; }, [&](int i) { return b1 + (size_t)i * 32 * D; }, 16, smem);
    }
    char* stg = smem + 98304 + wave * 12288;
    auto noscale = [](int, h8&) {};
    if (nt < 4 || nt >= 16) {
      half_t* dst; int ld, c0; bool gel = false;
      if (nt < 4) { dst = P.QF; ld = 512; c0 = nt * 128; }
      else if (nt < 18) { dst = P.gy; ld = 256; c0 = (nt - 16) * 128; gel = true; }
      else { dst = P.rr; ld = 256; c0 = (nt - 18) * 128; }
      half_t* base = dst + (size_t)r0 * ld + c0 + wc * 64;
      if (gel) wave_store_tile([&](int m, int n, int j) { return gelu_tanh(acc[m][n][j]); }, stg, [&](int r) { return base + (size_t)r * ld; }, noscale);
      else wave_store_tile([&](int m, int n, int j) { return acc[m][n][j]; }, stg, [&](int r) { return base + (size_t)r * ld; }, noscale);
    } else if (nt < 12) {
      const bool isq = nt < 8; const int head = isq ? nt - 4 : nt - 8;
      const float2* rcl = (const float2*)(smem + 147456);
      half_t* base = (isq ? P.q + (size_t)r0 * 512 : P.kall + ((size_t)b * KV + pos0) * 512) + head * 128 + wc * 64;
#pragma unroll
      for (int mh = 0; mh < 2; mh++) {
#pragma unroll
        for (int mm = 0; mm < 4; mm++) {
          const int m = mh * 4 + mm;
#pragma unroll
          for (int j = 0; j < 4; j++) {
            float ss = 0.f;
#pragma unroll
            for (int n = 0; n < 4; n++) ss += acc[m][n][j] * acc[m][n][j];
            ss = dpp_row_sum(ss);
            const float rstd = rsqrtf(ss * (1.f / 64.f) + EPS);
            float o[4];
#pragma unroll
            for (int n = 0; n < 4; n++) o[n] = acc[m][n][j] * rstd * gg[n];
            if (!isctx) {
              const float2 cr = rr2[mh], cc = rcl[(mm * 16 + fq * 4 + j) * 16 + fr];
              float a0 = o[0] * cr.x - o[1] * cr.y, a1 = o[1] * cr.x + o[0] * cr.y;
              float a2 = o[2] * cc.x - o[3] * cc.y, a3 = o[3] * cc.x + o[2] * cc.y;
              o[0] = a0; o[1] = a1; o[2] = a2; o[3] = a3;
            }
#pragma unroll
            for (int n = 0; n < 4; n++) stage_put(stg, mm, n, j, fr, fq, o[n]);
          }
        }
        stage_flush(stg, mh, [&](int r) { return base + (size_t)r * 512; }, noscale);
      }
    } else {
      const int head = nt - 12;
#pragma unroll
      for (int m = 0; m < 8; m++)
#pragma unroll
        for (int n = 0; n < 4; n++) {
          h4 o; o[0] = (half_t)acc[m][n][0]; o[1] = (half_t)acc[m][n][1]; o[2] = (half_t)acc[m][n][2]; o[3] = (half_t)acc[m][n][3];
          int d = wc * 64 + n * 16 + fr;
          asm volatile("" : "+v"(d) :: "memory");
          *(h4*)(P.vT + ((size_t)(b * 4 + head) * 128 + d) * KV + pos0 + m * 16 + fq * 4) = o;
        }
    }
    mt = mt2; nt = nt2; it = it2; have = have2; a0 = a1; b0 = b1;
  }
}

DI void gemm_out_phase(const Params& P, int l, char* smem) {
  const int tid = TIDX;
  const half_t* Wt = P.WtOut + (size_t)l * 1048576;
  const int mt0 = l == 0 ? 0 : TC / 256;
  const int MT = 264 - mt0;
  const int sc = slot_col(), srow = tid >> 3;
  int it = 0, mt, nt;
  bool have = next_tile(it, MT, 8, mt, nt);
  const half_t* a0 = nullptr; const half_t* b0 = nullptr;
  if (have) {
    asm volatile("" : "+s"(mt), "+s"(nt));
    a0 = P.mix + (size_t)((mt + mt0) * 256 + srow) * D + sc; b0 = Wt + (size_t)(nt * 128 + srow) * D + sc;
    gemm_prologue([&](int i) { return a0 + (size_t)i * 32 * D; }, [&](int i) { return b0 + (size_t)i * 32 * D; }, 16, smem);
  }
#pragma unroll 1
  while (have) {
    f4 acc[8][4];
    gemm256<true>([&](int i) { return a0 + (size_t)i * 32 * D; }, [&](int i) { return b0 + (size_t)i * 32 * D; }, 16, smem, acc);
    const int tid2 = TIDX, lane2 = tid2 & 63, wave2 = tid2 >> 6, fr2 = lane2 & 15, fq2 = lane2 >> 4, wr2 = wave2 >> 1, wc2 = wave2 & 1;
    const int r0 = (mt + mt0) * 256 + wr2 * 128;
    const int n = row_mod(r0);
    const int cbase = nt * 128 + wc2 * 64;
    const float* res; float* dst;
    if (r0 < TC) { res = P.ctx + (size_t)r0 * D; dst = P.xcbuf + (size_t)r0 * D; }
    else { dst = P.out + (size_t)(r0 - TC) * D; res = l == 0 ? P.x + (size_t)(r0 - TC) * D : dst; }
    res += cbase + fr2 * 4; dst += cbase + fr2 * 4;
    const float4 g4 = *(const float4*)(P.mod + (size_t)(l * 9 + n) * 6144 + 2 * 1024 + cbase + fr2 * 4);
    float4 rres[4][8];
#pragma unroll
    for (int q = 0; q < 4; q++)
#pragma unroll
      for (int i = 0; i < 8; i++) rres[q][i] = *(const float4*)(res + (size_t)(q * 32 + i * 4 + fq2) * D);
    int it2 = it + 1, mt2, nt2;
    const bool have2 = next_tile(it2, MT, 8, mt2, nt2);
    const half_t* a1 = a0; const half_t* b1 = b0;
    if (have2) {
      asm volatile("" : "+s"(mt2), "+s"(nt2));
      a1 = P.mix + (size_t)((mt2 + mt0) * 256 + srow) * D + sc; b1 = Wt + (size_t)(nt2 * 128 + srow) * D + sc;
      gemm_prologue([&](int i) { return a1 + (size_t)i * 32 * D; }, [&](int i) { return b1 + (size_t)i * 32 * D; }, 16, smem);
    }
    {
      float* stg = (float*)(smem + 98304 + wave2 * 12288);
#pragma unroll
      for (int q = 0; q < 4; q++) {
#pragma unroll
        for (int ml = 0; ml < 2; ml++)
#pragma unroll
          for (int nn = 0; nn < 4; nn++)
#pragma unroll
            for (int j = 0; j < 4; j++) stg[(ml * 16 + fq2 * 4 + j) * 68 + nn * 16 + fr2] = acc[q * 2 + ml][nn][j];
        __builtin_amdgcn_wave_barrier();
#pragma unroll
        for (int i = 0; i < 8; i++) {
          const int row = i * 4 + fq2;
          const float4 a = *(const float4*)(stg + row * 68 + fr2 * 4);
          float4 r = rres[q][i];
          r.x += g4.x * a.x; r.y += g4.y * a.y; r.z += g4.z * a.z; r.w += g4.w * a.w;
          *(float4*)(dst + (size_t)(q * 32 + row) * D) = r;
        }
        __builtin_amdgcn_wave_barrier();
      }
    }
    mt = mt2; nt = nt2; it = it2; have = have2; a0 = a1; b0 = b1;
  }
}

DI void moe_prefix(const Params& P, int l, int* tb) {
  __syncthreads();
  if (TIDX == 0) { int s = 0; for (int e = 0; e < 32; e++) { tb[e] = s; s += (P.cnt[l * 32 + e] + 255) >> 8; } tb[32] = s; }
  __syncthreads();
}
DI void moe_e1_phase(const Params& P, int l, char* smem, int* tb) {
  const int tid = TIDX;
  moe_prefix(P, l, tb);
  const int sc = slot_col(), srow = tid >> 3;
  const int MT = tb[32];
  auto setup = [&](int rt, int nt, int (&tok)[8], const half_t*& w1, const half_t*& w3) {
    int e = 0;
    while (tb[e + 1] <= rt) e++;
    const int rl = rt - tb[e], cnt = P.cnt[l * 32 + e];
    const int* lst = P.list + (size_t)e * LCAP;
    w1 = P.Wt1 + ((size_t)(l * 32 + e) * 512 + nt * 64) * 1024 + sc;
    w3 = P.Wt3 + ((size_t)(l * 32 + e) * 512 + nt * 64) * 1024 + sc;
#pragma unroll
    for (int i = 0; i < 8; i++) tok[i] = lst[min(rl * 256 + i * 32 + srow, cnt - 1)] >> 1;
  };
  int it = 0, rt, nt;
  bool have = next_tile(it, MT, 8, rt, nt);
  int tok[8]; const half_t* w1 = nullptr; const half_t* w3 = nullptr;
  if (have) {
    asm volatile("" : "+s"(rt), "+s"(nt));
    setup(rt, nt, tok, w1, w3);
    gemm_prologue([&](int i) { return P.hx + (size_t)tok[i] * D + sc; }, [&](int i) { return ((i & 1) ? w3 : w1) + (size_t)((i >> 1) * 32 + srow) * 1024; }, 16, smem);
  }
#pragma unroll 1
  while (have) {
    int it2 = it + 1, rt2, nt2;
    const bool have2 = next_tile(it2, MT, 8, rt2, nt2);
    int tok2[8]; const half_t* w1n = w1; const half_t* w3n = w3;
#pragma unroll
    for (int i = 0; i < 8; i++) tok2[i] = tok[i];
    if (have2) {
      asm volatile("" : "+s"(rt2), "+s"(nt2));
      setup(rt2, nt2, tok2, w1n, w3n);
    }
    f4 acc[8][4];
    gemm256<true>([&](int i) { return P.hx + (size_t)tok[i] * D + sc; },
                  [&](int i) { return ((i & 1) ? w3 : w1) + (size_t)((i >> 1) * 32 + srow) * 1024; }, 16, smem, acc);
    if (have2) {
      gemm_prologue([&](int i) { return P.hx + (size_t)tok2[i] * D + sc; }, [&](int i) { return ((i & 1) ? w3n : w1n) + (size_t)((i >> 1) * 32 + srow) * 1024; }, 16, smem);
    }
    {
      const int tid2 = TIDX, lane2 = tid2 & 63, wave2 = tid2 >> 6, fr2 = lane2 & 15, fq2 = lane2 >> 4, wr2 = wave2 >> 1, wc2 = wave2 & 1;
      char* stg = smem + 98304 + wave2 * 12288;
      half_t* Hd = P.H + ((size_t)rt * 256 + wr2 * 128) * 512 + nt * 64 + wc2 * 32;
#pragma unroll
      for (int h = 0; h < 2; h++) {
#pragma unroll
        for (int ml = 0; ml < 4; ml++)
#pragma unroll
          for (int n = 0; n < 2; n++)
#pragma unroll
            for (int j = 0; j < 4; j++) {
              float a1 = acc[h * 4 + ml][n][j], a3 = acc[h * 4 + ml][n + 2][j];
              *(half_t*)(stg + (ml * 16 + fq2 * 4 + j) * 80 + (n * 16 + fr2) * 2) = (half_t)(a1 * sigmoidf_(a1) * a3);
            }
        __builtin_amdgcn_wave_barrier();
#pragma unroll
        for (int i = 0; i < 4; i++) {
          const int c = i * 64 + lane2, row = c >> 2, c16 = c & 3;
          h8 v = *(const h8*)(stg + row * 80 + c16 * 16);
          *(h8*)(Hd + (size_t)(h * 64 + row) * 512 + c16 * 8) = v;
        }
        __builtin_amdgcn_wave_barrier();
      }
    }
    rt = rt2; nt = nt2; it = it2; have = have2; w1 = w1n; w3 = w3n;
#pragma unroll
    for (int i = 0; i < 8; i++) tok[i] = tok2[i];
  }
}
DI void moe_e2_phase(const Params& P, int l, char* smem, int* tb) {
  const int tid = TIDX;
  moe_prefix(P, l, tb);
  const int sc = slot_col(), srow = tid >> 3;
  const int MT = tb[32];
  auto ptrs = [&](int rt, int nt, const half_t*& a0, const half_t*& b0) {
    int e = 0;
    while (tb[e + 1] <= rt) e++;
    a0 = P.H + ((size_t)rt * 256 + srow) * 512 + sc;
    b0 = P.Wt2 + ((size_t)(l * 32 + e) * 1024 + nt * 128 + srow) * 512 + sc;
  };
  int it = 0, rt, nt;
  bool have = next_tile(it, MT, 8, rt, nt);
  const half_t* a0 = nullptr; const half_t* b0 = nullptr;
  if (have) {
    asm volatile("" : "+s"(rt), "+s"(nt));
    ptrs(rt, nt, a0, b0);
    gemm_prologue([&](int i) { return a0 + (size_t)i * 32 * 512; }, [&](int i) { return b0 + (size_t)i * 32 * 512; }, 8, smem);
  }
#pragma unroll 1
  while (have) {
    const int tid2 = TIDX, lane2 = tid2 & 63, wave2 = tid2 >> 6, wr2 = wave2 >> 1, wc2 = wave2 & 1;
    int e = 0;
    while (tb[e + 1] <= rt) e++;
    const int rl = rt - tb[e], cnt = P.cnt[l * 32 + e];
    const int* lst = P.list + (size_t)e * LCAP; const float* lstw = P.listW + (size_t)e * LCAP;
    int aa[2][8]; float ww[2][8];
#pragma unroll
    for (int h = 0; h < 2; h++)
#pragma unroll
      for (int i = 0; i < 8; i++) {
        const int idx = rl * 256 + wr2 * 128 + h * 64 + ((i * 64 + lane2) >> 3);
        const int ic = min(idx, cnt - 1);
        const int av = lst[ic]; const float wv = lstw[ic];
        aa[h][i] = idx < cnt ? av : -1; ww[h][i] = wv;
      }
    f4 acc[8][4];
    gemm256<true>([&](int i) { return a0 + (size_t)i * 32 * 512; }, [&](int i) { return b0 + (size_t)i * 32 * 512; }, 8, smem, acc);
    int it2 = it + 1, rt2, nt2;
    const bool have2 = next_tile(it2, MT, 8, rt2, nt2);
    const half_t* a1 = a0; const half_t* b1 = b0;
    if (have2) {
      asm volatile("" : "+s"(rt2), "+s"(nt2));
      ptrs(rt2, nt2, a1, b1);
      gemm_prologue([&](int i) { return a1 + (size_t)i * 32 * 512; }, [&](int i) { return b1 + (size_t)i * 32 * 512; }, 8, smem);
    }
    {
      char* stg = smem + 98304 + wave2 * 12288;
      const int fr2 = lane2 & 15, fq2 = lane2 >> 4;
#pragma unroll
      for (int h = 0; h < 2; h++) {
#pragma unroll
        for (int ml = 0; ml < 4; ml++)
#pragma unroll
          for (int n = 0; n < 4; n++)
#pragma unroll
            for (int j = 0; j < 4; j++) stage_put(stg, ml, n, j, fr2, fq2, acc[h * 4 + ml][n][j]);
        __builtin_amdgcn_wave_barrier();
#pragma unroll
        for (int i = 0; i < 8; i++) {
          const int c = i * 64 + lane2, row = c >> 3, c16 = c & 7;
          h8 v = *(const h8*)(stg + row * 144 + c16 * 16);
          if (aa[h][i] >= 0) {
            const float w = ww[h][i];
#pragma unroll
            for (int u = 0; u < 8; u++) v[u] = (half_t)(w * (float)v[u]);
            *(h8*)(P.yA + (size_t)aa[h][i] * D + nt * 128 + wc2 * 64 + c16 * 8) = v;
          }
        }
        __builtin_amdgcn_wave_barrier();
      }
    }
    rt = rt2; nt = nt2; it = it2; have = have2; a0 = a1; b0 = b1;
  }
}

DI int swap23(int x) { return (x & ~12) | ((x & 4) << 1) | ((x & 8) >> 1); }
DI void attn_item(const Params& P, int l, int b, int head, int row0, int nkeys, char* smem) {
  const int tid = TIDX, lane = tid & 63, wave = tid >> 6, ql = lane & 31, hh = lane >> 5;
  const float lam = P.consts[l * 4 + 0], negc = -P.consts[l * 4 + 1], lam_init = P.consts[l * 4 + 2];
  const int myrow = row0 + wave * 32 + ql;
  h8 qf[2][4];
  {
    const half_t* qp = P.q + (size_t)myrow * 512 + head * 128 + hh * 8;
#pragma unroll
    for (int m = 0; m < 2; m++)
#pragma unroll
      for (int s = 0; s < 4; s++) { qf[m][s] = *(const h8*)(qp + m * 64 + s * 16); }
#pragma unroll
    for (int m = 0; m < 2; m++)
#pragma unroll
      for (int s = 0; s < 4; s++) tie(qf[m][s]);
  }
  f16v o0[4], o1[4];
#pragma unroll
  for (int dt = 0; dt < 4; dt++)
#pragma unroll
    for (int i = 0; i < 16; i++) { o0[dt][i] = 0.f; o1[dt][i] = 0.f; }
  float ls0 = 0.f, ls1 = 0.f;
  const half_t* kp[4]; const half_t* vp[4];
  {
    const half_t* kbase = P.kall + (size_t)b * KV * 512 + head * 128;
    const half_t* vbase = P.vT + (size_t)(b * 4 + head) * 128 * KV;
#pragma unroll
    for (int i = 0; i < 4; i++) {
      int s = i * 256 + tid;
      int row = s >> 4, c = (s & 15) ^ (row & 15); kp[i] = kbase + (size_t)row * 512 + c * 8;
      int vr = s >> 3, vc = (s & 7) ^ ((vr >> 1) & 7); vp[i] = vbase + (size_t)vr * KV + vc * 8;
    }
  }
  const int ntile = nkeys >> 6;
  const unsigned sbase = lds_addr(smem);
  auto issue = [&](int t) {
    char* d = smem + (t & 3) * 32768 + tid * 16;
#pragma unroll
    for (int i = 0; i < 4; i++) { glds16(kp[i] + (size_t)t * 64 * 512, d + i * 4096); glds16(vp[i] + t * 64, d + 16384 + i * 4096); }
  };
  unsigned koff[2];
  const int kr_lo = swap23(ql), ksw = kr_lo & 15;
  koff[0] = kr_lo * 256; koff[1] = (32 + kr_lo) * 256;
  unsigned voff[4];
#pragma unroll
  for (int dt = 0; dt < 4; dt++) { int vrow = dt * 32 + ql; voff[dt] = 16384 + vrow * 128; }
  const int vsw = (ql >> 1) & 7;
  f16v negcv;
#pragma unroll
  for (int i = 0; i < 16; i++) negcv[i] = negc;
  h8 pp0[2], pp1[2];
  unsigned pendV = 0; int pendkt = 0; bool pend = false;
  auto half_step = [&](h8 (&kf)[8], unsigned cur, int kt) {
    h8 vf[8];
    if (pend) {
#pragma unroll
      for (int sp = 0; sp < 2; sp++)
#pragma unroll
        for (int dt = 0; dt < 4; dt++) vf[sp * 4 + dt] = lds128(pendV + voff[dt] + (((pendkt * 4 + sp * 2 + hh) ^ vsw) << 4));
    }
    f16v s0 = mfma32(kf[0], qf[0][0], negcv), s1 = mfma32(kf[4], qf[1][0], negcv);
#pragma unroll
    for (int st = 1; st < 4; st++) { s0 = mfma32(kf[st], qf[0][st], s0); s1 = mfma32(kf[4 + st], qf[1][st], s1); }
    if (pend) {
      WAIT_LGKM(0);
#pragma unroll
      for (int i = 0; i < 8; i++) tie(vf[i]);
#pragma unroll
      for (int sp = 0; sp < 2; sp++)
#pragma unroll
        for (int dt = 0; dt < 4; dt++) { o0[dt] = mfma32(vf[sp * 4 + dt], pp0[sp], o0[dt]); o1[dt] = mfma32(vf[sp * 4 + dt], pp1[sp], o1[dt]); }
    }
#pragma unroll
    for (int i = 0; i < 16; i++) { s0[i] = __builtin_amdgcn_exp2f(s0[i]); ls0 += s0[i]; s1[i] = __builtin_amdgcn_exp2f(s1[i]); ls1 += s1[i]; }
#pragma unroll
    for (int sp = 0; sp < 2; sp++) {
      u4 a, c;
      a[0] = pk2(s0[8*sp+0], s0[8*sp+1]); a[1] = pk2(s0[8*sp+2], s0[8*sp+3]); a[2] = pk2(s0[8*sp+4], s0[8*sp+5]); a[3] = pk2(s0[8*sp+6], s0[8*sp+7]);
      c[0] = pk2(s1[8*sp+0], s1[8*sp+1]); c[1] = pk2(s1[8*sp+2], s1[8*sp+3]); c[2] = pk2(s1[8*sp+4], s1[8*sp+5]); c[3] = pk2(s1[8*sp+6], s1[8*sp+7]);
      pp0[sp] = __builtin_bit_cast(h8, a); pp1[sp] = __builtin_bit_cast(h8, c);
    }
    pend = true; pendV = cur; pendkt = kt;
  };
  issue(0);
  if (ntile > 1) issue(1);
#pragma unroll 1
  for (int t = 0; t < ntile; t++) {
    if (t + 1 < ntile) asm volatile("s_waitcnt vmcnt(8)" ::: "memory"); else wait_vm0();
    raw_barrier();
    if (t + 2 < ntile) issue(t + 2);
    const unsigned cur = sbase + (t & 3) * 32768;
    h8 kfa[8], kfb[8];
#pragma unroll
    for (int st = 0; st < 4; st++) {
      kfa[st] = lds128(cur + koff[0] + (((st * 2 + hh) ^ ksw) << 4));
      kfa[4 + st] = lds128(cur + koff[0] + (((8 + st * 2 + hh) ^ ksw) << 4));
    }
#pragma unroll
    for (int st = 0; st < 4; st++) {
      kfb[st] = lds128(cur + koff[1] + (((st * 2 + hh) ^ ksw) << 4));
      kfb[4 + st] = lds128(cur + koff[1] + (((8 + st * 2 + hh) ^ ksw) << 4));
    }
    WAIT_LGKM(8);
#pragma unroll
    for (int i = 0; i < 8; i++) tie(kfa[i]);
    half_step(kfa, cur, 0);
    WAIT_LGKM(0);
#pragma unroll
    for (int i = 0; i < 8; i++) tie(kfb[i]);
    half_step(kfb, cur, 1);
  }
  {
    h8 vf[8];
#pragma unroll
    for (int sp = 0; sp < 2; sp++)
#pragma unroll
      for (int dt = 0; dt < 4; dt++) vf[sp * 4 + dt] = lds128(pendV + voff[dt] + (((pendkt * 4 + sp * 2 + hh) ^ vsw) << 4));
    WAIT_LGKM(0);
#pragma unroll
    for (int i = 0; i < 8; i++) tie(vf[i]);
#pragma unroll
    for (int sp = 0; sp < 2; sp++)
#pragma unroll
      for (int dt = 0; dt < 4; dt++) { o0[dt] = mfma32(vf[sp * 4 + dt], pp0[sp], o0[dt]); o1[dt] = mfma32(vf[sp * 4 + dt], pp1[sp], o1[dt]); }
  }
  raw_barrier();
  ls0 += shx(ls0, 32); ls1 += shx(ls1, 32);
  const float i0 = 1.f / ls0, i1 = lam / ls1;
  float ss = 0.f;
#pragma unroll
  for (int dt = 0; dt < 4; dt++)
#pragma unroll
    for (int i = 0; i < 16; i++) { float v = o0[dt][i] * i0 - o1[dt][i] * i1; o0[dt][i] = v; ss += v * v; }
  ss += shx(ss, 32);
  const float mult = rsqrtf(ss * (1.f / 128.f) + EPS) * (1.f - lam_init);
  const float* sg = P.subln_g + l * 128;
  half_t* dst = P.mix + (size_t)myrow * D + 256 + head * 128;
#pragma unroll
  for (int dt = 0; dt < 4; dt++)
#pragma unroll
    for (int g = 0; g < 4; g++) {
      const int d0 = dt * 32 + 8 * g + 4 * hh;
      float4 gv = *(const float4*)(sg + d0);
      h4 o; o[0] = (half_t)(o0[dt][4*g] * mult * gv.x); o[1] = (half_t)(o0[dt][4*g+1] * mult * gv.y);
      o[2] = (half_t)(o0[dt][4*g+2] * mult * gv.z); o[3] = (half_t)(o0[dt][4*g+3] * mult * gv.w);
      *(h4*)(dst + d0) = o;
    }
}

DI int swz128(int row, int colh) { return row * 128 + ((((colh >> 3)) ^ ((row >> 1) & 7)) << 4) + (colh & 7) * 2; }
DI void lru_load_w(const Params& P, int l, int g, char* Wt) {
  const int tid = TIDX;
  for (int dg = 0; dg < 4; dg++) {
    const int dir = dg >> 1;
    const float* w = ((dg & 1) ? P.gate_x_w : P.gate_a_w) + ((size_t)((l * 2 + dir) * 4 + g)) * 4096;
    for (int idx = tid; idx < 4096; idx += 256) { int i = idx >> 6, o = idx & 63; *(half_t*)(Wt + dg * 8192 + swz128(o, i)) = (half_t)w[idx]; }
  }
}
struct LruK { float ba[2][4], bx[2][4], sp8[2][4], cw[5]; };
DI void lru_consts(const Params& P, int l, int g, LruK& K) {
  const int tid = TIDX, fr = tid & 15, gc = g * 64 + (tid & 63);
#pragma unroll
  for (int dir = 0; dir < 2; dir++)
#pragma unroll
    for (int n = 0; n < 4; n++) {
      const int cc = (l * 2 + dir) * 256 + g * 64 + n * 16 + fr;
      K.ba[dir][n] = P.gate_a_b[cc]; K.bx[dir][n] = P.gate_x_b[cc]; K.sp8[dir][n] = -8.f * log1pf(__expf(-P.lru_lambda[cc]));
    }
#pragma unroll
  for (int k = 0; k < 4; k++) K.cw[k] = P.conv_w[(l * 4 + k) * 256 + gc];
  K.cw[4] = P.conv_b[l * 256 + gc];
}
DI void lru_tile(const Params& P, int l, int b, int tile, int g, char* smem, bool final, const LruK& K) {
  const int tid = TIDX, lane = tid & 63, wave = tid >> 6, fr = lane & 15, fq = lane >> 4;
  char* Wt = smem;
  char* xr16 = smem + 32768;
  float2* ab = (float2*)(smem + 40960);
  half_t* raw = (half_t*)(smem + 40960);
  float2* subst = (float2*)(smem + 73728);
  const int ch = tid & 63, tq = tid >> 6, gc = g * 64 + ch;
  const int T = tile < 4 ? CL : SEQ;
  const int t0 = tile < 4 ? tile * 64 : (tile - 4) * 64;
  const int rowbase = tile < 4 ? b * CL : TC + b * SEQ;
  unsigned* lab = (unsigned*)P.hx;
  __syncthreads();
  if (final) {
    float gyv[16], hsum[16];
#pragma unroll
    for (int e = 0; e < 16; e++) { gyv[e] = (float)P.gy[(size_t)(rowbase + t0 + tq * 16 + e) * 256 + gc]; hsum[e] = 0.f; }
    unsigned pk0[16], pk1[16];
#pragma unroll
    for (int e = 0; e < 16; e++) { pk0[e] = lab[((size_t)rowbase + t0 + tq * 16 + e) * 256 + gc]; pk1[e] = lab[((size_t)TA + rowbase + t0 + tq * 16 + e) * 256 + gc]; }
    const float car0 = P.lcar[((size_t)((b * 2 + 0) * 132 + tile)) * 256 + gc], car1 = P.lcar[((size_t)((b * 2 + 1) * 132 + tile)) * 256 + gc];
#pragma unroll 1
    for (int dir = 0; dir < 2; dir++) {
      unsigned pk[16];
#pragma unroll
      for (int e = 0; e < 16; e++) pk[e] = dir == 0 ? pk0[e] : pk1[e];
      float2 av[16];
      float A = 1.f, h = 0.f;
#pragma unroll
      for (int e = 0; e < 16; e++) {
        const int ee = dir == 0 ? e : 15 - e;
        unsigned u = pk[0];
#pragma unroll
        for (int q = 1; q < 16; q++) u = (q == ee) ? pk[q] : u;
        fp16x2 hv = __builtin_bit_cast(fp16x2, u);
        av[e] = make_float2(__expf((float)hv[0]), (float)hv[1]);
        h = av[e].x * h + av[e].y; A *= av[e].x;
      }
      subst[tq * 64 + ch] = make_float2(A, h);
      __syncthreads();
      h = dir == 0 ? car0 : car1;
      if (dir == 0) { for (int s2 = 0; s2 < tq; s2++) { float2 ss = subst[s2 * 64 + ch]; h = ss.x * h + ss.y; } }
      else { for (int s2 = 3; s2 > tq; s2--) { float2 ss = subst[s2 * 64 + ch]; h = ss.x * h + ss.y; } }
#pragma unroll
      for (int e = 0; e < 16; e++) {
        const int ee = dir == 0 ? e : 15 - e;
        h = av[e].x * h + av[e].y;
#pragma unroll
        for (int q = 0; q < 16; q++) hsum[q] += (q == ee) ? h : 0.f;
      }
      __syncthreads();
    }
#pragma unroll
    for (int e = 0; e < 16; e++)
      P.mix[(size_t)(rowbase + t0 + tq * 16 + e) * D + 768 + gc] = (half_t)(gyv[e] * hsum[e]);
    return;
  }
  for (int idx = tid; idx < 67 * 8; idx += 256) {
    int row = idx >> 3, c = idx & 7, tt = t0 - 1 + row;
    h8 v = {0, 0, 0, 0, 0, 0, 0, 0};
    if (tt >= 0 && tt < T) v = *(const h8*)(P.rr + (size_t)(rowbase + tt) * 256 + g * 64 + c * 8);
    *(h8*)(raw + row * 64 + c * 8) = v;
  }
  const float cw0 = K.cw[0], cw1 = K.cw[1], cw2 = K.cw[2], cw3 = K.cw[3], cb = K.cw[4];
  __syncthreads();
  {
    float v[19];
#pragma unroll
    for (int e = 0; e < 19; e++) v[e] = (float)raw[(tq * 16 + e) * 64 + ch];
    __syncthreads();
#pragma unroll
    for (int e = 0; e < 16; e++) {
      float xv = cb + cw0 * v[e] + cw1 * v[e + 1] + cw2 * v[e + 2] + cw3 * v[e + 3];
      *(half_t*)(xr16 + swz128(tq * 16 + e, ch)) = (half_t)xv;
    }
  }
  __syncthreads();
#pragma unroll 1
  for (int dir = 0; dir < 2; dir++) {
    {
      f4 acc[2][4];
#pragma unroll
      for (int gt = 0; gt < 2; gt++)
#pragma unroll
        for (int n = 0; n < 4; n++) acc[gt][n] = (f4){0.f, 0.f, 0.f, 0.f};
#pragma unroll
      for (int kk = 0; kk < 2; kk++) {
        int row = wave * 16 + fr;
        h8 af = *(const h8*)(xr16 + row * 128 + (((kk * 4 + fq) ^ ((row >> 1) & 7)) << 4));
#pragma unroll
        for (int gt = 0; gt < 2; gt++)
#pragma unroll
          for (int n = 0; n < 4; n++) {
            int orow = n * 16 + fr;
            h8 bf = *(const h8*)(Wt + (dir * 2 + gt) * 8192 + orow * 128 + (((kk * 4 + fq) ^ ((orow >> 1) & 7)) << 4));
            acc[gt][n] = mfma16(af, bf, acc[gt][n]);
          }
      }
#pragma unroll
      for (int n = 0; n < 4; n++) {
        const float ba = dir == 0 ? K.ba[0][n] : K.ba[1][n], bx = dir == 0 ? K.bx[0][n] : K.bx[1][n], sp8 = dir == 0 ? K.sp8[0][n] : K.sp8[1][n];
#pragma unroll
        for (int j = 0; j < 4; j++) {
          int tl = wave * 16 + fq * 4 + j, c2 = n * 16 + fr;
          float xv = (float)*(const half_t*)(xr16 + swz128(tl, c2));
          float rg = sigmoidf_(acc[0][n][j] + ba), ig = sigmoidf_(acc[1][n][j] + bx);
          float log_a = rg * sp8;
          float x2 = 2.f * log_a;
          float om = -x2 * (1.f + x2 * (0.5f + x2 * (0.16666667f + x2 * (0.041666668f + x2 * (0.008333334f + x2 * 0.0013888889f)))));
          if (x2 < -0.4f) { float a = __expf(log_a); om = 1.f - a * a; }
          ab[tl * 64 + c2] = make_float2(log_a, sqrtf(om) * (ig * xv));
        }
      }
    }
    __syncthreads();
    {
      float A = 1.f, h = 0.f;
#pragma unroll
      for (int e = 0; e < 16; e++) {
        const int ee = dir == 0 ? e : 15 - e;
        const float2 lb = ab[(tq * 16 + ee) * 64 + ch];
        fp16x2 hv; hv[0] = (__fp16)lb.x; hv[1] = (__fp16)lb.y;
        lab[((size_t)dir * TA + rowbase + t0 + tq * 16 + ee) * 256 + gc] = __builtin_bit_cast(unsigned, hv);
        const float a = __expf((float)hv[0]), bt = (float)hv[1];
        h = a * h + bt; A *= a;
      }
      subst[tq * 64 + ch] = make_float2(A, h);
    }
    __syncthreads();
    if (tq == 0) {
      float A = 1.f, h = 0.f;
#pragma unroll
      for (int s2 = 0; s2 < 4; s2++) { float2 ss = subst[(dir == 0 ? s2 : 3 - s2) * 64 + ch]; h = ss.x * h + ss.y; A *= ss.x; }
      P.lsum[((size_t)((b * 2 + dir) * 132 + tile)) * 256 + gc] = make_float2(A, h);
    }
    __syncthreads();
  }
}
DI void lru_carry_item(const Params& P, int it) {
  const int ch = TIDX, dir = it & 1;
  const size_t base = (size_t)it * 132 * 256 + ch;
  float c = 0.f;
#pragma unroll 4
  for (int k = 0; k < 132; k++) {
    int tile = dir == 0 ? k : (k < 4 ? 3 - k : 135 - k);
    float2 s = P.lsum[base + (size_t)tile * 256];
    P.lcar[base + (size_t)tile * 256] = c;
    c = s.x * c + s.y;
  }
}

template <int NROWS>
DI void fft_load(const half_t* src, size_t rs, char* Bt, int rowbytes, int k0) {
  const int tid = TIDX;
  h8 v[NROWS / 16];
#pragma unroll
  for (int i = 0; i < NROWS / 16; i++) { int idx = i * 256 + tid; v[i] = *(const h8*)(src + (size_t)(idx >> 4) * rs + (idx & 15) * 8); }
#pragma unroll
  for (int i = 0; i < NROWS / 16; i++) {
    int idx = i * 256 + tid, kr = idx >> 4, cc = idx & 15, k = k0 + kr;
#pragma unroll
    for (int u = 0; u < 8; u++) { int n = cc * 8 + u; *(half_t*)(Bt + n * rowbytes + ((((k >> 3)) ^ (n & 15)) << 4) + (k & 7) * 2) = v[i][u]; }
  }
}
template <class RF>
DI void fft_mma(const half_t* Dm, int ldD, int nkk, const char* Bt, int rowbytes, f4 (&acc)[4][4], RF arow) {
  const int lane = TIDX & 63, wave = TIDX >> 6, fr = lane & 15, fq = lane >> 4, wc = wave & 1;
#pragma unroll 4
  for (int kk = 0; kk < nkk; kk++) {
    h8 af[4], bf[4];
#pragma unroll
    for (int ms = 0; ms < 4; ms++) af[ms] = *(const h8*)(Dm + (size_t)arow(ms) * ldD + kk * 32 + fq * 8);
#pragma unroll
    for (int ns = 0; ns < 4; ns++) { int n = wc * 64 + ns * 16 + fr; bf[ns] = *(const h8*)(Bt + n * rowbytes + (((kk * 4 + fq) ^ (n & 15)) << 4)); }
#pragma unroll
    for (int ms = 0; ms < 4; ms++)
#pragma unroll
      for (int ns = 0; ns < 4; ns++) acc[ms][ns] = mfma16(af[ms], bf[ns], acc[ms][ns]);
  }
}
DI void zero44(f4 (&acc)[4][4]) {
#pragma unroll
  for (int m = 0; m < 4; m++)
#pragma unroll
    for (int n = 0; n < 4; n++) acc[m][n] = (f4){0.f, 0.f, 0.f, 0.f};
}
DI void fftA_item(const Params& P, int it, char* smem) {
  const int b = it >> 8, bb = (it >> 1) & 127, chh = it & 1;
  const int lane = TIDX & 63, wave = TIDX >> 6, fr = lane & 15, fq = lane >> 4, wr = wave >> 1, wc = wave & 1;
  __syncthreads();
  fft_load<64>(P.QF + (size_t)(TC + b * SEQ + bb) * 512 + chh * 128, (size_t)128 * 512, smem, 256, 0);
  fft_load<64>(P.QF + (size_t)(TC + b * SEQ + bb) * 512 + 256 + chh * 128, (size_t)128 * 512, smem, 256, 64);
  __syncthreads();
  f4 acc[4][4]; zero44(acc);
  fft_mma(P.DA, 128, 4, smem, 256, acc, [&](int ms) { return (ms >> 1) * 64 + wr * 32 + (ms & 1) * 16 + fr; });
#pragma unroll
  for (int ms = 0; ms < 2; ms++)
#pragma unroll
    for (int j = 0; j < 4; j++) {
      const int f1 = wr * 32 + ms * 16 + fq * 4 + j;
      const float2 w = P.tw[(bb * f1) & 8191];
      half_t* d0 = P.GA + ((size_t)(b * 64 + f1) * 256 + bb) * 256 + chh * 128 + wc * 64 + fr;
#pragma unroll
      for (int ns = 0; ns < 4; ns++) {
        float gr = acc[ms][ns][j], gi = acc[ms + 2][ns][j];
        d0[ns * 16] = (half_t)(gr * w.x + gi * w.y);
        d0[(size_t)128 * 256 + ns * 16] = (half_t)(gi * w.x - gr * w.y);
      }
    }
}
DI void fftB_item(const Params& P, int it, char* smem) {
  const int b = it >> 7, f1 = (it >> 1) & 63, chh = it & 1;
  const int lane = TIDX & 63, wave = TIDX >> 6, fr = lane & 15, fq = lane >> 4, wr = wave >> 1, wc = wave & 1;
  __syncthreads();
  fft_load<256>(P.GA + (size_t)(b * 64 + f1) * 256 * 256 + chh * 128, 256, smem, 512, 0);
  __syncthreads();
  f4 acc[4][4]; zero44(acc);
  fft_mma(P.DB, 256, 8, smem, 512, acc, [&](int ms) { return wr * 64 + ms * 16 + fr; });
#pragma unroll
  for (int ms = 0; ms < 4; ms++)
#pragma unroll
    for (int j = 0; j < 4; j++) {
      const int f2 = wr * 64 + ms * 16 + fq * 4 + j;
      half_t* d0 = P.mix + (size_t)(TC + b * SEQ + f1 + 64 * f2) * D + chh * 128 + wc * 64 + fr;
#pragma unroll
      for (int ns = 0; ns < 4; ns++) d0[ns * 16] = (half_t)acc[ms][ns][j];
    }
}
DI void fftC_item(const Params& P, int it, char* smem) {
  const int b = it >> 1, chh = it & 1;
  const int lane = TIDX & 63, wave = TIDX >> 6, fr = lane & 15, fq = lane >> 4, wr = wave >> 1, wc = wave & 1;
#pragma unroll 1
  for (int mh = 0; mh < 2; mh++) {
    f4 acc[4][4]; zero44(acc);
#pragma unroll 1
    for (int part = 0; part < 2; part++) {
      __syncthreads();
      fft_load<256>(P.QF + (size_t)(b * CL) * 512 + part * 256 + chh * 128, 512, smem, 512, 0);
      __syncthreads();
      fft_mma(P.DC + part * 256, 512, 8, smem, 512, acc, [&](int ms) { return mh * 128 + wr * 64 + ms * 16 + fr; });
    }
#pragma unroll
    for (int ms = 0; ms < 4; ms++)
#pragma unroll
      for (int j = 0; j < 4; j++) {
        const int f = mh * 128 + wr * 64 + ms * 16 + fq * 4 + j;
        half_t* d0 = P.mix + (size_t)(b * CL + f) * D + chh * 128 + wc * 64 + fr;
#pragma unroll
        for (int ns = 0; ns < 4; ns++) d0[ns * 16] = (half_t)acc[ms][ns][j];
      }
  }
}

#ifndef MX
#define MX 15
#endif
DI void mix_phase(const Params& P, int l, char* smem, int* s_item, int qi) {
  const int nL = 0, nA = 0, nC = l == 0 ? 64 : 0, nFA = 2048, nFC = l == 0 ? 16 : 0;
  const int total = nL + nA + nC + nFA + nFC;
  {
    const int g = blockIdx.x & 3;
    lru_load_w(P, l, g, smem);
    LruK K; lru_consts(P, l, g, K);
    for (int u = blockIdx.x >> 2; u < NB_ * 132; u += gridDim.x >> 2) lru_tile(P, l, u / 132, u % 132, g, smem, false, K);
    asm volatile("s_waitcnt vmcnt(0)" ::: "memory");
    __syncthreads();
    if (TIDX == 0) {
      __builtin_amdgcn_fence(__ATOMIC_RELEASE, "agent");
      asm volatile("s_waitcnt vmcnt(0)" ::: "memory");
      __hip_atomic_fetch_add((unsigned*)&P.qctr[48 + l], 1u, __ATOMIC_RELAXED, __HIP_MEMORY_SCOPE_AGENT);
    }
  }
  int stage = 0;
  for (;;) {
    __syncthreads();
    if (TIDX == 0) *s_item = stage == 0 ? atomicAdd(&P.qctr[8 + qi * 8 + (blockIdx.x & 7)], 1) : atomicAdd(&P.qctr[qi], 1);
    __syncthreads();
    int it = *s_item;
    int kind = -1, b = 0, head = 0, row0 = 0, nk = 0;
    if (stage == 0) {
      if (it >= 256) {
        stage = 1;
        if (blockIdx.x >= gridDim.x - 16) {
          if (TIDX == 0) {
            while (__hip_atomic_load((unsigned*)&P.qctr[48 + l], __ATOMIC_RELAXED, __HIP_MEMORY_SCOPE_AGENT) < gridDim.x) __builtin_amdgcn_s_sleep(1);
            __builtin_amdgcn_fence(__ATOMIC_ACQUIRE, "agent");
            asm volatile("s_waitcnt vmcnt(0)" ::: "memory");
          }
          __syncthreads();
          lru_carry_item(P, gridDim.x - 1 - blockIdx.x);
        }
        continue;
      }
      const int pair = (blockIdx.x & 7) + 8 * (it >> 6);
      b = pair >> 2; head = pair & 3; row0 = TC + b * SEQ + (it & 63) * 128; nk = KV; kind = 0;
    } else {
      if (it >= total) break;
      if (it < nC) { b = it >> 3; head = (it >> 1) & 3; row0 = b * CL + (it & 1) * 128; nk = CL; kind = 0; }
      else if (it < nC + nFA) { kind = 1; it -= nC; }
      else { kind = 2; it -= nC + nFA; }
    }
    if (kind == 0) attn_item(P, l, b, head, row0, nk, smem);
    else if (kind == 1) fftA_item(P, it, smem);
    else fftC_item(P, it, smem);
  }
}

DI void grid_barrier(unsigned* bar, unsigned k, unsigned xn, unsigned nx) {
  asm volatile("s_waitcnt vmcnt(0)" ::: "memory");
  __syncthreads();
  if (threadIdx.x == 0) {
    const unsigned x = (unsigned)__builtin_amdgcn_s_getreg((3 << 11) | 20) & 0x7u;
    unsigned* xc = bar + 16 + x * 16; unsigned* top = bar;
    const unsigned old = __hip_atomic_fetch_add(xc, 1u, __ATOMIC_RELAXED, __HIP_MEMORY_SCOPE_AGENT);
    if (old == k * xn - 1u) {
      __builtin_amdgcn_fence(__ATOMIC_RELEASE, "agent");
      asm volatile("s_waitcnt vmcnt(0)" ::: "memory");
      __hip_atomic_fetch_add(top, 1u, __ATOMIC_RELAXED, __HIP_MEMORY_SCOPE_AGENT);
    }
    while (__hip_atomic_load(top, __ATOMIC_RELAXED, __HIP_MEMORY_SCOPE_AGENT) < k * nx) __builtin_amdgcn_s_sleep(1);
    __builtin_amdgcn_fence(__ATOMIC_ACQUIRE, "agent");
    asm volatile("s_waitcnt vmcnt(0)" ::: "memory");
  }
  __syncthreads();
}
__global__ void __launch_bounds__(256, 1) fwd_megakernel(Params Pin) {
  Params P = Pin; bind_ws(P);
  __shared__ __attribute__((aligned(16))) char smem[147456 + 8192];
  __shared__ int tb[33];
  __shared__ int s_item;
  cg::grid_group grid = cg::this_grid();
  unsigned* bar = (unsigned*)(P.ws + O_bar); unsigned bk = 0;
  if (threadIdx.x == 0) __hip_atomic_fetch_add(bar + 160 + ((unsigned)__builtin_amdgcn_s_getreg((3 << 11) | 20) & 0x7u), 1u, __ATOMIC_RELAXED, __HIP_MEMORY_SCOPE_AGENT);
#ifndef PH
#define PH 0xFFFF
#endif
#if PH & 1
  phase0(P, smem);
#endif
  grid.sync();
  unsigned xn, nx = 0;
  {
    const unsigned myx = (unsigned)__builtin_amdgcn_s_getreg((3 << 11) | 20) & 0x7u;
    xn = __hip_atomic_load(bar + 160 + myx, __ATOMIC_RELAXED, __HIP_MEMORY_SCOPE_AGENT);
#pragma unroll
    for (int x = 0; x < 8; x++) nx += __hip_atomic_load(bar + 160 + x, __ATOMIC_RELAXED, __HIP_MEMORY_SCOPE_AGENT) != 0u;
  }
  for (int l = 0; l < 2; l++) {
#if PH & 2
    row1_phase(P, l == 0 ? -1 : 0, l, 0);
#endif
    grid_barrier(bar, ++bk, xn, nx);
#if PH & 4
    gemm_in_phase(P, l, smem);
#ifdef DUP_GEMM
    grid_barrier(bar, ++bk, xn, nx);
    gemm_in_phase(P, l, smem);
#endif
#endif
    grid_barrier(bar, ++bk, xn, nx);
#if PH & 8
    mix_phase(P, l, smem, &s_item, l);
#ifdef DUP_MIX
    grid_barrier(bar, ++bk, xn, nx);
    mix_phase(P, l, smem, &s_item, 2 + l);
#endif
#endif
    grid_barrier(bar, ++bk, xn, nx);
#if PH & 16
    for (int it = blockIdx.x; it < 1024; it += gridDim.x) fftB_item(P, it, smem);
#endif
#if PH & 512
    {
      const int g = blockIdx.x & 3;
      LruK K{};
      for (int u = blockIdx.x >> 2; u < NB_ * 132; u += gridDim.x >> 2) lru_tile(P, l, u / 132, u % 132, g, smem, true, K);
    }
#endif
    grid_barrier(bar, ++bk, xn, nx);
#if PH & 32
    gemm_out_phase(P, l, smem);
#endif
    grid_barrier(bar, ++bk, xn, nx);
#if PH & 64
    row2_phase(P, l, l == 0 ? 0 : TC, smem);
#endif
    grid_barrier(bar, ++bk, xn, nx);
#if PH & 128
    moe_e1_phase(P, l, smem, tb);
#ifdef DUP_GEMM
    grid_barrier(bar, ++bk, xn, nx);
    moe_e1_phase(P, l, smem, tb);
#endif
#endif
    grid_barrier(bar, ++bk, xn, nx);
#if PH & 256
    moe_e2_phase(P, l, smem, tb);
#ifdef DUP_GEMM
    grid_barrier(bar, ++bk, xn, nx);
    moe_e2_phase(P, l, smem, tb);
#endif
#endif
    grid_barrier(bar, ++bk, xn, nx);
  }
#if PH & 2
  row1_phase(P, 1, -1, TC);
#endif
}

extern "C" void kernel_launch(void* const* d_in, const int* in_sizes, int n_in, void* d_out, int out_size, void* d_ws, size_t ws_size,
                              hipStream_t stream) {
  static int grid_blocks = 0;
  if (!grid_blocks) {
    int dev = 0, cus = 0, per_cu = 0;
    hipGetDevice(&dev);
    hipDeviceGetAttribute(&cus, hipDeviceAttributeMultiprocessorCount, dev);
    hipOccupancyMaxActiveBlocksPerMultiprocessor(&per_cu, fwd_megakernel, 256, 0);
    if (per_cu > 2) per_cu = 2;
    grid_blocks = cus * per_cu;
    if (grid_blocks > 256) grid_blocks = 256;
  }
  if (grid_blocks != 256) { fprintf(stderr, "need 256 co-resident blocks, have %d\n", grid_blocks); return; }
  Params p{};
  const float** pin = (const float**)&p;
  for (int i = 0; i < 31; i++) pin[i] = (const float*)d_in[i];
  p.out = (float*)d_out;
  p.ws = (char*)d_ws;
  if (WS_NEED > ws_size) { fprintf(stderr, "workspace too small: need %zu have %zu\n", (size_t)WS_NEED, ws_size); return; }
  hipMemsetAsync((char*)d_ws + O_bar, 0, 1024, stream);
  void* args[] = {&p};
  hipError_t e = hipLaunchCooperativeKernel((void*)fwd_megakernel, dim3(grid_blocks), dim3(256), args, 0, stream);
  if (e != hipSuccess) fprintf(stderr, "cooperative launch failed: %s (grid %d)\n", hipGetErrorString(e), grid_blocks);
}
```

```cpp
#include <hip/hip_runtime.h>
#include <hip/hip_cooperative_groups.h>
#include <cstdio>
namespace cg = cooperative_groups;

typedef _Float16 half_t;
typedef _Float16 h8 __attribute__((ext_vector_type(8)));
typedef _Float16 h4 __attribute__((ext_vector_type(4)));
typedef __fp16 fp16x2 __attribute__((ext_vector_type(2)));
typedef unsigned u4 __attribute__((ext_vector_type(4)));
typedef float f4 __attribute__((ext_vector_type(4)));
typedef float f16v __attribute__((ext_vector_type(16)));
#define DI __device__ __forceinline__
__device__ __forceinline__ int tid_opaque() { int t = threadIdx.x; asm volatile("" : "+v"(t)); return t; }
#define TIDX tid_opaque()

constexpr int D = 1024, NB_ = 8, SEQ = 8192, CL = 256;
constexpr int TC = NB_ * CL;
constexpr int TX = NB_ * SEQ;
constexpr int TA = TC + TX;
constexpr int KV = CL + SEQ;
constexpr int NIN = 2560;
constexpr int LCAP = 2 * TA;
constexpr float EPS = 1e-6f;

struct Params {
  const float *x, *c, *ctx, *c_ctx, *w_mod, *b_mod, *norm1_g, *norm2_g, *w_in, *q_norm_g, *k_norm_g, *lq1, *lk1, *lq2, *lk2,
      *subln_g, *conv_w, *conv_b, *gate_a_w, *gate_a_b, *gate_x_w, *gate_x_b, *lru_lambda, *w_out, *w_group, *b_group,
      *w_router, *b_router, *w1, *w3, *w2;
  float* out; char* ws;
  half_t *WtIn, *WtOut, *Wt1, *Wt3, *Wt2;
  float* mod; float2* rope; float2* tw; half_t *DA, *DB, *DC; float* consts; int* cnt; int* qctr; float* tokW; int* list; float* listW;
  float* xcbuf; half_t* WrH;
  half_t *hx, *mix, *q, *kall, *vT, *QF, *gy, *rr; float2* lsum; float* lcar; half_t* GA; half_t *H, *yA;
};


constexpr size_t al256(size_t x) { return (x + 255) & ~(size_t)255; }
constexpr size_t O_WtIn = 0;
constexpr size_t O_WtOut = O_WtIn + al256((size_t)2 * NIN * 1024 * 2);
constexpr size_t O_Wt1 = O_WtOut + al256((size_t)2 * 1024 * 1024 * 2);
constexpr size_t O_Wt3 = O_Wt1 + al256((size_t)64 * 524288 * 2);
constexpr size_t O_Wt2 = O_Wt3 + al256((size_t)64 * 524288 * 2);
constexpr size_t O_mod = O_Wt2 + al256((size_t)64 * 524288 * 2);
constexpr size_t O_rope = O_mod + al256((size_t)2 * 9 * 6144 * 4);
constexpr size_t O_tw = O_rope + al256(128 * 16 * 8);
constexpr size_t O_DA = O_tw + al256(8192 * 8);
constexpr size_t O_DB = O_DA + al256(16384 * 2);
constexpr size_t O_DC = O_DB + al256(32768 * 2);
constexpr size_t O_consts = O_DC + al256(131072 * 2);
constexpr size_t O_cnt = O_consts + 256;
constexpr size_t O_qctr = O_cnt + 256;
constexpr size_t O_bar = O_qctr + 256;
constexpr size_t O_tokW = O_bar + 1024;
constexpr size_t O_list = O_tokW + al256((size_t)2 * TA * 4);
constexpr size_t O_listW = O_list + al256((size_t)32 * LCAP * 4);
constexpr size_t O_xcbuf = O_listW + al256((size_t)32 * LCAP * 4);
constexpr size_t O_WrT = O_xcbuf + al256((size_t)TC * D * 4);
constexpr size_t O_hx = O_WrT + al256((size_t)2 * 2 * 48 * 1024 * 2);
constexpr size_t O_mix = O_hx + al256((size_t)TA * D * 2);
constexpr size_t O_regB = O_mix + al256((size_t)TA * D * 2);
constexpr size_t O_q = O_regB;
constexpr size_t O_kall = O_q + al256((size_t)TA * 512 * 2);
constexpr size_t O_vT = O_kall + al256((size_t)NB_ * KV * 512 * 2);
constexpr size_t O_QF = O_vT + al256((size_t)NB_ * 4 * 128 * KV * 2);
constexpr size_t O_gy = O_QF + al256((size_t)TA * 512 * 2);
constexpr size_t O_rr = O_gy + al256((size_t)TA * 256 * 2);
constexpr size_t O_lsum = O_rr + al256((size_t)TA * 256 * 2);
constexpr size_t O_lcar = O_lsum + al256((size_t)16 * 132 * 256 * 8);
constexpr size_t O_GA = O_lcar + al256((size_t)16 * 132 * 256 * 4);
constexpr size_t O_mixer_end = O_GA + al256((size_t)NB_ * 64 * 256 * 256 * 2);
constexpr size_t O_H = O_regB;
constexpr size_t O_yA = O_H + al256((size_t)(2 * TA + 32 * 256) * 512 * 2);
constexpr size_t O_moe_end = O_yA + al256((size_t)2 * TA * D * 2);
constexpr size_t WS_NEED = O_mixer_end > O_moe_end ? O_mixer_end : O_moe_end;
DI void bind_ws(Params& P) {
  char* w = P.ws;
  P.WtIn = (half_t*)(w + O_WtIn); P.WtOut = (half_t*)(w + O_WtOut); P.Wt1 = (half_t*)(w + O_Wt1); P.Wt3 = (half_t*)(w + O_Wt3); P.Wt2 = (half_t*)(w + O_Wt2);
  P.mod = (float*)(w + O_mod); P.rope = (float2*)(w + O_rope); P.tw = (float2*)(w + O_tw); P.DA = (half_t*)(w + O_DA); P.DB = (half_t*)(w + O_DB); P.DC = (half_t*)(w + O_DC);
  P.consts = (float*)(w + O_consts); P.cnt = (int*)(w + O_cnt); P.qctr = (int*)(w + O_qctr); P.tokW = (float*)(w + O_tokW); P.list = (int*)(w + O_list); P.listW = (float*)(w + O_listW);
  P.xcbuf = (float*)(w + O_xcbuf); P.WrH = (half_t*)(w + O_WrT); P.hx = (half_t*)(w + O_hx); P.mix = (half_t*)(w + O_mix);
  P.q = (half_t*)(w + O_q); P.kall = (half_t*)(w + O_kall); P.vT = (half_t*)(w + O_vT); P.QF = (half_t*)(w + O_QF); P.gy = (half_t*)(w + O_gy); P.rr = (half_t*)(w + O_rr);
  P.lsum = (float2*)(w + O_lsum); P.lcar = (float*)(w + O_lcar); P.GA = (half_t*)(w + O_GA); P.H = (half_t*)(w + O_H); P.yA = (half_t*)(w + O_yA);
}
DI float shx(float v, int o) { int ln = TIDX & 63; return __builtin_bit_cast(float, __builtin_amdgcn_ds_bpermute((ln ^ o) << 2, __builtin_bit_cast(int, v))); }
DI float shi(float v, int idx) { return __builtin_bit_cast(float, __builtin_amdgcn_ds_bpermute(idx << 2, __builtin_bit_cast(int, v))); }
DI float wave_sum(float v) {
#pragma unroll
  for (int o = 32; o; o >>= 1) v += shx(v, o);
  return v;
}
DI void glds16(const void* g, void* l) {
  __builtin_amdgcn_global_load_lds((const unsigned*)g, (unsigned*)l, 16, 0, 0);
}
DI void wait_vm0() { asm volatile("s_waitcnt vmcnt(0)" ::: "memory"); }
DI f4 mfma16(h8 a, h8 b, f4 c) { return __builtin_amdgcn_mfma_f32_16x16x32_f16(a, b, c, 0, 0, 0); }
DI f16v mfma32(h8 a, h8 b, f16v c) { return __builtin_amdgcn_mfma_f32_32x32x16_f16(a, b, c, 0, 0, 0); }
DI unsigned pk2(float a, float b) { fp16x2 r = __builtin_amdgcn_cvt_pkrtz(a, b); return __builtin_bit_cast(unsigned, r); }
DI float sigmoidf_(float x) { return 1.f / (1.f + __expf(-x)); }
DI float gelu_tanh(float x) {
  float u = 0.7978845608028654f * (x + 0.044715f * x * x * x);
  float e = __expf(2.f * u);
  float t = 1.f - 2.f / (e + 1.f);
  return 0.5f * x * (1.f + t);
}
DI int row_mod(int r) { return r < TC ? 8 : ((r - TC) >> 13); }

DI void transpose_tile4(const float* src, int lds_, half_t* dst, int ldd, float* tile) {
  const int tid = TIDX;
  {
    const int k0 = tid >> 6, c4 = tid & 63;
    const float* sp = src + (size_t)k0 * lds_ + c4 * 4;
    float* tp = tile + (c4 >> 4) * 4352 + k0 * 68 + (c4 & 15) * 4;
#pragma unroll
    for (int i = 0; i < 16; i++) *(float4*)(tp + i * 4 * 68) = *(const float4*)(sp + (size_t)i * 4 * lds_);
  }
  __syncthreads();
#pragma unroll
  for (int i = 0; i < 8; i++) {
    int idx = i * 256 + tid, j = idx >> 9, r = idx & 511, kc = r >> 6, n = r & 63;
    const float* t = tile + j * 4352 + kc * 8 * 68 + n;
    h8 o;
#pragma unroll
    for (int u = 0; u < 8; u++) o[u] = (half_t)t[u * 68];
    *(h8*)(dst + (size_t)(j * 64 + n) * ldd + kc * 8) = o;
  }
  __syncthreads();
}

DI void phase0(const Params& P, char* smem) {
  float* tile = (float*)smem;
  const int tid = TIDX;
  constexpr int NT = 6528, NF = 128, NM = 192, NX = 6;
  for (int t0 = blockIdx.x; t0 < NT + NF + NM + NX; t0 += gridDim.x) {
    const int t = t0 < NF + NM + NX ? NT + t0 : t0 - (NF + NM + NX);
    if (t < NT) {
      const float* src; half_t* dst; int lds_, ldd;
      if (t < 256) {
        int l = t / 128, r = t % 128, kt = r / 8, nt = (r % 8) * 4;
        src = P.w_in + (size_t)l * 1024 * 2304 + (size_t)kt * 64 * 2304 + 256 + nt * 64; lds_ = 2304;
        dst = P.WtIn + (size_t)l * NIN * 1024 + (size_t)(512 + nt * 64) * 1024 + kt * 64; ldd = 1024;
      } else if (t < 384) {
        int u = t - 256, l = u / 64, r = u % 64, kt = r / 4, nt = (r % 4) * 4;
        src = P.w_out + (size_t)l * 1048576 + (size_t)kt * 64 * 1024 + nt * 64; lds_ = 1024;
        dst = P.WtOut + (size_t)l * 1048576 + (size_t)nt * 64 * 1024 + kt * 64; ldd = 1024;
      } else if (t < 384 + 4096) {
        int u = t - 384; const float* w = P.w1; half_t* o = P.Wt1;
        if (u >= 2048) { u -= 2048; w = P.w3; o = P.Wt3; }
        int le = u / 32, r = u % 32, kt = r / 2, nt = (r % 2) * 4;
        src = w + (size_t)le * 524288 + (size_t)kt * 64 * 512 + nt * 64; lds_ = 512;
        dst = o + (size_t)le * 524288 + (size_t)nt * 64 * 1024 + kt * 64; ldd = 1024;
      } else {
        int u = t - 384 - 4096, le = u / 32, r = u % 32, kt = r / 4, nt = (r % 4) * 4;
        src = P.w2 + (size_t)le * 524288 + (size_t)kt * 64 * 1024 + nt * 64; lds_ = 1024;
        dst = P.Wt2 + (size_t)le * 524288 + (size_t)nt * 64 * 512 + kt * 64; ldd = 512;
      }
      transpose_tile4(src, lds_, dst, ldd, tile);
    } else if (t < NT + NF) {
      int f = t - NT, l = f / 64, r = f % 64, kt = r / 4, g = r % 4;
      float* cst = tile + 64 * 65; float* snt = cst + 64;
      const float* src = P.w_in + (size_t)l * 1024 * 2304 + (size_t)kt * 64 * 2304 + g * 64;
      { int n = tid & 63, kq = tid >> 6;
        for (int i = 0; i < 16; i++) { int k = i * 4 + kq; tile[k * 65 + n] = src[(size_t)k * 2304 + n]; } }
      if (tid < 64) { float s, c; sincospif((float)tid / 32.f, &s, &c); cst[tid] = c; snt[tid] = s; }
      __syncthreads();
      int k = tid & 63, jq = tid >> 6;
      half_t* o = P.WtIn + (size_t)l * NIN * 1024 + kt * 64 + k;
      for (int jj = 0; jj < 16; jj++) {
        int j = jq * 16 + jj; float ac = 0.f, as = 0.f;
        for (int c = 0; c < 64; c++) { float v = tile[k * 65 + c]; int idx = (c * j) & 63; ac += v * cst[idx]; as += v * snt[idx]; }
        o[(size_t)(g * 64 + j) * 1024] = (half_t)(ac * 0.125f);
        o[(size_t)(256 + g * 64 + j) * 1024] = (half_t)(-as * 0.125f);
      }
      __syncthreads();
    } else if (t < NT + NF + NM) {
      int mi = t - NT - NF, l = mi / 96, col0 = (mi % 96) * 64;
      float* scond = tile; float* red = tile + 9216;
      for (int idx = tid; idx < 9216; idx += 256) {
        int n = idx >> 10, k = idx & 1023; float v = n < 8 ? P.c[n * 1024 + k] : P.c_ctx[k];
        scond[idx] = v / (1.f + expf(-v));
      }
      __syncthreads();
      int col = tid & 63, kq = tid >> 6; float acc[9];
#pragma unroll
      for (int n = 0; n < 9; n++) acc[n] = 0.f;
      const float* w = P.w_mod + ((size_t)l * 1024 + kq * 256) * 6144 + col0 + col;
#pragma unroll 16
      for (int k = 0; k < 256; k++) {
        float wv = w[(size_t)k * 6144];
#pragma unroll
        for (int n = 0; n < 9; n++) acc[n] += scond[n * 1024 + kq * 256 + k] * wv;
      }
#pragma unroll
      for (int n = 0; n < 9; n++) red[(kq * 9 + n) * 64 + col] = acc[n];
      __syncthreads();
      for (int idx = tid; idx < 576; idx += 256) {
        int n = idx / 64, cc = idx % 64;
        float s = red[(0 * 9 + n) * 64 + cc] + red[(1 * 9 + n) * 64 + cc] + red[(2 * 9 + n) * 64 + cc] + red[(3 * 9 + n) * 64 + cc];
        P.mod[(size_t)(l * 9 + n) * 6144 + col0 + cc] = s + P.b_mod[l * 6144 + col0 + cc];
      }
      __syncthreads();
    } else {
      int m = t - NT - NF - NM;
      if (m == 0) {
        for (int idx = tid; idx < 128 * 16; idx += 256) {
          int pos = idx >> 4, i = idx & 15; float f = powf(10000.f, -(float)i / 16.f); float ang = (float)pos * f;
          float s, c; sincosf(ang, &s, &c); P.rope[idx] = make_float2(c, s);
        }
      } else if (m == 1) {
        for (int j = tid; j < 8192; j += 256) { float s, c; sincospif((float)j / 4096.f, &s, &c); P.tw[j] = make_float2(c, s); }
      } else if (m == 2) {
        for (int idx = tid; idx < 16384; idx += 256) {
          int mm = idx >> 7, k = idx & 127, part = mm >> 6, f1 = mm & 63, pp = k >> 6, a = k & 63;
          float s, c; sincospif((float)((a * f1) & 63) / 32.f, &s, &c);
          float v = part == 0 ? (pp == 0 ? c : s) : (pp == 0 ? -s : c);
          P.DA[idx] = (half_t)(v * 0.125f);
        }
      } else if (m == 3) {
        for (int idx = tid; idx < 32768; idx += 256) {
          int mm = idx >> 8, k = idx & 255, part = k >> 7, bb = k & 127;
          float s, c; sincospif((float)((bb * mm) & 127) / 64.f, &s, &c);
          P.DB[idx] = (half_t)((part == 0 ? c : s) * 0.08838834764831845f);
        }
      } else if (m == 4) {
        for (int idx = tid; idx < 131072; idx += 256) {
          int mm = idx >> 9, k = idx & 511, part = k >> 8, tt = k & 255;
          float s, c; sincospif((float)((tt * mm) & 255) / 128.f, &s, &c);
          P.DC[idx] = (half_t)((part == 0 ? c : s) * 0.0625f);
        }
      } else {
        for (int idx = tid; idx < 2 * 48 * 1024; idx += 256) {
          int l = idx / 49152, r = idx % 49152, col = r >> 10, k = r & 1023;
          float w = col < 4 ? P.w_group[((size_t)l * 1024 + k) * 4 + col] : (col < 36 ? P.w_router[((size_t)l * 1024 + k) * 32 + col - 4] : 0.f);
          half_t hi = (half_t)w, lo = (half_t)(w - (float)hi);
          P.WrH[(size_t)(l * 2) * 49152 + r] = hi; P.WrH[(size_t)(l * 2 + 1) * 49152 + r] = lo;
        }
        if (tid < 2) {
          int l = tid; float s1 = 0.f, s2 = 0.f, mq = 0.f, mk = 0.f;
          for (int i = 0; i < 64; i++) {
            s1 += P.lq1[l * 64 + i] * P.lk1[l * 64 + i]; s2 += P.lq2[l * 64 + i] * P.lk2[l * 64 + i];
            mq = fmaxf(mq, fabsf(P.q_norm_g[l * 64 + i])); mk = fmaxf(mk, fabsf(P.k_norm_g[l * 64 + i]));
          }
          float lam_init = 0.8f - 0.6f * expf(-0.3f * (float)l);
          P.consts[l * 4 + 0] = expf(s1) - expf(s2) + lam_init;
          P.consts[l * 4 + 1] = 8.f * mq * mk * 1.4426950408889634f * 1.002f - 15.f;
          P.consts[l * 4 + 2] = lam_init;
        }
        if (tid < 64) P.cnt[tid] = 0;
        if (tid < 64) P.qctr[tid] = 0;
      }
    }
  }
}

DI void row1_phase(const Params& P, int combine_l, int norm_l, int r_begin) {
  const int lane = TIDX & 63, gw = blockIdx.x * 4 + (TIDX >> 6), nw = gridDim.x * 4;
  auto load_row = [&](int r, float4 (&xv)[4], h4 (&ya)[4], h4 (&yb)[4]) {
    if (combine_l < 0) {
      const float* src = r < TC ? P.ctx + (size_t)r * D : P.x + (size_t)(r - TC) * D;
#pragma unroll
      for (int i = 0; i < 4; i++) xv[i] = *(const float4*)(src + i * 256 + lane * 4);
    } else {
      const float* xm = r < TC ? P.xcbuf + (size_t)r * D : P.out + (size_t)(r - TC) * D;
      const half_t* y0 = P.yA + (size_t)(2 * r) * D; const half_t* y1 = y0 + D;
#pragma unroll
      for (int i = 0; i < 4; i++) { int c = i * 256 + lane * 4; xv[i] = *(const float4*)(xm + c); ya[i] = *(const h4*)(y0 + c); yb[i] = *(const h4*)(y1 + c); }
    }
  };
  auto process = [&](int r, float4 (&xv)[4], h4 (&ya)[4], h4 (&yb)[4]) {
    const int n = row_mod(r);
    if (combine_l >= 0) {
      float* xm = r < TC ? P.xcbuf + (size_t)r * D : P.out + (size_t)(r - TC) * D;
      const float* g2 = P.mod + (size_t)(combine_l * 9 + n) * 6144 + 5 * 1024;
#pragma unroll
      for (int i = 0; i < 4; i++) {
        int c = i * 256 + lane * 4;
        float4 g = *(const float4*)(g2 + c); float4 t = xv[i];
        t.x += g.x * ((float)ya[i][0] + (float)yb[i][0]); t.y += g.y * ((float)ya[i][1] + (float)yb[i][1]);
        t.z += g.z * ((float)ya[i][2] + (float)yb[i][2]); t.w += g.w * ((float)ya[i][3] + (float)yb[i][3]);
        *(float4*)(xm + c) = t; xv[i] = t;
      }
    }
    if (norm_l >= 0) {
      float ss = 0.f;
#pragma unroll
      for (int i = 0; i < 4; i++) ss += xv[i].x * xv[i].x + xv[i].y * xv[i].y + xv[i].z * xv[i].z + xv[i].w * xv[i].w;
      ss = wave_sum(ss);
      const float rstd = rsqrtf(ss * (1.f / 1024.f) + EPS);
      const float* g = P.norm1_g + norm_l * 1024;
      const float* sh = P.mod + (size_t)(norm_l * 9 + n) * 6144; const float* sc = sh + 1024;
#pragma unroll
      for (int i = 0; i < 4; i++) {
        int c = i * 256 + lane * 4;
        float4 gg = *(const float4*)(g + c), s1 = *(const float4*)(sc + c), s0 = *(const float4*)(sh + c);
        h4 o;
        o[0] = (half_t)(xv[i].x * rstd * gg.x * (1.f + s1.x) + s0.x); o[1] = (half_t)(xv[i].y * rstd * gg.y * (1.f + s1.y) + s0.y);
        o[2] = (half_t)(xv[i].z * rstd * gg.z * (1.f + s1.z) + s0.z); o[3] = (half_t)(xv[i].w * rstd * gg.w * (1.f + s1.w) + s0.w);
        *(h4*)(P.hx + (size_t)r * D + c) = o;
      }
    }
  };
#pragma unroll 1
  for (int r = r_begin + gw; r < TA; r += 4 * nw) {
    float4 x0[4], x1[4], x2[4], x3[4]; h4 a0[4], b0[4], a1[4], b1[4], a2[4], b2[4], a3[4], b3[4];
    const int r1 = r + nw, r2 = r + 2 * nw, r3 = r + 3 * nw;
    load_row(r, x0, a0, b0);
    if (r1 < TA) load_row(r1, x1, a1, b1);
    if (r2 < TA) load_row(r2, x2, a2, b2);
    if (r3 < TA) load_row(r3, x3, a3, b3);
    process(r, x0, a0, b0);
    if (r1 < TA) process(r1, x1, a1, b1);
    if (r2 < TA) process(r2, x2, a2, b2);
    if (r3 < TA) process(r3, x3, a3, b3);
  }
}

DI void row2_phase(const Params& P, int l, int r_begin, char* smem) {
  const int tid = TIDX, lane = tid & 63, wave = tid >> 6, fr = lane & 15, fq = lane >> 4;
  float* lg = (float*)smem + wave * 16 * 48;
  const half_t* Whi = P.WrH + (size_t)(l * 2) * 49152; const half_t* Wlo = Whi + 49152;
  const int ngroups = (TA - r_begin) >> 4, gw = blockIdx.x * 4 + wave, nw = gridDim.x * 4;
  const float* gam = P.norm2_g + l * 1024;
#pragma unroll 1
  for (int grp = gw; grp < ngroups; grp += nw) {
    const int r0 = r_begin + grp * 16, row = r0 + fr, n = row_mod(r0);
    const float* xm = (row < TC ? P.xcbuf + (size_t)row * D : P.out + (size_t)(row - TC) * D) + fq * 8;
    float ss = 0.f;
#pragma unroll 16
    for (int kk = 0; kk < 32; kk++) {
      const float4 a = *(const float4*)(xm + kk * 32), b = *(const float4*)(xm + kk * 32 + 4);
      ss += a.x * a.x + a.y * a.y + a.z * a.z + a.w * a.w + b.x * b.x + b.y * b.y + b.z * b.z + b.w * b.w;
    }
    ss += shx(ss, 16); ss += shx(ss, 32);
    const float rstd = rsqrtf(ss * (1.f / 1024.f) + EPS);
    const float* sh = P.mod + (size_t)(l * 9 + n) * 6144 + 3 * 1024 + fq * 8; const float* sc = sh + 1024;
    f4 acc[3];
#pragma unroll
    for (int i = 0; i < 3; i++) acc[i] = (f4){0.f, 0.f, 0.f, 0.f};
    half_t* hxo = P.hx + (size_t)row * D + fq * 8;
#pragma unroll 4
    for (int kk = 0; kk < 32; kk++) {
      const int k0 = kk * 32;
      float x[8], g[8], s1[8], s0[8];
      *(float4*)&x[0] = *(const float4*)(xm + k0); *(float4*)&x[4] = *(const float4*)(xm + k0 + 4);
      *(float4*)&g[0] = *(const float4*)(gam + fq * 8 + k0); *(float4*)&g[4] = *(const float4*)(gam + fq * 8 + k0 + 4);
      *(float4*)&s1[0] = *(const float4*)(sc + k0); *(float4*)&s1[4] = *(const float4*)(sc + k0 + 4);
      *(float4*)&s0[0] = *(const float4*)(sh + k0); *(float4*)&s0[4] = *(const float4*)(sh + k0 + 4);
      h8 hi, lo;
#pragma unroll
      for (int i = 0; i < 8; i++) {
        float v = x[i] * rstd * g[i] * (1.f + s1[i]) + s0[i];
        hi[i] = (half_t)v; lo[i] = (half_t)(v - (float)hi[i]);
      }
      *(h8*)(hxo + k0) = hi;
#pragma unroll
      for (int n3 = 0; n3 < 3; n3++) {
        h8 bh = *(const h8*)(Whi + (size_t)(n3 * 16 + fr) * 1024 + k0 + fq * 8);
        h8 bl = *(const h8*)(Wlo + (size_t)(n3 * 16 + fr) * 1024 + k0 + fq * 8);
        acc[n3] = mfma16(hi, bh, acc[n3]); acc[n3] = mfma16(lo, bh, acc[n3]); acc[n3] = mfma16(hi, bl, acc[n3]);
      }
    }
    __builtin_amdgcn_wave_barrier();
#pragma unroll
    for (int n3 = 0; n3 < 3; n3++)
#pragma unroll
      for (int j = 0; j < 4; j++) lg[(fq * 4 + j) * 48 + n3 * 16 + fr] = acc[n3][j];
    __builtin_amdgcn_wave_barrier();
    if (lane < 16) {
      const int r = r0 + lane;
      const float* L = lg + lane * 48;
      float gl[4]; int gi = 0;
#pragma unroll
      for (int j = 0; j < 4; j++) gl[j] = L[j] + P.b_group[l * 4 + j];
      float gm = gl[0];
#pragma unroll
      for (int j = 1; j < 4; j++) if (gl[j] > gm) { gm = gl[j]; gi = j; }
      float gs = 0.f;
#pragma unroll
      for (int j = 0; j < 4; j++) gs += expf(gl[j] - gm);
      const float pg = 1.f / gs;
      float el[8];
#pragma unroll
      for (int j = 0; j < 8; j++) el[j] = L[4 + gi * 8 + j] + P.b_router[l * 32 + gi * 8 + j];
      int i0 = 0; float v0 = el[0];
#pragma unroll
      for (int j = 1; j < 8; j++) if (el[j] > v0) { v0 = el[j]; i0 = j; }
      int i1 = -1; float v1 = -3.0e38f;
#pragma unroll
      for (int j = 0; j < 8; j++) if (j != i0 && el[j] > v1) { v1 = el[j]; i1 = j; }
      const float ex = expf(v1 - v0);
      const float w0 = pg / (1.f + ex), w1 = pg * ex / (1.f + ex);
      const int e0 = gi * 8 + i0, e1 = gi * 8 + i1;
      int p0 = atomicAdd(&P.cnt[l * 32 + e0], 1); P.list[(size_t)e0 * LCAP + p0] = 2 * r; P.listW[(size_t)e0 * LCAP + p0] = w0;
      int p1 = atomicAdd(&P.cnt[l * 32 + e1], 1); P.list[(size_t)e1 * LCAP + p1] = 2 * r + 1; P.listW[(size_t)e1 * LCAP + p1] = w1;
    }
    __builtin_amdgcn_wave_barrier();
  }
}

DI h8 lds128(unsigned a) { h8 r; asm volatile("ds_read_b128 %0, %1" : "=v"(r) : "v"(a)); return r; }
DI void tie(h8& x) { asm volatile("" : "+v"(x)); }
DI unsigned lds_addr(const void* p) { return (unsigned)(size_t)p; }
#define WAIT_LGKM(n) asm volatile("s_waitcnt lgkmcnt(" #n ")" ::: "memory")
DI void raw_barrier() { asm volatile("" ::: "memory"); __builtin_amdgcn_s_barrier(); asm volatile("" ::: "memory"); }
DI void slot_rc(int i, int& row, int& coff) { int s = i * 256 + TIDX; row = s >> 3; coff = ((s & 7) ^ ((row >> 1) & 7)) * 8; }

template <class AF, class BF>
DI void gemm_prologue(AF aptr, BF bptr, int nk, char* smem) {
  const int tid = TIDX;
#pragma unroll
  for (int st = 0; st < 2; st++) {
    if (st < nk) {
      char* d = smem + st * 49152 + tid * 16;
#pragma unroll
      for (int i = 0; i < 8; i++) glds16(aptr(i) + st * 64, d + i * 4096);
#pragma unroll
      for (int i = 0; i < 4; i++) glds16(bptr(i) + st * 64, d + 32768 + i * 4096);
    }
  }
}
template <bool PRE = false, class AF, class BF>
DI void gemm256(AF aptr, BF bptr, int nk, char* smem, f4 (&acc)[8][4]) {
  const int tid = TIDX, lane = tid & 63, wave = tid >> 6, fr = lane & 15, fq = lane >> 4, wr = wave >> 1, wc = wave & 1;
#pragma unroll
  for (int m = 0; m < 8; m++)
#pragma unroll
    for (int n = 0; n < 4; n++) acc[m][n] = (f4){0.f, 0.f, 0.f, 0.f};
  auto issue = [&](int kt, int st) {
    char* d = smem + st * 49152 + tid * 16;
#pragma unroll
    for (int i = 0; i < 8; i++) glds16(aptr(i) + kt * 64, d + i * 4096);
#pragma unroll
    for (int i = 0; i < 4; i++) glds16(bptr(i) + kt * 64, d + 32768 + i * 4096);
  };
  const unsigned sw = (unsigned)((fq ^ (fr >> 1)) << 4);
  const unsigned offA = (wr * 128 + fr) * 128 + sw, offB = 32768 + (wc * 64 + fr) * 128 + sw;
  const unsigned sbase = lds_addr(smem);
  if (!PRE) { issue(0, 0); if (nk > 1) issue(1, 1); }
  int st = 0;
#pragma unroll 1
  for (int kt = 0; kt < nk; kt++) {
    if (kt + 1 < nk) asm volatile("s_waitcnt vmcnt(12)" ::: "memory"); else wait_vm0();
    raw_barrier();
    if (kt + 2 < nk) issue(kt + 2, st == 0 ? 2 : st - 1);
    const unsigned base = sbase + st * 49152;
    st = st == 2 ? 0 : st + 1;
    h8 a0[8], b0[4], a1[8], b1[4];
#pragma unroll
    for (int m = 0; m < 8; m++) a0[m] = lds128(base + offA + m * 2048);
#pragma unroll
    for (int n = 0; n < 4; n++) b0[n] = lds128(base + offB + n * 2048);
#pragma unroll
    for (int m = 0; m < 8; m++) a1[m] = lds128(base + (offA ^ 64) + m * 2048);
#pragma unroll
    for (int n = 0; n < 4; n++) b1[n] = lds128(base + (offB ^ 64) + n * 2048);
    WAIT_LGKM(12);
#pragma unroll
    for (int m = 0; m < 8; m++) tie(a0[m]);
#pragma unroll
    for (int n = 0; n < 4; n++) tie(b0[n]);
#pragma unroll
    for (int m = 0; m < 8; m++)
#pragma unroll
      for (int n = 0; n < 4; n++) acc[m][n] = mfma16(a0[m], b0[n], acc[m][n]);
    WAIT_LGKM(0);
#pragma unroll
    for (int m = 0; m < 8; m++) tie(a1[m]);
#pragma unroll
    for (int n = 0; n < 4; n++) tie(b1[n]);
#pragma unroll
    for (int m = 0; m < 8; m++)
#pragma unroll
      for (int n = 0; n < 4; n++) acc[m][n] = mfma16(a1[m], b1[n], acc[m][n]);
  }
  raw_barrier();
}
DI bool xcd_tile(int it, int MT, int NT, int& mt, int& nt) {
  const int x = blockIdx.x & 7, j = blockIdx.x >> 3;
  const int nsn = NT >> 2, nsm = (MT + 7) >> 3;
  const int s = x + 8 * it;
  if (s >= nsm * nsn) return false;
  const int sm = s / nsn, sn = s % nsn;
  mt = sm * 8 + (j >> 2); nt = sn * 4 + (j & 3);
  return true;
}
DI bool next_tile(int& it, int MT, int NT, int& mt, int& nt) {
  for (;; it++) {
    if (!xcd_tile(it, MT, NT, mt, nt)) return false;
    if (mt < MT) return true;
  }
}
DI int slot_col() { int t = TIDX; return ((t & 7) ^ ((t >> 4) & 7)) * 8; }

DI float dpp_row_sum(float v) {
  v += __builtin_bit_cast(float, __builtin_amdgcn_update_dpp(0, __builtin_bit_cast(int, v), 0x128, 0xf, 0xf, false));
  v += __builtin_bit_cast(float, __builtin_amdgcn_update_dpp(0, __builtin_bit_cast(int, v), 0x124, 0xf, 0xf, false));
  v += __builtin_bit_cast(float, __builtin_amdgcn_update_dpp(0, __builtin_bit_cast(int, v), 0x122, 0xf, 0xf, false));
  v += __builtin_bit_cast(float, __builtin_amdgcn_update_dpp(0, __builtin_bit_cast(int, v), 0x121, 0xf, 0xf, false));
  return v;
}
DI void stage_put(char* stg, int ml, int n, int j, int fr, int fq, float v) { *(half_t*)(stg + (ml * 16 + fq * 4 + j) * 144 + (n * 16 + fr) * 2) = (half_t)v; }
template <class RP, class SC>
DI void stage_flush(char* stg, int h, RP rowptr, SC rowscale) {
  const int lane = TIDX & 63;
  __builtin_amdgcn_wave_barrier();
#pragma unroll
  for (int i = 0; i < 8; i++) {
    const int c = i * 64 + lane, row = c >> 3, c16 = c & 7;
    h8 v = *(const h8*)(stg + row * 144 + c16 * 16);
    half_t* d = rowptr(h * 64 + row);
    if (d) { rowscale(h * 64 + row, v); *(h8*)(d + c16 * 8) = v; }
  }
  __builtin_amdgcn_wave_barrier();
}
template <class VF, class RP, class SC>
DI void wave_store_tile(VF val, char* stg, RP rowptr, SC rowscale) {
  const int lane = TIDX & 63, fr = lane & 15, fq = lane >> 4;
#pragma unroll
  for (int h = 0; h < 2; h++) {
#pragma unroll
    for (int ml = 0; ml < 4; ml++)
#pragma unroll
      for (int n = 0; n < 4; n++)
#pragma unroll
        for (int j = 0; j < 4; j++) stage_put(stg, ml, n, j, fr, fq, val(h * 4 + ml, n, j));
    stage_flush(stg, h, rowptr, rowscale);
  }
}
DI void gemm_in_phase(const Params& P, int l, char* smem) {
  const int tid = TIDX;
  const half_t* Wt = P.WtIn + (size_t)l * NIN * 1024;
  const int sc = slot_col(), srow = tid >> 3;
  {
    float2* rcl = (float2*)(smem + 147456);
    for (int i = tid; i < 1024; i += 256) rcl[i] = P.rope[i];
    __syncthreads();
  }
  int it = 0, mt, nt;
  bool have = next_tile(it, 264, 20, mt, nt);
  const half_t* a0 = nullptr; const half_t* b0 = nullptr;
  if (have) {
    asm volatile("" : "+s"(mt), "+s"(nt));
    a0 = P.hx + (size_t)(mt * 256 + srow) * D + sc; b0 = Wt + (size_t)(nt * 128 + srow) * D + sc;
    gemm_prologue([&](int i) { return a0 + (size_t)i * 32 * D; }, [&](int i) { return b0 + (size_t)i * 32 * D; }, 16, smem);
  }
#pragma unroll 1
  while (have) {
    f4 acc[8][4];
    gemm256<true>([&](int i) { return a0 + (size_t)i * 32 * D; }, [&](int i) { return b0 + (size_t)i * 32 * D; }, 16, smem, acc);
    const int tid2 = TIDX, lane = tid2 & 63, wave = tid2 >> 6, fr = lane & 15, fq = lane >> 4, wr = wave >> 1, wc = wave & 1;
    const int r0 = mt * 256 + wr * 128;
    const bool isctx = r0 < TC;
    int b, pos0;
    if (isctx) { b = r0 >> 8; pos0 = r0 & 255; } else { b = (r0 - TC) >> 13; pos0 = 256 + ((r0 - TC) & 8191); }
    const bool isqk = nt >= 4 && nt < 12;
    float gg[4] = {0.f, 0.f, 0.f, 0.f}; float2 rr2[2] = {make_float2(1.f, 0.f), make_float2(1.f, 0.f)};
    if (isqk) {
      const float* gvec = (nt < 8 ? P.q_norm_g : P.k_norm_g) + l * 64;
      const float qs = nt < 8 ? 0.125f * 1.4426950408889634f : 1.f;
#pragma unroll
      for (int n = 0; n < 4; n++) gg[n] = gvec[n * 16 + fr] * qs;
      if (!isctx) { const int tp0 = pos0 - 256; rr2[0] = P.rope[(tp0 >> 6) * 16 + fr]; rr2[1] = P.rope[((tp0 >> 6) + 1) * 16 + fr]; }
    }
#pragma unroll
    for (int n = 0; n < 4; n++) asm volatile("" : "+v"(gg[n]));
    asm volatile("" : "+v"(rr2[0].x), "+v"(rr2[0].y), "+v"(rr2[1].x), "+v"(rr2[1].y));
    int it2 = it + 1, mt2, nt2;
    const bool have2 = next_tile(it2, 264, 20, mt2, nt2);
    const half_t* a1 = a0; const half_t* b1 = b0;
    if (have2) {
      asm volatile("" : "+s"(mt2), "+s"(nt2));
      a1 = P.hx + (size_t)(mt2 * 256 + srow) * D + sc; b1 = Wt + (size_t)(nt2 * 128 + srow) * D + sc;
      gemm_prologue([&](int i) { return a1 + (size_t)i * 32 * D; }, [&](int i) { return b1 + (size_t)i * 32 * D; }, 16, smem);
    }
    char* stg = smem + 98304 + wave * 12288;
    auto noscale = [](int, h8&) {};
    if (nt < 4 || nt >= 16) {
      half_t* dst; int ld, c0; bool gel = false;
      if (nt < 4) { dst = P.QF; ld = 512; c0 = nt * 128; }
      else if (nt < 18) { dst = P.gy; ld = 256; c0 = (nt - 16) * 128; gel = true; }
      else { dst = P.rr; ld = 256; c0 = (nt - 18) * 128; }
      half_t* base = dst + (size_t)r0 * ld + c0 + wc * 64;
      if (gel) wave_store_tile([&](int m, int n, int j) { return gelu_tanh(acc[m][n][j]); }, stg, [&](int r) { return base + (size_t)r * ld; }, noscale);
      else wave_store_tile([&](int m, int n, int j) { return acc[m][n][j]; }, stg, [&](int r) { return base + (size_t)r * ld; }, noscale);
    } else if (nt < 12) {
      const bool isq = nt < 8; const int head = isq ? nt - 4 : nt - 8;
      const float2* rcl = (const float2*)(smem + 147456);
      half_t* base = (isq ? P.q + (size_t)r0 * 512 : P.kall + ((size_t)b * KV + pos0) * 512) + head * 128 + wc * 64;
#pragma unroll
      for (int mh = 0; mh < 2; mh++) {
#pragma unroll
        for (int mm = 0; mm < 4; mm++) {
          const int m = mh * 4 + mm;
#pragma unroll
          for (int j = 0; j < 4; j++) {
            float ss = 0.f;
#pragma unroll
            for (int n = 0; n < 4; n++) ss += acc[m][n][j] * acc[m][n][j];
            ss = dpp_row_sum(ss);
            const float rstd = rsqrtf(ss * (1.f / 64.f) + EPS);
            float o[4];
#pragma unroll
            for (int n = 0; n < 4; n++) o[n] = acc[m][n][j] * rstd * gg[n];
            if (!isctx) {
              const float2 cr = rr2[mh], cc = rcl[(mm * 16 + fq * 4 + j) * 16 + fr];
              float a0 = o[0] * cr.x - o[1] * cr.y, a1 = o[1] * cr.x + o[0] * cr.y;
              float a2 = o[2] * cc.x - o[3] * cc.y, a3 = o[3] * cc.x + o[2] * cc.y;
              o[0] = a0; o[1] = a1; o[2] = a2; o[3] = a3;
            }
#pragma unroll
            for (int n = 0; n < 4; n++) stage_put(stg, mm, n, j, fr, fq, o[n]);
          }
        }
        stage_flush(stg, mh, [&](int r) { return base + (size_t)r * 512; }, noscale);
      }
    } else {
      const int head = nt - 12;
#pragma unroll
      for (int m = 0; m < 8; m++)
#pragma unroll
        for (int n = 0; n < 4; n++) {
          h4 o; o[0] = (half_t)acc[m][n][0]; o[1] = (half_t)acc[m][n][1]; o[2] = (half_t)acc[m][n][2]; o[3] = (half_t)acc[m][n][3];
          int d = wc * 64 + n * 16 + fr;
          asm volatile("" : "+v"(d) :: "memory");
          *(h4*)(P.vT + ((size_t)(b * 4 + head) * 128 + d) * KV + pos0 + m * 16 + fq * 4) = o;
        }
    }
    mt = mt2; nt = nt2; it = it2; have = have2; a0 = a1; b0 = b1;
  }
}

DI void gemm_out_phase(const Params& P, int l, char* smem) {
  const int tid = TIDX;
  const half_t* Wt = P.WtOut + (size_t)l * 1048576;
  const int mt0 = l == 0 ? 0 : TC / 256;
  const int MT = 264 - mt0;
  const int sc = slot_col(), srow = tid >> 3;
  int it = 0, mt, nt;
  bool have = next_tile(it, MT, 8, mt, nt);
  const half_t* a0 = nullptr; const half_t* b0 = nullptr;
  if (have) {
    asm volatile("" : "+s"(mt), "+s"(nt));
    a0 = P.mix + (size_t)((mt + mt0) * 256 + srow) * D + sc; b0 = Wt + (size_t)(nt * 128 + srow) * D + sc;
    gemm_prologue([&](int i) { return a0 + (size_t)i * 32 * D; }, [&](int i) { return b0 + (size_t)i * 32 * D; }, 16, smem);
  }
#pragma unroll 1
  while (have) {
    f4 acc[8][4];
    gemm256<true>([&](int i) { return a0 + (size_t)i * 32 * D; }, [&](int i) { return b0 + (size_t)i * 32 * D; }, 16, smem, acc);
    const int tid2 = TIDX, lane2 = tid2 & 63, wave2 = tid2 >> 6, fr2 = lane2 & 15, fq2 = lane2 >> 4, wr2 = wave2 >> 1, wc2 = wave2 & 1;
    const int r0 = (mt + mt0) * 256 + wr2 * 128;
    const int n = row_mod(r0);
    const int cbase = nt * 128 + wc2 * 64;
    const float* res; float* dst;
    if (r0 < TC) { res = P.ctx + (size_t)r0 * D; dst = P.xcbuf + (size_t)r0 * D; }
    else { dst = P.out + (size_t)(r0 - TC) * D; res = l == 0 ? P.x + (size_t)(r0 - TC) * D : dst; }
    res += cbase + fr2 * 4; dst += cbase + fr2 * 4;
    const float4 g4 = *(const float4*)(P.mod + (size_t)(l * 9 + n) * 6144 + 2 * 1024 + cbase + fr2 * 4);
    float4 rres[4][8];
#pragma unroll
    for (int q = 0; q < 4; q++)
#pragma unroll
      for (int i = 0; i < 8; i++) rres[q][i] = *(const float4*)(res + (size_t)(q * 32 + i * 4 + fq2) * D);
    int it2 = it + 1, mt2, nt2;
    const bool have2 = next_tile(it2, MT, 8, mt2, nt2);
    const half_t* a1 = a0; const half_t* b1 = b0;
    if (have2) {
      asm volatile("" : "+s"(mt2), "+s"(nt2));
      a1 = P.mix + (size_t)((mt2 + mt0) * 256 + srow) * D + sc; b1 = Wt + (size_t)(nt2 * 128 + srow) * D + sc;
      gemm_prologue([&](int i) { return a1 + (size_t)i * 32 * D; }, [&](int i) { return b1 + (size_t)i * 32 * D; }, 16, smem);
    }
    {
      float* stg = (float*)(smem + 98304 + wave2 * 12288);
#pragma unroll
      for (int q = 0; q < 4; q++) {
#pragma unroll
        for (int ml = 0; ml < 2; ml++)
#pragma unroll
          for (int nn = 0; nn < 4; nn++)
#pragma unroll
            for (int j = 0; j < 4; j++) stg[(ml * 16 + fq2 * 4 + j) * 68 + nn * 16 + fr2] = acc[q * 2 + ml][nn][j];
        __builtin_amdgcn_wave_barrier();
#pragma unroll
        for (int i = 0; i < 8; i++) {
          const int row = i * 4 + fq2;
          const float4 a = *(const float4*)(stg + row * 68 + fr2 * 4);
          float4 r = rres[q][i];
          r.x += g4.x * a.x; r.y += g4.y * a.y; r.z += g4.z * a.z; r.w += g4.w * a.w;
          *(float4*)(dst + (size_t)(q * 32 + row) * D) = r;
        }
        __builtin_amdgcn_wave_barrier();
      }
    }
    mt = mt2; nt = nt2; it = it2; have = have2; a0 = a1; b0 = b1;
  }
}

DI void moe_prefix(const Params& P, int l, int* tb) {
  __syncthreads();
  if (TIDX == 0) { int s = 0; for (int e = 0; e < 32; e++) { tb[e] = s; s += (P.cnt[l * 32 + e] + 255) >> 8; } tb[32] = s; }
  __syncthreads();
}
DI void moe_e1_phase(const Params& P, int l, char* smem, int* tb) {
  const int tid = TIDX;
  moe_prefix(P, l, tb);
  const int sc = slot_col(), srow = tid >> 3;
  const int MT = tb[32];
  auto setup = [&](int rt, int nt, int (&tok)[8], const half_t*& w1, const half_t*& w3) {
    int e = 0;
    while (tb[e + 1] <= rt) e++;
    const int rl = rt - tb[e], cnt = P.cnt[l * 32 + e];
    const int* lst = P.list + (size_t)e * LCAP;
    w1 = P.Wt1 + ((size_t)(l * 32 + e) * 512 + nt * 64) * 1024 + sc;
    w3 = P.Wt3 + ((size_t)(l * 32 + e) * 512 + nt * 64) * 1024 + sc;
#pragma unroll
    for (int i = 0; i < 8; i++) tok[i] = lst[min(rl * 256 + i * 32 + srow, cnt - 1)] >> 1;
  };
  int it = 0, rt, nt;
  bool have = next_tile(it, MT, 8, rt, nt);
  int tok[8]; const half_t* w1 = nullptr; const half_t* w3 = nullptr;
  if (have) {
    asm volatile("" : "+s"(rt), "+s"(nt));
    setup(rt, nt, tok, w1, w3);
    gemm_prologue([&](int i) { return P.hx + (size_t)tok[i] * D + sc; }, [&](int i) { return ((i & 1) ? w3 : w1) + (size_t)((i >> 1) * 32 + srow) * 1024; }, 16, smem);
  }
#pragma unroll 1
  while (have) {
    int it2 = it + 1, rt2, nt2;
    const bool have2 = next_tile(it2, MT, 8, rt2, nt2);
    int tok2[8]; const half_t* w1n = w1; const half_t* w3n = w3;
#pragma unroll
    for (int i = 0; i < 8; i++) tok2[i] = tok[i];
    if (have2) {
      asm volatile("" : "+s"(rt2), "+s"(nt2));
      setup(rt2, nt2, tok2, w1n, w3n);
    }
    f4 acc[8][4];
    gemm256<true>([&](int i) { return P.hx + (size_t)tok[i] * D + sc; },
                  [&](int i) { return ((i & 1) ? w3 : w1) + (size_t)((i >> 1) * 32 + srow) * 1024; }, 16, smem, acc);
    if (have2) {
      gemm_prologue([&](int i) { return P.hx + (size_t)tok2[i] * D + sc; }, [&](int i) { return ((i & 1) ? w3n : w1n) + (size_t)((i >> 1) * 32 + srow) * 1024; }, 16, smem);
    }
    {
      const int tid2 = TIDX, lane2 = tid2 & 63, wave2 = tid2 >> 6, fr2 = lane2 & 15, fq2 = lane2 >> 4, wr2 = wave2 >> 1, wc2 = wave2 & 1;
      char* stg = smem + 98304 + wave2 * 12288;
      half_t* Hd = P.H + ((size_t)rt * 256 + wr2 * 128) * 512 + nt * 64 + wc2 * 32;
#pragma unroll
      for (int h = 0; h < 2; h++) {
#pragma unroll
        for (int ml = 0; ml < 4; ml++)
#pragma unroll
          for (int n = 0; n < 2; n++)
#pragma unroll
            for (int j = 0; j < 4; j++) {
              float a1 = acc[h * 4 + ml][n][j], a3 = acc[h * 4 + ml][n + 2][j];
              *(half_t*)(stg + (ml * 16 + fq2 * 4 + j) * 80 + (n * 16 + fr2) * 2) = (half_t)(a1 * sigmoidf_(a1) * a3);
            }
        __builtin_amdgcn_wave_barrier();
#pragma unroll
        for (int i = 0; i < 4; i++) {
          const int c = i * 64 + lane2, row = c >> 2, c16 = c & 3;
          h8 v = *(const h8*)(stg + row * 80 + c16 * 16);
          *(h8*)(Hd + (size_t)(h * 64 + row) * 512 + c16 * 8) = v;
        }
        __builtin_amdgcn_wave_barrier();
      }
    }
    rt = rt2; nt = nt2; it = it2; have = have2; w1 = w1n; w3 = w3n;
#pragma unroll
    for (int i = 0; i < 8; i++) tok[i] = tok2[i];
  }
}
DI void moe_e2_phase(const Params& P, int l, char* smem, int* tb) {
  const int tid = TIDX;
  moe_prefix(P, l, tb);
  const int sc = slot_col(), srow = tid >> 3;
  const int MT = tb[32];
  auto ptrs = [&](int rt, int nt, const half_t*& a0, const half_t*& b0) {
    int e = 0;
    while (tb[e + 1] <= rt) e++;
    a0 = P.H + ((size_t)rt * 256 + srow) * 512 + sc;
    b0 = P.Wt2 + ((size_t)(l * 32 + e) * 1024 + nt * 128 + srow) * 512 + sc;
  };
  int it = 0, rt, nt;
  bool have = next_tile(it, MT, 8, rt, nt);
  const half_t* a0 = nullptr; const half_t* b0 = nullptr;
  if (have) {
    asm volatile("" : "+s"(rt), "+s"(nt));
    ptrs(rt, nt, a0, b0);
    gemm_prologue([&](int i) { return a0 + (size_t)i * 32 * 512; }, [&](int i) { return b0 + (size_t)i * 32 * 512; }, 8, smem);
  }
#pragma unroll 1
  while (have) {
    const int tid2 = TIDX, lane2 = tid2 & 63, wave2 = tid2 >> 6, wr2 = wave2 >> 1, wc2 = wave2 & 1;
    int e = 0;
    while (tb[e + 1] <= rt) e++;
    const int rl = rt - tb[e], cnt = P.cnt[l * 32 + e];
    const int* lst = P.list + (size_t)e * LCAP; const float* lstw = P.listW + (size_t)e * LCAP;
    int aa[2][8]; float ww[2][8];
#pragma unroll
    for (int h = 0; h < 2; h++)
#pragma unroll
      for (int i = 0; i < 8; i++) {
        const int idx = rl * 256 + wr2 * 128 + h * 64 + ((i * 64 + lane2) >> 3);
        const int ic = min(idx, cnt - 1);
        const int av = lst[ic]; const float wv = lstw[ic];
        aa[h][i] = idx < cnt ? av : -1; ww[h][i] = wv;
      }
    f4 acc[8][4];
    gemm256<true>([&](int i) { return a0 + (size_t)i * 32 * 512; }, [&](int i) { return b0 + (size_t)i * 32 * 512; }, 8, smem, acc);
    int it2 = it + 1, rt2, nt2;
    const bool have2 = next_tile(it2, MT, 8, rt2, nt2);
    const half_t* a1 = a0; const half_t* b1 = b0;
    if (have2) {
      asm volatile("" : "+s"(rt2), "+s"(nt2));
      ptrs(rt2, nt2, a1, b1);
      gemm_prologue([&](int i) { return a1 + (size_t)i * 32 * 512; }, [&](int i) { return b1 + (size_t)i * 32 * 512; }, 8, smem);
    }
    {
      char* stg = smem + 98304 + wave2 * 12288;
      const int fr2 = lane2 & 15, fq2 = lane2 >> 4;
#pragma unroll
      for (int h = 0; h < 2; h++) {
#pragma unroll
        for (int ml = 0; ml < 4; ml++)
#pragma unroll
          for (int n = 0; n < 4; n++)
#pragma unroll
            for (int j = 0; j < 4; j++) stage_put(stg, ml, n, j, fr2, fq2, acc[h * 4 + ml][n][j]);
        __builtin_amdgcn_wave_barrier();
#pragma unroll
        for (int i = 0; i < 8; i++) {
          const int c = i * 64 + lane2, row = c >> 3, c16 = c & 7;
          h8 v = *(const h8*)(stg + row * 144 + c16 * 16);
          if (aa[h][i] >= 0) {
            const float w = ww[h][i];
#pragma unroll
            for (int u = 0; u < 8; u++) v[u] = (half_t)(w * (float)v[u]);
            *(h8*)(P.yA + (size_t)aa[h][i] * D + nt * 128 + wc2 * 64 + c16 * 8) = v;
          }
        }
        __builtin_amdgcn_wave_barrier();
      }
    }
    rt = rt2; nt = nt2; it = it2; have = have2; a0 = a1; b0 = b1;
  }
}

DI int swap23(int x) { return (x & ~12) | ((x & 4) << 1) | ((x & 8) >> 1); }
DI void attn_item(const Params& P, int l, int b, int head, int row0, int nkeys, char* smem) {
  const int tid = TIDX, lane = tid & 63, wave = tid >> 6, ql = lane & 31, hh = lane >> 5;
  const float lam = P.consts[l * 4 + 0], negc = -P.consts[l * 4 + 1], lam_init = P.consts[l * 4 + 2];
  const int myrow = row0 + wave * 32 + ql;
  h8 qf[2][4];
  {
    const half_t* qp = P.q + (size_t)myrow * 512 + head * 128 + hh * 8;
#pragma unroll
    for (int m = 0; m < 2; m++)
#pragma unroll
      for (int s = 0; s < 4; s++) { qf[m][s] = *(const h8*)(qp + m * 64 + s * 16); }
#pragma unroll
    for (int m = 0; m < 2; m++)
#pragma unroll
      for (int s = 0; s < 4; s++) tie(qf[m][s]);
  }
  f16v o0[4], o1[4];
#pragma unroll
  for (int dt = 0; dt < 4; dt++)
#pragma unroll
    for (int i = 0; i < 16; i++) { o0[dt][i] = 0.f; o1[dt][i] = 0.f; }
  float ls0 = 0.f, ls1 = 0.f;
  const half_t* kp[4]; const half_t* vp[4];
  {
    const half_t* kbase = P.kall + (size_t)b * KV * 512 + head * 128;
    const half_t* vbase = P.vT + (size_t)(b * 4 + head) * 128 * KV;
#pragma unroll
    for (int i = 0; i < 4; i++) {
      int s = i * 256 + tid;
      int row = s >> 4, c = (s & 15) ^ (row & 15); kp[i] = kbase + (size_t)row * 512 + c * 8;
      int vr = s >> 3, vc = (s & 7) ^ ((vr >> 1) & 7); vp[i] = vbase + (size_t)vr * KV + vc * 8;
    }
  }
  const int ntile = nkeys >> 6;
  const unsigned sbase = lds_addr(smem);
  auto issue = [&](int t) {
    char* d = smem + (t & 3) * 32768 + tid * 16;
#pragma unroll
    for (int i = 0; i < 4; i++) { glds16(kp[i] + (size_t)t * 64 * 512, d + i * 4096); glds16(vp[i] + t * 64, d + 16384 + i * 4096); }
  };
  unsigned koff[2];
  const int kr_lo = swap23(ql), ksw = kr_lo & 15;
  koff[0] = kr_lo * 256; koff[1] = (32 + kr_lo) * 256;
  unsigned voff[4];
#pragma unroll
  for (int dt = 0; dt < 4; dt++) { int vrow = dt * 32 + ql; voff[dt] = 16384 + vrow * 128; }
  const int vsw = (ql >> 1) & 7;
  f16v negcv;
#pragma unroll
  for (int i = 0; i < 16; i++) negcv[i] = negc;
  h8 pp0[2], pp1[2];
  unsigned pendV = 0; int pendkt = 0; bool pend = false;
  auto half_step = [&](h8 (&kf)[8], unsigned cur, int kt) {
    h8 vf[8];
    if (pend) {
#pragma unroll
      for (int sp = 0; sp < 2; sp++)
#pragma unroll
        for (int dt = 0; dt < 4; dt++) vf[sp * 4 + dt] = lds128(pendV + voff[dt] + (((pendkt * 4 + sp * 2 + hh) ^ vsw) << 4));
    }
    f16v s0 = mfma32(kf[0], qf[0][0], negcv), s1 = mfma32(kf[4], qf[1][0], negcv);
#pragma unroll
    for (int st = 1; st < 4; st++) { s0 = mfma32(kf[st], qf[0][st], s0); s1 = mfma32(kf[4 + st], qf[1][st], s1); }
    if (pend) {
      WAIT_LGKM(0);
#pragma unroll
      for (int i = 0; i < 8; i++) tie(vf[i]);
#pragma unroll
      for (int sp = 0; sp < 2; sp++)
#pragma unroll
        for (int dt = 0; dt < 4; dt++) { o0[dt] = mfma32(vf[sp * 4 + dt], pp0[sp], o0[dt]); o1[dt] = mfma32(vf[sp * 4 + dt], pp1[sp], o1[dt]); }
    }
#pragma unroll
    for (int i = 0; i < 16; i++) { s0[i] = __builtin_amdgcn_exp2f(s0[i]); ls0 += s0[i]; s1[i] = __builtin_amdgcn_exp2f(s1[i]); ls1 += s1[i]; }
#pragma unroll
    for (int sp = 0; sp < 2; sp++) {
      u4 a, c;
      a[0] = pk2(s0[8*sp+0], s0[8*sp+1]); a[1] = pk2(s0[8*sp+2], s0[8*sp+3]); a[2] = pk2(s0[8*sp+4], s0[8*sp+5]); a[3] = pk2(s0[8*sp+6], s0[8*sp+7]);
      c[0] = pk2(s1[8*sp+0], s1[8*sp+1]); c[1] = pk2(s1[8*sp+2], s1[8*sp+3]); c[2] = pk2(s1[8*sp+4], s1[8*sp+5]); c[3] = pk2(s1[8*sp+6], s1[8*sp+7]);
      pp0[sp] = __builtin_bit_cast(h8, a); pp1[sp] = __builtin_bit_cast(h8, c);
    }
    pend = true; pendV = cur; pendkt = kt;
  };
  issue(0);
  if (ntile > 1) issue(1);
#pragma unroll 1
  for (int t = 0; t < ntile; t++) {
    if (t + 1 < ntile) asm volatile("s_waitcnt vmcnt(8)" ::: "memory"); else wait_vm0();
    raw_barrier();
    if (t + 2 < ntile) issue(t + 2);
    const unsigned cur = sbase + (t & 3) * 32768;
    h8 kfa[8], kfb[8];
#pragma unroll
    for (int st = 0; st < 4; st++) {
      kfa[st] = lds128(cur + koff[0] + (((st * 2 + hh) ^ ksw) << 4));
      kfa[4 + st] = lds128(cur + koff[0] + (((8 + st * 2 + hh) ^ ksw) << 4));
    }
#pragma unroll
    for (int st = 0; st < 4; st++) {
      kfb[st] = lds128(cur + koff[1] + (((st * 2 + hh) ^ ksw) << 4));
      kfb[4 + st] = lds128(cur + koff[1] + (((8 + st * 2 + hh) ^ ksw) << 4));
    }
    WAIT_LGKM(8);
#pragma unroll
    for (int i = 0; i < 8; i++) tie(kfa[i]);
    half_step(kfa, cur, 0);
    WAIT_LGKM(0);
#pragma unroll
    for (int i = 0; i < 8; i++) tie(kfb[i]);
    half_step(kfb, cur, 1);
  }
  {
    h8 vf[8];
#pragma unroll
    for (int sp = 0; sp < 2; sp++)
#pragma unroll
      for (int dt = 0; dt < 4; dt++) vf[sp * 4 + dt] = lds128(pendV + voff[dt] + (((pendkt * 4 + sp * 2 + hh) ^ vsw) << 4));
    WAIT_LGKM(0);
#pragma unroll
    for (int i = 0; i < 8; i++) tie(vf[i]);
#pragma unroll
    for (int sp = 0; sp < 2; sp++)
#pragma unroll
      for (int dt = 0; dt < 4; dt++) { o0[dt] = mfma32(vf[sp * 4 + dt], pp0[sp], o0[dt]); o1[dt] = mfma32(vf[sp * 4 + dt], pp1[sp], o1[dt]); }
  }
  raw_barrier();
  ls0 += shx(ls0, 32); ls1 += shx(ls1, 32);
  const float i0 = 1.f / ls0, i1 = lam / ls1;
  float ss = 0.f;
#pragma unroll
  for (int dt = 0; dt < 4; dt++)
#pragma unroll
    for (int i = 0; i < 16; i++) { float v = o0[dt][i] * i0 - o1[dt][i] * i1; o0[dt][i] = v; ss += v * v; }
  ss += shx(ss, 32);
  const float mult = rsqrtf(ss * (1.f / 128.f) + EPS) * (1.f - lam_init);
  const float* sg = P.subln_g + l * 128;
  half_t* dst = P.mix + (size_t)myrow * D + 256 + head * 128;
#pragma unroll
  for (int dt = 0; dt < 4; dt++)
#pragma unroll
    for (int g = 0; g < 4; g++) {
      const int d0 = dt * 32 + 8 * g + 4 * hh;
      float4 gv = *(const float4*)(sg + d0);
      h4 o; o[0] = (half_t)(o0[dt][4*g] * mult * gv.x); o[1] = (half_t)(o0[dt][4*g+1] * mult * gv.y);
      o[2] = (half_t)(o0[dt][4*g+2] * mult * gv.z); o[3] = (half_t)(o0[dt][4*g+3] * mult * gv.w);
      *(h4*)(dst + d0) = o;
    }
}

DI int swz128(int row, int colh) { return row * 128 + ((((colh >> 3)) ^ ((row >> 1) & 7)) << 4) + (colh & 7) * 2; }
DI void lru_load_w(const Params& P, int l, int g, char* Wt) {
  const int tid = TIDX;
  for (int dg = 0; dg < 4; dg++) {
    const int dir = dg >> 1;
    const float* w = ((dg & 1) ? P.gate_x_w : P.gate_a_w) + ((size_t)((l * 2 + dir) * 4 + g)) * 4096;
    for (int idx = tid; idx < 4096; idx += 256) { int i = idx >> 6, o = idx & 63; *(half_t*)(Wt + dg * 8192 + swz128(o, i)) = (half_t)w[idx]; }
  }
}
struct LruK { float ba[2][4], bx[2][4], sp8[2][4], cw[5]; };
DI void lru_consts(const Params& P, int l, int g, LruK& K) {
  const int tid = TIDX, fr = tid & 15, gc = g * 64 + (tid & 63);
#pragma unroll
  for (int dir = 0; dir < 2; dir++)
#pragma unroll
    for (int n = 0; n < 4; n++) {
      const int cc = (l * 2 + dir) * 256 + g * 64 + n * 16 + fr;
      K.ba[dir][n] = P.gate_a_b[cc]; K.bx[dir][n] = P.gate_x_b[cc]; K.sp8[dir][n] = -8.f * log1pf(__expf(-P.lru_lambda[cc]));
    }
#pragma unroll
  for (int k = 0; k < 4; k++) K.cw[k] = P.conv_w[(l * 4 + k) * 256 + gc];
  K.cw[4] = P.conv_b[l * 256 + gc];
}
DI void lru_tile(const Params& P, int l, int b, int tile, int g, char* smem, bool final, const LruK& K) {
  const int tid = TIDX, lane = tid & 63, wave = tid >> 6, fr = lane & 15, fq = lane >> 4;
  char* Wt = smem;
  char* xr16 = smem + 32768;
  float2* ab = (float2*)(smem + 40960);
  half_t* raw = (half_t*)(smem + 40960);
  float2* subst = (float2*)(smem + 73728);
  const int ch = tid & 63, tq = tid >> 6, gc = g * 64 + ch;
  const int T = tile < 4 ? CL : SEQ;
  const int t0 = tile < 4 ? tile * 64 : (tile - 4) * 64;
  const int rowbase = tile < 4 ? b * CL : TC + b * SEQ;
  unsigned* lab = (unsigned*)P.hx;
  __syncthreads();
  if (final) {
    float gyv[16], hsum[16];
#pragma unroll
    for (int e = 0; e < 16; e++) { gyv[e] = (float)P.gy[(size_t)(rowbase + t0 + tq * 16 + e) * 256 + gc]; hsum[e] = 0.f; }
    unsigned pk0[16], pk1[16];
#pragma unroll
    for (int e = 0; e < 16; e++) { pk0[e] = lab[((size_t)rowbase + t0 + tq * 16 + e) * 256 + gc]; pk1[e] = lab[((size_t)TA + rowbase + t0 + tq * 16 + e) * 256 + gc]; }
    const float car0 = P.lcar[((size_t)((b * 2 + 0) * 132 + tile)) * 256 + gc], car1 = P.lcar[((size_t)((b * 2 + 1) * 132 + tile)) * 256 + gc];
#pragma unroll 1
    for (int dir = 0; dir < 2; dir++) {
      unsigned pk[16];
#pragma unroll
      for (int e = 0; e < 16; e++) pk[e] = dir == 0 ? pk0[e] : pk1[e];
      float2 av[16];
      float A = 1.f, h = 0.f;
#pragma unroll
      for (int e = 0; e < 16; e++) {
        const int ee = dir == 0 ? e : 15 - e;
        unsigned u = pk[0];
#pragma unroll
        for (int q = 1; q < 16; q++) u = (q == ee) ? pk[q] : u;
        fp16x2 hv = __builtin_bit_cast(fp16x2, u);
        av[e] = make_float2(__expf((float)hv[0]), (float)hv[1]);
        h = av[e].x * h + av[e].y; A *= av[e].x;
      }
      subst[tq * 64 + ch] = make_float2(A, h);
      __syncthreads();
      h = dir == 0 ? car0 : car1;
      if (dir == 0) { for (int s2 = 0; s2 < tq; s2++) { float2 ss = subst[s2 * 64 + ch]; h = ss.x * h + ss.y; } }
      else { for (int s2 = 3; s2 > tq; s2--) { float2 ss = subst[s2 * 64 + ch]; h = ss.x * h + ss.y; } }
#pragma unroll
      for (int e = 0; e < 16; e++) {
        const int ee = dir == 0 ? e : 15 - e;
        h = av[e].x * h + av[e].y;
#pragma unroll
        for (int q = 0; q < 16; q++) hsum[q] += (q == ee) ? h : 0.f;
      }
      __syncthreads();
    }
#pragma unroll
    for (int e = 0; e < 16; e++)
      P.mix[(size_t)(rowbase + t0 + tq * 16 + e) * D + 768 + gc] = (half_t)(gyv[e] * hsum[e]);
    return;
  }
  for (int idx = tid; idx < 67 * 8; idx += 256) {
    int row = idx >> 3, c = idx & 7, tt = t0 - 1 + row;
    h8 v = {0, 0, 0, 0, 0, 0, 0, 0};
    if (tt >= 0 && tt < T) v = *(const h8*)(P.rr + (size_t)(rowbase + tt) * 256 + g * 64 + c * 8);
    *(h8*)(raw + row * 64 + c * 8) = v;
  }
  const float cw0 = K.cw[0], cw1 = K.cw[1], cw2 = K.cw[2], cw3 = K.cw[3], cb = K.cw[4];
  __syncthreads();
  {
    float v[19];
#pragma unroll
    for (int e = 0; e < 19; e++) v[e] = (float)raw[(tq * 16 + e) * 64 + ch];
    __syncthreads();
#pragma unroll
    for (int e = 0; e < 16; e++) {
      float xv = cb + cw0 * v[e] + cw1 * v[e + 1] + cw2 * v[e + 2] + cw3 * v[e + 3];
      *(half_t*)(xr16 + swz128(tq * 16 + e, ch)) = (half_t)xv;
    }
  }
  __syncthreads();
#pragma unroll 1
  for (int dir = 0; dir < 2; dir++) {
    {
      f4 acc[2][4];
#pragma unroll
      for (int gt = 0; gt < 2; gt++)
#pragma unroll
        for (int n = 0; n < 4; n++) acc[gt][n] = (f4){0.f, 0.f, 0.f, 0.f};
#pragma unroll
      for (int kk = 0; kk < 2; kk++) {
        int row = wave * 16 + fr;
        h8 af = *(const h8*)(xr16 + row * 128 + (((kk * 4 + fq) ^ ((row >> 1) & 7)) << 4));
#pragma unroll
        for (int gt = 0; gt < 2; gt++)
#pragma unroll
          for (int n = 0; n < 4; n++) {
            int orow = n * 16 + fr;
            h8 bf = *(const h8*)(Wt + (dir * 2 + gt) * 8192 + orow * 128 + (((kk * 4 + fq) ^ ((orow >> 1) & 7)) << 4));
            acc[gt][n] = mfma16(af, bf, acc[gt][n]);
          }
      }
#pragma unroll
      for (int n = 0; n < 4; n++) {
        const float ba = dir == 0 ? K.ba[0][n] : K.ba[1][n], bx = dir == 0 ? K.bx[0][n] : K.bx[1][n], sp8 = dir == 0 ? K.sp8[0][n] : K.sp8[1][n];
#pragma unroll
        for (int j = 0; j < 4; j++) {
          int tl = wave * 16 + fq * 4 + j, c2 = n * 16 + fr;
          float xv = (float)*(const half_t*)(xr16 + swz128(tl, c2));
          float rg = sigmoidf_(acc[0][n][j] + ba), ig = sigmoidf_(acc[1][n][j] + bx);
          float log_a = rg * sp8;
          float x2 = 2.f * log_a;
          float om = -x2 * (1.f + x2 * (0.5f + x2 * (0.16666667f + x2 * (0.041666668f + x2 * (0.008333334f + x2 * 0.0013888889f)))));
          if (x2 < -0.4f) { float a = __expf(log_a); om = 1.f - a * a; }
          ab[tl * 64 + c2] = make_float2(log_a, sqrtf(om) * (ig * xv));
        }
      }
    }
    __syncthreads();
    {
      float A = 1.f, h = 0.f;
#pragma unroll
      for (int e = 0; e < 16; e++) {
        const int ee = dir == 0 ? e : 15 - e;
        const float2 lb = ab[(tq * 16 + ee) * 64 + ch];
        fp16x2 hv; hv[0] = (__fp16)lb.x; hv[1] = (__fp16)lb.y;
        lab[((size_t)dir * TA + rowbase + t0 + tq * 16 + ee) * 256 + gc] = __builtin_bit_cast(unsigned, hv);
        const float a = __expf((float)hv[0]), bt = (float)hv[1];
        h = a * h + bt; A *= a;
      }
      subst[tq * 64 + ch] = make_float2(A, h);
    }
    __syncthreads();
    if (tq == 0) {
      float A = 1.f, h = 0.f;
#pragma unroll
      for (int s2 = 0; s2 < 4; s2++) { float2 ss = subst[(dir == 0 ? s2 : 3 - s2) * 64 + ch]; h = ss.x * h + ss.y; A *= ss.x; }
      P.lsum[((size_t)((b * 2 + dir) * 132 + tile)) * 256 + gc] = make_float2(A, h);
    }
    __syncthreads();
  }
}
DI void lru_carry_item(const Params& P, int it) {
  const int ch = TIDX, dir = it & 1;
  const size_t base = (size_t)it * 132 * 256 + ch;
  float c = 0.f;
#pragma unroll 4
  for (int k = 0; k < 132; k++) {
    int tile = dir == 0 ? k : (k < 4 ? 3 - k : 135 - k);
    float2 s = P.lsum[base + (size_t)tile * 256];
    P.lcar[base + (size_t)tile * 256] = c;
    c = s.x * c + s.y;
  }
}

template <int NROWS>
DI void fft_load(const half_t* src, size_t rs, char* Bt, int rowbytes, int k0) {
  const int tid = TIDX;
  h8 v[NROWS / 16];
#pragma unroll
  for (int i = 0; i < NROWS / 16; i++) { int idx = i * 256 + tid; v[i] = *(const h8*)(src + (size_t)(idx >> 4) * rs + (idx & 15) * 8); }
#pragma unroll
  for (int i = 0; i < NROWS / 16; i++) {
    int idx = i * 256 + tid, kr = idx >> 4, cc = idx & 15, k = k0 + kr;
#pragma unroll
    for (int u = 0; u < 8; u++) { int n = cc * 8 + u; *(half_t*)(Bt + n * rowbytes + ((((k >> 3)) ^ (n & 15)) << 4) + (k & 7) * 2) = v[i][u]; }
  }
}
template <class RF>
DI void fft_mma(const half_t* Dm, int ldD, int nkk, const char* Bt, int rowbytes, f4 (&acc)[4][4], RF arow) {
  const int lane = TIDX & 63, wave = TIDX >> 6, fr = lane & 15, fq = lane >> 4, wc = wave & 1;
#pragma unroll 4
  for (int kk = 0; kk < nkk; kk++) {
    h8 af[4], bf[4];
#pragma unroll
    for (int ms = 0; ms < 4; ms++) af[ms] = *(const h8*)(Dm + (size_t)arow(ms) * ldD + kk * 32 + fq * 8);
#pragma unroll
    for (int ns = 0; ns < 4; ns++) { int n = wc * 64 + ns * 16 + fr; bf[ns] = *(const h8*)(Bt + n * rowbytes + (((kk * 4 + fq) ^ (n & 15)) << 4)); }
#pragma unroll
    for (int ms = 0; ms < 4; ms++)
#pragma unroll
      for (int ns = 0; ns < 4; ns++) acc[ms][ns] = mfma16(af[ms], bf[ns], acc[ms][ns]);
  }
}
DI void zero44(f4 (&acc)[4][4]) {
#pragma unroll
  for (int m = 0; m < 4; m++)
#pragma unroll
    for (int n = 0; n < 4; n++) acc[m][n] = (f4){0.f, 0.f, 0.f, 0.f};
}
DI void fftA_item(const Params& P, int it, char* smem) {
  const int b = it >> 8, bb = (it >> 1) & 127, chh = it & 1;
  const int lane = TIDX & 63, wave = TIDX >> 6, fr = lane & 15, fq = lane >> 4, wr = wave >> 1, wc = wave & 1;
  __syncthreads();
  fft_load<64>(P.QF + (size_t)(TC + b * SEQ + bb) * 512 + chh * 128, (size_t)128 * 512, smem, 256, 0);
  fft_load<64>(P.QF + (size_t)(TC + b * SEQ + bb) * 512 + 256 + chh * 128, (size_t)128 * 512, smem, 256, 64);
  __syncthreads();
  f4 acc[4][4]; zero44(acc);
  fft_mma(P.DA, 128, 4, smem, 256, acc, [&](int ms) { return (ms >> 1) * 64 + wr * 32 + (ms & 1) * 16 + fr; });
#pragma unroll
  for (int ms = 0; ms < 2; ms++)
#pragma unroll
    for (int j = 0; j < 4; j++) {
      const int f1 = wr * 32 + ms * 16 + fq * 4 + j;
      const float2 w = P.tw[(bb * f1) & 8191];
      half_t* d0 = P.GA + ((size_t)(b * 64 + f1) * 256 + bb) * 256 + chh * 128 + wc * 64 + fr;
#pragma unroll
      for (int ns = 0; ns < 4; ns++) {
        float gr = acc[ms][ns][j], gi = acc[ms + 2][ns][j];
        d0[ns * 16] = (half_t)(gr * w.x + gi * w.y);
        d0[(size_t)128 * 256 + ns * 16] = (half_t)(gi * w.x - gr * w.y);
      }
    }
}
DI void fftB_item(const Params& P, int it, char* smem) {
  const int b = it >> 7, f1 = (it >> 1) & 63, chh = it & 1;
  const int lane = TIDX & 63, wave = TIDX >> 6, fr = lane & 15, fq = lane >> 4, wr = wave >> 1, wc = wave & 1;
  __syncthreads();
  fft_load<256>(P.GA + (size_t)(b * 64 + f1) * 256 * 256 + chh * 128, 256, smem, 512, 0);
  __syncthreads();
  f4 acc[4][4]; zero44(acc);
  fft_mma(P.DB, 256, 8, smem, 512, acc, [&](int ms) { return wr * 64 + ms * 16 + fr; });
#pragma unroll
  for (int ms = 0; ms < 4; ms++)
#pragma unroll
    for (int j = 0; j < 4; j++) {
      const int f2 = wr * 64 + ms * 16 + fq * 4 + j;
      half_t* d0 = P.mix + (size_t)(TC + b * SEQ + f1 + 64 * f2) * D + chh * 128 + wc * 64 + fr;
#pragma unroll
      for (int ns = 0; ns < 4; ns++) d0[ns * 16] = (half_t)acc[ms][ns][j];
    }
}
DI void fftC_item(const Params& P, int it, char* smem) {
  const int b = it >> 1, chh = it & 1;
  const int lane = TIDX & 63, wave = TIDX >> 6, fr = lane & 15, fq = lane >> 4, wr = wave >> 1, wc = wave & 1;
#pragma unroll 1
  for (int mh = 0; mh < 2; mh++) {
    f4 acc[4][4]; zero44(acc);
#pragma unroll 1
    for (int part = 0; part < 2; part++) {
      __syncthreads();
      fft_load<256>(P.QF + (size_t)(b * CL) * 512 + part * 256 + chh * 128, 512, smem, 512, 0);
      __syncthreads();
      fft_mma(P.DC + part * 256, 512, 8, smem, 512, acc, [&](int ms) { return mh * 128 + wr * 64 + ms * 16 + fr; });
    }
#pragma unroll
    for (int ms = 0; ms < 4; ms++)
#pragma unroll
      for (int j = 0; j < 4; j++) {
        const int f = mh * 128 + wr * 64 + ms * 16 + fq * 4 + j;
        half_t* d0 = P.mix + (size_t)(b * CL + f) * D + chh * 128 + wc * 64 + fr;
#pragma unroll
        for (int ns = 0; ns < 4; ns++) d0[ns * 16] = (half_t)acc[ms][ns][j];
      }
  }
}

#ifndef MX
#define MX 15
#endif
DI void mix_phase(const Params& P, int l, char* smem, int* s_item, int qi) {
  const int nL = 0, nA = 0, nC = l == 0 ? 64 : 0, nFA = 2048, nFC = l == 0 ? 16 : 0;
  const int total = nL + nA + nC + nFA + nFC;
  {
    const int g = blockIdx.x & 3;
    lru_load_w(P, l, g, smem);
    LruK K; lru_consts(P, l, g, K);
    for (int u = blockIdx.x >> 2; u < NB_ * 132; u += gridDim.x >> 2) lru_tile(P, l, u / 132, u % 132, g, smem, false, K);
    asm volatile("s_waitcnt vmcnt(0)" ::: "memory");
    __syncthreads();
    if (TIDX == 0) {
      __builtin_amdgcn_fence(__ATOMIC_RELEASE, "agent");
      asm volatile("s_waitcnt vmcnt(0)" ::: "memory");
      __hip_atomic_fetch_add((unsigned*)&P.qctr[48 + l], 1u, __ATOMIC_RELAXED, __HIP_MEMORY_SCOPE_AGENT);
    }
  }
  int stage = 0;
  for (;;) {
    __syncthreads();
    if (TIDX == 0) *s_item = stage == 0 ? atomicAdd(&P.qctr[8 + qi * 8 + (blockIdx.x & 7)], 1) : atomicAdd(&P.qctr[qi], 1);
    __syncthreads();
    int it = *s_item;
    int kind = -1, b = 0, head = 0, row0 = 0, nk = 0;
    if (stage == 0) {
      if (it >= 256) {
        stage = 1;
        if (blockIdx.x >= gridDim.x - 16) {
          if (TIDX == 0) {
            while (__hip_atomic_load((unsigned*)&P.qctr[48 + l], __ATOMIC_RELAXED, __HIP_MEMORY_SCOPE_AGENT) < gridDim.x) __builtin_amdgcn_s_sleep(1);
            __builtin_amdgcn_fence(__ATOMIC_ACQUIRE, "agent");
            asm volatile("s_waitcnt vmcnt(0)" ::: "memory");
          }
          __syncthreads();
          lru_carry_item(P, gridDim.x - 1 - blockIdx.x);
        }
        continue;
      }
      const int pair = (blockIdx.x & 7) + 8 * (it >> 6);
      b = pair >> 2; head = pair & 3; row0 = TC + b * SEQ + (it & 63) * 128; nk = KV; kind = 0;
    } else {
      if (it >= total) break;
      if (it < nFC) { kind = 2; }
      else if (it < nFC + nC) { it -= nFC; b = it >> 3; head = (it >> 1) & 3; row0 = b * CL + (it & 1) * 128; nk = CL; kind = 0; }
      else { kind = 1; it -= nFC + nC; }
    }
    if (kind == 0) attn_item(P, l, b, head, row0, nk, smem);
    else if (kind == 1) fftA_item(P, it, smem);
    else fftC_item(P, it, smem);
  }
}

DI void grid_barrier(unsigned* bar, unsigned k, unsigned xn, unsigned nx) {
  asm volatile("s_waitcnt vmcnt(0)" ::: "memory");
  __syncthreads();
  if (threadIdx.x == 0) {
    const unsigned x = (unsigned)__builtin_amdgcn_s_getreg((3 << 11) | 20) & 0x7u;
    unsigned* xc = bar + 16 + x * 16; unsigned* top = bar;
    const unsigned old = __hip_atomic_fetch_add(xc, 1u, __ATOMIC_RELAXED, __HIP_MEMORY_SCOPE_AGENT);
    if (old == k * xn - 1u) {
      __builtin_amdgcn_fence(__ATOMIC_RELEASE, "agent");
      asm volatile("s_waitcnt vmcnt(0)" ::: "memory");
      __hip_atomic_fetch_add(top, 1u, __ATOMIC_RELAXED, __HIP_MEMORY_SCOPE_AGENT);
    }
    while (__hip_atomic_load(top, __ATOMIC_RELAXED, __HIP_MEMORY_SCOPE_AGENT) < k * nx) __builtin_amdgcn_s_sleep(1);
    __builtin_amdgcn_fence(__ATOMIC_ACQUIRE, "agent");
    asm volatile("s_waitcnt vmcnt(0)" ::: "memory");
  }
  __syncthreads();
}
__global__ void __launch_bounds__(256, 1) fwd_megakernel(Params Pin) {
  Params P = Pin; bind_ws(P);
  __shared__ __attribute__((aligned(16))) char smem[147456 + 8192];
  __shared__ int tb[33];
  __shared__ int s_item;
  cg::grid_group grid = cg::this_grid();
  unsigned* bar = (unsigned*)(P.ws + O_bar); unsigned bk = 0;
  if (threadIdx.x == 0) __hip_atomic_fetch_add(bar + 160 + ((unsigned)__builtin_amdgcn_s_getreg((3 << 11) | 20) & 0x7u), 1u, __ATOMIC_RELAXED, __HIP_MEMORY_SCOPE_AGENT);
#ifndef PH
#define PH 0xFFFF
#endif
#if PH & 1
  phase0(P, smem);
#endif
  grid.sync();
  unsigned xn, nx = 0;
  {
    const unsigned myx = (unsigned)__builtin_amdgcn_s_getreg((3 << 11) | 20) & 0x7u;
    xn = __hip_atomic_load(bar + 160 + myx, __ATOMIC_RELAXED, __HIP_MEMORY_SCOPE_AGENT);
#pragma unroll
    for (int x = 0; x < 8; x++) nx += __hip_atomic_load(bar + 160 + x, __ATOMIC_RELAXED, __HIP_MEMORY_SCOPE_AGENT) != 0u;
  }
  for (int l = 0; l < 2; l++) {
#if PH & 2
    row1_phase(P, l == 0 ? -1 : 0, l, 0);
#endif
    grid_barrier(bar, ++bk, xn, nx);
#if PH & 4
    gemm_in_phase(P, l, smem);
#ifdef DUP_GEMM
    grid_barrier(bar, ++bk, xn, nx);
    gemm_in_phase(P, l, smem);
#endif
#endif
    grid_barrier(bar, ++bk, xn, nx);
#if PH & 8
    mix_phase(P, l, smem, &s_item, l);
#ifdef DUP_MIX
    grid_barrier(bar, ++bk, xn, nx);
    mix_phase(P, l, smem, &s_item, 2 + l);
#endif
#endif
    grid_barrier(bar, ++bk, xn, nx);
#if PH & 16
    for (int it = blockIdx.x; it < 1024; it += gridDim.x) fftB_item(P, it, smem);
#endif
#if PH & 512
    {
      const int g = blockIdx.x & 3;
      LruK K{};
      for (int u = blockIdx.x >> 2; u < NB_ * 132; u += gridDim.x >> 2) lru_tile(P, l, u / 132, u % 132, g, smem, true, K);
    }
#endif
    grid_barrier(bar, ++bk, xn, nx);
#if PH & 32
    gemm_out_phase(P, l, smem);
#endif
    grid_barrier(bar, ++bk, xn, nx);
#if PH & 64
    row2_phase(P, l, l == 0 ? 0 : TC, smem);
#endif
    grid_barrier(bar, ++bk, xn, nx);
#if PH & 128
    moe_e1_phase(P, l, smem, tb);
#ifdef DUP_GEMM
    grid_barrier(bar, ++bk, xn, nx);
    moe_e1_phase(P, l, smem, tb);
#endif
#endif
    grid_barrier(bar, ++bk, xn, nx);
#if PH & 256
    moe_e2_phase(P, l, smem, tb);
#ifdef DUP_GEMM
    grid_barrier(bar, ++bk, xn, nx);
    moe_e2_phase(P, l, smem, tb);
#endif
#endif
    grid_barrier(bar, ++bk, xn, nx);
  }
#if PH & 2
  row1_phase(P, 1, -1, TC);
#endif
}

extern "C" void kernel_launch(void* const* d_in, const int* in_sizes, int n_in, void* d_out, int out_size, void* d_ws, size_t ws_size,
                              hipStream_t stream) {
  static int grid_blocks = 0;
  if (!grid_blocks) {
    int dev = 0, cus = 0, per_cu = 0;
    hipGetDevice(&dev);
    hipDeviceGetAttribute(&cus, hipDeviceAttributeMultiprocessorCount, dev);
    hipOccupancyMaxActiveBlocksPerMultiprocessor(&per_cu, fwd_megakernel, 256, 0);
    if (per_cu > 2) per_cu = 2;
    grid_blocks = cus * per_cu;
    if (grid_blocks > 256) grid_blocks = 256;
  }
  if (grid_blocks != 256) { fprintf(stderr, "need 256 co-resident blocks, have %d\n", grid_blocks); return; }
  Params p{};
  const float** pin = (const float**)&p;
  for (int i = 0; i < 31; i++) pin[i] = (const float*)d_in[i];
  p.out = (float*)d_out;
  p.ws = (char*)d_ws;
  if (WS_NEED > ws_size) { fprintf(stderr, "workspace too small: need %zu have %zu\n", (size_t)WS_NEED, ws_size); return; }
  hipMemsetAsync((char*)d_ws + O_bar, 0, 1024, stream);
  void* args[] = {&p};
  hipError_t e = hipLaunchCooperativeKernel((void*)fwd_megakernel, dim3(grid_blocks), dim3(256), args, 0, stream);
  if (e != hipSuccess) fprintf(stderr, "cooperative launch failed: %s (grid %d)\n", hipGetErrorString(e), grid_blocks);
}
```

```cpp
#include <hip/hip_runtime.h>
#include <hip/hip_cooperative_groups.h>
#include <cstdio>
namespace cg = cooperative_groups;

typedef _Float16 half_t;
typedef _Float16 h8 __attribute__((ext_vector_type(8)));
typedef _Float16 h4 __attribute__((ext_vector_type(4)));
typedef __fp16 fp16x2 __attribute__((ext_vector_type(2)));
typedef unsigned u4 __attribute__((ext_vector_type(4)));
typedef float f4 __attribute__((ext_vector_type(4)));
typedef float f16v __attribute__((ext_vector_type(16)));
#define DI __device__ __forceinline__
__device__ __forceinline__ int tid_opaque() { int t = threadIdx.x; asm volatile("" : "+v"(t)); return t; }
#define TIDX tid_opaque()

constexpr int D = 1024, NB_ = 8, SEQ = 8192, CL = 256;
constexpr int TC = NB_ * CL;
constexpr int TX = NB_ * SEQ;
constexpr int TA = TC + TX;
constexpr int KV = CL + SEQ;
constexpr int NIN = 2560;
constexpr int LCAP = 2 * TA;
constexpr float EPS = 1e-6f;

struct Params {
  const float *x, *c, *ctx, *c_ctx, *w_mod, *b_mod, *norm1_g, *norm2_g, *w_in, *q_norm_g, *k_norm_g, *lq1, *lk1, *lq2, *lk2,
      *subln_g, *conv_w, *conv_b, *gate_a_w, *gate_a_b, *gate_x_w, *gate_x_b, *lru_lambda, *w_out, *w_group, *b_group,
      *w_router, *b_router, *w1, *w3, *w2;
  float* out; char* ws;
  half_t *WtIn, *WtOut, *Wt1, *Wt3, *Wt2;
  float* mod; float2* rope; float2* tw; half_t *DA, *DB, *DC; float* consts; int* cnt; int* qctr; float* tokW; int* list; float* listW;
  float* xcbuf; half_t* WrH;
  half_t *hx, *mix, *q, *kall, *vT, *QF, *gy, *rr; float2* lsum; float* lcar; half_t* GA; half_t *H, *yA;
};


constexpr size_t al256(size_t x) { return (x + 255) & ~(size_t)255; }
constexpr size_t O_WtIn = 0;
constexpr size_t O_WtOut = O_WtIn + al256((size_t)2 * NIN * 1024 * 2);
constexpr size_t O_Wt1 = O_WtOut + al256((size_t)2 * 1024 * 1024 * 2);
constexpr size_t O_Wt3 = O_Wt1 + al256((size_t)64 * 524288 * 2);
constexpr size_t O_Wt2 = O_Wt3 + al256((size_t)64 * 524288 * 2);
constexpr size_t O_mod = O_Wt2 + al256((size_t)64 * 524288 * 2);
constexpr size_t O_rope = O_mod + al256((size_t)2 * 9 * 6144 * 4);
constexpr size_t O_tw = O_rope + al256(128 * 16 * 8);
constexpr size_t O_DA = O_tw + al256(8192 * 8);
constexpr size_t O_DB = O_DA + al256(16384 * 2);
constexpr size_t O_DC = O_DB + al256(32768 * 2);
constexpr size_t O_consts = O_DC + al256(131072 * 2);
constexpr size_t O_cnt = O_consts + 256;
constexpr size_t O_qctr = O_cnt + 256;
constexpr size_t O_bar = O_qctr + 256;
constexpr size_t O_tokW = O_bar + 1024;
constexpr size_t O_list = O_tokW + al256((size_t)2 * TA * 4);
constexpr size_t O_listW = O_list + al256((size_t)32 * LCAP * 4);
constexpr size_t O_xcbuf = O_listW + al256((size_t)32 * LCAP * 4);
constexpr size_t O_WrT = O_xcbuf + al256((size_t)TC * D * 4);
constexpr size_t O_hx = O_WrT + al256((size_t)2 * 2 * 48 * 1024 * 2);
constexpr size_t O_mix = O_hx + al256((size_t)TA * D * 2);
constexpr size_t O_regB = O_mix + al256((size_t)TA * D * 2);
constexpr size_t O_q = O_regB;
constexpr size_t O_kall = O_q + al256((size_t)TA * 512 * 2);
constexpr size_t O_vT = O_kall + al256((size_t)NB_ * KV * 512 * 2);
constexpr size_t O_QF = O_vT + al256((size_t)NB_ * 4 * 128 * KV * 2);
constexpr size_t O_gy = O_QF + al256((size_t)TA * 512 * 2);
constexpr size_t O_rr = O_gy + al256((size_t)TA * 256 * 2);
constexpr size_t O_lsum = O_rr + al256((size_t)TA * 256 * 2);
constexpr size_t O_lcar = O_lsum + al256((size_t)16 * 132 * 256 * 8);
constexpr size_t O_GA = O_lcar + al256((size_t)16 * 132 * 256 * 4);
constexpr size_t O_mixer_end = O_GA + al256((size_t)NB_ * 64 * 256 * 256 * 2);
constexpr size_t O_H = O_regB;
constexpr size_t O_yA = O_H + al256((size_t)(2 * TA + 32 * 256) * 512 * 2);
constexpr size_t O_moe_end = O_yA + al256((size_t)2 * TA * D * 2);
constexpr size_t WS_NEED = O_mixer_end > O_moe_end ? O_mixer_end : O_moe_end;
DI void bind_ws(Params& P) {
  char* w = P.ws;
  P.WtIn = (half_t*)(w + O_WtIn); P.WtOut = (half_t*)(w + O_WtOut); P.Wt1 = (half_t*)(w + O_Wt1); P.Wt3 = (half_t*)(w + O_Wt3); P.Wt2 = (half_t*)(w + O_Wt2);
  P.mod = (float*)(w + O_mod); P.rope = (float2*)(w + O_rope); P.tw = (float2*)(w + O_tw); P.DA = (half_t*)(w + O_DA); P.DB = (half_t*)(w + O_DB); P.DC = (half_t*)(w + O_DC);
  P.consts = (float*)(w + O_consts); P.cnt = (int*)(w + O_cnt); P.qctr = (int*)(w + O_qctr); P.tokW = (float*)(w + O_tokW); P.list = (int*)(w + O_list); P.listW = (float*)(w + O_listW);
  P.xcbuf = (float*)(w + O_xcbuf); P.WrH = (half_t*)(w + O_WrT); P.hx = (half_t*)(w + O_hx); P.mix = (half_t*)(w + O_mix);
  P.q = (half_t*)(w + O_q); P.kall = (half_t*)(w + O_kall); P.vT = (half_t*)(w + O_vT); P.QF = (half_t*)(w + O_QF); P.gy = (half_t*)(w + O_gy); P.rr = (half_t*)(w + O_rr);
  P.lsum = (float2*)(w + O_lsum); P.lcar = (float*)(w + O_lcar); P.GA = (half_t*)(w + O_GA); P.H = (half_t*)(w + O_H); P.yA = (half_t*)(w + O_yA);
}
DI float shx(float v, int o) { int ln = TIDX & 63; return __builtin_bit_cast(float, __builtin_amdgcn_ds_bpermute((ln ^ o) << 2, __builtin_bit_cast(int, v))); }
DI float shi(float v, int idx) { return __builtin_bit_cast(float, __builtin_amdgcn_ds_bpermute(idx << 2, __builtin_bit_cast(int, v))); }
DI float wave_sum(float v) {
#pragma unroll
  for (int o = 32; o; o >>= 1) v += shx(v, o);
  return v;
}
DI void glds16(const void* g, void* l) {
  __builtin_amdgcn_global_load_lds((const unsigned*)g, (unsigned*)l, 16, 0, 0);
}
DI void wait_vm0() { asm volatile("s_waitcnt vmcnt(0)" ::: "memory"); }
DI f4 mfma16(h8 a, h8 b, f4 c) { return __builtin_amdgcn_mfma_f32_16x16x32_f16(a, b, c, 0, 0, 0); }
DI f16v mfma32(h8 a, h8 b, f16v c) { return __builtin_amdgcn_mfma_f32_32x32x16_f16(a, b, c, 0, 0, 0); }
DI unsigned pk2(float a, float b) { fp16x2 r = __builtin_amdgcn_cvt_pkrtz(a, b); return __builtin_bit_cast(unsigned, r); }
DI float sigmoidf_(float x) { return 1.f / (1.f + __expf(-x)); }
DI float gelu_tanh(float x) {
  float u = 0.7978845608028654f * (x + 0.044715f * x * x * x);
  float e = __expf(2.f * u);
  float t = 1.f - 2.f / (e + 1.f);
  return 0.5f * x * (1.f + t);
}
DI int row_mod(int r) { return r < TC ? 8 : ((r - TC) >> 13); }

DI void transpose_tile4(const float* src, int lds_, half_t* dst, int ldd, float* tile) {
  const int tid = TIDX;
  {
    const int k0 = tid >> 6, c4 = tid & 63;
    const float* sp = src + (size_t)k0 * lds_ + c4 * 4;
    float* tp = tile + (c4 >> 4) * 4352 + k0 * 68 + (c4 & 15) * 4;
#pragma unroll
    for (int i = 0; i < 16; i++) *(float4*)(tp + i * 4 * 68) = *(const float4*)(sp + (size_t)i * 4 * lds_);
  }
  __syncthreads();
#pragma unroll
  for (int i = 0; i < 8; i++) {
    int idx = i * 256 + tid, j = idx >> 9, r = idx & 511, kc = r >> 6, n = r & 63;
    const float* t = tile + j * 4352 + kc * 8 * 68 + n;
    h8 o;
#pragma unroll
    for (int u = 0; u < 8; u++) o[u] = (half_t)t[u * 68];
    *(h8*)(dst + (size_t)(j * 64 + n) * ldd + kc * 8) = o;
  }
  __syncthreads();
}

DI void phase0(const Params& P, char* smem) {
  float* tile = (float*)smem;
  const int tid = TIDX;
  constexpr int NT = 6528, NF = 128, NM = 192, NX = 6;
  for (int t0 = blockIdx.x; t0 < NT + NF + NM + NX; t0 += gridDim.x) {
    const int t = t0 < NF + NM + NX ? NT + t0 : t0 - (NF + NM + NX);
    if (t < NT) {
      const float* src; half_t* dst; int lds_, ldd;
      if (t < 256) {
        int l = t / 128, r = t % 128, kt = r / 8, nt = (r % 8) * 4;
        src = P.w_in + (size_t)l * 1024 * 2304 + (size_t)kt * 64 * 2304 + 256 + nt * 64; lds_ = 2304;
        dst = P.WtIn + (size_t)l * NIN * 1024 + (size_t)(512 + nt * 64) * 1024 + kt * 64; ldd = 1024;
      } else if (t < 384) {
        int u = t - 256, l = u / 64, r = u % 64, kt = r / 4, nt = (r % 4) * 4;
        src = P.w_out + (size_t)l * 1048576 + (size_t)kt * 64 * 1024 + nt * 64; lds_ = 1024;
        dst = P.WtOut + (size_t)l * 1048576 + (size_t)nt * 64 * 1024 + kt * 64; ldd = 1024;
      } else if (t < 384 + 4096) {
        int u = t - 384; const float* w = P.w1; half_t* o = P.Wt1;
        if (u >= 2048) { u -= 2048; w = P.w3; o = P.Wt3; }
        int le = u / 32, r = u % 32, kt = r / 2, nt = (r % 2) * 4;
        src = w + (size_t)le * 524288 + (size_t)kt * 64 * 512 + nt * 64; lds_ = 512;
        dst = o + (size_t)le * 524288 + (size_t)nt * 64 * 1024 + kt * 64; ldd = 1024;
      } else {
        int u = t - 384 - 4096, le = u / 32, r = u % 32, kt = r / 4, nt = (r % 4) * 4;
        src = P.w2 + (size_t)le * 524288 + (size_t)kt * 64 * 1024 + nt * 64; lds_ = 1024;
        dst = P.Wt2 + (size_t)le * 524288 + (size_t)nt * 64 * 512 + kt * 64; ldd = 512;
      }
      transpose_tile4(src, lds_, dst, ldd, tile);
    } else if (t < NT + NF) {
      int f = t - NT, l = f / 64, r = f % 64, kt = r / 4, g = r % 4;
      float* cst = tile + 64 * 65; float* snt = cst + 64;
      const float* src = P.w_in + (size_t)l * 1024 * 2304 + (size_t)kt * 64 * 2304 + g * 64;
      { int n = tid & 63, kq = tid >> 6;
        for (int i = 0; i < 16; i++) { int k = i * 4 + kq; tile[k * 65 + n] = src[(size_t)k * 2304 + n]; } }
      if (tid < 64) { float s, c; sincospif((float)tid / 32.f, &s, &c); cst[tid] = c; snt[tid] = s; }
      __syncthreads();
      int k = tid & 63, jq = tid >> 6;
      half_t* o = P.WtIn + (size_t)l * NIN * 1024 + kt * 64 + k;
      for (int jj = 0; jj < 16; jj++) {
        int j = jq * 16 + jj; float ac = 0.f, as = 0.f;
        for (int c = 0; c < 64; c++) { float v = tile[k * 65 + c]; int idx = (c * j) & 63; ac += v * cst[idx]; as += v * snt[idx]; }
        o[(size_t)(g * 64 + j) * 1024] = (half_t)(ac * 0.125f);
        o[(size_t)(256 + g * 64 + j) * 1024] = (half_t)(-as * 0.125f);
      }
      __syncthreads();
    } else if (t < NT + NF + NM) {
      int mi = t - NT - NF, l = mi / 96, col0 = (mi % 96) * 64;
      float* scond = tile; float* red = tile + 9216;
      for (int idx = tid; idx < 9216; idx += 256) {
        int n = idx >> 10, k = idx & 1023; float v = n < 8 ? P.c[n * 1024 + k] : P.c_ctx[k];
        scond[idx] = v / (1.f + expf(-v));
      }
      __syncthreads();
      int col = tid & 63, kq = tid >> 6; float acc[9];
#pragma unroll
      for (int n = 0; n < 9; n++) acc[n] = 0.f;
      const float* w = P.w_mod + ((size_t)l * 1024 + kq * 256) * 6144 + col0 + col;
#pragma unroll 16
      for (int k = 0; k < 256; k++) {
        float wv = w[(size_t)k * 6144];
#pragma unroll
        for (int n = 0; n < 9; n++) acc[n] += scond[n * 1024 + kq * 256 + k] * wv;
      }
#pragma unroll
      for (int n = 0; n < 9; n++) red[(kq * 9 + n) * 64 + col] = acc[n];
      __syncthreads();
      for (int idx = tid; idx < 576; idx += 256) {
        int n = idx / 64, cc = idx % 64;
        float s = red[(0 * 9 + n) * 64 + cc] + red[(1 * 9 + n) * 64 + cc] + red[(2 * 9 + n) * 64 + cc] + red[(3 * 9 + n) * 64 + cc];
        P.mod[(size_t)(l * 9 + n) * 6144 + col0 + cc] = s + P.b_mod[l * 6144 + col0 + cc];
      }
      __syncthreads();
    } else {
      int m = t - NT - NF - NM;
      if (m == 0) {
        for (int idx = tid; idx < 128 * 16; idx += 256) {
          int pos = idx >> 4, i = idx & 15; float f = powf(10000.f, -(float)i / 16.f); float ang = (float)pos * f;
          float s, c; sincosf(ang, &s, &c); P.rope[idx] = make_float2(c, s);
        }
      } else if (m == 1) {
        for (int j = tid; j < 8192; j += 256) { float s, c; sincospif((float)j / 4096.f, &s, &c); P.tw[j] = make_float2(c, s); }
      } else if (m == 2) {
        for (int idx = tid; idx < 16384; idx += 256) {
          int mm = idx >> 7, k = idx & 127, part = mm >> 6, f1 = mm & 63, pp = k >> 6, a = k & 63;
          float s, c; sincospif((float)((a * f1) & 63) / 32.f, &s, &c);
          float v = part == 0 ? (pp == 0 ? c : s) : (pp == 0 ? -s : c);
          P.DA[idx] = (half_t)(v * 0.125f);
        }
      } else if (m == 3) {
        for (int idx = tid; idx < 32768; idx += 256) {
          int mm = idx >> 8, k = idx & 255, part = k >> 7, bb = k & 127;
          float s, c; sincospif((float)((bb * mm) & 127) / 64.f, &s, &c);
          P.DB[idx] = (half_t)((part == 0 ? c : s) * 0.08838834764831845f);
        }
      } else if (m == 4) {
        for (int idx = tid; idx < 131072; idx += 256) {
          int mm = idx >> 9, k = idx & 511, part = k >> 8, tt = k & 255;
          float s, c; sincospif((float)((tt * mm) & 255) / 128.f, &s, &c);
          P.DC[idx] = (half_t)((part == 0 ? c : s) * 0.0625f);
        }
      } else {
        for (int idx = tid; idx < 2 * 48 * 1024; idx += 256) {
          int l = idx / 49152, r = idx % 49152, col = r >> 10, k = r & 1023;
          float w = col < 4 ? P.w_group[((size_t)l * 1024 + k) * 4 + col] : (col < 36 ? P.w_router[((size_t)l * 1024 + k) * 32 + col - 4] : 0.f);
          half_t hi = (half_t)w, lo = (half_t)(w - (float)hi);
          P.WrH[(size_t)(l * 2) * 49152 + r] = hi; P.WrH[(size_t)(l * 2 + 1) * 49152 + r] = lo;
        }
        if (tid < 2) {
          int l = tid; float s1 = 0.f, s2 = 0.f, mq = 0.f, mk = 0.f;
          for (int i = 0; i < 64; i++) {
            s1 += P.lq1[l * 64 + i] * P.lk1[l * 64 + i]; s2 += P.lq2[l * 64 + i] * P.lk2[l * 64 + i];
            mq = fmaxf(mq, fabsf(P.q_norm_g[l * 64 + i])); mk = fmaxf(mk, fabsf(P.k_norm_g[l * 64 + i]));
          }
          float lam_init = 0.8f - 0.6f * expf(-0.3f * (float)l);
          P.consts[l * 4 + 0] = expf(s1) - expf(s2) + lam_init;
          P.consts[l * 4 + 1] = 8.f * mq * mk * 1.4426950408889634f * 1.002f - 15.f;
          P.consts[l * 4 + 2] = lam_init;
        }
        if (tid < 64) P.cnt[tid] = 0;
        if (tid < 64) P.qctr[tid] = 0;
      }
    }
  }
}

DI void row1_phase(const Params& P, int combine_l, int norm_l, int r_begin) {
  const int lane = TIDX & 63, gw = blockIdx.x * 4 + (TIDX >> 6), nw = gridDim.x * 4;
  auto load_row = [&](int r, float4 (&xv)[4], h4 (&ya)[4], h4 (&yb)[4]) {
    if (combine_l < 0) {
      const float* src = r < TC ? P.ctx + (size_t)r * D : P.x + (size_t)(r - TC) * D;
#pragma unroll
      for (int i = 0; i < 4; i++) xv[i] = *(const float4*)(src + i * 256 + lane * 4);
    } else {
      const float* xm = r < TC ? P.xcbuf + (size_t)r * D : P.out + (size_t)(r - TC) * D;
      const half_t* y0 = P.yA + (size_t)(2 * r) * D; const half_t* y1 = y0 + D;
#pragma unroll
      for (int i = 0; i < 4; i++) { int c = i * 256 + lane * 4; xv[i] = *(const float4*)(xm + c); ya[i] = *(const h4*)(y0 + c); yb[i] = *(const h4*)(y1 + c); }
    }
  };
  auto process = [&](int r, float4 (&xv)[4], h4 (&ya)[4], h4 (&yb)[4]) {
    const int n = row_mod(r);
    if (combine_l >= 0) {
      float* xm = r < TC ? P.xcbuf + (size_t)r * D : P.out + (size_t)(r - TC) * D;
      const float* g2 = P.mod + (size_t)(combine_l * 9 + n) * 6144 + 5 * 1024;
#pragma unroll
      for (int i = 0; i < 4; i++) {
        int c = i * 256 + lane * 4;
        float4 g = *(const float4*)(g2 + c); float4 t = xv[i];
        t.x += g.x * ((float)ya[i][0] + (float)yb[i][0]); t.y += g.y * ((float)ya[i][1] + (float)yb[i][1]);
        t.z += g.z * ((float)ya[i][2] + (float)yb[i][2]); t.w += g.w * ((float)ya[i][3] + (float)yb[i][3]);
        *(float4*)(xm + c) = t; xv[i] = t;
      }
    }
    if (norm_l >= 0) {
      float ss = 0.f;
#pragma unroll
      for (int i = 0; i < 4; i++) ss += xv[i].x * xv[i].x + xv[i].y * xv[i].y + xv[i].z * xv[i].z + xv[i].w * xv[i].w;
      ss = wave_sum(ss);
      const float rstd = rsqrtf(ss * (1.f / 1024.f) + EPS);
      const float* g = P.norm1_g + norm_l * 1024;
      const float* sh = P.mod + (size_t)(norm_l * 9 + n) * 6144; const float* sc = sh + 1024;
#pragma unroll
      for (int i = 0; i < 4; i++) {
        int c = i * 256 + lane * 4;
        float4 gg = *(const float4*)(g + c), s1 = *(const float4*)(sc + c), s0 = *(const float4*)(sh + c);
        h4 o;
        o[0] = (half_t)(xv[i].x * rstd * gg.x * (1.f + s1.x) + s0.x); o[1] = (half_t)(xv[i].y * rstd * gg.y * (1.f + s1.y) + s0.y);
        o[2] = (half_t)(xv[i].z * rstd * gg.z * (1.f + s1.z) + s0.z); o[3] = (half_t)(xv[i].w * rstd * gg.w * (1.f + s1.w) + s0.w);
        *(h4*)(P.hx + (size_t)r * D + c) = o;
      }
    }
  };
  const int nrows = TA - r_begin;
  const int r_lo = r_begin + (int)(((long long)gw * nrows) / nw), r_hi = r_begin + (int)(((long long)(gw + 1) * nrows) / nw);
#pragma unroll 1
  for (int r = r_lo; r < r_hi; r += 4) {
    float4 x0[4], x1[4], x2[4], x3[4]; h4 a0[4], b0[4], a1[4], b1[4], a2[4], b2[4], a3[4], b3[4];
    const int r1 = r + 1, r2 = r + 2, r3 = r + 3;
    load_row(r, x0, a0, b0);
    if (r1 < r_hi) load_row(r1, x1, a1, b1);
    if (r2 < r_hi) load_row(r2, x2, a2, b2);
    if (r3 < r_hi) load_row(r3, x3, a3, b3);
    process(r, x0, a0, b0);
    if (r1 < r_hi) process(r1, x1, a1, b1);
    if (r2 < r_hi) process(r2, x2, a2, b2);
    if (r3 < r_hi) process(r3, x3, a3, b3);
  }
}

DI void row2_phase(const Params& P, int l, int r_begin, char* smem) {
  const int tid = TIDX, lane = tid & 63, wave = tid >> 6, fr = lane & 15, fq = lane >> 4;
  float* lg = (float*)smem + wave * 16 * 48;
  const half_t* Whi = P.WrH + (size_t)(l * 2) * 49152; const half_t* Wlo = Whi + 49152;
  const int ngroups = (TA - r_begin) >> 4, gw = blockIdx.x * 4 + wave, nw = gridDim.x * 4;
  const float* gam = P.norm2_g + l * 1024;
  const int gper = (ngroups + nw - 1) / nw;
#pragma unroll 1
  for (int grp = gw * gper; grp < min((gw + 1) * gper, ngroups); grp++) {
    const int r0 = r_begin + grp * 16, row = r0 + fr, n = row_mod(r0);
    const float* xm = (row < TC ? P.xcbuf + (size_t)row * D : P.out + (size_t)(row - TC) * D) + fq * 8;
    float ss = 0.f;
#pragma unroll 16
    for (int kk = 0; kk < 32; kk++) {
      const float4 a = *(const float4*)(xm + kk * 32), b = *(const float4*)(xm + kk * 32 + 4);
      ss += a.x * a.x + a.y * a.y + a.z * a.z + a.w * a.w + b.x * b.x + b.y * b.y + b.z * b.z + b.w * b.w;
    }
    ss += shx(ss, 16); ss += shx(ss, 32);
    const float rstd = rsqrtf(ss * (1.f / 1024.f) + EPS);
    const float* sh = P.mod + (size_t)(l * 9 + n) * 6144 + 3 * 1024 + fq * 8; const float* sc = sh + 1024;
    f4 acc[3];
#pragma unroll
    for (int i = 0; i < 3; i++) acc[i] = (f4){0.f, 0.f, 0.f, 0.f};
    half_t* hxo = P.hx + (size_t)row * D + fq * 8;
#pragma unroll 4
    for (int kk = 0; kk < 32; kk++) {
      const int k0 = kk * 32;
      float x[8], g[8], s1[8], s0[8];
      *(float4*)&x[0] = *(const float4*)(xm + k0); *(float4*)&x[4] = *(const float4*)(xm + k0 + 4);
      *(float4*)&g[0] = *(const float4*)(gam + fq * 8 + k0); *(float4*)&g[4] = *(const float4*)(gam + fq * 8 + k0 + 4);
      *(float4*)&s1[0] = *(const float4*)(sc + k0); *(float4*)&s1[4] = *(const float4*)(sc + k0 + 4);
      *(float4*)&s0[0] = *(const float4*)(sh + k0); *(float4*)&s0[4] = *(const float4*)(sh + k0 + 4);
      h8 hi, lo;
#pragma unroll
      for (int i = 0; i < 8; i++) {
        float v = x[i] * rstd * g[i] * (1.f + s1[i]) + s0[i];
        hi[i] = (half_t)v; lo[i] = (half_t)(v - (float)hi[i]);
      }
      *(h8*)(hxo + k0) = hi;
#pragma unroll
      for (int n3 = 0; n3 < 3; n3++) {
        h8 bh = *(const h8*)(Whi + (size_t)(n3 * 16 + fr) * 1024 + k0 + fq * 8);
        h8 bl = *(const h8*)(Wlo + (size_t)(n3 * 16 + fr) * 1024 + k0 + fq * 8);
        acc[n3] = mfma16(hi, bh, acc[n3]); acc[n3] = mfma16(lo, bh, acc[n3]); acc[n3] = mfma16(hi, bl, acc[n3]);
      }
    }
    __builtin_amdgcn_wave_barrier();
#pragma unroll
    for (int n3 = 0; n3 < 3; n3++)
#pragma unroll
      for (int j = 0; j < 4; j++) lg[(fq * 4 + j) * 48 + n3 * 16 + fr] = acc[n3][j];
    __builtin_amdgcn_wave_barrier();
    if (lane < 16) {
      const int r = r0 + lane;
      const float* L = lg + lane * 48;
      float gl[4]; int gi = 0;
#pragma unroll
      for (int j = 0; j < 4; j++) gl[j] = L[j] + P.b_group[l * 4 + j];
      float gm = gl[0];
#pragma unroll
      for (int j = 1; j < 4; j++) if (gl[j] > gm) { gm = gl[j]; gi = j; }
      float gs = 0.f;
#pragma unroll
      for (int j = 0; j < 4; j++) gs += expf(gl[j] - gm);
      const float pg = 1.f / gs;
      float el[8];
#pragma unroll
      for (int j = 0; j < 8; j++) el[j] = L[4 + gi * 8 + j] + P.b_router[l * 32 + gi * 8 + j];
      int i0 = 0; float v0 = el[0];
#pragma unroll
      for (int j = 1; j < 8; j++) if (el[j] > v0) { v0 = el[j]; i0 = j; }
      int i1 = -1; float v1 = -3.0e38f;
#pragma unroll
      for (int j = 0; j < 8; j++) if (j != i0 && el[j] > v1) { v1 = el[j]; i1 = j; }
      const float ex = expf(v1 - v0);
      const float w0 = pg / (1.f + ex), w1 = pg * ex / (1.f + ex);
      const int e0 = gi * 8 + i0, e1 = gi * 8 + i1;
      int p0 = atomicAdd(&P.cnt[l * 32 + e0], 1); P.list[(size_t)e0 * LCAP + p0] = 2 * r; P.listW[(size_t)e0 * LCAP + p0] = w0;
      int p1 = atomicAdd(&P.cnt[l * 32 + e1], 1); P.list[(size_t)e1 * LCAP + p1] = 2 * r + 1; P.listW[(size_t)e1 * LCAP + p1] = w1;
    }
    __builtin_amdgcn_wave_barrier();
  }
}

DI h8 lds128(unsigned a) { h8 r; asm volatile("ds_read_b128 %0, %1" : "=v"(r) : "v"(a)); return r; }
DI void tie(h8& x) { asm volatile("" : "+v"(x)); }
DI unsigned lds_addr(const void* p) { return (unsigned)(size_t)p; }
#define WAIT_LGKM(n) asm volatile("s_waitcnt lgkmcnt(" #n ")" ::: "memory")
DI void raw_barrier() { asm volatile("" ::: "memory"); __builtin_amdgcn_s_barrier(); asm volatile("" ::: "memory"); }
DI void slot_rc(int i, int& row, int& coff) { int s = i * 256 + TIDX; row = s >> 3; coff = ((s & 7) ^ ((row >> 1) & 7)) * 8; }

template <class AF, class BF>
DI void gemm_prologue(AF aptr, BF bptr, int nk, char* smem) {
  const int tid = TIDX;
#pragma unroll
  for (int st = 0; st < 2; st++) {
    if (st < nk) {
      char* d = smem + st * 49152 + tid * 16;
#pragma unroll
      for (int i = 0; i < 8; i++) glds16(aptr(i) + st * 64, d + i * 4096);
#pragma unroll
      for (int i = 0; i < 4; i++) glds16(bptr(i) + st * 64, d + 32768 + i * 4096);
    }
  }
}
template <bool PRE = false, class AF, class BF>
DI void gemm256(AF aptr, BF bptr, int nk, char* smem, f4 (&acc)[8][4]) {
  const int tid = TIDX, lane = tid & 63, wave = tid >> 6, fr = lane & 15, fq = lane >> 4, wr = wave >> 1, wc = wave & 1;
#pragma unroll
  for (int m = 0; m < 8; m++)
#pragma unroll
    for (int n = 0; n < 4; n++) acc[m][n] = (f4){0.f, 0.f, 0.f, 0.f};
  auto issue = [&](int kt, int st) {
    char* d = smem + st * 49152 + tid * 16;
#pragma unroll
    for (int i = 0; i < 8; i++) glds16(aptr(i) + kt * 64, d + i * 4096);
#pragma unroll
    for (int i = 0; i < 4; i++) glds16(bptr(i) + kt * 64, d + 32768 + i * 4096);
  };
  const unsigned sw = (unsigned)((fq ^ (fr >> 1)) << 4);
  const unsigned offA = (wr * 128 + fr) * 128 + sw, offB = 32768 + (wc * 64 + fr) * 128 + sw;
  const unsigned sbase = lds_addr(smem);
  if (!PRE) { issue(0, 0); if (nk > 1) issue(1, 1); }
  int st = 0;
#pragma unroll 1
  for (int kt = 0; kt < nk; kt++) {
    if (kt + 1 < nk) asm volatile("s_waitcnt vmcnt(12)" ::: "memory"); else wait_vm0();
    raw_barrier();
    if (kt + 2 < nk) issue(kt + 2, st == 0 ? 2 : st - 1);
    const unsigned base = sbase + st * 49152;
    st = st == 2 ? 0 : st + 1;
    h8 a0[8], b0[4], a1[8], b1[4];
#pragma unroll
    for (int m = 0; m < 8; m++) a0[m] = lds128(base + offA + m * 2048);
#pragma unroll
    for (int n = 0; n < 4; n++) b0[n] = lds128(base + offB + n * 2048);
#pragma unroll
    for (int m = 0; m < 8; m++) a1[m] = lds128(base + (offA ^ 64) + m * 2048);
#pragma unroll
    for (int n = 0; n < 4; n++) b1[n] = lds128(base + (offB ^ 64) + n * 2048);
    WAIT_LGKM(12);
#pragma unroll
    for (int m = 0; m < 8; m++) tie(a0[m]);
#pragma unroll
    for (int n = 0; n < 4; n++) tie(b0[n]);
#pragma unroll
    for (int m = 0; m < 8; m++)
#pragma unroll
      for (int n = 0; n < 4; n++) acc[m][n] = mfma16(a0[m], b0[n], acc[m][n]);
    WAIT_LGKM(0);
#pragma unroll
    for (int m = 0; m < 8; m++) tie(a1[m]);
#pragma unroll
    for (int n = 0; n < 4; n++) tie(b1[n]);
#pragma unroll
    for (int m = 0; m < 8; m++)
#pragma unroll
      for (int n = 0; n < 4; n++) acc[m][n] = mfma16(a1[m], b1[n], acc[m][n]);
  }
  raw_barrier();
}
DI bool xcd_tile(int it, int MT, int NT, int& mt, int& nt) {
  const int x = blockIdx.x & 7, j = blockIdx.x >> 3;
  const int nsn = NT >> 2, nsm = (MT + 7) >> 3;
  const int s = x + 8 * it;
  if (s >= nsm * nsn) return false;
  const int sm = s / nsn, sn = s % nsn;
  mt = sm * 8 + (j >> 2); nt = sn * 4 + (j & 3);
  return true;
}
DI bool next_tile(int& it, int MT, int NT, int& mt, int& nt) {
  for (;; it++) {
    if (!xcd_tile(it, MT, NT, mt, nt)) return false;
    if (mt < MT) return true;
  }
}
DI int slot_col() { int t = TIDX; return ((t & 7) ^ ((t >> 4) & 7)) * 8; }

DI float dpp_row_sum(float v) {
  v += __builtin_bit_cast(float, __builtin_amdgcn_update_dpp(0, __builtin_bit_cast(int, v), 0x128, 0xf, 0xf, false));
  v += __builtin_bit_cast(float, __builtin_amdgcn_update_dpp(0, __builtin_bit_cast(int, v), 0x124, 0xf, 0xf, false));
  v += __builtin_bit_cast(float, __builtin_amdgcn_update_dpp(0, __builtin_bit_cast(int, v), 0x122, 0xf, 0xf, false));
  v += __builtin_bit_cast(float, __builtin_amdgcn_update_dpp(0, __builtin_bit_cast(int, v), 0x121, 0xf, 0xf, false));
  return v;
}
DI void stage_put(char* stg, int ml, int n, int j, int fr, int fq, float v) { *(half_t*)(stg + (ml * 16 + fq * 4 + j) * 144 + (n * 16 + fr) * 2) = (half_t)v; }
template <class RP, class SC>
DI void stage_flush(char* stg, int h, RP rowptr, SC rowscale) {
  const int lane = TIDX & 63;
  __builtin_amdgcn_wave_barrier();
#pragma unroll
  for (int i = 0; i < 8; i++) {
    const int c = i * 64 + lane, row = c >> 3, c16 = c & 7;
    h8 v = *(const h8*)(stg + row * 144 + c16 * 16);
    half_t* d = rowptr(h * 64 + row);
    if (d) { rowscale(h * 64 + row, v); *(h8*)(d + c16 * 8) = v; }
  }
  __builtin_amdgcn_wave_barrier();
}
template <class VF, class RP, class SC>
DI void wave_store_tile(VF val, char* stg, RP rowptr, SC rowscale) {
  const int lane = TIDX & 63, fr = lane & 15, fq = lane >> 4;
#pragma unroll
  for (int h = 0; h < 2; h++) {
#pragma unroll
    for (int ml = 0; ml < 4; ml++)
#pragma unroll
      for (int n = 0; n < 4; n++)
#pragma unroll
        for (int j = 0; j < 4; j++) stage_put(stg, ml, n, j, fr, fq, val(h * 4 + ml, n, j));
    stage_flush(stg, h, rowptr, rowscale);
  }
}
DI void gemm_in_phase(const Params& P, int l, char* smem) {
  const int tid = TIDX;
  const half_t* Wt = P.WtIn + (size_t)l * NIN * 1024;
  const int sc = slot_col(), srow = tid >> 3;
  {
    float2* rcl = (float2*)(smem + 147456);
    for (int i = tid; i < 1024; i += 256) rcl[i] = P.rope[i];
    __syncthreads();
  }
  int it = 0, mt, nt;
  bool have = next_tile(it, 264, 20, mt, nt);
  const half_t* a0 = nullptr; const half_t* b0 = nullptr;
  if (have) {
    asm volatile("" : "+s"(mt), "+s"(nt));
    a0 = P.hx + (size_t)(mt * 256 + srow) * D + sc; b0 = Wt + (size_t)(nt * 128 + srow) * D + sc;
    gemm_prologue([&](int i) { return a0 + (size_t)i * 32 * D; }, [&](int i) { return b0 + (size_t)i * 32 * D; }, 16, smem);
  }
#pragma unroll 1
  while (have) {
    f4 acc[8][4];
    gemm256<true>([&](int i) { return a0 + (size_t)i * 32 * D; }, [&](int i) { return b0 + (size_t)i * 32 * D; }, 16, smem, acc);
    const int tid2 = TIDX, lane = tid2 & 63, wave = tid2 >> 6, fr = lane & 15, fq = lane >> 4, wr = wave >> 1, wc = wave & 1;
    const int r0 = mt * 256 + wr * 128;
    const bool isctx = r0 < TC;
    int b, pos0;
    if (isctx) { b = r0 >> 8; pos0 = r0 & 255; } else { b = (r0 - TC) >> 13; pos0 = 256 + ((r0 - TC) & 8191); }
    const bool isqk = nt >= 4 && nt < 12;
    float gg[4] = {0.f, 0.f, 0.f, 0.f}; float2 rr2[2] = {make_float2(1.f, 0.f), make_float2(1.f, 0.f)};
    if (isqk) {
      const float* gvec = (nt < 8 ? P.q_norm_g : P.k_norm_g) + l * 64;
      const float qs = nt < 8 ? 0.125f * 1.4426950408889634f : 1.f;
#pragma unroll
      for (int n = 0; n < 4; n++) gg[n] = gvec[n * 16 + fr] * qs;
      if (!isctx) { const int tp0 = pos0 - 256; rr2[0] = P.rope[(tp0 >> 6) * 16 + fr]; rr2[1] = P.rope[((tp0 >> 6) + 1) * 16 + fr]; }
    }
#pragma unroll
    for (int n = 0; n < 4; n++) asm volatile("" : "+v"(gg[n]));
    asm volatile("" : "+v"(rr2[0].x), "+v"(rr2[0].y), "+v"(rr2[1].x), "+v"(rr2[1].y));
    int it2 = it + 1, mt2, nt2;
    const bool have2 = next_tile(it2, 264, 20, mt2, nt2);
    const half_t* a1 = a0; const half_t* b1 = b0;
    if (have2) {
      asm volatile("" : "+s"(mt2), "+s"(nt2));
      a1 = P.hx + (size_t)(mt2 * 256 + srow) * D + sc; b1 = Wt + (size_t)(nt2 * 128 + srow) * D + sc;
      gemm_prologue([&](int i) { return a1 + (size_t)i * 32 * D; }, [&](int i) { return b1 + (size_t)i * 32 * D; }, 16, smem);
    }
    char* stg = smem + 98304 + wave * 12288;
    auto noscale = [](int, h8&) {};
    if (nt < 4 || nt >= 16) {
      half_t* dst; int ld, c0; bool gel = false;
      if (nt < 4) { dst = P.QF; ld = 512; c0 = nt * 128; }
      else if (nt < 18) { dst = P.gy; ld = 256; c0 = (nt - 16) * 128; gel = true; }
      else { dst = P.rr; ld = 256; c0 = (nt - 18) * 128; }
      half_t* base = dst + (size_t)r0 * ld + c0 + wc * 64;
      if (gel) wave_store_tile([&](int m, int n, int j) { return gelu_tanh(acc[m][n][j]); }, stg, [&](int r) { return base + (size_t)r * ld; }, noscale);
      else wave_store_tile([&](int m, int n, int j) { return acc[m][n][j]; }, stg, [&](int r) { return base + (size_t)r * ld; }, noscale);
    } else if (nt < 12) {
      const bool isq = nt < 8; const int head = isq ? nt - 4 : nt - 8;
      const float2* rcl = (const float2*)(smem + 147456);
      half_t* base = (isq ? P.q + (size_t)r0 * 512 : P.kall + ((size_t)b * KV + pos0) * 512) + head * 128 + wc * 64;
#pragma unroll
      for (int mh = 0; mh < 2; mh++) {
#pragma unroll
        for (int mm = 0; mm < 4; mm++) {
          const int m = mh * 4 + mm;
#pragma unroll
          for (int j = 0; j < 4; j++) {
            float ss = 0.f;
#pragma unroll
            for (int n = 0; n < 4; n++) ss += acc[m][n][j] * acc[m][n][j];
            ss = dpp_row_sum(ss);
            const float rstd = rsqrtf(ss * (1.f / 64.f) + EPS);
            float o[4];
#pragma unroll
            for (int n = 0; n < 4; n++) o[n] = acc[m][n][j] * rstd * gg[n];
            if (!isctx) {
              const float2 cr = rr2[mh], cc = rcl[(mm * 16 + fq * 4 + j) * 16 + fr];
              float a0 = o[0] * cr.x - o[1] * cr.y, a1 = o[1] * cr.x + o[0] * cr.y;
              float a2 = o[2] * cc.x - o[3] * cc.y, a3 = o[3] * cc.x + o[2] * cc.y;
              o[0] = a0; o[1] = a1; o[2] = a2; o[3] = a3;
            }
#pragma unroll
            for (int n = 0; n < 4; n++) stage_put(stg, mm, n, j, fr, fq, o[n]);
          }
        }
        stage_flush(stg, mh, [&](int r) { return base + (size_t)r * 512; }, noscale);
      }
    } else {
      const int head = nt - 12;
#pragma unroll
      for (int m = 0; m < 8; m++)
#pragma unroll
        for (int n = 0; n < 4; n++) {
          h4 o; o[0] = (half_t)acc[m][n][0]; o[1] = (half_t)acc[m][n][1]; o[2] = (half_t)acc[m][n][2]; o[3] = (half_t)acc[m][n][3];
          int d = wc * 64 + n * 16 + fr;
          asm volatile("" : "+v"(d) :: "memory");
          *(h4*)(P.vT + ((size_t)(b * 4 + head) * 128 + d) * KV + pos0 + m * 16 + fq * 4) = o;
        }
    }
    mt = mt2; nt = nt2; it = it2; have = have2; a0 = a1; b0 = b1;
  }
}

DI void gemm_out_phase(const Params& P, int l, char* smem) {
  const int tid = TIDX;
  const half_t* Wt = P.WtOut + (size_t)l * 1048576;
  const int mt0 = l == 0 ? 0 : TC / 256;
  const int MT = 264 - mt0;
  const int sc = slot_col(), srow = tid >> 3;
  int it = 0, mt, nt;
  bool have = next_tile(it, MT, 8, mt, nt);
  const half_t* a0 = nullptr; const half_t* b0 = nullptr;
  if (have) {
    asm volatile("" : "+s"(mt), "+s"(nt));
    a0 = P.mix + (size_t)((mt + mt0) * 256 + srow) * D + sc; b0 = Wt + (size_t)(nt * 128 + srow) * D + sc;
    gemm_prologue([&](int i) { return a0 + (size_t)i * 32 * D; }, [&](int i) { return b0 + (size_t)i * 32 * D; }, 16, smem);
  }
#pragma unroll 1
  while (have) {
    f4 acc[8][4];
    gemm256<true>([&](int i) { return a0 + (size_t)i * 32 * D; }, [&](int i) { return b0 + (size_t)i * 32 * D; }, 16, smem, acc);
    const int tid2 = TIDX, lane2 = tid2 & 63, wave2 = tid2 >> 6, fr2 = lane2 & 15, fq2 = lane2 >> 4, wr2 = wave2 >> 1, wc2 = wave2 & 1;
    const int r0 = (mt + mt0) * 256 + wr2 * 128;
    const int n = row_mod(r0);
    const int cbase = nt * 128 + wc2 * 64;
    const float* res; float* dst;
    if (r0 < TC) { res = P.ctx + (size_t)r0 * D; dst = P.xcbuf + (size_t)r0 * D; }
    else { dst = P.out + (size_t)(r0 - TC) * D; res = l == 0 ? P.x + (size_t)(r0 - TC) * D : dst; }
    res += cbase + fr2 * 4; dst += cbase + fr2 * 4;
    const float4 g4 = *(const float4*)(P.mod + (size_t)(l * 9 + n) * 6144 + 2 * 1024 + cbase + fr2 * 4);
    float4 rres[4][8];
#pragma unroll
    for (int q = 0; q < 4; q++)
#pragma unroll
      for (int i = 0; i < 8; i++) rres[q][i] = *(const float4*)(res + (size_t)(q * 32 + i * 4 + fq2) * D);
    int it2 = it + 1, mt2, nt2;
    const bool have2 = next_tile(it2, MT, 8, mt2, nt2);
    const half_t* a1 = a0; const half_t* b1 = b0;
    if (have2) {
      asm volatile("" : "+s"(mt2), "+s"(nt2));
      a1 = P.mix + (size_t)((mt2 + mt0) * 256 + srow) * D + sc; b1 = Wt + (size_t)(nt2 * 128 + srow) * D + sc;
      gemm_prologue([&](int i) { return a1 + (size_t)i * 32 * D; }, [&](int i) { return b1 + (size_t)i * 32 * D; }, 16, smem);
    }
    {
      float* stg = (float*)(smem + 98304 + wave2 * 12288);
#pragma unroll
      for (int q = 0; q < 4; q++) {
#pragma unroll
        for (int ml = 0; ml < 2; ml++)
#pragma unroll
          for (int nn = 0; nn < 4; nn++)
#pragma unroll
            for (int j = 0; j < 4; j++) stg[(ml * 16 + fq2 * 4 + j) * 68 + nn * 16 + fr2] = acc[q * 2 + ml][nn][j];
        __builtin_amdgcn_wave_barrier();
#pragma unroll
        for (int i = 0; i < 8; i++) {
          const int row = i * 4 + fq2;
          const float4 a = *(const float4*)(stg + row * 68 + fr2 * 4);
          float4 r = rres[q][i];
          r.x += g4.x * a.x; r.y += g4.y * a.y; r.z += g4.z * a.z; r.w += g4.w * a.w;
          *(float4*)(dst + (size_t)(q * 32 + row) * D) = r;
        }
        __builtin_amdgcn_wave_barrier();
      }
    }
    mt = mt2; nt = nt2; it = it2; have = have2; a0 = a1; b0 = b1;
  }
}

DI void moe_prefix(const Params& P, int l, int* tb) {
  __syncthreads();
  if (TIDX == 0) { int s = 0; for (int e = 0; e < 32; e++) { tb[e] = s; s += (P.cnt[l * 32 + e] + 255) >> 8; } tb[32] = s; }
  __syncthreads();
}
DI void moe_e1_phase(const Params& P, int l, char* smem, int* tb) {
  const int tid = TIDX;
  moe_prefix(P, l, tb);
  const int sc = slot_col(), srow = tid >> 3;
  const int MT = tb[32];
  auto setup = [&](int rt, int nt, int (&tok)[8], const half_t*& w1, const half_t*& w3) {
    int e = 0;
    while (tb[e + 1] <= rt) e++;
    const int rl = rt - tb[e], cnt = P.cnt[l * 32 + e];
    const int* lst = P.list + (size_t)e * LCAP;
    w1 = P.Wt1 + ((size_t)(l * 32 + e) * 512 + nt * 64) * 1024 + sc;
    w3 = P.Wt3 + ((size_t)(l * 32 + e) * 512 + nt * 64) * 1024 + sc;
#pragma unroll
    for (int i = 0; i < 8; i++) tok[i] = lst[min(rl * 256 + i * 32 + srow, cnt - 1)] >> 1;
  };
  int it = 0, rt, nt;
  bool have = next_tile(it, MT, 8, rt, nt);
  int tok[8]; const half_t* w1 = nullptr; const half_t* w3 = nullptr;
  if (have) {
    asm volatile("" : "+s"(rt), "+s"(nt));
    setup(rt, nt, tok, w1, w3);
    gemm_prologue([&](int i) { return P.hx + (size_t)tok[i] * D + sc; }, [&](int i) { return ((i & 1) ? w3 : w1) + (size_t)((i >> 1) * 32 + srow) * 1024; }, 16, smem);
  }
#pragma unroll 1
  while (have) {
    int it2 = it + 1, rt2, nt2;
    const bool have2 = next_tile(it2, MT, 8, rt2, nt2);
    int tok2[8]; const half_t* w1n = w1; const half_t* w3n = w3;
#pragma unroll
    for (int i = 0; i < 8; i++) tok2[i] = tok[i];
    if (have2) {
      asm volatile("" : "+s"(rt2), "+s"(nt2));
      setup(rt2, nt2, tok2, w1n, w3n);
    }
    f4 acc[8][4];
    gemm256<true>([&](int i) { return P.hx + (size_t)tok[i] * D + sc; },
                  [&](int i) { return ((i & 1) ? w3 : w1) + (size_t)((i >> 1) * 32 + srow) * 1024; }, 16, smem, acc);
    if (have2) {
      gemm_prologue([&](int i) { return P.hx + (size_t)tok2[i] * D + sc; }, [&](int i) { return ((i & 1) ? w3n : w1n) + (size_t)((i >> 1) * 32 + srow) * 1024; }, 16, smem);
    }
    {
      const int tid2 = TIDX, lane2 = tid2 & 63, wave2 = tid2 >> 6, fr2 = lane2 & 15, fq2 = lane2 >> 4, wr2 = wave2 >> 1, wc2 = wave2 & 1;
      char* stg = smem + 98304 + wave2 * 12288;
      half_t* Hd = P.H + ((size_t)rt * 256 + wr2 * 128) * 512 + nt * 64 + wc2 * 32;
#pragma unroll
      for (int h = 0; h < 2; h++) {
#pragma unroll
        for (int ml = 0; ml < 4; ml++)
#pragma unroll
          for (int n = 0; n < 2; n++)
#pragma unroll
            for (int j = 0; j < 4; j++) {
              float a1 = acc[h * 4 + ml][n][j], a3 = acc[h * 4 + ml][n + 2][j];
              *(half_t*)(stg + (ml * 16 + fq2 * 4 + j) * 80 + (n * 16 + fr2) * 2) = (half_t)(a1 * sigmoidf_(a1) * a3);
            }
        __builtin_amdgcn_wave_barrier();
#pragma unroll
        for (int i = 0; i < 4; i++) {
          const int c = i * 64 + lane2, row = c >> 2, c16 = c & 3;
          h8 v = *(const h8*)(stg + row * 80 + c16 * 16);
          *(h8*)(Hd + (size_t)(h * 64 + row) * 512 + c16 * 8) = v;
        }
        __builtin_amdgcn_wave_barrier();
      }
    }
    rt = rt2; nt = nt2; it = it2; have = have2; w1 = w1n; w3 = w3n;
#pragma unroll
    for (int i = 0; i < 8; i++) tok[i] = tok2[i];
  }
}
DI void moe_e2_phase(const Params& P, int l, char* smem, int* tb) {
  const int tid = TIDX;
  moe_prefix(P, l, tb);
  const int sc = slot_col(), srow = tid >> 3;
  const int MT = tb[32];
  auto ptrs = [&](int rt, int nt, const half_t*& a0, const half_t*& b0) {
    int e = 0;
    while (tb[e + 1] <= rt) e++;
    a0 = P.H + ((size_t)rt * 256 + srow) * 512 + sc;
    b0 = P.Wt2 + ((size_t)(l * 32 + e) * 1024 + nt * 128 + srow) * 512 + sc;
  };
  int it = 0, rt, nt;
  bool have = next_tile(it, MT, 8, rt, nt);
  const half_t* a0 = nullptr; const half_t* b0 = nullptr;
  if (have) {
    asm volatile("" : "+s"(rt), "+s"(nt));
    ptrs(rt, nt, a0, b0);
    gemm_prologue([&](int i) { return a0 + (size_t)i * 32 * 512; }, [&](int i) { return b0 + (size_t)i * 32 * 512; }, 8, smem);
  }
#pragma unroll 1
  while (have) {
    const int tid2 = TIDX, lane2 = tid2 & 63, wave2 = tid2 >> 6, wr2 = wave2 >> 1, wc2 = wave2 & 1;
    int e = 0;
    while (tb[e + 1] <= rt) e++;
    const int rl = rt - tb[e], cnt = P.cnt[l * 32 + e];
    const int* lst = P.list + (size_t)e * LCAP; const float* lstw = P.listW + (size_t)e * LCAP;
    int aa[2][8]; float ww[2][8];
#pragma unroll
    for (int h = 0; h < 2; h++)
#pragma unroll
      for (int i = 0; i < 8; i++) {
        const int idx = rl * 256 + wr2 * 128 + h * 64 + ((i * 64 + lane2) >> 3);
        const int ic = min(idx, cnt - 1);
        const int av = lst[ic]; const float wv = lstw[ic];
        aa[h][i] = idx < cnt ? av : -1; ww[h][i] = wv;
      }
    f4 acc[8][4];
    gemm256<true>([&](int i) { return a0 + (size_t)i * 32 * 512; }, [&](int i) { return b0 + (size_t)i * 32 * 512; }, 8, smem, acc);
    int it2 = it + 1, rt2, nt2;
    const bool have2 = next_tile(it2, MT, 8, rt2, nt2);
    const half_t* a1 = a0; const half_t* b1 = b0;
    if (have2) {
      asm volatile("" : "+s"(rt2), "+s"(nt2));
      ptrs(rt2, nt2, a1, b1);
      gemm_prologue([&](int i) { return a1 + (size_t)i * 32 * 512; }, [&](int i) { return b1 + (size_t)i * 32 * 512; }, 8, smem);
    }
    {
      char* stg = smem + 98304 + wave2 * 12288;
      const int fr2 = lane2 & 15, fq2 = lane2 >> 4;
#pragma unroll
      for (int h = 0; h < 2; h++) {
#pragma unroll
        for (int ml = 0; ml < 4; ml++)
#pragma unroll
          for (int n = 0; n < 4; n++)
#pragma unroll
            for (int j = 0; j < 4; j++) stage_put(stg, ml, n, j, fr2, fq2, acc[h * 4 + ml][n][j]);
        __builtin_amdgcn_wave_barrier();
#pragma unroll
        for (int i = 0; i < 8; i++) {
          const int c = i * 64 + lane2, row = c >> 3, c16 = c & 7;
          h8 v = *(const h8*)(stg + row * 144 + c16 * 16);
          if (aa[h][i] >= 0) {
            const float w = ww[h][i];
#pragma unroll
            for (int u = 0; u < 8; u++) v[u] = (half_t)(w * (float)v[u]);
            *(h8*)(P.yA + (size_t)aa[h][i] * D + nt * 128 + wc2 * 64 + c16 * 8) = v;
          }
        }
        __builtin_amdgcn_wave_barrier();
      }
    }
    rt = rt2; nt = nt2; it = it2; have = have2; a0 = a1; b0 = b1;
  }
}

DI int swap23(int x) { return (x & ~12) | ((x & 4) << 1) | ((x & 8) >> 1); }
DI void attn_item(const Params& P, int l, int b, int head, int row0, int nkeys, char* smem) {
  const int tid = TIDX, lane = tid & 63, wave = tid >> 6, ql = lane & 31, hh = lane >> 5;
  const float lam = P.consts[l * 4 + 0], negc = -P.consts[l * 4 + 1], lam_init = P.consts[l * 4 + 2];
  const int myrow = row0 + wave * 32 + ql;
  h8 qf[2][4];
  {
    const half_t* qp = P.q + (size_t)myrow * 512 + head * 128 + hh * 8;
#pragma unroll
    for (int m = 0; m < 2; m++)
#pragma unroll
      for (int s = 0; s < 4; s++) { qf[m][s] = *(const h8*)(qp + m * 64 + s * 16); }
#pragma unroll
    for (int m = 0; m < 2; m++)
#pragma unroll
      for (int s = 0; s < 4; s++) tie(qf[m][s]);
  }
  f16v o0[4], o1[4];
#pragma unroll
  for (int dt = 0; dt < 4; dt++)
#pragma unroll
    for (int i = 0; i < 16; i++) { o0[dt][i] = 0.f; o1[dt][i] = 0.f; }
  float ls0 = 0.f, ls1 = 0.f;
  const half_t* kp[4]; const half_t* vp[4];
  {
    const half_t* kbase = P.kall + (size_t)b * KV * 512 + head * 128;
    const half_t* vbase = P.vT + (size_t)(b * 4 + head) * 128 * KV;
#pragma unroll
    for (int i = 0; i < 4; i++) {
      int s = i * 256 + tid;
      int row = s >> 4, c = (s & 15) ^ (row & 15); kp[i] = kbase + (size_t)row * 512 + c * 8;
      int vr = s >> 3, vc = (s & 7) ^ ((vr >> 1) & 7); vp[i] = vbase + (size_t)vr * KV + vc * 8;
    }
  }
  const int ntile = nkeys >> 6;
  const unsigned sbase = lds_addr(smem);
  auto issue = [&](int t) {
    char* d = smem + (t & 3) * 32768 + tid * 16;
#pragma unroll
    for (int i = 0; i < 4; i++) { glds16(kp[i] + (size_t)t * 64 * 512, d + i * 4096); glds16(vp[i] + t * 64, d + 16384 + i * 4096); }
  };
  unsigned koff[2];
  const int kr_lo = swap23(ql), ksw = kr_lo & 15;
  koff[0] = kr_lo * 256; koff[1] = (32 + kr_lo) * 256;
  unsigned voff[4];
#pragma unroll
  for (int dt = 0; dt < 4; dt++) { int vrow = dt * 32 + ql; voff[dt] = 16384 + vrow * 128; }
  const int vsw = (ql >> 1) & 7;
  f16v negcv;
#pragma unroll
  for (int i = 0; i < 16; i++) negcv[i] = negc;
  h8 pp0[2], pp1[2];
  unsigned pendV = 0; int pendkt = 0; bool pend = false;
  auto half_step = [&](h8 (&kf)[8], unsigned cur, int kt) {
    h8 vf[8];
    if (pend) {
#pragma unroll
      for (int sp = 0; sp < 2; sp++)
#pragma unroll
        for (int dt = 0; dt < 4; dt++) vf[sp * 4 + dt] = lds128(pendV + voff[dt] + (((pendkt * 4 + sp * 2 + hh) ^ vsw) << 4));
    }
    f16v s0 = mfma32(kf[0], qf[0][0], negcv), s1 = mfma32(kf[4], qf[1][0], negcv);
#pragma unroll
    for (int st = 1; st < 4; st++) { s0 = mfma32(kf[st], qf[0][st], s0); s1 = mfma32(kf[4 + st], qf[1][st], s1); }
    if (pend) {
      WAIT_LGKM(0);
#pragma unroll
      for (int i = 0; i < 8; i++) tie(vf[i]);
#pragma unroll
      for (int sp = 0; sp < 2; sp++)
#pragma unroll
        for (int dt = 0; dt < 4; dt++) { o0[dt] = mfma32(vf[sp * 4 + dt], pp0[sp], o0[dt]); o1[dt] = mfma32(vf[sp * 4 + dt], pp1[sp], o1[dt]); }
    }
#pragma unroll
    for (int i = 0; i < 16; i++) { s0[i] = __builtin_amdgcn_exp2f(s0[i]); ls0 += s0[i]; s1[i] = __builtin_amdgcn_exp2f(s1[i]); ls1 += s1[i]; }
#pragma unroll
    for (int sp = 0; sp < 2; sp++) {
      u4 a, c;
      a[0] = pk2(s0[8*sp+0], s0[8*sp+1]); a[1] = pk2(s0[8*sp+2], s0[8*sp+3]); a[2] = pk2(s0[8*sp+4], s0[8*sp+5]); a[3] = pk2(s0[8*sp+6], s0[8*sp+7]);
      c[0] = pk2(s1[8*sp+0], s1[8*sp+1]); c[1] = pk2(s1[8*sp+2], s1[8*sp+3]); c[2] = pk2(s1[8*sp+4], s1[8*sp+5]); c[3] = pk2(s1[8*sp+6], s1[8*sp+7]);
      pp0[sp] = __builtin_bit_cast(h8, a); pp1[sp] = __builtin_bit_cast(h8, c);
    }
    pend = true; pendV = cur; pendkt = kt;
  };
  issue(0);
  if (ntile > 1) issue(1);
#pragma unroll 1
  for (int t = 0; t < ntile; t++) {
    if (t + 1 < ntile) asm volatile("s_waitcnt vmcnt(8)" ::: "memory"); else wait_vm0();
    raw_barrier();
    if (t + 2 < ntile) issue(t + 2);
    const unsigned cur = sbase + (t & 3) * 32768;
    h8 kfa[8], kfb[8];
#pragma unroll
    for (int st = 0; st < 4; st++) {
      kfa[st] = lds128(cur + koff[0] + (((st * 2 + hh) ^ ksw) << 4));
      kfa[4 + st] = lds128(cur + koff[0] + (((8 + st * 2 + hh) ^ ksw) << 4));
    }
#pragma unroll
    for (int st = 0; st < 4; st++) {
      kfb[st] = lds128(cur + koff[1] + (((st * 2 + hh) ^ ksw) << 4));
      kfb[4 + st] = lds128(cur + koff[1] + (((8 + st * 2 + hh) ^ ksw) << 4));
    }
    WAIT_LGKM(8);
#pragma unroll
    for (int i = 0; i < 8; i++) tie(kfa[i]);
    half_step(kfa, cur, 0);
    WAIT_LGKM(0);
#pragma unroll
    for (int i = 0; i < 8; i++) tie(kfb[i]);
    half_step(kfb, cur, 1);
  }
  {
    h8 vf[8];
#pragma unroll
    for (int sp = 0; sp < 2; sp++)
#pragma unroll
      for (int dt = 0; dt < 4; dt++) vf[sp * 4 + dt] = lds128(pendV + voff[dt] + (((pendkt * 4 + sp * 2 + hh) ^ vsw) << 4));
    WAIT_LGKM(0);
#pragma unroll
    for (int i = 0; i < 8; i++) tie(vf[i]);
#pragma unroll
    for (int sp = 0; sp < 2; sp++)
#pragma unroll
      for (int dt = 0; dt < 4; dt++) { o0[dt] = mfma32(vf[sp * 4 + dt], pp0[sp], o0[dt]); o1[dt] = mfma32(vf[sp * 4 + dt], pp1[sp], o1[dt]); }
  }
  raw_barrier();
  ls0 += shx(ls0, 32); ls1 += shx(ls1, 32);
  const float i0 = 1.f / ls0, i1 = lam / ls1;
  float ss = 0.f;
#pragma unroll
  for (int dt = 0; dt < 4; dt++)
#pragma unroll
    for (int i = 0; i < 16; i++) { float v = o0[dt][i] * i0 - o1[dt][i] * i1; o0[dt][i] = v; ss += v * v; }
  ss += shx(ss, 32);
  const float mult = rsqrtf(ss * (1.f / 128.f) + EPS) * (1.f - lam_init);
  const float* sg = P.subln_g + l * 128;
  half_t* dst = P.mix + (size_t)myrow * D + 256 + head * 128;
#pragma unroll
  for (int dt = 0; dt < 4; dt++)
#pragma unroll
    for (int g = 0; g < 4; g++) {
      const int d0 = dt * 32 + 8 * g + 4 * hh;
      float4 gv = *(const float4*)(sg + d0);
      h4 o; o[0] = (half_t)(o0[dt][4*g] * mult * gv.x); o[1] = (half_t)(o0[dt][4*g+1] * mult * gv.y);
      o[2] = (half_t)(o0[dt][4*g+2] * mult * gv.z); o[3] = (half_t)(o0[dt][4*g+3] * mult * gv.w);
      *(h4*)(dst + d0) = o;
    }
}

DI int swz128(int row, int colh) { return row * 128 + ((((colh >> 3)) ^ ((row >> 1) & 7)) << 4) + (colh & 7) * 2; }
DI void lru_load_w(const Params& P, int l, int g, char* Wt) {
  const int tid = TIDX;
  for (int dg = 0; dg < 4; dg++) {
    const int dir = dg >> 1;
    const float* w = ((dg & 1) ? P.gate_x_w : P.gate_a_w) + ((size_t)((l * 2 + dir) * 4 + g)) * 4096;
    for (int idx = tid; idx < 4096; idx += 256) { int i = idx >> 6, o = idx & 63; *(half_t*)(Wt + dg * 8192 + swz128(o, i)) = (half_t)w[idx]; }
  }
}
struct LruK { float ba[2][4], bx[2][4], sp8[2][4], cw[5]; };
DI void lru_consts(const Params& P, int l, int g, LruK& K) {
  const int tid = TIDX, fr = tid & 15, gc = g * 64 + (tid & 63);
#pragma unroll
  for (int dir = 0; dir < 2; dir++)
#pragma unroll
    for (int n = 0; n < 4; n++) {
      const int cc = (l * 2 + dir) * 256 + g * 64 + n * 16 + fr;
      K.ba[dir][n] = P.gate_a_b[cc]; K.bx[dir][n] = P.gate_x_b[cc]; K.sp8[dir][n] = -8.f * log1pf(__expf(-P.lru_lambda[cc]));
    }
#pragma unroll
  for (int k = 0; k < 4; k++) K.cw[k] = P.conv_w[(l * 4 + k) * 256 + gc];
  K.cw[4] = P.conv_b[l * 256 + gc];
}
DI void lru_tile(const Params& P, int l, int b, int tile, int g, char* smem, bool final, const LruK& K) {
  const int tid = TIDX, lane = tid & 63, wave = tid >> 6, fr = lane & 15, fq = lane >> 4;
  char* Wt = smem;
  char* xr16 = smem + 32768;
  float2* ab = (float2*)(smem + 40960);
  half_t* raw = (half_t*)(smem + 40960);
  float2* subst = (float2*)(smem + 73728);
  const int ch = tid & 63, tq = tid >> 6, gc = g * 64 + ch;
  const int T = tile < 4 ? CL : SEQ;
  const int t0 = tile < 4 ? tile * 64 : (tile - 4) * 64;
  const int rowbase = tile < 4 ? b * CL : TC + b * SEQ;
  unsigned* lab = (unsigned*)P.hx;
  __syncthreads();
  if (final) {
    float gyv[16], hsum[16];
#pragma unroll
    for (int e = 0; e < 16; e++) { gyv[e] = (float)P.gy[(size_t)(rowbase + t0 + tq * 16 + e) * 256 + gc]; hsum[e] = 0.f; }
    unsigned pk0[16], pk1[16];
#pragma unroll
    for (int e = 0; e < 16; e++) { pk0[e] = lab[((size_t)rowbase + t0 + tq * 16 + e) * 256 + gc]; pk1[e] = lab[((size_t)TA + rowbase + t0 + tq * 16 + e) * 256 + gc]; }
    const float car0 = P.lcar[((size_t)((b * 2 + 0) * 132 + tile)) * 256 + gc], car1 = P.lcar[((size_t)((b * 2 + 1) * 132 + tile)) * 256 + gc];
#pragma unroll 1
    for (int dir = 0; dir < 2; dir++) {
      unsigned pk[16];
#pragma unroll
      for (int e = 0; e < 16; e++) pk[e] = dir == 0 ? pk0[e] : pk1[e];
      float2 av[16];
      float A = 1.f, h = 0.f;
#pragma unroll
      for (int e = 0; e < 16; e++) {
        const int ee = dir == 0 ? e : 15 - e;
        unsigned u = pk[0];
#pragma unroll
        for (int q = 1; q < 16; q++) u = (q == ee) ? pk[q] : u;
        fp16x2 hv = __builtin_bit_cast(fp16x2, u);
        av[e] = make_float2(__expf((float)hv[0]), (float)hv[1]);
        h = av[e].x * h + av[e].y; A *= av[e].x;
      }
      subst[tq * 64 + ch] = make_float2(A, h);
      __syncthreads();
      h = dir == 0 ? car0 : car1;
      if (dir == 0) { for (int s2 = 0; s2 < tq; s2++) { float2 ss = subst[s2 * 64 + ch]; h = ss.x * h + ss.y; } }
      else { for (int s2 = 3; s2 > tq; s2--) { float2 ss = subst[s2 * 64 + ch]; h = ss.x * h + ss.y; } }
#pragma unroll
      for (int e = 0; e < 16; e++) {
        const int ee = dir == 0 ? e : 15 - e;
        h = av[e].x * h + av[e].y;
#pragma unroll
        for (int q = 0; q < 16; q++) hsum[q] += (q == ee) ? h : 0.f;
      }
      __syncthreads();
    }
#pragma unroll
    for (int e = 0; e < 16; e++)
      P.mix[(size_t)(rowbase + t0 + tq * 16 + e) * D + 768 + gc] = (half_t)(gyv[e] * hsum[e]);
    return;
  }
  for (int idx = tid; idx < 67 * 8; idx += 256) {
    int row = idx >> 3, c = idx & 7, tt = t0 - 1 + row;
    h8 v = {0, 0, 0, 0, 0, 0, 0, 0};
    if (tt >= 0 && tt < T) v = *(const h8*)(P.rr + (size_t)(rowbase + tt) * 256 + g * 64 + c * 8);
    *(h8*)(raw + row * 64 + c * 8) = v;
  }
  const float cw0 = K.cw[0], cw1 = K.cw[1], cw2 = K.cw[2], cw3 = K.cw[3], cb = K.cw[4];
  __syncthreads();
  {
    float v[19];
#pragma unroll
    for (int e = 0; e < 19; e++) v[e] = (float)raw[(tq * 16 + e) * 64 + ch];
    __syncthreads();
#pragma unroll
    for (int e = 0; e < 16; e++) {
      float xv = cb + cw0 * v[e] + cw1 * v[e + 1] + cw2 * v[e + 2] + cw3 * v[e + 3];
      *(half_t*)(xr16 + swz128(tq * 16 + e, ch)) = (half_t)xv;
    }
  }
  __syncthreads();
#pragma unroll 1
  for (int dir = 0; dir < 2; dir++) {
    {
      f4 acc[2][4];
#pragma unroll
      for (int gt = 0; gt < 2; gt++)
#pragma unroll
        for (int n = 0; n < 4; n++) acc[gt][n] = (f4){0.f, 0.f, 0.f, 0.f};
#pragma unroll
      for (int kk = 0; kk < 2; kk++) {
        int row = wave * 16 + fr;
        h8 af = *(const h8*)(xr16 + row * 128 + (((kk * 4 + fq) ^ ((row >> 1) & 7)) << 4));
#pragma unroll
        for (int gt = 0; gt < 2; gt++)
#pragma unroll
          for (int n = 0; n < 4; n++) {
            int orow = n * 16 + fr;
            h8 bf = *(const h8*)(Wt + (dir * 2 + gt) * 8192 + orow * 128 + (((kk * 4 + fq) ^ ((orow >> 1) & 7)) << 4));
            acc[gt][n] = mfma16(af, bf, acc[gt][n]);
          }
      }
#pragma unroll
      for (int n = 0; n < 4; n++) {
        const float ba = dir == 0 ? K.ba[0][n] : K.ba[1][n], bx = dir == 0 ? K.bx[0][n] : K.bx[1][n], sp8 = dir == 0 ? K.sp8[0][n] : K.sp8[1][n];
#pragma unroll
        for (int j = 0; j < 4; j++) {
          int tl = wave * 16 + fq * 4 + j, c2 = n * 16 + fr;
          float xv = (float)*(const half_t*)(xr16 + swz128(tl, c2));
          float rg = sigmoidf_(acc[0][n][j] + ba), ig = sigmoidf_(acc[1][n][j] + bx);
          float log_a = rg * sp8;
          float x2 = 2.f * log_a;
          float om = -x2 * (1.f + x2 * (0.5f + x2 * (0.16666667f + x2 * (0.041666668f + x2 * (0.008333334f + x2 * 0.0013888889f)))));
          if (x2 < -0.4f) { float a = __expf(log_a); om = 1.f - a * a; }
          ab[tl * 64 + c2] = make_float2(log_a, sqrtf(om) * (ig * xv));
        }
      }
    }
    __syncthreads();
    {
      float A = 1.f, h = 0.f;
#pragma unroll
      for (int e = 0; e < 16; e++) {
        const int ee = dir == 0 ? e : 15 - e;
        const float2 lb = ab[(tq * 16 + ee) * 64 + ch];
        fp16x2 hv; hv[0] = (__fp16)lb.x; hv[1] = (__fp16)lb.y;
        lab[((size_t)dir * TA + rowbase + t0 + tq * 16 + ee) * 256 + gc] = __builtin_bit_cast(unsigned, hv);
        const float a = __expf((float)hv[0]), bt = (float)hv[1];
        h = a * h + bt; A *= a;
      }
      subst[tq * 64 + ch] = make_float2(A, h);
    }
    __syncthreads();
    if (tq == 0) {
      float A = 1.f, h = 0.f;
#pragma unroll
      for (int s2 = 0; s2 < 4; s2++) { float2 ss = subst[(dir == 0 ? s2 : 3 - s2) * 64 + ch]; h = ss.x * h + ss.y; A *= ss.x; }
      P.lsum[((size_t)((b * 2 + dir) * 132 + tile)) * 256 + gc] = make_float2(A, h);
    }
    __syncthreads();
  }
}
DI void lru_carry_item(const Params& P, int it) {
  const int ch = TIDX, dir = it & 1;
  const size_t base = (size_t)it * 132 * 256 + ch;
  float c = 0.f;
#pragma unroll 4
  for (int k = 0; k < 132; k++) {
    int tile = dir == 0 ? k : (k < 4 ? 3 - k : 135 - k);
    float2 s = P.lsum[base + (size_t)tile * 256];
    P.lcar[base + (size_t)tile * 256] = c;
    c = s.x * c + s.y;
  }
}

template <int NROWS>
DI void fft_load(const half_t* src, size_t rs, char* Bt, int rowbytes, int k0) {
  const int tid = TIDX;
  h8 v[NROWS / 16];
#pragma unroll
  for (int i = 0; i < NROWS / 16; i++) { int idx = i * 256 + tid; v[i] = *(const h8*)(src + (size_t)(idx >> 4) * rs + (idx & 15) * 8); }
#pragma unroll
  for (int i = 0; i < NROWS / 16; i++) {
    int idx = i * 256 + tid, kr = idx >> 4, cc = idx & 15, k = k0 + kr;
#pragma unroll
    for (int u = 0; u < 8; u++) { int n = cc * 8 + u; *(half_t*)(Bt + n * rowbytes + ((((k >> 3)) ^ (n & 15)) << 4) + (k & 7) * 2) = v[i][u]; }
  }
}
template <class RF>
DI void fft_mma(const half_t* Dm, int ldD, int nkk, const char* Bt, int rowbytes, f4 (&acc)[4][4], RF arow) {
  const int lane = TIDX & 63, wave = TIDX >> 6, fr = lane & 15, fq = lane >> 4, wc = wave & 1;
#pragma unroll 4
  for (int kk = 0; kk < nkk; kk++) {
    h8 af[4], bf[4];
#pragma unroll
    for (int ms = 0; ms < 4; ms++) af[ms] = *(const h8*)(Dm + (size_t)arow(ms) * ldD + kk * 32 + fq * 8);
#pragma unroll
    for (int ns = 0; ns < 4; ns++) { int n = wc * 64 + ns * 16 + fr; bf[ns] = *(const h8*)(Bt + n * rowbytes + (((kk * 4 + fq) ^ (n & 15)) << 4)); }
#pragma unroll
    for (int ms = 0; ms < 4; ms++)
#pragma unroll
      for (int ns = 0; ns < 4; ns++) acc[ms][ns] = mfma16(af[ms], bf[ns], acc[ms][ns]);
  }
}
DI void zero44(f4 (&acc)[4][4]) {
#pragma unroll
  for (int m = 0; m < 4; m++)
#pragma unroll
    for (int n = 0; n < 4; n++) acc[m][n] = (f4){0.f, 0.f, 0.f, 0.f};
}
DI void fftA_item(const Params& P, int it, char* smem) {
  const int b = it >> 8, bb = (it >> 1) & 127, chh = it & 1;
  const int lane = TIDX & 63, wave = TIDX >> 6, fr = lane & 15, fq = lane >> 4, wr = wave >> 1, wc = wave & 1;
  __syncthreads();
  fft_load<64>(P.QF + (size_t)(TC + b * SEQ + bb) * 512 + chh * 128, (size_t)128 * 512, smem, 256, 0);
  fft_load<64>(P.QF + (size_t)(TC + b * SEQ + bb) * 512 + 256 + chh * 128, (size_t)128 * 512, smem, 256, 64);
  __syncthreads();
  f4 acc[4][4]; zero44(acc);
  fft_mma(P.DA, 128, 4, smem, 256, acc, [&](int ms) { return (ms >> 1) * 64 + wr * 32 + (ms & 1) * 16 + fr; });
#pragma unroll
  for (int ms = 0; ms < 2; ms++)
#pragma unroll
    for (int j = 0; j < 4; j++) {
      const int f1 = wr * 32 + ms * 16 + fq * 4 + j;
      const float2 w = P.tw[(bb * f1) & 8191];
      half_t* d0 = P.GA + ((size_t)(b * 64 + f1) * 256 + bb) * 256 + chh * 128 + wc * 64 + fr;
#pragma unroll
      for (int ns = 0; ns < 4; ns++) {
        float gr = acc[ms][ns][j], gi = acc[ms + 2][ns][j];
        d0[ns * 16] = (half_t)(gr * w.x + gi * w.y);
        d0[(size_t)128 * 256 + ns * 16] = (half_t)(gi * w.x - gr * w.y);
      }
    }
}
DI void fftB_item(const Params& P, int it, char* smem) {
  const int b = it >> 7, f1 = (it >> 1) & 63, chh = it & 1;
  const int lane = TIDX & 63, wave = TIDX >> 6, fr = lane & 15, fq = lane >> 4, wr = wave >> 1, wc = wave & 1;
  __syncthreads();
  fft_load<256>(P.GA + (size_t)(b * 64 + f1) * 256 * 256 + chh * 128, 256, smem, 512, 0);
  __syncthreads();
  f4 acc[4][4]; zero44(acc);
  fft_mma(P.DB, 256, 8, smem, 512, acc, [&](int ms) { return wr * 64 + ms * 16 + fr; });
#pragma unroll
  for (int ms = 0; ms < 4; ms++)
#pragma unroll
    for (int j = 0; j < 4; j++) {
      const int f2 = wr * 64 + ms * 16 + fq * 4 + j;
      half_t* d0 = P.mix + (size_t)(TC + b * SEQ + f1 + 64 * f2) * D + chh * 128 + wc * 64 + fr;
#pragma unroll
      for (int ns = 0; ns < 4; ns++) d0[ns * 16] = (half_t)acc[ms][ns][j];
    }
}
DI void fftC_item(const Params& P, int it, char* smem) {
  const int b = it >> 1, chh = it & 1;
  const int lane = TIDX & 63, wave = TIDX >> 6, fr = lane & 15, fq = lane >> 4, wr = wave >> 1, wc = wave & 1;
#pragma unroll 1
  for (int mh = 0; mh < 2; mh++) {
    f4 acc[4][4]; zero44(acc);
#pragma unroll 1
    for (int part = 0; part < 2; part++) {
      __syncthreads();
      fft_load<256>(P.QF + (size_t)(b * CL) * 512 + part * 256 + chh * 128, 512, smem, 512, 0);
      __syncthreads();
      fft_mma(P.DC + part * 256, 512, 8, smem, 512, acc, [&](int ms) { return mh * 128 + wr * 64 + ms * 16 + fr; });
    }
#pragma unroll
    for (int ms = 0; ms < 4; ms++)
#pragma unroll
      for (int j = 0; j < 4; j++) {
        const int f = mh * 128 + wr * 64 + ms * 16 + fq * 4 + j;
        half_t* d0 = P.mix + (size_t)(b * CL + f) * D + chh * 128 + wc * 64 + fr;
#pragma unroll
        for (int ns = 0; ns < 4; ns++) d0[ns * 16] = (half_t)acc[ms][ns][j];
      }
  }
}

#ifndef MX
#define MX 15
#endif
DI void mix_phase(const Params& P, int l, char* smem, int* s_item, int qi) {
  const int nL = 0, nA = 0, nC = l == 0 ? 64 : 0, nFA = 2048, nFC = l == 0 ? 16 : 0;
  const int total = nL + nA + nC + nFA + nFC;
  {
    const int g = blockIdx.x & 3;
    lru_load_w(P, l, g, smem);
    LruK K; lru_consts(P, l, g, K);
    for (int u = blockIdx.x >> 2; u < NB_ * 132; u += gridDim.x >> 2) lru_tile(P, l, u / 132, u % 132, g, smem, false, K);
    asm volatile("s_waitcnt vmcnt(0)" ::: "memory");
    __syncthreads();
    if (TIDX == 0) {
      __builtin_amdgcn_fence(__ATOMIC_RELEASE, "agent");
      asm volatile("s_waitcnt vmcnt(0)" ::: "memory");
      __hip_atomic_fetch_add((unsigned*)&P.qctr[48 + l], 1u, __ATOMIC_RELAXED, __HIP_MEMORY_SCOPE_AGENT);
    }
  }
  int stage = 0;
  for (;;) {
    __syncthreads();
    if (TIDX == 0) *s_item = stage == 0 ? atomicAdd(&P.qctr[8 + qi * 8 + (blockIdx.x & 7)], 1) : atomicAdd(&P.qctr[qi], 1);
    __syncthreads();
    int it = *s_item;
    int kind = -1, b = 0, head = 0, row0 = 0, nk = 0;
    if (stage == 0) {
      if (it >= 256) {
        stage = 1;
        if (blockIdx.x >= gridDim.x - 16) {
          if (TIDX == 0) {
            while (__hip_atomic_load((unsigned*)&P.qctr[48 + l], __ATOMIC_RELAXED, __HIP_MEMORY_SCOPE_AGENT) < gridDim.x) __builtin_amdgcn_s_sleep(1);
            __builtin_amdgcn_fence(__ATOMIC_ACQUIRE, "agent");
            asm volatile("s_waitcnt vmcnt(0)" ::: "memory");
          }
          __syncthreads();
          lru_carry_item(P, gridDim.x - 1 - blockIdx.x);
        }
        continue;
      }
      const int pair = (blockIdx.x & 7) + 8 * (it >> 6);
      b = pair >> 2; head = pair & 3; row0 = TC + b * SEQ + (it & 63) * 128; nk = KV; kind = 0;
    } else {
      if (it >= total) break;
      if (it < nFC) { kind = 2; }
      else if (it < nFC + nC) { it -= nFC; b = it >> 3; head = (it >> 1) & 3; row0 = b * CL + (it & 1) * 128; nk = CL; kind = 0; }
      else { kind = 1; it -= nFC + nC; }
    }
    if (kind == 0) attn_item(P, l, b, head, row0, nk, smem);
    else if (kind == 1) fftA_item(P, it, smem);
    else fftC_item(P, it, smem);
  }
}

DI void grid_barrier(unsigned* bar, unsigned k, unsigned xn, unsigned nx) {
  asm volatile("s_waitcnt vmcnt(0)" ::: "memory");
  __syncthreads();
  if (threadIdx.x == 0) {
    const unsigned x = (unsigned)__builtin_amdgcn_s_getreg((3 << 11) | 20) & 0x7u;
    unsigned* xc = bar + 16 + x * 16; unsigned* top = bar;
    const unsigned old = __hip_atomic_fetch_add(xc, 1u, __ATOMIC_RELAXED, __HIP_MEMORY_SCOPE_AGENT);
    if (old == k * xn - 1u) {
      __builtin_amdgcn_fence(__ATOMIC_RELEASE, "agent");
      asm volatile("s_waitcnt vmcnt(0)" ::: "memory");
      __hip_atomic_fetch_add(top, 1u, __ATOMIC_RELAXED, __HIP_MEMORY_SCOPE_AGENT);
    }
    while (__hip_atomic_load(top, __ATOMIC_RELAXED, __HIP_MEMORY_SCOPE_AGENT) < k * nx) __builtin_amdgcn_s_sleep(1);
    __builtin_amdgcn_fence(__ATOMIC_ACQUIRE, "agent");
    asm volatile("s_waitcnt vmcnt(0)" ::: "memory");
  }
  __syncthreads();
}
__global__ void __launch_bounds__(256, 1) fwd_megakernel(Params Pin) {
  Params P = Pin; bind_ws(P);
  __shared__ __attribute__((aligned(16))) char smem[147456 + 8192];
  __shared__ int tb[33];
  __shared__ int s_item;
  cg::grid_group grid = cg::this_grid();
  unsigned* bar = (unsigned*)(P.ws + O_bar); unsigned bk = 0;
  if (threadIdx.x == 0) __hip_atomic_fetch_add(bar + 160 + ((unsigned)__builtin_amdgcn_s_getreg((3 << 11) | 20) & 0x7u), 1u, __ATOMIC_RELAXED, __HIP_MEMORY_SCOPE_AGENT);
#ifndef PH
#define PH 0xFFFF
#endif
#if PH & 1
  phase0(P, smem);
#endif
  grid.sync();
  unsigned xn, nx = 0;
  {
    const unsigned myx = (unsigned)__builtin_amdgcn_s_getreg((3 << 11) | 20) & 0x7u;
    xn = __hip_atomic_load(bar + 160 + myx, __ATOMIC_RELAXED, __HIP_MEMORY_SCOPE_AGENT);
#pragma unroll
    for (int x = 0; x < 8; x++) nx += __hip_atomic_load(bar + 160 + x, __ATOMIC_RELAXED, __HIP_MEMORY_SCOPE_AGENT) != 0u;
  }
  for (int l = 0; l < 2; l++) {
#if PH & 2
    row1_phase(P, l == 0 ? -1 : 0, l, 0);
#endif
    grid_barrier(bar, ++bk, xn, nx);
#if PH & 4
    gemm_in_phase(P, l, smem);
#ifdef DUP_GEMM
    grid_barrier(bar, ++bk, xn, nx);
    gemm_in_phase(P, l, smem);
#endif
#endif
    grid_barrier(bar, ++bk, xn, nx);
#if PH & 8
    mix_phase(P, l, smem, &s_item, l);
#ifdef DUP_MIX
    grid_barrier(bar, ++bk, xn, nx);
    mix_phase(P, l, smem, &s_item, 2 + l);
#endif
#endif
    grid_barrier(bar, ++bk, xn, nx);
#if PH & 16
    for (int it = blockIdx.x; it < 1024; it += gridDim.x) fftB_item(P, it, smem);
#endif
#if PH & 512
    {
      const int g = blockIdx.x & 3;
      LruK K{};
      for (int u = blockIdx.x >> 2; u < NB_ * 132; u += gridDim.x >> 2) lru_tile(P, l, u / 132, u % 132, g, smem, true, K);
    }
#endif
    grid_barrier(bar, ++bk, xn, nx);
#if PH & 32
    gemm_out_phase(P, l, smem);
#endif
    grid_barrier(bar, ++bk, xn, nx);
#if PH & 64
    row2_phase(P, l, l == 0 ? 0 : TC, smem);
#endif
    grid_barrier(bar, ++bk, xn, nx);
#if PH & 128
    moe_e1_phase(P, l, smem, tb);
#ifdef DUP_GEMM
    grid_barrier(bar, ++bk, xn, nx);
    moe_e1_phase(P, l, smem, tb);
#endif
#endif
    grid_barrier(bar, ++bk, xn, nx);
#if PH & 256
    moe_e2_phase(P, l, smem, tb);
#ifdef DUP_GEMM
    grid_barrier(bar, ++bk, xn, nx);
    moe_e2_phase(P, l, smem, tb);
#endif
#endif
    grid_barrier(bar, ++bk, xn, nx);
  }
#if PH & 2
  row1_phase(P, 1, -1, TC);
#endif
}

extern "C" void kernel_launch(void* const* d_in, const int* in_sizes, int n_in, void* d_out, int out_size, void* d_ws, size_t ws_size,
                              hipStream_t stream) {
  static int grid_blocks = 0;
  if (!grid_blocks) {
    int dev = 0, cus = 0, per_cu = 0;
    hipGetDevice(&dev);
    hipDeviceGetAttribute(&cus, hipDeviceAttributeMultiprocessorCount, dev);
    hipOccupancyMaxActiveBlocksPerMultiprocessor(&per_cu, fwd_megakernel, 256, 0);
    if (per_cu > 2) per_cu = 2;
    grid_blocks = cus * per_cu;
    if (grid_blocks > 256) grid_blocks = 256;
  }
  if (grid_blocks != 256) { fprintf(stderr, "need 256 co-resident blocks, have %d\n", grid_blocks); return; }
  Params p{};
  const float** pin = (const float**)&p;
  for (int i = 0; i < 31; i++) pin[i] = (const float*)d_in[i];
  p.out = (float*)d_out;
  p.ws = (char*)d_ws;
  if (WS_NEED > ws_size) { fprintf(stderr, "workspace too small: need %zu have %zu\n", (size_t)WS_NEED, ws_size); return; }
  hipMemsetAsync((char*)d_ws + O_bar, 0, 1024, stream);
  void* args[] = {&p};
  hipError_t e = hipLaunchCooperativeKernel((void*)fwd_megakernel, dim3(grid_blocks), dim3(256), args, 0, stream);
  if (e != hipSuccess) fprintf(stderr, "cooperative launch failed: %s (grid %d)\n", hipGetErrorString(e), grid_blocks);
}
```

```cpp
#include <hip/hip_runtime.h>
#include <hip/hip_cooperative_groups.h>
#include <cstdio>
namespace cg = cooperative_groups;

typedef _Float16 half_t;
typedef _Float16 h8 __attribute__((ext_vector_type(8)));
typedef _Float16 h4 __attribute__((ext_vector_type(4)));
typedef __fp16 fp16x2 __attribute__((ext_vector_type(2)));
typedef unsigned u4 __attribute__((ext_vector_type(4)));
typedef float f4 __attribute__((ext_vector_type(4)));
typedef float f16v __attribute__((ext_vector_type(16)));
#define DI __device__ __forceinline__
__device__ __forceinline__ int tid_opaque() { int t = threadIdx.x; asm volatile("" : "+v"(t)); return t; }
#define TIDX tid_opaque()

constexpr int D = 1024, NB_ = 8, SEQ = 8192, CL = 256;
constexpr int TC = NB_ * CL;
constexpr int TX = NB_ * SEQ;
constexpr int TA = TC + TX;
constexpr int KV = CL + SEQ;
constexpr int NIN = 2560;
constexpr int LCAP = 2 * TA;
constexpr float EPS = 1e-6f;

struct Params {
  const float *x, *c, *ctx, *c_ctx, *w_mod, *b_mod, *norm1_g, *norm2_g, *w_in, *q_norm_g, *k_norm_g, *lq1, *lk1, *lq2, *lk2,
      *subln_g, *conv_w, *conv_b, *gate_a_w, *gate_a_b, *gate_x_w, *gate_x_b, *lru_lambda, *w_out, *w_group, *b_group,
      *w_router, *b_router, *w1, *w3, *w2;
  float* out; char* ws;
  half_t *WtIn, *WtOut, *Wt1, *Wt3, *Wt2;
  float* mod; float2* rope; float2* tw; half_t *DA, *DB, *DC; float* consts; int* cnt; int* qctr; float* tokW; int* list; float* listW;
  float* xcbuf; half_t* WrH;
  half_t *hx, *mix, *q, *kall, *vT, *QF, *gy, *rr; float2* lsum; float* lcar; half_t* GA; half_t *H, *yA;
};


constexpr size_t al256(size_t x) { return (x + 255) & ~(size_t)255; }
constexpr size_t O_WtIn = 0;
constexpr size_t O_WtOut = O_WtIn + al256((size_t)2 * NIN * 1024 * 2);
constexpr size_t O_Wt1 = O_WtOut + al256((size_t)2 * 1024 * 1024 * 2);
constexpr size_t O_Wt3 = O_Wt1 + al256((size_t)64 * 524288 * 2);
constexpr size_t O_Wt2 = O_Wt3 + al256((size_t)64 * 524288 * 2);
constexpr size_t O_mod = O_Wt2 + al256((size_t)64 * 524288 * 2);
constexpr size_t O_rope = O_mod + al256((size_t)2 * 9 * 6144 * 4);
constexpr size_t O_tw = O_rope + al256(128 * 16 * 8);
constexpr size_t O_DA = O_tw + al256(8192 * 8);
constexpr size_t O_DB = O_DA + al256(16384 * 2);
constexpr size_t O_DC = O_DB + al256(32768 * 2);
constexpr size_t O_consts = O_DC + al256(131072 * 2);
constexpr size_t O_cnt = O_consts + 256;
constexpr size_t O_qctr = O_cnt + 256;
constexpr size_t O_bar = O_qctr + 256;
constexpr size_t O_tokW = O_bar + 1024;
constexpr size_t O_list = O_tokW + al256((size_t)2 * TA * 4);
constexpr size_t O_listW = O_list + al256((size_t)32 * LCAP * 4);
constexpr size_t O_xcbuf = O_listW + al256((size_t)32 * LCAP * 4);
constexpr size_t O_WrT = O_xcbuf + al256((size_t)TC * D * 4);
constexpr size_t O_hx = O_WrT + al256((size_t)2 * 2 * 48 * 1024 * 2);
constexpr size_t O_mix = O_hx + al256((size_t)TA * D * 2);
constexpr size_t O_regB = O_mix + al256((size_t)TA * D * 2);
constexpr size_t O_q = O_regB;
constexpr size_t O_kall = O_q + al256((size_t)TA * 512 * 2);
constexpr size_t O_vT = O_kall + al256((size_t)NB_ * KV * 512 * 2);
constexpr size_t O_QF = O_vT + al256((size_t)NB_ * 4 * 128 * KV * 2);
constexpr size_t O_gy = O_QF + al256((size_t)TA * 512 * 2);
constexpr size_t O_rr = O_gy + al256((size_t)TA * 256 * 2);
constexpr size_t O_lsum = O_rr + al256((size_t)TA * 256 * 2);
constexpr size_t O_lcar = O_lsum + al256((size_t)16 * 132 * 256 * 8);
constexpr size_t O_GA = O_lcar + al256((size_t)16 * 132 * 256 * 4);
constexpr size_t O_mixer_end = O_GA + al256((size_t)NB_ * 64 * 256 * 256 * 2);
constexpr size_t O_H = O_regB;
constexpr size_t O_yA = O_H + al256((size_t)(2 * TA + 32 * 256) * 512 * 2);
constexpr size_t O_moe_end = O_yA + al256((size_t)2 * TA * D * 2);
constexpr size_t WS_NEED = O_mixer_end > O_moe_end ? O_mixer_end : O_moe_end;
DI void bind_ws(Params& P) {
  char* w = P.ws;
  P.WtIn = (half_t*)(w + O_WtIn); P.WtOut = (half_t*)(w + O_WtOut); P.Wt1 = (half_t*)(w + O_Wt1); P.Wt3 = (half_t*)(w + O_Wt3); P.Wt2 = (half_t*)(w + O_Wt2);
  P.mod = (float*)(w + O_mod); P.rope = (float2*)(w + O_rope); P.tw = (float2*)(w + O_tw); P.DA = (half_t*)(w + O_DA); P.DB = (half_t*)(w + O_DB); P.DC = (half_t*)(w + O_DC);
  P.consts = (float*)(w + O_consts); P.cnt = (int*)(w + O_cnt); P.qctr = (int*)(w + O_qctr); P.tokW = (float*)(w + O_tokW); P.list = (int*)(w + O_list); P.listW = (float*)(w + O_listW);
  P.xcbuf = (float*)(w + O_xcbuf); P.WrH = (half_t*)(w + O_WrT); P.hx = (half_t*)(w + O_hx); P.mix = (half_t*)(w + O_mix);
  P.q = (half_t*)(w + O_q); P.kall = (half_t*)(w + O_kall); P.vT = (half_t*)(w + O_vT); P.QF = (half_t*)(w + O_QF); P.gy = (half_t*)(w + O_gy); P.rr = (half_t*)(w + O_rr);
  P.lsum = (float2*)(w + O_lsum); P.lcar = (float*)(w + O_lcar); P.GA = (half_t*)(w + O_GA); P.H = (half_t*)(w + O_H); P.yA = (half_t*)(w + O_yA);
}
DI float shx(float v, int o) { int ln = TIDX & 63; return __builtin_bit_cast(float, __builtin_amdgcn_ds_bpermute((ln ^ o) << 2, __builtin_bit_cast(int, v))); }
DI float shi(float v, int idx) { return __builtin_bit_cast(float, __builtin_amdgcn_ds_bpermute(idx << 2, __builtin_bit_cast(int, v))); }
DI float wave_sum(float v) {
#pragma unroll
  for (int o = 32; o; o >>= 1) v += shx(v, o);
  return v;
}
DI void glds16(const void* g, void* l) {
  __builtin_amdgcn_global_load_lds((const unsigned*)g, (unsigned*)l, 16, 0, 0);
}
DI void wait_vm0() { asm volatile("s_waitcnt vmcnt(0)" ::: "memory"); }
DI f4 mfma16(h8 a, h8 b, f4 c) { return __builtin_amdgcn_mfma_f32_16x16x32_f16(a, b, c, 0, 0, 0); }
DI f16v mfma32(h8 a, h8 b, f16v c) { return __builtin_amdgcn_mfma_f32_32x32x16_f16(a, b, c, 0, 0, 0); }
DI unsigned pk2(float a, float b) { fp16x2 r = __builtin_amdgcn_cvt_pkrtz(a, b); return __builtin_bit_cast(unsigned, r); }
DI float sigmoidf_(float x) { return 1.f / (1.f + __expf(-x)); }
DI float gelu_tanh(float x) {
  float u = 0.7978845608028654f * (x + 0.044715f * x * x * x);
  float e = __expf(2.f * u);
  float t = 1.f - 2.f / (e + 1.f);
  return 0.5f * x * (1.f + t);
}
DI int row_mod(int r) { return r < TC ? 8 : ((r - TC) >> 13); }

DI void transpose_tile4(const float* src, int lds_, half_t* dst, int ldd, float* tile) {
  const int tid = TIDX;
  {
    const int k0 = tid >> 6, c4 = tid & 63;
    const float* sp = src + (size_t)k0 * lds_ + c4 * 4;
    float* tp = tile + (c4 >> 4) * 4352 + k0 * 68 + (c4 & 15) * 4;
#pragma unroll
    for (int i = 0; i < 16; i++) *(float4*)(tp + i * 4 * 68) = *(const float4*)(sp + (size_t)i * 4 * lds_);
  }
  __syncthreads();
#pragma unroll
  for (int i = 0; i < 8; i++) {
    int idx = i * 256 + tid, j = idx >> 9, r = idx & 511, kc = r >> 6, n = r & 63;
    const float* t = tile + j * 4352 + kc * 8 * 68 + n;
    h8 o;
#pragma unroll
    for (int u = 0; u < 8; u++) o[u] = (half_t)t[u * 68];
    *(h8*)(dst + (size_t)(j * 64 + n) * ldd + kc * 8) = o;
  }
  __syncthreads();
}

DI void phase0(const Params& P, char* smem) {
  float* tile = (float*)smem;
  const int tid = TIDX;
  constexpr int NT = 6528, NF = 128, NM = 192, NX = 6;
  for (int t0 = blockIdx.x; t0 < NT + NF + NM + NX; t0 += gridDim.x) {
    const int t = t0 < NF + NM + NX ? NT + t0 : t0 - (NF + NM + NX);
    if (t < NT) {
      const float* src; half_t* dst; int lds_, ldd;
      if (t < 256) {
        int l = t / 128, r = t % 128, kt = r / 8, nt = (r % 8) * 4;
        src = P.w_in + (size_t)l * 1024 * 2304 + (size_t)kt * 64 * 2304 + 256 + nt * 64; lds_ = 2304;
        dst = P.WtIn + (size_t)l * NIN * 1024 + (size_t)(512 + nt * 64) * 1024 + kt * 64; ldd = 1024;
      } else if (t < 384) {
        int u = t - 256, l = u / 64, r = u % 64, kt = r / 4, nt = (r % 4) * 4;
        src = P.w_out + (size_t)l * 1048576 + (size_t)kt * 64 * 1024 + nt * 64; lds_ = 1024;
        dst = P.WtOut + (size_t)l * 1048576 + (size_t)nt * 64 * 1024 + kt * 64; ldd = 1024;
      } else if (t < 384 + 4096) {
        int u = t - 384; const float* w = P.w1; half_t* o = P.Wt1;
        if (u >= 2048) { u -= 2048; w = P.w3; o = P.Wt3; }
        int le = u / 32, r = u % 32, kt = r / 2, nt = (r % 2) * 4;
        src = w + (size_t)le * 524288 + (size_t)kt * 64 * 512 + nt * 64; lds_ = 512;
        dst = o + (size_t)le * 524288 + (size_t)nt * 64 * 1024 + kt * 64; ldd = 1024;
      } else {
        int u = t - 384 - 4096, le = u / 32, r = u % 32, kt = r / 4, nt = (r % 4) * 4;
        src = P.w2 + (size_t)le * 524288 + (size_t)kt * 64 * 1024 + nt * 64; lds_ = 1024;
        dst = P.Wt2 + (size_t)le * 524288 + (size_t)nt * 64 * 512 + kt * 64; ldd = 512;
      }
      transpose_tile4(src, lds_, dst, ldd, tile);
    } else if (t < NT + NF) {
      int f = t - NT, l = f / 64, r = f % 64, kt = r / 4, g = r % 4;
      float* cst = tile + 64 * 65; float* snt = cst + 64;
      const float* src = P.w_in + (size_t)l * 1024 * 2304 + (size_t)kt * 64 * 2304 + g * 64;
      { int n = tid & 63, kq = tid >> 6;
        for (int i = 0; i < 16; i++) { int k = i * 4 + kq; tile[k * 65 + n] = src[(size_t)k * 2304 + n]; } }
      if (tid < 64) { float s, c; sincospif((float)tid / 32.f, &s, &c); cst[tid] = c; snt[tid] = s; }
      __syncthreads();
      int k = tid & 63, jq = tid >> 6;
      half_t* o = P.WtIn + (size_t)l * NIN * 1024 + kt * 64 + k;
      for (int jj = 0; jj < 16; jj++) {
        int j = jq * 16 + jj; float ac = 0.f, as = 0.f;
        for (int c = 0; c < 64; c++) { float v = tile[k * 65 + c]; int idx = (c * j) & 63; ac += v * cst[idx]; as += v * snt[idx]; }
        o[(size_t)(g * 64 + j) * 1024] = (half_t)(ac * 0.125f);
        o[(size_t)(256 + g * 64 + j) * 1024] = (half_t)(-as * 0.125f);
      }
      __syncthreads();
    } else if (t < NT + NF + NM) {
      int mi = t - NT - NF, l = mi / 96, col0 = (mi % 96) * 64;
      float* scond = tile; float* red = tile + 9216;
      for (int idx = tid; idx < 9216; idx += 256) {
        int n = idx >> 10, k = idx & 1023; float v = n < 8 ? P.c[n * 1024 + k] : P.c_ctx[k];
        scond[idx] = v / (1.f + expf(-v));
      }
      __syncthreads();
      int col = tid & 63, kq = tid >> 6; float acc[9];
#pragma unroll
      for (int n = 0; n < 9; n++) acc[n] = 0.f;
      const float* w = P.w_mod + ((size_t)l * 1024 + kq * 256) * 6144 + col0 + col;
#pragma unroll 16
      for (int k = 0; k < 256; k++) {
        float wv = w[(size_t)k * 6144];
#pragma unroll
        for (int n = 0; n < 9; n++) acc[n] += scond[n * 1024 + kq * 256 + k] * wv;
      }
#pragma unroll
      for (int n = 0; n < 9; n++) red[(kq * 9 + n) * 64 + col] = acc[n];
      __syncthreads();
      for (int idx = tid; idx < 576; idx += 256) {
        int n = idx / 64, cc = idx % 64;
        float s = red[(0 * 9 + n) * 64 + cc] + red[(1 * 9 + n) * 64 + cc] + red[(2 * 9 + n) * 64 + cc] + red[(3 * 9 + n) * 64 + cc];
        P.mod[(size_t)(l * 9 + n) * 6144 + col0 + cc] = s + P.b_mod[l * 6144 + col0 + cc];
      }
      __syncthreads();
    } else {
      int m = t - NT - NF - NM;
      if (m == 0) {
        for (int idx = tid; idx < 128 * 16; idx += 256) {
          int pos = idx >> 4, i = idx & 15; float f = powf(10000.f, -(float)i / 16.f); float ang = (float)pos * f;
          float s, c; sincosf(ang, &s, &c); P.rope[idx] = make_float2(c, s);
        }
      } else if (m == 1) {
        for (int j = tid; j < 8192; j += 256) { float s, c; sincospif((float)j / 4096.f, &s, &c); P.tw[j] = make_float2(c, s); }
      } else if (m == 2) {
        for (int idx = tid; idx < 16384; idx += 256) {
          int mm = idx >> 7, k = idx & 127, part = mm >> 6, f1 = mm & 63, pp = k >> 6, a = k & 63;
          float s, c; sincospif((float)((a * f1) & 63) / 32.f, &s, &c);
          float v = part == 0 ? (pp == 0 ? c : s) : (pp == 0 ? -s : c);
          P.DA[idx] = (half_t)(v * 0.125f);
        }
      } else if (m == 3) {
        for (int idx = tid; idx < 32768; idx += 256) {
          int mm = idx >> 8, k = idx & 255, part = k >> 7, bb = k & 127;
          float s, c; sincospif((float)((bb * mm) & 127) / 64.f, &s, &c);
          P.DB[idx] = (half_t)((part == 0 ? c : s) * 0.08838834764831845f);
        }
      } else if (m == 4) {
        for (int idx = tid; idx < 131072; idx += 256) {
          int mm = idx >> 9, k = idx & 511, part = k >> 8, tt = k & 255;
          float s, c; sincospif((float)((tt * mm) & 255) / 128.f, &s, &c);
          P.DC[idx] = (half_t)((part == 0 ? c : s) * 0.0625f);
        }
      } else {
        for (int idx = tid; idx < 2 * 48 * 1024; idx += 256) {
          int l = idx / 49152, r = idx % 49152, col = r >> 10, k = r & 1023;
          float w = col < 4 ? P.w_group[((size_t)l * 1024 + k) * 4 + col] : (col < 36 ? P.w_router[((size_t)l * 1024 + k) * 32 + col - 4] : 0.f);
          half_t hi = (half_t)w, lo = (half_t)(w - (float)hi);
          P.WrH[(size_t)(l * 2) * 49152 + r] = hi; P.WrH[(size_t)(l * 2 + 1) * 49152 + r] = lo;
        }
        if (tid < 2) {
          int l = tid; float s1 = 0.f, s2 = 0.f, mq = 0.f, mk = 0.f;
          for (int i = 0; i < 64; i++) {
            s1 += P.lq1[l * 64 + i] * P.lk1[l * 64 + i]; s2 += P.lq2[l * 64 + i] * P.lk2[l * 64 + i];
            mq = fmaxf(mq, fabsf(P.q_norm_g[l * 64 + i])); mk = fmaxf(mk, fabsf(P.k_norm_g[l * 64 + i]));
          }
          float lam_init = 0.8f - 0.6f * expf(-0.3f * (float)l);
          P.consts[l * 4 + 0] = expf(s1) - expf(s2) + lam_init;
          P.consts[l * 4 + 1] = 8.f * mq * mk * 1.4426950408889634f * 1.002f - 15.f;
          P.consts[l * 4 + 2] = lam_init;
        }
        if (tid < 64) P.cnt[tid] = 0;
        if (tid < 64) P.qctr[tid] = 0;
      }
    }
  }
}

DI void row1_phase(const Params& P, int combine_l, int norm_l, int r_begin) {
  const int lane = TIDX & 63, gw = blockIdx.x * 4 + (TIDX >> 6), nw = gridDim.x * 4;
  auto load_row = [&](int r, float4 (&xv)[4], h4 (&ya)[4], h4 (&yb)[4]) {
    if (combine_l < 0) {
      const float* src = r < TC ? P.ctx + (size_t)r * D : P.x + (size_t)(r - TC) * D;
#pragma unroll
      for (int i = 0; i < 4; i++) xv[i] = *(const float4*)(src + i * 256 + lane * 4);
    } else {
      const float* xm = r < TC ? P.xcbuf + (size_t)r * D : P.out + (size_t)(r - TC) * D;
      const half_t* y0 = P.yA + (size_t)(2 * r) * D; const half_t* y1 = y0 + D;
#pragma unroll
      for (int i = 0; i < 4; i++) { int c = i * 256 + lane * 4; xv[i] = *(const float4*)(xm + c); ya[i] = *(const h4*)(y0 + c); yb[i] = *(const h4*)(y1 + c); }
    }
  };
  auto process = [&](int r, float4 (&xv)[4], h4 (&ya)[4], h4 (&yb)[4]) {
    const int n = row_mod(r);
    if (combine_l >= 0) {
      float* xm = r < TC ? P.xcbuf + (size_t)r * D : P.out + (size_t)(r - TC) * D;
      const float* g2 = P.mod + (size_t)(combine_l * 9 + n) * 6144 + 5 * 1024;
#pragma unroll
      for (int i = 0; i < 4; i++) {
        int c = i * 256 + lane * 4;
        float4 g = *(const float4*)(g2 + c); float4 t = xv[i];
        t.x += g.x * ((float)ya[i][0] + (float)yb[i][0]); t.y += g.y * ((float)ya[i][1] + (float)yb[i][1]);
        t.z += g.z * ((float)ya[i][2] + (float)yb[i][2]); t.w += g.w * ((float)ya[i][3] + (float)yb[i][3]);
        *(float4*)(xm + c) = t; xv[i] = t;
      }
    }
    if (norm_l >= 0) {
      float ss = 0.f;
#pragma unroll
      for (int i = 0; i < 4; i++) ss += xv[i].x * xv[i].x + xv[i].y * xv[i].y + xv[i].z * xv[i].z + xv[i].w * xv[i].w;
      ss = wave_sum(ss);
      const float rstd = rsqrtf(ss * (1.f / 1024.f) + EPS);
      const float* g = P.norm1_g + norm_l * 1024;
      const float* sh = P.mod + (size_t)(norm_l * 9 + n) * 6144; const float* sc = sh + 1024;
#pragma unroll
      for (int i = 0; i < 4; i++) {
        int c = i * 256 + lane * 4;
        float4 gg = *(const float4*)(g + c), s1 = *(const float4*)(sc + c), s0 = *(const float4*)(sh + c);
        h4 o;
        o[0] = (half_t)(xv[i].x * rstd * gg.x * (1.f + s1.x) + s0.x); o[1] = (half_t)(xv[i].y * rstd * gg.y * (1.f + s1.y) + s0.y);
        o[2] = (half_t)(xv[i].z * rstd * gg.z * (1.f + s1.z) + s0.z); o[3] = (half_t)(xv[i].w * rstd * gg.w * (1.f + s1.w) + s0.w);
        *(h4*)(P.hx + (size_t)r * D + c) = o;
      }
    }
  };
  const int nrows = TA - r_begin;
  const int r_lo = r_begin + (int)(((long long)gw * nrows) / nw), r_hi = r_begin + (int)(((long long)(gw + 1) * nrows) / nw);
#pragma unroll 1
  for (int r = r_lo; r < r_hi; r += 4) {
    float4 x0[4], x1[4], x2[4], x3[4]; h4 a0[4], b0[4], a1[4], b1[4], a2[4], b2[4], a3[4], b3[4];
    const int r1 = r + 1, r2 = r + 2, r3 = r + 3;
    load_row(r, x0, a0, b0);
    if (r1 < r_hi) load_row(r1, x1, a1, b1);
    if (r2 < r_hi) load_row(r2, x2, a2, b2);
    if (r3 < r_hi) load_row(r3, x3, a3, b3);
    process(r, x0, a0, b0);
    if (r1 < r_hi) process(r1, x1, a1, b1);
    if (r2 < r_hi) process(r2, x2, a2, b2);
    if (r3 < r_hi) process(r3, x3, a3, b3);
  }
}

DI void row2_phase(const Params& P, int l, int r_begin, char* smem) {
  const int tid = TIDX, lane = tid & 63, wave = tid >> 6, fr = lane & 15, fq = lane >> 4;
  float* lg = (float*)smem + wave * 16 * 48;
  const half_t* Whi = P.WrH + (size_t)(l * 2) * 49152; const half_t* Wlo = Whi + 49152;
  const int ngroups = (TA - r_begin) >> 4, gw = blockIdx.x * 4 + wave, nw = gridDim.x * 4;
  const float* gam = P.norm2_g + l * 1024;
  const int gper = (ngroups + nw - 1) / nw;
#pragma unroll 1
  for (int grp = gw * gper; grp < min((gw + 1) * gper, ngroups); grp++) {
    const int r0 = r_begin + grp * 16, row = r0 + fr, n = row_mod(r0);
    const float* xm = (row < TC ? P.xcbuf + (size_t)row * D : P.out + (size_t)(row - TC) * D) + fq * 8;
    float ss = 0.f;
#pragma unroll 16
    for (int kk = 0; kk < 32; kk++) {
      const float4 a = *(const float4*)(xm + kk * 32), b = *(const float4*)(xm + kk * 32 + 4);
      ss += a.x * a.x + a.y * a.y + a.z * a.z + a.w * a.w + b.x * b.x + b.y * b.y + b.z * b.z + b.w * b.w;
    }
    ss += shx(ss, 16); ss += shx(ss, 32);
    const float rstd = rsqrtf(ss * (1.f / 1024.f) + EPS);
    const float* sh = P.mod + (size_t)(l * 9 + n) * 6144 + 3 * 1024 + fq * 8; const float* sc = sh + 1024;
    f4 acc[3];
#pragma unroll
    for (int i = 0; i < 3; i++) acc[i] = (f4){0.f, 0.f, 0.f, 0.f};
    half_t* hxo = P.hx + (size_t)row * D + fq * 8;
#pragma unroll 4
    for (int kk = 0; kk < 32; kk++) {
      const int k0 = kk * 32;
      float x[8], g[8], s1[8], s0[8];
      *(float4*)&x[0] = *(const float4*)(xm + k0); *(float4*)&x[4] = *(const float4*)(xm + k0 + 4);
      *(float4*)&g[0] = *(const float4*)(gam + fq * 8 + k0); *(float4*)&g[4] = *(const float4*)(gam + fq * 8 + k0 + 4);
      *(float4*)&s1[0] = *(const float4*)(sc + k0); *(float4*)&s1[4] = *(const float4*)(sc + k0 + 4);
      *(float4*)&s0[0] = *(const float4*)(sh + k0); *(float4*)&s0[4] = *(const float4*)(sh + k0 + 4);
      h8 hi, lo;
#pragma unroll
      for (int i = 0; i < 8; i++) {
        float v = x[i] * rstd * g[i] * (1.f + s1[i]) + s0[i];
        hi[i] = (half_t)v; lo[i] = (half_t)(v - (float)hi[i]);
      }
      *(h8*)(hxo + k0) = hi;
#pragma unroll
      for (int n3 = 0; n3 < 3; n3++) {
        h8 bh = *(const h8*)(Whi + (size_t)(n3 * 16 + fr) * 1024 + k0 + fq * 8);
        h8 bl = *(const h8*)(Wlo + (size_t)(n3 * 16 + fr) * 1024 + k0 + fq * 8);
        acc[n3] = mfma16(hi, bh, acc[n3]); acc[n3] = mfma16(lo, bh, acc[n3]); acc[n3] = mfma16(hi, bl, acc[n3]);
      }
    }
    __builtin_amdgcn_wave_barrier();
#pragma unroll
    for (int n3 = 0; n3 < 3; n3++)
#pragma unroll
      for (int j = 0; j < 4; j++) lg[(fq * 4 + j) * 48 + n3 * 16 + fr] = acc[n3][j];
    __builtin_amdgcn_wave_barrier();
    if (lane < 16) {
      const int r = r0 + lane;
      const float* L = lg + lane * 48;
      float gl[4]; int gi = 0;
#pragma unroll
      for (int j = 0; j < 4; j++) gl[j] = L[j] + P.b_group[l * 4 + j];
      float gm = gl[0];
#pragma unroll
      for (int j = 1; j < 4; j++) if (gl[j] > gm) { gm = gl[j]; gi = j; }
      float gs = 0.f;
#pragma unroll
      for (int j = 0; j < 4; j++) gs += expf(gl[j] - gm);
      const float pg = 1.f / gs;
      float el[8];
#pragma unroll
      for (int j = 0; j < 8; j++) el[j] = L[4 + gi * 8 + j] + P.b_router[l * 32 + gi * 8 + j];
      int i0 = 0; float v0 = el[0];
#pragma unroll
      for (int j = 1; j < 8; j++) if (el[j] > v0) { v0 = el[j]; i0 = j; }
      int i1 = -1; float v1 = -3.0e38f;
#pragma unroll
      for (int j = 0; j < 8; j++) if (j != i0 && el[j] > v1) { v1 = el[j]; i1 = j; }
      const float ex = expf(v1 - v0);
      const float w0 = pg / (1.f + ex), w1 = pg * ex / (1.f + ex);
      const int e0 = gi * 8 + i0, e1 = gi * 8 + i1;
      int p0 = atomicAdd(&P.cnt[l * 32 + e0], 1); P.list[(size_t)e0 * LCAP + p0] = 2 * r; P.listW[(size_t)e0 * LCAP + p0] = w0;
      int p1 = atomicAdd(&P.cnt[l * 32 + e1], 1); P.list[(size_t)e1 * LCAP + p1] = 2 * r + 1; P.listW[(size_t)e1 * LCAP + p1] = w1;
    }
    __builtin_amdgcn_wave_barrier();
  }
}

DI h8 lds128(unsigned a) { h8 r; asm volatile("ds_read_b128 %0, %1" : "=v"(r) : "v"(a)); return r; }
DI void tie(h8& x) { asm volatile("" : "+v"(x)); }
DI unsigned lds_addr(const void* p) { return (unsigned)(size_t)p; }
#define WAIT_LGKM(n) asm volatile("s_waitcnt lgkmcnt(" #n ")" ::: "memory")
DI void raw_barrier() { asm volatile("" ::: "memory"); __builtin_amdgcn_s_barrier(); asm volatile("" ::: "memory"); }
DI void slot_rc(int i, int& row, int& coff) { int s = i * 256 + TIDX; row = s >> 3; coff = ((s & 7) ^ ((row >> 1) & 7)) * 8; }

template <class AF, class BF>
DI void gemm_prologue(AF aptr, BF bptr, int nk, char* smem) {
  const int tid = TIDX;
#pragma unroll
  for (int st = 0; st < 2; st++) {
    if (st < nk) {
      char* d = smem + st * 49152 + tid * 16;
#pragma unroll
      for (int i = 0; i < 8; i++) glds16(aptr(i) + st * 64, d + i * 4096);
#pragma unroll
      for (int i = 0; i < 4; i++) glds16(bptr(i) + st * 64, d + 32768 + i * 4096);
    }
  }
}
template <bool PRE = false, class AF, class BF>
DI void gemm256(AF aptr, BF bptr, int nk, char* smem, f4 (&acc)[8][4]) {
  const int tid = TIDX, lane = tid & 63, wave = tid >> 6, fr = lane & 15, fq = lane >> 4, wr = wave >> 1, wc = wave & 1;
#pragma unroll
  for (int m = 0; m < 8; m++)
#pragma unroll
    for (int n = 0; n < 4; n++) acc[m][n] = (f4){0.f, 0.f, 0.f, 0.f};
  auto issue = [&](int kt, int st) {
    char* d = smem + st * 49152 + tid * 16;
#pragma unroll
    for (int i = 0; i < 8; i++) glds16(aptr(i) + kt * 64, d + i * 4096);
#pragma unroll
    for (int i = 0; i < 4; i++) glds16(bptr(i) + kt * 64, d + 32768 + i * 4096);
  };
  const unsigned sw = (unsigned)((fq ^ (fr >> 1)) << 4);
  const unsigned offA = (wr * 128 + fr) * 128 + sw, offB = 32768 + (wc * 64 + fr) * 128 + sw;
  const unsigned sbase = lds_addr(smem);
  if (!PRE) { issue(0, 0); if (nk > 1) issue(1, 1); }
  int st = 0;
#pragma unroll 1
  for (int kt = 0; kt < nk; kt++) {
    if (kt + 1 < nk) asm volatile("s_waitcnt vmcnt(12)" ::: "memory"); else wait_vm0();
    raw_barrier();
    if (kt + 2 < nk) issue(kt + 2, st == 0 ? 2 : st - 1);
    const unsigned base = sbase + st * 49152;
    st = st == 2 ? 0 : st + 1;
    h8 a0[8], b0[4], a1[8], b1[4];
#pragma unroll
    for (int m = 0; m < 8; m++) a0[m] = lds128(base + offA + m * 2048);
#pragma unroll
    for (int n = 0; n < 4; n++) b0[n] = lds128(base + offB + n * 2048);
#pragma unroll
    for (int m = 0; m < 8; m++) a1[m] = lds128(base + (offA ^ 64) + m * 2048);
#pragma unroll
    for (int n = 0; n < 4; n++) b1[n] = lds128(base + (offB ^ 64) + n * 2048);
    WAIT_LGKM(12);
#pragma unroll
    for (int m = 0; m < 8; m++) tie(a0[m]);
#pragma unroll
    for (int n = 0; n < 4; n++) tie(b0[n]);
#pragma unroll
    for (int m = 0; m < 8; m++)
#pragma unroll
      for (int n = 0; n < 4; n++) acc[m][n] = mfma16(a0[m], b0[n], acc[m][n]);
    WAIT_LGKM(0);
#pragma unroll
    for (int m = 0; m < 8; m++) tie(a1[m]);
#pragma unroll
    for (int n = 0; n < 4; n++) tie(b1[n]);
#pragma unroll
    for (int m = 0; m < 8; m++)
#pragma unroll
      for (int n = 0; n < 4; n++) acc[m][n] = mfma16(a1[m], b1[n], acc[m][n]);
  }
  raw_barrier();
}
DI bool xcd_tile(int it, int MT, int NT, int& mt, int& nt) {
  const int x = blockIdx.x & 7, j = blockIdx.x >> 3;
  const int nsn = NT >> 2, nsm = (MT + 7) >> 3;
  const int s = x + 8 * it;
  if (s >= nsm * nsn) return false;
  const int sm = s / nsn, sn = s % nsn;
  mt = sm * 8 + (j >> 2); nt = sn * 4 + (j & 3);
  return true;
}
DI bool next_tile(int& it, int MT, int NT, int& mt, int& nt) {
  for (;; it++) {
    if (!xcd_tile(it, MT, NT, mt, nt)) return false;
    if (mt < MT) return true;
  }
}
DI int slot_col() { int t = TIDX; return ((t & 7) ^ ((t >> 4) & 7)) * 8; }

DI float dpp_row_sum(float v) {
  v += __builtin_bit_cast(float, __builtin_amdgcn_update_dpp(0, __builtin_bit_cast(int, v), 0x128, 0xf, 0xf, false));
  v += __builtin_bit_cast(float, __builtin_amdgcn_update_dpp(0, __builtin_bit_cast(int, v), 0x124, 0xf, 0xf, false));
  v += __builtin_bit_cast(float, __builtin_amdgcn_update_dpp(0, __builtin_bit_cast(int, v), 0x122, 0xf, 0xf, false));
  v += __builtin_bit_cast(float, __builtin_amdgcn_update_dpp(0, __builtin_bit_cast(int, v), 0x121, 0xf, 0xf, false));
  return v;
}
DI void stage_put(char* stg, int ml, int n, int j, int fr, int fq, float v) { *(half_t*)(stg + (ml * 16 + fq * 4 + j) * 144 + (n * 16 + fr) * 2) = (half_t)v; }
template <class RP, class SC>
DI void stage_flush(char* stg, int h, RP rowptr, SC rowscale) {
  const int lane = TIDX & 63;
  __builtin_amdgcn_wave_barrier();
#pragma unroll
  for (int i = 0; i < 8; i++) {
    const int c = i * 64 + lane, row = c >> 3, c16 = c & 7;
    h8 v = *(const h8*)(stg + row * 144 + c16 * 16);
    half_t* d = rowptr(h * 64 + row);
    if (d) { rowscale(h * 64 + row, v); *(h8*)(d + c16 * 8) = v; }
  }
  __builtin_amdgcn_wave_barrier();
}
template <class VF, class RP, class SC>
DI void wave_store_tile(VF val, char* stg, RP rowptr, SC rowscale) {
  const int lane = TIDX & 63, fr = lane & 15, fq = lane >> 4;
#pragma unroll
  for (int h = 0; h < 2; h++) {
#pragma unroll
    for (int ml = 0; ml < 4; ml++)
#pragma unroll
      for (int n = 0; n < 4; n++)
#pragma unroll
        for (int j = 0; j < 4; j++) stage_put(stg, ml, n, j, fr, fq, val(h * 4 + ml, n, j));
    stage_flush(stg, h, rowptr, rowscale);
  }
}
DI void gemm_in_phase(const Params& P, int l, char* smem) {
  const int tid = TIDX;
  const half_t* Wt = P.WtIn + (size_t)l * NIN * 1024;
  const int sc = slot_col(), srow = tid >> 3;
  {
    float2* rcl = (float2*)(smem + 147456);
    for (int i = tid; i < 1024; i += 256) rcl[i] = P.rope[i];
    __syncthreads();
  }
  int it = 0, mt, nt;
  bool have = next_tile(it, 264, 20, mt, nt);
  const half_t* a0 = nullptr; const half_t* b0 = nullptr;
  if (have) {
    asm volatile("" : "+s"(mt), "+s"(nt));
    a0 = P.hx + (size_t)(mt * 256 + srow) * D + sc; b0 = Wt + (size_t)(nt * 128 + srow) * D + sc;
    gemm_prologue([&](int i) { return a0 + (size_t)i * 32 * D; }, [&](int i) { return b0 + (size_t)i * 32 * D; }, 16, smem);
  }
#pragma unroll 1
  while (have) {
    f4 acc[8][4];
    gemm256<true>([&](int i) { return a0 + (size_t)i * 32 * D; }, [&](int i) { return b0 + (size_t)i * 32 * D; }, 16, smem, acc);
    const int tid2 = TIDX, lane = tid2 & 63, wave = tid2 >> 6, fr = lane & 15, fq = lane >> 4, wr = wave >> 1, wc = wave & 1;
    const int r0 = mt * 256 + wr * 128;
    const bool isctx = r0 < TC;
    int b, pos0;
    if (isctx) { b = r0 >> 8; pos0 = r0 & 255; } else { b = (r0 - TC) >> 13; pos0 = 256 + ((r0 - TC) & 8191); }
    const bool isqk = nt >= 4 && nt < 12;
    float gg[4] = {0.f, 0.f, 0.f, 0.f}; float2 rr2[2] = {make_float2(1.f, 0.f), make_float2(1.f, 0.f)};
    if (isqk) {
      const float* gvec = (nt < 8 ? P.q_norm_g : P.k_norm_g) + l * 64;
      const float qs = nt < 8 ? 0.125f * 1.4426950408889634f : 1.f;
#pragma unroll
      for (int n = 0; n < 4; n++) gg[n] = gvec[n * 16 + fr] * qs;
      if (!isctx) { const int tp0 = pos0 - 256; rr2[0] = P.rope[(tp0 >> 6) * 16 + fr]; rr2[1] = P.rope[((tp0 >> 6) + 1) * 16 + fr]; }
    }
#pragma unroll
    for (int n = 0; n < 4; n++) asm volatile("" : "+v"(gg[n]));
    asm volatile("" : "+v"(rr2[0].x), "+v"(rr2[0].y), "+v"(rr2[1].x), "+v"(rr2[1].y));
    int it2 = it + 1, mt2, nt2;
    const bool have2 = next_tile(it2, 264, 20, mt2, nt2);
    const half_t* a1 = a0; const half_t* b1 = b0;
    if (have2) {
      asm volatile("" : "+s"(mt2), "+s"(nt2));
      a1 = P.hx + (size_t)(mt2 * 256 + srow) * D + sc; b1 = Wt + (size_t)(nt2 * 128 + srow) * D + sc;
      gemm_prologue([&](int i) { return a1 + (size_t)i * 32 * D; }, [&](int i) { return b1 + (size_t)i * 32 * D; }, 16, smem);
    }
    char* stg = smem + 98304 + wave * 12288;
    auto noscale = [](int, h8&) {};
    if (nt < 4 || nt >= 16) {
      half_t* dst; int ld, c0; bool gel = false;
      if (nt < 4) { dst = P.QF; ld = 512; c0 = nt * 128; }
      else if (nt < 18) { dst = P.gy; ld = 256; c0 = (nt - 16) * 128; gel = true; }
      else { dst = P.rr; ld = 256; c0 = (nt - 18) * 128; }
      half_t* base = dst + (size_t)r0 * ld + c0 + wc * 64;
      if (gel) wave_store_tile([&](int m, int n, int j) { return gelu_tanh(acc[m][n][j]); }, stg, [&](int r) { return base + (size_t)r * ld; }, noscale);
      else wave_store_tile([&](int m, int n, int j) { return acc[m][n][j]; }, stg, [&](int r) { return base + (size_t)r * ld; }, noscale);
    } else if (nt < 12) {
      const bool isq = nt < 8; const int head = isq ? nt - 4 : nt - 8;
      const float2* rcl = (const float2*)(smem + 147456);
      half_t* base = (isq ? P.q + (size_t)r0 * 512 : P.kall + ((size_t)b * KV + pos0) * 512) + head * 128 + wc * 64;
#pragma unroll
      for (int mh = 0; mh < 2; mh++) {
#pragma unroll
        for (int mm = 0; mm < 4; mm++) {
          const int m = mh * 4 + mm;
#pragma unroll
          for (int j = 0; j < 4; j++) {
            float ss = 0.f;
#pragma unroll
            for (int n = 0; n < 4; n++) ss += acc[m][n][j] * acc[m][n][j];
            ss = dpp_row_sum(ss);
            const float rstd = rsqrtf(ss * (1.f / 64.f) + EPS);
            float o[4];
#pragma unroll
            for (int n = 0; n < 4; n++) o[n] = acc[m][n][j] * rstd * gg[n];
            if (!isctx) {
              const float2 cr = rr2[mh], cc = rcl[(mm * 16 + fq * 4 + j) * 16 + fr];
              float a0 = o[0] * cr.x - o[1] * cr.y, a1 = o[1] * cr.x + o[0] * cr.y;
              float a2 = o[2] * cc.x - o[3] * cc.y, a3 = o[3] * cc.x + o[2] * cc.y;
              o[0] = a0; o[1] = a1; o[2] = a2; o[3] = a3;
            }
#pragma unroll
            for (int n = 0; n < 4; n++) stage_put(stg, mm, n, j, fr, fq, o[n]);
          }
        }
        stage_flush(stg, mh, [&](int r) { return base + (size_t)r * 512; }, noscale);
      }
    } else {
      const int head = nt - 12;
      half_t* vbase = P.vT + ((size_t)(b * 4 + head) * 128 + wc * 64) * KV + pos0;
#pragma unroll
      for (int h = 0; h < 2; h++) {
#pragma unroll
        for (int ml = 0; ml < 4; ml++)
#pragma unroll
          for (int n = 0; n < 4; n++) {
            h4 o; o[0] = (half_t)acc[h * 4 + ml][n][0]; o[1] = (half_t)acc[h * 4 + ml][n][1]; o[2] = (half_t)acc[h * 4 + ml][n][2]; o[3] = (half_t)acc[h * 4 + ml][n][3];
            *(h4*)(stg + (n * 16 + fr) * 144 + (ml * 16 + fq * 4) * 2) = o;
          }
        __builtin_amdgcn_wave_barrier();
#pragma unroll
        for (int i = 0; i < 8; i++) {
          const int c = i * 64 + lane, drow = c >> 3, c16 = c & 7;
          h8 v = *(const h8*)(stg + drow * 144 + c16 * 16);
          *(h8*)(vbase + (size_t)drow * KV + h * 64 + c16 * 8) = v;
        }
        __builtin_amdgcn_wave_barrier();
      }
    }
    mt = mt2; nt = nt2; it = it2; have = have2; a0 = a1; b0 = b1;
  }
}

DI void gemm_out_phase(const Params& P, int l, char* smem) {
  const int tid = TIDX;
  const half_t* Wt = P.WtOut + (size_t)l * 1048576;
  const int mt0 = l == 0 ? 0 : TC / 256;
  const int MT = 264 - mt0;
  const int sc = slot_col(), srow = tid >> 3;
  int it = 0, mt, nt;
  bool have = next_tile(it, MT, 8, mt, nt);
  const half_t* a0 = nullptr; const half_t* b0 = nullptr;
  if (have) {
    asm volatile("" : "+s"(mt), "+s"(nt));
    a0 = P.mix + (size_t)((mt + mt0) * 256 + srow) * D + sc; b0 = Wt + (size_t)(nt * 128 + srow) * D + sc;
    gemm_prologue([&](int i) { return a0 + (size_t)i * 32 * D; }, [&](int i) { return b0 + (size_t)i * 32 * D; }, 16, smem);
  }
#pragma unroll 1
  while (have) {
    f4 acc[8][4];
    gemm256<true>([&](int i) { return a0 + (size_t)i * 32 * D; }, [&](int i) { return b0 + (size_t)i * 32 * D; }, 16, smem, acc);
    const int tid2 = TIDX, lane2 = tid2 & 63, wave2 = tid2 >> 6, fr2 = lane2 & 15, fq2 = lane2 >> 4, wr2 = wave2 >> 1, wc2 = wave2 & 1;
    const int r0 = (mt + mt0) * 256 + wr2 * 128;
    const int n = row_mod(r0);
    const int cbase = nt * 128 + wc2 * 64;
    const float* res; float* dst;
    if (r0 < TC) { res = P.ctx + (size_t)r0 * D; dst = P.xcbuf + (size_t)r0 * D; }
    else { dst = P.out + (size_t)(r0 - TC) * D; res = l == 0 ? P.x + (size_t)(r0 - TC) * D : dst; }
    res += cbase + fr2 * 4; dst += cbase + fr2 * 4;
    const float4 g4 = *(const float4*)(P.mod + (size_t)(l * 9 + n) * 6144 + 2 * 1024 + cbase + fr2 * 4);
    float4 rres[4][8];
#pragma unroll
    for (int q = 0; q < 4; q++)
#pragma unroll
      for (int i = 0; i < 8; i++) rres[q][i] = *(const float4*)(res + (size_t)(q * 32 + i * 4 + fq2) * D);
    int it2 = it + 1, mt2, nt2;
    const bool have2 = next_tile(it2, MT, 8, mt2, nt2);
    const half_t* a1 = a0; const half_t* b1 = b0;
    if (have2) {
      asm volatile("" : "+s"(mt2), "+s"(nt2));
      a1 = P.mix + (size_t)((mt2 + mt0) * 256 + srow) * D + sc; b1 = Wt + (size_t)(nt2 * 128 + srow) * D + sc;
      gemm_prologue([&](int i) { return a1 + (size_t)i * 32 * D; }, [&](int i) { return b1 + (size_t)i * 32 * D; }, 16, smem);
    }
    {
      float* stg = (float*)(smem + 98304 + wave2 * 12288);
#pragma unroll
      for (int q = 0; q < 4; q++) {
#pragma unroll
        for (int ml = 0; ml < 2; ml++)
#pragma unroll
          for (int nn = 0; nn < 4; nn++)
#pragma unroll
            for (int j = 0; j < 4; j++) stg[(ml * 16 + fq2 * 4 + j) * 68 + nn * 16 + fr2] = acc[q * 2 + ml][nn][j];
        __builtin_amdgcn_wave_barrier();
#pragma unroll
        for (int i = 0; i < 8; i++) {
          const int row = i * 4 + fq2;
          const float4 a = *(const float4*)(stg + row * 68 + fr2 * 4);
          float4 r = rres[q][i];
          r.x += g4.x * a.x; r.y += g4.y * a.y; r.z += g4.z * a.z; r.w += g4.w * a.w;
          *(float4*)(dst + (size_t)(q * 32 + row) * D) = r;
        }
        __builtin_amdgcn_wave_barrier();
      }
    }
    mt = mt2; nt = nt2; it = it2; have = have2; a0 = a1; b0 = b1;
  }
}

DI void moe_prefix(const Params& P, int l, int* tb) {
  __syncthreads();
  if (TIDX == 0) { int s = 0; for (int e = 0; e < 32; e++) { tb[e] = s; s += (P.cnt[l * 32 + e] + 255) >> 8; } tb[32] = s; }
  __syncthreads();
}
DI void moe_e1_phase(const Params& P, int l, char* smem, int* tb) {
  const int tid = TIDX;
  moe_prefix(P, l, tb);
  const int sc = slot_col(), srow = tid >> 3;
  const int MT = tb[32];
  auto setup = [&](int rt, int nt, int (&tok)[8], const half_t*& w1, const half_t*& w3) {
    int e = 0;
    while (tb[e + 1] <= rt) e++;
    const int rl = rt - tb[e], cnt = P.cnt[l * 32 + e];
    const int* lst = P.list + (size_t)e * LCAP;
    w1 = P.Wt1 + ((size_t)(l * 32 + e) * 512 + nt * 64) * 1024 + sc;
    w3 = P.Wt3 + ((size_t)(l * 32 + e) * 512 + nt * 64) * 1024 + sc;
#pragma unroll
    for (int i = 0; i < 8; i++) tok[i] = lst[min(rl * 256 + i * 32 + srow, cnt - 1)] >> 1;
  };
  int it = 0, rt, nt;
  bool have = next_tile(it, MT, 8, rt, nt);
  int tok[8]; const half_t* w1 = nullptr; const half_t* w3 = nullptr;
  if (have) {
    asm volatile("" : "+s"(rt), "+s"(nt));
    setup(rt, nt, tok, w1, w3);
    gemm_prologue([&](int i) { return P.hx + (size_t)tok[i] * D + sc; }, [&](int i) { return ((i & 1) ? w3 : w1) + (size_t)((i >> 1) * 32 + srow) * 1024; }, 16, smem);
  }
#pragma unroll 1
  while (have) {
    int it2 = it + 1, rt2, nt2;
    const bool have2 = next_tile(it2, MT, 8, rt2, nt2);
    int tok2[8]; const half_t* w1n = w1; const half_t* w3n = w3;
#pragma unroll
    for (int i = 0; i < 8; i++) tok2[i] = tok[i];
    if (have2) {
      asm volatile("" : "+s"(rt2), "+s"(nt2));
      setup(rt2, nt2, tok2, w1n, w3n);
    }
    f4 acc[8][4];
    gemm256<true>([&](int i) { return P.hx + (size_t)tok[i] * D + sc; },
                  [&](int i) { return ((i & 1) ? w3 : w1) + (size_t)((i >> 1) * 32 + srow) * 1024; }, 16, smem, acc);
    if (have2) {
      gemm_prologue([&](int i) { return P.hx + (size_t)tok2[i] * D + sc; }, [&](int i) { return ((i & 1) ? w3n : w1n) + (size_t)((i >> 1) * 32 + srow) * 1024; }, 16, smem);
    }
    {
      const int tid2 = TIDX, lane2 = tid2 & 63, wave2 = tid2 >> 6, fr2 = lane2 & 15, fq2 = lane2 >> 4, wr2 = wave2 >> 1, wc2 = wave2 & 1;
      char* stg = smem + 98304 + wave2 * 12288;
      half_t* Hd = P.H + ((size_t)rt * 256 + wr2 * 128) * 512 + nt * 64 + wc2 * 32;
#pragma unroll
      for (int h = 0; h < 2; h++) {
#pragma unroll
        for (int ml = 0; ml < 4; ml++)
#pragma unroll
          for (int n = 0; n < 2; n++)
#pragma unroll
            for (int j = 0; j < 4; j++) {
              float a1 = acc[h * 4 + ml][n][j], a3 = acc[h * 4 + ml][n + 2][j];
              *(half_t*)(stg + (ml * 16 + fq2 * 4 + j) * 80 + (n * 16 + fr2) * 2) = (half_t)(a1 * sigmoidf_(a1) * a3);
            }
        __builtin_amdgcn_wave_barrier();
#pragma unroll
        for (int i = 0; i < 4; i++) {
          const int c = i * 64 + lane2, row = c >> 2, c16 = c & 3;
          h8 v = *(const h8*)(stg + row * 80 + c16 * 16);
          *(h8*)(Hd + (size_t)(h * 64 + row) * 512 + c16 * 8) = v;
        }
        __builtin_amdgcn_wave_barrier();
      }
    }
    rt = rt2; nt = nt2; it = it2; have = have2; w1 = w1n; w3 = w3n;
#pragma unroll
    for (int i = 0; i < 8; i++) tok[i] = tok2[i];
  }
}
DI void moe_e2_phase(const Params& P, int l, char* smem, int* tb) {
  const int tid = TIDX;
  moe_prefix(P, l, tb);
  const int sc = slot_col(), srow = tid >> 3;
  const int MT = tb[32];
  auto ptrs = [&](int rt, int nt, const half_t*& a0, const half_t*& b0) {
    int e = 0;
    while (tb[e + 1] <= rt) e++;
    a0 = P.H + ((size_t)rt * 256 + srow) * 512 + sc;
    b0 = P.Wt2 + ((size_t)(l * 32 + e) * 1024 + nt * 128 + srow) * 512 + sc;
  };
  int it = 0, rt, nt;
  bool have = next_tile(it, MT, 8, rt, nt);
  const half_t* a0 = nullptr; const half_t* b0 = nullptr;
  if (have) {
    asm volatile("" : "+s"(rt), "+s"(nt));
    ptrs(rt, nt, a0, b0);
    gemm_prologue([&](int i) { return a0 + (size_t)i * 32 * 512; }, [&](int i) { return b0 + (size_t)i * 32 * 512; }, 8, smem);
  }
#pragma unroll 1
  while (have) {
    const int tid2 = TIDX, lane2 = tid2 & 63, wave2 = tid2 >> 6, wr2 = wave2 >> 1, wc2 = wave2 & 1;
    int e = 0;
    while (tb[e + 1] <= rt) e++;
    const int rl = rt - tb[e], cnt = P.cnt[l * 32 + e];
    const int* lst = P.list + (size_t)e * LCAP; const float* lstw = P.listW + (size_t)e * LCAP;
    int aa[2][8]; float ww[2][8];
#pragma unroll
    for (int h = 0; h < 2; h++)
#pragma unroll
      for (int i = 0; i < 8; i++) {
        const int idx = rl * 256 + wr2 * 128 + h * 64 + ((i * 64 + lane2) >> 3);
        const int ic = min(idx, cnt - 1);
        const int av = lst[ic]; const float wv = lstw[ic];
        aa[h][i] = idx < cnt ? av : -1; ww[h][i] = wv;
      }
    f4 acc[8][4];
    gemm256<true>([&](int i) { return a0 + (size_t)i * 32 * 512; }, [&](int i) { return b0 + (size_t)i * 32 * 512; }, 8, smem, acc);
    int it2 = it + 1, rt2, nt2;
    const bool have2 = next_tile(it2, MT, 8, rt2, nt2);
    const half_t* a1 = a0; const half_t* b1 = b0;
    if (have2) {
      asm volatile("" : "+s"(rt2), "+s"(nt2));
      ptrs(rt2, nt2, a1, b1);
      gemm_prologue([&](int i) { return a1 + (size_t)i * 32 * 512; }, [&](int i) { return b1 + (size_t)i * 32 * 512; }, 8, smem);
    }
    {
      char* stg = smem + 98304 + wave2 * 12288;
      const int fr2 = lane2 & 15, fq2 = lane2 >> 4;
#pragma unroll
      for (int h = 0; h < 2; h++) {
#pragma unroll
        for (int ml = 0; ml < 4; ml++)
#pragma unroll
          for (int n = 0; n < 4; n++)
#pragma unroll
            for (int j = 0; j < 4; j++) stage_put(stg, ml, n, j, fr2, fq2, acc[h * 4 + ml][n][j]);
        __builtin_amdgcn_wave_barrier();
#pragma unroll
        for (int i = 0; i < 8; i++) {
          const int c = i * 64 + lane2, row = c >> 3, c16 = c & 7;
          h8 v = *(const h8*)(stg + row * 144 + c16 * 16);
          if (aa[h][i] >= 0) {
            const float w = ww[h][i];
#pragma unroll
            for (int u = 0; u < 8; u++) v[u] = (half_t)(w * (float)v[u]);
            *(h8*)(P.yA + (size_t)aa[h][i] * D + nt * 128 + wc2 * 64 + c16 * 8) = v;
          }
        }
        __builtin_amdgcn_wave_barrier();
      }
    }
    rt = rt2; nt = nt2; it = it2; have = have2; a0 = a1; b0 = b1;
  }
}

DI int swap23(int x) { return (x & ~12) | ((x & 4) << 1) | ((x & 8) >> 1); }
DI void attn_item(const Params& P, int l, int b, int head, int row0, int nkeys, char* smem) {
  const int tid = TIDX, lane = tid & 63, wave = tid >> 6, ql = lane & 31, hh = lane >> 5;
  const float lam = P.consts[l * 4 + 0], negc = -P.consts[l * 4 + 1], lam_init = P.consts[l * 4 + 2];
  const int myrow = row0 + wave * 32 + ql;
  h8 qf[2][4];
  {
    const half_t* qp = P.q + (size_t)myrow * 512 + head * 128 + hh * 8;
#pragma unroll
    for (int m = 0; m < 2; m++)
#pragma unroll
      for (int s = 0; s < 4; s++) { qf[m][s] = *(const h8*)(qp + m * 64 + s * 16); }
#pragma unroll
    for (int m = 0; m < 2; m++)
#pragma unroll
      for (int s = 0; s < 4; s++) tie(qf[m][s]);
  }
  f16v o0[4], o1[4];
#pragma unroll
  for (int dt = 0; dt < 4; dt++)
#pragma unroll
    for (int i = 0; i < 16; i++) { o0[dt][i] = 0.f; o1[dt][i] = 0.f; }
  float ls0 = 0.f, ls1 = 0.f;
  const half_t* kp[4]; const half_t* vp[4];
  {
    const half_t* kbase = P.kall + (size_t)b * KV * 512 + head * 128;
    const half_t* vbase = P.vT + (size_t)(b * 4 + head) * 128 * KV;
#pragma unroll
    for (int i = 0; i < 4; i++) {
      int s = i * 256 + tid;
      int row = s >> 4, c = (s & 15) ^ (row & 15); kp[i] = kbase + (size_t)row * 512 + c * 8;
      int vr = s >> 3, vc = (s & 7) ^ ((vr >> 1) & 7); vp[i] = vbase + (size_t)vr * KV + vc * 8;
    }
  }
  const int ntile = nkeys >> 6;
  const unsigned sbase = lds_addr(smem);
  auto issue = [&](int t) {
    char* d = smem + (t & 3) * 32768 + tid * 16;
#pragma unroll
    for (int i = 0; i < 4; i++) { glds16(kp[i] + (size_t)t * 64 * 512, d + i * 4096); glds16(vp[i] + t * 64, d + 16384 + i * 4096); }
  };
  unsigned koff[2];
  const int kr_lo = swap23(ql), ksw = kr_lo & 15;
  koff[0] = kr_lo * 256; koff[1] = (32 + kr_lo) * 256;
  unsigned voff[4];
#pragma unroll
  for (int dt = 0; dt < 4; dt++) { int vrow = dt * 32 + ql; voff[dt] = 16384 + vrow * 128; }
  const int vsw = (ql >> 1) & 7;
  f16v negcv;
#pragma unroll
  for (int i = 0; i < 16; i++) negcv[i] = negc;
  h8 pp0[2], pp1[2];
  unsigned pendV = 0; int pendkt = 0; bool pend = false;
  auto half_step = [&](h8 (&kf)[8], unsigned cur, int kt) {
    h8 vf[8];
    if (pend) {
#pragma unroll
      for (int sp = 0; sp < 2; sp++)
#pragma unroll
        for (int dt = 0; dt < 4; dt++) vf[sp * 4 + dt] = lds128(pendV + voff[dt] + (((pendkt * 4 + sp * 2 + hh) ^ vsw) << 4));
    }
    f16v s0 = mfma32(kf[0], qf[0][0], negcv), s1 = mfma32(kf[4], qf[1][0], negcv);
#pragma unroll
    for (int st = 1; st < 4; st++) { s0 = mfma32(kf[st], qf[0][st], s0); s1 = mfma32(kf[4 + st], qf[1][st], s1); }
    if (pend) {
      WAIT_LGKM(0);
#pragma unroll
      for (int i = 0; i < 8; i++) tie(vf[i]);
#pragma unroll
      for (int sp = 0; sp < 2; sp++)
#pragma unroll
        for (int dt = 0; dt < 4; dt++) { o0[dt] = mfma32(vf[sp * 4 + dt], pp0[sp], o0[dt]); o1[dt] = mfma32(vf[sp * 4 + dt], pp1[sp], o1[dt]); }
    }
#pragma unroll
    for (int i = 0; i < 16; i++) { s0[i] = __builtin_amdgcn_exp2f(s0[i]); ls0 += s0[i]; s1[i] = __builtin_amdgcn_exp2f(s1[i]); ls1 += s1[i]; }
#pragma unroll
    for (int sp = 0; sp < 2; sp++) {
      u4 a, c;
      a[0] = pk2(s0[8*sp+0], s0[8*sp+1]); a[1] = pk2(s0[8*sp+2], s0[8*sp+3]); a[2] = pk2(s0[8*sp+4], s0[8*sp+5]); a[3] = pk2(s0[8*sp+6], s0[8*sp+7]);
      c[0] = pk2(s1[8*sp+0], s1[8*sp+1]); c[1] = pk2(s1[8*sp+2], s1[8*sp+3]); c[2] = pk2(s1[8*sp+4], s1[8*sp+5]); c[3] = pk2(s1[8*sp+6], s1[8*sp+7]);
      pp0[sp] = __builtin_bit_cast(h8, a); pp1[sp] = __builtin_bit_cast(h8, c);
    }
    pend = true; pendV = cur; pendkt = kt;
  };
  issue(0);
  if (ntile > 1) issue(1);
#pragma unroll 1
  for (int t = 0; t < ntile; t++) {
    if (t + 1 < ntile) asm volatile("s_waitcnt vmcnt(8)" ::: "memory"); else wait_vm0();
    raw_barrier();
    if (t + 2 < ntile) issue(t + 2);
    const unsigned cur = sbase + (t & 3) * 32768;
    h8 kfa[8], kfb[8];
#pragma unroll
    for (int st = 0; st < 4; st++) {
      kfa[st] = lds128(cur + koff[0] + (((st * 2 + hh) ^ ksw) << 4));
      kfa[4 + st] = lds128(cur + koff[0] + (((8 + st * 2 + hh) ^ ksw) << 4));
    }
#pragma unroll
    for (int st = 0; st < 4; st++) {
      kfb[st] = lds128(cur + koff[1] + (((st * 2 + hh) ^ ksw) << 4));
      kfb[4 + st] = lds128(cur + koff[1] + (((8 + st * 2 + hh) ^ ksw) << 4));
    }
    WAIT_LGKM(8);
#pragma unroll
    for (int i = 0; i < 8; i++) tie(kfa[i]);
    half_step(kfa, cur, 0);
    WAIT_LGKM(0);
#pragma unroll
    for (int i = 0; i < 8; i++) tie(kfb[i]);
    half_step(kfb, cur, 1);
  }
  {
    h8 vf[8];
#pragma unroll
    for (int sp = 0; sp < 2; sp++)
#pragma unroll
      for (int dt = 0; dt < 4; dt++) vf[sp * 4 + dt] = lds128(pendV + voff[dt] + (((pendkt * 4 + sp * 2 + hh) ^ vsw) << 4));
    WAIT_LGKM(0);
#pragma unroll
    for (int i = 0; i < 8; i++) tie(vf[i]);
#pragma unroll
    for (int sp = 0; sp < 2; sp++)
#pragma unroll
      for (int dt = 0; dt < 4; dt++) { o0[dt] = mfma32(vf[sp * 4 + dt], pp0[sp], o0[dt]); o1[dt] = mfma32(vf[sp * 4 + dt], pp1[sp], o1[dt]); }
  }
  raw_barrier();
  ls0 += shx(ls0, 32); ls1 += shx(ls1, 32);
  const float i0 = 1.f / ls0, i1 = lam / ls1;
  float ss = 0.f;
#pragma unroll
  for (int dt = 0; dt < 4; dt++)
#pragma unroll
    for (int i = 0; i < 16; i++) { float v = o0[dt][i] * i0 - o1[dt][i] * i1; o0[dt][i] = v; ss += v * v; }
  ss += shx(ss, 32);
  const float mult = rsqrtf(ss * (1.f / 128.f) + EPS) * (1.f - lam_init);
  const float* sg = P.subln_g + l * 128;
  half_t* dst = P.mix + (size_t)myrow * D + 256 + head * 128;
#pragma unroll
  for (int dt = 0; dt < 4; dt++)
#pragma unroll
    for (int g = 0; g < 4; g++) {
      const int d0 = dt * 32 + 8 * g + 4 * hh;
      float4 gv = *(const float4*)(sg + d0);
      h4 o; o[0] = (half_t)(o0[dt][4*g] * mult * gv.x); o[1] = (half_t)(o0[dt][4*g+1] * mult * gv.y);
      o[2] = (half_t)(o0[dt][4*g+2] * mult * gv.z); o[3] = (half_t)(o0[dt][4*g+3] * mult * gv.w);
      *(h4*)(dst + d0) = o;
    }
}

DI int swz128(int row, int colh) { return row * 128 + ((((colh >> 3)) ^ ((row >> 1) & 7)) << 4) + (colh & 7) * 2; }
DI void lru_load_w(const Params& P, int l, int g, char* Wt) {
  const int tid = TIDX;
  for (int dg = 0; dg < 4; dg++) {
    const int dir = dg >> 1;
    const float* w = ((dg & 1) ? P.gate_x_w : P.gate_a_w) + ((size_t)((l * 2 + dir) * 4 + g)) * 4096;
    for (int idx = tid; idx < 4096; idx += 256) { int i = idx >> 6, o = idx & 63; *(half_t*)(Wt + dg * 8192 + swz128(o, i)) = (half_t)w[idx]; }
  }
}
struct LruK { float ba[2][4], bx[2][4], sp8[2][4], cw[5]; };
DI void lru_consts(const Params& P, int l, int g, LruK& K) {
  const int tid = TIDX, fr = tid & 15, gc = g * 64 + (tid & 63);
#pragma unroll
  for (int dir = 0; dir < 2; dir++)
#pragma unroll
    for (int n = 0; n < 4; n++) {
      const int cc = (l * 2 + dir) * 256 + g * 64 + n * 16 + fr;
      K.ba[dir][n] = P.gate_a_b[cc]; K.bx[dir][n] = P.gate_x_b[cc]; K.sp8[dir][n] = -8.f * log1pf(__expf(-P.lru_lambda[cc]));
    }
#pragma unroll
  for (int k = 0; k < 4; k++) K.cw[k] = P.conv_w[(l * 4 + k) * 256 + gc];
  K.cw[4] = P.conv_b[l * 256 + gc];
}
DI void lru_tile(const Params& P, int l, int b, int tile, int g, char* smem, bool final, const LruK& K) {
  const int tid = TIDX, lane = tid & 63, wave = tid >> 6, fr = lane & 15, fq = lane >> 4;
  char* Wt = smem;
  char* xr16 = smem + 32768;
  float2* ab = (float2*)(smem + 40960);
  half_t* raw = (half_t*)(smem + 40960);
  float2* subst = (float2*)(smem + 73728);
  const int ch = tid & 63, tq = tid >> 6, gc = g * 64 + ch;
  const int T = tile < 4 ? CL : SEQ;
  const int t0 = tile < 4 ? tile * 64 : (tile - 4) * 64;
  const int rowbase = tile < 4 ? b * CL : TC + b * SEQ;
  unsigned* lab = (unsigned*)P.hx;
  __syncthreads();
  if (final) {
    float gyv[16], hsum[16];
#pragma unroll
    for (int e = 0; e < 16; e++) { gyv[e] = (float)P.gy[(size_t)(rowbase + t0 + tq * 16 + e) * 256 + gc]; hsum[e] = 0.f; }
    unsigned pk0[16], pk1[16];
#pragma unroll
    for (int e = 0; e < 16; e++) { pk0[e] = lab[((size_t)rowbase + t0 + tq * 16 + e) * 256 + gc]; pk1[e] = lab[((size_t)TA + rowbase + t0 + tq * 16 + e) * 256 + gc]; }
    const float car0 = P.lcar[((size_t)((b * 2 + 0) * 132 + tile)) * 256 + gc], car1 = P.lcar[((size_t)((b * 2 + 1) * 132 + tile)) * 256 + gc];
#pragma unroll 1
    for (int dir = 0; dir < 2; dir++) {
      unsigned pk[16];
#pragma unroll
      for (int e = 0; e < 16; e++) pk[e] = dir == 0 ? pk0[e] : pk1[e];
      float2 av[16];
      float A = 1.f, h = 0.f;
#pragma unroll
      for (int e = 0; e < 16; e++) {
        const int ee = dir == 0 ? e : 15 - e;
        unsigned u = pk[0];
#pragma unroll
        for (int q = 1; q < 16; q++) u = (q == ee) ? pk[q] : u;
        fp16x2 hv = __builtin_bit_cast(fp16x2, u);
        av[e] = make_float2(__expf((float)hv[0]), (float)hv[1]);
        h = av[e].x * h + av[e].y; A *= av[e].x;
      }
      subst[tq * 64 + ch] = make_float2(A, h);
      __syncthreads();
      h = dir == 0 ? car0 : car1;
      if (dir == 0) { for (int s2 = 0; s2 < tq; s2++) { float2 ss = subst[s2 * 64 + ch]; h = ss.x * h + ss.y; } }
      else { for (int s2 = 3; s2 > tq; s2--) { float2 ss = subst[s2 * 64 + ch]; h = ss.x * h + ss.y; } }
#pragma unroll
      for (int e = 0; e < 16; e++) {
        const int ee = dir == 0 ? e : 15 - e;
        h = av[e].x * h + av[e].y;
#pragma unroll
        for (int q = 0; q < 16; q++) hsum[q] += (q == ee) ? h : 0.f;
      }
      __syncthreads();
    }
#pragma unroll
    for (int e = 0; e < 16; e++)
      P.mix[(size_t)(rowbase + t0 + tq * 16 + e) * D + 768 + gc] = (half_t)(gyv[e] * hsum[e]);
    return;
  }
  for (int idx = tid; idx < 67 * 8; idx += 256) {
    int row = idx >> 3, c = idx & 7, tt = t0 - 1 + row;
    h8 v = {0, 0, 0, 0, 0, 0, 0, 0};
    if (tt >= 0 && tt < T) v = *(const h8*)(P.rr + (size_t)(rowbase + tt) * 256 + g * 64 + c * 8);
    *(h8*)(raw + row * 64 + c * 8) = v;
  }
  const float cw0 = K.cw[0], cw1 = K.cw[1], cw2 = K.cw[2], cw3 = K.cw[3], cb = K.cw[4];
  __syncthreads();
  {
    float v[19];
#pragma unroll
    for (int e = 0; e < 19; e++) v[e] = (float)raw[(tq * 16 + e) * 64 + ch];
    __syncthreads();
#pragma unroll
    for (int e = 0; e < 16; e++) {
      float xv = cb + cw0 * v[e] + cw1 * v[e + 1] + cw2 * v[e + 2] + cw3 * v[e + 3];
      *(half_t*)(xr16 + swz128(tq * 16 + e, ch)) = (half_t)xv;
    }
  }
  __syncthreads();
#pragma unroll 1
  for (int dir = 0; dir < 2; dir++) {
    {
      f4 acc[2][4];
#pragma unroll
      for (int gt = 0; gt < 2; gt++)
#pragma unroll
        for (int n = 0; n < 4; n++) acc[gt][n] = (f4){0.f, 0.f, 0.f, 0.f};
#pragma unroll
      for (int kk = 0; kk < 2; kk++) {
        int row = wave * 16 + fr;
        h8 af = *(const h8*)(xr16 + row * 128 + (((kk * 4 + fq) ^ ((row >> 1) & 7)) << 4));
#pragma unroll
        for (int gt = 0; gt < 2; gt++)
#pragma unroll
          for (int n = 0; n < 4; n++) {
            int orow = n * 16 + fr;
            h8 bf = *(const h8*)(Wt + (dir * 2 + gt) * 8192 + orow * 128 + (((kk * 4 + fq) ^ ((orow >> 1) & 7)) << 4));
            acc[gt][n] = mfma16(af, bf, acc[gt][n]);
          }
      }
#pragma unroll
      for (int n = 0; n < 4; n++) {
        const float ba = dir == 0 ? K.ba[0][n] : K.ba[1][n], bx = dir == 0 ? K.bx[0][n] : K.bx[1][n], sp8 = dir == 0 ? K.sp8[0][n] : K.sp8[1][n];
#pragma unroll
        for (int j = 0; j < 4; j++) {
          int tl = wave * 16 + fq * 4 + j, c2 = n * 16 + fr;
          float xv = (float)*(const half_t*)(xr16 + swz128(tl, c2));
          float rg = sigmoidf_(acc[0][n][j] + ba), ig = sigmoidf_(acc[1][n][j] + bx);
          float log_a = rg * sp8;
          float x2 = 2.f * log_a;
          float om = -x2 * (1.f + x2 * (0.5f + x2 * (0.16666667f + x2 * (0.041666668f + x2 * (0.008333334f + x2 * 0.0013888889f)))));
          if (x2 < -0.4f) { float a = __expf(log_a); om = 1.f - a * a; }
          ab[tl * 64 + c2] = make_float2(log_a, sqrtf(om) * (ig * xv));
        }
      }
    }
    __syncthreads();
    {
      float A = 1.f, h = 0.f;
#pragma unroll
      for (int e = 0; e < 16; e++) {
        const int ee = dir == 0 ? e : 15 - e;
        const float2 lb = ab[(tq * 16 + ee) * 64 + ch];
        fp16x2 hv; hv[0] = (__fp16)lb.x; hv[1] = (__fp16)lb.y;
        lab[((size_t)dir * TA + rowbase + t0 + tq * 16 + ee) * 256 + gc] = __builtin_bit_cast(unsigned, hv);
        const float a = __expf((float)hv[0]), bt = (float)hv[1];
        h = a * h + bt; A *= a;
      }
      subst[tq * 64 + ch] = make_float2(A, h);
    }
    __syncthreads();
    if (tq == 0) {
      float A = 1.f, h = 0.f;
#pragma unroll
      for (int s2 = 0; s2 < 4; s2++) { float2 ss = subst[(dir == 0 ? s2 : 3 - s2) * 64 + ch]; h = ss.x * h + ss.y; A *= ss.x; }
      P.lsum[((size_t)((b * 2 + dir) * 132 + tile)) * 256 + gc] = make_float2(A, h);
    }
    __syncthreads();
  }
}
DI void lru_carry_item(const Params& P, int it) {
  const int ch = TIDX, dir = it & 1;
  const size_t base = (size_t)it * 132 * 256 + ch;
  float c = 0.f;
#pragma unroll 4
  for (int k = 0; k < 132; k++) {
    int tile = dir == 0 ? k : (k < 4 ? 3 - k : 135 - k);
    float2 s = P.lsum[base + (size_t)tile * 256];
    P.lcar[base + (size_t)tile * 256] = c;
    c = s.x * c + s.y;
  }
}

template <int NROWS>
DI void fft_load(const half_t* src, size_t rs, char* Bt, int rowbytes, int k0) {
  const int tid = TIDX;
  h8 v[NROWS / 16];
#pragma unroll
  for (int i = 0; i < NROWS / 16; i++) { int idx = i * 256 + tid; v[i] = *(const h8*)(src + (size_t)(idx >> 4) * rs + (idx & 15) * 8); }
#pragma unroll
  for (int i = 0; i < NROWS / 16; i++) {
    int idx = i * 256 + tid, kr = idx >> 4, cc = idx & 15, k = k0 + kr;
#pragma unroll
    for (int u = 0; u < 8; u++) { int n = cc * 8 + u; *(half_t*)(Bt + n * rowbytes + ((((k >> 3)) ^ (n & 15)) << 4) + (k & 7) * 2) = v[i][u]; }
  }
}
template <class RF>
DI void fft_mma(const half_t* Dm, int ldD, int nkk, const char* Bt, int rowbytes, f4 (&acc)[4][4], RF arow) {
  const int lane = TIDX & 63, wave = TIDX >> 6, fr = lane & 15, fq = lane >> 4, wc = wave & 1;
#pragma unroll 4
  for (int kk = 0; kk < nkk; kk++) {
    h8 af[4], bf[4];
#pragma unroll
    for (int ms = 0; ms < 4; ms++) af[ms] = *(const h8*)(Dm + (size_t)arow(ms) * ldD + kk * 32 + fq * 8);
#pragma unroll
    for (int ns = 0; ns < 4; ns++) { int n = wc * 64 + ns * 16 + fr; bf[ns] = *(const h8*)(Bt + n * rowbytes + (((kk * 4 + fq) ^ (n & 15)) << 4)); }
#pragma unroll
    for (int ms = 0; ms < 4; ms++)
#pragma unroll
      for (int ns = 0; ns < 4; ns++) acc[ms][ns] = mfma16(af[ms], bf[ns], acc[ms][ns]);
  }
}
DI void zero44(f4 (&acc)[4][4]) {
#pragma unroll
  for (int m = 0; m < 4; m++)
#pragma unroll
    for (int n = 0; n < 4; n++) acc[m][n] = (f4){0.f, 0.f, 0.f, 0.f};
}
DI void fftA_item(const Params& P, int it, char* smem) {
  const int b = it >> 8, bb = (it >> 1) & 127, chh = it & 1;
  const int lane = TIDX & 63, wave = TIDX >> 6, fr = lane & 15, fq = lane >> 4, wr = wave >> 1, wc = wave & 1;
  __syncthreads();
  fft_load<64>(P.QF + (size_t)(TC + b * SEQ + bb) * 512 + chh * 128, (size_t)128 * 512, smem, 256, 0);
  fft_load<64>(P.QF + (size_t)(TC + b * SEQ + bb) * 512 + 256 + chh * 128, (size_t)128 * 512, smem, 256, 64);
  __syncthreads();
  f4 acc[4][4]; zero44(acc);
  fft_mma(P.DA, 128, 4, smem, 256, acc, [&](int ms) { return (ms >> 1) * 64 + wr * 32 + (ms & 1) * 16 + fr; });
#pragma unroll
  for (int ms = 0; ms < 2; ms++)
#pragma unroll
    for (int j = 0; j < 4; j++) {
      const int f1 = wr * 32 + ms * 16 + fq * 4 + j;
      const float2 w = P.tw[(bb * f1) & 8191];
      half_t* d0 = P.GA + ((size_t)(b * 64 + f1) * 256 + bb) * 256 + chh * 128 + wc * 64 + fr;
#pragma unroll
      for (int ns = 0; ns < 4; ns++) {
        float gr = acc[ms][ns][j], gi = acc[ms + 2][ns][j];
        d0[ns * 16] = (half_t)(gr * w.x + gi * w.y);
        d0[(size_t)128 * 256 + ns * 16] = (half_t)(gi * w.x - gr * w.y);
      }
    }
}
DI void fftB_item(const Params& P, int it, char* smem) {
  const int b = it >> 7, f1 = (it >> 1) & 63, chh = it & 1;
  const int lane = TIDX & 63, wave = TIDX >> 6, fr = lane & 15, fq = lane >> 4, wr = wave >> 1, wc = wave & 1;
  __syncthreads();
  fft_load<256>(P.GA + (size_t)(b * 64 + f1) * 256 * 256 + chh * 128, 256, smem, 512, 0);
  __syncthreads();
  f4 acc[4][4]; zero44(acc);
  fft_mma(P.DB, 256, 8, smem, 512, acc, [&](int ms) { return wr * 64 + ms * 16 + fr; });
#pragma unroll
  for (int ms = 0; ms < 4; ms++)
#pragma unroll
    for (int j = 0; j < 4; j++) {
      const int f2 = wr * 64 + ms * 16 + fq * 4 + j;
      half_t* d0 = P.mix + (size_t)(TC + b * SEQ + f1 + 64 * f2) * D + chh * 128 + wc * 64 + fr;
#pragma unroll
      for (int ns = 0; ns < 4; ns++) d0[ns * 16] = (half_t)acc[ms][ns][j];
    }
}
DI void fftC_item(const Params& P, int it, char* smem) {
  const int b = it >> 1, chh = it & 1;
  const int lane = TIDX & 63, wave = TIDX >> 6, fr = lane & 15, fq = lane >> 4, wr = wave >> 1, wc = wave & 1;
#pragma unroll 1
  for (int mh = 0; mh < 2; mh++) {
    f4 acc[4][4]; zero44(acc);
#pragma unroll 1
    for (int part = 0; part < 2; part++) {
      __syncthreads();
      fft_load<256>(P.QF + (size_t)(b * CL) * 512 + part * 256 + chh * 128, 512, smem, 512, 0);
      __syncthreads();
      fft_mma(P.DC + part * 256, 512, 8, smem, 512, acc, [&](int ms) { return mh * 128 + wr * 64 + ms * 16 + fr; });
    }
#pragma unroll
    for (int ms = 0; ms < 4; ms++)
#pragma unroll
      for (int j = 0; j < 4; j++) {
        const int f = mh * 128 + wr * 64 + ms * 16 + fq * 4 + j;
        half_t* d0 = P.mix + (size_t)(b * CL + f) * D + chh * 128 + wc * 64 + fr;
#pragma unroll
        for (int ns = 0; ns < 4; ns++) d0[ns * 16] = (half_t)acc[ms][ns][j];
      }
  }
}

#ifndef MX
#define MX 15
#endif
DI void mix_phase(const Params& P, int l, char* smem, int* s_item, int qi) {
  const int nL = 0, nA = 0, nC = l == 0 ? 64 : 0, nFA = 2048, nFC = l == 0 ? 16 : 0;
  const int total = nL + nA + nC + nFA + nFC;
  {
    const int g = blockIdx.x & 3;
    lru_load_w(P, l, g, smem);
    LruK K; lru_consts(P, l, g, K);
    for (int u = blockIdx.x >> 2; u < NB_ * 132; u += gridDim.x >> 2) lru_tile(P, l, u / 132, u % 132, g, smem, false, K);
    asm volatile("s_waitcnt vmcnt(0)" ::: "memory");
    __syncthreads();
    if (TIDX == 0) {
      __builtin_amdgcn_fence(__ATOMIC_RELEASE, "agent");
      asm volatile("s_waitcnt vmcnt(0)" ::: "memory");
      __hip_atomic_fetch_add((unsigned*)&P.qctr[48 + l], 1u, __ATOMIC_RELAXED, __HIP_MEMORY_SCOPE_AGENT);
    }
  }
  int stage = 0;
  for (;;) {
    __syncthreads();
    if (TIDX == 0) *s_item = stage == 0 ? atomicAdd(&P.qctr[8 + qi * 8 + (blockIdx.x & 7)], 1) : atomicAdd(&P.qctr[qi], 1);
    __syncthreads();
    int it = *s_item;
    int kind = -1, b = 0, head = 0, row0 = 0, nk = 0;
    if (stage == 0) {
      if (it >= 256) {
        stage = 1;
        if (blockIdx.x >= gridDim.x - 16) {
          if (TIDX == 0) {
            while (__hip_atomic_load((unsigned*)&P.qctr[48 + l], __ATOMIC_RELAXED, __HIP_MEMORY_SCOPE_AGENT) < gridDim.x) __builtin_amdgcn_s_sleep(1);
            __builtin_amdgcn_fence(__ATOMIC_ACQUIRE, "agent");
            asm volatile("s_waitcnt vmcnt(0)" ::: "memory");
          }
          __syncthreads();
          lru_carry_item(P, gridDim.x - 1 - blockIdx.x);
        }
        continue;
      }
      const int pair = (blockIdx.x & 7) + 8 * (it >> 6);
      b = pair >> 2; head = pair & 3; row0 = TC + b * SEQ + (it & 63) * 128; nk = KV; kind = 0;
    } else {
      if (it >= total) break;
      if (it < nFC) { kind = 2; }
      else if (it < nFC + nC) { it -= nFC; b = it >> 3; head = (it >> 1) & 3; row0 = b * CL + (it & 1) * 128; nk = CL; kind = 0; }
      else { kind = 1; it -= nFC + nC; }
    }
    if (kind == 0) attn_item(P, l, b, head, row0, nk, smem);
    else if (kind == 1) fftA_item(P, it, smem);
    else fftC_item(P, it, smem);
  }
}

DI void grid_barrier(unsigned* bar, unsigned k, unsigned xn, unsigned nx) {
  asm volatile("s_waitcnt vmcnt(0)" ::: "memory");
  __syncthreads();
  if (threadIdx.x == 0) {
    const unsigned x = (unsigned)__builtin_amdgcn_s_getreg((3 << 11) | 20) & 0x7u;
    unsigned* xc = bar + 16 + x * 16; unsigned* top = bar;
    const unsigned old = __hip_atomic_fetch_add(xc, 1u, __ATOMIC_RELAXED, __HIP_MEMORY_SCOPE_AGENT);
    if (old == k * xn - 1u) {
      __builtin_amdgcn_fence(__ATOMIC_RELEASE, "agent");
      asm volatile("s_waitcnt vmcnt(0)" ::: "memory");
      __hip_atomic_fetch_add(top, 1u, __ATOMIC_RELAXED, __HIP_MEMORY_SCOPE_AGENT);
    }
    while (__hip_atomic_load(top, __ATOMIC_RELAXED, __HIP_MEMORY_SCOPE_AGENT) < k * nx) __builtin_amdgcn_s_sleep(1);
    __builtin_amdgcn_fence(__ATOMIC_ACQUIRE, "agent");
    asm volatile("s_waitcnt vmcnt(0)" ::: "memory");
  }
  __syncthreads();
}
__global__ void __launch_bounds__(256, 1) fwd_megakernel(Params Pin) {
  Params P = Pin; bind_ws(P);
  __shared__ __attribute__((aligned(16))) char smem[147456 + 8192];
  __shared__ int tb[33];
  __shared__ int s_item;
  cg::grid_group grid = cg::this_grid();
  unsigned* bar = (unsigned*)(P.ws + O_bar); unsigned bk = 0;
  if (threadIdx.x == 0) __hip_atomic_fetch_add(bar + 160 + ((unsigned)__builtin_amdgcn_s_getreg((3 << 11) | 20) & 0x7u), 1u, __ATOMIC_RELAXED, __HIP_MEMORY_SCOPE_AGENT);
#ifndef PH
#define PH 0xFFFF
#endif
#if PH & 1
  phase0(P, smem);
#endif
  grid.sync();
  unsigned xn, nx = 0;
  {
    const unsigned myx = (unsigned)__builtin_amdgcn_s_getreg((3 << 11) | 20) & 0x7u;
    xn = __hip_atomic_load(bar + 160 + myx, __ATOMIC_RELAXED, __HIP_MEMORY_SCOPE_AGENT);
#pragma unroll
    for (int x = 0; x < 8; x++) nx += __hip_atomic_load(bar + 160 + x, __ATOMIC_RELAXED, __HIP_MEMORY_SCOPE_AGENT) != 0u;
  }
  for (int l = 0; l < 2; l++) {
#if PH & 2
    row1_phase(P, l == 0 ? -1 : 0, l, 0);
#endif
    grid_barrier(bar, ++bk, xn, nx);
#if PH & 4
    gemm_in_phase(P, l, smem);
#ifdef DUP_GEMM
    grid_barrier(bar, ++bk, xn, nx);
    gemm_in_phase(P, l, smem);
#endif
#endif
    grid_barrier(bar, ++bk, xn, nx);
#if PH & 8
    mix_phase(P, l, smem, &s_item, l);
#ifdef DUP_MIX
    grid_barrier(bar, ++bk, xn, nx);
    mix_phase(P, l, smem, &s_item, 2 + l);
#endif
#endif
    grid_barrier(bar, ++bk, xn, nx);
#if PH & 16
    for (int it = blockIdx.x; it < 1024; it += gridDim.x) fftB_item(P, it, smem);
#endif
#if PH & 512
    {
      const int g = blockIdx.x & 3;
      LruK K{};
      for (int u = blockIdx.x >> 2; u < NB_ * 132; u += gridDim.x >> 2) lru_tile(P, l, u / 132, u % 132, g, smem, true, K);
    }
#endif
    grid_barrier(bar, ++bk, xn, nx);
#if PH & 32
    gemm_out_phase(P, l, smem);
#endif
    grid_barrier(bar, ++bk, xn, nx);
#if PH & 64
    row2_phase(P, l, l == 0 ? 0 : TC, smem);
#endif
    grid_barrier(bar, ++bk, xn, nx);
#if PH & 128
    moe_e1_phase(P, l, smem, tb);
#ifdef DUP_GEMM
    grid_barrier(bar, ++bk, xn, nx);
    moe_e1_phase(P, l, smem, tb);
#endif
#endif
    grid_barrier(bar, ++bk, xn, nx);
#if PH & 256
    moe_e2_phase(P, l, smem, tb);
#ifdef DUP_GEMM
    grid_barrier(bar, ++bk, xn, nx);
    moe_e2_phase(P, l, smem, tb);
#endif
#endif
    grid_barrier(bar, ++bk, xn, nx);
  }
#if PH & 2
  row1_phase(P, 1, -1, TC);
#endif
}

extern "C" void kernel_launch(void* const* d_in, const int* in_sizes, int n_in, void* d_out, int out_size, void* d_ws, size_t ws_size,
                              hipStream_t stream) {
  static int grid_blocks = 0;
  if (!grid_blocks) {
    int dev = 0, cus = 0, per_cu = 0;
    hipGetDevice(&dev);
    hipDeviceGetAttribute(&cus, hipDeviceAttributeMultiprocessorCount, dev);
    hipOccupancyMaxActiveBlocksPerMultiprocessor(&per_cu, fwd_megakernel, 256, 0);
    if (per_cu > 2) per_cu = 2;
    grid_blocks = cus * per_cu;
    if (grid_blocks > 256) grid_blocks = 256;
  }
  if (grid_blocks != 256) { fprintf(stderr, "need 256 co-resident blocks, have %d\n", grid_blocks); return; }
  Params p{};
  const float** pin = (const float**)&p;
  for (int i = 0; i < 31; i++) pin[i] = (const float*)d_in[i];
  p.out = (float*)d_out;
  p.ws = (char*)d_ws;
  if (WS_NEED > ws_size) { fprintf(stderr, "workspace too small: need %zu have %zu\n", (size_t)WS_NEED, ws_size); return; }
  hipMemsetAsync((char*)d_ws + O_bar, 0, 1024, stream);
  void* args[] = {&p};
  hipError_t e = hipLaunchCooperativeKernel((void*)fwd_megakernel, dim3(grid_blocks), dim3(256), args, 0, stream);
  if (e != hipSuccess) fprintf(stderr, "cooperative launch failed: %s (grid %d)\n", hipGetErrorString(e), grid_blocks);
}
```

```cpp
#include <hip/hip_runtime.h>
#include <hip/hip_cooperative_groups.h>
#include <cstdio>
namespace cg = cooperative_groups;

typedef _Float16 half_t;
typedef _Float16 h8 __attribute__((ext_vector_type(8)));
typedef _Float16 h4 __attribute__((ext_vector_type(4)));
typedef __fp16 fp16x2 __attribute__((ext_vector_type(2)));
typedef unsigned u4 __attribute__((ext_vector_type(4)));
typedef float f4 __attribute__((ext_vector_type(4)));
typedef float f16v __attribute__((ext_vector_type(16)));
#define DI __device__ __forceinline__
__device__ __forceinline__ int tid_opaque() { int t = threadIdx.x; asm volatile("" : "+v"(t)); return t; }
#define TIDX tid_opaque()

constexpr int D = 1024, NB_ = 8, SEQ = 8192, CL = 256;
constexpr int TC = NB_ * CL;
constexpr int TX = NB_ * SEQ;
constexpr int TA = TC + TX;
constexpr int KV = CL + SEQ;
constexpr int NIN = 2560;
constexpr int LCAP = 2 * TA;
constexpr float EPS = 1e-6f;

struct Params {
  const float *x, *c, *ctx, *c_ctx, *w_mod, *b_mod, *norm1_g, *norm2_g, *w_in, *q_norm_g, *k_norm_g, *lq1, *lk1, *lq2, *lk2,
      *subln_g, *conv_w, *conv_b, *gate_a_w, *gate_a_b, *gate_x_w, *gate_x_b, *lru_lambda, *w_out, *w_group, *b_group,
      *w_router, *b_router, *w1, *w3, *w2;
  float* out; char* ws;
  half_t *WtIn, *WtOut, *Wt1, *Wt3, *Wt2;
  float* mod; float2* rope; float2* tw; half_t *DA, *DB, *DC; float* consts; int* cnt; int* qctr; float* tokW; int* list; float* listW;
  float* xcbuf; half_t* WrH;
  half_t *hx, *mix, *q, *kall, *vT, *QF, *gy, *rr; float2* lsum; float* lcar; half_t* GA; half_t *H, *yA;
};


constexpr size_t al256(size_t x) { return (x + 255) & ~(size_t)255; }
constexpr size_t O_WtIn = 0;
constexpr size_t O_WtOut = O_WtIn + al256((size_t)2 * NIN * 1024 * 2);
constexpr size_t O_Wt1 = O_WtOut + al256((size_t)2 * 1024 * 1024 * 2);
constexpr size_t O_Wt3 = O_Wt1 + al256((size_t)64 * 524288 * 2);
constexpr size_t O_Wt2 = O_Wt3 + al256((size_t)64 * 524288 * 2);
constexpr size_t O_mod = O_Wt2 + al256((size_t)64 * 524288 * 2);
constexpr size_t O_rope = O_mod + al256((size_t)2 * 9 * 6144 * 4);
constexpr size_t O_tw = O_rope + al256(128 * 16 * 8);
constexpr size_t O_DA = O_tw + al256(8192 * 8);
constexpr size_t O_DB = O_DA + al256(16384 * 2);
constexpr size_t O_DC = O_DB + al256(32768 * 2);
constexpr size_t O_consts = O_DC + al256(131072 * 2);
constexpr size_t O_cnt = O_consts + 256;
constexpr size_t O_qctr = O_cnt + 256;
constexpr size_t O_bar = O_qctr + 256;
constexpr size_t O_tokW = O_bar + 1024;
constexpr size_t O_list = O_tokW + al256((size_t)2 * TA * 4);
constexpr size_t O_listW = O_list + al256((size_t)32 * LCAP * 4);
constexpr size_t O_xcbuf = O_listW + al256((size_t)32 * LCAP * 4);
constexpr size_t O_WrT = O_xcbuf + al256((size_t)TC * D * 4);
constexpr size_t O_hx = O_WrT + al256((size_t)2 * 2 * 48 * 1024 * 2);
constexpr size_t O_mix = O_hx + al256((size_t)TA * D * 2);
constexpr size_t O_regB = O_mix + al256((size_t)TA * D * 2);
constexpr size_t O_q = O_regB;
constexpr size_t O_kall = O_q + al256((size_t)TA * 512 * 2);
constexpr size_t O_vT = O_kall + al256((size_t)NB_ * KV * 512 * 2);
constexpr size_t O_QF = O_vT + al256((size_t)NB_ * 4 * 128 * KV * 2);
constexpr size_t O_gy = O_QF + al256((size_t)TA * 512 * 2);
constexpr size_t O_rr = O_gy + al256((size_t)TA * 256 * 2);
constexpr size_t O_lsum = O_rr + al256((size_t)TA * 256 * 2);
constexpr size_t O_lcar = O_lsum + al256((size_t)16 * 132 * 256 * 8);
constexpr size_t O_GA = O_lcar + al256((size_t)16 * 132 * 256 * 4);
constexpr size_t O_mixer_end = O_GA + al256((size_t)NB_ * 64 * 256 * 256 * 2);
constexpr size_t O_H = O_regB;
constexpr size_t O_yA = O_H + al256((size_t)(2 * TA + 32 * 256) * 512 * 2);
constexpr size_t O_moe_end = O_yA + al256((size_t)2 * TA * D * 2);
constexpr size_t WS_NEED = O_mixer_end > O_moe_end ? O_mixer_end : O_moe_end;
DI void bind_ws(Params& P) {
  char* w = P.ws;
  P.WtIn = (half_t*)(w + O_WtIn); P.WtOut = (half_t*)(w + O_WtOut); P.Wt1 = (half_t*)(w + O_Wt1); P.Wt3 = (half_t*)(w + O_Wt3); P.Wt2 = (half_t*)(w + O_Wt2);
  P.mod = (float*)(w + O_mod); P.rope = (float2*)(w + O_rope); P.tw = (float2*)(w + O_tw); P.DA = (half_t*)(w + O_DA); P.DB = (half_t*)(w + O_DB); P.DC = (half_t*)(w + O_DC);
  P.consts = (float*)(w + O_consts); P.cnt = (int*)(w + O_cnt); P.qctr = (int*)(w + O_qctr); P.tokW = (float*)(w + O_tokW); P.list = (int*)(w + O_list); P.listW = (float*)(w + O_listW);
  P.xcbuf = (float*)(w + O_xcbuf); P.WrH = (half_t*)(w + O_WrT); P.hx = (half_t*)(w + O_hx); P.mix = (half_t*)(w + O_mix);
  P.q = (half_t*)(w + O_q); P.kall = (half_t*)(w + O_kall); P.vT = (half_t*)(w + O_vT); P.QF = (half_t*)(w + O_QF); P.gy = (half_t*)(w + O_gy); P.rr = (half_t*)(w + O_rr);
  P.lsum = (float2*)(w + O_lsum); P.lcar = (float*)(w + O_lcar); P.GA = (half_t*)(w + O_GA); P.H = (half_t*)(w + O_H); P.yA = (half_t*)(w + O_yA);
}
DI float shx(float v, int o) { int ln = TIDX & 63; return __builtin_bit_cast(float, __builtin_amdgcn_ds_bpermute((ln ^ o) << 2, __builtin_bit_cast(int, v))); }
DI float shi(float v, int idx) { return __builtin_bit_cast(float, __builtin_amdgcn_ds_bpermute(idx << 2, __builtin_bit_cast(int, v))); }
DI float wave_sum(float v) {
#pragma unroll
  for (int o = 32; o; o >>= 1) v += shx(v, o);
  return v;
}
DI void glds16(const void* g, void* l) {
  __builtin_amdgcn_global_load_lds((const unsigned*)g, (unsigned*)l, 16, 0, 0);
}
DI void wait_vm0() { asm volatile("s_waitcnt vmcnt(0)" ::: "memory"); }
DI f4 mfma16(h8 a, h8 b, f4 c) { return __builtin_amdgcn_mfma_f32_16x16x32_f16(a, b, c, 0, 0, 0); }
DI f16v mfma32(h8 a, h8 b, f16v c) { return __builtin_amdgcn_mfma_f32_32x32x16_f16(a, b, c, 0, 0, 0); }
DI unsigned pk2(float a, float b) { fp16x2 r = __builtin_amdgcn_cvt_pkrtz(a, b); return __builtin_bit_cast(unsigned, r); }
DI float sigmoidf_(float x) { return 1.f / (1.f + __expf(-x)); }
DI float gelu_tanh(float x) {
  float u = 0.7978845608028654f * (x + 0.044715f * x * x * x);
  float e = __expf(2.f * u);
  float t = 1.f - 2.f / (e + 1.f);
  return 0.5f * x * (1.f + t);
}
DI int row_mod(int r) { return r < TC ? 8 : ((r - TC) >> 13); }

DI void transpose_tile4(const float* src, int lds_, half_t* dst, int ldd, float* tile) {
  const int tid = TIDX;
  {
    const int k0 = tid >> 6, c4 = tid & 63;
    const float* sp = src + (size_t)k0 * lds_ + c4 * 4;
    float* tp = tile + (c4 >> 4) * 4352 + k0 * 68 + (c4 & 15) * 4;
#pragma unroll
    for (int i = 0; i < 16; i++) *(float4*)(tp + i * 4 * 68) = *(const float4*)(sp + (size_t)i * 4 * lds_);
  }
  __syncthreads();
#pragma unroll
  for (int i = 0; i < 8; i++) {
    int idx = i * 256 + tid, j = idx >> 9, r = idx & 511, kc = r >> 6, n = r & 63;
    const float* t = tile + j * 4352 + kc * 8 * 68 + n;
    h8 o;
#pragma unroll
    for (int u = 0; u < 8; u++) o[u] = (half_t)t[u * 68];
    *(h8*)(dst + (size_t)(j * 64 + n) * ldd + kc * 8) = o;
  }
  __syncthreads();
}

DI void phase0(const Params& P, char* smem) {
  float* tile = (float*)smem;
  const int tid = TIDX;
  constexpr int NT = 6528, NF = 128, NM = 192, NX = 6;
  for (int t0 = blockIdx.x; t0 < NT + NF + NM + NX; t0 += gridDim.x) {
    const int t = t0 < NF + NM + NX ? NT + t0 : t0 - (NF + NM + NX);
    if (t < NT) {
      const float* src; half_t* dst; int lds_, ldd;
      if (t < 256) {
        int l = t / 128, r = t % 128, kt = r / 8, nt = (r % 8) * 4;
        src = P.w_in + (size_t)l * 1024 * 2304 + (size_t)kt * 64 * 2304 + 256 + nt * 64; lds_ = 2304;
        dst = P.WtIn + (size_t)l * NIN * 1024 + (size_t)(512 + nt * 64) * 1024 + kt * 64; ldd = 1024;
      } else if (t < 384) {
        int u = t - 256, l = u / 64, r = u % 64, kt = r / 4, nt = (r % 4) * 4;
        src = P.w_out + (size_t)l * 1048576 + (size_t)kt * 64 * 1024 + nt * 64; lds_ = 1024;
        dst = P.WtOut + (size_t)l * 1048576 + (size_t)nt * 64 * 1024 + kt * 64; ldd = 1024;
      } else if (t < 384 + 4096) {
        int u = t - 384; const float* w = P.w1; half_t* o = P.Wt1;
        if (u >= 2048) { u -= 2048; w = P.w3; o = P.Wt3; }
        int le = u / 32, r = u % 32, kt = r / 2, nt = (r % 2) * 4;
        src = w + (size_t)le * 524288 + (size_t)kt * 64 * 512 + nt * 64; lds_ = 512;
        dst = o + (size_t)le * 524288 + (size_t)nt * 64 * 1024 + kt * 64; ldd = 1024;
      } else {
        int u = t - 384 - 4096, le = u / 32, r = u % 32, kt = r / 4, nt = (r % 4) * 4;
        src = P.w2 + (size_t)le * 524288 + (size_t)kt * 64 * 1024 + nt * 64; lds_ = 1024;
        dst = P.Wt2 + (size_t)le * 524288 + (size_t)nt * 64 * 512 + kt * 64; ldd = 512;
      }
      transpose_tile4(src, lds_, dst, ldd, tile);
    } else if (t < NT + NF) {
      int f = t - NT, l = f / 64, r = f % 64, kt = r / 4, g = r % 4;
      float* cst = tile + 64 * 65; float* snt = cst + 64;
      const float* src = P.w_in + (size_t)l * 1024 * 2304 + (size_t)kt * 64 * 2304 + g * 64;
      { int n = tid & 63, kq = tid >> 6;
        for (int i = 0; i < 16; i++) { int k = i * 4 + kq; tile[k * 65 + n] = src[(size_t)k * 2304 + n]; } }
      if (tid < 64) { float s, c; sincospif((float)tid / 32.f, &s, &c); cst[tid] = c; snt[tid] = s; }
      __syncthreads();
      int k = tid & 63, jq = tid >> 6;
      half_t* o = P.WtIn + (size_t)l * NIN * 1024 + kt * 64 + k;
      for (int jj = 0; jj < 16; jj++) {
        int j = jq * 16 + jj; float ac = 0.f, as = 0.f;
        for (int c = 0; c < 64; c++) { float v = tile[k * 65 + c]; int idx = (c * j) & 63; ac += v * cst[idx]; as += v * snt[idx]; }
        o[(size_t)(g * 64 + j) * 1024] = (half_t)(ac * 0.125f);
        o[(size_t)(256 + g * 64 + j) * 1024] = (half_t)(-as * 0.125f);
      }
      __syncthreads();
    } else if (t < NT + NF + NM) {
      int mi = t - NT - NF, l = mi / 96, col0 = (mi % 96) * 64;
      float* scond = tile; float* red = tile + 9216;
      for (int idx = tid; idx < 9216; idx += 256) {
        int n = idx >> 10, k = idx & 1023; float v = n < 8 ? P.c[n * 1024 + k] : P.c_ctx[k];
        scond[idx] = v / (1.f + expf(-v));
      }
      __syncthreads();
      int col = tid & 63, kq = tid >> 6; float acc[9];
#pragma unroll
      for (int n = 0; n < 9; n++) acc[n] = 0.f;
      const float* w = P.w_mod + ((size_t)l * 1024 + kq * 256) * 6144 + col0 + col;
#pragma unroll 16
      for (int k = 0; k < 256; k++) {
        float wv = w[(size_t)k * 6144];
#pragma unroll
        for (int n = 0; n < 9; n++) acc[n] += scond[n * 1024 + kq * 256 + k] * wv;
      }
#pragma unroll
      for (int n = 0; n < 9; n++) red[(kq * 9 + n) * 64 + col] = acc[n];
      __syncthreads();
      for (int idx = tid; idx < 576; idx += 256) {
        int n = idx / 64, cc = idx % 64;
        float s = red[(0 * 9 + n) * 64 + cc] + red[(1 * 9 + n) * 64 + cc] + red[(2 * 9 + n) * 64 + cc] + red[(3 * 9 + n) * 64 + cc];
        P.mod[(size_t)(l * 9 + n) * 6144 + col0 + cc] = s + P.b_mod[l * 6144 + col0 + cc];
      }
      __syncthreads();
    } else {
      int m = t - NT - NF - NM;
      if (m == 0) {
        for (int idx = tid; idx < 128 * 16; idx += 256) {
          int pos = idx >> 4, i = idx & 15; float f = powf(10000.f, -(float)i / 16.f); float ang = (float)pos * f;
          float s, c; sincosf(ang, &s, &c); P.rope[idx] = make_float2(c, s);
        }
      } else if (m == 1) {
        for (int j = tid; j < 8192; j += 256) { float s, c; sincospif((float)j / 4096.f, &s, &c); P.tw[j] = make_float2(c, s); }
      } else if (m == 2) {
        for (int idx = tid; idx < 16384; idx += 256) {
          int mm = idx >> 7, k = idx & 127, part = mm >> 6, f1 = mm & 63, pp = k >> 6, a = k & 63;
          float s, c; sincospif((float)((a * f1) & 63) / 32.f, &s, &c);
          float v = part == 0 ? (pp == 0 ? c : s) : (pp == 0 ? -s : c);
          P.DA[idx] = (half_t)(v * 0.125f);
        }
      } else if (m == 3) {
        for (int idx = tid; idx < 32768; idx += 256) {
          int mm = idx >> 8, k = idx & 255, part = k >> 7, bb = k & 127;
          float s, c; sincospif((float)((bb * mm) & 127) / 64.f, &s, &c);
          P.DB[idx] = (half_t)((part == 0 ? c : s) * 0.08838834764831845f);
        }
      } else if (m == 4) {
        for (int idx = tid; idx < 131072; idx += 256) {
          int mm = idx >> 9, k = idx & 511, part = k >> 8, tt = k & 255;
          float s, c; sincospif((float)((tt * mm) & 255) / 128.f, &s, &c);
          P.DC[idx] = (half_t)((part == 0 ? c : s) * 0.0625f);
        }
      } else {
        for (int idx = tid; idx < 2 * 48 * 1024; idx += 256) {
          int l = idx / 49152, r = idx % 49152, col = r >> 10, k = r & 1023;
          float w = col < 4 ? P.w_group[((size_t)l * 1024 + k) * 4 + col] : (col < 36 ? P.w_router[((size_t)l * 1024 + k) * 32 + col - 4] : 0.f);
          half_t hi = (half_t)w, lo = (half_t)(w - (float)hi);
          P.WrH[(size_t)(l * 2) * 49152 + r] = hi; P.WrH[(size_t)(l * 2 + 1) * 49152 + r] = lo;
        }
        if (tid < 2) {
          int l = tid; float s1 = 0.f, s2 = 0.f, mq = 0.f, mk = 0.f;
          for (int i = 0; i < 64; i++) {
            s1 += P.lq1[l * 64 + i] * P.lk1[l * 64 + i]; s2 += P.lq2[l * 64 + i] * P.lk2[l * 64 + i];
            mq = fmaxf(mq, fabsf(P.q_norm_g[l * 64 + i])); mk = fmaxf(mk, fabsf(P.k_norm_g[l * 64 + i]));
          }
          float lam_init = 0.8f - 0.6f * expf(-0.3f * (float)l);
          P.consts[l * 4 + 0] = expf(s1) - expf(s2) + lam_init;
          P.consts[l * 4 + 1] = 8.f * mq * mk * 1.4426950408889634f * 1.002f - 15.f;
          P.consts[l * 4 + 2] = lam_init;
        }
        if (tid < 64) P.cnt[tid] = 0;
        if (tid < 64) P.qctr[tid] = 0;
      }
    }
  }
}

DI void row1_phase(const Params& P, int combine_l, int norm_l, int r_begin) {
  const int lane = TIDX & 63, gw = blockIdx.x * 4 + (TIDX >> 6), nw = gridDim.x * 4;
  auto load_row = [&](int r, float4 (&xv)[4], h4 (&ya)[4], h4 (&yb)[4]) {
    if (combine_l < 0) {
      const float* src = r < TC ? P.ctx + (size_t)r * D : P.x + (size_t)(r - TC) * D;
#pragma unroll
      for (int i = 0; i < 4; i++) xv[i] = *(const float4*)(src + i * 256 + lane * 4);
    } else {
      const float* xm = r < TC ? P.xcbuf + (size_t)r * D : P.out + (size_t)(r - TC) * D;
      const half_t* y0 = P.yA + (size_t)(2 * r) * D; const half_t* y1 = y0 + D;
#pragma unroll
      for (int i = 0; i < 4; i++) { int c = i * 256 + lane * 4; xv[i] = *(const float4*)(xm + c); ya[i] = *(const h4*)(y0 + c); yb[i] = *(const h4*)(y1 + c); }
    }
  };
  auto process = [&](int r, float4 (&xv)[4], h4 (&ya)[4], h4 (&yb)[4]) {
    const int n = row_mod(r);
    if (combine_l >= 0) {
      float* xm = r < TC ? P.xcbuf + (size_t)r * D : P.out + (size_t)(r - TC) * D;
      const float* g2 = P.mod + (size_t)(combine_l * 9 + n) * 6144 + 5 * 1024;
#pragma unroll
      for (int i = 0; i < 4; i++) {
        int c = i * 256 + lane * 4;
        float4 g = *(const float4*)(g2 + c); float4 t = xv[i];
        t.x += g.x * ((float)ya[i][0] + (float)yb[i][0]); t.y += g.y * ((float)ya[i][1] + (float)yb[i][1]);
        t.z += g.z * ((float)ya[i][2] + (float)yb[i][2]); t.w += g.w * ((float)ya[i][3] + (float)yb[i][3]);
        *(float4*)(xm + c) = t; xv[i] = t;
      }
    }
    if (norm_l >= 0) {
      float ss = 0.f;
#pragma unroll
      for (int i = 0; i < 4; i++) ss += xv[i].x * xv[i].x + xv[i].y * xv[i].y + xv[i].z * xv[i].z + xv[i].w * xv[i].w;
      ss = wave_sum(ss);
      const float rstd = rsqrtf(ss * (1.f / 1024.f) + EPS);
      const float* g = P.norm1_g + norm_l * 1024;
      const float* sh = P.mod + (size_t)(norm_l * 9 + n) * 6144; const float* sc = sh + 1024;
#pragma unroll
      for (int i = 0; i < 4; i++) {
        int c = i * 256 + lane * 4;
        float4 gg = *(const float4*)(g + c), s1 = *(const float4*)(sc + c), s0 = *(const float4*)(sh + c);
        h4 o;
        o[0] = (half_t)(xv[i].x * rstd * gg.x * (1.f + s1.x) + s0.x); o[1] = (half_t)(xv[i].y * rstd * gg.y * (1.f + s1.y) + s0.y);
        o[2] = (half_t)(xv[i].z * rstd * gg.z * (1.f + s1.z) + s0.z); o[3] = (half_t)(xv[i].w * rstd * gg.w * (1.f + s1.w) + s0.w);
        *(h4*)(P.hx + (size_t)r * D + c) = o;
      }
    }
  };
  const int nrows = TA - r_begin;
  const int r_lo = r_begin + (int)(((long long)gw * nrows) / nw), r_hi = r_begin + (int)(((long long)(gw + 1) * nrows) / nw);
#pragma unroll 1
  for (int r = r_lo; r < r_hi; r += 4) {
    float4 x0[4], x1[4], x2[4], x3[4]; h4 a0[4], b0[4], a1[4], b1[4], a2[4], b2[4], a3[4], b3[4];
    const int r1 = r + 1, r2 = r + 2, r3 = r + 3;
    load_row(r, x0, a0, b0);
    if (r1 < r_hi) load_row(r1, x1, a1, b1);
    if (r2 < r_hi) load_row(r2, x2, a2, b2);
    if (r3 < r_hi) load_row(r3, x3, a3, b3);
    process(r, x0, a0, b0);
    if (r1 < r_hi) process(r1, x1, a1, b1);
    if (r2 < r_hi) process(r2, x2, a2, b2);
    if (r3 < r_hi) process(r3, x3, a3, b3);
  }
}

DI void row2_phase(const Params& P, int l, int r_begin, char* smem) {
  const int tid = TIDX, lane = tid & 63, wave = tid >> 6, fr = lane & 15, fq = lane >> 4;
  float* lg = (float*)smem + wave * 16 * 48;
  const half_t* Whi = P.WrH + (size_t)(l * 2) * 49152; const half_t* Wlo = Whi + 49152;
  const int ngroups = (TA - r_begin) >> 4, gw = blockIdx.x * 4 + wave, nw = gridDim.x * 4;
  const float* gam = P.norm2_g + l * 1024;
  const int gper = (ngroups + nw - 1) / nw;
#pragma unroll 1
  for (int grp = gw * gper; grp < min((gw + 1) * gper, ngroups); grp++) {
    const int r0 = r_begin + grp * 16, row = r0 + fr, n = row_mod(r0);
    const float* xm = (row < TC ? P.xcbuf + (size_t)row * D : P.out + (size_t)(row - TC) * D) + fq * 8;
    float ss = 0.f;
#pragma unroll 16
    for (int kk = 0; kk < 32; kk++) {
      const float4 a = *(const float4*)(xm + kk * 32), b = *(const float4*)(xm + kk * 32 + 4);
      ss += a.x * a.x + a.y * a.y + a.z * a.z + a.w * a.w + b.x * b.x + b.y * b.y + b.z * b.z + b.w * b.w;
    }
    ss += shx(ss, 16); ss += shx(ss, 32);
    const float rstd = rsqrtf(ss * (1.f / 1024.f) + EPS);
    const float* sh = P.mod + (size_t)(l * 9 + n) * 6144 + 3 * 1024 + fq * 8; const float* sc = sh + 1024;
    f4 acc[3];
#pragma unroll
    for (int i = 0; i < 3; i++) acc[i] = (f4){0.f, 0.f, 0.f, 0.f};
    half_t* hxo = P.hx + (size_t)row * D + fq * 8;
#pragma unroll 4
    for (int kk = 0; kk < 32; kk++) {
      const int k0 = kk * 32;
      float x[8], g[8], s1[8], s0[8];
      *(float4*)&x[0] = *(const float4*)(xm + k0); *(float4*)&x[4] = *(const float4*)(xm + k0 + 4);
      *(float4*)&g[0] = *(const float4*)(gam + fq * 8 + k0); *(float4*)&g[4] = *(const float4*)(gam + fq * 8 + k0 + 4);
      *(float4*)&s1[0] = *(const float4*)(sc + k0); *(float4*)&s1[4] = *(const float4*)(sc + k0 + 4);
      *(float4*)&s0[0] = *(const float4*)(sh + k0); *(float4*)&s0[4] = *(const float4*)(sh + k0 + 4);
      h8 hi, lo;
#pragma unroll
      for (int i = 0; i < 8; i++) {
        float v = x[i] * rstd * g[i] * (1.f + s1[i]) + s0[i];
        hi[i] = (half_t)v; lo[i] = (half_t)(v - (float)hi[i]);
      }
      *(h8*)(hxo + k0) = hi;
#pragma unroll
      for (int n3 = 0; n3 < 3; n3++) {
        h8 bh = *(const h8*)(Whi + (size_t)(n3 * 16 + fr) * 1024 + k0 + fq * 8);
        h8 bl = *(const h8*)(Wlo + (size_t)(n3 * 16 + fr) * 1024 + k0 + fq * 8);
        acc[n3] = mfma16(hi, bh, acc[n3]); acc[n3] = mfma16(lo, bh, acc[n3]); acc[n3] = mfma16(hi, bl, acc[n3]);
      }
    }
    __builtin_amdgcn_wave_barrier();
#pragma unroll
    for (int n3 = 0; n3 < 3; n3++)
#pragma unroll
      for (int j = 0; j < 4; j++) lg[(fq * 4 + j) * 48 + n3 * 16 + fr] = acc[n3][j];
    __builtin_amdgcn_wave_barrier();
    if (lane < 16) {
      const int r = r0 + lane;
      const float* L = lg + lane * 48;
      float gl[4]; int gi = 0;
#pragma unroll
      for (int j = 0; j < 4; j++) gl[j] = L[j] + P.b_group[l * 4 + j];
      float gm = gl[0];
#pragma unroll
      for (int j = 1; j < 4; j++) if (gl[j] > gm) { gm = gl[j]; gi = j; }
      float gs = 0.f;
#pragma unroll
      for (int j = 0; j < 4; j++) gs += expf(gl[j] - gm);
      const float pg = 1.f / gs;
      float el[8];
#pragma unroll
      for (int j = 0; j < 8; j++) el[j] = L[4 + gi * 8 + j] + P.b_router[l * 32 + gi * 8 + j];
      int i0 = 0; float v0 = el[0];
#pragma unroll
      for (int j = 1; j < 8; j++) if (el[j] > v0) { v0 = el[j]; i0 = j; }
      int i1 = -1; float v1 = -3.0e38f;
#pragma unroll
      for (int j = 0; j < 8; j++) if (j != i0 && el[j] > v1) { v1 = el[j]; i1 = j; }
      const float ex = expf(v1 - v0);
      const float w0 = pg / (1.f + ex), w1 = pg * ex / (1.f + ex);
      const int e0 = gi * 8 + i0, e1 = gi * 8 + i1;
      int p0 = atomicAdd(&P.cnt[l * 32 + e0], 1); P.list[(size_t)e0 * LCAP + p0] = 2 * r; P.listW[(size_t)e0 * LCAP + p0] = w0;
      int p1 = atomicAdd(&P.cnt[l * 32 + e1], 1); P.list[(size_t)e1 * LCAP + p1] = 2 * r + 1; P.listW[(size_t)e1 * LCAP + p1] = w1;
    }
    __builtin_amdgcn_wave_barrier();
  }
}

DI h8 lds128(unsigned a) { h8 r; asm volatile("ds_read_b128 %0, %1" : "=v"(r) : "v"(a)); return r; }
DI void tie(h8& x) { asm volatile("" : "+v"(x)); }
DI unsigned lds_addr(const void* p) { return (unsigned)(size_t)p; }
#define WAIT_LGKM(n) asm volatile("s_waitcnt lgkmcnt(" #n ")" ::: "memory")
DI void raw_barrier() { asm volatile("" ::: "memory"); __builtin_amdgcn_s_barrier(); asm volatile("" ::: "memory"); }
DI void slot_rc(int i, int& row, int& coff) { int s = i * 256 + TIDX; row = s >> 3; coff = ((s & 7) ^ ((row >> 1) & 7)) * 8; }

template <class AF, class BF>
DI void gemm_prologue(AF aptr, BF bptr, int nk, char* smem) {
  const int tid = TIDX;
#pragma unroll
  for (int st = 0; st < 2; st++) {
    if (st < nk) {
      char* d = smem + st * 49152 + tid * 16;
#pragma unroll
      for (int i = 0; i < 8; i++) glds16(aptr(i) + st * 64, d + i * 4096);
#pragma unroll
      for (int i = 0; i < 4; i++) glds16(bptr(i) + st * 64, d + 32768 + i * 4096);
    }
  }
}
template <bool PRE = false, class AF, class BF>
DI void gemm256(AF aptr, BF bptr, int nk, char* smem, f4 (&acc)[8][4]) {
  const int tid = TIDX, lane = tid & 63, wave = tid >> 6, fr = lane & 15, fq = lane >> 4, wr = wave >> 1, wc = wave & 1;
#pragma unroll
  for (int m = 0; m < 8; m++)
#pragma unroll
    for (int n = 0; n < 4; n++) acc[m][n] = (f4){0.f, 0.f, 0.f, 0.f};
  auto issue = [&](int kt, int st) {
    char* d = smem + st * 49152 + tid * 16;
#pragma unroll
    for (int i = 0; i < 8; i++) glds16(aptr(i) + kt * 64, d + i * 4096);
#pragma unroll
    for (int i = 0; i < 4; i++) glds16(bptr(i) + kt * 64, d + 32768 + i * 4096);
  };
  const unsigned sw = (unsigned)((fq ^ (fr >> 1)) << 4);
  const unsigned offA = (wr * 128 + fr) * 128 + sw, offB = 32768 + (wc * 64 + fr) * 128 + sw;
  const unsigned sbase = lds_addr(smem);
  if (!PRE) { issue(0, 0); if (nk > 1) issue(1, 1); }
  int st = 0;
#pragma unroll 1
  for (int kt = 0; kt < nk; kt++) {
    if (kt + 1 < nk) asm volatile("s_waitcnt vmcnt(12)" ::: "memory"); else wait_vm0();
    raw_barrier();
    if (kt + 2 < nk) issue(kt + 2, st == 0 ? 2 : st - 1);
    const unsigned base = sbase + st * 49152;
    st = st == 2 ? 0 : st + 1;
    h8 a0[8], b0[4], a1[8], b1[4];
#pragma unroll
    for (int m = 0; m < 8; m++) a0[m] = lds128(base + offA + m * 2048);
#pragma unroll
    for (int n = 0; n < 4; n++) b0[n] = lds128(base + offB + n * 2048);
    WAIT_LGKM(0);
#pragma unroll
    for (int m = 0; m < 8; m++) tie(a0[m]);
#pragma unroll
    for (int n = 0; n < 4; n++) tie(b0[n]);
#pragma unroll
    for (int m = 0; m < 8; m++) a1[m] = lds128(base + (offA ^ 64) + m * 2048);
#pragma unroll
    for (int n = 0; n < 4; n++) b1[n] = lds128(base + (offB ^ 64) + n * 2048);
#pragma unroll
    for (int m = 0; m < 8; m++)
#pragma unroll
      for (int n = 0; n < 4; n++) acc[m][n] = mfma16(a0[m], b0[n], acc[m][n]);
    WAIT_LGKM(0);
#pragma unroll
    for (int m = 0; m < 8; m++) tie(a1[m]);
#pragma unroll
    for (int n = 0; n < 4; n++) tie(b1[n]);
#pragma unroll
    for (int m = 0; m < 8; m++)
#pragma unroll
      for (int n = 0; n < 4; n++) acc[m][n] = mfma16(a1[m], b1[n], acc[m][n]);
  }
  raw_barrier();
}
DI bool xcd_tile(int it, int MT, int NT, int& mt, int& nt) {
  const int x = blockIdx.x & 7, j = blockIdx.x >> 3;
  const int nsn = NT >> 2, nsm = (MT + 7) >> 3;
  const int s = x + 8 * it;
  if (s >= nsm * nsn) return false;
  const int sm = s / nsn, sn = s % nsn;
  mt = sm * 8 + (j >> 2); nt = sn * 4 + (j & 3);
  return true;
}
DI bool next_tile(int& it, int MT, int NT, int& mt, int& nt) {
  for (;; it++) {
    if (!xcd_tile(it, MT, NT, mt, nt)) return false;
    if (mt < MT) return true;
  }
}
DI int slot_col() { int t = TIDX; return ((t & 7) ^ ((t >> 4) & 7)) * 8; }

DI float dpp_row_sum(float v) {
  v += __builtin_bit_cast(float, __builtin_amdgcn_update_dpp(0, __builtin_bit_cast(int, v), 0x128, 0xf, 0xf, false));
  v += __builtin_bit_cast(float, __builtin_amdgcn_update_dpp(0, __builtin_bit_cast(int, v), 0x124, 0xf, 0xf, false));
  v += __builtin_bit_cast(float, __builtin_amdgcn_update_dpp(0, __builtin_bit_cast(int, v), 0x122, 0xf, 0xf, false));
  v += __builtin_bit_cast(float, __builtin_amdgcn_update_dpp(0, __builtin_bit_cast(int, v), 0x121, 0xf, 0xf, false));
  return v;
}
DI void stage_put(char* stg, int ml, int n, int j, int fr, int fq, float v) { *(half_t*)(stg + (ml * 16 + fq * 4 + j) * 144 + (n * 16 + fr) * 2) = (half_t)v; }
template <class RP, class SC>
DI void stage_flush(char* stg, int h, RP rowptr, SC rowscale) {
  const int lane = TIDX & 63;
  __builtin_amdgcn_wave_barrier();
#pragma unroll
  for (int i = 0; i < 8; i++) {
    const int c = i * 64 + lane, row = c >> 3, c16 = c & 7;
    h8 v = *(const h8*)(stg + row * 144 + c16 * 16);
    half_t* d = rowptr(h * 64 + row);
    if (d) { rowscale(h * 64 + row, v); *(h8*)(d + c16 * 8) = v; }
  }
  __builtin_amdgcn_wave_barrier();
}
template <class VF, class RP, class SC>
DI void wave_store_tile(VF val, char* stg, RP rowptr, SC rowscale) {
  const int lane = TIDX & 63, fr = lane & 15, fq = lane >> 4;
#pragma unroll
  for (int h = 0; h < 2; h++) {
#pragma unroll
    for (int ml = 0; ml < 4; ml++)
#pragma unroll
      for (int n = 0; n < 4; n++)
#pragma unroll
        for (int j = 0; j < 4; j++) stage_put(stg, ml, n, j, fr, fq, val(h * 4 + ml, n, j));
    stage_flush(stg, h, rowptr, rowscale);
  }
}
DI void gemm_in_phase(const Params& P, int l, char* smem) {
  const int tid = TIDX;
  const half_t* Wt = P.WtIn + (size_t)l * NIN * 1024;
  const int sc = slot_col(), srow = tid >> 3;
  {
    float2* rcl = (float2*)(smem + 147456);
    for (int i = tid; i < 1024; i += 256) rcl[i] = P.rope[i];
    __syncthreads();
  }
  int it = 0, mt, nt;
  bool have = next_tile(it, 264, 20, mt, nt);
  const half_t* a0 = nullptr; const half_t* b0 = nullptr;
  if (have) {
    asm volatile("" : "+s"(mt), "+s"(nt));
    a0 = P.hx + (size_t)(mt * 256 + srow) * D + sc; b0 = Wt + (size_t)(nt * 128 + srow) * D + sc;
    gemm_prologue([&](int i) { return a0 + (size_t)i * 32 * D; }, [&](int i) { return b0 + (size_t)i * 32 * D; }, 16, smem);
  }
#pragma unroll 1
  while (have) {
    f4 acc[8][4];
    gemm256<true>([&](int i) { return a0 + (size_t)i * 32 * D; }, [&](int i) { return b0 + (size_t)i * 32 * D; }, 16, smem, acc);
    const int tid2 = TIDX, lane = tid2 & 63, wave = tid2 >> 6, fr = lane & 15, fq = lane >> 4, wr = wave >> 1, wc = wave & 1;
    const int r0 = mt * 256 + wr * 128;
    const bool isctx = r0 < TC;
    int b, pos0;
    if (isctx) { b = r0 >> 8; pos0 = r0 & 255; } else { b = (r0 - TC) >> 13; pos0 = 256 + ((r0 - TC) & 8191); }
    const bool isqk = nt >= 4 && nt < 12;
    float gg[4] = {0.f, 0.f, 0.f, 0.f}; float2 rr2[2] = {make_float2(1.f, 0.f), make_float2(1.f, 0.f)};
    if (isqk) {
      const float* gvec = (nt < 8 ? P.q_norm_g : P.k_norm_g) + l * 64;
      const float qs = nt < 8 ? 0.125f * 1.4426950408889634f : 1.f;
#pragma unroll
      for (int n = 0; n < 4; n++) gg[n] = gvec[n * 16 + fr] * qs;
      if (!isctx) { const int tp0 = pos0 - 256; rr2[0] = P.rope[(tp0 >> 6) * 16 + fr]; rr2[1] = P.rope[((tp0 >> 6) + 1) * 16 + fr]; }
    }
#pragma unroll
    for (int n = 0; n < 4; n++) asm volatile("" : "+v"(gg[n]));
    asm volatile("" : "+v"(rr2[0].x), "+v"(rr2[0].y), "+v"(rr2[1].x), "+v"(rr2[1].y));
    int it2 = it + 1, mt2, nt2;
    const bool have2 = next_tile(it2, 264, 20, mt2, nt2);
    const half_t* a1 = a0; const half_t* b1 = b0;
    if (have2) {
      asm volatile("" : "+s"(mt2), "+s"(nt2));
      a1 = P.hx + (size_t)(mt2 * 256 + srow) * D + sc; b1 = Wt + (size_t)(nt2 * 128 + srow) * D + sc;
      gemm_prologue([&](int i) { return a1 + (size_t)i * 32 * D; }, [&](int i) { return b1 + (size_t)i * 32 * D; }, 16, smem);
    }
    char* stg = smem + 98304 + wave * 12288;
    auto noscale = [](int, h8&) {};
    if (nt < 4 || nt >= 16) {
      half_t* dst; int ld, c0; bool gel = false;
      if (nt < 4) { dst = P.QF; ld = 512; c0 = nt * 128; }
      else if (nt < 18) { dst = P.gy; ld = 256; c0 = (nt - 16) * 128; gel = true; }
      else { dst = P.rr; ld = 256; c0 = (nt - 18) * 128; }
      half_t* base = dst + (size_t)r0 * ld + c0 + wc * 64;
      if (gel) wave_store_tile([&](int m, int n, int j) { return gelu_tanh(acc[m][n][j]); }, stg, [&](int r) { return base + (size_t)r * ld; }, noscale);
      else wave_store_tile([&](int m, int n, int j) { return acc[m][n][j]; }, stg, [&](int r) { return base + (size_t)r * ld; }, noscale);
    } else if (nt < 12) {
      const bool isq = nt < 8; const int head = isq ? nt - 4 : nt - 8;
      const float2* rcl = (const float2*)(smem + 147456);
      half_t* base = (isq ? P.q + (size_t)r0 * 512 : P.kall + ((size_t)b * KV + pos0) * 512) + head * 128 + wc * 64;
#pragma unroll
      for (int mh = 0; mh < 2; mh++) {
#pragma unroll
        for (int mm = 0; mm < 4; mm++) {
          const int m = mh * 4 + mm;
#pragma unroll
          for (int j = 0; j < 4; j++) {
            float ss = 0.f;
#pragma unroll
            for (int n = 0; n < 4; n++) ss += acc[m][n][j] * acc[m][n][j];
            ss = dpp_row_sum(ss);
            const float rstd = rsqrtf(ss * (1.f / 64.f) + EPS);
            float o[4];
#pragma unroll
            for (int n = 0; n < 4; n++) o[n] = acc[m][n][j] * rstd * gg[n];
            if (!isctx) {
              const float2 cr = rr2[mh], cc = rcl[(mm * 16 + fq * 4 + j) * 16 + fr];
              float a0 = o[0] * cr.x - o[1] * cr.y, a1 = o[1] * cr.x + o[0] * cr.y;
              float a2 = o[2] * cc.x - o[3] * cc.y, a3 = o[3] * cc.x + o[2] * cc.y;
              o[0] = a0; o[1] = a1; o[2] = a2; o[3] = a3;
            }
#pragma unroll
            for (int n = 0; n < 4; n++) stage_put(stg, mm, n, j, fr, fq, o[n]);
          }
        }
        stage_flush(stg, mh, [&](int r) { return base + (size_t)r * 512; }, noscale);
      }
    } else {
      const int head = nt - 12;
      half_t* vbase = P.vT + ((size_t)(b * 4 + head) * 128 + wc * 64) * KV + pos0;
#pragma unroll
      for (int h = 0; h < 2; h++) {
#pragma unroll
        for (int ml = 0; ml < 4; ml++)
#pragma unroll
          for (int n = 0; n < 4; n++) {
            h4 o; o[0] = (half_t)acc[h * 4 + ml][n][0]; o[1] = (half_t)acc[h * 4 + ml][n][1]; o[2] = (half_t)acc[h * 4 + ml][n][2]; o[3] = (half_t)acc[h * 4 + ml][n][3];
            *(h4*)(stg + (n * 16 + fr) * 144 + (ml * 16 + fq * 4) * 2) = o;
          }
        __builtin_amdgcn_wave_barrier();
#pragma unroll
        for (int i = 0; i < 8; i++) {
          const int c = i * 64 + lane, drow = c >> 3, c16 = c & 7;
          h8 v = *(const h8*)(stg + drow * 144 + c16 * 16);
          *(h8*)(vbase + (size_t)drow * KV + h * 64 + c16 * 8) = v;
        }
        __builtin_amdgcn_wave_barrier();
      }
    }
    mt = mt2; nt = nt2; it = it2; have = have2; a0 = a1; b0 = b1;
  }
}

DI void gemm_out_phase(const Params& P, int l, char* smem) {
  const int tid = TIDX;
  const half_t* Wt = P.WtOut + (size_t)l * 1048576;
  const int mt0 = l == 0 ? 0 : TC / 256;
  const int MT = 264 - mt0;
  const int sc = slot_col(), srow = tid >> 3;
  int it = 0, mt, nt;
  bool have = next_tile(it, MT, 8, mt, nt);
  const half_t* a0 = nullptr; const half_t* b0 = nullptr;
  if (have) {
    asm volatile("" : "+s"(mt), "+s"(nt));
    a0 = P.mix + (size_t)((mt + mt0) * 256 + srow) * D + sc; b0 = Wt + (size_t)(nt * 128 + srow) * D + sc;
    gemm_prologue([&](int i) { return a0 + (size_t)i * 32 * D; }, [&](int i) { return b0 + (size_t)i * 32 * D; }, 16, smem);
  }
#pragma unroll 1
  while (have) {
    f4 acc[8][4];
    gemm256<true>([&](int i) { return a0 + (size_t)i * 32 * D; }, [&](int i) { return b0 + (size_t)i * 32 * D; }, 16, smem, acc);
    const int tid2 = TIDX, lane2 = tid2 & 63, wave2 = tid2 >> 6, fr2 = lane2 & 15, fq2 = lane2 >> 4, wr2 = wave2 >> 1, wc2 = wave2 & 1;
    const int r0 = (mt + mt0) * 256 + wr2 * 128;
    const int n = row_mod(r0);
    const int cbase = nt * 128 + wc2 * 64;
    const float* res; float* dst;
    if (r0 < TC) { res = P.ctx + (size_t)r0 * D; dst = P.xcbuf + (size_t)r0 * D; }
    else { dst = P.out + (size_t)(r0 - TC) * D; res = l == 0 ? P.x + (size_t)(r0 - TC) * D : dst; }
    res += cbase + fr2 * 4; dst += cbase + fr2 * 4;
    const float4 g4 = *(const float4*)(P.mod + (size_t)(l * 9 + n) * 6144 + 2 * 1024 + cbase + fr2 * 4);
    float4 rres[4][8];
#pragma unroll
    for (int q = 0; q < 4; q++)
#pragma unroll
      for (int i = 0; i < 8; i++) rres[q][i] = *(const float4*)(res + (size_t)(q * 32 + i * 4 + fq2) * D);
    int it2 = it + 1, mt2, nt2;
    const bool have2 = next_tile(it2, MT, 8, mt2, nt2);
    const half_t* a1 = a0; const half_t* b1 = b0;
    if (have2) {
      asm volatile("" : "+s"(mt2), "+s"(nt2));
      a1 = P.mix + (size_t)((mt2 + mt0) * 256 + srow) * D + sc; b1 = Wt + (size_t)(nt2 * 128 + srow) * D + sc;
      gemm_prologue([&](int i) { return a1 + (size_t)i * 32 * D; }, [&](int i) { return b1 + (size_t)i * 32 * D; }, 16, smem);
    }
    {
      float* stg = (float*)(smem + 98304 + wave2 * 12288);
#pragma unroll
      for (int q = 0; q < 4; q++) {
#pragma unroll
        for (int ml = 0; ml < 2; ml++)
#pragma unroll
          for (int nn = 0; nn < 4; nn++)
#pragma unroll
            for (int j = 0; j < 4; j++) stg[(ml * 16 + fq2 * 4 + j) * 68 + nn * 16 + fr2] = acc[q * 2 + ml][nn][j];
        __builtin_amdgcn_wave_barrier();
#pragma unroll
        for (int i = 0; i < 8; i++) {
          const int row = i * 4 + fq2;
          const float4 a = *(const float4*)(stg + row * 68 + fr2 * 4);
          float4 r = rres[q][i];
          r.x += g4.x * a.x; r.y += g4.y * a.y; r.z += g4.z * a.z; r.w += g4.w * a.w;
          *(float4*)(dst + (size_t)(q * 32 + row) * D) = r;
        }
        __builtin_amdgcn_wave_barrier();
      }
    }
    mt = mt2; nt = nt2; it = it2; have = have2; a0 = a1; b0 = b1;
  }
}

DI void moe_prefix(const Params& P, int l, int* tb) {
  __syncthreads();
  if (TIDX == 0) { int s = 0; for (int e = 0; e < 32; e++) { tb[e] = s; s += (P.cnt[l * 32 + e] + 255) >> 8; } tb[32] = s; }
  __syncthreads();
}
DI void moe_e1_phase(const Params& P, int l, char* smem, int* tb) {
  const int tid = TIDX;
  moe_prefix(P, l, tb);
  const int sc = slot_col(), srow = tid >> 3;
  const int MT = tb[32];
  auto setup = [&](int rt, int nt, int (&tok)[8], const half_t*& w1, const half_t*& w3) {
    int e = 0;
    while (tb[e + 1] <= rt) e++;
    const int rl = rt - tb[e], cnt = P.cnt[l * 32 + e];
    const int* lst = P.list + (size_t)e * LCAP;
    w1 = P.Wt1 + ((size_t)(l * 32 + e) * 512 + nt * 64) * 1024 + sc;
    w3 = P.Wt3 + ((size_t)(l * 32 + e) * 512 + nt * 64) * 1024 + sc;
#pragma unroll
    for (int i = 0; i < 8; i++) tok[i] = lst[min(rl * 256 + i * 32 + srow, cnt - 1)] >> 1;
  };
  int it = 0, rt, nt;
  bool have = next_tile(it, MT, 8, rt, nt);
  int tok[8]; const half_t* w1 = nullptr; const half_t* w3 = nullptr;
  if (have) {
    asm volatile("" : "+s"(rt), "+s"(nt));
    setup(rt, nt, tok, w1, w3);
    gemm_prologue([&](int i) { return P.hx + (size_t)tok[i] * D + sc; }, [&](int i) { return ((i & 1) ? w3 : w1) + (size_t)((i >> 1) * 32 + srow) * 1024; }, 16, smem);
  }
#pragma unroll 1
  while (have) {
    int it2 = it + 1, rt2, nt2;
    const bool have2 = next_tile(it2, MT, 8, rt2, nt2);
    int tok2[8]; const half_t* w1n = w1; const half_t* w3n = w3;
#pragma unroll
    for (int i = 0; i < 8; i++) tok2[i] = tok[i];
    if (have2) {
      asm volatile("" : "+s"(rt2), "+s"(nt2));
      setup(rt2, nt2, tok2, w1n, w3n);
    }
    f4 acc[8][4];
    gemm256<true>([&](int i) { return P.hx + (size_t)tok[i] * D + sc; },
                  [&](int i) { return ((i & 1) ? w3 : w1) + (size_t)((i >> 1) * 32 + srow) * 1024; }, 16, smem, acc);
    if (have2) {
      gemm_prologue([&](int i) { return P.hx + (size_t)tok2[i] * D + sc; }, [&](int i) { return ((i & 1) ? w3n : w1n) + (size_t)((i >> 1) * 32 + srow) * 1024; }, 16, smem);
    }
    {
      const int tid2 = TIDX, lane2 = tid2 & 63, wave2 = tid2 >> 6, fr2 = lane2 & 15, fq2 = lane2 >> 4, wr2 = wave2 >> 1, wc2 = wave2 & 1;
      char* stg = smem + 98304 + wave2 * 12288;
      half_t* Hd = P.H + ((size_t)rt * 256 + wr2 * 128) * 512 + nt * 64 + wc2 * 32;
#pragma unroll
      for (int h = 0; h < 2; h++) {
#pragma unroll
        for (int ml = 0; ml < 4; ml++)
#pragma unroll
          for (int n = 0; n < 2; n++)
#pragma unroll
            for (int j = 0; j < 4; j++) {
              float a1 = acc[h * 4 + ml][n][j], a3 = acc[h * 4 + ml][n + 2][j];
              *(half_t*)(stg + (ml * 16 + fq2 * 4 + j) * 80 + (n * 16 + fr2) * 2) = (half_t)(a1 * sigmoidf_(a1) * a3);
            }
        __builtin_amdgcn_wave_barrier();
#pragma unroll
        for (int i = 0; i < 4; i++) {
          const int c = i * 64 + lane2, row = c >> 2, c16 = c & 3;
          h8 v = *(const h8*)(stg + row * 80 + c16 * 16);
          *(h8*)(Hd + (size_t)(h * 64 + row) * 512 + c16 * 8) = v;
        }
        __builtin_amdgcn_wave_barrier();
      }
    }
    rt = rt2; nt = nt2; it = it2; have = have2; w1 = w1n; w3 = w3n;
#pragma unroll
    for (int i = 0; i < 8; i++) tok[i] = tok2[i];
  }
}
DI void moe_e2_phase(const Params& P, int l, char* smem, int* tb) {
  const int tid = TIDX;
  moe_prefix(P, l, tb);
  const int sc = slot_col(), srow = tid >> 3;
  const int MT = tb[32];
  auto ptrs = [&](int rt, int nt, const half_t*& a0, const half_t*& b0) {
    int e = 0;
    while (tb[e + 1] <= rt) e++;
    a0 = P.H + ((size_t)rt * 256 + srow) * 512 + sc;
    b0 = P.Wt2 + ((size_t)(l * 32 + e) * 1024 + nt * 128 + srow) * 512 + sc;
  };
  int it = 0, rt, nt;
  bool have = next_tile(it, MT, 8, rt, nt);
  const half_t* a0 = nullptr; const half_t* b0 = nullptr;
  if (have) {
    asm volatile("" : "+s"(rt), "+s"(nt));
    ptrs(rt, nt, a0, b0);
    gemm_prologue([&](int i) { return a0 + (size_t)i * 32 * 512; }, [&](int i) { return b0 + (size_t)i * 32 * 512; }, 8, smem);
  }
#pragma unroll 1
  while (have) {
    const int tid2 = TIDX, lane2 = tid2 & 63, wave2 = tid2 >> 6, wr2 = wave2 >> 1, wc2 = wave2 & 1;
    int e = 0;
    while (tb[e + 1] <= rt) e++;
    const int rl = rt - tb[e], cnt = P.cnt[l * 32 + e];
    const int* lst = P.list + (size_t)e * LCAP; const float* lstw = P.listW + (size_t)e * LCAP;
    int aa[2][8]; float ww[2][8];
#pragma unroll
    for (int h = 0; h < 2; h++)
#pragma unroll
      for (int i = 0; i < 8; i++) {
        const int idx = rl * 256 + wr2 * 128 + h * 64 + ((i * 64 + lane2) >> 3);
        const int ic = min(idx, cnt - 1);
        const int av = lst[ic]; const float wv = lstw[ic];
        aa[h][i] = idx < cnt ? av : -1; ww[h][i] = wv;
      }
    f4 acc[8][4];
    gemm256<true>([&](int i) { return a0 + (size_t)i * 32 * 512; }, [&](int i) { return b0 + (size_t)i * 32 * 512; }, 8, smem, acc);
    int it2 = it + 1, rt2, nt2;
    const bool have2 = next_tile(it2, MT, 8, rt2, nt2);
    const half_t* a1 = a0; const half_t* b1 = b0;
    if (have2) {
      asm volatile("" : "+s"(rt2), "+s"(nt2));
      ptrs(rt2, nt2, a1, b1);
      gemm_prologue([&](int i) { return a1 + (size_t)i * 32 * 512; }, [&](int i) { return b1 + (size_t)i * 32 * 512; }, 8, smem);
    }
    {
      char* stg = smem + 98304 + wave2 * 12288;
      const int fr2 = lane2 & 15, fq2 = lane2 >> 4;
#pragma unroll
      for (int h = 0; h < 2; h++) {
#pragma unroll
        for (int ml = 0; ml < 4; ml++)
#pragma unroll
          for (int n = 0; n < 4; n++)
#pragma unroll
            for (int j = 0; j < 4; j++) stage_put(stg, ml, n, j, fr2, fq2, acc[h * 4 + ml][n][j]);
        __builtin_amdgcn_wave_barrier();
#pragma unroll
        for (int i = 0; i < 8; i++) {
          const int c = i * 64 + lane2, row = c >> 3, c16 = c & 7;
          h8 v = *(const h8*)(stg + row * 144 + c16 * 16);
          if (aa[h][i] >= 0) {
            const float w = ww[h][i];
#pragma unroll
            for (int u = 0; u < 8; u++) v[u] = (half_t)(w * (float)v[u]);
            *(h8*)(P.yA + (size_t)aa[h][i] * D + nt * 128 + wc2 * 64 + c16 * 8) = v;
          }
        }
        __builtin_amdgcn_wave_barrier();
      }
    }
    rt = rt2; nt = nt2; it = it2; have = have2; a0 = a1; b0 = b1;
  }
}

DI int swap23(int x) { return (x & ~12) | ((x & 4) << 1) | ((x & 8) >> 1); }
DI void attn_item(const Params& P, int l, int b, int head, int row0, int nkeys, char* smem) {
  const int tid = TIDX, lane = tid & 63, wave = tid >> 6, ql = lane & 31, hh = lane >> 5;
  const float lam = P.consts[l * 4 + 0], negc = -P.consts[l * 4 + 1], lam_init = P.consts[l * 4 + 2];
  const int myrow = row0 + wave * 32 + ql;
  h8 qf[2][4];
  {
    const half_t* qp = P.q + (size_t)myrow * 512 + head * 128 + hh * 8;
#pragma unroll
    for (int m = 0; m < 2; m++)
#pragma unroll
      for (int s = 0; s < 4; s++) { qf[m][s] = *(const h8*)(qp + m * 64 + s * 16); }
#pragma unroll
    for (int m = 0; m < 2; m++)
#pragma unroll
      for (int s = 0; s < 4; s++) tie(qf[m][s]);
  }
  f16v o0[4], o1[4];
#pragma unroll
  for (int dt = 0; dt < 4; dt++)
#pragma unroll
    for (int i = 0; i < 16; i++) { o0[dt][i] = 0.f; o1[dt][i] = 0.f; }
  float ls0 = 0.f, ls1 = 0.f;
  const half_t* kp[4]; const half_t* vp[4];
  {
    const half_t* kbase = P.kall + (size_t)b * KV * 512 + head * 128;
    const half_t* vbase = P.vT + (size_t)(b * 4 + head) * 128 * KV;
#pragma unroll
    for (int i = 0; i < 4; i++) {
      int s = i * 256 + tid;
      int row = s >> 4, c = (s & 15) ^ (row & 15); kp[i] = kbase + (size_t)row * 512 + c * 8;
      int vr = s >> 3, vc = (s & 7) ^ ((vr >> 1) & 7); vp[i] = vbase + (size_t)vr * KV + vc * 8;
    }
  }
  const int ntile = nkeys >> 6;
  const unsigned sbase = lds_addr(smem);
  auto issue = [&](int t) {
    char* d = smem + (t & 3) * 32768 + tid * 16;
#pragma unroll
    for (int i = 0; i < 4; i++) { glds16(kp[i] + (size_t)t * 64 * 512, d + i * 4096); glds16(vp[i] + t * 64, d + 16384 + i * 4096); }
  };
  unsigned koff[2];
  const int kr_lo = swap23(ql), ksw = kr_lo & 15;
  koff[0] = kr_lo * 256; koff[1] = (32 + kr_lo) * 256;
  unsigned voff[4];
#pragma unroll
  for (int dt = 0; dt < 4; dt++) { int vrow = dt * 32 + ql; voff[dt] = 16384 + vrow * 128; }
  const int vsw = (ql >> 1) & 7;
  f16v negcv;
#pragma unroll
  for (int i = 0; i < 16; i++) negcv[i] = negc;
  h8 pp0[2], pp1[2];
  unsigned pendV = 0; int pendkt = 0; bool pend = false;
  auto half_step = [&](h8 (&kf)[8], unsigned cur, int kt) {
    h8 vf[8];
    if (pend) {
#pragma unroll
      for (int sp = 0; sp < 2; sp++)
#pragma unroll
        for (int dt = 0; dt < 4; dt++) vf[sp * 4 + dt] = lds128(pendV + voff[dt] + (((pendkt * 4 + sp * 2 + hh) ^ vsw) << 4));
    }
    f16v s0 = mfma32(kf[0], qf[0][0], negcv), s1 = mfma32(kf[4], qf[1][0], negcv);
#pragma unroll
    for (int st = 1; st < 4; st++) { s0 = mfma32(kf[st], qf[0][st], s0); s1 = mfma32(kf[4 + st], qf[1][st], s1); }
    if (pend) {
      WAIT_LGKM(0);
#pragma unroll
      for (int i = 0; i < 8; i++) tie(vf[i]);
#pragma unroll
      for (int sp = 0; sp < 2; sp++)
#pragma unroll
        for (int dt = 0; dt < 4; dt++) { o0[dt] = mfma32(vf[sp * 4 + dt], pp0[sp], o0[dt]); o1[dt] = mfma32(vf[sp * 4 + dt], pp1[sp], o1[dt]); }
    }
#pragma unroll
    for (int i = 0; i < 16; i++) { s0[i] = __builtin_amdgcn_exp2f(s0[i]); ls0 += s0[i]; s1[i] = __builtin_amdgcn_exp2f(s1[i]); ls1 += s1[i]; }
#pragma unroll
    for (int sp = 0; sp < 2; sp++) {
      u4 a, c;
      a[0] = pk2(s0[8*sp+0], s0[8*sp+1]); a[1] = pk2(s0[8*sp+2], s0[8*sp+3]); a[2] = pk2(s0[8*sp+4], s0[8*sp+5]); a[3] = pk2(s0[8*sp+6], s0[8*sp+7]);
      c[0] = pk2(s1[8*sp+0], s1[8*sp+1]); c[1] = pk2(s1[8*sp+2], s1[8*sp+3]); c[2] = pk2(s1[8*sp+4], s1[8*sp+5]); c[3] = pk2(s1[8*sp+6], s1[8*sp+7]);
      pp0[sp] = __builtin_bit_cast(h8, a); pp1[sp] = __builtin_bit_cast(h8, c);
    }
    pend = true; pendV = cur; pendkt = kt;
  };
  issue(0);
  if (ntile > 1) issue(1);
#pragma unroll 1
  for (int t = 0; t < ntile; t++) {
    if (t + 1 < ntile) asm volatile("s_waitcnt vmcnt(8)" ::: "memory"); else wait_vm0();
    raw_barrier();
    if (t + 2 < ntile) issue(t + 2);
    const unsigned cur = sbase + (t & 3) * 32768;
    h8 kfa[8], kfb[8];
#pragma unroll
    for (int st = 0; st < 4; st++) {
      kfa[st] = lds128(cur + koff[0] + (((st * 2 + hh) ^ ksw) << 4));
      kfa[4 + st] = lds128(cur + koff[0] + (((8 + st * 2 + hh) ^ ksw) << 4));
    }
#pragma unroll
    for (int st = 0; st < 4; st++) {
      kfb[st] = lds128(cur + koff[1] + (((st * 2 + hh) ^ ksw) << 4));
      kfb[4 + st] = lds128(cur + koff[1] + (((8 + st * 2 + hh) ^ ksw) << 4));
    }
    WAIT_LGKM(8);
#pragma unroll
    for (int i = 0; i < 8; i++) tie(kfa[i]);
    half_step(kfa, cur, 0);
    WAIT_LGKM(0);
#pragma unroll
    for (int i = 0; i < 8; i++) tie(kfb[i]);
    half_step(kfb, cur, 1);
  }
  {
    h8 vf[8];
#pragma unroll
    for (int sp = 0; sp < 2; sp++)
#pragma unroll
      for (int dt = 0; dt < 4; dt++) vf[sp * 4 + dt] = lds128(pendV + voff[dt] + (((pendkt * 4 + sp * 2 + hh) ^ vsw) << 4));
    WAIT_LGKM(0);
#pragma unroll
    for (int i = 0; i < 8; i++) tie(vf[i]);
#pragma unroll
    for (int sp = 0; sp < 2; sp++)
#pragma unroll
      for (int dt = 0; dt < 4; dt++) { o0[dt] = mfma32(vf[sp * 4 + dt], pp0[sp], o0[dt]); o1[dt] = mfma32(vf[sp * 4 + dt], pp1[sp], o1[dt]); }
  }
  raw_barrier();
  ls0 += shx(ls0, 32); ls1 += shx(ls1, 32);
  const float i0 = 1.f / ls0, i1 = lam / ls1;
  float ss = 0.f;
#pragma unroll
  for (int dt = 0; dt < 4; dt++)
#pragma unroll
    for (int i = 0; i < 16; i++) { float v = o0[dt][i] * i0 - o1[dt][i] * i1; o0[dt][i] = v; ss += v * v; }
  ss += shx(ss, 32);
  const float mult = rsqrtf(ss * (1.f / 128.f) + EPS) * (1.f - lam_init);
  const float* sg = P.subln_g + l * 128;
  half_t* dst = P.mix + (size_t)myrow * D + 256 + head * 128;
#pragma unroll
  for (int dt = 0; dt < 4; dt++)
#pragma unroll
    for (int g = 0; g < 4; g++) {
      const int d0 = dt * 32 + 8 * g + 4 * hh;
      float4 gv = *(const float4*)(sg + d0);
      h4 o; o[0] = (half_t)(o0[dt][4*g] * mult * gv.x); o[1] = (half_t)(o0[dt][4*g+1] * mult * gv.y);
      o[2] = (half_t)(o0[dt][4*g+2] * mult * gv.z); o[3] = (half_t)(o0[dt][4*g+3] * mult * gv.w);
      *(h4*)(dst + d0) = o;
    }
}

DI int swz128(int row, int colh) { return row * 128 + ((((colh >> 3)) ^ ((row >> 1) & 7)) << 4) + (colh & 7) * 2; }
DI void lru_load_w(const Params& P, int l, int g, char* Wt) {
  const int tid = TIDX;
  for (int dg = 0; dg < 4; dg++) {
    const int dir = dg >> 1;
    const float* w = ((dg & 1) ? P.gate_x_w : P.gate_a_w) + ((size_t)((l * 2 + dir) * 4 + g)) * 4096;
    for (int idx = tid; idx < 4096; idx += 256) { int i = idx >> 6, o = idx & 63; *(half_t*)(Wt + dg * 8192 + swz128(o, i)) = (half_t)w[idx]; }
  }
}
struct LruK { float ba[2][4], bx[2][4], sp8[2][4], cw[5]; };
DI void lru_consts(const Params& P, int l, int g, LruK& K) {
  const int tid = TIDX, fr = tid & 15, gc = g * 64 + (tid & 63);
#pragma unroll
  for (int dir = 0; dir < 2; dir++)
#pragma unroll
    for (int n = 0; n < 4; n++) {
      const int cc = (l * 2 + dir) * 256 + g * 64 + n * 16 + fr;
      K.ba[dir][n] = P.gate_a_b[cc]; K.bx[dir][n] = P.gate_x_b[cc]; K.sp8[dir][n] = -8.f * log1pf(__expf(-P.lru_lambda[cc]));
    }
#pragma unroll
  for (int k = 0; k < 4; k++) K.cw[k] = P.conv_w[(l * 4 + k) * 256 + gc];
  K.cw[4] = P.conv_b[l * 256 + gc];
}
DI void lru_tile(const Params& P, int l, int b, int tile, int g, char* smem, bool final, const LruK& K) {
  const int tid = TIDX, lane = tid & 63, wave = tid >> 6, fr = lane & 15, fq = lane >> 4;
  char* Wt = smem;
  char* xr16 = smem + 32768;
  float2* ab = (float2*)(smem + 40960);
  half_t* raw = (half_t*)(smem + 40960);
  float2* subst = (float2*)(smem + 73728);
  const int ch = tid & 63, tq = tid >> 6, gc = g * 64 + ch;
  const int T = tile < 4 ? CL : SEQ;
  const int t0 = tile < 4 ? tile * 64 : (tile - 4) * 64;
  const int rowbase = tile < 4 ? b * CL : TC + b * SEQ;
  unsigned* lab = (unsigned*)P.hx;
  __syncthreads();
  if (final) {
    float gyv[16], hsum[16];
#pragma unroll
    for (int e = 0; e < 16; e++) { gyv[e] = (float)P.gy[(size_t)(rowbase + t0 + tq * 16 + e) * 256 + gc]; hsum[e] = 0.f; }
    unsigned pk0[16], pk1[16];
#pragma unroll
    for (int e = 0; e < 16; e++) { pk0[e] = lab[((size_t)rowbase + t0 + tq * 16 + e) * 256 + gc]; pk1[e] = lab[((size_t)TA + rowbase + t0 + tq * 16 + e) * 256 + gc]; }
    const float car0 = P.lcar[((size_t)((b * 2 + 0) * 132 + tile)) * 256 + gc], car1 = P.lcar[((size_t)((b * 2 + 1) * 132 + tile)) * 256 + gc];
#pragma unroll 1
    for (int dir = 0; dir < 2; dir++) {
      unsigned pk[16];
#pragma unroll
      for (int e = 0; e < 16; e++) pk[e] = dir == 0 ? pk0[e] : pk1[e];
      float2 av[16];
      float A = 1.f, h = 0.f;
#pragma unroll
      for (int e = 0; e < 16; e++) {
        const int ee = dir == 0 ? e : 15 - e;
        unsigned u = pk[0];
#pragma unroll
        for (int q = 1; q < 16; q++) u = (q == ee) ? pk[q] : u;
        fp16x2 hv = __builtin_bit_cast(fp16x2, u);
        av[e] = make_float2(__expf((float)hv[0]), (float)hv[1]);
        h = av[e].x * h + av[e].y; A *= av[e].x;
      }
      subst[tq * 64 + ch] = make_float2(A, h);
      __syncthreads();
      h = dir == 0 ? car0 : car1;
      if (dir == 0) { for (int s2 = 0; s2 < tq; s2++) { float2 ss = subst[s2 * 64 + ch]; h = ss.x * h + ss.y; } }
      else { for (int s2 = 3; s2 > tq; s2--) { float2 ss = subst[s2 * 64 + ch]; h = ss.x * h + ss.y; } }
#pragma unroll
      for (int e = 0; e < 16; e++) {
        const int ee = dir == 0 ? e : 15 - e;
        h = av[e].x * h + av[e].y;
#pragma unroll
        for (int q = 0; q < 16; q++) hsum[q] += (q == ee) ? h : 0.f;
      }
      __syncthreads();
    }
#pragma unroll
    for (int e = 0; e < 16; e++)
      P.mix[(size_t)(rowbase + t0 + tq * 16 + e) * D + 768 + gc] = (half_t)(gyv[e] * hsum[e]);
    return;
  }
  for (int idx = tid; idx < 67 * 8; idx += 256) {
    int row = idx >> 3, c = idx & 7, tt = t0 - 1 + row;
    h8 v = {0, 0, 0, 0, 0, 0, 0, 0};
    if (tt >= 0 && tt < T) v = *(const h8*)(P.rr + (size_t)(rowbase + tt) * 256 + g * 64 + c * 8);
    *(h8*)(raw + row * 64 + c * 8) = v;
  }
  const float cw0 = K.cw[0], cw1 = K.cw[1], cw2 = K.cw[2], cw3 = K.cw[3], cb = K.cw[4];
  __syncthreads();
  {
    float v[19];
#pragma unroll
    for (int e = 0; e < 19; e++) v[e] = (float)raw[(tq * 16 + e) * 64 + ch];
    __syncthreads();
#pragma unroll
    for (int e = 0; e < 16; e++) {
      float xv = cb + cw0 * v[e] + cw1 * v[e + 1] + cw2 * v[e + 2] + cw3 * v[e + 3];
      *(half_t*)(xr16 + swz128(tq * 16 + e, ch)) = (half_t)xv;
    }
  }
  __syncthreads();
#pragma unroll 1
  for (int dir = 0; dir < 2; dir++) {
    {
      f4 acc[2][4];
#pragma unroll
      for (int gt = 0; gt < 2; gt++)
#pragma unroll
        for (int n = 0; n < 4; n++) acc[gt][n] = (f4){0.f, 0.f, 0.f, 0.f};
#pragma unroll
      for (int kk = 0; kk < 2; kk++) {
        int row = wave * 16 + fr;
        h8 af = *(const h8*)(xr16 + row * 128 + (((kk * 4 + fq) ^ ((row >> 1) & 7)) << 4));
#pragma unroll
        for (int gt = 0; gt < 2; gt++)
#pragma unroll
          for (int n = 0; n < 4; n++) {
            int orow = n * 16 + fr;
            h8 bf = *(const h8*)(Wt + (dir * 2 + gt) * 8192 + orow * 128 + (((kk * 4 + fq) ^ ((orow >> 1) & 7)) << 4));
            acc[gt][n] = mfma16(af, bf, acc[gt][n]);
          }
      }
#pragma unroll
      for (int n = 0; n < 4; n++) {
        const float ba = dir == 0 ? K.ba[0][n] : K.ba[1][n], bx = dir == 0 ? K.bx[0][n] : K.bx[1][n], sp8 = dir == 0 ? K.sp8[0][n] : K.sp8[1][n];
#pragma unroll
        for (int j = 0; j < 4; j++) {
          int tl = wave * 16 + fq * 4 + j, c2 = n * 16 + fr;
          float xv = (float)*(const half_t*)(xr16 + swz128(tl, c2));
          float rg = sigmoidf_(acc[0][n][j] + ba), ig = sigmoidf_(acc[1][n][j] + bx);
          float log_a = rg * sp8;
          float x2 = 2.f * log_a;
          float om = -x2 * (1.f + x2 * (0.5f + x2 * (0.16666667f + x2 * (0.041666668f + x2 * (0.008333334f + x2 * 0.0013888889f)))));
          if (x2 < -0.4f) { float a = __expf(log_a); om = 1.f - a * a; }
          ab[tl * 64 + c2] = make_float2(log_a, sqrtf(om) * (ig * xv));
        }
      }
    }
    __syncthreads();
    {
      float A = 1.f, h = 0.f;
#pragma unroll
      for (int e = 0; e < 16; e++) {
        const int ee = dir == 0 ? e : 15 - e;
        const float2 lb = ab[(tq * 16 + ee) * 64 + ch];
        fp16x2 hv; hv[0] = (__fp16)lb.x; hv[1] = (__fp16)lb.y;
        lab[((size_t)dir * TA + rowbase + t0 + tq * 16 + ee) * 256 + gc] = __builtin_bit_cast(unsigned, hv);
        const float a = __expf((float)hv[0]), bt = (float)hv[1];
        h = a * h + bt; A *= a;
      }
      subst[tq * 64 + ch] = make_float2(A, h);
    }
    __syncthreads();
    if (tq == 0) {
      float A = 1.f, h = 0.f;
#pragma unroll
      for (int s2 = 0; s2 < 4; s2++) { float2 ss = subst[(dir == 0 ? s2 : 3 - s2) * 64 + ch]; h = ss.x * h + ss.y; A *= ss.x; }
      P.lsum[((size_t)((b * 2 + dir) * 132 + tile)) * 256 + gc] = make_float2(A, h);
    }
    __syncthreads();
  }
}
DI void lru_carry_item(const Params& P, int it) {
  const int ch = TIDX, dir = it & 1;
  const size_t base = (size_t)it * 132 * 256 + ch;
  float c = 0.f;
#pragma unroll 4
  for (int k = 0; k < 132; k++) {
    int tile = dir == 0 ? k : (k < 4 ? 3 - k : 135 - k);
    float2 s = P.lsum[base + (size_t)tile * 256];
    P.lcar[base + (size_t)tile * 256] = c;
    c = s.x * c + s.y;
  }
}

template <int NROWS>
DI void fft_load(const half_t* src, size_t rs, char* Bt, int rowbytes, int k0) {
  const int tid = TIDX;
  h8 v[NROWS / 16];
#pragma unroll
  for (int i = 0; i < NROWS / 16; i++) { int idx = i * 256 + tid; v[i] = *(const h8*)(src + (size_t)(idx >> 4) * rs + (idx & 15) * 8); }
#pragma unroll
  for (int i = 0; i < NROWS / 16; i++) {
    int idx = i * 256 + tid, kr = idx >> 4, cc = idx & 15, k = k0 + kr;
#pragma unroll
    for (int u = 0; u < 8; u++) { int n = cc * 8 + u; *(half_t*)(Bt + n * rowbytes + ((((k >> 3)) ^ (n & 15)) << 4) + (k & 7) * 2) = v[i][u]; }
  }
}
template <class RF>
DI void fft_mma(const half_t* Dm, int ldD, int nkk, const char* Bt, int rowbytes, f4 (&acc)[4][4], RF arow) {
  const int lane = TIDX & 63, wave = TIDX >> 6, fr = lane & 15, fq = lane >> 4, wc = wave & 1;
#pragma unroll 4
  for (int kk = 0; kk < nkk; kk++) {
    h8 af[4], bf[4];
#pragma unroll
    for (int ms = 0; ms < 4; ms++) af[ms] = *(const h8*)(Dm + (size_t)arow(ms) * ldD + kk * 32 + fq * 8);
#pragma unroll
    for (int ns = 0; ns < 4; ns++) { int n = wc * 64 + ns * 16 + fr; bf[ns] = *(const h8*)(Bt + n * rowbytes + (((kk * 4 + fq) ^ (n & 15)) << 4)); }
#pragma unroll
    for (int ms = 0; ms < 4; ms++)
#pragma unroll
      for (int ns = 0; ns < 4; ns++) acc[ms][ns] = mfma16(af[ms], bf[ns], acc[ms][ns]);
  }
}
DI void zero44(f4 (&acc)[4][4]) {
#pragma unroll
  for (int m = 0; m < 4; m++)
#pragma unroll
    for (int n = 0; n < 4; n++) acc[m][n] = (f4){0.f, 0.f, 0.f, 0.f};
}
DI void fftA_item(const Params& P, int it, char* smem) {
  const int b = it >> 8, bb = (it >> 1) & 127, chh = it & 1;
  const int lane = TIDX & 63, wave = TIDX >> 6, fr = lane & 15, fq = lane >> 4, wr = wave >> 1, wc = wave & 1;
  __syncthreads();
  fft_load<64>(P.QF + (size_t)(TC + b * SEQ + bb) * 512 + chh * 128, (size_t)128 * 512, smem, 256, 0);
  fft_load<64>(P.QF + (size_t)(TC + b * SEQ + bb) * 512 + 256 + chh * 128, (size_t)128 * 512, smem, 256, 64);
  __syncthreads();
  f4 acc[4][4]; zero44(acc);
  fft_mma(P.DA, 128, 4, smem, 256, acc, [&](int ms) { return (ms >> 1) * 64 + wr * 32 + (ms & 1) * 16 + fr; });
#pragma unroll
  for (int ms = 0; ms < 2; ms++)
#pragma unroll
    for (int j = 0; j < 4; j++) {
      const int f1 = wr * 32 + ms * 16 + fq * 4 + j;
      const float2 w = P.tw[(bb * f1) & 8191];
      half_t* d0 = P.GA + ((size_t)(b * 64 + f1) * 256 + bb) * 256 + chh * 128 + wc * 64 + fr;
#pragma unroll
      for (int ns = 0; ns < 4; ns++) {
        float gr = acc[ms][ns][j], gi = acc[ms + 2][ns][j];
        d0[ns * 16] = (half_t)(gr * w.x + gi * w.y);
        d0[(size_t)128 * 256 + ns * 16] = (half_t)(gi * w.x - gr * w.y);
      }
    }
}
DI void fftB_item(const Params& P, int it, char* smem) {
  const int b = it >> 7, f1 = (it >> 1) & 63, chh = it & 1;
  const int lane = TIDX & 63, wave = TIDX >> 6, fr = lane & 15, fq = lane >> 4, wr = wave >> 1, wc = wave & 1;
  __syncthreads();
  fft_load<256>(P.GA + (size_t)(b * 64 + f1) * 256 * 256 + chh * 128, 256, smem, 512, 0);
  __syncthreads();
  f4 acc[4][4]; zero44(acc);
  fft_mma(P.DB, 256, 8, smem, 512, acc, [&](int ms) { return wr * 64 + ms * 16 + fr; });
#pragma unroll
  for (int ms = 0; ms < 4; ms++)
#pragma unroll
    for (int j = 0; j < 4; j++) {
      const int f2 = wr * 64 + ms * 16 + fq * 4 + j;
      half_t* d0 = P.mix + (size_t)(TC + b * SEQ + f1 + 64 * f2) * D + chh * 128 + wc * 64 + fr;
#pragma unroll
      for (int ns = 0; ns < 4; ns++) d0[ns * 16] = (half_t)acc[ms][ns][j];
    }
}
DI void fftC_item(const Params& P, int it, char* smem) {
  const int b = it >> 1, chh = it & 1;
  const int lane = TIDX & 63, wave = TIDX >> 6, fr = lane & 15, fq = lane >> 4, wr = wave >> 1, wc = wave & 1;
#pragma unroll 1
  for (int mh = 0; mh < 2; mh++) {
    f4 acc[4][4]; zero44(acc);
#pragma unroll 1
    for (int part = 0; part < 2; part++) {
      __syncthreads();
      fft_load<256>(P.QF + (size_t)(b * CL) * 512 + part * 256 + chh * 128, 512, smem, 512, 0);
      __syncthreads();
      fft_mma(P.DC + part * 256, 512, 8, smem, 512, acc, [&](int ms) { return mh * 128 + wr * 64 + ms * 16 + fr; });
    }
#pragma unroll
    for (int ms = 0; ms < 4; ms++)
#pragma unroll
      for (int j = 0; j < 4; j++) {
        const int f = mh * 128 + wr * 64 + ms * 16 + fq * 4 + j;
        half_t* d0 = P.mix + (size_t)(b * CL + f) * D + chh * 128 + wc * 64 + fr;
#pragma unroll
        for (int ns = 0; ns < 4; ns++) d0[ns * 16] = (half_t)acc[ms][ns][j];
      }
  }
}

#ifndef MX
#define MX 15
#endif
DI void mix_phase(const Params& P, int l, char* smem, int* s_item, int qi) {
  const int nL = 0, nA = 0, nC = l == 0 ? 64 : 0, nFA = 2048, nFC = l == 0 ? 16 : 0;
  const int total = nL + nA + nC + nFA + nFC;
  {
    const int g = blockIdx.x & 3;
    lru_load_w(P, l, g, smem);
    LruK K; lru_consts(P, l, g, K);
    for (int u = blockIdx.x >> 2; u < NB_ * 132; u += gridDim.x >> 2) lru_tile(P, l, u / 132, u % 132, g, smem, false, K);
    asm volatile("s_waitcnt vmcnt(0)" ::: "memory");
    __syncthreads();
    if (TIDX == 0) {
      __builtin_amdgcn_fence(__ATOMIC_RELEASE, "agent");
      asm volatile("s_waitcnt vmcnt(0)" ::: "memory");
      __hip_atomic_fetch_add((unsigned*)&P.qctr[48 + l], 1u, __ATOMIC_RELAXED, __HIP_MEMORY_SCOPE_AGENT);
    }
  }
  int stage = 0;
  for (;;) {
    __syncthreads();
    if (TIDX == 0) *s_item = stage == 0 ? atomicAdd(&P.qctr[8 + qi * 8 + (blockIdx.x & 7)], 1) : atomicAdd(&P.qctr[qi], 1);
    __syncthreads();
    int it = *s_item;
    int kind = -1, b = 0, head = 0, row0 = 0, nk = 0;
    if (stage == 0) {
      if (it >= 256) {
        stage = 1;
        if (blockIdx.x >= gridDim.x - 16) {
          if (TIDX == 0) {
            while (__hip_atomic_load((unsigned*)&P.qctr[48 + l], __ATOMIC_RELAXED, __HIP_MEMORY_SCOPE_AGENT) < gridDim.x) __builtin_amdgcn_s_sleep(1);
            __builtin_amdgcn_fence(__ATOMIC_ACQUIRE, "agent");
            asm volatile("s_waitcnt vmcnt(0)" ::: "memory");
          }
          __syncthreads();
          lru_carry_item(P, gridDim.x - 1 - blockIdx.x);
        }
        continue;
      }
      const int pair = (blockIdx.x & 7) + 8 * (it >> 6);
      b = pair >> 2; head = pair & 3; row0 = TC + b * SEQ + (it & 63) * 128; nk = KV; kind = 0;
    } else {
      if (it >= total) break;
      if (it < nFC) { kind = 2; }
      else if (it < nFC + nC) { it -= nFC; b = it >> 3; head = (it >> 1) & 3; row0 = b * CL + (it & 1) * 128; nk = CL; kind = 0; }
      else { kind = 1; it -= nFC + nC; }
    }
    if (kind == 0) attn_item(P, l, b, head, row0, nk, smem);
    else if (kind == 1) fftA_item(P, it, smem);
    else fftC_item(P, it, smem);
  }
}

DI void grid_barrier(unsigned* bar, unsigned k, unsigned xn, unsigned nx) {
  asm volatile("s_waitcnt vmcnt(0)" ::: "memory");
  __syncthreads();
  if (threadIdx.x == 0) {
    const unsigned x = (unsigned)__builtin_amdgcn_s_getreg((3 << 11) | 20) & 0x7u;
    unsigned* xc = bar + 16 + x * 16; unsigned* top = bar;
    const unsigned old = __hip_atomic_fetch_add(xc, 1u, __ATOMIC_RELAXED, __HIP_MEMORY_SCOPE_AGENT);
    if (old == k * xn - 1u) {
      __builtin_amdgcn_fence(__ATOMIC_RELEASE, "agent");
      asm volatile("s_waitcnt vmcnt(0)" ::: "memory");
      __hip_atomic_fetch_add(top, 1u, __ATOMIC_RELAXED, __HIP_MEMORY_SCOPE_AGENT);
    }
    while (__hip_atomic_load(top, __ATOMIC_RELAXED, __HIP_MEMORY_SCOPE_AGENT) < k * nx) __builtin_amdgcn_s_sleep(1);
    __builtin_amdgcn_fence(__ATOMIC_ACQUIRE, "agent");
    asm volatile("s_waitcnt vmcnt(0)" ::: "memory");
  }
  __syncthreads();
}
__global__ void __launch_bounds__(256, 1) fwd_megakernel(Params Pin) {
  Params P = Pin; bind_ws(P);
  __shared__ __attribute__((aligned(16))) char smem[147456 + 8192];
  __shared__ int tb[33];
  __shared__ int s_item;
  cg::grid_group grid = cg::this_grid();
  unsigned* bar = (unsigned*)(P.ws + O_bar); unsigned bk = 0;
  if (threadIdx.x == 0) __hip_atomic_fetch_add(bar + 160 + ((unsigned)__builtin_amdgcn_s_getreg((3 << 11) | 20) & 0x7u), 1u, __ATOMIC_RELAXED, __HIP_MEMORY_SCOPE_AGENT);
#ifndef PH
#define PH 0xFFFF
#endif
#if PH & 1
  phase0(P, smem);
#endif
  grid.sync();
  unsigned xn, nx = 0;
  {
    const unsigned myx = (unsigned)__builtin_amdgcn_s_getreg((3 << 11) | 20) & 0x7u;
    xn = __hip_atomic_load(bar + 160 + myx, __ATOMIC_RELAXED, __HIP_MEMORY_SCOPE_AGENT);
#pragma unroll
    for (int x = 0; x < 8; x++) nx += __hip_atomic_load(bar + 160 + x, __ATOMIC_RELAXED, __HIP_MEMORY_SCOPE_AGENT) != 0u;
  }
  for (int l = 0; l < 2; l++) {
#if PH & 2
    row1_phase(P, l == 0 ? -1 : 0, l, 0);
#endif
    grid_barrier(bar, ++bk, xn, nx);
#if PH & 4
    gemm_in_phase(P, l, smem);
#ifdef DUP_GEMM
    grid_barrier(bar, ++bk, xn, nx);
    gemm_in_phase(P, l, smem);
#endif
#endif
    grid_barrier(bar, ++bk, xn, nx);
#if PH & 8
    mix_phase(P, l, smem, &s_item, l);
#ifdef DUP_MIX
    grid_barrier(bar, ++bk, xn, nx);
    mix_phase(P, l, smem, &s_item, 2 + l);
#endif
#endif
    grid_barrier(bar, ++bk, xn, nx);
#if PH & 16
    for (int it = blockIdx.x; it < 1024; it += gridDim.x) fftB_item(P, it, smem);
#endif
#if PH & 512
    {
      const int g = blockIdx.x & 3;
      LruK K{};
      for (int u = blockIdx.x >> 2; u < NB_ * 132; u += gridDim.x >> 2) lru_tile(P, l, u / 132, u % 132, g, smem, true, K);
    }
#endif
    grid_barrier(bar, ++bk, xn, nx);
#if PH & 32
    gemm_out_phase(P, l, smem);
#endif
    grid_barrier(bar, ++bk, xn, nx);
#if PH & 64
    row2_phase(P, l, l == 0 ? 0 : TC, smem);
#endif
    grid_barrier(bar, ++bk, xn, nx);
#if PH & 128
    moe_e1_phase(P, l, smem, tb);
#ifdef DUP_GEMM
    grid_barrier(bar, ++bk, xn, nx);
    moe_e1_phase(P, l, smem, tb);
#endif
#endif
    grid_barrier(bar, ++bk, xn, nx);
#if PH & 256
    moe_e2_phase(P, l, smem, tb);
#ifdef DUP_GEMM
    grid_barrier(bar, ++bk, xn, nx);
    moe_e2_phase(P, l, smem, tb);
#endif
#endif
    grid_barrier(bar, ++bk, xn, nx);
  }
#if PH & 2
  row1_phase(P, 1, -1, TC);
#endif
}

extern "C" void kernel_launch(void* const* d_in, const int* in_sizes, int n_in, void* d_out, int out_size, void* d_ws, size_t ws_size,
                              hipStream_t stream) {
  static int grid_blocks = 0;
  if (!grid_blocks) {
    int dev = 0, cus = 0, per_cu = 0;
    hipGetDevice(&dev);
    hipDeviceGetAttribute(&cus, hipDeviceAttributeMultiprocessorCount, dev);
    hipOccupancyMaxActiveBlocksPerMultiprocessor(&per_cu, fwd_megakernel, 256, 0);
    if (per_cu > 2) per_cu = 2;
    grid_blocks = cus * per_cu;
    if (grid_blocks > 256) grid_blocks = 256;
  }
  if (grid_blocks != 256) { fprintf(stderr, "need 256 co-resident blocks, have %d\n", grid_blocks); return; }
  Params p{};
  const float** pin = (const float**)&p;
  for (int i = 0; i < 31; i++) pin[i] = (const float*)d_in[i];
  p.out = (float*)d_out;
  p.ws = (char*)d_ws;
  if (WS_NEED > ws_size) { fprintf(stderr, "workspace too small: need %zu have %zu\n", (size_t)WS_NEED, ws_size); return; }
  hipMemsetAsync((char*)d_ws + O_bar, 0, 1024, stream);
  void* args[] = {&p};
  hipError_t e = hipLaunchCooperativeKernel((void*)fwd_megakernel, dim3(grid_blocks), dim3(256), args, 0, stream);
  if (e != hipSuccess) fprintf(stderr, "cooperative launch failed: %s (grid %d)\n", hipGetErrorString(e), grid_blocks);
}
```
